# Optimizing an MI355X kernel written in HIP

```python
import math
import jax, jax.numpy as jnp
from jax import lax
import numpy as np

D_MODEL = 1024
BATCH = 4
SEQ = 8192
DEPTH = 2

N_BRANCH = 4
BRANCH_WIDTH = 256
NORM_EPS = 1e-6
NEG_INF = -1e30

GLA_HEADS = 4
GLA_DK = 32
GLA_DV = 64
GLA_LOWRANK = 16
GLA_TAU = 16.0
GLA_CHUNK = 64

SWA_HEADS = 4
SWA_KV_HEADS = 2
SWA_HD = 64
SWA_WINDOW = 128

MOBA_HEADS = 4
MOBA_HD = 64
MOBA_BLOCK = 256
MOBA_TOPK = 3
MOBA_QCHUNK = 64

RET_HEADS = 4
RET_DK = 32
RET_DV = 64
RET_CHUNK = 128
RET_ROPE_BASE = 10000.0

N_GROUPS = 4
EXPERTS_PER_GROUP = 8
N_EXPERTS = N_GROUPS * EXPERTS_PER_GROUP
EXPERT_TOPK = 2
EXPERT_HIDDEN = 256
MOE_BLOCK = 256

IN_LAYOUT = (
    ('gla_q', GLA_HEADS * GLA_DK), ('gla_k', GLA_HEADS * GLA_DK), ('gla_v', GLA_HEADS * GLA_DV),
    ('gla_r', GLA_HEADS * GLA_DV), ('gla_a', GLA_LOWRANK),
    ('swa_q', SWA_HEADS * SWA_HD), ('swa_k', SWA_KV_HEADS * SWA_HD), ('swa_v', SWA_KV_HEADS * SWA_HD),
    ('moba_q', MOBA_HEADS * MOBA_HD), ('moba_k', MOBA_HEADS * MOBA_HD), ('moba_v', MOBA_HEADS * MOBA_HD),
    ('ret_q', RET_HEADS * RET_DK), ('ret_k', RET_HEADS * RET_DK), ('ret_v', RET_HEADS * RET_DV),
    ('ret_g', RET_HEADS * RET_DV),
    ('gates', N_BRANCH * D_MODEL),
)
IN_WIDTH = sum(w for _, w in IN_LAYOUT)

kernel_name = 'hybrid_gla_swa_moba_retention_hmoe'


def rms_norm(x, g):
    xf = x.astype(jnp.float32)
    y = xf * lax.rsqrt(jnp.mean(xf * xf, axis=-1, keepdims=True) + NORM_EPS)
    return (y * g.astype(jnp.float32)).astype(x.dtype)


def split_columns(z):
    parts, off = {}, 0
    for name, width in IN_LAYOUT:
        parts[name] = z[..., off:off + width]
        off += width
    return parts


def gla_mixer(q, k, v, r, a_lr, w_a2, b_a, norm_g):
    B, S, _ = q.shape
    H, DK, DV, C = GLA_HEADS, GLA_DK, GLA_DV, GLA_CHUNK
    N = S // C
    f32 = jnp.float32

    def chunked(t, d):
        return t.astype(f32).reshape(B, N, C, H, d).transpose(0, 3, 1, 2, 4)

    log_a = jax.nn.log_sigmoid((a_lr @ w_a2 + b_a).astype(f32)) / GLA_TAU
    b = jnp.cumsum(chunked(log_a, DK), axis=3)
    b_last = b[:, :, :, -1:, :]
    qc = chunked(q, DK) * (DK ** -0.5)
    kc = chunked(k, DK)
    vc = chunked(v, DV)
    q_dec = qc * jnp.exp(b)
    k_dec = kc * jnp.exp(-b)
    causal = jnp.tril(jnp.ones((C, C), dtype=bool))
    att = jnp.where(causal, jnp.einsum('bhnid,bhnjd->bhnij', q_dec, k_dec), 0.0)
    o = jnp.einsum('bhnij,bhnje->bhnie', att, vc)
    kv = jnp.einsum('bhnjd,bhnje->bhnde', kc * jnp.exp(b_last - b), vc)
    decay = jnp.exp(b_last[:, :, :, 0, :])

    def step(state, inp):
        dec, kv_n = inp
        return dec[..., None] * state + kv_n, state

    _, prev = lax.scan(step, jnp.zeros((B, H, DK, DV), f32),
                       (jnp.moveaxis(decay, 2, 0), jnp.moveaxis(kv, 2, 0)))
    o = o + jnp.einsum('bhnid,bhnde->bhnie', q_dec, jnp.moveaxis(prev, 0, 2))
    o = o.transpose(0, 2, 3, 1, 4).reshape(B, S, H, DV)
    o = rms_norm(o, norm_g) * jax.nn.silu(r.astype(f32).reshape(B, S, H, DV))
    return o.reshape(B, S, H * DV).astype(q.dtype)


def swa_mixer(q, k, v, sinks):
    B, S, _ = q.shape
    H, KV, HD, W = SWA_HEADS, SWA_KV_HEADS, SWA_HD, SWA_WINDOW
    G = H // KV
    NB = S // W
    f32 = jnp.float32
    qb = q.reshape(B, NB, W, KV, G, HD).transpose(0, 3, 4, 1, 2, 5)

    def band(t):
        t = t.reshape(B, NB, W, KV, HD).transpose(0, 3, 1, 2, 4)
        prev = jnp.pad(t, ((0, 0), (0, 0), (1, 0), (0, 0), (0, 0)))[:, :, :-1]
        return jnp.concatenate([prev, t], axis=3)

    kb, vb = band(k), band(v)
    s = jnp.einsum('bkgnqd,bknsd->bkgnqs', qb, kb).astype(f32) * (HD ** -0.5)
    qi = jnp.arange(W)[:, None]
    sj = jnp.arange(2 * W)[None, :]
    in_window = (sj > qi) & (sj <= qi + W)
    started = (jnp.arange(NB)[:, None, None] > 0) | (sj[None] >= W)
    s = jnp.where(in_window[None] & started, s, NEG_INF)
    sink = sinks.astype(f32).reshape(KV, G)[None, :, :, None, None]
    m = jnp.maximum(jnp.max(s, axis=-1), sink)
    p = jnp.exp(s - m[..., None])
    denom = jnp.sum(p, axis=-1) + jnp.exp(sink - m)
    o = jnp.einsum('bkgnqs,bknsd->bkgnqd', p, vb.astype(f32)) / denom[..., None]
    o = o.transpose(0, 3, 4, 1, 2, 5).reshape(B, S, H * HD)
    return o.astype(q.dtype)


def moba_mixer(q, k, v):
    B, S, _ = q.shape
    H, HD, BLK, QC = MOBA_HEADS, MOBA_HD, MOBA_BLOCK, MOBA_QCHUNK
    NBK = -(-S // BLK)
    SP = NBK * BLK
    NQ = SP // QC
    f32 = jnp.float32
    scale = HD ** -0.5

    def heads(t):
        t = t.reshape(B, S, H, HD).transpose(0, 2, 1, 3)
        return jnp.pad(t, ((0, 0), (0, 0), (0, SP - S), (0, 0)))

    qh, kh, vh = heads(q), heads(k), heads(v)
    kb = kh.reshape(B, H, NBK, BLK, HD)
    vb = vh.reshape(B, H, NBK, BLK, HD)
    k_mean = jnp.mean(kb.astype(f32), axis=3)
    gate = jnp.einsum('bhsd,bhnd->bhsn', qh.astype(f32), k_mean)
    q_blk = jnp.arange(SP) // BLK
    past = jnp.arange(NBK)[None, :] < q_blk[:, None]
    gate = jnp.where(past, gate, NEG_INF)
    n_sel = min(MOBA_TOPK, max(NBK - 1, 1))
    _, sel = lax.top_k(gate, n_sel)
    sel_valid = sel < q_blk[:, None]

    def chunks(t):
        return jnp.moveaxis(t.reshape((B, H, NQ, QC) + t.shape[3:]), 2, 0)

    b_ix = jnp.arange(B)[:, None, None, None]
    h_ix = jnp.arange(H)[None, :, None, None]

    def attend(args):
        qc, selc, validc, c = args
        blk = (c * QC) // BLK
        k_own = lax.dynamic_index_in_dim(kb, blk, axis=2, keepdims=False)
        v_own = lax.dynamic_index_in_dim(vb, blk, axis=2, keepdims=False)
        q_pos = c * QC + jnp.arange(QC)
        k_pos = blk * BLK + jnp.arange(BLK)
        s_own = jnp.einsum('bhqd,bhkd->bhqk', qc, k_own).astype(f32)
        s_own = jnp.where(k_pos[None, :] <= q_pos[:, None], s_own, NEG_INF)
        k_sel = kb[b_ix, h_ix, selc]
        v_sel = vb[b_ix, h_ix, selc]
        s_sel = jnp.einsum('bhqd,bhqnkd->bhqnk', qc, k_sel).astype(f32)
        s_sel = jnp.where(validc[..., None], s_sel, NEG_INF).reshape(B, H, QC, n_sel * BLK)
        p = jax.nn.softmax(jnp.concatenate([s_own, s_sel], axis=-1), axis=-1)
        o = jnp.einsum('bhqk,bhkd->bhqd', p[..., :BLK], v_own.astype(f32))
        o = o + jnp.einsum('bhqnk,bhqnkd->bhqd', p[..., BLK:].reshape(B, H, QC, n_sel, BLK),
                           v_sel.astype(f32))
        return o.astype(qc.dtype)

    out = lax.map(attend, (chunks(qh * scale), chunks(sel), chunks(sel_valid), jnp.arange(NQ)))
    out = jnp.moveaxis(out, 0, 2).reshape(B, H, SP, HD)[:, :, :S]
    return out.transpose(0, 2, 1, 3).reshape(B, S, H * HD)


def retention_mixer(q, k, v, g, norm_g):
    B, S, _ = q.shape
    H, DK, DV, C = RET_HEADS, RET_DK, RET_DV, RET_CHUNK
    N = S // C
    half = DK // 2
    f32 = jnp.float32
    pos = jnp.arange(S, dtype=f32)
    inv_freq = RET_ROPE_BASE ** (-jnp.arange(half, dtype=f32) * 2.0 / DK)
    ang = pos[:, None] * inv_freq[None, :]
    cos = jnp.cos(ang)[:, None, :]
    sin = jnp.sin(ang)[:, None, :]

    def rotate(t):
        t1, t2 = t[..., :half], t[..., half:]
        return jnp.concatenate([t1 * cos - t2 * sin, t1 * sin + t2 * cos], axis=-1)

    def chunked(t, d):
        return t.reshape(B, N, C, H, d).transpose(0, 3, 1, 2, 4)

    qc = chunked(rotate(q.astype(f32).reshape(B, S, H, DK)), DK)
    kc = chunked(rotate(k.astype(f32).reshape(B, S, H, DK)), DK) * (DK ** -0.5)
    vc = chunked(v.astype(f32).reshape(B, S, H, DV), DV)
    log_gamma = jnp.log1p(-jnp.exp2(-5.0 - jnp.arange(H, dtype=f32)))
    idx = jnp.arange(C, dtype=f32)
    rel = idx[:, None] - idx[None, :]
    decay_mat = jnp.where(rel >= 0, jnp.exp(jnp.maximum(rel, 0.0)[None] * log_gamma[:, None, None]), 0.0)
    att = jnp.einsum('bhnid,bhnjd->bhnij', qc, kc) * decay_mat[None, :, None]
    o = jnp.einsum('bhnij,bhnje->bhnie', att, vc)
    key_decay = jnp.exp((C - 1 - idx)[None, :] * log_gamma[:, None])
    query_decay = jnp.exp((idx + 1)[None, :] * log_gamma[:, None])
    chunk_decay = jnp.exp(C * log_gamma)
    kv = jnp.einsum('bhnjd,bhnje->bhnde', kc * key_decay[None, :, None, :, None], vc)

    def step(state, kv_n):
        return chunk_decay[None, :, None, None] * state + kv_n, state

    _, prev = lax.scan(step, jnp.zeros((B, H, DK, DV), f32), jnp.moveaxis(kv, 2, 0))
    o = o + jnp.einsum('bhnid,bhnde->bhnie', qc, jnp.moveaxis(prev, 0, 2)) * query_decay[None, :, None, :, None]
    o = o.transpose(0, 2, 3, 1, 4).reshape(B, S, H, DV)
    o = rms_norm(o, norm_g) * jax.nn.silu(g.astype(f32).reshape(B, S, H, DV))
    return o.reshape(B, S, H * DV).astype(q.dtype)


def token_mixer(u, w_in, gla_w_a2, gla_b_a, gla_norm_g, swa_sinks, ret_norm_g, w_branch, w_out):
    p = split_columns(u @ w_in)
    branches = (
        gla_mixer(p['gla_q'], p['gla_k'], p['gla_v'], p['gla_r'], p['gla_a'], gla_w_a2, gla_b_a, gla_norm_g),
        swa_mixer(p['swa_q'], p['swa_k'], p['swa_v'], swa_sinks),
        moba_mixer(p['moba_q'], p['moba_k'], p['moba_v']),
        retention_mixer(p['ret_q'], p['ret_k'], p['ret_v'], p['ret_g'], ret_norm_g),
    )
    gates = p['gates']
    merged = None
    for i, o in enumerate(branches):
        term = jax.nn.sigmoid(gates[..., i * D_MODEL:(i + 1) * D_MODEL]) * (o @ w_branch[i])
        merged = term if merged is None else merged + term
    return merged @ w_out


def hier_moe(u, w_group, b_group, w_expert, b_expert, w1, w3, w2):
    B, S, D = u.shape
    T = B * S
    TK = T * EXPERT_TOPK
    f32 = jnp.float32
    xt = u.reshape(T, D)
    p_group = jax.nn.softmax((xt @ w_group + b_group).astype(f32), axis=-1)
    g_sel = jnp.argmax(p_group, axis=-1)
    g_w = jnp.take_along_axis(p_group, g_sel[:, None], axis=1)[:, 0]
    e_logits = (xt @ w_expert + b_expert).astype(f32).reshape(T, N_GROUPS, EXPERTS_PER_GROUP)
    e_logits = jnp.take_along_axis(e_logits, g_sel[:, None, None], axis=1)[:, 0]
    top_logit, top_local = lax.top_k(e_logits, EXPERT_TOPK)
    top_w = jax.nn.softmax(top_logit, axis=-1) * g_w[:, None]
    expert_id = (g_sel[:, None] * EXPERTS_PER_GROUP + top_local).reshape(TK).astype(jnp.int32)
    weight = top_w.reshape(TK).astype(u.dtype)
    token_id = jnp.repeat(jnp.arange(T, dtype=jnp.int32), EXPERT_TOPK)

    n_blocks = -(-TK // MOE_BLOCK) + N_EXPERTS
    P = n_blocks * MOE_BLOCK
    order = jnp.argsort(expert_id)
    e_sorted = expert_id[order]
    counts = jnp.bincount(expert_id, length=N_EXPERTS)
    padded = ((counts + MOE_BLOCK - 1) // MOE_BLOCK) * MOE_BLOCK
    start = jnp.cumsum(counts) - counts
    pend = jnp.cumsum(padded)
    pstart = pend - padded
    dest = pstart[e_sorted] + jnp.arange(TK, dtype=jnp.int32) - start[e_sorted]
    slot_tok = jnp.full((P,), T, dtype=jnp.int32).at[dest].set(token_id[order])
    slot_w = jnp.zeros((P,), dtype=u.dtype).at[dest].set(weight[order])
    blk_e = jnp.clip(jnp.searchsorted(pend, jnp.arange(n_blocks, dtype=pend.dtype) * MOE_BLOCK, side='right'),
                     0, N_EXPERTS - 1)
    x_pad = jnp.concatenate([xt, jnp.zeros((1, D), xt.dtype)], axis=0)
    xs = x_pad[slot_tok].reshape(n_blocks, MOE_BLOCK, D)

    def expert_block(args):
        xb, e = args
        hdn = jax.nn.silu(xb @ w1[e]) * (xb @ w3[e])
        return hdn @ w2[e]

    ys = lax.map(expert_block, (xs, blk_e)).reshape(P, D)
    out = jnp.zeros((T + 1, D), ys.dtype).at[slot_tok].add(ys * slot_w[:, None])[:T]
    return out.reshape(B, S, D)


def setup_inputs(seed: int = 0) -> dict:
    key = jax.random.key(seed)
    ks = jax.random.split(key, 19)
    f32 = jnp.float32
    L, D = DEPTH, D_MODEL

    def nrm(k, shape, scale):
        return jax.random.normal(k, shape, f32) * scale

    return {
        'x': nrm(ks[0], (BATCH, SEQ, D), 1.0),
        'ln1_g': 1.0 + nrm(ks[1], (L, D), 0.02),
        'w_in': nrm(ks[2], (L, D, IN_WIDTH), D ** -0.5),
        'gla_w_a2': nrm(ks[3], (L, GLA_LOWRANK, GLA_HEADS * GLA_DK), GLA_LOWRANK ** -0.5),
        'gla_b_a': nrm(ks[4], (L, GLA_HEADS * GLA_DK), 0.1),
        'gla_norm_g': 1.0 + nrm(ks[5], (L, GLA_DV), 0.02),
        'swa_sinks': nrm(ks[6], (L, SWA_HEADS), 0.5),
        'ret_norm_g': 1.0 + nrm(ks[7], (L, RET_DV), 0.02),
        'w_branch': nrm(ks[8], (L, N_BRANCH, BRANCH_WIDTH, D), BRANCH_WIDTH ** -0.5),
        'w_out': nrm(ks[9], (L, D, D), D ** -0.5),
        'ln2_g': 1.0 + nrm(ks[10], (L, D), 0.02),
        'w_group': nrm(ks[11], (L, D, N_GROUPS), D ** -0.5),
        'b_group': nrm(ks[12], (L, N_GROUPS), 0.01),
        'w_expert': nrm(ks[13], (L, D, N_EXPERTS), D ** -0.5),
        'b_expert': nrm(ks[14], (L, N_EXPERTS), 0.01),
        'w1': nrm(ks[15], (L, N_EXPERTS, D, EXPERT_HIDDEN), D ** -0.5),
        'w3': nrm(ks[16], (L, N_EXPERTS, D, EXPERT_HIDDEN), D ** -0.5),
        'w2': nrm(ks[17], (L, N_EXPERTS, EXPERT_HIDDEN, D), EXPERT_HIDDEN ** -0.5),
        'final_g': 1.0 + nrm(ks[18], (D,), 0.02),
    }


def reference(x, ln1_g, w_in, gla_w_a2, gla_b_a, gla_norm_g, swa_sinks, ret_norm_g, w_branch, w_out,
              ln2_g, w_group, b_group, w_expert, b_expert, w1, w3, w2, final_g):
    h = x
    for l in range(DEPTH):
        h = h + token_mixer(rms_norm(h, ln1_g[l]), w_in[l], gla_w_a2[l], gla_b_a[l], gla_norm_g[l],
                            swa_sinks[l], ret_norm_g[l], w_branch[l], w_out[l])
        h = h + hier_moe(rms_norm(h, ln2_g[l]), w_group[l], b_group[l], w_expert[l], b_expert[l],
                         w1[l], w3[l], w2[l])
    return rms_norm(h, final_g)
```

```cpp
#include <hip/hip_runtime.h>
#include <cstdio>
#include <cstdint>
#include <cmath>

#define LAS __attribute__((address_space(3)))
#define GAS __attribute__((address_space(1)))
typedef unsigned short bf16_t;
typedef short bf16x8 __attribute__((ext_vector_type(8)));
typedef float f32x4 __attribute__((ext_vector_type(4)));
typedef float f32x2 __attribute__((ext_vector_type(2)));
typedef unsigned u32x4 __attribute__((ext_vector_type(4)));
typedef unsigned u32x2 __attribute__((ext_vector_type(2)));

constexpr int T_ = 32768, D_ = 1024, S_ = 8192, NBATCH = 4, DEPTH_ = 2;
constexpr int ZW = 3072;
constexpr int Z_GQ = 0, Z_GK = 128, Z_GV = 256, Z_GR = 512, Z_GA = 768, Z_SQ = 784, Z_SK = 1040, Z_SV = 1168, Z_MQ = 1296, Z_MK = 1552, Z_MV = 1808,
              Z_RQ = 2064, Z_RK = 2192, Z_RV = 2320, Z_RG = 2576, Z_GATE = 2832, IN_W = 6928;
constexpr float LOG2E = 1.4426950408889634f;
constexpr float C2 = 0.125f * 1.4426950408889634f;
constexpr float RSQ32 = 0.17677669529663687f;
constexpr float NORM_EPS = 1e-6f;
constexpr int NEXP = 32, EHID = 256, MOE_BLK = 256, NSLOTBLK = 288, NSLOT = NSLOTBLK * MOE_BLK;

constexpr size_t MiB = 1u << 20;
constexpr size_t WS_WIN = 0, WS_WG = 6 * MiB, WS_WB = 14 * MiB, WS_WO = 16 * MiB, WS_WR = 18 * MiB, WS_E1 = 19 * MiB, WS_E2 = 51 * MiB;
constexpr size_t WS_YS = 68 * MiB;
constexpr size_t WS_GKV = 68 * MiB, WS_RKV = 84 * MiB, WS_GDEC = 92 * MiB, WS_KMEAN = 93 * MiB, WS_O = 108 * MiB;
constexpr size_t WS_U = 197 * MiB;
constexpr size_t WS_Z = 261 * MiB;
constexpr size_t WS_YH = 261 * MiB;
constexpr size_t WS_XS = 261 * MiB, WS_HDN = 405 * MiB;
constexpr size_t WS_LOGIT = 453 * MiB;
constexpr size_t WS_TOKE = 461 * MiB, WS_TOKW = WS_TOKE + 256 * 1024, WS_TOKR = WS_TOKW + 256 * 1024, WS_HIST = WS_TOKR + 256 * 1024,
                 WS_SDST = WS_HIST + 64 * 1024, WS_BLKE = WS_SDST + 512 * 1024;
constexpr size_t WS_CTL = 465 * MiB, CTL_BYTES = 64 * 1024;
constexpr size_t WS_END = 466 * MiB;
constexpr int YS_TRASH_ROW = 2 * T_;

__device__ __forceinline__ float bf2f(bf16_t v) { return __uint_as_float(((unsigned)v) << 16); }
__device__ __forceinline__ unsigned f2bf(float f) { unsigned u = __float_as_uint(f); return (u + 0x7fffu + ((u >> 16) & 1u)) >> 16; }
__device__ __forceinline__ unsigned pk2(float lo, float hi) { return f2bf(lo) | (f2bf(hi) << 16); }
__device__ __forceinline__ float sigmoidf_(float x) { return __builtin_amdgcn_rcpf(1.0f + __builtin_amdgcn_exp2f(-x * LOG2E)); }

namespace pg8 {
#define PG8_LAS __attribute__((address_space(3)))
constexpr int BM = 256, BK = 64, HALF = 128, HTB = HALF * BK * 2  , STAGE_BYTES = 8 * HTB, NXCD = 8, WGM = 8;

__host__ __device__ __forceinline__ int lds_byte(int r, int c) { const int st = (r >> 4) * 2 + (c >> 5), rr = r & 15, cc = c & 31, ob = rr * 64 + cc * 2; return st * 1024 + (ob ^ (((ob >> 9) & 1) << 5)); }
__host__ __device__ __forceinline__ void stage_rc(int b, int& R, int& C) { const int st = b / 1024, sb = b % 1024, swz = sb ^ (((sb >> 9) & 1) << 5); R = (st >> 1) * 16 + swz / 64; C = (st & 1) * 32 + (swz % 64) / 2; }
__host__ __device__ __forceinline__ int perm32(int rho) { const int n = rho >> 4, i = rho & 15; return 8 * (i >> 2) + 4 * n + (i & 3); }

struct Unit { int pm, pn; size_t aoff, boff; };
struct Gemm { const bf16_t* A; const bf16_t* Bt; int lda, ldb, K; };

struct StaticOrder {
    int nM, nN, nwg, G, c, pm_base, a_shift; size_t a_mul, a_tstep, b_tstep;
    __device__ void init(int M, int N, int G_, int c_, int lda, int ldb, int pm_base_ = 0, int a_shift_ = 30, size_t a_mul_ = 0) {
        nM = M / BM; nN = N / BM; nwg = nM * nN; G = G_; c = c_; pm_base = pm_base_; a_shift = a_shift_; a_mul = a_mul_; a_tstep = (size_t)BM * lda * 2; b_tstep = (size_t)BM * ldb * 2; }
    __device__ bool next(int i, Unit& u) const {
        const long L = (long)i * G + c; if (L >= nwg) return false;
        int wgid = (int)L; { const int q = nwg / NXCD, r = nwg % NXCD, xcd = wgid % NXCD, off = wgid / NXCD; wgid = (xcd < r ? xcd * (q + 1) : r * (q + 1) + (xcd - r) * q) + off; }
        const int nig = WGM * nN, gid = wgid / nig, fm = gid * WGM, gsz = (nM - fm) < WGM ? (nM - fm) : WGM;
        u.pm = pm_base + fm + ((wgid % nig) % gsz); u.pn = (wgid % nig) / gsz;
        u.aoff = (size_t)u.pm * a_tstep + (size_t)(u.pn >> a_shift) * a_mul; u.boff = (size_t)u.pn * b_tstep; return true;
    }
};
template <int NCOL> struct MoeOrder {
    const int* blk_e; int nb, G, c; size_t a_tstep, b_tstep, b_estep;
    __device__ bool next(int i, Unit& u) const {
        const int L = i * G + c; if (L >= nb * NCOL) return false;
        const int rb = L / NCOL, pn = L % NCOL; const int e = __builtin_amdgcn_readfirstlane(blk_e[rb]);
        u.pm = rb; u.pn = pn; u.aoff = (size_t)rb * a_tstep; u.boff = (size_t)e * b_estep + (size_t)pn * b_tstep; return true;
    }
};

__device__ __forceinline__ unsigned cvt_pk_bf16(float lo, float hi) { unsigned r; asm volatile("v_cvt_pk_bf16_f32 %0, %1, %2" : "=v"(r) : "v"(lo), "v"(hi)); return r; }

struct EpiBf16 {
    static constexpr bool PERM = true;
    bf16_t* O; int ldc; int row_sub;
    __device__ __forceinline__ void operator()(const f32x4 (&acc)[2][2][4][2], const Unit& u, int wr, int wc, int fr, int fq) const {
        const int row0 = u.pm * BM + wr * 64 + fr - row_sub; const int col0 = u.pn * BM + wc * 32 + 8 * fq;
#pragma unroll
        for (int ai = 0; ai < 2; ++ai)
#pragma unroll
            for (int m = 0; m < 4; ++m) { bf16_t* rowp = O + (size_t)(row0 + ai * HALF + m * 16) * ldc + col0;
#pragma unroll
                for (int bj = 0; bj < 2; ++bj) { const f32x4 v0 = acc[ai][bj][m][0], v1 = acc[ai][bj][m][1];
                    u32x4 w; w.x = cvt_pk_bf16(v0[0], v0[1]); w.y = cvt_pk_bf16(v0[2], v0[3]); w.z = cvt_pk_bf16(v1[0], v1[1]); w.w = cvt_pk_bf16(v1[2], v1[3]);
                    *(u32x4*)(rowp + bj * HALF) = w; } }
    }
};
struct EpiRes {
    static constexpr bool PERM = false;
    const float* base; float* C; int ldc;
    __device__ __forceinline__ void operator()(const f32x4 (&acc)[2][2][4][2], const Unit& u, int wr, int wc, int fr, int fq) const {
        const int row0 = u.pm * BM + wr * 64 + fr, col0 = u.pn * BM + wc * 32 + 4 * fq;
#pragma unroll
        for (int ai = 0; ai < 2; ++ai)
#pragma unroll
            for (int m = 0; m < 4; ++m) { const size_t off = (size_t)(row0 + ai * HALF + m * 16) * ldc + col0;
#pragma unroll
                for (int bj = 0; bj < 2; ++bj)
#pragma unroll
                    for (int n = 0; n < 2; ++n) { const f32x4 b = *(const f32x4*)(base + off + bj * HALF + n * 16); *(f32x4*)(C + off + bj * HALF + n * 16) = b + acc[ai][bj][m][n]; }
                asm volatile("" ::: "memory"); }
    }
};
struct EpiRouter {
    static constexpr bool PERM = false;
    float* L;
    __device__ __forceinline__ void operator()(const f32x4 (&acc)[2][2][4][2], const Unit& u, int wr, int wc, int fr, int fq) const {
        if (wc >= 2) return;
        const int row0 = u.pm * BM + wr * 64 + fr, col0 = wc * 32 + 4 * fq;
#pragma unroll
        for (int ai = 0; ai < 2; ++ai)
#pragma unroll
            for (int m = 0; m < 4; ++m) { float* rowp = L + (size_t)(row0 + ai * HALF + m * 16) * 64 + col0;
#pragma unroll
                for (int n = 0; n < 2; ++n) *(f32x4*)(rowp + n * 16) = acc[ai][0][m][n]; }
    }
};
struct EpiGate {
    static constexpr bool PERM = false;
    const bf16_t* Y; int y_row_sub; bf16_t* Mg;
    __device__ __forceinline__ void operator()(const f32x4 (&acc)[2][2][4][2], const Unit& u, int wr, int wc, int fr, int fq) const {
        const int row0 = u.pm * BM + wr * 64 + fr, d0 = u.pn * 64 + wc * 16 + fq * 4;
#pragma unroll
        for (int ai = 0; ai < 2; ++ai)
#pragma unroll
            for (int m = 0; m < 4; ++m) { const int r = row0 + ai * HALF + m * 16; const bf16_t* yrow = Y + (size_t)(r - y_row_sub) * 4096 + d0;
                f32x4 s = (f32x4){0.f, 0.f, 0.f, 0.f};
#pragma unroll
                for (int i = 0; i < 4; ++i) { const u32x2 yv = *(const u32x2*)(yrow + 1024 * i); const f32x4 g = acc[ai][i >> 1][m][i & 1];
                    s[0] += sigmoidf_(g[0]) * __uint_as_float(yv.x << 16); s[1] += sigmoidf_(g[1]) * __uint_as_float(yv.x & 0xffff0000u);
                    s[2] += sigmoidf_(g[2]) * __uint_as_float(yv.y << 16); s[3] += sigmoidf_(g[3]) * __uint_as_float(yv.y & 0xffff0000u); }
                u32x2 w; w.x = cvt_pk_bf16(s[0], s[1]); w.y = cvt_pk_bf16(s[2], s[3]);
                *(u32x2*)(Mg + (size_t)r * 1024 + d0) = w;
                asm volatile("" ::: "memory"); }
    }
};
struct EpiE1 {
    static constexpr bool PERM = true;
    bf16_t* H;
    __device__ __forceinline__ void operator()(const f32x4 (&acc)[2][2][4][2], const Unit& u, int wr, int wc, int fr, int fq) const {
        const int row0 = u.pm * BM + wr * 64 + fr, col0 = u.pn * 128 + wc * 32 + 8 * fq;
#pragma unroll
        for (int ai = 0; ai < 2; ++ai)
#pragma unroll
            for (int m = 0; m < 4; ++m) { bf16_t* rowp = H + (size_t)(row0 + ai * HALF + m * 16) * EHID + col0;
                const f32x4 a0 = acc[ai][0][m][0], a1 = acc[ai][0][m][1], b0 = acc[ai][1][m][0], b1 = acc[ai][1][m][1];
                f32x4 v0, v1;
#pragma unroll
                for (int j = 0; j < 4; ++j) { v0[j] = a0[j] * sigmoidf_(a0[j]) * b0[j]; v1[j] = a1[j] * sigmoidf_(a1[j]) * b1[j]; }
                u32x4 w; w.x = cvt_pk_bf16(v0[0], v0[1]); w.y = cvt_pk_bf16(v0[2], v0[3]); w.z = cvt_pk_bf16(v1[0], v1[1]); w.w = cvt_pk_bf16(v1[2], v1[3]);
                *(u32x4*)rowp = w; }
    }
};
struct EpiE2 {
    static constexpr bool PERM = true;
    bf16_t* YS; const int* sdst;
    __device__ __forceinline__ void operator()(const f32x4 (&acc)[2][2][4][2], const Unit& u, int wr, int wc, int fr, int fq) const {
        const int row0 = u.pm * BM + wr * 64 + fr, col0 = u.pn * BM + wc * 32 + 8 * fq;
#pragma unroll
        for (int ai = 0; ai < 2; ++ai)
#pragma unroll
            for (int m = 0; m < 4; ++m) { const int dst = sdst[row0 + ai * HALF + m * 16];
                bf16_t* rowp = YS + (size_t)dst * 1024 + col0;
#pragma unroll
                for (int bj = 0; bj < 2; ++bj) { const f32x4 v0 = acc[ai][bj][m][0], v1 = acc[ai][bj][m][1];
                    u32x4 w; w.x = cvt_pk_bf16(v0[0], v0[1]); w.y = cvt_pk_bf16(v0[2], v0[3]); w.z = cvt_pk_bf16(v1[0], v1[1]); w.w = cvt_pk_bf16(v1[2], v1[3]);
                    *(u32x4*)(rowp + bj * HALF) = w; }
                asm volatile("" ::: "memory"); }
    }
};

template <class Epi, class Sched>
__device__ __forceinline__ void gemm_phase(PG8_LAS unsigned char* lds, const Gemm g, const Sched& S, const Epi& E) {
    int tid = threadIdx.x; asm volatile("" : "+v"(tid));
    const int wid = __builtin_amdgcn_readfirstlane(tid >> 6), lane = tid & 63, wr = wid >> 2, wc = wid & 3, fr = lane & 15, fq = lane >> 4;
    const int K = g.K, nt = K / BK;
    unsigned voffA[2], voffB[2];
#pragma unroll
    for (int i = 0; i < 2; ++i) { int R, C; stage_rc(tid * 16 + i * 8192, R, C); const int Rb = Epi::PERM ? ((R & ~31) + perm32(R & 31)) : R;
        voffA[i] = (unsigned)(R * g.lda + C) * 2u; voffB[i] = (unsigned)(Rb * g.ldb + C) * 2u; }
    const size_t kstep = (size_t)(BK * 2);
    const size_t hstepA = (size_t)HALF * g.lda * 2, hstepB = (size_t)HALF * g.ldb * 2;
    const unsigned ldsw = (unsigned)wid * 1024u;
    const int aoff = lds_byte(wr * 64 + fr, fq * 8), boff = lds_byte(wc * 32 + fr, fq * 8);
#define PG8_SA(b, h) (((b) * 2 + (h)) * HTB)
#define PG8_SB(b, h) ((4 + (b) * 2 + (h)) * HTB)
#define PG8_STAGE(bufoff, gbase, voff) do { _Pragma("unroll") for (int _i = 0; _i < 2; ++_i) \
        __builtin_amdgcn_global_load_lds((const unsigned*)((const char*)(gbase) + (voff)[_i]), (PG8_LAS unsigned*)(lds + (bufoff) + ldsw + _i * 8192), 16, 0, 0); } while (0)
#define PG8_LDA(dst, b, h) do { _Pragma("unroll") for (int m = 0; m < 4; ++m) _Pragma("unroll") for (int k = 0; k < 2; ++k) dst[m][k] = *(const PG8_LAS bf16x8*)(lds + PG8_SA(b, h) + aoff + m * 2048 + k * 1024); } while (0)
#define PG8_LDB(dst, b, h) do { _Pragma("unroll") for (int n = 0; n < 2; ++n) _Pragma("unroll") for (int k = 0; k < 2; ++k) dst[n][k] = *(const PG8_LAS bf16x8*)(lds + PG8_SB(b, h) + boff + n * 2048 + k * 1024); } while (0)
#define PG8_MMA(ai, bj, At, Bt) do { __builtin_amdgcn_s_setprio(1); _Pragma("unroll") for (int m = 0; m < 4; ++m) _Pragma("unroll") for (int n = 0; n < 2; ++n) _Pragma("unroll") for (int k = 0; k < 2; ++k) \
        acc[ai][bj][m][n] = __builtin_amdgcn_mfma_f32_16x16x32_bf16(Bt[n][k], At[m][k], acc[ai][bj][m][n], 0, 0, 0); __builtin_amdgcn_s_setprio(0); } while (0)
#define PG8_WAIT_V(n) asm volatile("s_waitcnt vmcnt(" #n ")" ::: "memory")
#define PG8_WAIT_L(n) asm volatile("s_waitcnt lgkmcnt(" #n ")" ::: "memory")
#define PG8_BAR __builtin_amdgcn_s_barrier()
#define PG8_SCHED __builtin_amdgcn_sched_barrier(0)
    Unit cur, nxt; int ui = 0;
    if (!S.next(0, cur)) return;
    f32x4 acc[2][2][4][2];
#pragma unroll
    for (int a = 0; a < 2; ++a)
#pragma unroll
        for (int b = 0; b < 2; ++b)
#pragma unroll
            for (int m = 0; m < 4; ++m)
#pragma unroll
                for (int n = 0; n < 2; ++n) acc[a][b][m][n] = (f32x4){0.f, 0.f, 0.f, 0.f};
    bf16x8 At[4][2], B0[2][2], B1[2][2];
    const char* cA = (const char*)g.A + cur.aoff; const char* cB = (const char*)g.Bt + cur.boff;
    PG8_STAGE(PG8_SB(0, 0), cB, voffB); PG8_STAGE(PG8_SA(0, 0), cA, voffA); PG8_STAGE(PG8_SB(0, 1), cB + hstepB, voffB); PG8_STAGE(PG8_SA(0, 1), cA + hstepA, voffA);
    if (wr == 1) PG8_BAR;
    PG8_WAIT_V(4); PG8_BAR;
    PG8_STAGE(PG8_SB(1, 0), cB + kstep, voffB); PG8_STAGE(PG8_SA(1, 0), cA + kstep, voffA); PG8_STAGE(PG8_SB(1, 1), cB + hstepB + kstep, voffB);
    PG8_WAIT_V(6); PG8_BAR;
    for (;;) {
        const bool has_next = S.next(ui + 1, nxt);
        const char* nA = has_next ? (const char*)g.A + nxt.aoff : cA; const char* nB = has_next ? (const char*)g.Bt + nxt.boff : cB;
        for (int t = 0; t < nt; t += 2) {
            const bool last = (t == nt - 2);
            const char* a1 = cA + (size_t)(t + 1) * kstep;
            const char* a2 = last ? nA : cA + (size_t)(t + 2) * kstep; const char* b2 = last ? nB : cB + (size_t)(t + 2) * kstep;
            const char* a3 = a2 + kstep; const char* b3 = b2 + kstep;
            PG8_LDB(B0, 0, 0); PG8_SCHED; PG8_LDA(At, 0, 0); PG8_STAGE(PG8_SA(1, 1), a1 + hstepA, voffA);
            PG8_WAIT_L(8); PG8_BAR; PG8_WAIT_L(0); PG8_MMA(0, 0, At, B0); PG8_BAR; PG8_SCHED;
            PG8_LDB(B1, 0, 1); PG8_STAGE(PG8_SB(0, 0), b2, voffB);
            PG8_BAR; PG8_WAIT_L(0); PG8_MMA(0, 1, At, B1); PG8_BAR;
            PG8_LDA(At, 0, 1); PG8_STAGE(PG8_SA(0, 0), a2, voffA);
            PG8_BAR; PG8_WAIT_L(0); PG8_MMA(1, 0, At, B0); PG8_BAR; PG8_SCHED;
            PG8_STAGE(PG8_SB(0, 1), b2 + hstepB, voffB);
            PG8_WAIT_V(6); PG8_BAR; PG8_MMA(1, 1, At, B1); PG8_BAR;
            PG8_LDB(B0, 1, 0); PG8_SCHED; PG8_LDA(At, 1, 0); PG8_STAGE(PG8_SA(0, 1), a2 + hstepA, voffA);
            PG8_WAIT_L(8); PG8_BAR; PG8_WAIT_L(0); PG8_MMA(0, 0, At, B0); PG8_BAR; PG8_SCHED;
            PG8_LDB(B1, 1, 1); PG8_STAGE(PG8_SB(1, 0), b3, voffB);
            PG8_BAR; PG8_WAIT_L(0); PG8_MMA(0, 1, At, B1); PG8_BAR;
            PG8_LDA(At, 1, 1); PG8_STAGE(PG8_SA(1, 0), a3, voffA);
            PG8_BAR; PG8_WAIT_L(0); PG8_MMA(1, 0, At, B0); PG8_BAR; PG8_SCHED;
            PG8_STAGE(PG8_SB(1, 1), b3 + hstepB, voffB);
            PG8_WAIT_V(6); PG8_BAR; PG8_MMA(1, 1, At, B1); PG8_BAR;
        }
        E(acc, cur, wr, wc, fr, fq);
        if (!has_next) break;
#pragma unroll
        for (int a = 0; a < 2; ++a)
#pragma unroll
            for (int b = 0; b < 2; ++b)
#pragma unroll
                for (int m = 0; m < 4; ++m)
#pragma unroll
                    for (int n = 0; n < 2; ++n) acc[a][b][m][n] = (f32x4){0.f, 0.f, 0.f, 0.f};
        cur = nxt; cA = nA; cB = nB; ++ui;
    }
    PG8_WAIT_V(0);
    if (wr == 0) PG8_BAR;
    PG8_BAR;
#undef PG8_SA
#undef PG8_SB
#undef PG8_STAGE
#undef PG8_LDA
#undef PG8_LDB
#undef PG8_MMA
#undef PG8_WAIT_V
#undef PG8_WAIT_L
#undef PG8_BAR
#undef PG8_SCHED
}
}

#define XB_TMO      128
#define XB_XCNT(j)  (256  + 64 * (j))
#define XB_XSUB(j)  (1280 + 64 * (j))
#define XB_XGEN(j)  (2304 + 64 * (j))
#define XB_TOP      3328
#define XB_TOPGEN   3392
#define XCD_BAR_WORDS 3456
#define XB_SPIN_CAP (1u << 21)

__device__ __forceinline__ unsigned xb_ld(unsigned* p)              { return __hip_atomic_load(p, __ATOMIC_RELAXED, __HIP_MEMORY_SCOPE_AGENT); }
__device__ __forceinline__ unsigned xb_add(unsigned* p, unsigned v) { return __hip_atomic_fetch_add(p, v, __ATOMIC_RELAXED, __HIP_MEMORY_SCOPE_AGENT); }
__device__ __forceinline__ unsigned xb_xcc_id() { return (unsigned)__builtin_amdgcn_s_getreg((3 << 11) | 20) & 0xFu; }
#define XB_SPIN(cond, bar) do { unsigned _sp = 0; while (cond) { __builtin_amdgcn_s_sleep(1); \
    if ((++_sp & 255u) == 0u) { if (xb_ld(&(bar)[XB_TMO])) break; if (_sp > XB_SPIN_CAP) { atomicAdd(&(bar)[XB_TMO], 1u); break; } } } } while (0)

struct XcdBarrier {
    unsigned* bar; unsigned x;
    volatile LAS unsigned* st;
};

__device__ __forceinline__ XcdBarrier xcd_barrier_post(unsigned* bar, volatile LAS unsigned* st) {
    XcdBarrier b; b.bar = bar; b.x = xb_xcc_id(); b.st = st;
    if (threadIdx.x == 0) (void)xb_add(&bar[XB_XCNT(b.x)], 1u);
    return b;
}
__device__ __forceinline__ void xcd_barrier_complete(unsigned* bar, unsigned x, unsigned& nloc, unsigned& nx) {
    const unsigned G = gridDim.x * gridDim.y * gridDim.z;
    unsigned sum, cnt, mine, sp = 0u;
    for (;;) {
        sum = 0u; cnt = 0u; mine = 0u;
#pragma unroll
        for (unsigned j = 0; j < 16; ++j) { const unsigned c = xb_ld(&bar[XB_XCNT(j)]); sum += c; cnt += (c > 0u) ? 1u : 0u; mine = (j == x) ? c : mine; }
        if (sum == G) break;
        __builtin_amdgcn_s_sleep(1);
        if ((++sp & 255u) == 0u) { if (xb_ld(&bar[XB_TMO])) break; if (sp > XB_SPIN_CAP) { atomicAdd(&bar[XB_TMO], 1u); break; } }
    }
    nloc = mine > 0u ? mine : 1u; nx = cnt > 0u ? cnt : 1u;
}

__device__ __forceinline__ void xcd_barrier(const XcdBarrier& b) {
    asm volatile("s_waitcnt vmcnt(0)" ::: "memory");
    __syncthreads();
    if (threadIdx.x == 0) {
        unsigned* bar = b.bar;
        __builtin_amdgcn_s_waitcnt(0);
        unsigned nloc = b.st[0], nx = b.st[1];
        if (nloc == 0u) { xcd_barrier_complete(bar, b.x, nloc, nx); b.st[0] = nloc; b.st[1] = nx; }
        const unsigned old = xb_add(&bar[XB_XSUB(b.x)], 1u);
        const unsigned gen = old / nloc;
        if (old + 1u == (gen + 1u) * nloc) {
            __builtin_amdgcn_fence(__ATOMIC_RELEASE, "agent");
            asm volatile("s_waitcnt vmcnt(0)" ::: "memory");
            const unsigned og = xb_add(&bar[XB_TOP], 1u);
            const unsigned tg = og / nx;
            if (og + 1u == (tg + 1u) * nx) xb_add(&bar[XB_TOPGEN], 1u);
            else XB_SPIN(xb_ld(&bar[XB_TOPGEN]) == tg, bar);
            __builtin_amdgcn_fence(__ATOMIC_ACQUIRE, "agent");
            xb_add(&bar[XB_XGEN(b.x)], 1u);
            asm volatile("s_waitcnt vmcnt(0)" ::: "memory");
        } else {
            XB_SPIN(xb_ld(&bar[XB_XGEN(b.x)]) == gen, bar);
            __builtin_amdgcn_fence(__ATOMIC_ACQUIRE, "agent");
            asm volatile("s_waitcnt vmcnt(0)" ::: "memory");
        }
    }
    __syncthreads();
}

constexpr int NWAVES = 8, NTHREADS = 512;
constexpr int RING_BYTES = 131072;
constexpr int LDSCTL_OFF = RING_BYTES, MISC_OFF = LDSCTL_OFF + 320;
constexpr int LDS_BYTES = 147456;

struct Params { const float* in[19]; float* out; unsigned char* ws; float inv_freq[16]; float ret_lg2[4]; int ph_lo, ph_hi; };
typedef const __attribute__((address_space(4))) Params& KPRef;

__device__ __forceinline__ float wave_sum(float v) {
#pragma unroll
    for (int o = 1; o < 64; o <<= 1) v += __shfl_xor(v, o);
    return v;
}
#define LDS_WAIT() asm volatile("s_waitcnt lgkmcnt(0)" ::: "memory")

template <class LD>
__device__ __forceinline__ void conv_item(LD ld, bf16_t* WT, int K, float* scr, int kb, int nb, int lane) {
    const int k0 = 64 * kb, n0 = 32 * nb;
#pragma unroll 8
    for (int i = 0; i < 32; ++i) { const int kk = 2 * i + (lane >> 5); scr[kk * 33 + (lane & 31)] = ld(k0 + kk, n0 + (lane & 31)); }
    LDS_WAIT();
    const int c = lane & 7;
#pragma unroll
    for (int j = 0; j < 4; ++j) { const int n = (lane >> 3) + 8 * j; const float* s = scr + (8 * c) * 33 + n;
        u32x4 o; o.x = pk2(s[0 * 33], s[1 * 33]); o.y = pk2(s[2 * 33], s[3 * 33]); o.z = pk2(s[4 * 33], s[5 * 33]); o.w = pk2(s[6 * 33], s[7 * 33]);
        *(u32x4*)(WT + (size_t)(n0 + n) * K + k0 + 8 * c) = o; }
    LDS_WAIT();
}

__device__ __forceinline__ void conv_phase(KPRef p, int l, unsigned char* lds, int gw, int NGW, int wave, int lane) {
    float* scr = (float*)(lds + wave * 16384);
    unsigned char* ws = p.ws;
    {
        const float* W = p.in[2] + (size_t)l * 1024 * IN_W; bf16_t* WT = (bf16_t*)(ws + WS_WIN);
        for (int it = gw; it < 16 * 96; it += NGW) { const int kb = it / 96, nb = it % 96;
            conv_item([&](int k, int n) -> float { if (n >= Z_GATE) return 0.f; float s = 1.f;
                if (n < Z_GK) s = RSQ32; else if (n >= Z_SQ && n < Z_SK) s = C2; else if (n >= Z_MQ && n < Z_MK) s = C2; else if (n >= Z_RK && n < Z_RV) s = RSQ32;
                return W[(size_t)k * IN_W + n] * s; }, WT, 1024, scr, kb, nb, lane); }
    }
    {
        const float* W = p.in[2] + (size_t)l * 1024 * IN_W; bf16_t* WT = (bf16_t*)(ws + WS_WG);
        for (int it = gw; it < 16 * 128; it += NGW) { const int kb = it / 128, nb = it % 128;
            conv_item([&](int k, int n) -> float { const int pn = n >> 8, c = n & 255, bj = (c >> 7) & 1, wc = (c >> 5) & 3, nn = (c >> 4) & 1, fq = (c >> 2) & 3, j = c & 3;
                const int col = Z_GATE + 1024 * (2 * bj + nn) + 64 * pn + 16 * wc + 4 * fq + j; return W[(size_t)k * IN_W + col]; }, WT, 1024, scr, kb, nb, lane); }
    }
    {
        for (int it = gw; it < 512; it += NGW) { const int i = it / 128, r = it % 128, kb = r / 32, nb = r % 32;
            const float* W = p.in[8] + (size_t)(l * 4 + i) * 256 * 1024; bf16_t* WT = (bf16_t*)(ws + WS_WB) + (size_t)i * 1024 * 256;
            conv_item([&](int k, int n) -> float { return W[(size_t)k * 1024 + n]; }, WT, 256, scr, kb, nb, lane); }
    }
    {
        const float* W = p.in[9] + (size_t)l * 1024 * 1024; bf16_t* WT = (bf16_t*)(ws + WS_WO);
        for (int it = gw; it < 16 * 32; it += NGW) { const int kb = it / 32, nb = it % 32;
            conv_item([&](int k, int n) -> float { return W[(size_t)k * 1024 + n]; }, WT, 1024, scr, kb, nb, lane); }
    }
    {
        const float* Wg = p.in[11] + (size_t)l * 1024 * 4; const float* We = p.in[13] + (size_t)l * 1024 * 32; bf16_t* WT = (bf16_t*)(ws + WS_WR);
        for (int it = gw; it < 16 * 8; it += NGW) { const int kb = it / 8, nb = it % 8;
            conv_item([&](int k, int n) -> float { if (n < 4) return Wg[k * 4 + n]; if (n < 36) return We[k * 32 + (n - 4)]; return 0.f; }, WT, 1024, scr, kb, nb, lane); }
    }
    {
        for (int it = gw; it < 32 * 256; it += NGW) { const int e = it / 256, r = it % 256, kb = r / 16, nb = r % 16;
            const int n0 = 32 * nb, pn = n0 >> 8, c0 = n0 & 255;
            const float* W = ((c0 < 128) ? p.in[15] : p.in[16]) + (size_t)(l * 32 + e) * 1024 * 256 + 128 * pn + (c0 & 127) - n0;
            bf16_t* WT = (bf16_t*)(ws + WS_E1) + (size_t)e * 512 * 1024;
            conv_item([&](int k, int n) -> float { return W[(size_t)k * 256 + n]; }, WT, 1024, scr, kb, nb, lane); }
    }
    {
        for (int it = gw; it < 32 * 128; it += NGW) { const int e = it / 128, r = it % 128, kb = r / 32, nb = r % 32;
            const float* W = p.in[17] + (size_t)(l * 32 + e) * 256 * 1024; bf16_t* WT = (bf16_t*)(ws + WS_E2) + (size_t)e * 1024 * 256;
            conv_item([&](int k, int n) -> float { return W[(size_t)k * 1024 + n]; }, WT, 256, scr, kb, nb, lane); }
    }
}

template <int MODE>
__device__ __forceinline__ void norm_phase(KPRef p, int l, int gw, int NGW, int lane) {
    const float* src = (MODE == 0) ? p.in[0] : p.out;
    const float* gain = (MODE == 3) ? p.in[18] : (MODE == 2 ? p.in[10] + l * 1024 : p.in[1] + l * 1024);
    const bf16_t* ys = (const bf16_t*)(p.ws + WS_YS); const float* tokw = (const float*)(p.ws + WS_TOKW);
    bf16_t* u = (bf16_t*)(p.ws + WS_U);
    f32x4 gg[4];
#pragma unroll
    for (int j = 0; j < 4; ++j) gg[j] = ((const f32x4*)gain)[lane + 64 * j];
    for (int row = gw; row < T_; row += NGW) {
        const f32x4* xr = (const f32x4*)(src + (size_t)row * 1024) + lane;
        f32x4 v[4];
#pragma unroll
        for (int j = 0; j < 4; ++j) v[j] = xr[64 * j];
        if (MODE == 1 || MODE == 3) {
            const float w0 = tokw[2 * row], w1 = tokw[2 * row + 1];
            const u32x2* y0 = (const u32x2*)(ys + (size_t)(2 * row) * 1024) + lane; const u32x2* y1 = (const u32x2*)(ys + (size_t)(2 * row + 1) * 1024) + lane;
#pragma unroll
            for (int j = 0; j < 4; ++j) { const u32x2 a = y0[64 * j], b = y1[64 * j];
                v[j][0] += w0 * __uint_as_float(a.x << 16) + w1 * __uint_as_float(b.x << 16); v[j][1] += w0 * __uint_as_float(a.x & 0xffff0000u) + w1 * __uint_as_float(b.x & 0xffff0000u);
                v[j][2] += w0 * __uint_as_float(a.y << 16) + w1 * __uint_as_float(b.y << 16); v[j][3] += w0 * __uint_as_float(a.y & 0xffff0000u) + w1 * __uint_as_float(b.y & 0xffff0000u); }
            if (MODE == 1) { f32x4* hr = (f32x4*)(p.out + (size_t)row * 1024) + lane;
#pragma unroll
                for (int j = 0; j < 4; ++j) hr[64 * j] = v[j]; }
        }
        float s = 0.f;
#pragma unroll
        for (int j = 0; j < 4; ++j) s += (v[j][0] * v[j][0] + v[j][1] * v[j][1]) + (v[j][2] * v[j][2] + v[j][3] * v[j][3]);
        const float rstd = rsqrtf(wave_sum(s) * (1.0f / 1024.0f) + NORM_EPS);
        if (MODE == 3) { f32x4* orow = (f32x4*)(p.out + (size_t)row * 1024) + lane;
#pragma unroll
            for (int j = 0; j < 4; ++j) orow[64 * j] = v[j] * rstd * gg[j];
        } else { u32x2* o8 = (u32x2*)(u + (size_t)row * 1024) + lane;
#pragma unroll
            for (int j = 0; j < 4; ++j) { const f32x4 o = v[j] * rstd * gg[j]; u32x2 w; w.x = pk2(o[0], o[1]); w.y = pk2(o[2], o[3]); o8[64 * j] = w; } }
    }
}

__device__ __forceinline__ float logsigmoidf_(float x) { return fminf(x, 0.f) - log1pf(expf(-fabsf(x))); }

__device__ __forceinline__ void gla_front(KPRef p, int l, float* sm, int b, int h, int n, bool need_q, int tid) {
    const bf16_t* z = (const bf16_t*)(p.ws + WS_Z); const size_t t0 = (size_t)b * S_ + (size_t)n * 64;
    float* A = sm, *K = sm + 1024, *V = sm + 3072, *Bc = sm + 7168, *Q = sm + 9216;
    for (int idx = tid; idx < 64 * 16; idx += NTHREADS) { const int i = idx >> 4, r = idx & 15; A[idx] = bf2f(z[(t0 + i) * ZW + Z_GA + r]); }
    for (int idx = tid; idx < 64 * 32; idx += NTHREADS) { const int i = idx >> 5, d = idx & 31; K[idx] = bf2f(z[(t0 + i) * ZW + Z_GK + h * 32 + d]); if (need_q) Q[idx] = bf2f(z[(t0 + i) * ZW + Z_GQ + h * 32 + d]); }
    for (int idx = tid; idx < 64 * 64; idx += NTHREADS) { const int i = idx >> 6, e = idx & 63; V[idx] = bf2f(z[(t0 + i) * ZW + Z_GV + h * 64 + e]); }
    __syncthreads();
    const float* wa2 = p.in[3] + (size_t)l * 16 * 128; const float* ba = p.in[4] + (size_t)l * 128;
    for (int idx = tid; idx < 64 * 32; idx += NTHREADS) { const int i = idx >> 5, d = idx & 31; float x = ba[h * 32 + d];
#pragma unroll
        for (int r = 0; r < 16; ++r) x += A[i * 16 + r] * wa2[r * 128 + h * 32 + d];
        Bc[idx] = logsigmoidf_(x) * (1.0f / 16.0f); }
    __syncthreads();
    if (tid < 32) { float run = 0.f;
#pragma unroll 4
        for (int i = 0; i < 64; ++i) { run += Bc[i * 32 + tid]; Bc[i * 32 + tid] = run; } }
    __syncthreads();
}
__device__ __forceinline__ void gla_kv_unit(KPRef p, int l, float* sm, int unit, int tid) {
    const int n = unit & 127, bh = unit >> 7, h = bh & 3, b = bh >> 2;
    gla_front(p, l, sm, b, h, n, false, tid);
    float* K = sm + 1024, *V = sm + 3072, *Bc = sm + 7168;
    for (int idx = tid; idx < 64 * 32; idx += NTHREADS) { const int d = idx & 31; K[idx] *= expf(Bc[63 * 32 + d] - Bc[idx]); }
    __syncthreads();
    float* gkv = (float*)(p.ws + WS_GKV) + (size_t)unit * 2048; float* gdec = (float*)(p.ws + WS_GDEC) + (size_t)unit * 32;
    for (int idx = tid; idx < 32 * 64; idx += NTHREADS) { const int d = idx >> 6, e = idx & 63; float s = 0.f;
#pragma unroll 4
        for (int j = 0; j < 64; ++j) s += K[j * 32 + d] * V[j * 64 + e];
        gkv[idx] = s; }
    if (tid < 32) gdec[tid] = expf(Bc[63 * 32 + tid]);
    __syncthreads();
}
__device__ __forceinline__ void gla_out_unit(KPRef p, int l, float* sm, int unit, int tid) {
    const int n = unit & 127, bh = unit >> 7, h = bh & 3, b = bh >> 2;
    gla_front(p, l, sm, b, h, n, true, tid);
    float* K = sm + 1024, *V = sm + 3072, *Bc = sm + 7168, *Q = sm + 9216, *ATT = sm + 11264, *O = sm + 15360, *PREV = sm + 19456, *RSTD = sm + 21504;
    const float* gprev = (const float*)(p.ws + WS_GKV) + (size_t)unit * 2048;
    for (int idx = tid; idx < 64 * 32; idx += NTHREADS) { const float bb = Bc[idx]; Q[idx] *= expf(bb); K[idx] *= expf(-bb); }
    for (int idx = tid; idx < 2048; idx += NTHREADS) PREV[idx] = gprev[idx];
    __syncthreads();
    for (int idx = tid; idx < 64 * 64; idx += NTHREADS) { const int i = idx >> 6, j = idx & 63; float s = 0.f;
        if (j <= i) {
#pragma unroll 8
            for (int d = 0; d < 32; ++d) s += Q[i * 32 + d] * K[j * 32 + d]; }
        ATT[idx] = s; }
    __syncthreads();
    for (int idx = tid; idx < 64 * 64; idx += NTHREADS) { const int i = idx >> 6, e = idx & 63; float s = 0.f;
#pragma unroll 4
        for (int j = 0; j <= i; ++j) s += ATT[i * 64 + j] * V[j * 64 + e];
#pragma unroll 8
        for (int d = 0; d < 32; ++d) s += Q[i * 32 + d] * PREV[d * 64 + e];
        O[idx] = s; }
    __syncthreads();
    if (tid < 64) { float s = 0.f;
#pragma unroll 4
        for (int e = 0; e < 64; ++e) { const float v = O[tid * 64 + e]; s += v * v; } RSTD[tid] = rsqrtf(s * (1.0f / 64.0f) + NORM_EPS); }
    __syncthreads();
    const bf16_t* z = (const bf16_t*)(p.ws + WS_Z); bf16_t* ob = (bf16_t*)(p.ws + WS_O); const size_t t0 = (size_t)b * S_ + (size_t)n * 64;
    const float* ng = p.in[5] + l * 64;
    for (int idx = tid; idx < 64 * 64; idx += NTHREADS) { const int i = idx >> 6, e = idx & 63; const float r = bf2f(z[(t0 + i) * ZW + Z_GR + h * 64 + e]);
        ob[(t0 + i) * 1024 + 0 + h * 64 + e] = (bf16_t)f2bf(O[idx] * RSTD[i] * ng[e] * (r * sigmoidf_(r))); }
    __syncthreads();
}

__device__ __forceinline__ void rope_cs(float pos, float invf, float& c, float& s) {
    const float ang = pos * invf; const double t = (double)ang * 0.15915494309189535; const float fr = (float)(t - floor(t));
    c = __builtin_amdgcn_cosf(fr); s = __builtin_amdgcn_sinf(fr);
}
__device__ __forceinline__ void ret_rot_rows(KPRef p, const bf16_t* z, size_t t0, int pos0, int nrows, int col0, float* dst, int tid) {
    for (int idx = tid; idx < nrows * 16; idx += NTHREADS) { const int i = idx >> 4, f = idx & 15; float c, s; rope_cs((float)(pos0 + i), p.inv_freq[f], c, s);
        const float x1 = bf2f(z[(t0 + i) * ZW + col0 + f]), x2 = bf2f(z[(t0 + i) * ZW + col0 + 16 + f]);
        dst[i * 32 + f] = x1 * c - x2 * s; dst[i * 32 + 16 + f] = x1 * s + x2 * c; }
}
__device__ __forceinline__ void ret_kv_unit(KPRef p, float* sm, int unit, int tid) {
    const int n = unit & 63, bh = unit >> 6, h = bh & 3, b = bh >> 2;
    const bf16_t* z = (const bf16_t*)(p.ws + WS_Z); const size_t t0 = (size_t)b * S_ + (size_t)n * 128;
    float* K = sm, *V = sm + 4096;
    ret_rot_rows(p, z, t0, n * 128, 128, Z_RK + h * 32, K, tid);
    for (int idx = tid; idx < 128 * 64; idx += NTHREADS) { const int i = idx >> 6, e = idx & 63; V[idx] = bf2f(z[(t0 + i) * ZW + Z_RV + h * 64 + e]); }
    __syncthreads();
    const float lg = p.ret_lg2[h];
    for (int idx = tid; idx < 128 * 32; idx += NTHREADS) { const int j = idx >> 5; K[idx] *= __builtin_amdgcn_exp2f((float)(127 - j) * lg); }
    __syncthreads();
    float* rkv = (float*)(p.ws + WS_RKV) + (size_t)unit * 2048;
    for (int idx = tid; idx < 32 * 64; idx += NTHREADS) { const int d = idx >> 6, e = idx & 63; float s = 0.f;
#pragma unroll 4
        for (int j = 0; j < 128; ++j) s += K[j * 32 + d] * V[j * 64 + e];
        rkv[idx] = s; }
    __syncthreads();
}
__device__ __forceinline__ void ret_out_unit(KPRef p, int l, float* sm, int unit2, int tid) {
    const int hf = unit2 & 1, unit = unit2 >> 1, n = unit & 63, bh = unit >> 6, h = bh & 3, b = bh >> 2;
    const bf16_t* z = (const bf16_t*)(p.ws + WS_Z); const size_t t0 = (size_t)b * S_ + (size_t)n * 128;
    float* K = sm, *V = sm + 4096, *Q = sm + 12288, *ATT = sm + 14336, *O = sm + 22528, *PREV = sm + 26624, *RSTD = sm + 28672;
    ret_rot_rows(p, z, t0, n * 128, 128, Z_RK + h * 32, K, tid);
    ret_rot_rows(p, z, t0 + 64 * hf, n * 128 + 64 * hf, 64, Z_RQ + h * 32, Q, tid);
    for (int idx = tid; idx < 128 * 64; idx += NTHREADS) { const int i = idx >> 6, e = idx & 63; V[idx] = bf2f(z[(t0 + i) * ZW + Z_RV + h * 64 + e]); }
    const float* gprev = (const float*)(p.ws + WS_RKV) + (size_t)unit * 2048;
    for (int idx = tid; idx < 2048; idx += NTHREADS) PREV[idx] = gprev[idx];
    __syncthreads();
    const float lg = p.ret_lg2[h];
    for (int idx = tid; idx < 64 * 128; idx += NTHREADS) { const int ii = idx >> 7, j = idx & 127, i = 64 * hf + ii; float s = 0.f;
        if (j <= i) {
#pragma unroll 8
            for (int d = 0; d < 32; ++d) s += Q[ii * 32 + d] * K[j * 32 + d];
            s *= __builtin_amdgcn_exp2f((float)(i - j) * lg); }
        ATT[idx] = s; }
    __syncthreads();
    for (int idx = tid; idx < 64 * 64; idx += NTHREADS) { const int ii = idx >> 6, e = idx & 63, i = 64 * hf + ii; float s = 0.f;
#pragma unroll 4
        for (int j = 0; j <= i; ++j) s += ATT[ii * 128 + j] * V[j * 64 + e];
        float c = 0.f;
#pragma unroll 8
        for (int d = 0; d < 32; ++d) c += Q[ii * 32 + d] * PREV[d * 64 + e];
        O[idx] = s + c * __builtin_amdgcn_exp2f((float)(i + 1) * lg); }
    __syncthreads();
    if (tid < 64) { float s = 0.f;
#pragma unroll 4
        for (int e = 0; e < 64; ++e) { const float v = O[tid * 64 + e]; s += v * v; } RSTD[tid] = rsqrtf(s * (1.0f / 64.0f) + NORM_EPS); }
    __syncthreads();
    bf16_t* ob = (bf16_t*)(p.ws + WS_O); const float* ng = p.in[7] + l * 64;
    for (int idx = tid; idx < 64 * 64; idx += NTHREADS) { const int ii = idx >> 6, e = idx & 63; const size_t t = t0 + 64 * hf + ii; const float g = bf2f(z[t * ZW + Z_RG + h * 64 + e]);
        ob[t * 1024 + 768 + h * 64 + e] = (bf16_t)f2bf(O[idx] * RSTD[ii] * ng[e] * (g * sigmoidf_(g))); }
    __syncthreads();
}

__device__ __forceinline__ void scan_phase(KPRef p, int wg, int tid) {
    if (wg < 64) {
        const int bh = wg >> 2, elem = (wg & 3) * 512 + tid, d = elem >> 6;
        float* base = (float*)(p.ws + WS_GKV) + (size_t)bh * 128 * 2048 + elem; const float* dec = (const float*)(p.ws + WS_GDEC) + (size_t)bh * 128 * 32 + d;
        float s = 0.f;
#pragma unroll 1
        for (int n0 = 0; n0 < 128; n0 += 8) { float kv[8], dc[8];
#pragma unroll
            for (int j = 0; j < 8; ++j) { kv[j] = base[(size_t)(n0 + j) * 2048]; dc[j] = dec[(n0 + j) * 32]; }
#pragma unroll
            for (int j = 0; j < 8; ++j) { base[(size_t)(n0 + j) * 2048] = s; s = dc[j] * s + kv[j]; } }
    } else if (wg < 128) {
        const int w2 = wg - 64, bh = w2 >> 2, h = bh & 3, elem = (w2 & 3) * 512 + tid;
        float* base = (float*)(p.ws + WS_RKV) + (size_t)bh * 64 * 2048 + elem; const float dc = __builtin_amdgcn_exp2f(128.0f * p.ret_lg2[h]);
        float s = 0.f;
#pragma unroll 1
        for (int n0 = 0; n0 < 64; n0 += 8) { float kv[8];
#pragma unroll
            for (int j = 0; j < 8; ++j) kv[j] = base[(size_t)(n0 + j) * 2048];
#pragma unroll
            for (int j = 0; j < 8; ++j) { base[(size_t)(n0 + j) * 2048] = s; s = dc * s + kv[j]; } }
    }
}

__device__ __forceinline__ void kmean_unit(KPRef p, float* sm, int unit, int tid) {
    const bf16_t* z = (const bf16_t*)(p.ws + WS_Z); const size_t t0 = (size_t)unit * 256;
    const int c = tid & 255, part = tid >> 8; float s = 0.f;
#pragma unroll 8
    for (int i = part * 128; i < part * 128 + 128; ++i) s += bf2f(z[(t0 + i) * ZW + Z_MK + c]);
    sm[tid] = s; __syncthreads();
    if (tid < 256) ((float*)(p.ws + WS_KMEAN))[(size_t)unit * 256 + tid] = (sm[tid] + sm[tid + 256]) * (1.0f / 256.0f);
    __syncthreads();
}

struct AttAcc { float m, l; float o[8]; };
__device__ __forceinline__ void unpack8(float (&d)[8], const bf16_t* src) { const u32x4 kk = *(const u32x4*)src;
    d[0] = __uint_as_float(kk.x << 16); d[1] = __uint_as_float(kk.x & 0xffff0000u); d[2] = __uint_as_float(kk.y << 16); d[3] = __uint_as_float(kk.y & 0xffff0000u);
    d[4] = __uint_as_float(kk.z << 16); d[5] = __uint_as_float(kk.z & 0xffff0000u); d[6] = __uint_as_float(kk.w << 16); d[7] = __uint_as_float(kk.w & 0xffff0000u); }
__device__ __forceinline__ float dot8_group(const float (&q)[8], const bf16_t* krow8) {
    float k[8]; unpack8(k, krow8); float s = 0.f;
#pragma unroll
    for (int c = 0; c < 8; ++c) s += q[c] * k[c];
    s += __shfl_xor(s, 1); s += __shfl_xor(s, 2); s += __shfl_xor(s, 4); return s;
}
__device__ __forceinline__ void att_key(AttAcc& a, const float (&q)[8], const bf16_t* krow8, const bf16_t* vrow8) {
    const float s = dot8_group(q, krow8);
    const float mn = fmaxf(a.m, s), sc = __builtin_amdgcn_exp2f(a.m - mn), pr = __builtin_amdgcn_exp2f(s - mn);
    float v[8]; unpack8(v, vrow8);
    a.l = a.l * sc + pr; a.m = mn;
#pragma unroll
    for (int c = 0; c < 8; ++c) a.o[c] = a.o[c] * sc + pr * v[c];
}
__device__ __forceinline__ void att_finish(const AttAcc& a, float extra, bf16_t* orow8) {
    const float M = fmaxf(a.m, extra), sc = __builtin_amdgcn_exp2f(a.m - M), l = a.l * sc + __builtin_amdgcn_exp2f(extra - M), f = sc / l;
    u32x4 w; w.x = pk2(a.o[0] * f, a.o[1] * f); w.y = pk2(a.o[2] * f, a.o[3] * f); w.z = pk2(a.o[4] * f, a.o[5] * f); w.w = pk2(a.o[6] * f, a.o[7] * f);
    *(u32x4*)orow8 = w;
}
__device__ __forceinline__ void swa_unit(KPRef p, int l, int unit, int tid) {
    const int c64 = unit & 127, bh = unit >> 7, h = bh & 3, b = bh >> 2, kvh = h >> 1;
    const bf16_t* z = (const bf16_t*)(p.ws + WS_Z); const size_t tb = (size_t)b * S_;
    const int qi = tid >> 3, g = tid & 7, i = c64 * 64 + qi;
    float q[8]; unpack8(q, z + (tb + i) * ZW + Z_SQ + h * 64 + 8 * g);
    AttAcc a; a.m = -1e30f; a.l = 0.f;
#pragma unroll
    for (int e = 0; e < 8; ++e) a.o[e] = 0.f;
    const int j0 = (i - 127 > 0) ? i - 127 : 0;
    for (int j = j0; j <= i; ++j) att_key(a, q, z + (tb + j) * ZW + Z_SK + kvh * 64 + 8 * g, z + (tb + j) * ZW + Z_SV + kvh * 64 + 8 * g);
    const float sink2 = p.in[6][l * 4 + h] * LOG2E;
    att_finish(a, sink2, (bf16_t*)(p.ws + WS_O) + (tb + i) * 1024 + 256 + h * 64 + 8 * g);
}
__device__ __forceinline__ void moba_unit(KPRef p, int unit, int tid) {
    const int c64 = unit & 127, bh = unit >> 7, h = bh & 3, b = bh >> 2;
    const bf16_t* z = (const bf16_t*)(p.ws + WS_Z); const size_t tb = (size_t)b * S_;
    const int qi = tid >> 3, g = tid & 7, i = c64 * 64 + qi, blk = (c64 * 64) >> 8;
    float q[8]; unpack8(q, z + (tb + i) * ZW + Z_MQ + h * 64 + 8 * g);
    const float* km = (const float*)(p.ws + WS_KMEAN) + (size_t)b * 32 * 256 + h * 64 + 8 * g;
    float v0 = -3e38f, v1 = -3e38f, v2 = -3e38f; int i0 = -1, i1 = -1, i2 = -1;
    for (int nb = 0; nb < blk; ++nb) { float s = 0.f;
#pragma unroll
        for (int d = 0; d < 8; ++d) s += q[d] * km[nb * 256 + d];
        s += __shfl_xor(s, 1); s += __shfl_xor(s, 2); s += __shfl_xor(s, 4);
        if (s > v0) { v2 = v1; i2 = i1; v1 = v0; i1 = i0; v0 = s; i0 = nb; } else if (s > v1) { v2 = v1; i2 = i1; v1 = s; i1 = nb; } else if (s > v2) { v2 = s; i2 = nb; } }
    AttAcc a; a.m = -1e30f; a.l = 0.f;
#pragma unroll
    for (int e = 0; e < 8; ++e) a.o[e] = 0.f;
    const bf16_t* kb = z + tb * ZW + Z_MK + h * 64 + 8 * g; const bf16_t* vb = z + tb * ZW + Z_MV + h * 64 + 8 * g;
    for (int j = blk * 256; j <= i; ++j) att_key(a, q, kb + (size_t)j * ZW, vb + (size_t)j * ZW);
    for (int s3 = 0; s3 < 3; ++s3) { const int sb = (s3 == 0) ? i0 : (s3 == 1 ? i1 : i2); if (sb < 0) continue;
        for (int j = sb * 256; j < sb * 256 + 256; ++j) att_key(a, q, kb + (size_t)j * ZW, vb + (size_t)j * ZW); }
    att_finish(a, -1e30f, (bf16_t*)(p.ws + WS_O) + (tb + i) * 1024 + 512 + h * 64 + 8 * g);
}

__device__ __forceinline__ void route_phase(KPRef p, int l, float* sm, int wg, int tid) {
    int* se = (int*)sm;
    int* toke = (int*)(p.ws + WS_TOKE); float* tokw = (float*)(p.ws + WS_TOKW); int* tokr = (int*)(p.ws + WS_TOKR); int* hist = (int*)(p.ws + WS_HIST); int* sdst = (int*)(p.ws + WS_SDST);
    if (tid < 128) { const int t = wg * 128 + tid; const float* lg = (const float*)(p.ws + WS_LOGIT) + (size_t)t * 64; const float* bg = p.in[12] + l * 4; const float* be = p.in[14] + l * 32;
        float g0 = lg[0] + bg[0], g1 = lg[1] + bg[1], g2 = lg[2] + bg[2], g3 = lg[3] + bg[3];
        int gs = 0; float gm = g0; if (g1 > gm) { gm = g1; gs = 1; } if (g2 > gm) { gm = g2; gs = 2; } if (g3 > gm) { gm = g3; gs = 3; }
        const float gw_ = 1.0f / (expf(g0 - gm) + expf(g1 - gm) + expf(g2 - gm) + expf(g3 - gm));
        float v0 = -3e38f, v1 = -3e38f; int i0 = 0, i1 = 0;
#pragma unroll
        for (int j = 0; j < 8; ++j) { const float s = lg[4 + 8 * gs + j] + be[8 * gs + j]; if (s > v0) { v1 = v0; i1 = i0; v0 = s; i0 = j; } else if (s > v1) { v1 = s; i1 = j; } }
        const float e1 = expf(v1 - v0), w0 = 1.0f / (1.0f + e1), w1 = e1 * w0;
        const int ea = 8 * gs + i0, eb = 8 * gs + i1;
        se[2 * tid] = ea; se[2 * tid + 1] = eb; toke[2 * t] = ea; toke[2 * t + 1] = eb; tokw[2 * t] = w0 * gw_; tokw[2 * t + 1] = w1 * gw_; }
    __syncthreads();
    if (tid < 256) { const int e = se[tid]; int r = 0;
#pragma unroll 4
        for (int a = 0; a < tid; ++a) r += (se[a] == e) ? 1 : 0; tokr[wg * 256 + tid] = r; }
    if (tid >= 256 && tid < 288) { const int e = tid - 256; int c = 0;
#pragma unroll 4
        for (int a = 0; a < 256; ++a) c += (se[a] == e) ? 1 : 0; hist[wg * 32 + e] = c; }
    for (int i = tid; i < NSLOTBLK; i += NTHREADS) sdst[wg * NSLOTBLK + i] = YS_TRASH_ROW;
    __syncthreads();
}
__device__ __forceinline__ void assign_phase(KPRef p, float* sm, int wg, int tid, int wave, int lane) {
    int* cnt = (int*)sm, *bas = cnt + 32, *pend = cnt + 64, *slot_of = cnt + 128;
    const int* hist = (const int*)(p.ws + WS_HIST); const int* toke = (const int*)(p.ws + WS_TOKE); const int* tokr = (const int*)(p.ws + WS_TOKR);
    int* sdst = (int*)(p.ws + WS_SDST); int* blke = (int*)(p.ws + WS_BLKE);
    if (tid < 32) { int c = 0, bb = 0;
#pragma unroll 8
        for (int w = 0; w < 256; ++w) { const int v = hist[w * 32 + tid]; c += v; if (w < wg) bb += v; } cnt[tid] = c; bas[tid] = bb; }
    __syncthreads();
    if (tid == 0) { int run = 0; for (int e = 0; e < 32; ++e) { const int pad = ((cnt[e] + 255) >> 8) << 8; bas[e] += run; run += pad; pend[e] = run; } }
    __syncthreads();
    if (wg == 0) { if (tid < NSLOTBLK) { int e = 0; for (int k = 0; k < 32; ++k) e += (pend[k] <= tid * 256) ? 1 : 0; blke[tid] = e > 31 ? 31 : e; } if (tid == 0) blke[511] = pend[31] >> 8; }
    if (tid < 256) { const int a = wg * 256 + tid; const int e = toke[a]; const int slot = bas[e] + tokr[a]; sdst[slot] = a; slot_of[tid] = slot; }
    __syncthreads();
    const bf16_t* u2 = (const bf16_t*)(p.ws + WS_U); bf16_t* xs = (bf16_t*)(p.ws + WS_XS);
    for (int a = wave; a < 256; a += NWAVES) { const u32x4* src = (const u32x4*)(u2 + (size_t)(wg * 128 + (a >> 1)) * 1024); u32x4* dst = (u32x4*)(xs + (size_t)slot_of[a] * 1024);
        dst[lane] = src[lane]; dst[lane + 64] = src[lane + 64]; }
    __syncthreads();
}

#ifndef MK_PER_PHASE
#define MK_PER_PHASE 0
#endif
constexpr int PH_PER_LAYER = 16, N_PHASES = DEPTH_ * PH_PER_LAYER + 1;
constexpr int CW_BAR = 1024;

__global__ void __launch_bounds__(NTHREADS, 2) mega(Params p_unused) {
    extern __shared__ __attribute__((aligned(16))) unsigned char lds[];
    const int tid0 = threadIdx.x;
    const int G = gridDim.x, wg = blockIdx.x, NGW = G * NWAVES;
#define PHASE_BEGIN() KPRef p = *KP(); unsigned char* ws = p.ws; (void)ws; int tid = threadIdx.x; asm volatile("" : "+v"(tid)); const int lane = tid & 63, wave = __builtin_amdgcn_readfirstlane(tid >> 6), gw = wg * NWAVES + wave; (void)lane; (void)gw
    volatile LAS unsigned* MISC = (volatile LAS unsigned*)((LAS unsigned char*)lds + MISC_OFF);
    for (int u = tid0; u < (LDS_BYTES - LDSCTL_OFF) / 4; u += NTHREADS) ((LAS unsigned*)((LAS unsigned char*)lds + LDSCTL_OFF))[u] = 0u;
    __syncthreads();
#define KP() ({ const __attribute__((address_space(4))) Params* _k = (const __attribute__((address_space(4))) Params*)__builtin_amdgcn_kernarg_segment_ptr(); asm volatile("" : "+s"(_k)); _k; })
    unsigned* ctl; { const __attribute__((address_space(4))) Params* k0 = KP(); ctl = (unsigned*)(k0->ws + WS_CTL); }
    XcdBarrier bar = xcd_barrier_post(ctl + CW_BAR, MISC + 8);
    int lo, hi; { const __attribute__((address_space(4))) Params* k0 = KP(); lo = k0->ph_lo; hi = k0->ph_hi; }
    float* sm = (float*)lds;
    PG8_LAS unsigned char* ring = (PG8_LAS unsigned char*)lds;
#ifndef PH_MASK
#define PH_MASK 0x1ffffu
#endif
#define IN(k) ((((PH_MASK) >> ((k) == DEPTH_ * PH_PER_LAYER ? 16 : ((k) % PH_PER_LAYER))) & 1u) && lo <= (k) && (k) < hi)
#define SEAM(k) do { if ((k) + 1 < hi) xcd_barrier(bar); } while (0)

    for (int l = 0; l < DEPTH_; ++l) {
        const int P0 = l * PH_PER_LAYER;
        if (IN(P0 + 0)) { PHASE_BEGIN();
            conv_phase(p, l, lds, gw, NGW, wave, lane);
            if (l == 0) norm_phase<0>(p, l, gw, NGW, lane); else norm_phase<1>(p, l, gw, NGW, lane);
            SEAM(P0 + 0);
        }
        if (IN(P0 + 1)) { PHASE_BEGIN();
            pg8::Gemm g{(const bf16_t*)(ws + WS_U), (const bf16_t*)(ws + WS_WIN), 1024, 1024, 1024};
            pg8::StaticOrder S; S.init(T_, ZW, G, wg, 1024, 1024);
            pg8::EpiBf16 E{(bf16_t*)(ws + WS_Z), ZW, 0};
            pg8::gemm_phase(ring, g, S, E);
            SEAM(P0 + 1);
        }
        if (IN(P0 + 2)) { PHASE_BEGIN();
            for (int u = wg; u < 2048; u += G) gla_kv_unit(p, l, sm, u, tid);
            for (int u = wg; u < 1024; u += G) ret_kv_unit(p, sm, u, tid);
            for (int u = wg; u < 128; u += G) kmean_unit(p, sm, u, tid);
            for (int u = wg; u < 2048; u += G) swa_unit(p, l, u, tid);
            SEAM(P0 + 2);
        }
        if (IN(P0 + 3)) { PHASE_BEGIN(); scan_phase(p, wg, tid); SEAM(P0 + 3); }
        if (IN(P0 + 4)) { PHASE_BEGIN();
            for (int u = wg; u < 2048; u += G) gla_out_unit(p, l, sm, u, tid);
            for (int u = wg; u < 2048; u += G) ret_out_unit(p, l, sm, u, tid);
            for (int u = wg; u < 2048; u += G) moba_unit(p, u, tid);
            SEAM(P0 + 4);
        }
        for (int hf = 0; hf < 2; ++hf) {
            if (IN(P0 + 5 + 2 * hf)) { PHASE_BEGIN();
                pg8::Gemm g{(const bf16_t*)(ws + WS_O), (const bf16_t*)(ws + WS_WB), 1024, 256, 256};
                pg8::StaticOrder S; S.init(T_ / 2, 4096, G, wg, 1024, 256, 64 * hf, 2, 512);
                pg8::EpiBf16 E{(bf16_t*)(ws + WS_YH), 4096, 16384 * hf};
                pg8::gemm_phase(ring, g, S, E);
                SEAM(P0 + 5 + 2 * hf);
            }
            if (IN(P0 + 6 + 2 * hf)) { PHASE_BEGIN();
                pg8::Gemm g{(const bf16_t*)(ws + WS_U), (const bf16_t*)(ws + WS_WG), 1024, 1024, 1024};
                pg8::StaticOrder S; S.init(T_ / 2, 4096, G, wg, 1024, 1024, 64 * hf);
                pg8::EpiGate E{(const bf16_t*)(ws + WS_YH), 16384 * hf, (bf16_t*)(ws + WS_O)};
                pg8::gemm_phase(ring, g, S, E);
                SEAM(P0 + 6 + 2 * hf);
            }
        }
        if (IN(P0 + 9)) { PHASE_BEGIN();
            pg8::Gemm g{(const bf16_t*)(ws + WS_O), (const bf16_t*)(ws + WS_WO), 1024, 1024, 1024};
            pg8::StaticOrder S; S.init(T_, 1024, G, wg, 1024, 1024);
            pg8::EpiRes E{l == 0 ? p.in[0] : p.out, p.out, 1024};
            pg8::gemm_phase(ring, g, S, E);
            SEAM(P0 + 9);
        }
        if (IN(P0 + 10)) { PHASE_BEGIN(); norm_phase<2>(p, l, gw, NGW, lane); SEAM(P0 + 10); }
        if (IN(P0 + 11)) { PHASE_BEGIN();
            pg8::Gemm g{(const bf16_t*)(ws + WS_U), (const bf16_t*)(ws + WS_WR), 1024, 1024, 1024};
            pg8::StaticOrder S; S.init(T_, 256, G, wg, 1024, 1024);
            pg8::EpiRouter E{(float*)(ws + WS_LOGIT)};
            pg8::gemm_phase(ring, g, S, E);
            SEAM(P0 + 11);
        }
        if (IN(P0 + 12)) { PHASE_BEGIN(); route_phase(p, l, sm, wg, tid); SEAM(P0 + 12); }
        if (IN(P0 + 13)) { PHASE_BEGIN(); assign_phase(p, sm, wg, tid, wave, lane); SEAM(P0 + 13); }
        if (IN(P0 + 14)) { PHASE_BEGIN();
            const int* blke = (const int*)(ws + WS_BLKE); const int nb = __builtin_amdgcn_readfirstlane(blke[511]);
            pg8::Gemm g{(const bf16_t*)(ws + WS_XS), (const bf16_t*)(ws + WS_E1), 1024, 1024, 1024};
            pg8::MoeOrder<2> S{blke, nb, G, wg, (size_t)256 * 1024 * 2, (size_t)256 * 1024 * 2, (size_t)512 * 1024 * 2};
            pg8::EpiE1 E{(bf16_t*)(ws + WS_HDN)};
            pg8::gemm_phase(ring, g, S, E);
            SEAM(P0 + 14);
        }
        if (IN(P0 + 15)) { PHASE_BEGIN();
            const int* blke = (const int*)(ws + WS_BLKE); const int nb = __builtin_amdgcn_readfirstlane(blke[511]);
            pg8::Gemm g{(const bf16_t*)(ws + WS_HDN), (const bf16_t*)(ws + WS_E2), 256, 256, 256};
            pg8::MoeOrder<4> S{blke, nb, G, wg, (size_t)256 * 256 * 2, (size_t)256 * 256 * 2, (size_t)1024 * 256 * 2};
            pg8::EpiE2 E{(bf16_t*)(ws + WS_YS), (const int*)(ws + WS_SDST)};
            pg8::gemm_phase(ring, g, S, E);
            SEAM(P0 + 15);
        }
    }
    if (IN(DEPTH_ * PH_PER_LAYER)) { PHASE_BEGIN(); norm_phase<3>(p, 0, gw, NGW, lane); }
#undef IN
#undef SEAM
}

extern "C" void kernel_launch(void* const* d_in, const int* in_sizes, int n_in, void* d_out, int out_size, void* d_ws, size_t ws_size, hipStream_t stream) {
    static int grid = 0;
    if (grid == 0) {
        if (n_in != 19 || out_size != T_ * D_ || ws_size < WS_END) { fprintf(stderr, "kernel_launch: unexpected shapes (n_in %d, out %d, ws %zu); nothing launched\n", n_in, out_size, ws_size); grid = -1; return; }
        int dev = 0, cus = 0;
        if (hipGetDevice(&dev) != hipSuccess || hipDeviceGetAttribute(&cus, hipDeviceAttributeMultiprocessorCount, dev) != hipSuccess) { grid = -1; return; }
        if (hipFuncSetAttribute((const void*)mega, hipFuncAttributeMaxDynamicSharedMemorySize, LDS_BYTES) != hipSuccess) { fprintf(stderr, "kernel_launch: hipFuncSetAttribute failed\n"); grid = -1; return; }
        int per_cu = 0;
        if (hipOccupancyMaxActiveBlocksPerMultiprocessor(&per_cu, (const void*)mega, NTHREADS, LDS_BYTES) != hipSuccess || per_cu < 1) { fprintf(stderr, "kernel_launch: occupancy query reports %d blocks per CU\n", per_cu); }
        (void)hipGetLastError();
        grid = cus;
    }
    if (grid <= 0) return;
    Params p{};
    for (int i = 0; i < 19; ++i) p.in[i] = (const float*)d_in[i];
    p.out = (float*)d_out; p.ws = (unsigned char*)d_ws;
    for (int f = 0; f < 16; ++f) p.inv_freq[f] = (float)std::pow(10000.0, -(double)f / 16.0);
    for (int h = 0; h < 4; ++h) p.ret_lg2[h] = (float)std::log2(1.0 - std::exp2(-5.0 - (double)h));
    hipMemsetAsync((unsigned char*)d_ws + WS_CTL, 0, CTL_BYTES, stream);
#if MK_PER_PHASE
    for (int ph = 0; ph < N_PHASES; ++ph) { p.ph_lo = ph; p.ph_hi = ph + 1; hipLaunchKernelGGL(mega, dim3(grid), dim3(NTHREADS), LDS_BYTES, stream, p); }
#else
    p.ph_lo = 0; p.ph_hi = N_PHASES;
    hipLaunchKernelGGL(mega, dim3(grid), dim3(NTHREADS), LDS_BYTES, stream, p);
#endif
}
```

```cpp
#include <hip/hip_runtime.h>
#include <cstdio>
#include <cstdint>
#include <cmath>

#define LAS __attribute__((address_space(3)))
#define GAS __attribute__((address_space(1)))
typedef unsigned short bf16_t;
typedef short bf16x8 __attribute__((ext_vector_type(8)));
typedef float f32x4 __attribute__((ext_vector_type(4)));
typedef float f32x2 __attribute__((ext_vector_type(2)));
typedef unsigned u32x4 __attribute__((ext_vector_type(4)));
typedef unsigned u32x2 __attribute__((ext_vector_type(2)));

constexpr int T_ = 32768, D_ = 1024, S_ = 8192, NBATCH = 4, DEPTH_ = 2;
constexpr int ZW = 3072;
constexpr int Z_GQ = 0, Z_GK = 128, Z_GV = 256, Z_GR = 512, Z_GA = 768, Z_SQ = 784, Z_SK = 1040, Z_SV = 1168, Z_MQ = 1296, Z_MK = 1552, Z_MV = 1808,
              Z_RQ = 2064, Z_RK = 2192, Z_RV = 2320, Z_RG = 2576, Z_GATE = 2832, IN_W = 6928;
constexpr float LOG2E = 1.4426950408889634f;
constexpr float C2 = 0.125f * 1.4426950408889634f;
constexpr float RSQ32 = 0.17677669529663687f;
constexpr float NORM_EPS = 1e-6f;
constexpr int NEXP = 32, EHID = 256, MOE_BLK = 256, NSLOTBLK = 288, NSLOT = NSLOTBLK * MOE_BLK;

constexpr size_t MiB = 1u << 20;
constexpr size_t WS_WIN = 0, WS_WG = 6 * MiB, WS_WB = 14 * MiB, WS_WO = 16 * MiB, WS_WR = 18 * MiB, WS_E1 = 19 * MiB, WS_E2 = 51 * MiB;
constexpr size_t WS_YS = 68 * MiB;
constexpr size_t WS_GKV = 68 * MiB, WS_RKV = 84 * MiB, WS_GDEC = 92 * MiB, WS_KMEAN = 93 * MiB, WS_O = 108 * MiB;
constexpr size_t WS_U = 197 * MiB;
constexpr size_t WS_Z = 261 * MiB;
constexpr size_t WS_YH = 261 * MiB;
constexpr size_t WS_XS = 261 * MiB, WS_HDN = 405 * MiB;
constexpr size_t WS_LOGIT = 453 * MiB;
constexpr size_t WS_TOKE = 461 * MiB, WS_TOKW = WS_TOKE + 256 * 1024, WS_TOKR = WS_TOKW + 256 * 1024, WS_HIST = WS_TOKR + 256 * 1024,
                 WS_SDST = WS_HIST + 64 * 1024, WS_BLKE = WS_SDST + 512 * 1024;
constexpr size_t WS_MLIST = 94 * MiB, WS_MCNT = 102 * MiB;
constexpr size_t WS_PARTO = 453 * MiB, WS_PARTML = 501 * MiB;
constexpr size_t WS_CTL = 511 * MiB, CTL_BYTES = 64 * 1024;
constexpr size_t WS_END = 512 * MiB;
constexpr int YS_TRASH_ROW = 2 * T_;

__device__ __forceinline__ float bf2f(bf16_t v) { return __uint_as_float(((unsigned)v) << 16); }
__device__ __forceinline__ unsigned f2bf(float f) { unsigned u = __float_as_uint(f); return (u + 0x7fffu + ((u >> 16) & 1u)) >> 16; }
__device__ __forceinline__ unsigned pk2(float lo, float hi) { return f2bf(lo) | (f2bf(hi) << 16); }
__device__ __forceinline__ float sigmoidf_(float x) { return __builtin_amdgcn_rcpf(1.0f + __builtin_amdgcn_exp2f(-x * LOG2E)); }

namespace pg8 {
#define PG8_LAS __attribute__((address_space(3)))
constexpr int BM = 256, BK = 64, HALF = 128, HTB = HALF * BK * 2  , STAGE_BYTES = 8 * HTB, NXCD = 8, WGM = 8;

__host__ __device__ __forceinline__ int lds_byte(int r, int c) { const int st = (r >> 4) * 2 + (c >> 5), rr = r & 15, cc = c & 31, ob = rr * 64 + cc * 2; return st * 1024 + (ob ^ (((ob >> 9) & 1) << 5)); }
__host__ __device__ __forceinline__ void stage_rc(int b, int& R, int& C) { const int st = b / 1024, sb = b % 1024, swz = sb ^ (((sb >> 9) & 1) << 5); R = (st >> 1) * 16 + swz / 64; C = (st & 1) * 32 + (swz % 64) / 2; }
__host__ __device__ __forceinline__ int perm32(int rho) { const int n = rho >> 4, i = rho & 15; return 8 * (i >> 2) + 4 * n + (i & 3); }

struct Unit { int pm, pn; size_t aoff, boff; };
struct Gemm { const bf16_t* A; const bf16_t* Bt; int lda, ldb, K; };

struct StaticOrder {
    int nM, nN, nwg, G, c, pm_base, a_shift; size_t a_mul, a_tstep, b_tstep;
    __device__ void init(int M, int N, int G_, int c_, int lda, int ldb, int pm_base_ = 0, int a_shift_ = 30, size_t a_mul_ = 0) {
        nM = M / BM; nN = N / BM; nwg = nM * nN; G = G_; c = c_; pm_base = pm_base_; a_shift = a_shift_; a_mul = a_mul_; a_tstep = (size_t)BM * lda * 2; b_tstep = (size_t)BM * ldb * 2; }
    __device__ bool next(int i, Unit& u) const {
        const long L = (long)i * G + c; if (L >= nwg) return false;
        int wgid = (int)L; { const int q = nwg / NXCD, r = nwg % NXCD, xcd = wgid % NXCD, off = wgid / NXCD; wgid = (xcd < r ? xcd * (q + 1) : r * (q + 1) + (xcd - r) * q) + off; }
        const int nig = WGM * nN, gid = wgid / nig, fm = gid * WGM, gsz = (nM - fm) < WGM ? (nM - fm) : WGM;
        u.pm = pm_base + fm + ((wgid % nig) % gsz); u.pn = (wgid % nig) / gsz;
        u.aoff = (size_t)u.pm * a_tstep + (size_t)(u.pn >> a_shift) * a_mul; u.boff = (size_t)u.pn * b_tstep; return true;
    }
};
template <int NCOL> struct MoeOrder {
    const int* blk_e; int nb, G, c; size_t a_tstep, b_tstep, b_estep;
    __device__ bool next(int i, Unit& u) const {
        const int L = i * G + c; if (L >= nb * NCOL) return false;
        const int rb = L / NCOL, pn = L % NCOL; const int e = __builtin_amdgcn_readfirstlane(blk_e[rb]);
        u.pm = rb; u.pn = pn; u.aoff = (size_t)rb * a_tstep; u.boff = (size_t)e * b_estep + (size_t)pn * b_tstep; return true;
    }
};

__device__ __forceinline__ unsigned cvt_pk_bf16(float lo, float hi) { unsigned r; asm volatile("v_cvt_pk_bf16_f32 %0, %1, %2" : "=v"(r) : "v"(lo), "v"(hi)); return r; }

struct EpiBf16 {
    static constexpr bool PERM = true;
    bf16_t* O; int ldc; int row_sub;
    __device__ __forceinline__ void operator()(const f32x4 (&acc)[2][2][4][2], const Unit& u, int wr, int wc, int fr, int fq) const {
        const int row0 = u.pm * BM + wr * 64 + fr - row_sub; const int col0 = u.pn * BM + wc * 32 + 8 * fq;
#pragma unroll
        for (int ai = 0; ai < 2; ++ai)
#pragma unroll
            for (int m = 0; m < 4; ++m) { bf16_t* rowp = O + (size_t)(row0 + ai * HALF + m * 16) * ldc + col0;
#pragma unroll
                for (int bj = 0; bj < 2; ++bj) { const f32x4 v0 = acc[ai][bj][m][0], v1 = acc[ai][bj][m][1];
                    u32x4 w; w.x = cvt_pk_bf16(v0[0], v0[1]); w.y = cvt_pk_bf16(v0[2], v0[3]); w.z = cvt_pk_bf16(v1[0], v1[1]); w.w = cvt_pk_bf16(v1[2], v1[3]);
                    *(u32x4*)(rowp + bj * HALF) = w; } }
    }
};
struct EpiRes {
    static constexpr bool PERM = false;
    const float* base; float* C; int ldc;
    __device__ __forceinline__ void operator()(const f32x4 (&acc)[2][2][4][2], const Unit& u, int wr, int wc, int fr, int fq) const {
        const int row0 = u.pm * BM + wr * 64 + fr, col0 = u.pn * BM + wc * 32 + 4 * fq;
#pragma unroll
        for (int ai = 0; ai < 2; ++ai)
#pragma unroll
            for (int m = 0; m < 4; ++m) { const size_t off = (size_t)(row0 + ai * HALF + m * 16) * ldc + col0;
#pragma unroll
                for (int bj = 0; bj < 2; ++bj)
#pragma unroll
                    for (int n = 0; n < 2; ++n) { const f32x4 b = *(const f32x4*)(base + off + bj * HALF + n * 16); *(f32x4*)(C + off + bj * HALF + n * 16) = b + acc[ai][bj][m][n]; }
                asm volatile("" ::: "memory"); }
    }
};
struct EpiRouter {
    static constexpr bool PERM = false;
    float* L;
    __device__ __forceinline__ void operator()(const f32x4 (&acc)[2][2][4][2], const Unit& u, int wr, int wc, int fr, int fq) const {
        if (wc >= 2) return;
        const int row0 = u.pm * BM + wr * 64 + fr, col0 = wc * 32 + 4 * fq;
#pragma unroll
        for (int ai = 0; ai < 2; ++ai)
#pragma unroll
            for (int m = 0; m < 4; ++m) { float* rowp = L + (size_t)(row0 + ai * HALF + m * 16) * 64 + col0;
#pragma unroll
                for (int n = 0; n < 2; ++n) *(f32x4*)(rowp + n * 16) = acc[ai][0][m][n]; }
    }
};
struct EpiGate {
    static constexpr bool PERM = false;
    const bf16_t* Y; int y_row_sub; bf16_t* Mg;
    __device__ __forceinline__ void operator()(const f32x4 (&acc)[2][2][4][2], const Unit& u, int wr, int wc, int fr, int fq) const {
        const int row0 = u.pm * BM + wr * 64 + fr, d0 = u.pn * 64 + wc * 16 + fq * 4;
#pragma unroll
        for (int ai = 0; ai < 2; ++ai)
#pragma unroll
            for (int m = 0; m < 4; ++m) { const int r = row0 + ai * HALF + m * 16; const bf16_t* yrow = Y + (size_t)(r - y_row_sub) * 4096 + d0;
                f32x4 s = (f32x4){0.f, 0.f, 0.f, 0.f};
#pragma unroll
                for (int i = 0; i < 4; ++i) { const u32x2 yv = *(const u32x2*)(yrow + 1024 * i); const f32x4 g = acc[ai][i >> 1][m][i & 1];
                    s[0] += sigmoidf_(g[0]) * __uint_as_float(yv.x << 16); s[1] += sigmoidf_(g[1]) * __uint_as_float(yv.x & 0xffff0000u);
                    s[2] += sigmoidf_(g[2]) * __uint_as_float(yv.y << 16); s[3] += sigmoidf_(g[3]) * __uint_as_float(yv.y & 0xffff0000u); }
                u32x2 w; w.x = cvt_pk_bf16(s[0], s[1]); w.y = cvt_pk_bf16(s[2], s[3]);
                *(u32x2*)(Mg + (size_t)r * 1024 + d0) = w;
                asm volatile("" ::: "memory"); }
    }
};
struct EpiE1 {
    static constexpr bool PERM = true;
    bf16_t* H;
    __device__ __forceinline__ void operator()(const f32x4 (&acc)[2][2][4][2], const Unit& u, int wr, int wc, int fr, int fq) const {
        const int row0 = u.pm * BM + wr * 64 + fr, col0 = u.pn * 128 + wc * 32 + 8 * fq;
#pragma unroll
        for (int ai = 0; ai < 2; ++ai)
#pragma unroll
            for (int m = 0; m < 4; ++m) { bf16_t* rowp = H + (size_t)(row0 + ai * HALF + m * 16) * EHID + col0;
                const f32x4 a0 = acc[ai][0][m][0], a1 = acc[ai][0][m][1], b0 = acc[ai][1][m][0], b1 = acc[ai][1][m][1];
                f32x4 v0, v1;
#pragma unroll
                for (int j = 0; j < 4; ++j) { v0[j] = a0[j] * sigmoidf_(a0[j]) * b0[j]; v1[j] = a1[j] * sigmoidf_(a1[j]) * b1[j]; }
                u32x4 w; w.x = cvt_pk_bf16(v0[0], v0[1]); w.y = cvt_pk_bf16(v0[2], v0[3]); w.z = cvt_pk_bf16(v1[0], v1[1]); w.w = cvt_pk_bf16(v1[2], v1[3]);
                *(u32x4*)rowp = w; }
    }
};
struct EpiE2 {
    static constexpr bool PERM = true;
    bf16_t* YS; const int* sdst;
    __device__ __forceinline__ void operator()(const f32x4 (&acc)[2][2][4][2], const Unit& u, int wr, int wc, int fr, int fq) const {
        const int row0 = u.pm * BM + wr * 64 + fr, col0 = u.pn * BM + wc * 32 + 8 * fq;
#pragma unroll
        for (int ai = 0; ai < 2; ++ai)
#pragma unroll
            for (int m = 0; m < 4; ++m) { const int dst = sdst[row0 + ai * HALF + m * 16];
                bf16_t* rowp = YS + (size_t)dst * 1024 + col0;
#pragma unroll
                for (int bj = 0; bj < 2; ++bj) { const f32x4 v0 = acc[ai][bj][m][0], v1 = acc[ai][bj][m][1];
                    u32x4 w; w.x = cvt_pk_bf16(v0[0], v0[1]); w.y = cvt_pk_bf16(v0[2], v0[3]); w.z = cvt_pk_bf16(v1[0], v1[1]); w.w = cvt_pk_bf16(v1[2], v1[3]);
                    *(u32x4*)(rowp + bj * HALF) = w; }
                asm volatile("" ::: "memory"); }
    }
};

template <class Epi, class Sched>
__device__ __forceinline__ void gemm_phase(PG8_LAS unsigned char* lds, const Gemm g, const Sched& S, const Epi& E) {
    int tid = threadIdx.x; asm volatile("" : "+v"(tid));
    const int wid = __builtin_amdgcn_readfirstlane(tid >> 6), lane = tid & 63, wr = wid >> 2, wc = wid & 3, fr = lane & 15, fq = lane >> 4;
    const int K = g.K, nt = K / BK;
    unsigned voffA[2], voffB[2];
#pragma unroll
    for (int i = 0; i < 2; ++i) { int R, C; stage_rc(tid * 16 + i * 8192, R, C); const int Rb = Epi::PERM ? ((R & ~31) + perm32(R & 31)) : R;
        voffA[i] = (unsigned)(R * g.lda + C) * 2u; voffB[i] = (unsigned)(Rb * g.ldb + C) * 2u; }
    const size_t kstep = (size_t)(BK * 2);
    const size_t hstepA = (size_t)HALF * g.lda * 2, hstepB = (size_t)HALF * g.ldb * 2;
    const unsigned ldsw = (unsigned)wid * 1024u;
    const int aoff = lds_byte(wr * 64 + fr, fq * 8), boff = lds_byte(wc * 32 + fr, fq * 8);
#define PG8_SA(b, h) (((b) * 2 + (h)) * HTB)
#define PG8_SB(b, h) ((4 + (b) * 2 + (h)) * HTB)
#define PG8_STAGE(bufoff, gbase, voff) do { _Pragma("unroll") for (int _i = 0; _i < 2; ++_i) \
        __builtin_amdgcn_global_load_lds((const unsigned*)((const char*)(gbase) + (voff)[_i]), (PG8_LAS unsigned*)(lds + (bufoff) + ldsw + _i * 8192), 16, 0, 0); } while (0)
#define PG8_LDA(dst, b, h) do { _Pragma("unroll") for (int m = 0; m < 4; ++m) _Pragma("unroll") for (int k = 0; k < 2; ++k) dst[m][k] = *(const PG8_LAS bf16x8*)(lds + PG8_SA(b, h) + aoff + m * 2048 + k * 1024); } while (0)
#define PG8_LDB(dst, b, h) do { _Pragma("unroll") for (int n = 0; n < 2; ++n) _Pragma("unroll") for (int k = 0; k < 2; ++k) dst[n][k] = *(const PG8_LAS bf16x8*)(lds + PG8_SB(b, h) + boff + n * 2048 + k * 1024); } while (0)
#define PG8_MMA(ai, bj, At, Bt) do { __builtin_amdgcn_s_setprio(1); _Pragma("unroll") for (int m = 0; m < 4; ++m) _Pragma("unroll") for (int n = 0; n < 2; ++n) _Pragma("unroll") for (int k = 0; k < 2; ++k) \
        acc[ai][bj][m][n] = __builtin_amdgcn_mfma_f32_16x16x32_bf16(Bt[n][k], At[m][k], acc[ai][bj][m][n], 0, 0, 0); __builtin_amdgcn_s_setprio(0); } while (0)
#define PG8_WAIT_V(n) asm volatile("s_waitcnt vmcnt(" #n ")" ::: "memory")
#define PG8_WAIT_L(n) asm volatile("s_waitcnt lgkmcnt(" #n ")" ::: "memory")
#define PG8_BAR __builtin_amdgcn_s_barrier()
#define PG8_SCHED __builtin_amdgcn_sched_barrier(0)
    Unit cur, nxt; int ui = 0;
    if (!S.next(0, cur)) return;
    f32x4 acc[2][2][4][2];
#pragma unroll
    for (int a = 0; a < 2; ++a)
#pragma unroll
        for (int b = 0; b < 2; ++b)
#pragma unroll
            for (int m = 0; m < 4; ++m)
#pragma unroll
                for (int n = 0; n < 2; ++n) acc[a][b][m][n] = (f32x4){0.f, 0.f, 0.f, 0.f};
    bf16x8 At[4][2], B0[2][2], B1[2][2];
    const char* cA = (const char*)g.A + cur.aoff; const char* cB = (const char*)g.Bt + cur.boff;
    PG8_STAGE(PG8_SB(0, 0), cB, voffB); PG8_STAGE(PG8_SA(0, 0), cA, voffA); PG8_STAGE(PG8_SB(0, 1), cB + hstepB, voffB); PG8_STAGE(PG8_SA(0, 1), cA + hstepA, voffA);
    if (wr == 1) PG8_BAR;
    PG8_WAIT_V(4); PG8_BAR;
    PG8_STAGE(PG8_SB(1, 0), cB + kstep, voffB); PG8_STAGE(PG8_SA(1, 0), cA + kstep, voffA); PG8_STAGE(PG8_SB(1, 1), cB + hstepB + kstep, voffB);
    PG8_WAIT_V(6); PG8_BAR;
    for (;;) {
        const bool has_next = S.next(ui + 1, nxt);
        const char* nA = has_next ? (const char*)g.A + nxt.aoff : cA; const char* nB = has_next ? (const char*)g.Bt + nxt.boff : cB;
        for (int t = 0; t < nt; t += 2) {
            const bool last = (t == nt - 2);
            const char* a1 = cA + (size_t)(t + 1) * kstep;
            const char* a2 = last ? nA : cA + (size_t)(t + 2) * kstep; const char* b2 = last ? nB : cB + (size_t)(t + 2) * kstep;
            const char* a3 = a2 + kstep; const char* b3 = b2 + kstep;
            PG8_LDB(B0, 0, 0); PG8_SCHED; PG8_LDA(At, 0, 0); PG8_STAGE(PG8_SA(1, 1), a1 + hstepA, voffA);
            PG8_WAIT_L(8); PG8_BAR; PG8_WAIT_L(0); PG8_MMA(0, 0, At, B0); PG8_BAR; PG8_SCHED;
            PG8_LDB(B1, 0, 1); PG8_STAGE(PG8_SB(0, 0), b2, voffB);
            PG8_BAR; PG8_WAIT_L(0); PG8_MMA(0, 1, At, B1); PG8_BAR;
            PG8_LDA(At, 0, 1); PG8_STAGE(PG8_SA(0, 0), a2, voffA);
            PG8_BAR; PG8_WAIT_L(0); PG8_MMA(1, 0, At, B0); PG8_BAR; PG8_SCHED;
            PG8_STAGE(PG8_SB(0, 1), b2 + hstepB, voffB);
            PG8_WAIT_V(6); PG8_BAR; PG8_MMA(1, 1, At, B1); PG8_BAR;
            PG8_LDB(B0, 1, 0); PG8_SCHED; PG8_LDA(At, 1, 0); PG8_STAGE(PG8_SA(0, 1), a2 + hstepA, voffA);
            PG8_WAIT_L(8); PG8_BAR; PG8_WAIT_L(0); PG8_MMA(0, 0, At, B0); PG8_BAR; PG8_SCHED;
            PG8_LDB(B1, 1, 1); PG8_STAGE(PG8_SB(1, 0), b3, voffB);
            PG8_BAR; PG8_WAIT_L(0); PG8_MMA(0, 1, At, B1); PG8_BAR;
            PG8_LDA(At, 1, 1); PG8_STAGE(PG8_SA(1, 0), a3, voffA);
            PG8_BAR; PG8_WAIT_L(0); PG8_MMA(1, 0, At, B0); PG8_BAR; PG8_SCHED;
            PG8_STAGE(PG8_SB(1, 1), b3 + hstepB, voffB);
            PG8_WAIT_V(6); PG8_BAR; PG8_MMA(1, 1, At, B1); PG8_BAR;
        }
        E(acc, cur, wr, wc, fr, fq);
        if (!has_next) break;
#pragma unroll
        for (int a = 0; a < 2; ++a)
#pragma unroll
            for (int b = 0; b < 2; ++b)
#pragma unroll
                for (int m = 0; m < 4; ++m)
#pragma unroll
                    for (int n = 0; n < 2; ++n) acc[a][b][m][n] = (f32x4){0.f, 0.f, 0.f, 0.f};
        cur = nxt; cA = nA; cB = nB; ++ui;
    }
    PG8_WAIT_V(0);
    if (wr == 0) PG8_BAR;
    PG8_BAR;
#undef PG8_SA
#undef PG8_SB
#undef PG8_STAGE
#undef PG8_LDA
#undef PG8_LDB
#undef PG8_MMA
#undef PG8_WAIT_V
#undef PG8_WAIT_L
#undef PG8_BAR
#undef PG8_SCHED
}
}

#define XB_TMO      128
#define XB_XCNT(j)  (256  + 64 * (j))
#define XB_XSUB(j)  (1280 + 64 * (j))
#define XB_XGEN(j)  (2304 + 64 * (j))
#define XB_TOP      3328
#define XB_TOPGEN   3392
#define XCD_BAR_WORDS 3456
#define XB_SPIN_CAP (1u << 21)

__device__ __forceinline__ unsigned xb_ld(unsigned* p)              { return __hip_atomic_load(p, __ATOMIC_RELAXED, __HIP_MEMORY_SCOPE_AGENT); }
__device__ __forceinline__ unsigned xb_add(unsigned* p, unsigned v) { return __hip_atomic_fetch_add(p, v, __ATOMIC_RELAXED, __HIP_MEMORY_SCOPE_AGENT); }
__device__ __forceinline__ unsigned xb_xcc_id() { return (unsigned)__builtin_amdgcn_s_getreg((3 << 11) | 20) & 0xFu; }
#define XB_SPIN(cond, bar) do { unsigned _sp = 0; while (cond) { __builtin_amdgcn_s_sleep(1); \
    if ((++_sp & 255u) == 0u) { if (xb_ld(&(bar)[XB_TMO])) break; if (_sp > XB_SPIN_CAP) { atomicAdd(&(bar)[XB_TMO], 1u); break; } } } } while (0)

struct XcdBarrier {
    unsigned* bar; unsigned x;
    volatile LAS unsigned* st;
};

__device__ __forceinline__ XcdBarrier xcd_barrier_post(unsigned* bar, volatile LAS unsigned* st) {
    XcdBarrier b; b.bar = bar; b.x = xb_xcc_id(); b.st = st;
    if (threadIdx.x == 0) (void)xb_add(&bar[XB_XCNT(b.x)], 1u);
    return b;
}
__device__ __forceinline__ void xcd_barrier_complete(unsigned* bar, unsigned x, unsigned& nloc, unsigned& nx) {
    const unsigned G = gridDim.x * gridDim.y * gridDim.z;
    unsigned sum, cnt, mine, sp = 0u;
    for (;;) {
        sum = 0u; cnt = 0u; mine = 0u;
#pragma unroll
        for (unsigned j = 0; j < 16; ++j) { const unsigned c = xb_ld(&bar[XB_XCNT(j)]); sum += c; cnt += (c > 0u) ? 1u : 0u; mine = (j == x) ? c : mine; }
        if (sum == G) break;
        __builtin_amdgcn_s_sleep(1);
        if ((++sp & 255u) == 0u) { if (xb_ld(&bar[XB_TMO])) break; if (sp > XB_SPIN_CAP) { atomicAdd(&bar[XB_TMO], 1u); break; } }
    }
    nloc = mine > 0u ? mine : 1u; nx = cnt > 0u ? cnt : 1u;
}

__device__ __forceinline__ void xcd_barrier(const XcdBarrier& b) {
    asm volatile("s_waitcnt vmcnt(0)" ::: "memory");
    __syncthreads();
    if (threadIdx.x == 0) {
        unsigned* bar = b.bar;
        __builtin_amdgcn_s_waitcnt(0);
        unsigned nloc = b.st[0], nx = b.st[1];
        if (nloc == 0u) { xcd_barrier_complete(bar, b.x, nloc, nx); b.st[0] = nloc; b.st[1] = nx; }
        const unsigned old = xb_add(&bar[XB_XSUB(b.x)], 1u);
        const unsigned gen = old / nloc;
        if (old + 1u == (gen + 1u) * nloc) {
            __builtin_amdgcn_fence(__ATOMIC_RELEASE, "agent");
            asm volatile("s_waitcnt vmcnt(0)" ::: "memory");
            const unsigned og = xb_add(&bar[XB_TOP], 1u);
            const unsigned tg = og / nx;
            if (og + 1u == (tg + 1u) * nx) xb_add(&bar[XB_TOPGEN], 1u);
            else XB_SPIN(xb_ld(&bar[XB_TOPGEN]) == tg, bar);
            __builtin_amdgcn_fence(__ATOMIC_ACQUIRE, "agent");
            xb_add(&bar[XB_XGEN(b.x)], 1u);
            asm volatile("s_waitcnt vmcnt(0)" ::: "memory");
        } else {
            XB_SPIN(xb_ld(&bar[XB_XGEN(b.x)]) == gen, bar);
            __builtin_amdgcn_fence(__ATOMIC_ACQUIRE, "agent");
            asm volatile("s_waitcnt vmcnt(0)" ::: "memory");
        }
    }
    __syncthreads();
}

constexpr int NWAVES = 8, NTHREADS = 512;
constexpr int RING_BYTES = 131072;
constexpr int LDSCTL_OFF = 147456 - 1024, MISC_OFF = LDSCTL_OFF + 320;
constexpr int LDS_BYTES = 147456;

struct Params { const float* in[19]; float* out; unsigned char* ws; float inv_freq[16]; float ret_lg2[4]; int ph_lo, ph_hi; };
typedef const __attribute__((address_space(4))) Params& KPRef;

__device__ __forceinline__ float wave_sum(float v) {
#pragma unroll
    for (int o = 1; o < 64; o <<= 1) v += __shfl_xor(v, o);
    return v;
}
#define LDS_WAIT() asm volatile("s_waitcnt lgkmcnt(0)" ::: "memory")

template <class LD>
__device__ __forceinline__ void conv_item(LD ld, bf16_t* WT, int K, float* scr, int kb, int nb, int lane) {
    const int k0 = 64 * kb, n0 = 32 * nb;
#pragma unroll 8
    for (int i = 0; i < 32; ++i) { const int kk = 2 * i + (lane >> 5); scr[kk * 33 + (lane & 31)] = ld(k0 + kk, n0 + (lane & 31)); }
    LDS_WAIT();
    const int c = lane & 7;
#pragma unroll
    for (int j = 0; j < 4; ++j) { const int n = (lane >> 3) + 8 * j; const float* s = scr + (8 * c) * 33 + n;
        u32x4 o; o.x = pk2(s[0 * 33], s[1 * 33]); o.y = pk2(s[2 * 33], s[3 * 33]); o.z = pk2(s[4 * 33], s[5 * 33]); o.w = pk2(s[6 * 33], s[7 * 33]);
        *(u32x4*)(WT + (size_t)(n0 + n) * K + k0 + 8 * c) = o; }
    LDS_WAIT();
}

__device__ __forceinline__ void conv_phase(KPRef p, int l, unsigned char* lds, int gw, int NGW, int wave, int lane) {
    float* scr = (float*)(lds + wave * 16384);
    unsigned char* ws = p.ws;
    {
        const float* W = p.in[2] + (size_t)l * 1024 * IN_W; bf16_t* WT = (bf16_t*)(ws + WS_WIN);
        for (int it = gw; it < 16 * 96; it += NGW) { const int kb = it / 96, nb = it % 96;
            conv_item([&](int k, int n) -> float { if (n >= Z_GATE) return 0.f; float s = 1.f;
                if (n < Z_GK) s = RSQ32; else if (n >= Z_SQ && n < Z_SK) s = C2; else if (n >= Z_MQ && n < Z_MK) s = C2; else if (n >= Z_RK && n < Z_RV) s = RSQ32;
                return W[(size_t)k * IN_W + n] * s; }, WT, 1024, scr, kb, nb, lane); }
    }
    {
        const float* W = p.in[2] + (size_t)l * 1024 * IN_W; bf16_t* WT = (bf16_t*)(ws + WS_WG);
        for (int it = gw; it < 16 * 128; it += NGW) { const int kb = it / 128, nb = it % 128;
            conv_item([&](int k, int n) -> float { const int pn = n >> 8, c = n & 255, bj = (c >> 7) & 1, wc = (c >> 5) & 3, nn = (c >> 4) & 1, fq = (c >> 2) & 3, j = c & 3;
                const int col = Z_GATE + 1024 * (2 * bj + nn) + 64 * pn + 16 * wc + 4 * fq + j; return W[(size_t)k * IN_W + col]; }, WT, 1024, scr, kb, nb, lane); }
    }
    {
        for (int it = gw; it < 512; it += NGW) { const int i = it / 128, r = it % 128, kb = r / 32, nb = r % 32;
            const float* W = p.in[8] + (size_t)(l * 4 + i) * 256 * 1024; bf16_t* WT = (bf16_t*)(ws + WS_WB) + (size_t)i * 1024 * 256;
            conv_item([&](int k, int n) -> float { return W[(size_t)k * 1024 + n]; }, WT, 256, scr, kb, nb, lane); }
    }
    {
        const float* W = p.in[9] + (size_t)l * 1024 * 1024; bf16_t* WT = (bf16_t*)(ws + WS_WO);
        for (int it = gw; it < 16 * 32; it += NGW) { const int kb = it / 32, nb = it % 32;
            conv_item([&](int k, int n) -> float { return W[(size_t)k * 1024 + n]; }, WT, 1024, scr, kb, nb, lane); }
    }
    {
        const float* Wg = p.in[11] + (size_t)l * 1024 * 4; const float* We = p.in[13] + (size_t)l * 1024 * 32; bf16_t* WT = (bf16_t*)(ws + WS_WR);
        for (int it = gw; it < 16 * 8; it += NGW) { const int kb = it / 8, nb = it % 8;
            conv_item([&](int k, int n) -> float { if (n < 4) return Wg[k * 4 + n]; if (n < 36) return We[k * 32 + (n - 4)]; return 0.f; }, WT, 1024, scr, kb, nb, lane); }
    }
    {
        for (int it = gw; it < 32 * 256; it += NGW) { const int e = it / 256, r = it % 256, kb = r / 16, nb = r % 16;
            const int n0 = 32 * nb, pn = n0 >> 8, c0 = n0 & 255;
            const float* W = ((c0 < 128) ? p.in[15] : p.in[16]) + (size_t)(l * 32 + e) * 1024 * 256 + 128 * pn + (c0 & 127) - n0;
            bf16_t* WT = (bf16_t*)(ws + WS_E1) + (size_t)e * 512 * 1024;
            conv_item([&](int k, int n) -> float { return W[(size_t)k * 256 + n]; }, WT, 1024, scr, kb, nb, lane); }
    }
    {
        for (int it = gw; it < 32 * 128; it += NGW) { const int e = it / 128, r = it % 128, kb = r / 32, nb = r % 32;
            const float* W = p.in[17] + (size_t)(l * 32 + e) * 256 * 1024; bf16_t* WT = (bf16_t*)(ws + WS_E2) + (size_t)e * 1024 * 256;
            conv_item([&](int k, int n) -> float { return W[(size_t)k * 1024 + n]; }, WT, 256, scr, kb, nb, lane); }
    }
}

template <int MODE>
__device__ __forceinline__ void norm_phase(KPRef p, int l, int gw, int NGW, int lane) {
    const float* src = (MODE == 0) ? p.in[0] : p.out;
    const float* gain = (MODE == 3) ? p.in[18] : (MODE == 2 ? p.in[10] + l * 1024 : p.in[1] + l * 1024);
    const bf16_t* ys = (const bf16_t*)(p.ws + WS_YS); const float* tokw = (const float*)(p.ws + WS_TOKW);
    bf16_t* u = (bf16_t*)(p.ws + WS_U);
    f32x4 gg[4];
#pragma unroll
    for (int j = 0; j < 4; ++j) gg[j] = ((const f32x4*)gain)[lane + 64 * j];
    for (int row = gw; row < T_; row += NGW) {
        const f32x4* xr = (const f32x4*)(src + (size_t)row * 1024) + lane;
        f32x4 v[4];
#pragma unroll
        for (int j = 0; j < 4; ++j) v[j] = xr[64 * j];
        if (MODE == 1 || MODE == 3) {
            const float w0 = tokw[2 * row], w1 = tokw[2 * row + 1];
            const u32x2* y0 = (const u32x2*)(ys + (size_t)(2 * row) * 1024) + lane; const u32x2* y1 = (const u32x2*)(ys + (size_t)(2 * row + 1) * 1024) + lane;
#pragma unroll
            for (int j = 0; j < 4; ++j) { const u32x2 a = y0[64 * j], b = y1[64 * j];
                v[j][0] += w0 * __uint_as_float(a.x << 16) + w1 * __uint_as_float(b.x << 16); v[j][1] += w0 * __uint_as_float(a.x & 0xffff0000u) + w1 * __uint_as_float(b.x & 0xffff0000u);
                v[j][2] += w0 * __uint_as_float(a.y << 16) + w1 * __uint_as_float(b.y << 16); v[j][3] += w0 * __uint_as_float(a.y & 0xffff0000u) + w1 * __uint_as_float(b.y & 0xffff0000u); }
            if (MODE == 1) { f32x4* hr = (f32x4*)(p.out + (size_t)row * 1024) + lane;
#pragma unroll
                for (int j = 0; j < 4; ++j) hr[64 * j] = v[j]; }
        }
        float s = 0.f;
#pragma unroll
        for (int j = 0; j < 4; ++j) s += (v[j][0] * v[j][0] + v[j][1] * v[j][1]) + (v[j][2] * v[j][2] + v[j][3] * v[j][3]);
        const float rstd = rsqrtf(wave_sum(s) * (1.0f / 1024.0f) + NORM_EPS);
        if (MODE == 3) { f32x4* orow = (f32x4*)(p.out + (size_t)row * 1024) + lane;
#pragma unroll
            for (int j = 0; j < 4; ++j) orow[64 * j] = v[j] * rstd * gg[j];
        } else { u32x2* o8 = (u32x2*)(u + (size_t)row * 1024) + lane;
#pragma unroll
            for (int j = 0; j < 4; ++j) { const f32x4 o = v[j] * rstd * gg[j]; u32x2 w; w.x = pk2(o[0], o[1]); w.y = pk2(o[2], o[3]); o8[64 * j] = w; } }
    }
}

__device__ __forceinline__ float logsigmoidf_(float x) { return fminf(x, 0.f) - log1pf(expf(-fabsf(x))); }

__device__ __forceinline__ void gla_front(KPRef p, int l, float* sm, int b, int h, int n, bool need_q, int tid) {
    const bf16_t* z = (const bf16_t*)(p.ws + WS_Z); const size_t t0 = (size_t)b * S_ + (size_t)n * 64;
    float* A = sm, *K = sm + 1024, *V = sm + 3072, *Bc = sm + 7168, *Q = sm + 9216;
    for (int idx = tid; idx < 64 * 16; idx += NTHREADS) { const int i = idx >> 4, r = idx & 15; A[idx] = bf2f(z[(t0 + i) * ZW + Z_GA + r]); }
    for (int idx = tid; idx < 64 * 32; idx += NTHREADS) { const int i = idx >> 5, d = idx & 31; K[idx] = bf2f(z[(t0 + i) * ZW + Z_GK + h * 32 + d]); if (need_q) Q[idx] = bf2f(z[(t0 + i) * ZW + Z_GQ + h * 32 + d]); }
    for (int idx = tid; idx < 64 * 64; idx += NTHREADS) { const int i = idx >> 6, e = idx & 63; V[idx] = bf2f(z[(t0 + i) * ZW + Z_GV + h * 64 + e]); }
    __syncthreads();
    const float* wa2 = p.in[3] + (size_t)l * 16 * 128; const float* ba = p.in[4] + (size_t)l * 128;
    for (int idx = tid; idx < 64 * 32; idx += NTHREADS) { const int i = idx >> 5, d = idx & 31; float x = ba[h * 32 + d];
#pragma unroll
        for (int r = 0; r < 16; ++r) x += A[i * 16 + r] * wa2[r * 128 + h * 32 + d];
        Bc[idx] = logsigmoidf_(x) * (1.0f / 16.0f); }
    __syncthreads();
    if (tid < 32) { float run = 0.f;
#pragma unroll 4
        for (int i = 0; i < 64; ++i) { run += Bc[i * 32 + tid]; Bc[i * 32 + tid] = run; } }
    __syncthreads();
}
__device__ __forceinline__ void gla_kv_unit(KPRef p, int l, float* sm, int unit, int tid) {
    const int n = unit & 127, bh = unit >> 7, h = bh & 3, b = bh >> 2;
    gla_front(p, l, sm, b, h, n, false, tid);
    float* K = sm + 1024, *V = sm + 3072, *Bc = sm + 7168;
    for (int idx = tid; idx < 64 * 32; idx += NTHREADS) { const int d = idx & 31; K[idx] *= expf(Bc[63 * 32 + d] - Bc[idx]); }
    __syncthreads();
    float* gkv = (float*)(p.ws + WS_GKV) + (size_t)unit * 2048; float* gdec = (float*)(p.ws + WS_GDEC) + (size_t)unit * 32;
    for (int idx = tid; idx < 32 * 64; idx += NTHREADS) { const int d = idx >> 6, e = idx & 63; float s = 0.f;
#pragma unroll 4
        for (int j = 0; j < 64; ++j) s += K[j * 32 + d] * V[j * 64 + e];
        gkv[idx] = s; }
    if (tid < 32) gdec[tid] = expf(Bc[63 * 32 + tid]);
    __syncthreads();
}
__device__ __forceinline__ void gla_out_unit(KPRef p, int l, float* sm, int unit, int tid) {
    const int n = unit & 127, bh = unit >> 7, h = bh & 3, b = bh >> 2;
    gla_front(p, l, sm, b, h, n, true, tid);
    float* K = sm + 1024, *V = sm + 3072, *Bc = sm + 7168, *Q = sm + 9216, *ATT = sm + 11264, *O = sm + 15360, *PREV = sm + 19456, *RSTD = sm + 21504;
    const float* gprev = (const float*)(p.ws + WS_GKV) + (size_t)unit * 2048;
    for (int idx = tid; idx < 64 * 32; idx += NTHREADS) { const float bb = Bc[idx]; Q[idx] *= expf(bb); K[idx] *= expf(-bb); }
    for (int idx = tid; idx < 2048; idx += NTHREADS) PREV[idx] = gprev[idx];
    __syncthreads();
    for (int idx = tid; idx < 64 * 64; idx += NTHREADS) { const int i = idx >> 6, j = idx & 63; float s = 0.f;
        if (j <= i) {
#pragma unroll 8
            for (int d = 0; d < 32; ++d) s += Q[i * 32 + d] * K[j * 32 + d]; }
        ATT[idx] = s; }
    __syncthreads();
    for (int idx = tid; idx < 64 * 64; idx += NTHREADS) { const int i = idx >> 6, e = idx & 63; float s = 0.f;
#pragma unroll 4
        for (int j = 0; j <= i; ++j) s += ATT[i * 64 + j] * V[j * 64 + e];
#pragma unroll 8
        for (int d = 0; d < 32; ++d) s += Q[i * 32 + d] * PREV[d * 64 + e];
        O[idx] = s; }
    __syncthreads();
    if (tid < 64) { float s = 0.f;
#pragma unroll 4
        for (int e = 0; e < 64; ++e) { const float v = O[tid * 64 + e]; s += v * v; } RSTD[tid] = rsqrtf(s * (1.0f / 64.0f) + NORM_EPS); }
    __syncthreads();
    const bf16_t* z = (const bf16_t*)(p.ws + WS_Z); bf16_t* ob = (bf16_t*)(p.ws + WS_O); const size_t t0 = (size_t)b * S_ + (size_t)n * 64;
    const float* ng = p.in[5] + l * 64;
    for (int idx = tid; idx < 64 * 64; idx += NTHREADS) { const int i = idx >> 6, e = idx & 63; const float r = bf2f(z[(t0 + i) * ZW + Z_GR + h * 64 + e]);
        ob[(t0 + i) * 1024 + 0 + h * 64 + e] = (bf16_t)f2bf(O[idx] * RSTD[i] * ng[e] * (r * sigmoidf_(r))); }
    __syncthreads();
}

__device__ __forceinline__ void rope_cs(float pos, float invf, float& c, float& s) {
    const float ang = pos * invf; const double t = (double)ang * 0.15915494309189535; const float fr = (float)(t - floor(t));
    c = __builtin_amdgcn_cosf(fr); s = __builtin_amdgcn_sinf(fr);
}
__device__ __forceinline__ void ret_rot_rows(KPRef p, const bf16_t* z, size_t t0, int pos0, int nrows, int col0, float* dst, int tid) {
    for (int idx = tid; idx < nrows * 16; idx += NTHREADS) { const int i = idx >> 4, f = idx & 15; float c, s; rope_cs((float)(pos0 + i), p.inv_freq[f], c, s);
        const float x1 = bf2f(z[(t0 + i) * ZW + col0 + f]), x2 = bf2f(z[(t0 + i) * ZW + col0 + 16 + f]);
        dst[i * 32 + f] = x1 * c - x2 * s; dst[i * 32 + 16 + f] = x1 * s + x2 * c; }
}
__device__ __forceinline__ void ret_kv_unit(KPRef p, float* sm, int unit, int tid) {
    const int n = unit & 63, bh = unit >> 6, h = bh & 3, b = bh >> 2;
    const bf16_t* z = (const bf16_t*)(p.ws + WS_Z); const size_t t0 = (size_t)b * S_ + (size_t)n * 128;
    float* K = sm, *V = sm + 4096;
    ret_rot_rows(p, z, t0, n * 128, 128, Z_RK + h * 32, K, tid);
    for (int idx = tid; idx < 128 * 64; idx += NTHREADS) { const int i = idx >> 6, e = idx & 63; V[idx] = bf2f(z[(t0 + i) * ZW + Z_RV + h * 64 + e]); }
    __syncthreads();
    const float lg = p.ret_lg2[h];
    for (int idx = tid; idx < 128 * 32; idx += NTHREADS) { const int j = idx >> 5; K[idx] *= __builtin_amdgcn_exp2f((float)(127 - j) * lg); }
    __syncthreads();
    float* rkv = (float*)(p.ws + WS_RKV) + (size_t)unit * 2048;
    for (int idx = tid; idx < 32 * 64; idx += NTHREADS) { const int d = idx >> 6, e = idx & 63; float s = 0.f;
#pragma unroll 4
        for (int j = 0; j < 128; ++j) s += K[j * 32 + d] * V[j * 64 + e];
        rkv[idx] = s; }
    __syncthreads();
}
__device__ __forceinline__ void ret_out_unit(KPRef p, int l, float* sm, int unit2, int tid) {
    const int hf = unit2 & 1, unit = unit2 >> 1, n = unit & 63, bh = unit >> 6, h = bh & 3, b = bh >> 2;
    const bf16_t* z = (const bf16_t*)(p.ws + WS_Z); const size_t t0 = (size_t)b * S_ + (size_t)n * 128;
    float* K = sm, *V = sm + 4096, *Q = sm + 12288, *ATT = sm + 14336, *O = sm + 22528, *PREV = sm + 26624, *RSTD = sm + 28672;
    ret_rot_rows(p, z, t0, n * 128, 128, Z_RK + h * 32, K, tid);
    ret_rot_rows(p, z, t0 + 64 * hf, n * 128 + 64 * hf, 64, Z_RQ + h * 32, Q, tid);
    for (int idx = tid; idx < 128 * 64; idx += NTHREADS) { const int i = idx >> 6, e = idx & 63; V[idx] = bf2f(z[(t0 + i) * ZW + Z_RV + h * 64 + e]); }
    const float* gprev = (const float*)(p.ws + WS_RKV) + (size_t)unit * 2048;
    for (int idx = tid; idx < 2048; idx += NTHREADS) PREV[idx] = gprev[idx];
    __syncthreads();
    const float lg = p.ret_lg2[h];
    for (int idx = tid; idx < 64 * 128; idx += NTHREADS) { const int ii = idx >> 7, j = idx & 127, i = 64 * hf + ii; float s = 0.f;
        if (j <= i) {
#pragma unroll 8
            for (int d = 0; d < 32; ++d) s += Q[ii * 32 + d] * K[j * 32 + d];
            s *= __builtin_amdgcn_exp2f((float)(i - j) * lg); }
        ATT[idx] = s; }
    __syncthreads();
    for (int idx = tid; idx < 64 * 64; idx += NTHREADS) { const int ii = idx >> 6, e = idx & 63, i = 64 * hf + ii; float s = 0.f;
#pragma unroll 4
        for (int j = 0; j <= i; ++j) s += ATT[ii * 128 + j] * V[j * 64 + e];
        float c = 0.f;
#pragma unroll 8
        for (int d = 0; d < 32; ++d) c += Q[ii * 32 + d] * PREV[d * 64 + e];
        O[idx] = s + c * __builtin_amdgcn_exp2f((float)(i + 1) * lg); }
    __syncthreads();
    if (tid < 64) { float s = 0.f;
#pragma unroll 4
        for (int e = 0; e < 64; ++e) { const float v = O[tid * 64 + e]; s += v * v; } RSTD[tid] = rsqrtf(s * (1.0f / 64.0f) + NORM_EPS); }
    __syncthreads();
    bf16_t* ob = (bf16_t*)(p.ws + WS_O); const float* ng = p.in[7] + l * 64;
    for (int idx = tid; idx < 64 * 64; idx += NTHREADS) { const int ii = idx >> 6, e = idx & 63; const size_t t = t0 + 64 * hf + ii; const float g = bf2f(z[t * ZW + Z_RG + h * 64 + e]);
        ob[t * 1024 + 768 + h * 64 + e] = (bf16_t)f2bf(O[idx] * RSTD[ii] * ng[e] * (g * sigmoidf_(g))); }
    __syncthreads();
}

__device__ __forceinline__ void scan_phase(KPRef p, int wg, int tid) {
    if (wg < 64) {
        const int bh = wg >> 2, elem = (wg & 3) * 512 + tid, d = elem >> 6;
        float* base = (float*)(p.ws + WS_GKV) + (size_t)bh * 128 * 2048 + elem; const float* dec = (const float*)(p.ws + WS_GDEC) + (size_t)bh * 128 * 32 + d;
        float s = 0.f;
#pragma unroll 1
        for (int n0 = 0; n0 < 128; n0 += 8) { float kv[8], dc[8];
#pragma unroll
            for (int j = 0; j < 8; ++j) { kv[j] = base[(size_t)(n0 + j) * 2048]; dc[j] = dec[(n0 + j) * 32]; }
#pragma unroll
            for (int j = 0; j < 8; ++j) { base[(size_t)(n0 + j) * 2048] = s; s = dc[j] * s + kv[j]; } }
    } else if (wg < 128) {
        const int w2 = wg - 64, bh = w2 >> 2, h = bh & 3, elem = (w2 & 3) * 512 + tid;
        float* base = (float*)(p.ws + WS_RKV) + (size_t)bh * 64 * 2048 + elem; const float dc = __builtin_amdgcn_exp2f(128.0f * p.ret_lg2[h]);
        float s = 0.f;
#pragma unroll 1
        for (int n0 = 0; n0 < 64; n0 += 8) { float kv[8];
#pragma unroll
            for (int j = 0; j < 8; ++j) kv[j] = base[(size_t)(n0 + j) * 2048];
#pragma unroll
            for (int j = 0; j < 8; ++j) { base[(size_t)(n0 + j) * 2048] = s; s = dc * s + kv[j]; } }
    }
}

__device__ __forceinline__ void kmean_unit(KPRef p, float* sm, int unit, int tid) {
    const bf16_t* z = (const bf16_t*)(p.ws + WS_Z); const size_t t0 = (size_t)unit * 256;
    const int c = tid & 255, part = tid >> 8; float s = 0.f;
#pragma unroll 8
    for (int i = part * 128; i < part * 128 + 128; ++i) s += bf2f(z[(t0 + i) * ZW + Z_MK + c]);
    sm[tid] = s; __syncthreads();
    if (tid < 256) ((float*)(p.ws + WS_KMEAN))[(size_t)unit * 256 + tid] = (sm[tid] + sm[tid + 256]) * (1.0f / 256.0f);
    __syncthreads();
}

constexpr int AT_KS = 0, AT_VT = 36864, AT_PW = 70656, AT_PW_WAVE = 8448, AT_WSF = 138240, AT_END = 138240 + 8 * 256;
#define MFMA16(a, b, c) __builtin_amdgcn_mfma_f32_16x16x32_bf16(a, b, c, 0, 0, 0)
template <class Fn>
__device__ __forceinline__ void attn256_unit(unsigned char* lds, const bf16_t* kg, const bf16_t* vg, int key_lo_valid, const Fn& F, int tid) {
    const int lane = tid & 63, wave = __builtin_amdgcn_readfirstlane(tid >> 6), c16 = lane & 15, g = lane >> 4;
    bf16_t* KS = (bf16_t*)(lds + AT_KS); bf16_t* VT = (bf16_t*)(lds + AT_VT); bf16_t* PW = (bf16_t*)(lds + AT_PW + wave * AT_PW_WAVE); float* WSF = (float*)(lds + AT_WSF + wave * 256);
#pragma unroll
    for (int i = 0; i < 4; ++i) { const int c = tid + 512 * i, key = c >> 3, oct = c & 7;
        u32x4 kq = (u32x4){0u, 0u, 0u, 0u}, vq = (u32x4){0u, 0u, 0u, 0u};
        if (key >= key_lo_valid) { kq = *(const u32x4*)(kg + (size_t)key * ZW + 8 * oct); vq = *(const u32x4*)(vg + (size_t)key * ZW + 8 * oct); }
        *(u32x4*)(KS + key * 72 + 8 * oct) = kq;
        bf16_t* vt = VT + (8 * oct) * 264 + key;
        vt[0 * 264] = (bf16_t)(vq.x & 0xffffu); vt[1 * 264] = (bf16_t)(vq.x >> 16); vt[2 * 264] = (bf16_t)(vq.y & 0xffffu); vt[3 * 264] = (bf16_t)(vq.y >> 16);
        vt[4 * 264] = (bf16_t)(vq.z & 0xffffu); vt[5 * 264] = (bf16_t)(vq.z >> 16); vt[6 * 264] = (bf16_t)(vq.w & 0xffffu); vt[7 * 264] = (bf16_t)(vq.w >> 16); }
    __syncthreads();
#pragma unroll 1
    for (int rt = 0; rt < 2; ++rt) {
        const int rbase = 32 * wave + 16 * rt;
        const bf16_t* qp = F.rowptr(rbase + c16);
        const bf16x8 qa0 = *(const bf16x8*)(qp + 8 * g), qa1 = *(const bf16x8*)(qp + 32 + 8 * g);
        f32x4 S[16];
#pragma unroll
        for (int ct = 0; ct < 16; ++ct) { const bf16_t* kp = KS + (16 * ct + c16) * 72 + 8 * g;
            const bf16x8 b0 = *(const bf16x8*)kp, b1 = *(const bf16x8*)(kp + 32);
            f32x4 acc = (f32x4){0.f, 0.f, 0.f, 0.f}; acc = MFMA16(qa0, b0, acc); acc = MFMA16(qa1, b1, acc); S[ct] = acc; }
        float m[4] = {-1e30f, -1e30f, -1e30f, -1e30f};
#pragma unroll
        for (int ct = 0; ct < 16; ++ct)
#pragma unroll
            for (int r = 0; r < 4; ++r) { const float s = F.mask(rbase + 4 * g + r, 16 * ct + c16) ? S[ct][r] : -1e30f; S[ct][r] = s; m[r] = fmaxf(m[r], s); }
#pragma unroll
        for (int r = 0; r < 4; ++r) {
#pragma unroll
            for (int o = 1; o < 16; o <<= 1) m[r] = fmaxf(m[r], __shfl_xor(m[r], o)); }
        float l[4] = {0.f, 0.f, 0.f, 0.f};
#pragma unroll
        for (int ct = 0; ct < 16; ++ct)
#pragma unroll
            for (int r = 0; r < 4; ++r) { const float pr = __builtin_amdgcn_exp2f(S[ct][r] - m[r]); l[r] += pr; PW[(4 * g + r) * 264 + 16 * ct + c16] = (bf16_t)f2bf(pr); }
#pragma unroll
        for (int r = 0; r < 4; ++r) {
#pragma unroll
            for (int o = 1; o < 16; o <<= 1) l[r] += __shfl_xor(l[r], o); }
        LDS_WAIT();
        f32x4 O[4];
#pragma unroll
        for (int dt = 0; dt < 4; ++dt) O[dt] = (f32x4){0.f, 0.f, 0.f, 0.f};
#pragma unroll
        for (int s8 = 0; s8 < 8; ++s8) { const bf16x8 a = *(const bf16x8*)(PW + c16 * 264 + 32 * s8 + 8 * g);
#pragma unroll
            for (int dt = 0; dt < 4; ++dt) { const bf16x8 bb = *(const bf16x8*)(VT + (16 * dt + c16) * 264 + 32 * s8 + 8 * g); O[dt] = MFMA16(a, bb, O[dt]); } }
        float f[4];
#pragma unroll
        for (int r = 0; r < 4; ++r) f[r] = F.scale(rbase + 4 * g + r, m[r], l[r], WSF + (4 * g + r) * 4, c16 == 0);
        LDS_WAIT();
#pragma unroll
        for (int dt = 0; dt < 4; ++dt)
#pragma unroll
            for (int r = 0; r < 4; ++r) PW[(4 * g + r) * 72 + 16 * dt + c16] = (bf16_t)f2bf(O[dt][r] * f[r]);
        LDS_WAIT();
#pragma unroll
        for (int i = 0; i < 2; ++i) { const int ch = lane + 64 * i, row = ch >> 3, oct = ch & 7;
            const u32x4 v = *(const u32x4*)(PW + row * 72 + 8 * oct); F.store(rbase + row, oct, v, WSF + row * 4); }
        LDS_WAIT();
    }
    __syncthreads();
}

struct SwaFn { const bf16_t* z; bf16_t* ob; size_t tb; int q0, kvh; float sink2_0, sink2_1;
    __device__ __forceinline__ const bf16_t* rowptr(int row) const { return z + (tb + q0 + (row & 127)) * ZW + Z_SQ + (kvh * 2 + (row >> 7)) * 64; }
    __device__ __forceinline__ bool mask(int row, int kk) const { const int d = (row & 127) + 128 - kk; return d >= 0 && d < 128 && (q0 - 128 + kk) >= 0; }
    __device__ __forceinline__ float scale(int row, float m, float l, float*, bool) const { const float sk = (row >> 7) ? sink2_1 : sink2_0; const float M = fmaxf(m, sk), w0 = __builtin_amdgcn_exp2f(m - M);
        return w0 / (l * w0 + __builtin_amdgcn_exp2f(sk - M)); }
    __device__ __forceinline__ void store(int row, int oct, u32x4 v, const float*) const { *(u32x4*)(ob + (tb + q0 + (row & 127)) * 1024 + 256 + (kvh * 2 + (row >> 7)) * 64 + 8 * oct) = v; }
};
__device__ __forceinline__ void swa_unit(KPRef p, int l, unsigned char* lds, int unit, int tid) {
    const int qb = unit & 63, kvh = (unit >> 6) & 1, b = unit >> 7;
    const bf16_t* z = (const bf16_t*)(p.ws + WS_Z); const size_t tb = (size_t)b * S_; const int q0 = qb * 128;
    SwaFn F{z, (bf16_t*)(p.ws + WS_O), tb, q0, kvh, p.in[6][l * 4 + kvh * 2] * LOG2E, p.in[6][l * 4 + kvh * 2 + 1] * LOG2E};
    const long kb = (long)tb + q0 - 128;
    attn256_unit(lds, z + kb * ZW + Z_SK + kvh * 64, z + kb * ZW + Z_SV + kvh * 64, q0 == 0 ? 128 : 0, F, tid);
}

constexpr int ML_PER_BH = 126976;
__device__ __forceinline__ int ml_off(int j) { return 256 * (31 * j - (j * (j - 1)) / 2); }
__device__ __forceinline__ void moba_select(KPRef p, int wg, int tid) {
    const int gid = wg * NTHREADS + tid, t = gid >> 2, h = gid & 3, b = t >> 13, tl = t & 8191, blk = tl >> 8;
    const bf16_t* z = (const bf16_t*)(p.ws + WS_Z);
    float q[64];
    { const bf16_t* qp = z + (size_t)t * ZW + Z_MQ + h * 64;
#pragma unroll
      for (int c = 0; c < 8; ++c) { const u32x4 kk = *(const u32x4*)(qp + 8 * c);
        q[8 * c + 0] = __uint_as_float(kk.x << 16); q[8 * c + 1] = __uint_as_float(kk.x & 0xffff0000u); q[8 * c + 2] = __uint_as_float(kk.y << 16); q[8 * c + 3] = __uint_as_float(kk.y & 0xffff0000u);
        q[8 * c + 4] = __uint_as_float(kk.z << 16); q[8 * c + 5] = __uint_as_float(kk.z & 0xffff0000u); q[8 * c + 6] = __uint_as_float(kk.w << 16); q[8 * c + 7] = __uint_as_float(kk.w & 0xffff0000u); } }
    const float* km = (const float*)(p.ws + WS_KMEAN) + (size_t)b * 32 * 256 + h * 64;
    float v0 = -3e38f, v1 = -3e38f, v2 = -3e38f; int i0 = -1, i1 = -1, i2 = -1;
#pragma unroll 1
    for (int nb = 0; nb < blk; ++nb) { const f32x4* kr = (const f32x4*)(km + nb * 256); float s = 0.f;
#pragma unroll
        for (int c = 0; c < 16; ++c) { const f32x4 kv = kr[c]; s += q[4 * c] * kv[0] + q[4 * c + 1] * kv[1] + q[4 * c + 2] * kv[2] + q[4 * c + 3] * kv[3]; }
        if (s > v0) { v2 = v1; i2 = i1; v1 = v0; i1 = i0; v0 = s; i0 = nb; } else if (s > v1) { v2 = v1; i2 = i1; v1 = s; i1 = nb; } else if (s > v2) { v2 = s; i2 = nb; } }
    int* cnt = (int*)(p.ws + WS_MCNT) + (b * 4 + h) * 32; int* lst = (int*)(p.ws + WS_MLIST) + (size_t)(b * 4 + h) * ML_PER_BH; f32x2* pml = (f32x2*)(p.ws + WS_PARTML) + (size_t)gid * 3;
#pragma unroll
    for (int s3 = 0; s3 < 3; ++s3) { const int sb = (s3 == 0) ? i0 : (s3 == 1 ? i1 : i2);
        if (sb >= 0) { const int pos = atomicAdd(cnt + sb, 1); lst[ml_off(sb) + pos] = tl | (s3 << 13); }
        else pml[s3] = (f32x2){-1e30f, 0.f}; }
}
struct MobaSelFn { const bf16_t* z; const int* lst; bf16_t* po; f32x2* pml; size_t tb; int h, n_valid;
    __device__ __forceinline__ int entry(int row) const { return lst[row < n_valid ? row : 0]; }
    __device__ __forceinline__ const bf16_t* rowptr(int row) const { return z + (tb + (entry(row) & 8191)) * ZW + Z_MQ + h * 64; }
    __device__ __forceinline__ bool mask(int, int) const { return true; }
    __device__ __forceinline__ size_t pidx(int e) const { return ((tb + (e & 8191)) * 4 + h) * 3 + (e >> 13); }
    __device__ __forceinline__ float scale(int row, float m, float l, float*, bool writer) const { if (writer && row < n_valid) pml[pidx(lst[row])] = (f32x2){m, l}; return 1.0f / l; }
    __device__ __forceinline__ void store(int row, int oct, u32x4 v, const float*) const { if (row < n_valid) *(u32x4*)(po + pidx(lst[row]) * 64 + 8 * oct) = v; }
};
__device__ __forceinline__ void moba_sel_unit(KPRef p, unsigned char* lds, int unit, int tid) {
    const int bh = unit / 496; int idx = unit % 496, j = 0; while (idx >= 31 - j) { idx -= 31 - j; ++j; }
    const int cnt = __builtin_amdgcn_readfirstlane(((const int*)(p.ws + WS_MCNT))[bh * 32 + j]);
    if (idx * 256 >= cnt) return;
    const int b = bh >> 2, h = bh & 3; const bf16_t* z = (const bf16_t*)(p.ws + WS_Z); const size_t tb = (size_t)b * S_;
    const int nv = cnt - idx * 256;
    MobaSelFn F{z, (const int*)(p.ws + WS_MLIST) + (size_t)bh * ML_PER_BH + ml_off(j) + idx * 256, (bf16_t*)(p.ws + WS_PARTO), (f32x2*)(p.ws + WS_PARTML), tb, h, nv < 256 ? nv : 256};
    attn256_unit(lds, z + (tb + j * 256) * ZW + Z_MK + h * 64, z + (tb + j * 256) * ZW + Z_MV + h * 64, 0, F, tid);
}
struct MobaOwnFn { const bf16_t* z; bf16_t* ob; const bf16_t* po; const f32x2* pml; size_t t0; int h;
    __device__ __forceinline__ const bf16_t* rowptr(int row) const { return z + (t0 + row) * ZW + Z_MQ + h * 64; }
    __device__ __forceinline__ bool mask(int row, int kk) const { return kk <= row; }
    __device__ __forceinline__ float scale(int row, float m, float l, float* wsf, bool writer) const {
        const f32x2* ml = pml + ((t0 + row) * 4 + h) * 3; const f32x2 a = ml[0], b = ml[1], c = ml[2];
        const float M = fmaxf(fmaxf(m, a[0]), fmaxf(b[0], c[0]));
        const float w0 = __builtin_amdgcn_exp2f(m - M), wa = a[1] * __builtin_amdgcn_exp2f(a[0] - M), wb = b[1] * __builtin_amdgcn_exp2f(b[0] - M), wc = c[1] * __builtin_amdgcn_exp2f(c[0] - M);
        const float inv = 1.0f / (l * w0 + wa + wb + wc);
        if (writer) { wsf[0] = wa * inv; wsf[1] = wb * inv; wsf[2] = wc * inv; }
        return w0 * inv; }
    __device__ __forceinline__ void store(int row, int oct, u32x4 v, const float* wsf) const {
        float o[8]; o[0] = __uint_as_float(v.x << 16); o[1] = __uint_as_float(v.x & 0xffff0000u); o[2] = __uint_as_float(v.y << 16); o[3] = __uint_as_float(v.y & 0xffff0000u);
        o[4] = __uint_as_float(v.z << 16); o[5] = __uint_as_float(v.z & 0xffff0000u); o[6] = __uint_as_float(v.w << 16); o[7] = __uint_as_float(v.w & 0xffff0000u);
        const bf16_t* pr = po + (((t0 + row) * 4 + h) * 3) * 64 + 8 * oct;
#pragma unroll
        for (int s = 0; s < 3; ++s) { const float w = wsf[s]; if (w != 0.f) { const u32x4 q = *(const u32x4*)(pr + s * 64);
            o[0] += w * __uint_as_float(q.x << 16); o[1] += w * __uint_as_float(q.x & 0xffff0000u); o[2] += w * __uint_as_float(q.y << 16); o[3] += w * __uint_as_float(q.y & 0xffff0000u);
            o[4] += w * __uint_as_float(q.z << 16); o[5] += w * __uint_as_float(q.z & 0xffff0000u); o[6] += w * __uint_as_float(q.w << 16); o[7] += w * __uint_as_float(q.w & 0xffff0000u); } }
        u32x4 w4; w4.x = pk2(o[0], o[1]); w4.y = pk2(o[2], o[3]); w4.z = pk2(o[4], o[5]); w4.w = pk2(o[6], o[7]);
        *(u32x4*)(ob + (t0 + row) * 1024 + 512 + h * 64 + 8 * oct) = w4; }
};
__device__ __forceinline__ void moba_own_unit(KPRef p, unsigned char* lds, int unit, int tid) {
    const int qb = unit & 31, h = (unit >> 5) & 3, b = unit >> 7;
    const bf16_t* z = (const bf16_t*)(p.ws + WS_Z); const size_t t0 = (size_t)b * S_ + (size_t)qb * 256;
    MobaOwnFn F{z, (bf16_t*)(p.ws + WS_O), (const bf16_t*)(p.ws + WS_PARTO), (const f32x2*)(p.ws + WS_PARTML), t0, h};
    attn256_unit(lds, z + t0 * ZW + Z_MK + h * 64, z + t0 * ZW + Z_MV + h * 64, 0, F, tid);
}

__device__ __forceinline__ void route_phase(KPRef p, int l, float* sm, int wg, int tid) {
    int* se = (int*)sm;
    int* toke = (int*)(p.ws + WS_TOKE); float* tokw = (float*)(p.ws + WS_TOKW); int* tokr = (int*)(p.ws + WS_TOKR); int* hist = (int*)(p.ws + WS_HIST); int* sdst = (int*)(p.ws + WS_SDST);
    if (tid < 128) { const int t = wg * 128 + tid; const float* lg = (const float*)(p.ws + WS_LOGIT) + (size_t)t * 64; const float* bg = p.in[12] + l * 4; const float* be = p.in[14] + l * 32;
        float g0 = lg[0] + bg[0], g1 = lg[1] + bg[1], g2 = lg[2] + bg[2], g3 = lg[3] + bg[3];
        int gs = 0; float gm = g0; if (g1 > gm) { gm = g1; gs = 1; } if (g2 > gm) { gm = g2; gs = 2; } if (g3 > gm) { gm = g3; gs = 3; }
        const float gw_ = 1.0f / (expf(g0 - gm) + expf(g1 - gm) + expf(g2 - gm) + expf(g3 - gm));
        float v0 = -3e38f, v1 = -3e38f; int i0 = 0, i1 = 0;
#pragma unroll
        for (int j = 0; j < 8; ++j) { const float s = lg[4 + 8 * gs + j] + be[8 * gs + j]; if (s > v0) { v1 = v0; i1 = i0; v0 = s; i0 = j; } else if (s > v1) { v1 = s; i1 = j; } }
        const float e1 = expf(v1 - v0), w0 = 1.0f / (1.0f + e1), w1 = e1 * w0;
        const int ea = 8 * gs + i0, eb = 8 * gs + i1;
        se[2 * tid] = ea; se[2 * tid + 1] = eb; toke[2 * t] = ea; toke[2 * t + 1] = eb; tokw[2 * t] = w0 * gw_; tokw[2 * t + 1] = w1 * gw_; }
    __syncthreads();
    if (tid < 256) { const int e = se[tid]; int r = 0;
#pragma unroll 4
        for (int a = 0; a < tid; ++a) r += (se[a] == e) ? 1 : 0; tokr[wg * 256 + tid] = r; }
    if (tid >= 256 && tid < 288) { const int e = tid - 256; int c = 0;
#pragma unroll 4
        for (int a = 0; a < 256; ++a) c += (se[a] == e) ? 1 : 0; hist[wg * 32 + e] = c; }
    for (int i = tid; i < NSLOTBLK; i += NTHREADS) sdst[wg * NSLOTBLK + i] = YS_TRASH_ROW;
    __syncthreads();
}
__device__ __forceinline__ void assign_phase(KPRef p, float* sm, int wg, int tid, int wave, int lane) {
    int* cnt = (int*)sm, *bas = cnt + 32, *pend = cnt + 64, *slot_of = cnt + 128;
    const int* hist = (const int*)(p.ws + WS_HIST); const int* toke = (const int*)(p.ws + WS_TOKE); const int* tokr = (const int*)(p.ws + WS_TOKR);
    int* sdst = (int*)(p.ws + WS_SDST); int* blke = (int*)(p.ws + WS_BLKE);
    if (tid < 32) { int c = 0, bb = 0;
#pragma unroll 8
        for (int w = 0; w < 256; ++w) { const int v = hist[w * 32 + tid]; c += v; if (w < wg) bb += v; } cnt[tid] = c; bas[tid] = bb; }
    __syncthreads();
    if (tid == 0) { int run = 0; for (int e = 0; e < 32; ++e) { const int pad = ((cnt[e] + 255) >> 8) << 8; bas[e] += run; run += pad; pend[e] = run; } }
    __syncthreads();
    if (wg == 0) { if (tid < NSLOTBLK) { int e = 0; for (int k = 0; k < 32; ++k) e += (pend[k] <= tid * 256) ? 1 : 0; blke[tid] = e > 31 ? 31 : e; } if (tid == 0) blke[511] = pend[31] >> 8; }
    if (tid < 256) { const int a = wg * 256 + tid; const int e = toke[a]; const int slot = bas[e] + tokr[a]; sdst[slot] = a; slot_of[tid] = slot; }
    __syncthreads();
    const bf16_t* u2 = (const bf16_t*)(p.ws + WS_U); bf16_t* xs = (bf16_t*)(p.ws + WS_XS);
    for (int a = wave; a < 256; a += NWAVES) { const u32x4* src = (const u32x4*)(u2 + (size_t)(wg * 128 + (a >> 1)) * 1024); u32x4* dst = (u32x4*)(xs + (size_t)slot_of[a] * 1024);
        dst[lane] = src[lane]; dst[lane + 64] = src[lane + 64]; }
    __syncthreads();
}

#ifndef MK_PER_PHASE
#define MK_PER_PHASE 0
#endif
constexpr int PH_PER_LAYER = 17, N_PHASES = DEPTH_ * PH_PER_LAYER + 1;
constexpr int CW_BAR = 1024;

__global__ void __launch_bounds__(NTHREADS, 2) mega(Params p_unused) {
    extern __shared__ __attribute__((aligned(16))) unsigned char lds[];
    const int tid0 = threadIdx.x;
    const int G = gridDim.x, wg = blockIdx.x, NGW = G * NWAVES;
#define PHASE_BEGIN() KPRef p = *KP(); unsigned char* ws = p.ws; (void)ws; int tid = threadIdx.x; asm volatile("" : "+v"(tid)); const int lane = tid & 63, wave = __builtin_amdgcn_readfirstlane(tid >> 6), gw = wg * NWAVES + wave; (void)lane; (void)gw
    volatile LAS unsigned* MISC = (volatile LAS unsigned*)((LAS unsigned char*)lds + MISC_OFF);
    for (int u = tid0; u < (LDS_BYTES - LDSCTL_OFF) / 4; u += NTHREADS) ((LAS unsigned*)((LAS unsigned char*)lds + LDSCTL_OFF))[u] = 0u;
    __syncthreads();
#define KP() ({ const __attribute__((address_space(4))) Params* _k = (const __attribute__((address_space(4))) Params*)__builtin_amdgcn_kernarg_segment_ptr(); asm volatile("" : "+s"(_k)); _k; })
    unsigned* ctl; { const __attribute__((address_space(4))) Params* k0 = KP(); ctl = (unsigned*)(k0->ws + WS_CTL); }
    XcdBarrier bar = xcd_barrier_post(ctl + CW_BAR, MISC + 8);
    int lo, hi; { const __attribute__((address_space(4))) Params* k0 = KP(); lo = k0->ph_lo; hi = k0->ph_hi; }
    float* sm = (float*)lds;
    PG8_LAS unsigned char* ring = (PG8_LAS unsigned char*)lds;
#ifndef PH_MASK
#define PH_MASK 0x3ffffu
#endif
#define IN(k) ((((PH_MASK) >> ((k) == DEPTH_ * PH_PER_LAYER ? 17 : ((k) % PH_PER_LAYER))) & 1u) && lo <= (k) && (k) < hi)
#define SEAM(k) do { if ((k) + 1 < hi) xcd_barrier(bar); } while (0)

    for (int l = 0; l < DEPTH_; ++l) {
        const int P0 = l * PH_PER_LAYER;
        if (IN(P0 + 0)) { PHASE_BEGIN();
            conv_phase(p, l, lds, gw, NGW, wave, lane);
            if (l == 0) norm_phase<0>(p, l, gw, NGW, lane); else norm_phase<1>(p, l, gw, NGW, lane);
            SEAM(P0 + 0);
        }
        if (IN(P0 + 1)) { PHASE_BEGIN();
            pg8::Gemm g{(const bf16_t*)(ws + WS_U), (const bf16_t*)(ws + WS_WIN), 1024, 1024, 1024};
            pg8::StaticOrder S; S.init(T_, ZW, G, wg, 1024, 1024);
            pg8::EpiBf16 E{(bf16_t*)(ws + WS_Z), ZW, 0};
            pg8::gemm_phase(ring, g, S, E);
            SEAM(P0 + 1);
        }
        if (IN(P0 + 2)) { PHASE_BEGIN();
            if (wg == 0) { int* cnt = (int*)(ws + WS_MCNT); cnt[tid] = 0; }
            for (int u = wg; u < 2048; u += G) gla_kv_unit(p, l, sm, u, tid);
            for (int u = wg; u < 1024; u += G) ret_kv_unit(p, sm, u, tid);
            for (int u = wg; u < 128; u += G) kmean_unit(p, sm, u, tid);
            for (int u = wg; u < 512; u += G) swa_unit(p, l, lds, u, tid);
            SEAM(P0 + 2);
        }
        if (IN(P0 + 3)) { PHASE_BEGIN(); moba_select(p, wg, tid); scan_phase(p, wg, tid); SEAM(P0 + 3); }
        if (IN(P0 + 4)) { PHASE_BEGIN();
            for (int u = wg; u < 2048; u += G) gla_out_unit(p, l, sm, u, tid);
            for (int u = wg; u < 2048; u += G) ret_out_unit(p, l, sm, u, tid);
            for (int u = wg; u < 16 * 496; u += G) moba_sel_unit(p, lds, u, tid);
            SEAM(P0 + 4);
        }
        if (IN(P0 + 5)) { PHASE_BEGIN();
            for (int u = wg; u < 512; u += G) moba_own_unit(p, lds, u, tid);
            SEAM(P0 + 5);
        }
        for (int hf = 0; hf < 2; ++hf) {
            if (IN(P0 + 6 + 2 * hf)) { PHASE_BEGIN();
                pg8::Gemm g{(const bf16_t*)(ws + WS_O), (const bf16_t*)(ws + WS_WB), 1024, 256, 256};
                pg8::StaticOrder S; S.init(T_ / 2, 4096, G, wg, 1024, 256, 64 * hf, 2, 512);
                pg8::EpiBf16 E{(bf16_t*)(ws + WS_YH), 4096, 16384 * hf};
                pg8::gemm_phase(ring, g, S, E);
                SEAM(P0 + 6 + 2 * hf);
            }
            if (IN(P0 + 7 + 2 * hf)) { PHASE_BEGIN();
                pg8::Gemm g{(const bf16_t*)(ws + WS_U), (const bf16_t*)(ws + WS_WG), 1024, 1024, 1024};
                pg8::StaticOrder S; S.init(T_ / 2, 4096, G, wg, 1024, 1024, 64 * hf);
                pg8::EpiGate E{(const bf16_t*)(ws + WS_YH), 16384 * hf, (bf16_t*)(ws + WS_O)};
                pg8::gemm_phase(ring, g, S, E);
                SEAM(P0 + 7 + 2 * hf);
            }
        }
        if (IN(P0 + 10)) { PHASE_BEGIN();
            pg8::Gemm g{(const bf16_t*)(ws + WS_O), (const bf16_t*)(ws + WS_WO), 1024, 1024, 1024};
            pg8::StaticOrder S; S.init(T_, 1024, G, wg, 1024, 1024);
            pg8::EpiRes E{l == 0 ? p.in[0] : p.out, p.out, 1024};
            pg8::gemm_phase(ring, g, S, E);
            SEAM(P0 + 10);
        }
        if (IN(P0 + 11)) { PHASE_BEGIN(); norm_phase<2>(p, l, gw, NGW, lane); SEAM(P0 + 11); }
        if (IN(P0 + 12)) { PHASE_BEGIN();
            pg8::Gemm g{(const bf16_t*)(ws + WS_U), (const bf16_t*)(ws + WS_WR), 1024, 1024, 1024};
            pg8::StaticOrder S; S.init(T_, 256, G, wg, 1024, 1024);
            pg8::EpiRouter E{(float*)(ws + WS_LOGIT)};
            pg8::gemm_phase(ring, g, S, E);
            SEAM(P0 + 12);
        }
        if (IN(P0 + 13)) { PHASE_BEGIN(); route_phase(p, l, sm, wg, tid); SEAM(P0 + 13); }
        if (IN(P0 + 14)) { PHASE_BEGIN(); assign_phase(p, sm, wg, tid, wave, lane); SEAM(P0 + 14); }
        if (IN(P0 + 15)) { PHASE_BEGIN();
            const int* blke = (const int*)(ws + WS_BLKE); const int nb = __builtin_amdgcn_readfirstlane(blke[511]);
            pg8::Gemm g{(const bf16_t*)(ws + WS_XS), (const bf16_t*)(ws + WS_E1), 1024, 1024, 1024};
            pg8::MoeOrder<2> S{blke, nb, G, wg, (size_t)256 * 1024 * 2, (size_t)256 * 1024 * 2, (size_t)512 * 1024 * 2};
            pg8::EpiE1 E{(bf16_t*)(ws + WS_HDN)};
            pg8::gemm_phase(ring, g, S, E);
            SEAM(P0 + 15);
        }
        if (IN(P0 + 16)) { PHASE_BEGIN();
            const int* blke = (const int*)(ws + WS_BLKE); const int nb = __builtin_amdgcn_readfirstlane(blke[511]);
            pg8::Gemm g{(const bf16_t*)(ws + WS_HDN), (const bf16_t*)(ws + WS_E2), 256, 256, 256};
            pg8::MoeOrder<4> S{blke, nb, G, wg, (size_t)256 * 256 * 2, (size_t)256 * 256 * 2, (size_t)1024 * 256 * 2};
            pg8::EpiE2 E{(bf16_t*)(ws + WS_YS), (const int*)(ws + WS_SDST)};
            pg8::gemm_phase(ring, g, S, E);
            SEAM(P0 + 16);
        }
    }
    if (IN(DEPTH_ * PH_PER_LAYER)) { PHASE_BEGIN(); norm_phase<3>(p, 0, gw, NGW, lane); }
#undef IN
#undef SEAM
}

extern "C" void kernel_launch(void* const* d_in, const int* in_sizes, int n_in, void* d_out, int out_size, void* d_ws, size_t ws_size, hipStream_t stream) {
    static int grid = 0;
    if (grid == 0) {
        if (n_in != 19 || out_size != T_ * D_ || ws_size < WS_END) { fprintf(stderr, "kernel_launch: unexpected shapes (n_in %d, out %d, ws %zu); nothing launched\n", n_in, out_size, ws_size); grid = -1; return; }
        int dev = 0, cus = 0;
        if (hipGetDevice(&dev) != hipSuccess || hipDeviceGetAttribute(&cus, hipDeviceAttributeMultiprocessorCount, dev) != hipSuccess) { grid = -1; return; }
        if (hipFuncSetAttribute((const void*)mega, hipFuncAttributeMaxDynamicSharedMemorySize, LDS_BYTES) != hipSuccess) { fprintf(stderr, "kernel_launch: hipFuncSetAttribute failed\n"); grid = -1; return; }
        int per_cu = 0;
        if (hipOccupancyMaxActiveBlocksPerMultiprocessor(&per_cu, (const void*)mega, NTHREADS, LDS_BYTES) != hipSuccess || per_cu < 1) { fprintf(stderr, "kernel_launch: occupancy query reports %d blocks per CU\n", per_cu); }
        (void)hipGetLastError();
        grid = cus;
    }
    if (grid <= 0) return;
    Params p{};
    for (int i = 0; i < 19; ++i) p.in[i] = (const float*)d_in[i];
    p.out = (float*)d_out; p.ws = (unsigned char*)d_ws;
    for (int f = 0; f < 16; ++f) p.inv_freq[f] = (float)std::pow(10000.0, -(double)f / 16.0);
    for (int h = 0; h < 4; ++h) p.ret_lg2[h] = (float)std::log2(1.0 - std::exp2(-5.0 - (double)h));
    hipMemsetAsync((unsigned char*)d_ws + WS_CTL, 0, CTL_BYTES, stream);
#if MK_PER_PHASE
    for (int ph = 0; ph < N_PHASES; ++ph) { p.ph_lo = ph; p.ph_hi = ph + 1; hipLaunchKernelGGL(mega, dim3(grid), dim3(NTHREADS), LDS_BYTES, stream, p); }
#else
    p.ph_lo = 0; p.ph_hi = N_PHASES;
    hipLaunchKernelGGL(mega, dim3(grid), dim3(NTHREADS), LDS_BYTES, stream, p);
#endif
}
```

```cpp
#include <hip/hip_runtime.h>
#include <cstdio>
#include <cstdint>
#include <cmath>

#define LAS __attribute__((address_space(3)))
#define GAS __attribute__((address_space(1)))
typedef unsigned short bf16_t;
typedef short bf16x8 __attribute__((ext_vector_type(8)));
typedef float f32x4 __attribute__((ext_vector_type(4)));
typedef float f32x2 __attribute__((ext_vector_type(2)));
typedef unsigned u32x4 __attribute__((ext_vector_type(4)));
typedef unsigned u32x2 __attribute__((ext_vector_type(2)));

constexpr int T_ = 32768, D_ = 1024, S_ = 8192, NBATCH = 4, DEPTH_ = 2;
constexpr int ZW = 3072;
constexpr int Z_GQ = 0, Z_GK = 128, Z_GV = 256, Z_GR = 512, Z_GA = 768, Z_SQ = 784, Z_SK = 1040, Z_SV = 1168, Z_MQ = 1296, Z_MK = 1552, Z_MV = 1808,
              Z_RQ = 2064, Z_RK = 2192, Z_RV = 2320, Z_RG = 2576, Z_GATE = 2832, IN_W = 6928;
constexpr float LOG2E = 1.4426950408889634f;
constexpr float C2 = 0.125f * 1.4426950408889634f;
constexpr float RSQ32 = 0.17677669529663687f;
constexpr float NORM_EPS = 1e-6f;
constexpr int NEXP = 32, EHID = 256, MOE_BLK = 256, NSLOTBLK = 288, NSLOT = NSLOTBLK * MOE_BLK;

constexpr size_t MiB = 1u << 20;
constexpr size_t WS_WIN = 0, WS_WG = 6 * MiB, WS_WB = 14 * MiB, WS_WO = 16 * MiB, WS_WR = 18 * MiB, WS_E1 = 19 * MiB, WS_E2 = 51 * MiB;
constexpr size_t WS_YS = 68 * MiB;
constexpr size_t WS_GKV = 68 * MiB, WS_RKV = 84 * MiB, WS_GDEC = 92 * MiB, WS_KMEAN = 93 * MiB, WS_O = 108 * MiB;
constexpr size_t WS_U = 197 * MiB;
constexpr size_t WS_Z = 261 * MiB;
constexpr size_t WS_YH = 261 * MiB;
constexpr size_t WS_XS = 261 * MiB, WS_HDN = 405 * MiB;
constexpr size_t WS_LOGIT = 453 * MiB;
constexpr size_t WS_TOKE = 461 * MiB, WS_TOKW = WS_TOKE + 256 * 1024, WS_TOKR = WS_TOKW + 256 * 1024, WS_HIST = WS_TOKR + 256 * 1024,
                 WS_SDST = WS_HIST + 64 * 1024, WS_BLKE = WS_SDST + 512 * 1024;
constexpr size_t WS_MLIST = 94 * MiB, WS_MCNT = 102 * MiB;
constexpr size_t WS_PARTO = 453 * MiB, WS_PARTML = 501 * MiB;
constexpr size_t WS_CTL = 511 * MiB, CTL_BYTES = 64 * 1024;
constexpr size_t WS_END = 512 * MiB;
constexpr int YS_TRASH_ROW = 2 * T_;

__device__ __forceinline__ float bf2f(bf16_t v) { return __uint_as_float(((unsigned)v) << 16); }
__device__ __forceinline__ unsigned f2bf(float f) { unsigned u = __float_as_uint(f); return (u + 0x7fffu + ((u >> 16) & 1u)) >> 16; }
__device__ __forceinline__ unsigned pk2(float lo, float hi) { return f2bf(lo) | (f2bf(hi) << 16); }
__device__ __forceinline__ float sigmoidf_(float x) { return __builtin_amdgcn_rcpf(1.0f + __builtin_amdgcn_exp2f(-x * LOG2E)); }

namespace pg8 {
#define PG8_LAS __attribute__((address_space(3)))
constexpr int BM = 256, BK = 64, HALF = 128, HTB = HALF * BK * 2  , STAGE_BYTES = 8 * HTB, NXCD = 8, WGM = 8;

__host__ __device__ __forceinline__ int lds_byte(int r, int c) { const int st = (r >> 4) * 2 + (c >> 5), rr = r & 15, cc = c & 31, ob = rr * 64 + cc * 2; return st * 1024 + (ob ^ (((ob >> 9) & 1) << 5)); }
__host__ __device__ __forceinline__ void stage_rc(int b, int& R, int& C) { const int st = b / 1024, sb = b % 1024, swz = sb ^ (((sb >> 9) & 1) << 5); R = (st >> 1) * 16 + swz / 64; C = (st & 1) * 32 + (swz % 64) / 2; }
__host__ __device__ __forceinline__ int perm32(int rho) { const int n = rho >> 4, i = rho & 15; return 8 * (i >> 2) + 4 * n + (i & 3); }

struct Unit { int pm, pn; size_t aoff, boff; };
struct Gemm { const bf16_t* A; const bf16_t* Bt; int lda, ldb, K; };

struct StaticOrder {
    int nM, nN, nwg, G, c, pm_base, a_shift; size_t a_mul, a_tstep, b_tstep;
    __device__ void init(int M, int N, int G_, int c_, int lda, int ldb, int pm_base_ = 0, int a_shift_ = 30, size_t a_mul_ = 0) {
        nM = M / BM; nN = N / BM; nwg = nM * nN; G = G_; c = c_; pm_base = pm_base_; a_shift = a_shift_; a_mul = a_mul_; a_tstep = (size_t)BM * lda * 2; b_tstep = (size_t)BM * ldb * 2; }
    __device__ bool next(int i, Unit& u) const {
        const long L = (long)i * G + c; if (L >= nwg) return false;
        int wgid = (int)L; { const int q = nwg / NXCD, r = nwg % NXCD, xcd = wgid % NXCD, off = wgid / NXCD; wgid = (xcd < r ? xcd * (q + 1) : r * (q + 1) + (xcd - r) * q) + off; }
        const int nig = WGM * nN, gid = wgid / nig, fm = gid * WGM, gsz = (nM - fm) < WGM ? (nM - fm) : WGM;
        u.pm = pm_base + fm + ((wgid % nig) % gsz); u.pn = (wgid % nig) / gsz;
        u.aoff = (size_t)u.pm * a_tstep + (size_t)(u.pn >> a_shift) * a_mul; u.boff = (size_t)u.pn * b_tstep; return true;
    }
};
template <int NCOL> struct MoeOrder {
    const int* blk_e; int nb, G, c; size_t a_tstep, b_tstep, b_estep;
    __device__ bool next(int i, Unit& u) const {
        const int L = i * G + c; if (L >= nb * NCOL) return false;
        const int rb = L / NCOL, pn = L % NCOL; const int e = __builtin_amdgcn_readfirstlane(blk_e[rb]);
        u.pm = rb; u.pn = pn; u.aoff = (size_t)rb * a_tstep; u.boff = (size_t)e * b_estep + (size_t)pn * b_tstep; return true;
    }
};

__device__ __forceinline__ unsigned cvt_pk_bf16(float lo, float hi) { unsigned r; asm volatile("v_cvt_pk_bf16_f32 %0, %1, %2" : "=v"(r) : "v"(lo), "v"(hi)); return r; }

struct EpiBf16 {
    static constexpr bool PERM = true;
    bf16_t* O; int ldc; int row_sub;
    __device__ __forceinline__ void operator()(const f32x4 (&acc)[2][2][4][2], const Unit& u, int wr, int wc, int fr, int fq) const {
        const int row0 = u.pm * BM + wr * 64 + fr - row_sub; const int col0 = u.pn * BM + wc * 32 + 8 * fq;
#pragma unroll
        for (int ai = 0; ai < 2; ++ai)
#pragma unroll
            for (int m = 0; m < 4; ++m) { bf16_t* rowp = O + (size_t)(row0 + ai * HALF + m * 16) * ldc + col0;
#pragma unroll
                for (int bj = 0; bj < 2; ++bj) { const f32x4 v0 = acc[ai][bj][m][0], v1 = acc[ai][bj][m][1];
                    u32x4 w; w.x = cvt_pk_bf16(v0[0], v0[1]); w.y = cvt_pk_bf16(v0[2], v0[3]); w.z = cvt_pk_bf16(v1[0], v1[1]); w.w = cvt_pk_bf16(v1[2], v1[3]);
                    *(u32x4*)(rowp + bj * HALF) = w; } }
    }
};
struct EpiRes {
    static constexpr bool PERM = false;
    const float* base; float* C; int ldc;
    __device__ __forceinline__ void operator()(const f32x4 (&acc)[2][2][4][2], const Unit& u, int wr, int wc, int fr, int fq) const {
        const int row0 = u.pm * BM + wr * 64 + fr, col0 = u.pn * BM + wc * 32 + 4 * fq;
#pragma unroll
        for (int ai = 0; ai < 2; ++ai)
#pragma unroll
            for (int m = 0; m < 4; ++m) { const size_t off = (size_t)(row0 + ai * HALF + m * 16) * ldc + col0;
#pragma unroll
                for (int bj = 0; bj < 2; ++bj)
#pragma unroll
                    for (int n = 0; n < 2; ++n) { const f32x4 b = *(const f32x4*)(base + off + bj * HALF + n * 16); *(f32x4*)(C + off + bj * HALF + n * 16) = b + acc[ai][bj][m][n]; }
                asm volatile("" ::: "memory"); }
    }
};
struct EpiRouter {
    static constexpr bool PERM = false;
    float* L;
    __device__ __forceinline__ void operator()(const f32x4 (&acc)[2][2][4][2], const Unit& u, int wr, int wc, int fr, int fq) const {
        if (wc >= 2) return;
        const int row0 = u.pm * BM + wr * 64 + fr, col0 = wc * 32 + 4 * fq;
#pragma unroll
        for (int ai = 0; ai < 2; ++ai)
#pragma unroll
            for (int m = 0; m < 4; ++m) { float* rowp = L + (size_t)(row0 + ai * HALF + m * 16) * 64 + col0;
#pragma unroll
                for (int n = 0; n < 2; ++n) *(f32x4*)(rowp + n * 16) = acc[ai][0][m][n]; }
    }
};
struct EpiGate {
    static constexpr bool PERM = false;
    const bf16_t* Y; int y_row_sub; bf16_t* Mg;
    __device__ __forceinline__ void operator()(const f32x4 (&acc)[2][2][4][2], const Unit& u, int wr, int wc, int fr, int fq) const {
        const int row0 = u.pm * BM + wr * 64 + fr, d0 = u.pn * 64 + wc * 16 + fq * 4;
#pragma unroll
        for (int ai = 0; ai < 2; ++ai)
#pragma unroll
            for (int m = 0; m < 4; ++m) { const int r = row0 + ai * HALF + m * 16; const bf16_t* yrow = Y + (size_t)(r - y_row_sub) * 4096 + d0;
                f32x4 s = (f32x4){0.f, 0.f, 0.f, 0.f};
#pragma unroll
                for (int i = 0; i < 4; ++i) { const u32x2 yv = *(const u32x2*)(yrow + 1024 * i); const f32x4 g = acc[ai][i >> 1][m][i & 1];
                    s[0] += sigmoidf_(g[0]) * __uint_as_float(yv.x << 16); s[1] += sigmoidf_(g[1]) * __uint_as_float(yv.x & 0xffff0000u);
                    s[2] += sigmoidf_(g[2]) * __uint_as_float(yv.y << 16); s[3] += sigmoidf_(g[3]) * __uint_as_float(yv.y & 0xffff0000u); }
                u32x2 w; w.x = cvt_pk_bf16(s[0], s[1]); w.y = cvt_pk_bf16(s[2], s[3]);
                *(u32x2*)(Mg + (size_t)r * 1024 + d0) = w;
                asm volatile("" ::: "memory"); }
    }
};
struct EpiE1 {
    static constexpr bool PERM = true;
    bf16_t* H;
    __device__ __forceinline__ void operator()(const f32x4 (&acc)[2][2][4][2], const Unit& u, int wr, int wc, int fr, int fq) const {
        const int row0 = u.pm * BM + wr * 64 + fr, col0 = u.pn * 128 + wc * 32 + 8 * fq;
#pragma unroll
        for (int ai = 0; ai < 2; ++ai)
#pragma unroll
            for (int m = 0; m < 4; ++m) { bf16_t* rowp = H + (size_t)(row0 + ai * HALF + m * 16) * EHID + col0;
                const f32x4 a0 = acc[ai][0][m][0], a1 = acc[ai][0][m][1], b0 = acc[ai][1][m][0], b1 = acc[ai][1][m][1];
                f32x4 v0, v1;
#pragma unroll
                for (int j = 0; j < 4; ++j) { v0[j] = a0[j] * sigmoidf_(a0[j]) * b0[j]; v1[j] = a1[j] * sigmoidf_(a1[j]) * b1[j]; }
                u32x4 w; w.x = cvt_pk_bf16(v0[0], v0[1]); w.y = cvt_pk_bf16(v0[2], v0[3]); w.z = cvt_pk_bf16(v1[0], v1[1]); w.w = cvt_pk_bf16(v1[2], v1[3]);
                *(u32x4*)rowp = w; }
    }
};
struct EpiE2 {
    static constexpr bool PERM = true;
    bf16_t* YS; const int* sdst;
    __device__ __forceinline__ void operator()(const f32x4 (&acc)[2][2][4][2], const Unit& u, int wr, int wc, int fr, int fq) const {
        const int row0 = u.pm * BM + wr * 64 + fr, col0 = u.pn * BM + wc * 32 + 8 * fq;
#pragma unroll
        for (int ai = 0; ai < 2; ++ai)
#pragma unroll
            for (int m = 0; m < 4; ++m) { const int dst = sdst[row0 + ai * HALF + m * 16];
                bf16_t* rowp = YS + (size_t)dst * 1024 + col0;
#pragma unroll
                for (int bj = 0; bj < 2; ++bj) { const f32x4 v0 = acc[ai][bj][m][0], v1 = acc[ai][bj][m][1];
                    u32x4 w; w.x = cvt_pk_bf16(v0[0], v0[1]); w.y = cvt_pk_bf16(v0[2], v0[3]); w.z = cvt_pk_bf16(v1[0], v1[1]); w.w = cvt_pk_bf16(v1[2], v1[3]);
                    *(u32x4*)(rowp + bj * HALF) = w; }
                asm volatile("" ::: "memory"); }
    }
};

template <class Epi, class Sched>
__device__ __forceinline__ void gemm_phase(PG8_LAS unsigned char* lds, const Gemm g, const Sched& S, const Epi& E) {
    int tid = threadIdx.x; asm volatile("" : "+v"(tid));
    const int wid = __builtin_amdgcn_readfirstlane(tid >> 6), lane = tid & 63, wr = wid >> 2, wc = wid & 3, fr = lane & 15, fq = lane >> 4;
    const int K = g.K, nt = K / BK;
    unsigned voffA[2], voffB[2];
#pragma unroll
    for (int i = 0; i < 2; ++i) { int R, C; stage_rc(tid * 16 + i * 8192, R, C); const int Rb = Epi::PERM ? ((R & ~31) + perm32(R & 31)) : R;
        voffA[i] = (unsigned)(R * g.lda + C) * 2u; voffB[i] = (unsigned)(Rb * g.ldb + C) * 2u; }
    const size_t kstep = (size_t)(BK * 2);
    const size_t hstepA = (size_t)HALF * g.lda * 2, hstepB = (size_t)HALF * g.ldb * 2;
    const unsigned ldsw = (unsigned)wid * 1024u;
    const int aoff = lds_byte(wr * 64 + fr, fq * 8), boff = lds_byte(wc * 32 + fr, fq * 8);
#define PG8_SA(b, h) (((b) * 2 + (h)) * HTB)
#define PG8_SB(b, h) ((4 + (b) * 2 + (h)) * HTB)
#define PG8_STAGE(bufoff, gbase, voff) do { _Pragma("unroll") for (int _i = 0; _i < 2; ++_i) \
        __builtin_amdgcn_global_load_lds((const unsigned*)((const char*)(gbase) + (voff)[_i]), (PG8_LAS unsigned*)(lds + (bufoff) + ldsw + _i * 8192), 16, 0, 0); } while (0)
#define PG8_LDA(dst, b, h) do { _Pragma("unroll") for (int m = 0; m < 4; ++m) _Pragma("unroll") for (int k = 0; k < 2; ++k) dst[m][k] = *(const PG8_LAS bf16x8*)(lds + PG8_SA(b, h) + aoff + m * 2048 + k * 1024); } while (0)
#define PG8_LDB(dst, b, h) do { _Pragma("unroll") for (int n = 0; n < 2; ++n) _Pragma("unroll") for (int k = 0; k < 2; ++k) dst[n][k] = *(const PG8_LAS bf16x8*)(lds + PG8_SB(b, h) + boff + n * 2048 + k * 1024); } while (0)
#define PG8_MMA(ai, bj, At, Bt) do { __builtin_amdgcn_s_setprio(1); _Pragma("unroll") for (int m = 0; m < 4; ++m) _Pragma("unroll") for (int n = 0; n < 2; ++n) _Pragma("unroll") for (int k = 0; k < 2; ++k) \
        acc[ai][bj][m][n] = __builtin_amdgcn_mfma_f32_16x16x32_bf16(Bt[n][k], At[m][k], acc[ai][bj][m][n], 0, 0, 0); __builtin_amdgcn_s_setprio(0); } while (0)
#define PG8_WAIT_V(n) asm volatile("s_waitcnt vmcnt(" #n ")" ::: "memory")
#define PG8_WAIT_L(n) asm volatile("s_waitcnt lgkmcnt(" #n ")" ::: "memory")
#define PG8_BAR __builtin_amdgcn_s_barrier()
#define PG8_SCHED __builtin_amdgcn_sched_barrier(0)
    Unit cur, nxt; int ui = 0;
    if (!S.next(0, cur)) return;
    f32x4 acc[2][2][4][2];
#pragma unroll
    for (int a = 0; a < 2; ++a)
#pragma unroll
        for (int b = 0; b < 2; ++b)
#pragma unroll
            for (int m = 0; m < 4; ++m)
#pragma unroll
                for (int n = 0; n < 2; ++n) acc[a][b][m][n] = (f32x4){0.f, 0.f, 0.f, 0.f};
    bf16x8 At[4][2], B0[2][2], B1[2][2];
    const char* cA = (const char*)g.A + cur.aoff; const char* cB = (const char*)g.Bt + cur.boff;
    PG8_STAGE(PG8_SB(0, 0), cB, voffB); PG8_STAGE(PG8_SA(0, 0), cA, voffA); PG8_STAGE(PG8_SB(0, 1), cB + hstepB, voffB); PG8_STAGE(PG8_SA(0, 1), cA + hstepA, voffA);
    if (wr == 1) PG8_BAR;
    PG8_WAIT_V(4); PG8_BAR;
    PG8_STAGE(PG8_SB(1, 0), cB + kstep, voffB); PG8_STAGE(PG8_SA(1, 0), cA + kstep, voffA); PG8_STAGE(PG8_SB(1, 1), cB + hstepB + kstep, voffB);
    PG8_WAIT_V(6); PG8_BAR;
    for (;;) {
        const bool has_next = S.next(ui + 1, nxt);
        const char* nA = has_next ? (const char*)g.A + nxt.aoff : cA; const char* nB = has_next ? (const char*)g.Bt + nxt.boff : cB;
        for (int t = 0; t < nt; t += 2) {
            const bool last = (t == nt - 2);
            const char* a1 = cA + (size_t)(t + 1) * kstep;
            const char* a2 = last ? nA : cA + (size_t)(t + 2) * kstep; const char* b2 = last ? nB : cB + (size_t)(t + 2) * kstep;
            const char* a3 = a2 + kstep; const char* b3 = b2 + kstep;
            PG8_LDB(B0, 0, 0); PG8_SCHED; PG8_LDA(At, 0, 0); PG8_STAGE(PG8_SA(1, 1), a1 + hstepA, voffA);
            PG8_WAIT_L(8); PG8_BAR; PG8_WAIT_L(0); PG8_MMA(0, 0, At, B0); PG8_BAR; PG8_SCHED;
            PG8_LDB(B1, 0, 1); PG8_STAGE(PG8_SB(0, 0), b2, voffB);
            PG8_BAR; PG8_WAIT_L(0); PG8_MMA(0, 1, At, B1); PG8_BAR;
            PG8_LDA(At, 0, 1); PG8_STAGE(PG8_SA(0, 0), a2, voffA);
            PG8_BAR; PG8_WAIT_L(0); PG8_MMA(1, 0, At, B0); PG8_BAR; PG8_SCHED;
            PG8_STAGE(PG8_SB(0, 1), b2 + hstepB, voffB);
            PG8_WAIT_V(6); PG8_BAR; PG8_MMA(1, 1, At, B1); PG8_BAR;
            PG8_LDB(B0, 1, 0); PG8_SCHED; PG8_LDA(At, 1, 0); PG8_STAGE(PG8_SA(0, 1), a2 + hstepA, voffA);
            PG8_WAIT_L(8); PG8_BAR; PG8_WAIT_L(0); PG8_MMA(0, 0, At, B0); PG8_BAR; PG8_SCHED;
            PG8_LDB(B1, 1, 1); PG8_STAGE(PG8_SB(1, 0), b3, voffB);
            PG8_BAR; PG8_WAIT_L(0); PG8_MMA(0, 1, At, B1); PG8_BAR;
            PG8_LDA(At, 1, 1); PG8_STAGE(PG8_SA(1, 0), a3, voffA);
            PG8_BAR; PG8_WAIT_L(0); PG8_MMA(1, 0, At, B0); PG8_BAR; PG8_SCHED;
            PG8_STAGE(PG8_SB(1, 1), b3 + hstepB, voffB);
            PG8_WAIT_V(6); PG8_BAR; PG8_MMA(1, 1, At, B1); PG8_BAR;
        }
        E(acc, cur, wr, wc, fr, fq);
        if (!has_next) break;
#pragma unroll
        for (int a = 0; a < 2; ++a)
#pragma unroll
            for (int b = 0; b < 2; ++b)
#pragma unroll
                for (int m = 0; m < 4; ++m)
#pragma unroll
                    for (int n = 0; n < 2; ++n) acc[a][b][m][n] = (f32x4){0.f, 0.f, 0.f, 0.f};
        cur = nxt; cA = nA; cB = nB; ++ui;
    }
    PG8_WAIT_V(0);
    if (wr == 0) PG8_BAR;
    PG8_BAR;
#undef PG8_SA
#undef PG8_SB
#undef PG8_STAGE
#undef PG8_LDA
#undef PG8_LDB
#undef PG8_MMA
#undef PG8_WAIT_V
#undef PG8_WAIT_L
#undef PG8_BAR
#undef PG8_SCHED
}
}

#define XB_TMO      128
#define XB_XCNT(j)  (256  + 64 * (j))
#define XB_XSUB(j)  (1280 + 64 * (j))
#define XB_XGEN(j)  (2304 + 64 * (j))
#define XB_TOP      3328
#define XB_TOPGEN   3392
#define XCD_BAR_WORDS 3456
#define XB_SPIN_CAP (1u << 21)

__device__ __forceinline__ unsigned xb_ld(unsigned* p)              { return __hip_atomic_load(p, __ATOMIC_RELAXED, __HIP_MEMORY_SCOPE_AGENT); }
__device__ __forceinline__ unsigned xb_add(unsigned* p, unsigned v) { return __hip_atomic_fetch_add(p, v, __ATOMIC_RELAXED, __HIP_MEMORY_SCOPE_AGENT); }
__device__ __forceinline__ unsigned xb_xcc_id() { return (unsigned)__builtin_amdgcn_s_getreg((3 << 11) | 20) & 0xFu; }
#define XB_SPIN(cond, bar) do { unsigned _sp = 0; while (cond) { __builtin_amdgcn_s_sleep(1); \
    if ((++_sp & 255u) == 0u) { if (xb_ld(&(bar)[XB_TMO])) break; if (_sp > XB_SPIN_CAP) { atomicAdd(&(bar)[XB_TMO], 1u); break; } } } } while (0)

struct XcdBarrier {
    unsigned* bar; unsigned x;
    volatile LAS unsigned* st;
};

__device__ __forceinline__ XcdBarrier xcd_barrier_post(unsigned* bar, volatile LAS unsigned* st) {
    XcdBarrier b; b.bar = bar; b.x = xb_xcc_id(); b.st = st;
    if (threadIdx.x == 0) (void)xb_add(&bar[XB_XCNT(b.x)], 1u);
    return b;
}
__device__ __forceinline__ void xcd_barrier_complete(unsigned* bar, unsigned x, unsigned& nloc, unsigned& nx) {
    const unsigned G = gridDim.x * gridDim.y * gridDim.z;
    unsigned sum, cnt, mine, sp = 0u;
    for (;;) {
        sum = 0u; cnt = 0u; mine = 0u;
#pragma unroll
        for (unsigned j = 0; j < 16; ++j) { const unsigned c = xb_ld(&bar[XB_XCNT(j)]); sum += c; cnt += (c > 0u) ? 1u : 0u; mine = (j == x) ? c : mine; }
        if (sum == G) break;
        __builtin_amdgcn_s_sleep(1);
        if ((++sp & 255u) == 0u) { if (xb_ld(&bar[XB_TMO])) break; if (sp > XB_SPIN_CAP) { atomicAdd(&bar[XB_TMO], 1u); break; } }
    }
    nloc = mine > 0u ? mine : 1u; nx = cnt > 0u ? cnt : 1u;
}

__device__ __forceinline__ void xcd_barrier(const XcdBarrier& b) {
    asm volatile("s_waitcnt vmcnt(0)" ::: "memory");
    __syncthreads();
    if (threadIdx.x == 0) {
        unsigned* bar = b.bar;
        __builtin_amdgcn_s_waitcnt(0);
        unsigned nloc = b.st[0], nx = b.st[1];
        if (nloc == 0u) { xcd_barrier_complete(bar, b.x, nloc, nx); b.st[0] = nloc; b.st[1] = nx; }
        const unsigned old = xb_add(&bar[XB_XSUB(b.x)], 1u);
        const unsigned gen = old / nloc;
        if (old + 1u == (gen + 1u) * nloc) {
            __builtin_amdgcn_fence(__ATOMIC_RELEASE, "agent");
            asm volatile("s_waitcnt vmcnt(0)" ::: "memory");
            const unsigned og = xb_add(&bar[XB_TOP], 1u);
            const unsigned tg = og / nx;
            if (og + 1u == (tg + 1u) * nx) xb_add(&bar[XB_TOPGEN], 1u);
            else XB_SPIN(xb_ld(&bar[XB_TOPGEN]) == tg, bar);
            __builtin_amdgcn_fence(__ATOMIC_ACQUIRE, "agent");
            xb_add(&bar[XB_XGEN(b.x)], 1u);
            asm volatile("s_waitcnt vmcnt(0)" ::: "memory");
        } else {
            XB_SPIN(xb_ld(&bar[XB_XGEN(b.x)]) == gen, bar);
            __builtin_amdgcn_fence(__ATOMIC_ACQUIRE, "agent");
            asm volatile("s_waitcnt vmcnt(0)" ::: "memory");
        }
    }
    __syncthreads();
}

constexpr int NWAVES = 8, NTHREADS = 512;
constexpr int RING_BYTES = 131072;
constexpr int LDSCTL_OFF = 147456 - 1024, MISC_OFF = LDSCTL_OFF + 320;
constexpr int LDS_BYTES = 147456;

struct Params { const float* in[19]; float* out; unsigned char* ws; float inv_freq[16]; float ret_lg2[4]; int ph_lo, ph_hi; };
typedef const __attribute__((address_space(4))) Params& KPRef;

__device__ __forceinline__ float wave_sum(float v) {
#pragma unroll
    for (int o = 1; o < 64; o <<= 1) v += __shfl_xor(v, o);
    return v;
}
#define LDS_WAIT() asm volatile("s_waitcnt lgkmcnt(0)" ::: "memory")
#define MFMA16(a, b, c) __builtin_amdgcn_mfma_f32_16x16x32_bf16(a, b, c, 0, 0, 0)

template <class LD>
__device__ __forceinline__ void conv_item(LD ld, bf16_t* WT, int K, float* scr, int kb, int nb, int lane) {
    const int k0 = 64 * kb, n0 = 32 * nb;
#pragma unroll 8
    for (int i = 0; i < 32; ++i) { const int kk = 2 * i + (lane >> 5); scr[kk * 33 + (lane & 31)] = ld(k0 + kk, n0 + (lane & 31)); }
    LDS_WAIT();
    const int c = lane & 7;
#pragma unroll
    for (int j = 0; j < 4; ++j) { const int n = (lane >> 3) + 8 * j; const float* s = scr + (8 * c) * 33 + n;
        u32x4 o; o.x = pk2(s[0 * 33], s[1 * 33]); o.y = pk2(s[2 * 33], s[3 * 33]); o.z = pk2(s[4 * 33], s[5 * 33]); o.w = pk2(s[6 * 33], s[7 * 33]);
        *(u32x4*)(WT + (size_t)(n0 + n) * K + k0 + 8 * c) = o; }
    LDS_WAIT();
}

__device__ __forceinline__ void conv_phase(KPRef p, int l, unsigned char* lds, int gw, int NGW, int wave, int lane) {
    float* scr = (float*)(lds + wave * 16384);
    unsigned char* ws = p.ws;
    {
        const float* W = p.in[2] + (size_t)l * 1024 * IN_W; bf16_t* WT = (bf16_t*)(ws + WS_WIN);
        for (int it = gw; it < 16 * 96; it += NGW) { const int kb = it / 96, nb = it % 96;
            conv_item([&](int k, int n) -> float { if (n >= Z_GATE) return 0.f; float s = 1.f;
                if (n < Z_GK) s = RSQ32; else if (n >= Z_SQ && n < Z_SK) s = C2; else if (n >= Z_MQ && n < Z_MK) s = C2; else if (n >= Z_RK && n < Z_RV) s = RSQ32;
                return W[(size_t)k * IN_W + n] * s; }, WT, 1024, scr, kb, nb, lane); }
    }
    {
        const float* W = p.in[2] + (size_t)l * 1024 * IN_W; bf16_t* WT = (bf16_t*)(ws + WS_WG);
        for (int it = gw; it < 16 * 128; it += NGW) { const int kb = it / 128, nb = it % 128;
            conv_item([&](int k, int n) -> float { const int pn = n >> 8, c = n & 255, bj = (c >> 7) & 1, wc = (c >> 5) & 3, nn = (c >> 4) & 1, fq = (c >> 2) & 3, j = c & 3;
                const int col = Z_GATE + 1024 * (2 * bj + nn) + 64 * pn + 16 * wc + 4 * fq + j; return W[(size_t)k * IN_W + col]; }, WT, 1024, scr, kb, nb, lane); }
    }
    {
        for (int it = gw; it < 512; it += NGW) { const int i = it / 128, r = it % 128, kb = r / 32, nb = r % 32;
            const float* W = p.in[8] + (size_t)(l * 4 + i) * 256 * 1024; bf16_t* WT = (bf16_t*)(ws + WS_WB) + (size_t)i * 1024 * 256;
            conv_item([&](int k, int n) -> float { return W[(size_t)k * 1024 + n]; }, WT, 256, scr, kb, nb, lane); }
    }
    {
        const float* W = p.in[9] + (size_t)l * 1024 * 1024; bf16_t* WT = (bf16_t*)(ws + WS_WO);
        for (int it = gw; it < 16 * 32; it += NGW) { const int kb = it / 32, nb = it % 32;
            conv_item([&](int k, int n) -> float { return W[(size_t)k * 1024 + n]; }, WT, 1024, scr, kb, nb, lane); }
    }
    {
        const float* Wg = p.in[11] + (size_t)l * 1024 * 4; const float* We = p.in[13] + (size_t)l * 1024 * 32; bf16_t* WT = (bf16_t*)(ws + WS_WR);
        for (int it = gw; it < 16 * 8; it += NGW) { const int kb = it / 8, nb = it % 8;
            conv_item([&](int k, int n) -> float { if (n < 4) return Wg[k * 4 + n]; if (n < 36) return We[k * 32 + (n - 4)]; return 0.f; }, WT, 1024, scr, kb, nb, lane); }
    }
    {
        for (int it = gw; it < 32 * 256; it += NGW) { const int e = it / 256, r = it % 256, kb = r / 16, nb = r % 16;
            const int n0 = 32 * nb, pn = n0 >> 8, c0 = n0 & 255;
            const float* W = ((c0 < 128) ? p.in[15] : p.in[16]) + (size_t)(l * 32 + e) * 1024 * 256 + 128 * pn + (c0 & 127) - n0;
            bf16_t* WT = (bf16_t*)(ws + WS_E1) + (size_t)e * 512 * 1024;
            conv_item([&](int k, int n) -> float { return W[(size_t)k * 256 + n]; }, WT, 1024, scr, kb, nb, lane); }
    }
    {
        for (int it = gw; it < 32 * 128; it += NGW) { const int e = it / 128, r = it % 128, kb = r / 32, nb = r % 32;
            const float* W = p.in[17] + (size_t)(l * 32 + e) * 256 * 1024; bf16_t* WT = (bf16_t*)(ws + WS_E2) + (size_t)e * 1024 * 256;
            conv_item([&](int k, int n) -> float { return W[(size_t)k * 1024 + n]; }, WT, 256, scr, kb, nb, lane); }
    }
}

template <int MODE>
__device__ __forceinline__ void norm_phase(KPRef p, int l, int gw, int NGW, int lane) {
    const float* src = (MODE == 0) ? p.in[0] : p.out;
    const float* gain = (MODE == 3) ? p.in[18] : (MODE == 2 ? p.in[10] + l * 1024 : p.in[1] + l * 1024);
    const bf16_t* ys = (const bf16_t*)(p.ws + WS_YS); const float* tokw = (const float*)(p.ws + WS_TOKW);
    bf16_t* u = (bf16_t*)(p.ws + WS_U);
    f32x4 gg[4];
#pragma unroll
    for (int j = 0; j < 4; ++j) gg[j] = ((const f32x4*)gain)[lane + 64 * j];
    for (int row = gw; row < T_; row += NGW) {
        const f32x4* xr = (const f32x4*)(src + (size_t)row * 1024) + lane;
        f32x4 v[4];
#pragma unroll
        for (int j = 0; j < 4; ++j) v[j] = xr[64 * j];
        if (MODE == 1 || MODE == 3) {
            const float w0 = tokw[2 * row], w1 = tokw[2 * row + 1];
            const u32x2* y0 = (const u32x2*)(ys + (size_t)(2 * row) * 1024) + lane; const u32x2* y1 = (const u32x2*)(ys + (size_t)(2 * row + 1) * 1024) + lane;
#pragma unroll
            for (int j = 0; j < 4; ++j) { const u32x2 a = y0[64 * j], b = y1[64 * j];
                v[j][0] += w0 * __uint_as_float(a.x << 16) + w1 * __uint_as_float(b.x << 16); v[j][1] += w0 * __uint_as_float(a.x & 0xffff0000u) + w1 * __uint_as_float(b.x & 0xffff0000u);
                v[j][2] += w0 * __uint_as_float(a.y << 16) + w1 * __uint_as_float(b.y << 16); v[j][3] += w0 * __uint_as_float(a.y & 0xffff0000u) + w1 * __uint_as_float(b.y & 0xffff0000u); }
            if (MODE == 1) { f32x4* hr = (f32x4*)(p.out + (size_t)row * 1024) + lane;
#pragma unroll
                for (int j = 0; j < 4; ++j) hr[64 * j] = v[j]; }
        }
        float s = 0.f;
#pragma unroll
        for (int j = 0; j < 4; ++j) s += (v[j][0] * v[j][0] + v[j][1] * v[j][1]) + (v[j][2] * v[j][2] + v[j][3] * v[j][3]);
        const float rstd = rsqrtf(wave_sum(s) * (1.0f / 1024.0f) + NORM_EPS);
        if (MODE == 3) { f32x4* orow = (f32x4*)(p.out + (size_t)row * 1024) + lane;
#pragma unroll
            for (int j = 0; j < 4; ++j) orow[64 * j] = v[j] * rstd * gg[j];
        } else { u32x2* o8 = (u32x2*)(u + (size_t)row * 1024) + lane;
#pragma unroll
            for (int j = 0; j < 4; ++j) { const f32x4 o = v[j] * rstd * gg[j]; u32x2 w; w.x = pk2(o[0], o[1]); w.y = pk2(o[2], o[3]); o8[64 * j] = w; } }
    }
}

constexpr int LA_QS = 0, LA_KS = 10240, LA_VT = 20480, LA_KT = 37888, LA_PT = 46592, LA_PW = 56832, LA_PW_WAVE = 4352, LA_LA = 91648, LA_AS = 108544, LA_END = 116736;
__device__ __forceinline__ void unpack8f(float (&d)[8], u32x4 kk) {
    d[0] = __uint_as_float(kk.x << 16); d[1] = __uint_as_float(kk.x & 0xffff0000u); d[2] = __uint_as_float(kk.y << 16); d[3] = __uint_as_float(kk.y & 0xffff0000u);
    d[4] = __uint_as_float(kk.z << 16); d[5] = __uint_as_float(kk.z & 0xffff0000u); d[6] = __uint_as_float(kk.w << 16); d[7] = __uint_as_float(kk.w & 0xffff0000u); }
__device__ __forceinline__ u32x4 pack8f(const float (&o)[8]) { u32x4 w; w.x = pk2(o[0], o[1]); w.y = pk2(o[2], o[3]); w.z = pk2(o[4], o[5]); w.w = pk2(o[6], o[7]); return w; }

__device__ __forceinline__ void gla_decay_front(KPRef p, int l, unsigned char* lds, const bf16_t* zrow0, int h, int tid) {
    float* LA = (float*)(lds + LA_LA); float* AS = (float*)(lds + LA_AS);
    const int lane = tid & 63, wave = __builtin_amdgcn_readfirstlane(tid >> 6);
    if (tid < 256) { const int t = tid >> 1, hf = tid & 1; float a[8]; unpack8f(a, *(const u32x4*)(zrow0 + (size_t)t * ZW + Z_GA + 8 * hf));
#pragma unroll
        for (int e = 0; e < 8; ++e) AS[t * 16 + 8 * hf + e] = a[e]; }
    const int d = tid & 31; const float* wa2 = p.in[3] + (size_t)l * 16 * 128 + h * 32 + d; float wcol[16];
#pragma unroll
    for (int r = 0; r < 16; ++r) wcol[r] = wa2[r * 128];
    const float bias = p.in[4][l * 128 + h * 32 + d];
    __syncthreads();
#pragma unroll
    for (int i = 0; i < 8; ++i) { const int t = (tid >> 5) + 16 * i; float x = bias;
#pragma unroll
        for (int r = 0; r < 16; ++r) x += AS[t * 16 + r] * wcol[r];
        LA[t * 33 + d] = (fminf(x, 0.f) - log1pf(expf(-fabsf(x)))) * (1.0f / 16.0f); }
    __syncthreads();
#pragma unroll
    for (int s8 = 0; s8 < 8; ++s8) { const int s = wave * 8 + s8, ch = s >> 5, dd = s & 31; float v = LA[(64 * ch + lane) * 33 + dd];
#pragma unroll
        for (int o = 1; o < 64; o <<= 1) { const float t = __shfl_up(v, o); if (lane >= o) v += t; }
        LA[(64 * ch + lane) * 33 + dd] = v; }
    __syncthreads();
}
__device__ __forceinline__ void la_stage_vt(unsigned char* lds, const bf16_t* zrow0, int vcol, int tid) {
    bf16_t* VT = (bf16_t*)(lds + LA_VT);
#pragma unroll
    for (int i = 0; i < 2; ++i) { const int c = tid + 512 * i, t = c >> 3, oct = c & 7; const u32x4 vq = *(const u32x4*)(zrow0 + (size_t)t * ZW + vcol + 8 * oct);
        bf16_t* vt = VT + (8 * oct) * 136 + t;
        vt[0 * 136] = (bf16_t)(vq.x & 0xffffu); vt[1 * 136] = (bf16_t)(vq.x >> 16); vt[2 * 136] = (bf16_t)(vq.y & 0xffffu); vt[3 * 136] = (bf16_t)(vq.y >> 16);
        vt[4 * 136] = (bf16_t)(vq.z & 0xffffu); vt[5 * 136] = (bf16_t)(vq.z >> 16); vt[6 * 136] = (bf16_t)(vq.w & 0xffffu); vt[7 * 136] = (bf16_t)(vq.w >> 16); }
}
__device__ __forceinline__ void la_kv_mfma(unsigned char* lds, float* out0, int nch, int clen, int tid) {
    const bf16_t* KT = (const bf16_t*)(lds + LA_KT); const bf16_t* VT = (const bf16_t*)(lds + LA_VT);
    const int lane = tid & 63, wave = __builtin_amdgcn_readfirstlane(tid >> 6), c16 = lane & 15, g = lane >> 4;
    const int ntile = 8 * nch;
    for (int ti = wave; ti < ntile; ti += 8) { const int ch = ti >> 3, dt = (ti >> 2) & 1, et = ti & 3, tok0 = ch * clen;
        f32x4 acc = (f32x4){0.f, 0.f, 0.f, 0.f};
        for (int s = 0; s < clen / 32; ++s) { const bf16x8 a = *(const bf16x8*)(KT + (16 * dt + c16) * 136 + tok0 + 32 * s + 8 * g), bb = *(const bf16x8*)(VT + (16 * et + c16) * 136 + tok0 + 32 * s + 8 * g);
            acc = MFMA16(a, bb, acc); }
        float* o = out0 + (size_t)ch * 2048 + (16 * dt + 4 * g) * 64 + 16 * et + c16;
#pragma unroll
        for (int r = 0; r < 4; ++r) o[r * 64] = acc[r]; }
}
__device__ __forceinline__ void gla_kv_unit(KPRef p, int l, unsigned char* lds, int unit, int tid) {
    const int c = unit & 63, h = (unit >> 6) & 3, b = unit >> 8;
    const bf16_t* zrow0 = (const bf16_t*)(p.ws + WS_Z) + ((size_t)b * S_ + (size_t)c * 128) * ZW;
    gla_decay_front(p, l, lds, zrow0, h, tid);
    const float* LA = (const float*)(lds + LA_LA); bf16_t* KT = (bf16_t*)(lds + LA_KT);
    { const int t = tid >> 2, oct = tid & 3, ch = t >> 6; float k[8]; unpack8f(k, *(const u32x4*)(zrow0 + (size_t)t * ZW + Z_GK + h * 32 + 8 * oct));
#pragma unroll
      for (int e = 0; e < 8; ++e) { const int d = 8 * oct + e; KT[d * 136 + t] = (bf16_t)f2bf(k[e] * expf(LA[(64 * ch + 63) * 33 + d] - LA[t * 33 + d])); } }
    la_stage_vt(lds, zrow0, Z_GV + h * 64, tid);
    __syncthreads();
    const int cu = ((b * 4 + h) * 128 + 2 * c);
    la_kv_mfma(lds, (float*)(p.ws + WS_GKV) + (size_t)cu * 2048, 2, 64, tid);
    if (tid < 64) { const int ch = tid >> 5, d = tid & 31; ((float*)(p.ws + WS_GDEC))[(size_t)(cu + ch) * 32 + d] = expf(LA[(64 * ch + 63) * 33 + d]); }
    __syncthreads();
}
__device__ __forceinline__ void la_out_mfma(unsigned char* lds, const bf16_t* zrow0, int gcol, const float* ng, bf16_t* orow0, int ocol, int clen, int tid) {
    const bf16_t* QS = (const bf16_t*)(lds + LA_QS); const bf16_t* KS = (const bf16_t*)(lds + LA_KS); const bf16_t* VT = (const bf16_t*)(lds + LA_VT); const bf16_t* PT = (const bf16_t*)(lds + LA_PT);
    const int lane = tid & 63, wave = __builtin_amdgcn_readfirstlane(tid >> 6), c16 = lane & 15, g = lane >> 4;
    bf16_t* PW = (bf16_t*)(lds + LA_PW + wave * LA_PW_WAVE); float* PWf = (float*)PW;
    const int ch = (clen == 64) ? (wave >> 2) : 0, kt0 = (clen == 64) ? 4 * ch : 0;
    const bf16x8 qa = *(const bf16x8*)(QS + (16 * wave + c16) * 40 + 8 * g);
    for (int kt = kt0; kt <= wave; ++kt) { const bf16x8 kb = *(const bf16x8*)(KS + (16 * kt + c16) * 40 + 8 * g);
        f32x4 s = MFMA16(qa, kb, ((f32x4){0.f, 0.f, 0.f, 0.f}));
#pragma unroll
        for (int r = 0; r < 4; ++r) { const float v = (kt < wave || c16 <= 4 * g + r) ? s[r] : 0.f; PW[(4 * g + r) * 136 + 16 * kt + c16] = (bf16_t)f2bf(v); } }
    if ((wave & 1) == 0) {
#pragma unroll
        for (int r = 0; r < 4; ++r) PW[(4 * g + r) * 136 + 16 * (wave + 1) + c16] = (bf16_t)0; }
    LDS_WAIT();
    f32x4 O[4];
#pragma unroll
    for (int et = 0; et < 4; ++et) O[et] = MFMA16(qa, *(const bf16x8*)(PT + (ch * 64 + 16 * et + c16) * 40 + 8 * g), ((f32x4){0.f, 0.f, 0.f, 0.f}));
    for (int s = kt0 >> 1; s <= (wave >> 1); ++s) { const bf16x8 a = *(const bf16x8*)(PW + c16 * 136 + 32 * s + 8 * g);
#pragma unroll
        for (int et = 0; et < 4; ++et) O[et] = MFMA16(a, *(const bf16x8*)(VT + (16 * et + c16) * 136 + 32 * s + 8 * g), O[et]); }
    float rs[4];
#pragma unroll
    for (int r = 0; r < 4; ++r) { float ss = O[0][r] * O[0][r] + O[1][r] * O[1][r] + O[2][r] * O[2][r] + O[3][r] * O[3][r];
#pragma unroll
        for (int o = 1; o < 16; o <<= 1) ss += __shfl_xor(ss, o);
        rs[r] = rsqrtf(ss * (1.0f / 64.0f) + NORM_EPS); }
    LDS_WAIT();
#pragma unroll
    for (int et = 0; et < 4; ++et)
#pragma unroll
        for (int r = 0; r < 4; ++r) PWf[(4 * g + r) * 68 + 16 * et + c16] = O[et][r] * rs[r];
    LDS_WAIT();
#pragma unroll
    for (int i = 0; i < 2; ++i) { const int cidx = lane + 64 * i, row = cidx >> 3, oct = cidx & 7; const int t = 16 * wave + row;
        float gt[8]; unpack8f(gt, *(const u32x4*)(zrow0 + (size_t)t * ZW + gcol + 8 * oct));
        const f32x4 o0 = *(const f32x4*)(PWf + row * 68 + 8 * oct), o1 = *(const f32x4*)(PWf + row * 68 + 8 * oct + 4), n0 = *(const f32x4*)(ng + 8 * oct), n1 = *(const f32x4*)(ng + 8 * oct + 4);
        float o[8];
#pragma unroll
        for (int e = 0; e < 4; ++e) { o[e] = o0[e] * n0[e] * (gt[e] * sigmoidf_(gt[e])); o[4 + e] = o1[e] * n1[e] * (gt[4 + e] * sigmoidf_(gt[4 + e])); }
        *(u32x4*)(orow0 + (size_t)t * 1024 + ocol + 8 * oct) = pack8f(o); }
}
__device__ __forceinline__ void gla_out_unit(KPRef p, int l, unsigned char* lds, int unit, int tid) {
    const int c = unit & 63, h = (unit >> 6) & 3, b = unit >> 8;
    const size_t t0 = (size_t)b * S_ + (size_t)c * 128;
    const bf16_t* zrow0 = (const bf16_t*)(p.ws + WS_Z) + t0 * ZW;
    gla_decay_front(p, l, lds, zrow0, h, tid);
    const float* LA = (const float*)(lds + LA_LA); bf16_t* QS = (bf16_t*)(lds + LA_QS); bf16_t* KS = (bf16_t*)(lds + LA_KS); bf16_t* PT = (bf16_t*)(lds + LA_PT);
    { const int t = tid >> 2, oct = tid & 3; float k[8], q[8]; unpack8f(k, *(const u32x4*)(zrow0 + (size_t)t * ZW + Z_GK + h * 32 + 8 * oct)); unpack8f(q, *(const u32x4*)(zrow0 + (size_t)t * ZW + Z_GQ + h * 32 + 8 * oct));
#pragma unroll
      for (int e = 0; e < 8; ++e) { const float bb = LA[t * 33 + 8 * oct + e]; q[e] *= expf(bb); k[e] *= expf(-bb); }
      *(u32x4*)(QS + t * 40 + 8 * oct) = pack8f(q); *(u32x4*)(KS + t * 40 + 8 * oct) = pack8f(k); }
    la_stage_vt(lds, zrow0, Z_GV + h * 64, tid);
    const int cu = ((b * 4 + h) * 128 + 2 * c); const float* prev = (const float*)(p.ws + WS_GKV) + (size_t)cu * 2048;
#pragma unroll
    for (int i = 0; i < 8; ++i) { const int idx = tid + 512 * i, ch = idx >> 11, d = (idx >> 6) & 31, e = idx & 63; PT[(ch * 64 + e) * 40 + d] = (bf16_t)f2bf(prev[idx]); }
    __syncthreads();
    la_out_mfma(lds, zrow0, Z_GR + h * 64, p.in[5] + l * 64, (bf16_t*)(p.ws + WS_O) + t0 * 1024, 0 + h * 64, 64, tid);
    __syncthreads();
}
__device__ __forceinline__ void rope_cs(float pos, float invf, float& c, float& s) {
    const float ang = pos * invf; const double t = (double)ang * 0.15915494309189535; const float fr = (float)(t - floor(t));
    c = __builtin_amdgcn_cosf(fr); s = __builtin_amdgcn_sinf(fr);
}
__device__ __forceinline__ void ret_cs_table(KPRef p, unsigned char* lds, int pos0, int tid) {
    f32x2* CS = (f32x2*)(lds + LA_LA);
#pragma unroll
    for (int i = 0; i < 4; ++i) { const int idx = tid + 512 * i, t = idx >> 4, f = idx & 15; float c, s; rope_cs((float)(pos0 + t), p.inv_freq[f], c, s); CS[idx] = (f32x2){c, s}; }
}
__device__ __forceinline__ void ret_rot8(const unsigned char* lds, const bf16_t* src  , int t, int oct, float (&o)[8]) {
    const f32x2* CS = (const f32x2*)(lds + LA_LA); float own[8], oth[8]; unpack8f(own, *(const u32x4*)(src + 8 * oct)); unpack8f(oth, *(const u32x4*)(src + 8 * (oct ^ 2)));
#pragma unroll
    for (int e = 0; e < 8; ++e) { const f32x2 cs = CS[t * 16 + 8 * (oct & 1) + e]; o[e] = (oct < 2) ? (own[e] * cs[0] - oth[e] * cs[1]) : (oth[e] * cs[1] + own[e] * cs[0]); }
}
__device__ __forceinline__ void ret_kv_unit(KPRef p, unsigned char* lds, int unit, int tid) {
    const int n = unit & 63, bh = unit >> 6, h = bh & 3, b = bh >> 2;
    const bf16_t* zrow0 = (const bf16_t*)(p.ws + WS_Z) + ((size_t)b * S_ + (size_t)n * 128) * ZW;
    ret_cs_table(p, lds, n * 128, tid);
    la_stage_vt(lds, zrow0, Z_RV + h * 64, tid);
    __syncthreads();
    bf16_t* KT = (bf16_t*)(lds + LA_KT); const float lg = p.ret_lg2[h];
    { const int t = tid >> 2, oct = tid & 3; float k[8]; ret_rot8(lds, zrow0 + (size_t)t * ZW + Z_RK + h * 32, t, oct, k); const float dk = __builtin_amdgcn_exp2f((float)(127 - t) * lg);
#pragma unroll
      for (int e = 0; e < 8; ++e) KT[(8 * oct + e) * 136 + t] = (bf16_t)f2bf(k[e] * dk); }
    __syncthreads();
    la_kv_mfma(lds, (float*)(p.ws + WS_RKV) + (size_t)unit * 2048, 1, 128, tid);
    __syncthreads();
}
__device__ __forceinline__ void ret_out_unit(KPRef p, int l, unsigned char* lds, int unit, int tid) {
    const int n = unit & 63, bh = unit >> 6, h = bh & 3, b = bh >> 2;
    const size_t t0 = (size_t)b * S_ + (size_t)n * 128;
    const bf16_t* zrow0 = (const bf16_t*)(p.ws + WS_Z) + t0 * ZW;
    ret_cs_table(p, lds, n * 128, tid);
    la_stage_vt(lds, zrow0, Z_RV + h * 64, tid);
    const float lg = p.ret_lg2[h]; bf16_t* PT = (bf16_t*)(lds + LA_PT); const float* prev = (const float*)(p.ws + WS_RKV) + (size_t)unit * 2048; const float g1 = __builtin_amdgcn_exp2f(lg);
#pragma unroll
    for (int i = 0; i < 4; ++i) { const int idx = tid + 512 * i, d = idx >> 6, e = idx & 63; PT[e * 40 + d] = (bf16_t)f2bf(prev[idx] * g1); }
    __syncthreads();
    bf16_t* QS = (bf16_t*)(lds + LA_QS); bf16_t* KS = (bf16_t*)(lds + LA_KS);
    { const int t = tid >> 2, oct = tid & 3; float k[8], q[8]; ret_rot8(lds, zrow0 + (size_t)t * ZW + Z_RK + h * 32, t, oct, k); ret_rot8(lds, zrow0 + (size_t)t * ZW + Z_RQ + h * 32, t, oct, q);
      const float dq = __builtin_amdgcn_exp2f((float)t * lg), dk = __builtin_amdgcn_exp2f(-(float)t * lg);
#pragma unroll
      for (int e = 0; e < 8; ++e) { q[e] *= dq; k[e] *= dk; }
      *(u32x4*)(QS + t * 40 + 8 * oct) = pack8f(q); *(u32x4*)(KS + t * 40 + 8 * oct) = pack8f(k); }
    __syncthreads();
    la_out_mfma(lds, zrow0, Z_RG + h * 64, p.in[7] + l * 64, (bf16_t*)(p.ws + WS_O) + t0 * 1024, 768 + h * 64, 128, tid);
    __syncthreads();
}

__device__ __forceinline__ void scan_phase(KPRef p, int wg, int tid) {
    if (wg < 64) {
        const int bh = wg >> 2, elem = (wg & 3) * 512 + tid, d = elem >> 6;
        float* base = (float*)(p.ws + WS_GKV) + (size_t)bh * 128 * 2048 + elem; const float* dec = (const float*)(p.ws + WS_GDEC) + (size_t)bh * 128 * 32 + d;
        float s = 0.f;
#pragma unroll 1
        for (int n0 = 0; n0 < 128; n0 += 8) { float kv[8], dc[8];
#pragma unroll
            for (int j = 0; j < 8; ++j) { kv[j] = base[(size_t)(n0 + j) * 2048]; dc[j] = dec[(n0 + j) * 32]; }
#pragma unroll
            for (int j = 0; j < 8; ++j) { base[(size_t)(n0 + j) * 2048] = s; s = dc[j] * s + kv[j]; } }
    } else if (wg < 128) {
        const int w2 = wg - 64, bh = w2 >> 2, h = bh & 3, elem = (w2 & 3) * 512 + tid;
        float* base = (float*)(p.ws + WS_RKV) + (size_t)bh * 64 * 2048 + elem; const float dc = __builtin_amdgcn_exp2f(128.0f * p.ret_lg2[h]);
        float s = 0.f;
#pragma unroll 1
        for (int n0 = 0; n0 < 64; n0 += 8) { float kv[8];
#pragma unroll
            for (int j = 0; j < 8; ++j) kv[j] = base[(size_t)(n0 + j) * 2048];
#pragma unroll
            for (int j = 0; j < 8; ++j) { base[(size_t)(n0 + j) * 2048] = s; s = dc * s + kv[j]; } }
    }
}

__device__ __forceinline__ void kmean_unit(KPRef p, float* sm, int unit, int tid) {
    const bf16_t* z = (const bf16_t*)(p.ws + WS_Z); const size_t t0 = (size_t)unit * 256;
    const int c = tid & 255, part = tid >> 8; float s = 0.f;
#pragma unroll 8
    for (int i = part * 128; i < part * 128 + 128; ++i) s += bf2f(z[(t0 + i) * ZW + Z_MK + c]);
    sm[tid] = s; __syncthreads();
    if (tid < 256) ((float*)(p.ws + WS_KMEAN))[(size_t)unit * 256 + tid] = (sm[tid] + sm[tid + 256]) * (1.0f / 256.0f);
    __syncthreads();
}

constexpr int AT_KS = 0, AT_VT = 36864, AT_PW = 70656, AT_PW_WAVE = 8448, AT_WSF = 138240, AT_END = 138240 + 8 * 256;
template <class Fn>
__device__ __forceinline__ void attn256_unit(unsigned char* lds, const bf16_t* kg, const bf16_t* vg, int key_lo_valid, const Fn& F, int tid) {
    const int lane = tid & 63, wave = __builtin_amdgcn_readfirstlane(tid >> 6), c16 = lane & 15, g = lane >> 4;
    bf16_t* KS = (bf16_t*)(lds + AT_KS); bf16_t* VT = (bf16_t*)(lds + AT_VT); bf16_t* PW = (bf16_t*)(lds + AT_PW + wave * AT_PW_WAVE); float* WSF = (float*)(lds + AT_WSF + wave * 256);
#pragma unroll
    for (int i = 0; i < 4; ++i) { const int c = tid + 512 * i, key = c >> 3, oct = c & 7;
        u32x4 kq = (u32x4){0u, 0u, 0u, 0u}, vq = (u32x4){0u, 0u, 0u, 0u};
        if (key >= key_lo_valid) { kq = *(const u32x4*)(kg + (size_t)key * ZW + 8 * oct); vq = *(const u32x4*)(vg + (size_t)key * ZW + 8 * oct); }
        *(u32x4*)(KS + key * 72 + 8 * oct) = kq;
        bf16_t* vt = VT + (8 * oct) * 264 + key;
        vt[0 * 264] = (bf16_t)(vq.x & 0xffffu); vt[1 * 264] = (bf16_t)(vq.x >> 16); vt[2 * 264] = (bf16_t)(vq.y & 0xffffu); vt[3 * 264] = (bf16_t)(vq.y >> 16);
        vt[4 * 264] = (bf16_t)(vq.z & 0xffffu); vt[5 * 264] = (bf16_t)(vq.z >> 16); vt[6 * 264] = (bf16_t)(vq.w & 0xffffu); vt[7 * 264] = (bf16_t)(vq.w >> 16); }
    __syncthreads();
#pragma unroll 1
    for (int rt = 0; rt < 2; ++rt) {
        const int rbase = 32 * wave + 16 * rt;
        const bf16_t* qp = F.rowptr(rbase + c16);
        const bf16x8 qa0 = *(const bf16x8*)(qp + 8 * g), qa1 = *(const bf16x8*)(qp + 32 + 8 * g);
        f32x4 S[16];
#pragma unroll
        for (int ct = 0; ct < 16; ++ct) { const bf16_t* kp = KS + (16 * ct + c16) * 72 + 8 * g;
            const bf16x8 b0 = *(const bf16x8*)kp, b1 = *(const bf16x8*)(kp + 32);
            f32x4 acc = (f32x4){0.f, 0.f, 0.f, 0.f}; acc = MFMA16(qa0, b0, acc); acc = MFMA16(qa1, b1, acc); S[ct] = acc; }
        float m[4] = {-1e30f, -1e30f, -1e30f, -1e30f};
#pragma unroll
        for (int ct = 0; ct < 16; ++ct)
#pragma unroll
            for (int r = 0; r < 4; ++r) { const float s = F.mask(rbase + 4 * g + r, 16 * ct + c16) ? S[ct][r] : -1e30f; S[ct][r] = s; m[r] = fmaxf(m[r], s); }
#pragma unroll
        for (int r = 0; r < 4; ++r) {
#pragma unroll
            for (int o = 1; o < 16; o <<= 1) m[r] = fmaxf(m[r], __shfl_xor(m[r], o)); }
        float l[4] = {0.f, 0.f, 0.f, 0.f};
#pragma unroll
        for (int ct = 0; ct < 16; ++ct)
#pragma unroll
            for (int r = 0; r < 4; ++r) { const float pr = __builtin_amdgcn_exp2f(S[ct][r] - m[r]); l[r] += pr; PW[(4 * g + r) * 264 + 16 * ct + c16] = (bf16_t)f2bf(pr); }
#pragma unroll
        for (int r = 0; r < 4; ++r) {
#pragma unroll
            for (int o = 1; o < 16; o <<= 1) l[r] += __shfl_xor(l[r], o); }
        LDS_WAIT();
        f32x4 O[4];
#pragma unroll
        for (int dt = 0; dt < 4; ++dt) O[dt] = (f32x4){0.f, 0.f, 0.f, 0.f};
#pragma unroll
        for (int s8 = 0; s8 < 8; ++s8) { const bf16x8 a = *(const bf16x8*)(PW + c16 * 264 + 32 * s8 + 8 * g);
#pragma unroll
            for (int dt = 0; dt < 4; ++dt) { const bf16x8 bb = *(const bf16x8*)(VT + (16 * dt + c16) * 264 + 32 * s8 + 8 * g); O[dt] = MFMA16(a, bb, O[dt]); } }
        float f[4];
#pragma unroll
        for (int r = 0; r < 4; ++r) f[r] = F.scale(rbase + 4 * g + r, m[r], l[r], WSF + (4 * g + r) * 4, c16 == 0);
        LDS_WAIT();
#pragma unroll
        for (int dt = 0; dt < 4; ++dt)
#pragma unroll
            for (int r = 0; r < 4; ++r) PW[(4 * g + r) * 72 + 16 * dt + c16] = (bf16_t)f2bf(O[dt][r] * f[r]);
        LDS_WAIT();
#pragma unroll
        for (int i = 0; i < 2; ++i) { const int ch = lane + 64 * i, row = ch >> 3, oct = ch & 7;
            const u32x4 v = *(const u32x4*)(PW + row * 72 + 8 * oct); F.store(rbase + row, oct, v, WSF + row * 4); }
        LDS_WAIT();
    }
    __syncthreads();
}

struct SwaFn { const bf16_t* z; bf16_t* ob; size_t tb; int q0, kvh; float sink2_0, sink2_1;
    __device__ __forceinline__ const bf16_t* rowptr(int row) const { return z + (tb + q0 + (row & 127)) * ZW + Z_SQ + (kvh * 2 + (row >> 7)) * 64; }
    __device__ __forceinline__ bool mask(int row, int kk) const { const int d = (row & 127) + 128 - kk; return d >= 0 && d < 128 && (q0 - 128 + kk) >= 0; }
    __device__ __forceinline__ float scale(int row, float m, float l, float*, bool) const { const float sk = (row >> 7) ? sink2_1 : sink2_0; const float M = fmaxf(m, sk), w0 = __builtin_amdgcn_exp2f(m - M);
        return w0 / (l * w0 + __builtin_amdgcn_exp2f(sk - M)); }
    __device__ __forceinline__ void store(int row, int oct, u32x4 v, const float*) const { *(u32x4*)(ob + (tb + q0 + (row & 127)) * 1024 + 256 + (kvh * 2 + (row >> 7)) * 64 + 8 * oct) = v; }
};
__device__ __forceinline__ void swa_unit(KPRef p, int l, unsigned char* lds, int unit, int tid) {
    const int qb = unit & 63, kvh = (unit >> 6) & 1, b = unit >> 7;
    const bf16_t* z = (const bf16_t*)(p.ws + WS_Z); const size_t tb = (size_t)b * S_; const int q0 = qb * 128;
    SwaFn F{z, (bf16_t*)(p.ws + WS_O), tb, q0, kvh, p.in[6][l * 4 + kvh * 2] * LOG2E, p.in[6][l * 4 + kvh * 2 + 1] * LOG2E};
    const long kb = (long)tb + q0 - 128;
    attn256_unit(lds, z + kb * ZW + Z_SK + kvh * 64, z + kb * ZW + Z_SV + kvh * 64, q0 == 0 ? 128 : 0, F, tid);
}

constexpr int ML_PER_BH = 126976;
__device__ __forceinline__ int ml_off(int j) { return 256 * (31 * j - (j * (j - 1)) / 2); }
__device__ __forceinline__ void moba_select(KPRef p, int wg, int tid) {
    const int gid = wg * NTHREADS + tid, t = gid >> 2, h = gid & 3, b = t >> 13, tl = t & 8191, blk = tl >> 8;
    const bf16_t* z = (const bf16_t*)(p.ws + WS_Z);
    float q[64];
    { const bf16_t* qp = z + (size_t)t * ZW + Z_MQ + h * 64;
#pragma unroll
      for (int c = 0; c < 8; ++c) { const u32x4 kk = *(const u32x4*)(qp + 8 * c);
        q[8 * c + 0] = __uint_as_float(kk.x << 16); q[8 * c + 1] = __uint_as_float(kk.x & 0xffff0000u); q[8 * c + 2] = __uint_as_float(kk.y << 16); q[8 * c + 3] = __uint_as_float(kk.y & 0xffff0000u);
        q[8 * c + 4] = __uint_as_float(kk.z << 16); q[8 * c + 5] = __uint_as_float(kk.z & 0xffff0000u); q[8 * c + 6] = __uint_as_float(kk.w << 16); q[8 * c + 7] = __uint_as_float(kk.w & 0xffff0000u); } }
    const float* km = (const float*)(p.ws + WS_KMEAN) + (size_t)b * 32 * 256 + h * 64;
    float v0 = -3e38f, v1 = -3e38f, v2 = -3e38f; int i0 = -1, i1 = -1, i2 = -1;
#pragma unroll 1
    for (int nb = 0; nb < blk; ++nb) { const f32x4* kr = (const f32x4*)(km + nb * 256); float s = 0.f;
#pragma unroll
        for (int c = 0; c < 16; ++c) { const f32x4 kv = kr[c]; s += q[4 * c] * kv[0] + q[4 * c + 1] * kv[1] + q[4 * c + 2] * kv[2] + q[4 * c + 3] * kv[3]; }
        if (s > v0) { v2 = v1; i2 = i1; v1 = v0; i1 = i0; v0 = s; i0 = nb; } else if (s > v1) { v2 = v1; i2 = i1; v1 = s; i1 = nb; } else if (s > v2) { v2 = s; i2 = nb; } }
    int* cnt = (int*)(p.ws + WS_MCNT) + (b * 4 + h) * 32; int* lst = (int*)(p.ws + WS_MLIST) + (size_t)(b * 4 + h) * ML_PER_BH; f32x2* pml = (f32x2*)(p.ws + WS_PARTML) + (size_t)gid * 3;
#pragma unroll
    for (int s3 = 0; s3 < 3; ++s3) { const int sb = (s3 == 0) ? i0 : (s3 == 1 ? i1 : i2);
        if (sb >= 0) { const int pos = atomicAdd(cnt + sb, 1); lst[ml_off(sb) + pos] = tl | (s3 << 13); }
        else pml[s3] = (f32x2){-1e30f, 0.f}; }
}
struct MobaSelFn { const bf16_t* z; const int* lst; bf16_t* po; f32x2* pml; size_t tb; int h, n_valid;
    __device__ __forceinline__ int entry(int row) const { return lst[row < n_valid ? row : 0]; }
    __device__ __forceinline__ const bf16_t* rowptr(int row) const { return z + (tb + (entry(row) & 8191)) * ZW + Z_MQ + h * 64; }
    __device__ __forceinline__ bool mask(int, int) const { return true; }
    __device__ __forceinline__ size_t pidx(int e) const { return ((tb + (e & 8191)) * 4 + h) * 3 + (e >> 13); }
    __device__ __forceinline__ float scale(int row, float m, float l, float*, bool writer) const { if (writer && row < n_valid) pml[pidx(lst[row])] = (f32x2){m, l}; return 1.0f / l; }
    __device__ __forceinline__ void store(int row, int oct, u32x4 v, const float*) const { if (row < n_valid) *(u32x4*)(po + pidx(lst[row]) * 64 + 8 * oct) = v; }
};
__device__ __forceinline__ void moba_sel_unit(KPRef p, unsigned char* lds, int unit, int tid) {
    const int bh = unit / 496; int idx = unit % 496, j = 0; while (idx >= 31 - j) { idx -= 31 - j; ++j; }
    const int cnt = __builtin_amdgcn_readfirstlane(((const int*)(p.ws + WS_MCNT))[bh * 32 + j]);
    if (idx * 256 >= cnt) return;
    const int b = bh >> 2, h = bh & 3; const bf16_t* z = (const bf16_t*)(p.ws + WS_Z); const size_t tb = (size_t)b * S_;
    const int nv = cnt - idx * 256;
    MobaSelFn F{z, (const int*)(p.ws + WS_MLIST) + (size_t)bh * ML_PER_BH + ml_off(j) + idx * 256, (bf16_t*)(p.ws + WS_PARTO), (f32x2*)(p.ws + WS_PARTML), tb, h, nv < 256 ? nv : 256};
    attn256_unit(lds, z + (tb + j * 256) * ZW + Z_MK + h * 64, z + (tb + j * 256) * ZW + Z_MV + h * 64, 0, F, tid);
}
struct MobaOwnFn { const bf16_t* z; bf16_t* ob; const bf16_t* po; const f32x2* pml; size_t t0; int h;
    __device__ __forceinline__ const bf16_t* rowptr(int row) const { return z + (t0 + row) * ZW + Z_MQ + h * 64; }
    __device__ __forceinline__ bool mask(int row, int kk) const { return kk <= row; }
    __device__ __forceinline__ float scale(int row, float m, float l, float* wsf, bool writer) const {
        const f32x2* ml = pml + ((t0 + row) * 4 + h) * 3; const f32x2 a = ml[0], b = ml[1], c = ml[2];
        const float M = fmaxf(fmaxf(m, a[0]), fmaxf(b[0], c[0]));
        const float w0 = __builtin_amdgcn_exp2f(m - M), wa = a[1] * __builtin_amdgcn_exp2f(a[0] - M), wb = b[1] * __builtin_amdgcn_exp2f(b[0] - M), wc = c[1] * __builtin_amdgcn_exp2f(c[0] - M);
        const float inv = 1.0f / (l * w0 + wa + wb + wc);
        if (writer) { wsf[0] = wa * inv; wsf[1] = wb * inv; wsf[2] = wc * inv; }
        return w0 * inv; }
    __device__ __forceinline__ void store(int row, int oct, u32x4 v, const float* wsf) const {
        float o[8]; o[0] = __uint_as_float(v.x << 16); o[1] = __uint_as_float(v.x & 0xffff0000u); o[2] = __uint_as_float(v.y << 16); o[3] = __uint_as_float(v.y & 0xffff0000u);
        o[4] = __uint_as_float(v.z << 16); o[5] = __uint_as_float(v.z & 0xffff0000u); o[6] = __uint_as_float(v.w << 16); o[7] = __uint_as_float(v.w & 0xffff0000u);
        const bf16_t* pr = po + (((t0 + row) * 4 + h) * 3) * 64 + 8 * oct;
#pragma unroll
        for (int s = 0; s < 3; ++s) { const float w = wsf[s]; if (w != 0.f) { const u32x4 q = *(const u32x4*)(pr + s * 64);
            o[0] += w * __uint_as_float(q.x << 16); o[1] += w * __uint_as_float(q.x & 0xffff0000u); o[2] += w * __uint_as_float(q.y << 16); o[3] += w * __uint_as_float(q.y & 0xffff0000u);
            o[4] += w * __uint_as_float(q.z << 16); o[5] += w * __uint_as_float(q.z & 0xffff0000u); o[6] += w * __uint_as_float(q.w << 16); o[7] += w * __uint_as_float(q.w & 0xffff0000u); } }
        u32x4 w4; w4.x = pk2(o[0], o[1]); w4.y = pk2(o[2], o[3]); w4.z = pk2(o[4], o[5]); w4.w = pk2(o[6], o[7]);
        *(u32x4*)(ob + (t0 + row) * 1024 + 512 + h * 64 + 8 * oct) = w4; }
};
__device__ __forceinline__ void moba_own_unit(KPRef p, unsigned char* lds, int unit, int tid) {
    const int qb = unit & 31, h = (unit >> 5) & 3, b = unit >> 7;
    const bf16_t* z = (const bf16_t*)(p.ws + WS_Z); const size_t t0 = (size_t)b * S_ + (size_t)qb * 256;
    MobaOwnFn F{z, (bf16_t*)(p.ws + WS_O), (const bf16_t*)(p.ws + WS_PARTO), (const f32x2*)(p.ws + WS_PARTML), t0, h};
    attn256_unit(lds, z + t0 * ZW + Z_MK + h * 64, z + t0 * ZW + Z_MV + h * 64, 0, F, tid);
}

__device__ __forceinline__ void route_phase(KPRef p, int l, float* sm, int wg, int tid) {
    int* se = (int*)sm;
    int* toke = (int*)(p.ws + WS_TOKE); float* tokw = (float*)(p.ws + WS_TOKW); int* tokr = (int*)(p.ws + WS_TOKR); int* hist = (int*)(p.ws + WS_HIST); int* sdst = (int*)(p.ws + WS_SDST);
    if (tid < 128) { const int t = wg * 128 + tid; const float* lg = (const float*)(p.ws + WS_LOGIT) + (size_t)t * 64; const float* bg = p.in[12] + l * 4; const float* be = p.in[14] + l * 32;
        float g0 = lg[0] + bg[0], g1 = lg[1] + bg[1], g2 = lg[2] + bg[2], g3 = lg[3] + bg[3];
        int gs = 0; float gm = g0; if (g1 > gm) { gm = g1; gs = 1; } if (g2 > gm) { gm = g2; gs = 2; } if (g3 > gm) { gm = g3; gs = 3; }
        const float gw_ = 1.0f / (expf(g0 - gm) + expf(g1 - gm) + expf(g2 - gm) + expf(g3 - gm));
        float v0 = -3e38f, v1 = -3e38f; int i0 = 0, i1 = 0;
#pragma unroll
        for (int j = 0; j < 8; ++j) { const float s = lg[4 + 8 * gs + j] + be[8 * gs + j]; if (s > v0) { v1 = v0; i1 = i0; v0 = s; i0 = j; } else if (s > v1) { v1 = s; i1 = j; } }
        const float e1 = expf(v1 - v0), w0 = 1.0f / (1.0f + e1), w1 = e1 * w0;
        const int ea = 8 * gs + i0, eb = 8 * gs + i1;
        se[2 * tid] = ea; se[2 * tid + 1] = eb; toke[2 * t] = ea; toke[2 * t + 1] = eb; tokw[2 * t] = w0 * gw_; tokw[2 * t + 1] = w1 * gw_; }
    __syncthreads();
    if (tid < 256) { const int e = se[tid]; int r = 0;
#pragma unroll 4
        for (int a = 0; a < tid; ++a) r += (se[a] == e) ? 1 : 0; tokr[wg * 256 + tid] = r; }
    if (tid >= 256 && tid < 288) { const int e = tid - 256; int c = 0;
#pragma unroll 4
        for (int a = 0; a < 256; ++a) c += (se[a] == e) ? 1 : 0; hist[wg * 32 + e] = c; }
    for (int i = tid; i < NSLOTBLK; i += NTHREADS) sdst[wg * NSLOTBLK + i] = YS_TRASH_ROW;
    __syncthreads();
}
__device__ __forceinline__ void assign_phase(KPRef p, float* sm, int wg, int tid, int wave, int lane) {
    int* cnt = (int*)sm, *bas = cnt + 32, *pend = cnt + 64, *slot_of = cnt + 128;
    const int* hist = (const int*)(p.ws + WS_HIST); const int* toke = (const int*)(p.ws + WS_TOKE); const int* tokr = (const int*)(p.ws + WS_TOKR);
    int* sdst = (int*)(p.ws + WS_SDST); int* blke = (int*)(p.ws + WS_BLKE);
    if (tid < 32) { int c = 0, bb = 0;
#pragma unroll 8
        for (int w = 0; w < 256; ++w) { const int v = hist[w * 32 + tid]; c += v; if (w < wg) bb += v; } cnt[tid] = c; bas[tid] = bb; }
    __syncthreads();
    if (tid == 0) { int run = 0; for (int e = 0; e < 32; ++e) { const int pad = ((cnt[e] + 255) >> 8) << 8; bas[e] += run; run += pad; pend[e] = run; } }
    __syncthreads();
    if (wg == 0) { if (tid < NSLOTBLK) { int e = 0; for (int k = 0; k < 32; ++k) e += (pend[k] <= tid * 256) ? 1 : 0; blke[tid] = e > 31 ? 31 : e; } if (tid == 0) blke[511] = pend[31] >> 8; }
    if (tid < 256) { const int a = wg * 256 + tid; const int e = toke[a]; const int slot = bas[e] + tokr[a]; sdst[slot] = a; slot_of[tid] = slot; }
    __syncthreads();
    const bf16_t* u2 = (const bf16_t*)(p.ws + WS_U); bf16_t* xs = (bf16_t*)(p.ws + WS_XS);
    for (int a = wave; a < 256; a += NWAVES) { const u32x4* src = (const u32x4*)(u2 + (size_t)(wg * 128 + (a >> 1)) * 1024); u32x4* dst = (u32x4*)(xs + (size_t)slot_of[a] * 1024);
        dst[lane] = src[lane]; dst[lane + 64] = src[lane + 64]; }
    __syncthreads();
}

#ifndef MK_PER_PHASE
#define MK_PER_PHASE 0
#endif
constexpr int PH_PER_LAYER = 17, N_PHASES = DEPTH_ * PH_PER_LAYER + 1;
constexpr int CW_BAR = 1024;

__global__ void __launch_bounds__(NTHREADS, 2) mega(Params p_unused) {
    extern __shared__ __attribute__((aligned(16))) unsigned char lds[];
    const int tid0 = threadIdx.x;
    const int G = gridDim.x, wg = blockIdx.x, NGW = G * NWAVES;
#define PHASE_BEGIN() KPRef p = *KP(); unsigned char* ws = p.ws; (void)ws; int tid = threadIdx.x; asm volatile("" : "+v"(tid)); const int lane = tid & 63, wave = __builtin_amdgcn_readfirstlane(tid >> 6), gw = wg * NWAVES + wave; (void)lane; (void)gw
    volatile LAS unsigned* MISC = (volatile LAS unsigned*)((LAS unsigned char*)lds + MISC_OFF);
    for (int u = tid0; u < (LDS_BYTES - LDSCTL_OFF) / 4; u += NTHREADS) ((LAS unsigned*)((LAS unsigned char*)lds + LDSCTL_OFF))[u] = 0u;
    __syncthreads();
#define KP() ({ const __attribute__((address_space(4))) Params* _k = (const __attribute__((address_space(4))) Params*)__builtin_amdgcn_kernarg_segment_ptr(); asm volatile("" : "+s"(_k)); _k; })
    unsigned* ctl; { const __attribute__((address_space(4))) Params* k0 = KP(); ctl = (unsigned*)(k0->ws + WS_CTL); }
    XcdBarrier bar = xcd_barrier_post(ctl + CW_BAR, MISC + 8);
    int lo, hi; { const __attribute__((address_space(4))) Params* k0 = KP(); lo = k0->ph_lo; hi = k0->ph_hi; }
    float* sm = (float*)lds;
    PG8_LAS unsigned char* ring = (PG8_LAS unsigned char*)lds;
#ifndef PH_MASK
#define PH_MASK 0x3ffffu
#endif
#define IN(k) ((((PH_MASK) >> ((k) == DEPTH_ * PH_PER_LAYER ? 17 : ((k) % PH_PER_LAYER))) & 1u) && lo <= (k) && (k) < hi)
#define SEAM(k) do { if ((k) + 1 < hi) xcd_barrier(bar); } while (0)

    for (int l = 0; l < DEPTH_; ++l) {
        const int P0 = l * PH_PER_LAYER;
        if (IN(P0 + 0)) { PHASE_BEGIN();
            conv_phase(p, l, lds, gw, NGW, wave, lane);
            if (l == 0) norm_phase<0>(p, l, gw, NGW, lane); else norm_phase<1>(p, l, gw, NGW, lane);
            SEAM(P0 + 0);
        }
        if (IN(P0 + 1)) { PHASE_BEGIN();
            pg8::Gemm g{(const bf16_t*)(ws + WS_U), (const bf16_t*)(ws + WS_WIN), 1024, 1024, 1024};
            pg8::StaticOrder S; S.init(T_, ZW, G, wg, 1024, 1024);
            pg8::EpiBf16 E{(bf16_t*)(ws + WS_Z), ZW, 0};
            pg8::gemm_phase(ring, g, S, E);
            SEAM(P0 + 1);
        }
        if (IN(P0 + 2)) { PHASE_BEGIN();
            if (wg == 0) { int* cnt = (int*)(ws + WS_MCNT); cnt[tid] = 0; }
            for (int u = wg; u < 1024; u += G) gla_kv_unit(p, l, lds, u, tid);
            for (int u = wg; u < 1024; u += G) ret_kv_unit(p, lds, u, tid);
            for (int u = wg; u < 128; u += G) kmean_unit(p, sm, u, tid);
            for (int u = wg; u < 512; u += G) swa_unit(p, l, lds, u, tid);
            SEAM(P0 + 2);
        }
        if (IN(P0 + 3)) { PHASE_BEGIN(); moba_select(p, wg, tid); scan_phase(p, wg, tid); SEAM(P0 + 3); }
        if (IN(P0 + 4)) { PHASE_BEGIN();
            for (int u = wg; u < 1024; u += G) gla_out_unit(p, l, lds, u, tid);
            for (int u = wg; u < 1024; u += G) ret_out_unit(p, l, lds, u, tid);
            for (int u = wg; u < 16 * 496; u += G) moba_sel_unit(p, lds, u, tid);
            SEAM(P0 + 4);
        }
        if (IN(P0 + 5)) { PHASE_BEGIN();
            for (int u = wg; u < 512; u += G) moba_own_unit(p, lds, u, tid);
            SEAM(P0 + 5);
        }
        for (int hf = 0; hf < 2; ++hf) {
            if (IN(P0 + 6 + 2 * hf)) { PHASE_BEGIN();
                pg8::Gemm g{(const bf16_t*)(ws + WS_O), (const bf16_t*)(ws + WS_WB), 1024, 256, 256};
                pg8::StaticOrder S; S.init(T_ / 2, 4096, G, wg, 1024, 256, 64 * hf, 2, 512);
                pg8::EpiBf16 E{(bf16_t*)(ws + WS_YH), 4096, 16384 * hf};
                pg8::gemm_phase(ring, g, S, E);
                SEAM(P0 + 6 + 2 * hf);
            }
            if (IN(P0 + 7 + 2 * hf)) { PHASE_BEGIN();
                pg8::Gemm g{(const bf16_t*)(ws + WS_U), (const bf16_t*)(ws + WS_WG), 1024, 1024, 1024};
                pg8::StaticOrder S; S.init(T_ / 2, 4096, G, wg, 1024, 1024, 64 * hf);
                pg8::EpiGate E{(const bf16_t*)(ws + WS_YH), 16384 * hf, (bf16_t*)(ws + WS_O)};
                pg8::gemm_phase(ring, g, S, E);
                SEAM(P0 + 7 + 2 * hf);
            }
        }
        if (IN(P0 + 10)) { PHASE_BEGIN();
            pg8::Gemm g{(const bf16_t*)(ws + WS_O), (const bf16_t*)(ws + WS_WO), 1024, 1024, 1024};
            pg8::StaticOrder S; S.init(T_, 1024, G, wg, 1024, 1024);
            pg8::EpiRes E{l == 0 ? p.in[0] : p.out, p.out, 1024};
            pg8::gemm_phase(ring, g, S, E);
            SEAM(P0 + 10);
        }
        if (IN(P0 + 11)) { PHASE_BEGIN(); norm_phase<2>(p, l, gw, NGW, lane); SEAM(P0 + 11); }
        if (IN(P0 + 12)) { PHASE_BEGIN();
            pg8::Gemm g{(const bf16_t*)(ws + WS_U), (const bf16_t*)(ws + WS_WR), 1024, 1024, 1024};
            pg8::StaticOrder S; S.init(T_, 256, G, wg, 1024, 1024);
            pg8::EpiRouter E{(float*)(ws + WS_LOGIT)};
            pg8::gemm_phase(ring, g, S, E);
            SEAM(P0 + 12);
        }
        if (IN(P0 + 13)) { PHASE_BEGIN(); route_phase(p, l, sm, wg, tid); SEAM(P0 + 13); }
        if (IN(P0 + 14)) { PHASE_BEGIN(); assign_phase(p, sm, wg, tid, wave, lane); SEAM(P0 + 14); }
        if (IN(P0 + 15)) { PHASE_BEGIN();
            const int* blke = (const int*)(ws + WS_BLKE); const int nb = __builtin_amdgcn_readfirstlane(blke[511]);
            pg8::Gemm g{(const bf16_t*)(ws + WS_XS), (const bf16_t*)(ws + WS_E1), 1024, 1024, 1024};
            pg8::MoeOrder<2> S{blke, nb, G, wg, (size_t)256 * 1024 * 2, (size_t)256 * 1024 * 2, (size_t)512 * 1024 * 2};
            pg8::EpiE1 E{(bf16_t*)(ws + WS_HDN)};
            pg8::gemm_phase(ring, g, S, E);
            SEAM(P0 + 15);
        }
        if (IN(P0 + 16)) { PHASE_BEGIN();
            const int* blke = (const int*)(ws + WS_BLKE); const int nb = __builtin_amdgcn_readfirstlane(blke[511]);
            pg8::Gemm g{(const bf16_t*)(ws + WS_HDN), (const bf16_t*)(ws + WS_E2), 256, 256, 256};
            pg8::MoeOrder<4> S{blke, nb, G, wg, (size_t)256 * 256 * 2, (size_t)256 * 256 * 2, (size_t)1024 * 256 * 2};
            pg8::EpiE2 E{(bf16_t*)(ws + WS_YS), (const int*)(ws + WS_SDST)};
            pg8::gemm_phase(ring, g, S, E);
            SEAM(P0 + 16);
        }
    }
    if (IN(DEPTH_ * PH_PER_LAYER)) { PHASE_BEGIN(); norm_phase<3>(p, 0, gw, NGW, lane); }
#undef IN
#undef SEAM
}

extern "C" void kernel_launch(void* const* d_in, const int* in_sizes, int n_in, void* d_out, int out_size, void* d_ws, size_t ws_size, hipStream_t stream) {
    static int grid = 0;
    if (grid == 0) {
        if (n_in != 19 || out_size != T_ * D_ || ws_size < WS_END) { fprintf(stderr, "kernel_launch: unexpected shapes (n_in %d, out %d, ws %zu); nothing launched\n", n_in, out_size, ws_size); grid = -1; return; }
        int dev = 0, cus = 0;
        if (hipGetDevice(&dev) != hipSuccess || hipDeviceGetAttribute(&cus, hipDeviceAttributeMultiprocessorCount, dev) != hipSuccess) { grid = -1; return; }
        if (hipFuncSetAttribute((const void*)mega, hipFuncAttributeMaxDynamicSharedMemorySize, LDS_BYTES) != hipSuccess) { fprintf(stderr, "kernel_launch: hipFuncSetAttribute failed\n"); grid = -1; return; }
        int per_cu = 0;
        if (hipOccupancyMaxActiveBlocksPerMultiprocessor(&per_cu, (const void*)mega, NTHREADS, LDS_BYTES) != hipSuccess || per_cu < 1) { fprintf(stderr, "kernel_launch: occupancy query reports %d blocks per CU\n", per_cu); }
        (void)hipGetLastError();
        grid = cus;
    }
    if (grid <= 0) return;
    Params p{};
    for (int i = 0; i < 19; ++i) p.in[i] = (const float*)d_in[i];
    p.out = (float*)d_out; p.ws = (unsigned char*)d_ws;
    for (int f = 0; f < 16; ++f) p.inv_freq[f] = (float)std::pow(10000.0, -(double)f / 16.0);
    for (int h = 0; h < 4; ++h) p.ret_lg2[h] = (float)std::log2(1.0 - std::exp2(-5.0 - (double)h));
    hipMemsetAsync((unsigned char*)d_ws + WS_CTL, 0, CTL_BYTES, stream);
#if MK_PER_PHASE
    for (int ph = 0; ph < N_PHASES; ++ph) { p.ph_lo = ph; p.ph_hi = ph + 1; hipLaunchKernelGGL(mega, dim3(grid), dim3(NTHREADS), LDS_BYTES, stream, p); }
#else
    p.ph_lo = 0; p.ph_hi = N_PHASES;
    hipLaunchKernelGGL(mega, dim3(grid), dim3(NTHREADS), LDS_BYTES, stream, p);
#endif
}
```

```cpp
#include <hip/hip_runtime.h>
#include <cstdio>
#include <cstdint>
#include <cmath>

#define LAS __attribute__((address_space(3)))
#define GAS __attribute__((address_space(1)))
typedef unsigned short bf16_t;
typedef short bf16x8 __attribute__((ext_vector_type(8)));
typedef float f32x4 __attribute__((ext_vector_type(4)));
typedef float f32x2 __attribute__((ext_vector_type(2)));
typedef unsigned u32x4 __attribute__((ext_vector_type(4)));
typedef unsigned u32x2 __attribute__((ext_vector_type(2)));

constexpr int T_ = 32768, D_ = 1024, S_ = 8192, NBATCH = 4, DEPTH_ = 2;
constexpr int ZW = 3072;
constexpr int Z_GQ = 0, Z_GK = 128, Z_GV = 256, Z_GR = 512, Z_GA = 768, Z_SQ = 784, Z_SK = 1040, Z_SV = 1168, Z_MQ = 1296, Z_MK = 1552, Z_MV = 1808,
              Z_RQ = 2064, Z_RK = 2192, Z_RV = 2320, Z_RG = 2576, Z_GATE = 2832, IN_W = 6928;
constexpr float LOG2E = 1.4426950408889634f;
constexpr float C2 = 0.125f * 1.4426950408889634f;
constexpr float RSQ32 = 0.17677669529663687f;
constexpr float NORM_EPS = 1e-6f;
constexpr int NEXP = 32, EHID = 256, MOE_BLK = 256, NSLOTBLK = 288, NSLOT = NSLOTBLK * MOE_BLK;

constexpr size_t MiB = 1u << 20;
constexpr size_t WS_WIN = 0, WS_WG = 6 * MiB, WS_WB = 14 * MiB, WS_WO = 16 * MiB, WS_WR = 18 * MiB, WS_E1 = 19 * MiB, WS_E2 = 51 * MiB;
constexpr size_t WS_YS = 68 * MiB;
constexpr size_t WS_GKV = 68 * MiB, WS_RKV = 84 * MiB, WS_GDEC = 92 * MiB, WS_KMEAN = 93 * MiB, WS_O = 108 * MiB;
constexpr size_t WS_U = 197 * MiB;
constexpr size_t WS_Z = 261 * MiB;
constexpr size_t WS_YH = 261 * MiB;
constexpr size_t WS_XS = 261 * MiB, WS_HDN = 405 * MiB;
constexpr size_t WS_LOGIT = 453 * MiB;
constexpr size_t WS_TOKE = 461 * MiB, WS_TOKW = WS_TOKE + 256 * 1024, WS_TOKR = WS_TOKW + 256 * 1024, WS_HIST = WS_TOKR + 256 * 1024,
                 WS_SDST = WS_HIST + 64 * 1024, WS_BLKE = WS_SDST + 512 * 1024;
constexpr size_t WS_MLIST = 94 * MiB, WS_MCNT = 102 * MiB;
constexpr size_t WS_PARTO = 453 * MiB, WS_PARTML = 501 * MiB;
constexpr size_t WS_CTL = 511 * MiB, CTL_BYTES = 64 * 1024;
constexpr size_t WS_END = 512 * MiB;
constexpr int YS_TRASH_ROW = 2 * T_;

__device__ __forceinline__ float bf2f(bf16_t v) { return __uint_as_float(((unsigned)v) << 16); }
__device__ __forceinline__ unsigned f2bf(float f) { unsigned u = __float_as_uint(f); return (u + 0x7fffu + ((u >> 16) & 1u)) >> 16; }
__device__ __forceinline__ unsigned pk2(float lo, float hi) { return f2bf(lo) | (f2bf(hi) << 16); }
__device__ __forceinline__ float sigmoidf_(float x) { return __builtin_amdgcn_rcpf(1.0f + __builtin_amdgcn_exp2f(-x * LOG2E)); }

namespace pg8 {
#define PG8_LAS __attribute__((address_space(3)))
constexpr int BM = 256, BK = 64, HALF = 128, HTB = HALF * BK * 2  , STAGE_BYTES = 8 * HTB, NXCD = 8, WGM = 8;

__host__ __device__ __forceinline__ int lds_byte(int r, int c) { const int st = (r >> 4) * 2 + (c >> 5), rr = r & 15, cc = c & 31, ob = rr * 64 + cc * 2; return st * 1024 + (ob ^ (((ob >> 9) & 1) << 5)); }
__host__ __device__ __forceinline__ void stage_rc(int b, int& R, int& C) { const int st = b / 1024, sb = b % 1024, swz = sb ^ (((sb >> 9) & 1) << 5); R = (st >> 1) * 16 + swz / 64; C = (st & 1) * 32 + (swz % 64) / 2; }
__host__ __device__ __forceinline__ int perm32(int rho) { const int n = rho >> 4, i = rho & 15; return 8 * (i >> 2) + 4 * n + (i & 3); }

struct Unit { int pm, pn; size_t aoff, boff; };
struct Gemm { const bf16_t* A; const bf16_t* Bt; };

template <int NM, int NN, int LDA, int LDB, int A_SHIFT = 30, int A_MUL = 0> struct StaticOrder {
    int G, c, pm_base;
    __device__ bool next(int i, Unit& u) const {
        constexpr int nwg = NM * NN; const int L = i * G + c; if (L >= nwg) return false;
        int wgid = L; { constexpr int q = nwg / NXCD, r = nwg % NXCD; const int xcd = wgid % NXCD, off = wgid / NXCD; wgid = (xcd < r ? xcd * (q + 1) : r * (q + 1) + (xcd - r) * q) + off; }
        constexpr int nig = WGM * NN; const int gid = wgid / nig, fm = gid * WGM, gsz = (NM - fm) < WGM ? (NM - fm) : WGM;
        u.pm = pm_base + fm + ((wgid % nig) % gsz); u.pn = (wgid % nig) / gsz;
        u.aoff = (size_t)u.pm * ((size_t)BM * LDA * 2) + (size_t)(u.pn >> A_SHIFT) * A_MUL; u.boff = (size_t)u.pn * ((size_t)BM * LDB * 2); return true;
    }
};
template <int NCOL> struct MoeOrder {
    const int* blk_e; int nb, G, c; size_t a_tstep, b_tstep, b_estep;
    __device__ bool next(int i, Unit& u) const {
        const int L = i * G + c; if (L >= nb * NCOL) return false;
        const int rb = L / NCOL, pn = L % NCOL; const int e = __builtin_amdgcn_readfirstlane(blk_e[rb]);
        u.pm = rb; u.pn = pn; u.aoff = (size_t)rb * a_tstep; u.boff = (size_t)e * b_estep + (size_t)pn * b_tstep; return true;
    }
};

__device__ __forceinline__ unsigned cvt_pk_bf16(float lo, float hi) { unsigned r; asm volatile("v_cvt_pk_bf16_f32 %0, %1, %2" : "=v"(r) : "v"(lo), "v"(hi)); return r; }

struct EpiBf16 {
    static constexpr bool PERM = true;
    bf16_t* O; int ldc; int row_sub;
    __device__ __forceinline__ void operator()(const f32x4 (&acc)[2][2][4][2], const Unit& u, int wr, int wc, int fr, int fq) const {
        const int row0 = u.pm * BM + wr * 64 + fr - row_sub; const int col0 = u.pn * BM + wc * 32 + 8 * fq;
#pragma unroll
        for (int ai = 0; ai < 2; ++ai)
#pragma unroll
            for (int m = 0; m < 4; ++m) { bf16_t* rowp = O + (size_t)(row0 + ai * HALF + m * 16) * ldc + col0;
#pragma unroll
                for (int bj = 0; bj < 2; ++bj) { const f32x4 v0 = acc[ai][bj][m][0], v1 = acc[ai][bj][m][1];
                    u32x4 w; w.x = cvt_pk_bf16(v0[0], v0[1]); w.y = cvt_pk_bf16(v0[2], v0[3]); w.z = cvt_pk_bf16(v1[0], v1[1]); w.w = cvt_pk_bf16(v1[2], v1[3]);
                    *(u32x4*)(rowp + bj * HALF) = w; } }
    }
};
struct EpiRes {
    static constexpr bool PERM = false;
    const float* base; float* C; int ldc;
    __device__ __forceinline__ void operator()(const f32x4 (&acc)[2][2][4][2], const Unit& u, int wr, int wc, int fr, int fq) const {
        const int row0 = u.pm * BM + wr * 64 + fr, col0 = u.pn * BM + wc * 32 + 4 * fq;
#pragma unroll
        for (int ai = 0; ai < 2; ++ai) { f32x4 b[4][2][2];
#pragma unroll
            for (int m = 0; m < 4; ++m) { const size_t off = (size_t)(row0 + ai * HALF + m * 16) * ldc + col0;
#pragma unroll
                for (int bj = 0; bj < 2; ++bj)
#pragma unroll
                    for (int n = 0; n < 2; ++n) b[m][bj][n] = *(const f32x4*)(base + off + bj * HALF + n * 16); }
#pragma unroll
            for (int m = 0; m < 4; ++m) { const size_t off = (size_t)(row0 + ai * HALF + m * 16) * ldc + col0;
#pragma unroll
                for (int bj = 0; bj < 2; ++bj)
#pragma unroll
                    for (int n = 0; n < 2; ++n) *(f32x4*)(C + off + bj * HALF + n * 16) = b[m][bj][n] + acc[ai][bj][m][n]; }
            asm volatile("" ::: "memory"); }
    }
};
struct EpiRouter {
    static constexpr bool PERM = false;
    float* L;
    __device__ __forceinline__ void operator()(const f32x4 (&acc)[2][2][4][2], const Unit& u, int wr, int wc, int fr, int fq) const {
        if (wc >= 2) return;
        const int row0 = u.pm * BM + wr * 64 + fr, col0 = wc * 32 + 4 * fq;
#pragma unroll
        for (int ai = 0; ai < 2; ++ai)
#pragma unroll
            for (int m = 0; m < 4; ++m) { float* rowp = L + (size_t)(row0 + ai * HALF + m * 16) * 64 + col0;
#pragma unroll
                for (int n = 0; n < 2; ++n) *(f32x4*)(rowp + n * 16) = acc[ai][0][m][n]; }
    }
};
struct EpiGate {
    static constexpr bool PERM = false;
    const bf16_t* Y; int y_row_sub; bf16_t* Mg;
    __device__ __forceinline__ void operator()(const f32x4 (&acc)[2][2][4][2], const Unit& u, int wr, int wc, int fr, int fq) const {
        const int row0 = u.pm * BM + wr * 64 + fr, d0 = u.pn * 64 + wc * 16 + fq * 4;
#pragma unroll
        for (int ai = 0; ai < 2; ++ai) { u32x2 yv[4][4];
#pragma unroll
            for (int m = 0; m < 4; ++m) { const bf16_t* yrow = Y + (size_t)(row0 + ai * HALF + m * 16 - y_row_sub) * 4096 + d0;
#pragma unroll
                for (int i = 0; i < 4; ++i) yv[m][i] = *(const u32x2*)(yrow + 1024 * i); }
#pragma unroll
            for (int m = 0; m < 4; ++m) { const int r = row0 + ai * HALF + m * 16;
                f32x4 s = (f32x4){0.f, 0.f, 0.f, 0.f};
#pragma unroll
                for (int i = 0; i < 4; ++i) { const f32x4 g = acc[ai][i >> 1][m][i & 1];
                    s[0] += sigmoidf_(g[0]) * __uint_as_float(yv[m][i].x << 16); s[1] += sigmoidf_(g[1]) * __uint_as_float(yv[m][i].x & 0xffff0000u);
                    s[2] += sigmoidf_(g[2]) * __uint_as_float(yv[m][i].y << 16); s[3] += sigmoidf_(g[3]) * __uint_as_float(yv[m][i].y & 0xffff0000u); }
                u32x2 w; w.x = cvt_pk_bf16(s[0], s[1]); w.y = cvt_pk_bf16(s[2], s[3]);
                *(u32x2*)(Mg + (size_t)r * 1024 + d0) = w; }
            asm volatile("" ::: "memory"); }
    }
};
struct EpiE1 {
    static constexpr bool PERM = true;
    bf16_t* H;
    __device__ __forceinline__ void operator()(const f32x4 (&acc)[2][2][4][2], const Unit& u, int wr, int wc, int fr, int fq) const {
        const int row0 = u.pm * BM + wr * 64 + fr, col0 = u.pn * 128 + wc * 32 + 8 * fq;
#pragma unroll
        for (int ai = 0; ai < 2; ++ai)
#pragma unroll
            for (int m = 0; m < 4; ++m) { bf16_t* rowp = H + (size_t)(row0 + ai * HALF + m * 16) * EHID + col0;
                const f32x4 a0 = acc[ai][0][m][0], a1 = acc[ai][0][m][1], b0 = acc[ai][1][m][0], b1 = acc[ai][1][m][1];
                f32x4 v0, v1;
#pragma unroll
                for (int j = 0; j < 4; ++j) { v0[j] = a0[j] * sigmoidf_(a0[j]) * b0[j]; v1[j] = a1[j] * sigmoidf_(a1[j]) * b1[j]; }
                u32x4 w; w.x = cvt_pk_bf16(v0[0], v0[1]); w.y = cvt_pk_bf16(v0[2], v0[3]); w.z = cvt_pk_bf16(v1[0], v1[1]); w.w = cvt_pk_bf16(v1[2], v1[3]);
                *(u32x4*)rowp = w; }
    }
};
struct EpiE2 {
    static constexpr bool PERM = true;
    bf16_t* YS; const int* sdst;
    __device__ __forceinline__ void operator()(const f32x4 (&acc)[2][2][4][2], const Unit& u, int wr, int wc, int fr, int fq) const {
        const int row0 = u.pm * BM + wr * 64 + fr, col0 = u.pn * BM + wc * 32 + 8 * fq;
#pragma unroll
        for (int ai = 0; ai < 2; ++ai)
#pragma unroll
            for (int m = 0; m < 4; ++m) { const int dst = sdst[row0 + ai * HALF + m * 16];
                bf16_t* rowp = YS + (size_t)dst * 1024 + col0;
#pragma unroll
                for (int bj = 0; bj < 2; ++bj) { const f32x4 v0 = acc[ai][bj][m][0], v1 = acc[ai][bj][m][1];
                    u32x4 w; w.x = cvt_pk_bf16(v0[0], v0[1]); w.y = cvt_pk_bf16(v0[2], v0[3]); w.z = cvt_pk_bf16(v1[0], v1[1]); w.w = cvt_pk_bf16(v1[2], v1[3]);
                    *(u32x4*)(rowp + bj * HALF) = w; }
                asm volatile("" ::: "memory"); }
    }
};

template <int LDA, int LDB, int K, class Epi, class Sched>
__device__ __forceinline__ void gemm_phase(PG8_LAS unsigned char* lds, const Gemm g, const Sched& S, const Epi& E) {
    int tid = threadIdx.x; asm volatile("" : "+v"(tid));
    const int wid = __builtin_amdgcn_readfirstlane(tid >> 6), lane = tid & 63, wr = wid >> 2, wc = wid & 3, fr = lane & 15, fq = lane >> 4;
    constexpr int nt = K / BK;
    unsigned voffA[2], voffB[2];
#pragma unroll
    for (int i = 0; i < 2; ++i) { int R, C; stage_rc(tid * 16 + i * 8192, R, C); const int Rb = Epi::PERM ? ((R & ~31) + perm32(R & 31)) : R;
        voffA[i] = (unsigned)(R * LDA + C) * 2u; voffB[i] = (unsigned)(Rb * LDB + C) * 2u; }
    constexpr size_t kstep = (size_t)(BK * 2);
    constexpr size_t hstepA = (size_t)HALF * LDA * 2, hstepB = (size_t)HALF * LDB * 2;
    const unsigned ldsw = (unsigned)wid * 1024u;
    const int aoff = lds_byte(wr * 64 + fr, fq * 8), boff = lds_byte(wc * 32 + fr, fq * 8);
#define PG8_SA(b, h) (((b) * 2 + (h)) * HTB)
#define PG8_SB(b, h) ((4 + (b) * 2 + (h)) * HTB)
#define PG8_STAGE(bufoff, gbase, voff) do { _Pragma("unroll") for (int _i = 0; _i < 2; ++_i) \
        __builtin_amdgcn_global_load_lds((const unsigned*)((const char*)(gbase) + (voff)[_i]), (PG8_LAS unsigned*)(lds + (bufoff) + ldsw + _i * 8192), 16, 0, 0); } while (0)
#define PG8_LDA(dst, b, h) do { _Pragma("unroll") for (int m = 0; m < 4; ++m) _Pragma("unroll") for (int k = 0; k < 2; ++k) dst[m][k] = *(const PG8_LAS bf16x8*)(lds + PG8_SA(b, h) + aoff + m * 2048 + k * 1024); } while (0)
#define PG8_LDB(dst, b, h) do { _Pragma("unroll") for (int n = 0; n < 2; ++n) _Pragma("unroll") for (int k = 0; k < 2; ++k) dst[n][k] = *(const PG8_LAS bf16x8*)(lds + PG8_SB(b, h) + boff + n * 2048 + k * 1024); } while (0)
#define PG8_MMA(ai, bj, At, Bt) do { __builtin_amdgcn_s_setprio(1); _Pragma("unroll") for (int m = 0; m < 4; ++m) _Pragma("unroll") for (int n = 0; n < 2; ++n) _Pragma("unroll") for (int k = 0; k < 2; ++k) \
        acc[ai][bj][m][n] = __builtin_amdgcn_mfma_f32_16x16x32_bf16(Bt[n][k], At[m][k], acc[ai][bj][m][n], 0, 0, 0); __builtin_amdgcn_s_setprio(0); } while (0)
#define PG8_WAIT_V(n) asm volatile("s_waitcnt vmcnt(" #n ")" ::: "memory")
#define PG8_WAIT_L(n) asm volatile("s_waitcnt lgkmcnt(" #n ")" ::: "memory")
#define PG8_BAR __builtin_amdgcn_s_barrier()
#define PG8_SCHED __builtin_amdgcn_sched_barrier(0)
    Unit cur, nxt; int ui = 0;
    if (!S.next(0, cur)) return;
    f32x4 acc[2][2][4][2];
#pragma unroll
    for (int a = 0; a < 2; ++a)
#pragma unroll
        for (int b = 0; b < 2; ++b)
#pragma unroll
            for (int m = 0; m < 4; ++m)
#pragma unroll
                for (int n = 0; n < 2; ++n) acc[a][b][m][n] = (f32x4){0.f, 0.f, 0.f, 0.f};
    bf16x8 At[4][2], B0[2][2], B1[2][2];
    const char* cA = (const char*)g.A + cur.aoff; const char* cB = (const char*)g.Bt + cur.boff;
    PG8_STAGE(PG8_SB(0, 0), cB, voffB); PG8_STAGE(PG8_SA(0, 0), cA, voffA); PG8_STAGE(PG8_SB(0, 1), cB + hstepB, voffB); PG8_STAGE(PG8_SA(0, 1), cA + hstepA, voffA);
    if (wr == 1) PG8_BAR;
    PG8_WAIT_V(4); PG8_BAR;
    PG8_STAGE(PG8_SB(1, 0), cB + kstep, voffB); PG8_STAGE(PG8_SA(1, 0), cA + kstep, voffA); PG8_STAGE(PG8_SB(1, 1), cB + hstepB + kstep, voffB);
    PG8_WAIT_V(6); PG8_BAR;
    for (;;) {
        const bool has_next = S.next(ui + 1, nxt);
        const char* nA = has_next ? (const char*)g.A + nxt.aoff : cA; const char* nB = has_next ? (const char*)g.Bt + nxt.boff : cB;
        for (int t = 0; t < nt; t += 2) {
            const bool last = (t == nt - 2);
            const char* a1 = cA + (size_t)(t + 1) * kstep;
            const char* a2 = last ? nA : cA + (size_t)(t + 2) * kstep; const char* b2 = last ? nB : cB + (size_t)(t + 2) * kstep;
            const char* a3 = a2 + kstep; const char* b3 = b2 + kstep;
            PG8_LDB(B0, 0, 0); PG8_SCHED; PG8_LDA(At, 0, 0); PG8_STAGE(PG8_SA(1, 1), a1 + hstepA, voffA);
            PG8_WAIT_L(8); PG8_BAR; PG8_WAIT_L(0); PG8_MMA(0, 0, At, B0); PG8_BAR; PG8_SCHED;
            PG8_LDB(B1, 0, 1); PG8_STAGE(PG8_SB(0, 0), b2, voffB);
            PG8_BAR; PG8_WAIT_L(0); PG8_MMA(0, 1, At, B1); PG8_BAR;
            PG8_LDA(At, 0, 1); PG8_STAGE(PG8_SA(0, 0), a2, voffA);
            PG8_BAR; PG8_WAIT_L(0); PG8_MMA(1, 0, At, B0); PG8_BAR; PG8_SCHED;
            PG8_STAGE(PG8_SB(0, 1), b2 + hstepB, voffB);
            PG8_WAIT_V(6); PG8_BAR; PG8_MMA(1, 1, At, B1); PG8_BAR;
            PG8_LDB(B0, 1, 0); PG8_SCHED; PG8_LDA(At, 1, 0); PG8_STAGE(PG8_SA(0, 1), a2 + hstepA, voffA);
            PG8_WAIT_L(8); PG8_BAR; PG8_WAIT_L(0); PG8_MMA(0, 0, At, B0); PG8_BAR; PG8_SCHED;
            PG8_LDB(B1, 1, 1); PG8_STAGE(PG8_SB(1, 0), b3, voffB);
            PG8_BAR; PG8_WAIT_L(0); PG8_MMA(0, 1, At, B1); PG8_BAR;
            PG8_LDA(At, 1, 1); PG8_STAGE(PG8_SA(1, 0), a3, voffA);
            PG8_BAR; PG8_WAIT_L(0); PG8_MMA(1, 0, At, B0); PG8_BAR; PG8_SCHED;
            PG8_STAGE(PG8_SB(1, 1), b3 + hstepB, voffB);
            PG8_WAIT_V(6); PG8_BAR; PG8_MMA(1, 1, At, B1); PG8_BAR;
        }
        E(acc, cur, wr, wc, fr, fq);
        if (!has_next) break;
#pragma unroll
        for (int a = 0; a < 2; ++a)
#pragma unroll
            for (int b = 0; b < 2; ++b)
#pragma unroll
                for (int m = 0; m < 4; ++m)
#pragma unroll
                    for (int n = 0; n < 2; ++n) acc[a][b][m][n] = (f32x4){0.f, 0.f, 0.f, 0.f};
        cur = nxt; cA = nA; cB = nB; ++ui;
    }
    PG8_WAIT_V(0);
    if (wr == 0) PG8_BAR;
    PG8_BAR;
#undef PG8_SA
#undef PG8_SB
#undef PG8_STAGE
#undef PG8_LDA
#undef PG8_LDB
#undef PG8_MMA
#undef PG8_WAIT_V
#undef PG8_WAIT_L
#undef PG8_BAR
#undef PG8_SCHED
}
}

#define XB_TMO      128
#define XB_XCNT(j)  (256  + 64 * (j))
#define XB_XSUB(j)  (1280 + 64 * (j))
#define XB_XGEN(j)  (2304 + 64 * (j))
#define XB_TOP      3328
#define XB_TOPGEN   3392
#define XCD_BAR_WORDS 3456
#define XB_SPIN_CAP (1u << 21)

__device__ __forceinline__ unsigned xb_ld(unsigned* p)              { return __hip_atomic_load(p, __ATOMIC_RELAXED, __HIP_MEMORY_SCOPE_AGENT); }
__device__ __forceinline__ unsigned xb_add(unsigned* p, unsigned v) { return __hip_atomic_fetch_add(p, v, __ATOMIC_RELAXED, __HIP_MEMORY_SCOPE_AGENT); }
__device__ __forceinline__ unsigned xb_xcc_id() { return (unsigned)__builtin_amdgcn_s_getreg((3 << 11) | 20) & 0xFu; }
#define XB_SPIN(cond, bar) do { unsigned _sp = 0; while (cond) { __builtin_amdgcn_s_sleep(1); \
    if ((++_sp & 255u) == 0u) { if (xb_ld(&(bar)[XB_TMO])) break; if (_sp > XB_SPIN_CAP) { atomicAdd(&(bar)[XB_TMO], 1u); break; } } } } while (0)

struct XcdBarrier {
    unsigned* bar; unsigned x;
    volatile LAS unsigned* st;
};

__device__ __forceinline__ XcdBarrier xcd_barrier_post(unsigned* bar, volatile LAS unsigned* st) {
    XcdBarrier b; b.bar = bar; b.x = xb_xcc_id(); b.st = st;
    if (threadIdx.x == 0) (void)xb_add(&bar[XB_XCNT(b.x)], 1u);
    return b;
}
__device__ __forceinline__ void xcd_barrier_complete(unsigned* bar, unsigned x, unsigned& nloc, unsigned& nx) {
    const unsigned G = gridDim.x * gridDim.y * gridDim.z;
    unsigned sum, cnt, mine, sp = 0u;
    for (;;) {
        sum = 0u; cnt = 0u; mine = 0u;
#pragma unroll
        for (unsigned j = 0; j < 16; ++j) { const unsigned c = xb_ld(&bar[XB_XCNT(j)]); sum += c; cnt += (c > 0u) ? 1u : 0u; mine = (j == x) ? c : mine; }
        if (sum == G) break;
        __builtin_amdgcn_s_sleep(1);
        if ((++sp & 255u) == 0u) { if (xb_ld(&bar[XB_TMO])) break; if (sp > XB_SPIN_CAP) { atomicAdd(&bar[XB_TMO], 1u); break; } }
    }
    nloc = mine > 0u ? mine : 1u; nx = cnt > 0u ? cnt : 1u;
}

__device__ __forceinline__ void xcd_barrier(const XcdBarrier& b) {
    asm volatile("s_waitcnt vmcnt(0)" ::: "memory");
    __syncthreads();
    if (threadIdx.x == 0) {
        unsigned* bar = b.bar;
        __builtin_amdgcn_s_waitcnt(0);
        unsigned nloc = b.st[0], nx = b.st[1];
        if (nloc == 0u) { xcd_barrier_complete(bar, b.x, nloc, nx); b.st[0] = nloc; b.st[1] = nx; }
        const unsigned old = xb_add(&bar[XB_XSUB(b.x)], 1u);
        const unsigned gen = old / nloc;
        if (old + 1u == (gen + 1u) * nloc) {
            __builtin_amdgcn_fence(__ATOMIC_RELEASE, "agent");
            asm volatile("s_waitcnt vmcnt(0)" ::: "memory");
            const unsigned og = xb_add(&bar[XB_TOP], 1u);
            const unsigned tg = og / nx;
            if (og + 1u == (tg + 1u) * nx) xb_add(&bar[XB_TOPGEN], 1u);
            else XB_SPIN(xb_ld(&bar[XB_TOPGEN]) == tg, bar);
            __builtin_amdgcn_fence(__ATOMIC_ACQUIRE, "agent");
            xb_add(&bar[XB_XGEN(b.x)], 1u);
            asm volatile("s_waitcnt vmcnt(0)" ::: "memory");
        } else {
            XB_SPIN(xb_ld(&bar[XB_XGEN(b.x)]) == gen, bar);
            __builtin_amdgcn_fence(__ATOMIC_ACQUIRE, "agent");
            asm volatile("s_waitcnt vmcnt(0)" ::: "memory");
        }
    }
    __syncthreads();
}

constexpr int NWAVES = 8, NTHREADS = 512;
constexpr int RING_BYTES = 131072;
constexpr int LDSCTL_OFF = 155648 - 1024, MISC_OFF = LDSCTL_OFF + 320;
constexpr int LDS_BYTES = 155648;

struct Params { const float* in[19]; float* out; unsigned char* ws; float inv_freq[16]; float ret_lg2[4]; int ph_lo, ph_hi; };
typedef const __attribute__((address_space(4))) Params& KPRef;

__device__ __forceinline__ float wave_sum(float v) {
#pragma unroll
    for (int o = 1; o < 64; o <<= 1) v += __shfl_xor(v, o);
    return v;
}
#define LDS_WAIT() asm volatile("s_waitcnt lgkmcnt(0)" ::: "memory")
#define MFMA16(a, b, c) __builtin_amdgcn_mfma_f32_16x16x32_bf16(a, b, c, 0, 0, 0)
typedef short v4i16_t __attribute__((ext_vector_type(4)));
__device__ __forceinline__ v4i16_t lds_tr16(const bf16_t* p) { return __builtin_amdgcn_ds_read_tr16_b64_v4i16((LAS v4i16_t*)(LAS unsigned char*)(unsigned char*)p); }
__device__ __forceinline__ bf16x8 tr_frag(const bf16_t* tile, int stride, int rowa, int rowb, int col0, int lane) {
    const int i = lane & 15, q = i >> 2, pp = i & 3;
    const v4i16_t lo = lds_tr16(tile + (rowa + q) * stride + col0 + 4 * pp), hi = lds_tr16(tile + (rowb + q) * stride + col0 + 4 * pp);
    return (bf16x8){lo[0], lo[1], lo[2], lo[3], hi[0], hi[1], hi[2], hi[3]};
}
__device__ __forceinline__ bf16x8 pack_p(const f32x4& a, const f32x4& b) {
    u32x4 w; w.x = pg8::cvt_pk_bf16(a[0], a[1]); w.y = pg8::cvt_pk_bf16(a[2], a[3]); w.z = pg8::cvt_pk_bf16(b[0], b[1]); w.w = pg8::cvt_pk_bf16(b[2], b[3]); return __builtin_bit_cast(bf16x8, w); }


template <class LD>
__device__ __forceinline__ void conv_item(LD ld, bf16_t* WT, int K, float* scr, int kb, int nb, int lane) {
    const int k0 = 64 * kb, n0 = 32 * nb;
#pragma unroll 8
    for (int i = 0; i < 32; ++i) { const int kk = 2 * i + (lane >> 5); scr[kk * 33 + (lane & 31)] = ld(k0 + kk, n0 + (lane & 31)); }
    LDS_WAIT();
    const int c = lane & 7;
#pragma unroll
    for (int j = 0; j < 4; ++j) { const int n = (lane >> 3) + 8 * j; const float* s = scr + (8 * c) * 33 + n;
        u32x4 o; o.x = pk2(s[0 * 33], s[1 * 33]); o.y = pk2(s[2 * 33], s[3 * 33]); o.z = pk2(s[4 * 33], s[5 * 33]); o.w = pk2(s[6 * 33], s[7 * 33]);
        *(u32x4*)(WT + (size_t)(n0 + n) * K + k0 + 8 * c) = o; }
    LDS_WAIT();
}

__device__ __forceinline__ void conv_phase(KPRef p, int l, unsigned char* lds, int gw, int NGW, int wave, int lane) {
    float* scr = (float*)(lds + wave * 16384);
    unsigned char* ws = p.ws;
    {
        const float* W = p.in[2] + (size_t)l * 1024 * IN_W; bf16_t* WT = (bf16_t*)(ws + WS_WIN);
        for (int it = gw; it < 16 * 96; it += NGW) { const int kb = it / 96, nb = it % 96;
            conv_item([&](int k, int n) -> float { if (n >= Z_GATE) return 0.f; float s = 1.f;
                if (n < Z_GK) s = RSQ32; else if (n >= Z_SQ && n < Z_SK) s = C2; else if (n >= Z_MQ && n < Z_MK) s = C2; else if (n >= Z_RK && n < Z_RV) s = RSQ32;
                return W[(size_t)k * IN_W + n] * s; }, WT, 1024, scr, kb, nb, lane); }
    }
    {
        const float* W = p.in[2] + (size_t)l * 1024 * IN_W; bf16_t* WT = (bf16_t*)(ws + WS_WG);
        for (int it = gw; it < 16 * 128; it += NGW) { const int kb = it / 128, nb = it % 128;
            conv_item([&](int k, int n) -> float { const int pn = n >> 8, c = n & 255, bj = (c >> 7) & 1, wc = (c >> 5) & 3, nn = (c >> 4) & 1, fq = (c >> 2) & 3, j = c & 3;
                const int col = Z_GATE + 1024 * (2 * bj + nn) + 64 * pn + 16 * wc + 4 * fq + j; return W[(size_t)k * IN_W + col]; }, WT, 1024, scr, kb, nb, lane); }
    }
    {
        for (int it = gw; it < 512; it += NGW) { const int i = it / 128, r = it % 128, kb = r / 32, nb = r % 32;
            const float* W = p.in[8] + (size_t)(l * 4 + i) * 256 * 1024; bf16_t* WT = (bf16_t*)(ws + WS_WB) + (size_t)i * 1024 * 256;
            conv_item([&](int k, int n) -> float { return W[(size_t)k * 1024 + n]; }, WT, 256, scr, kb, nb, lane); }
    }
    {
        const float* W = p.in[9] + (size_t)l * 1024 * 1024; bf16_t* WT = (bf16_t*)(ws + WS_WO);
        for (int it = gw; it < 16 * 32; it += NGW) { const int kb = it / 32, nb = it % 32;
            conv_item([&](int k, int n) -> float { return W[(size_t)k * 1024 + n]; }, WT, 1024, scr, kb, nb, lane); }
    }
    {
        const float* Wg = p.in[11] + (size_t)l * 1024 * 4; const float* We = p.in[13] + (size_t)l * 1024 * 32; bf16_t* WT = (bf16_t*)(ws + WS_WR);
        for (int it = gw; it < 16 * 8; it += NGW) { const int kb = it / 8, nb = it % 8;
            conv_item([&](int k, int n) -> float { if (n < 4) return Wg[k * 4 + n]; if (n < 36) return We[k * 32 + (n - 4)]; return 0.f; }, WT, 1024, scr, kb, nb, lane); }
    }
    {
        for (int it = gw; it < 32 * 256; it += NGW) { const int e = it / 256, r = it % 256, kb = r / 16, nb = r % 16;
            const int n0 = 32 * nb, pn = n0 >> 8, c0 = n0 & 255;
            const float* W = ((c0 < 128) ? p.in[15] : p.in[16]) + (size_t)(l * 32 + e) * 1024 * 256 + 128 * pn + (c0 & 127) - n0;
            bf16_t* WT = (bf16_t*)(ws + WS_E1) + (size_t)e * 512 * 1024;
            conv_item([&](int k, int n) -> float { return W[(size_t)k * 256 + n]; }, WT, 1024, scr, kb, nb, lane); }
    }
    {
        for (int it = gw; it < 32 * 128; it += NGW) { const int e = it / 128, r = it % 128, kb = r / 32, nb = r % 32;
            const float* W = p.in[17] + (size_t)(l * 32 + e) * 256 * 1024; bf16_t* WT = (bf16_t*)(ws + WS_E2) + (size_t)e * 1024 * 256;
            conv_item([&](int k, int n) -> float { return W[(size_t)k * 1024 + n]; }, WT, 256, scr, kb, nb, lane); }
    }
}

template <int MODE>
__device__ __forceinline__ void norm_phase(KPRef p, int l, int gw, int NGW, int lane) {
    const float* src = (MODE == 0) ? p.in[0] : p.out;
    const float* gain = (MODE == 3) ? p.in[18] : (MODE == 2 ? p.in[10] + l * 1024 : p.in[1] + l * 1024);
    const bf16_t* ys = (const bf16_t*)(p.ws + WS_YS); const float* tokw = (const float*)(p.ws + WS_TOKW);
    bf16_t* u = (bf16_t*)(p.ws + WS_U);
    f32x4 gg[4];
#pragma unroll
    for (int j = 0; j < 4; ++j) gg[j] = ((const f32x4*)gain)[lane + 64 * j];
    constexpr int NR = (MODE == 1 || MODE == 3) ? 2 : 4;
    for (int row0 = gw * NR; row0 < T_; row0 += NGW * NR) {
        f32x4 v[NR][4];
#pragma unroll
        for (int r = 0; r < NR; ++r) { const f32x4* xr = (const f32x4*)(src + (size_t)(row0 + r) * 1024) + lane;
#pragma unroll
            for (int j = 0; j < 4; ++j) v[r][j] = xr[64 * j]; }
        if (MODE == 1 || MODE == 3) {
            u32x2 ya[NR][4], yb[NR][4]; float w0[NR], w1[NR];
#pragma unroll
            for (int r = 0; r < NR; ++r) { const int row = row0 + r; w0[r] = tokw[2 * row]; w1[r] = tokw[2 * row + 1];
                const u32x2* y0 = (const u32x2*)(ys + (size_t)(2 * row) * 1024) + lane; const u32x2* y1 = (const u32x2*)(ys + (size_t)(2 * row + 1) * 1024) + lane;
#pragma unroll
                for (int j = 0; j < 4; ++j) { ya[r][j] = y0[64 * j]; yb[r][j] = y1[64 * j]; } }
#pragma unroll
            for (int r = 0; r < NR; ++r) {
#pragma unroll
                for (int j = 0; j < 4; ++j) { const u32x2 a = ya[r][j], b = yb[r][j];
                    v[r][j][0] += w0[r] * __uint_as_float(a.x << 16) + w1[r] * __uint_as_float(b.x << 16); v[r][j][1] += w0[r] * __uint_as_float(a.x & 0xffff0000u) + w1[r] * __uint_as_float(b.x & 0xffff0000u);
                    v[r][j][2] += w0[r] * __uint_as_float(a.y << 16) + w1[r] * __uint_as_float(b.y << 16); v[r][j][3] += w0[r] * __uint_as_float(a.y & 0xffff0000u) + w1[r] * __uint_as_float(b.y & 0xffff0000u); }
                if (MODE == 1) { f32x4* hr = (f32x4*)(p.out + (size_t)(row0 + r) * 1024) + lane;
#pragma unroll
                    for (int j = 0; j < 4; ++j) hr[64 * j] = v[r][j]; } }
        }
#pragma unroll
        for (int r = 0; r < NR; ++r) {
            float s = 0.f;
#pragma unroll
            for (int j = 0; j < 4; ++j) s += (v[r][j][0] * v[r][j][0] + v[r][j][1] * v[r][j][1]) + (v[r][j][2] * v[r][j][2] + v[r][j][3] * v[r][j][3]);
            const float rstd = rsqrtf(wave_sum(s) * (1.0f / 1024.0f) + NORM_EPS);
            if (MODE == 3) { f32x4* orow = (f32x4*)(p.out + (size_t)(row0 + r) * 1024) + lane;
#pragma unroll
                for (int j = 0; j < 4; ++j) orow[64 * j] = v[r][j] * rstd * gg[j];
            } else { u32x2* o8 = (u32x2*)(u + (size_t)(row0 + r) * 1024) + lane;
#pragma unroll
                for (int j = 0; j < 4; ++j) { const f32x4 o = v[r][j] * rstd * gg[j]; u32x2 w; w.x = pk2(o[0], o[1]); w.y = pk2(o[2], o[3]); o8[64 * j] = w; } }
        }
    }
}

constexpr int LA_QS = 0, LA_KS = 10240, LA_VS = 20480  , LA_KD = 38912  , LA_PS = 49152  , LA_PW = 58368, LA_PW_WAVE = 4352,
              LA_LA = 93184, LA_AS = 110080, LA_END = 118272;
__device__ __forceinline__ void unpack8f(float (&d)[8], u32x4 kk) {
    d[0] = __uint_as_float(kk.x << 16); d[1] = __uint_as_float(kk.x & 0xffff0000u); d[2] = __uint_as_float(kk.y << 16); d[3] = __uint_as_float(kk.y & 0xffff0000u);
    d[4] = __uint_as_float(kk.z << 16); d[5] = __uint_as_float(kk.z & 0xffff0000u); d[6] = __uint_as_float(kk.w << 16); d[7] = __uint_as_float(kk.w & 0xffff0000u); }
__device__ __forceinline__ u32x4 pack8f(const float (&o)[8]) { u32x4 w; w.x = pk2(o[0], o[1]); w.y = pk2(o[2], o[3]); w.z = pk2(o[4], o[5]); w.w = pk2(o[6], o[7]); return w; }

__device__ __forceinline__ void gla_decay_front(KPRef p, int l, unsigned char* lds, const bf16_t* zrow0, int h, int tid) {
    float* LA = (float*)(lds + LA_LA); float* AS = (float*)(lds + LA_AS);
    const int lane = tid & 63, wave = __builtin_amdgcn_readfirstlane(tid >> 6);
    if (tid < 256) { const int t = tid >> 1, hf = tid & 1; float a[8]; unpack8f(a, *(const u32x4*)(zrow0 + (size_t)t * ZW + Z_GA + 8 * hf));
#pragma unroll
        for (int e = 0; e < 8; ++e) AS[t * 16 + 8 * hf + e] = a[e]; }
    const int d = tid & 31; const float* wa2 = p.in[3] + (size_t)l * 16 * 128 + h * 32 + d; float wcol[16];
#pragma unroll
    for (int r = 0; r < 16; ++r) wcol[r] = wa2[r * 128];
    const float bias = p.in[4][l * 128 + h * 32 + d];
    __syncthreads();
#pragma unroll
    for (int i = 0; i < 8; ++i) { const int t = (tid >> 5) + 16 * i; float x = bias;
#pragma unroll
        for (int r = 0; r < 16; ++r) x += AS[t * 16 + r] * wcol[r];
        LA[t * 33 + d] = (fminf(x, 0.f) - log1pf(expf(-fabsf(x)))) * (1.0f / 16.0f); }
    __syncthreads();
#pragma unroll
    for (int s8 = 0; s8 < 8; ++s8) { const int s = wave * 8 + s8, ch = s >> 5, dd = s & 31; float v = LA[(64 * ch + lane) * 33 + dd];
#pragma unroll
        for (int o = 1; o < 64; o <<= 1) { const float t = __shfl_up(v, o); if (lane >= o) v += t; }
        LA[(64 * ch + lane) * 33 + dd] = v; }
    __syncthreads();
}
__device__ __forceinline__ void la_stage_v(unsigned char* lds, const bf16_t* zrow0, int vcol, int tid) {
    bf16_t* VS = (bf16_t*)(lds + LA_VS);
#pragma unroll
    for (int i = 0; i < 2; ++i) { const int c = tid + 512 * i, t = c >> 3, oct = c & 7; *(u32x4*)(VS + t * 72 + 8 * oct) = *(const u32x4*)(zrow0 + (size_t)t * ZW + vcol + 8 * oct); }
}
__device__ __forceinline__ void la_kv_mfma(unsigned char* lds, float* out0, int nch, int clen, int tid) {
    const bf16_t* KD = (const bf16_t*)(lds + LA_KD); const bf16_t* VS = (const bf16_t*)(lds + LA_VS);
    const int lane = tid & 63, wave = __builtin_amdgcn_readfirstlane(tid >> 6), c16 = lane & 15, g = lane >> 4;
    const int ntile = 8 * nch;
    for (int ti = wave; ti < ntile; ti += 8) { const int ch = ti >> 3, dt = (ti >> 2) & 1, et = ti & 3, tok0 = ch * clen;
        f32x4 acc = (f32x4){0.f, 0.f, 0.f, 0.f};
        for (int s = 0; s < clen / 32; ++s) { const int r0 = tok0 + 32 * s + 8 * g;
            acc = MFMA16(tr_frag(KD, 40, r0, r0 + 4, 16 * dt, lane), tr_frag(VS, 72, r0, r0 + 4, 16 * et, lane), acc); }
        float* o = out0 + (size_t)ch * 2048 + (16 * dt + 4 * g) * 64 + 16 * et + c16;
#pragma unroll
        for (int r = 0; r < 4; ++r) o[r * 64] = acc[r]; }
}
__device__ __forceinline__ void gla_kv_unit(KPRef p, int l, unsigned char* lds, int unit, int tid) {
    const int c = unit & 63, h = (unit >> 6) & 3, b = unit >> 8;
    const bf16_t* zrow0 = (const bf16_t*)(p.ws + WS_Z) + ((size_t)b * S_ + (size_t)c * 128) * ZW;
    gla_decay_front(p, l, lds, zrow0, h, tid);
    const float* LA = (const float*)(lds + LA_LA); bf16_t* KD = (bf16_t*)(lds + LA_KD);
    { const int t = tid >> 2, oct = tid & 3, ch = t >> 6; float k[8]; unpack8f(k, *(const u32x4*)(zrow0 + (size_t)t * ZW + Z_GK + h * 32 + 8 * oct));
#pragma unroll
      for (int e = 0; e < 8; ++e) { const int d = 8 * oct + e; k[e] *= expf(LA[(64 * ch + 63) * 33 + d] - LA[t * 33 + d]); }
      *(u32x4*)(KD + t * 40 + 8 * oct) = pack8f(k); }
    la_stage_v(lds, zrow0, Z_GV + h * 64, tid);
    __syncthreads();
    const int cu = ((b * 4 + h) * 128 + 2 * c);
    la_kv_mfma(lds, (float*)(p.ws + WS_GKV) + (size_t)cu * 2048, 2, 64, tid);
    if (tid < 64) { const int ch = tid >> 5, d = tid & 31; ((float*)(p.ws + WS_GDEC))[(size_t)(cu + ch) * 32 + d] = expf(LA[(64 * ch + 63) * 33 + d]); }
    __syncthreads();
}
__device__ __forceinline__ void la_out_mfma(unsigned char* lds, const bf16_t* zrow0, int gcol, const float* ng, bf16_t* orow0, int ocol, int clen, int tid) {
    const bf16_t* QS = (const bf16_t*)(lds + LA_QS); const bf16_t* KS = (const bf16_t*)(lds + LA_KS); const bf16_t* VS = (const bf16_t*)(lds + LA_VS); const bf16_t* PS = (const bf16_t*)(lds + LA_PS);
    const int lane = tid & 63, wave = __builtin_amdgcn_readfirstlane(tid >> 6), c16 = lane & 15, g = lane >> 4;
    float* PWf = (float*)(lds + LA_PW + wave * LA_PW_WAVE);
    const int ch = (clen == 64) ? (wave >> 2) : 0, kt0 = (clen == 64) ? 4 * ch : 0;
    const bf16x8 qa = *(const bf16x8*)(QS + (16 * wave + c16) * 40 + 8 * g);
    f32x4 O[4];
#pragma unroll
    for (int et = 0; et < 4; ++et) O[et] = MFMA16(qa, tr_frag(PS + ch * 32 * 72, 72, 8 * g, 8 * g + 4, 16 * et, lane), ((f32x4){0.f, 0.f, 0.f, 0.f}));
    for (int s = kt0 >> 1; s <= (wave >> 1); ++s) {
        f32x4 P0, P1;
        { const int kt = 2 * s; P0 = MFMA16(*(const bf16x8*)(KS + (16 * kt + c16) * 40 + 8 * g), qa, ((f32x4){0.f, 0.f, 0.f, 0.f}));
          if (kt == wave) {
#pragma unroll
              for (int r = 0; r < 4; ++r) if (4 * g + r > c16) P0[r] = 0.f; } }
        { const int kt = 2 * s + 1;
          if (kt <= wave) { P1 = MFMA16(*(const bf16x8*)(KS + (16 * kt + c16) * 40 + 8 * g), qa, ((f32x4){0.f, 0.f, 0.f, 0.f}));
            if (kt == wave) {
#pragma unroll
                for (int r = 0; r < 4; ++r) if (4 * g + r > c16) P1[r] = 0.f; } }
          else P1 = (f32x4){0.f, 0.f, 0.f, 0.f}; }
        const bf16x8 pa = pack_p(P0, P1);
#pragma unroll
        for (int et = 0; et < 4; ++et) O[et] = MFMA16(pa, tr_frag(VS, 72, 32 * s + 4 * g, 32 * s + 16 + 4 * g, 16 * et, lane), O[et]); }
    float rs[4];
#pragma unroll
    for (int r = 0; r < 4; ++r) { float ss = O[0][r] * O[0][r] + O[1][r] * O[1][r] + O[2][r] * O[2][r] + O[3][r] * O[3][r];
#pragma unroll
        for (int o = 1; o < 16; o <<= 1) ss += __shfl_xor(ss, o);
        rs[r] = rsqrtf(ss * (1.0f / 64.0f) + NORM_EPS); }
#pragma unroll
    for (int et = 0; et < 4; ++et)
#pragma unroll
        for (int r = 0; r < 4; ++r) PWf[(4 * g + r) * 68 + 16 * et + c16] = O[et][r] * rs[r];
    LDS_WAIT();
#pragma unroll
    for (int i = 0; i < 2; ++i) { const int cidx = lane + 64 * i, row = cidx >> 3, oct = cidx & 7; const int t = 16 * wave + row;
        float gt[8]; unpack8f(gt, *(const u32x4*)(zrow0 + (size_t)t * ZW + gcol + 8 * oct));
        const f32x4 o0 = *(const f32x4*)(PWf + row * 68 + 8 * oct), o1 = *(const f32x4*)(PWf + row * 68 + 8 * oct + 4), n0 = *(const f32x4*)(ng + 8 * oct), n1 = *(const f32x4*)(ng + 8 * oct + 4);
        float o[8];
#pragma unroll
        for (int e = 0; e < 4; ++e) { o[e] = o0[e] * n0[e] * (gt[e] * sigmoidf_(gt[e])); o[4 + e] = o1[e] * n1[e] * (gt[4 + e] * sigmoidf_(gt[4 + e])); }
        *(u32x4*)(orow0 + (size_t)t * 1024 + ocol + 8 * oct) = pack8f(o); }
    LDS_WAIT();
}
__device__ __forceinline__ void gla_out_unit(KPRef p, int l, unsigned char* lds, int unit, int tid) {
    const int c = unit & 63, h = (unit >> 6) & 3, b = unit >> 8;
    const size_t t0 = (size_t)b * S_ + (size_t)c * 128;
    const bf16_t* zrow0 = (const bf16_t*)(p.ws + WS_Z) + t0 * ZW;
    gla_decay_front(p, l, lds, zrow0, h, tid);
    const float* LA = (const float*)(lds + LA_LA); bf16_t* QS = (bf16_t*)(lds + LA_QS); bf16_t* KS = (bf16_t*)(lds + LA_KS); bf16_t* PS = (bf16_t*)(lds + LA_PS);
    { const int t = tid >> 2, oct = tid & 3; float k[8], q[8]; unpack8f(k, *(const u32x4*)(zrow0 + (size_t)t * ZW + Z_GK + h * 32 + 8 * oct)); unpack8f(q, *(const u32x4*)(zrow0 + (size_t)t * ZW + Z_GQ + h * 32 + 8 * oct));
#pragma unroll
      for (int e = 0; e < 8; ++e) { const float bb = LA[t * 33 + 8 * oct + e]; q[e] *= expf(bb); k[e] *= expf(-bb); }
      *(u32x4*)(QS + t * 40 + 8 * oct) = pack8f(q); *(u32x4*)(KS + t * 40 + 8 * oct) = pack8f(k); }
    la_stage_v(lds, zrow0, Z_GV + h * 64, tid);
    const int cu = ((b * 4 + h) * 128 + 2 * c); const float* prev = (const float*)(p.ws + WS_GKV) + (size_t)cu * 2048;
    { const int row = tid >> 3, oct = tid & 7; const f32x4 a = *(const f32x4*)(prev + row * 64 + 8 * oct), bq = *(const f32x4*)(prev + row * 64 + 8 * oct + 4);
      float o[8] = {a[0], a[1], a[2], a[3], bq[0], bq[1], bq[2], bq[3]}; *(u32x4*)(PS + row * 72 + 8 * oct) = pack8f(o); }
    __syncthreads();
    la_out_mfma(lds, zrow0, Z_GR + h * 64, p.in[5] + l * 64, (bf16_t*)(p.ws + WS_O) + t0 * 1024, 0 + h * 64, 64, tid);
    __syncthreads();
}
__device__ __forceinline__ void rope_cs(float pos, float invf, float& c, float& s) {
    const float ang = pos * invf; const double t = (double)ang * 0.15915494309189535; const float fr = (float)(t - floor(t));
    c = __builtin_amdgcn_cosf(fr); s = __builtin_amdgcn_sinf(fr);
}
__device__ __forceinline__ void ret_cs_table(KPRef p, unsigned char* lds, int pos0, int tid) {
    f32x2* CS = (f32x2*)(lds + LA_LA);
#pragma unroll
    for (int i = 0; i < 4; ++i) { const int idx = tid + 512 * i, t = idx >> 4, f = idx & 15; float c, s; rope_cs((float)(pos0 + t), p.inv_freq[f], c, s); CS[idx] = (f32x2){c, s}; }
}
__device__ __forceinline__ void ret_rot8(const unsigned char* lds, const bf16_t* src  , int t, int oct, float (&o)[8]) {
    const f32x2* CS = (const f32x2*)(lds + LA_LA); float own[8], oth[8]; unpack8f(own, *(const u32x4*)(src + 8 * oct)); unpack8f(oth, *(const u32x4*)(src + 8 * (oct ^ 2)));
#pragma unroll
    for (int e = 0; e < 8; ++e) { const f32x2 cs = CS[t * 16 + 8 * (oct & 1) + e]; o[e] = (oct < 2) ? (own[e] * cs[0] - oth[e] * cs[1]) : (oth[e] * cs[1] + own[e] * cs[0]); }
}
__device__ __forceinline__ void ret_kv_unit(KPRef p, unsigned char* lds, int unit, int tid) {
    const int n = unit & 63, bh = unit >> 6, h = bh & 3, b = bh >> 2;
    const bf16_t* zrow0 = (const bf16_t*)(p.ws + WS_Z) + ((size_t)b * S_ + (size_t)n * 128) * ZW;
    ret_cs_table(p, lds, n * 128, tid);
    la_stage_v(lds, zrow0, Z_RV + h * 64, tid);
    __syncthreads();
    bf16_t* KD = (bf16_t*)(lds + LA_KD); const float lg = p.ret_lg2[h];
    { const int t = tid >> 2, oct = tid & 3; float k[8]; ret_rot8(lds, zrow0 + (size_t)t * ZW + Z_RK + h * 32, t, oct, k); const float dk = __builtin_amdgcn_exp2f((float)(127 - t) * lg);
#pragma unroll
      for (int e = 0; e < 8; ++e) k[e] *= dk;
      *(u32x4*)(KD + t * 40 + 8 * oct) = pack8f(k); }
    __syncthreads();
    la_kv_mfma(lds, (float*)(p.ws + WS_RKV) + (size_t)unit * 2048, 1, 128, tid);
    __syncthreads();
}
__device__ __forceinline__ void ret_out_unit(KPRef p, int l, unsigned char* lds, int unit, int tid) {
    const int n = unit & 63, bh = unit >> 6, h = bh & 3, b = bh >> 2;
    const size_t t0 = (size_t)b * S_ + (size_t)n * 128;
    const bf16_t* zrow0 = (const bf16_t*)(p.ws + WS_Z) + t0 * ZW;
    ret_cs_table(p, lds, n * 128, tid);
    la_stage_v(lds, zrow0, Z_RV + h * 64, tid);
    const float lg = p.ret_lg2[h]; bf16_t* PS = (bf16_t*)(lds + LA_PS); const float* prev = (const float*)(p.ws + WS_RKV) + (size_t)unit * 2048; const float g1 = __builtin_amdgcn_exp2f(lg);
    if (tid < 256) { const int row = tid >> 3, oct = tid & 7; const f32x4 a = *(const f32x4*)(prev + row * 64 + 8 * oct), bq = *(const f32x4*)(prev + row * 64 + 8 * oct + 4);
      float o[8] = {a[0] * g1, a[1] * g1, a[2] * g1, a[3] * g1, bq[0] * g1, bq[1] * g1, bq[2] * g1, bq[3] * g1}; *(u32x4*)(PS + row * 72 + 8 * oct) = pack8f(o); }
    __syncthreads();
    bf16_t* QS = (bf16_t*)(lds + LA_QS); bf16_t* KS = (bf16_t*)(lds + LA_KS);
    { const int t = tid >> 2, oct = tid & 3; float k[8], q[8]; ret_rot8(lds, zrow0 + (size_t)t * ZW + Z_RK + h * 32, t, oct, k); ret_rot8(lds, zrow0 + (size_t)t * ZW + Z_RQ + h * 32, t, oct, q);
      const float dq = __builtin_amdgcn_exp2f((float)t * lg), dk = __builtin_amdgcn_exp2f(-(float)t * lg);
#pragma unroll
      for (int e = 0; e < 8; ++e) { q[e] *= dq; k[e] *= dk; }
      *(u32x4*)(QS + t * 40 + 8 * oct) = pack8f(q); *(u32x4*)(KS + t * 40 + 8 * oct) = pack8f(k); }
    __syncthreads();
    la_out_mfma(lds, zrow0, Z_RG + h * 64, p.in[7] + l * 64, (bf16_t*)(p.ws + WS_O) + t0 * 1024, 768 + h * 64, 128, tid);
    __syncthreads();
}

__device__ __forceinline__ void scan_phase(KPRef p, int wg, int tid) {
    if (wg < 64) {
        const int bh = wg >> 2, elem = (wg & 3) * 512 + tid, d = elem >> 6;
        float* base = (float*)(p.ws + WS_GKV) + (size_t)bh * 128 * 2048 + elem; const float* dec = (const float*)(p.ws + WS_GDEC) + (size_t)bh * 128 * 32 + d;
        float s = 0.f;
#pragma unroll 1
        for (int n0 = 0; n0 < 128; n0 += 32) { float kv[32], dc[32];
#pragma unroll
            for (int j = 0; j < 32; ++j) { kv[j] = base[(size_t)(n0 + j) * 2048]; dc[j] = dec[(n0 + j) * 32]; }
#pragma unroll
            for (int j = 0; j < 32; ++j) { base[(size_t)(n0 + j) * 2048] = s; s = dc[j] * s + kv[j]; } }
    } else if (wg < 128) {
        const int w2 = wg - 64, bh = w2 >> 2, h = bh & 3, elem = (w2 & 3) * 512 + tid;
        float* base = (float*)(p.ws + WS_RKV) + (size_t)bh * 64 * 2048 + elem; const float dc = __builtin_amdgcn_exp2f(128.0f * p.ret_lg2[h]);
        float s = 0.f;
#pragma unroll 1
        for (int n0 = 0; n0 < 64; n0 += 32) { float kv[32];
#pragma unroll
            for (int j = 0; j < 32; ++j) kv[j] = base[(size_t)(n0 + j) * 2048];
#pragma unroll
            for (int j = 0; j < 32; ++j) { base[(size_t)(n0 + j) * 2048] = s; s = dc * s + kv[j]; } }
    }
}

__device__ __forceinline__ void kmean_unit(KPRef p, float* sm, int unit, int tid) {
    const bf16_t* z = (const bf16_t*)(p.ws + WS_Z); const size_t t0 = (size_t)unit * 256;
    const int c = tid & 255, part = tid >> 8; float s = 0.f;
#pragma unroll 8
    for (int i = part * 128; i < part * 128 + 128; ++i) s += bf2f(z[(t0 + i) * ZW + Z_MK + c]);
    sm[tid] = s; __syncthreads();
    if (tid < 256) ((float*)(p.ws + WS_KMEAN))[(size_t)unit * 256 + tid] = (sm[tid] + sm[tid + 256]) * (1.0f / 256.0f);
    __syncthreads();
}

constexpr int AT_BUF = 65536  , AT_PW = 131072, AT_PW_WAVE = 2304, AT_WSF = 149504, LDS_MTAB = 151552;
__device__ __forceinline__ void att_dma(unsigned char* lds, int buf, const bf16_t* kg, const bf16_t* vg, int key_lo_valid, int tid) {
    const int lane = tid & 63, wave = __builtin_amdgcn_readfirstlane(tid >> 6);
#pragma unroll
    for (int i = 0; i < 4; ++i) { const int j = wave * 4 + i, row = 8 * j + (lane >> 3), pos = lane & 7; const int srow = row < key_lo_valid ? key_lo_valid : row;
        const size_t goff = (size_t)srow * ZW + 8 * (pos ^ (row & 7));
        __builtin_amdgcn_global_load_lds((const unsigned*)(kg + goff), (LAS unsigned*)(LAS unsigned char*)(lds + buf * AT_BUF + j * 1024), 16, 0, 0);
        __builtin_amdgcn_global_load_lds((const unsigned*)(vg + goff), (LAS unsigned*)(LAS unsigned char*)(lds + buf * AT_BUF + 32768 + j * 1024), 16, 0, 0); }
}
template <class Fn>
__device__ __forceinline__ void att_loadq(bf16x8 (&Q)[2][2], const Fn& F, int tid) {
    const int lane = tid & 63, wave = __builtin_amdgcn_readfirstlane(tid >> 6), c16 = lane & 15, g = lane >> 4;
#pragma unroll
    for (int rt = 0; rt < 2; ++rt) { const bf16_t* qp = F.rowptr(32 * wave + 16 * rt + c16); Q[rt][0] = *(const bf16x8*)(qp + 8 * g); Q[rt][1] = *(const bf16x8*)(qp + 32 + 8 * g); }
}
__device__ __forceinline__ bf16x8 tr_frag_sw(const unsigned char* tile, int rowa, int rowb, int col0, int lane) {
    const int i = lane & 15, q = i >> 2, pp = i & 3, ch = (col0 >> 3) + (pp >> 1), sub = (pp & 1) * 8, ra = rowa + q, rb = rowb + q;
    const v4i16_t lo = lds_tr16((const bf16_t*)(tile + ra * 128 + ((ch ^ (ra & 7)) << 4) + sub)), hi = lds_tr16((const bf16_t*)(tile + rb * 128 + ((ch ^ (rb & 7)) << 4) + sub));
    return (bf16x8){lo[0], lo[1], lo[2], lo[3], hi[0], hi[1], hi[2], hi[3]};
}
template <class Fn>
__device__ __forceinline__ void att_compute(unsigned char* lds, int buf, const Fn& F, bf16x8 (&Q)[2][2], const Fn& Fnext, bool has_next, int tid) {
    const int lane = tid & 63, wave = __builtin_amdgcn_readfirstlane(tid >> 6), c16 = lane & 15, g = lane >> 4;
    const unsigned char* KS = lds + buf * AT_BUF; const unsigned char* VS = KS + 32768; bf16_t* PW = (bf16_t*)(lds + AT_PW + wave * AT_PW_WAVE); float* WSF = (float*)(lds + AT_WSF + wave * 256);
#pragma unroll 1
    for (int rt = 0; rt < 2; ++rt) {
        const int rbase = 32 * wave + 16 * rt;
        const typename Fn::Pre pre = F.prefetch(rbase, lane);
        const bf16x8 qa0 = rt ? Q[1][0] : Q[0][0], qa1 = rt ? Q[1][1] : Q[0][1];
        f32x4 S[16]; float m = -1e30f;
#pragma unroll
        for (int ct = 0; ct < 16; ++ct) {
            if (F.live(rbase, ct)) {
                const int R = 16 * ct + c16; const unsigned char* kp = KS + R * 128;
                const bf16x8 k0 = *(const bf16x8*)(kp + ((g ^ (R & 7)) << 4)), k1 = *(const bf16x8*)(kp + (((4 + g) ^ (R & 7)) << 4));
                f32x4 acc = (f32x4){0.f, 0.f, 0.f, 0.f}; acc = MFMA16(k0, qa0, acc); acc = MFMA16(k1, qa1, acc);
                if (Fn::MASKED) {
#pragma unroll
                    for (int r = 0; r < 4; ++r) { int kk = 16 * ct + 4 * g + r; asm volatile("" : "+v"(kk), "+v"(acc[r]));
                        acc[r] += F.pen(rbase + c16, kk); } }
                m = fmaxf(fmaxf(m, fmaxf(acc[0], acc[1])), fmaxf(acc[2], acc[3])); S[ct] = acc;
            } else S[ct] = (f32x4){-1e30f, -1e30f, -1e30f, -1e30f};
        }
        m = fmaxf(m, __shfl_xor(m, 16)); m = fmaxf(m, __shfl_xor(m, 32));
        float l = 0.f;
#pragma unroll
        for (int ct = 0; ct < 16; ++ct) {
            if (F.live(rbase, ct)) {
#pragma unroll
                for (int r = 0; r < 4; ++r) { const float pr = __builtin_amdgcn_exp2f(S[ct][r] - m); S[ct][r] = pr; l += pr; }
            } else S[ct] = (f32x4){0.f, 0.f, 0.f, 0.f};
        }
        l += __shfl_xor(l, 16); l += __shfl_xor(l, 32);
        f32x4 O[4];
#pragma unroll
        for (int dt = 0; dt < 4; ++dt) O[dt] = (f32x4){0.f, 0.f, 0.f, 0.f};
#pragma unroll
        for (int s8 = 0; s8 < 8; ++s8) if (F.live(rbase, 2 * s8) || F.live(rbase, 2 * s8 + 1)) { const bf16x8 pa = pack_p(S[2 * s8], S[2 * s8 + 1]);
#pragma unroll
            for (int dt = 0; dt < 4; ++dt) O[dt] = MFMA16(pa, tr_frag_sw(VS, 32 * s8 + 4 * g, 32 * s8 + 16 + 4 * g, 16 * dt, lane), O[dt]); }
        if (rt == 1 && has_next) att_loadq(Q, Fnext, tid);
        float f[4];
#pragma unroll
        for (int r = 0; r < 4; ++r) { const float mr = __shfl(m, 4 * g + r), lr = __shfl(l, 4 * g + r); f[r] = F.scale(rbase + 4 * g + r, mr, lr, pre, r, WSF + (4 * g + r) * 4, c16 == 0); }
#pragma unroll
        for (int dt = 0; dt < 4; ++dt)
#pragma unroll
            for (int r = 0; r < 4; ++r) PW[(4 * g + r) * 72 + 16 * dt + c16] = (bf16_t)f2bf(O[dt][r] * f[r]);
        LDS_WAIT();
#pragma unroll
        for (int i = 0; i < 2; ++i) { const int ch = lane + 64 * i, row = ch >> 3, oct = ch & 7;
            const u32x4 v = *(const u32x4*)(PW + row * 72 + 8 * oct); F.store(rbase + row, oct, v, pre, i, WSF + row * 4); }
        LDS_WAIT();
    }
}
template <class Fn, class Gen>
__device__ __forceinline__ void attn_loop(unsigned char* lds, const Gen& G, int tid) {
    Fn Fc, Fx; const bf16_t* kg; const bf16_t* vg; int lo;
    bool have = G.get(0, Fc, kg, vg, lo);
    if (!have) return;
    bf16x8 Q[2][2];
    att_dma(lds, 0, kg, vg, lo, tid); att_loadq(Q, Fc, tid);
    int buf = 0;
    for (int i = 1; have; ++i) {
        asm volatile("s_waitcnt vmcnt(0)" ::: "memory");
        __syncthreads();
        const bool hn = G.get(i, Fx, kg, vg, lo);
        if (hn) att_dma(lds, buf ^ 1, kg, vg, lo, tid);
        att_compute(lds, buf, Fc, Q, Fx, hn, tid);
        Fc = Fx; have = hn; buf ^= 1;
    }
    asm volatile("s_waitcnt vmcnt(0)" ::: "memory");
    __syncthreads();
}
struct NoPre {};

struct SwaFn { typedef NoPre Pre; static constexpr bool MASKED = true;
    __device__ __forceinline__ bool live(int rbase, int ct) const { const int i0 = rbase & 127; return 16 * ct + 15 >= i0 + 1 && 16 * ct <= i0 + 143; } const bf16_t* z; bf16_t* ob; size_t tb; int q0, kvh; float sink2_0, sink2_1;
    __device__ __forceinline__ const bf16_t* rowptr(int row) const { return z + (tb + q0 + (row & 127)) * ZW + Z_SQ + (kvh * 2 + (row >> 7)) * 64; }
    __device__ __forceinline__ float pen(int row, int kk) const { const int d = (row & 127) + 128 - kk; return __int_as_float(((d | (127 - d) | (q0 - 128 + kk)) >> 31) & (int)0xF149F2CAu); }
    __device__ __forceinline__ NoPre prefetch(int, int) const { return NoPre{}; }
    __device__ __forceinline__ float scale(int row, float m, float l, const NoPre&, int, float*, bool) const { const float sk = (row >> 7) ? sink2_1 : sink2_0; const float M = fmaxf(m, sk), w0 = __builtin_amdgcn_exp2f(m - M);
        return w0 / (l * w0 + __builtin_amdgcn_exp2f(sk - M)); }
    __device__ __forceinline__ void store(int row, int oct, u32x4 v, const NoPre&, int, const float*) const { *(u32x4*)(ob + (tb + q0 + (row & 127)) * 1024 + 256 + (kvh * 2 + (row >> 7)) * 64 + 8 * oct) = v; }
};
struct SwaGen { const bf16_t* z; bf16_t* ob; const float* sinks; int wg, G;
    __device__ __forceinline__ bool get(int i, SwaFn& F, const bf16_t*& kg, const bf16_t*& vg, int& lo) const {
        const int unit = wg + i * G; if (unit >= 512) return false;
        const int qb = unit & 63, kvh = (unit >> 6) & 1, b = unit >> 7; const size_t tb = (size_t)b * S_; const int q0 = qb * 128;
        F = SwaFn{z, ob, tb, q0, kvh, sinks[kvh * 2] * LOG2E, sinks[kvh * 2 + 1] * LOG2E};
        const long kb = (long)tb + q0 - 128;
        kg = z + kb * ZW + Z_SK + kvh * 64; vg = z + kb * ZW + Z_SV + kvh * 64; lo = (q0 == 0) ? 128 : 0; return true; }
};

constexpr int ML_PER_BH = 126976;
__device__ __forceinline__ int ml_off(int j) { return 256 * (31 * j - (j * (j - 1)) / 2); }
__device__ __forceinline__ void moba_select(KPRef p, int wg, int tid) {
    const int gid = wg * NTHREADS + tid, t = gid >> 2, h = gid & 3, b = t >> 13, tl = t & 8191, blk = tl >> 8;
    const bf16_t* z = (const bf16_t*)(p.ws + WS_Z);
    float q[64];
    { const bf16_t* qp = z + (size_t)t * ZW + Z_MQ + h * 64;
#pragma unroll
      for (int c = 0; c < 8; ++c) { const u32x4 kk = *(const u32x4*)(qp + 8 * c);
        q[8 * c + 0] = __uint_as_float(kk.x << 16); q[8 * c + 1] = __uint_as_float(kk.x & 0xffff0000u); q[8 * c + 2] = __uint_as_float(kk.y << 16); q[8 * c + 3] = __uint_as_float(kk.y & 0xffff0000u);
        q[8 * c + 4] = __uint_as_float(kk.z << 16); q[8 * c + 5] = __uint_as_float(kk.z & 0xffff0000u); q[8 * c + 6] = __uint_as_float(kk.w << 16); q[8 * c + 7] = __uint_as_float(kk.w & 0xffff0000u); } }
    const float* km = (const float*)(p.ws + WS_KMEAN) + (size_t)b * 32 * 256 + h * 64;
    float v0 = -3e38f, v1 = -3e38f, v2 = -3e38f; int i0 = -1, i1 = -1, i2 = -1;
#pragma unroll 1
    for (int nb = 0; nb < blk; ++nb) { const f32x4* kr = (const f32x4*)(km + nb * 256); float s = 0.f;
#pragma unroll
        for (int c = 0; c < 16; ++c) { const f32x4 kv = kr[c]; s += q[4 * c] * kv[0] + q[4 * c + 1] * kv[1] + q[4 * c + 2] * kv[2] + q[4 * c + 3] * kv[3]; }
        if (s > v0) { v2 = v1; i2 = i1; v1 = v0; i1 = i0; v0 = s; i0 = nb; } else if (s > v1) { v2 = v1; i2 = i1; v1 = s; i1 = nb; } else if (s > v2) { v2 = s; i2 = nb; } }
    int* cnt = (int*)(p.ws + WS_MCNT) + (b * 4 + h) * 32; int* lst = (int*)(p.ws + WS_MLIST) + (size_t)(b * 4 + h) * ML_PER_BH; f32x2* pml = (f32x2*)(p.ws + WS_PARTML) + (size_t)gid * 3;
#pragma unroll
    for (int s3 = 0; s3 < 3; ++s3) { const int sb = (s3 == 0) ? i0 : (s3 == 1 ? i1 : i2);
        if (sb >= 0) { const int pos = atomicAdd(cnt + sb, 1); lst[ml_off(sb) + pos] = tl | (s3 << 13); }
        else pml[s3] = (f32x2){-1e30f, 0.f}; }
}
struct MobaSelFn { typedef NoPre Pre; static constexpr bool MASKED = false;
    __device__ __forceinline__ bool live(int, int) const { return true; } const bf16_t* z; const int* lst; bf16_t* po; f32x2* pml; size_t tb; int h, n_valid;
    __device__ __forceinline__ int entry(int row) const { return lst[row < n_valid ? row : 0]; }
    __device__ __forceinline__ const bf16_t* rowptr(int row) const { return z + (tb + (entry(row) & 8191)) * ZW + Z_MQ + h * 64; }
    __device__ __forceinline__ float pen(int, int) const { return 0.f; }
    __device__ __forceinline__ NoPre prefetch(int, int) const { return NoPre{}; }
    __device__ __forceinline__ size_t pidx(int e) const { return ((tb + (e & 8191)) * 4 + h) * 3 + (e >> 13); }
    __device__ __forceinline__ float scale(int row, float m, float l, const NoPre&, int, float*, bool writer) const { if (writer && row < n_valid) pml[pidx(lst[row])] = (f32x2){m, l}; return 1.0f / l; }
    __device__ __forceinline__ void store(int row, int oct, u32x4 v, const NoPre&, int, const float*) const { if (row < n_valid) *(u32x4*)(po + pidx(lst[row]) * 64 + 8 * oct) = v; }
};
__device__ __forceinline__ void moba_sel_table(KPRef p, unsigned char* lds, int tid) {
    int* tab = (int*)(lds + LDS_MTAB); const int lane = tid & 63, wave = tid >> 6;
    const int cnt = ((const int*)(p.ws + WS_MCNT))[tid]; int v = (cnt + 255) >> 8;
    const int own = v;
#pragma unroll
    for (int o = 1; o < 64; o <<= 1) { const int t = __shfl_up(v, o); if (lane >= o) v += t; }
    if (lane == 63) tab[520 + wave] = v;
    __syncthreads();
    int base = 0;
    for (int w = 0; w < wave; ++w) base += tab[520 + w];
    tab[tid] = base + v - own;
    if (tid == 511) tab[512] = base + v;
    __syncthreads();
}
struct MobaSelGen { const bf16_t* z; const int* lists; const int* cnts; bf16_t* po; f32x2* pml; const int* tab; int wg, G;
    __device__ __forceinline__ bool get(int i, MobaSelFn& F, const bf16_t*& kg, const bf16_t*& vg, int& lo) const {
        const int u = wg + i * G; if (u >= tab[512]) return false;
        int lo_ = 0, hi_ = 511;
        while (lo_ < hi_) { const int mid = (lo_ + hi_ + 1) >> 1; if (tab[mid] <= u) lo_ = mid; else hi_ = mid - 1; }
        const int k = __builtin_amdgcn_readfirstlane(lo_), c = u - tab[k], bh = k >> 5, j = k & 31, b = bh >> 2, h = bh & 3;
        const int cnt = __builtin_amdgcn_readfirstlane(cnts[k]); const int nv = cnt - c * 256; const size_t tb = (size_t)b * S_;
        F = MobaSelFn{z, lists + (size_t)bh * ML_PER_BH + ml_off(j) + c * 256, po, pml, tb, h, nv < 256 ? nv : 256};
        kg = z + (tb + j * 256) * ZW + Z_MK + h * 64; vg = z + (tb + j * 256) * ZW + Z_MV + h * 64; lo = 0; return true; }
};
struct MobaOwnPre { f32x2 ml[4][3]; };
struct MobaOwnFn { typedef MobaOwnPre Pre; static constexpr bool MASKED = true;
    __device__ __forceinline__ bool live(int rbase, int ct) const { return 16 * ct <= rbase + 15; } const bf16_t* z; bf16_t* ob; const bf16_t* po; const f32x2* pml; size_t t0; int h;
    __device__ __forceinline__ const bf16_t* rowptr(int row) const { return z + (t0 + row) * ZW + Z_MQ + h * 64; }
    __device__ __forceinline__ float pen(int row, int kk) const { return __int_as_float(((row - kk) >> 31) & (int)0xF149F2CAu); }
    __device__ __forceinline__ MobaOwnPre prefetch(int rbase, int lane) const { MobaOwnPre P; const int g = lane >> 4;
#pragma unroll
        for (int r = 0; r < 4; ++r) { const f32x2* ml = pml + ((t0 + rbase + 4 * g + r) * 4 + h) * 3;
#pragma unroll
            for (int s = 0; s < 3; ++s) P.ml[r][s] = ml[s]; }
        return P; }
    __device__ __forceinline__ float scale(int row, float m, float l, const MobaOwnPre& P, int r, float* wsf, bool writer) const {
        const f32x2 a = P.ml[r][0], b = P.ml[r][1], c = P.ml[r][2];
        const float M = fmaxf(fmaxf(m, a[0]), fmaxf(b[0], c[0]));
        const float w0 = __builtin_amdgcn_exp2f(m - M), wa = a[1] * __builtin_amdgcn_exp2f(a[0] - M), wb = b[1] * __builtin_amdgcn_exp2f(b[0] - M), wc = c[1] * __builtin_amdgcn_exp2f(c[0] - M);
        const float inv = 1.0f / (l * w0 + wa + wb + wc);
        if (writer) { wsf[0] = wa * inv; wsf[1] = wb * inv; wsf[2] = wc * inv; }
        return w0 * inv; }
    __device__ __forceinline__ void store(int row, int oct, u32x4 v, const MobaOwnPre&, int, const float* wsf) const {
        float o[8]; unpack8f(o, v); const bf16_t* pr = po + (((t0 + row) * 4 + h) * 3) * 64 + 8 * oct;
        u32x4 pc[3];
#pragma unroll
        for (int s = 0; s < 3; ++s) pc[s] = (wsf[s] != 0.f) ? *(const u32x4*)(pr + s * 64) : (u32x4){0u, 0u, 0u, 0u};
#pragma unroll
        for (int s = 0; s < 3; ++s) { const float w = wsf[s]; float q[8]; unpack8f(q, pc[s]);
#pragma unroll
            for (int e = 0; e < 8; ++e) o[e] += w * q[e]; }
        *(u32x4*)(ob + (t0 + row) * 1024 + 512 + h * 64 + 8 * oct) = pack8f(o); }
};
struct MobaOwnGen { const bf16_t* z; bf16_t* ob; const bf16_t* po; const f32x2* pml; int wg, G;
    __device__ __forceinline__ bool get(int i, MobaOwnFn& F, const bf16_t*& kg, const bf16_t*& vg, int& lo) const {
        const int unit = wg + i * G; if (unit >= 512) return false;
        const int qb = unit & 31, h = (unit >> 5) & 3, b = unit >> 7; const size_t t0 = (size_t)b * S_ + (size_t)qb * 256;
        F = MobaOwnFn{z, ob, po, pml, t0, h}; kg = z + t0 * ZW + Z_MK + h * 64; vg = z + t0 * ZW + Z_MV + h * 64; lo = 0; return true; }
};

__device__ __forceinline__ void route_phase(KPRef p, int l, float* sm, int wg, int tid) {
    int* se = (int*)sm;
    int* toke = (int*)(p.ws + WS_TOKE); float* tokw = (float*)(p.ws + WS_TOKW); int* tokr = (int*)(p.ws + WS_TOKR); int* hist = (int*)(p.ws + WS_HIST); int* sdst = (int*)(p.ws + WS_SDST);
    if (tid < 128) { const int t = wg * 128 + tid; const float* lg = (const float*)(p.ws + WS_LOGIT) + (size_t)t * 64; const float* bg = p.in[12] + l * 4; const float* be = p.in[14] + l * 32;
        float g0 = lg[0] + bg[0], g1 = lg[1] + bg[1], g2 = lg[2] + bg[2], g3 = lg[3] + bg[3];
        int gs = 0; float gm = g0; if (g1 > gm) { gm = g1; gs = 1; } if (g2 > gm) { gm = g2; gs = 2; } if (g3 > gm) { gm = g3; gs = 3; }
        const float gw_ = 1.0f / (expf(g0 - gm) + expf(g1 - gm) + expf(g2 - gm) + expf(g3 - gm));
        float v0 = -3e38f, v1 = -3e38f; int i0 = 0, i1 = 0;
#pragma unroll
        for (int j = 0; j < 8; ++j) { const float s = lg[4 + 8 * gs + j] + be[8 * gs + j]; if (s > v0) { v1 = v0; i1 = i0; v0 = s; i0 = j; } else if (s > v1) { v1 = s; i1 = j; } }
        const float e1 = expf(v1 - v0), w0 = 1.0f / (1.0f + e1), w1 = e1 * w0;
        const int ea = 8 * gs + i0, eb = 8 * gs + i1;
        se[2 * tid] = ea; se[2 * tid + 1] = eb; toke[2 * t] = ea; toke[2 * t + 1] = eb; tokw[2 * t] = w0 * gw_; tokw[2 * t + 1] = w1 * gw_; }
    __syncthreads();
    if (tid < 256) { const int e = se[tid]; int r = 0;
#pragma unroll 4
        for (int a = 0; a < tid; ++a) r += (se[a] == e) ? 1 : 0; tokr[wg * 256 + tid] = r; }
    if (tid >= 256 && tid < 288) { const int e = tid - 256; int c = 0;
#pragma unroll 4
        for (int a = 0; a < 256; ++a) c += (se[a] == e) ? 1 : 0; hist[wg * 32 + e] = c; }
    for (int i = tid; i < NSLOTBLK; i += NTHREADS) sdst[wg * NSLOTBLK + i] = YS_TRASH_ROW;
    __syncthreads();
}
__device__ __forceinline__ void assign_phase(KPRef p, float* sm, int wg, int tid, int wave, int lane) {
    int* cnt = (int*)sm, *bas = cnt + 32, *pend = cnt + 64, *slot_of = cnt + 128;
    const int* hist = (const int*)(p.ws + WS_HIST); const int* toke = (const int*)(p.ws + WS_TOKE); const int* tokr = (const int*)(p.ws + WS_TOKR);
    int* sdst = (int*)(p.ws + WS_SDST); int* blke = (int*)(p.ws + WS_BLKE);
    if (tid < 32) { int c = 0, bb = 0;
#pragma unroll 8
        for (int w = 0; w < 256; ++w) { const int v = hist[w * 32 + tid]; c += v; if (w < wg) bb += v; } cnt[tid] = c; bas[tid] = bb; }
    __syncthreads();
    if (tid == 0) { int run = 0; for (int e = 0; e < 32; ++e) { const int pad = ((cnt[e] + 255) >> 8) << 8; bas[e] += run; run += pad; pend[e] = run; } }
    __syncthreads();
    if (wg == 0) { if (tid < NSLOTBLK) { int e = 0; for (int k = 0; k < 32; ++k) e += (pend[k] <= tid * 256) ? 1 : 0; blke[tid] = e > 31 ? 31 : e; } if (tid == 0) blke[511] = pend[31] >> 8; }
    if (tid < 256) { const int a = wg * 256 + tid; const int e = toke[a]; const int slot = bas[e] + tokr[a]; sdst[slot] = a; slot_of[tid] = slot; }
    __syncthreads();
    const bf16_t* u2 = (const bf16_t*)(p.ws + WS_U); bf16_t* xs = (bf16_t*)(p.ws + WS_XS);
    for (int a = wave; a < 256; a += NWAVES) { const u32x4* src = (const u32x4*)(u2 + (size_t)(wg * 128 + (a >> 1)) * 1024); u32x4* dst = (u32x4*)(xs + (size_t)slot_of[a] * 1024);
        dst[lane] = src[lane]; dst[lane + 64] = src[lane + 64]; }
    __syncthreads();
}

#ifndef MK_PER_PHASE
#define MK_PER_PHASE 0
#endif
constexpr int PH_PER_LAYER = 17, N_PHASES = DEPTH_ * PH_PER_LAYER + 1;
constexpr int CW_BAR = 1024;

__global__ void __launch_bounds__(NTHREADS, 2) mega(Params p_unused) {
    extern __shared__ __attribute__((aligned(16))) unsigned char lds[];
    const int tid0 = threadIdx.x;
    const int G = gridDim.x, wg = blockIdx.x, NGW = G * NWAVES;
#define PHASE_BEGIN() KPRef p = *KP(); unsigned char* ws = p.ws; (void)ws; int tid = threadIdx.x; asm volatile("" : "+v"(tid)); const int lane = tid & 63, wave = __builtin_amdgcn_readfirstlane(tid >> 6), gw = wg * NWAVES + wave; (void)lane; (void)gw
    volatile LAS unsigned* MISC = (volatile LAS unsigned*)((LAS unsigned char*)lds + MISC_OFF);
    for (int u = tid0; u < (LDS_BYTES - LDSCTL_OFF) / 4; u += NTHREADS) ((LAS unsigned*)((LAS unsigned char*)lds + LDSCTL_OFF))[u] = 0u;
    __syncthreads();
#define KP() ({ const __attribute__((address_space(4))) Params* _k = (const __attribute__((address_space(4))) Params*)__builtin_amdgcn_kernarg_segment_ptr(); asm volatile("" : "+s"(_k)); _k; })
    unsigned* ctl; { const __attribute__((address_space(4))) Params* k0 = KP(); ctl = (unsigned*)(k0->ws + WS_CTL); }
    XcdBarrier bar = xcd_barrier_post(ctl + CW_BAR, MISC + 8);
    int lo, hi; { const __attribute__((address_space(4))) Params* k0 = KP(); lo = k0->ph_lo; hi = k0->ph_hi; }
    float* sm = (float*)lds;
    PG8_LAS unsigned char* ring = (PG8_LAS unsigned char*)lds;
#ifndef PH_MASK
#define PH_MASK 0x3ffffu
#endif
#define IN(k) ((((PH_MASK) >> ((k) == DEPTH_ * PH_PER_LAYER ? 17 : ((k) % PH_PER_LAYER))) & 1u) && lo <= (k) && (k) < hi)
#define SEAM(k) do { if ((k) + 1 < hi) xcd_barrier(bar); } while (0)
#ifndef REPEAT_MASK
#define REPEAT_MASK 0u
#endif
#ifndef URM
#define URM 0u
#endif
#define UREP(bit) for (int ur_ = 0; ur_ < ((((URM) >> (bit)) & 1u) ? 2 : 1); ++ur_)
#ifndef REPEAT_L0
#define REPEAT_L0 0u
#endif
#define NREP(k) (((((REPEAT_MASK) >> ((k) % PH_PER_LAYER)) & 1u) || ((((REPEAT_L0) >> ((k) % PH_PER_LAYER)) & 1u) && (k) < PH_PER_LAYER)) ? 2 : 1)

    for (int l = 0; l < DEPTH_; ++l) {
        const int P0 = l * PH_PER_LAYER;
        if (IN(P0 + 0)) for (int rep_ = 0; rep_ < NREP(P0 + 0); ++rep_) { PHASE_BEGIN();
            UREP(8) conv_phase(p, l, lds, gw, NGW, wave, lane);
            if (l == 0) norm_phase<0>(p, l, gw, NGW, lane); else norm_phase<1>(p, l, gw, NGW, lane);
            SEAM(P0 + 0);
        }
        if (IN(P0 + 1)) for (int rep_ = 0; rep_ < NREP(P0 + 1); ++rep_) { PHASE_BEGIN();
            pg8::Gemm g{(const bf16_t*)(ws + WS_U), (const bf16_t*)(ws + WS_WIN)};
            pg8::StaticOrder<T_ / 256, ZW / 256, 1024, 1024> S{G, wg, 0};
            pg8::EpiBf16 E{(bf16_t*)(ws + WS_Z), ZW, 0};
            pg8::gemm_phase<1024, 1024, 1024>(ring, g, S, E);
            SEAM(P0 + 1);
        }
        if (IN(P0 + 2)) for (int rep_ = 0; rep_ < NREP(P0 + 2); ++rep_) { PHASE_BEGIN();
            if (wg == 0) { int* cnt = (int*)(ws + WS_MCNT); cnt[tid] = 0; }
            UREP(0) for (int u = wg; u < 1024; u += G) gla_kv_unit(p, l, lds, u, tid);
            UREP(1) for (int u = wg; u < 1024; u += G) ret_kv_unit(p, lds, u, tid);
            UREP(2) for (int u = wg; u < 128; u += G) kmean_unit(p, sm, u, tid);
            UREP(3) { SwaGen SG{(const bf16_t*)(ws + WS_Z), (bf16_t*)(ws + WS_O), p.in[6] + l * 4, wg, G}; attn_loop<SwaFn>(lds, SG, tid); }
            SEAM(P0 + 2);
        }
        if (IN(P0 + 3)) for (int rep_ = 0; rep_ < NREP(P0 + 3); ++rep_) { PHASE_BEGIN(); moba_select(p, wg, tid); scan_phase(p, wg, tid); SEAM(P0 + 3); }
        if (IN(P0 + 4)) for (int rep_ = 0; rep_ < NREP(P0 + 4); ++rep_) { PHASE_BEGIN();
            UREP(4) for (int u = wg; u < 1024; u += G) gla_out_unit(p, l, lds, u, tid);
            UREP(5) for (int u = wg; u < 1024; u += G) ret_out_unit(p, l, lds, u, tid);
            UREP(6) { moba_sel_table(p, lds, tid); MobaSelGen MG{(const bf16_t*)(ws + WS_Z), (const int*)(ws + WS_MLIST), (const int*)(ws + WS_MCNT), (bf16_t*)(ws + WS_PARTO), (f32x2*)(ws + WS_PARTML), (const int*)(lds + LDS_MTAB), wg, G}; attn_loop<MobaSelFn>(lds, MG, tid); }
            SEAM(P0 + 4);
        }
        if (IN(P0 + 5)) for (int rep_ = 0; rep_ < NREP(P0 + 5); ++rep_) { PHASE_BEGIN();
            UREP(7) { MobaOwnGen OG{(const bf16_t*)(ws + WS_Z), (bf16_t*)(ws + WS_O), (const bf16_t*)(ws + WS_PARTO), (const f32x2*)(ws + WS_PARTML), wg, G}; attn_loop<MobaOwnFn>(lds, OG, tid); }
            SEAM(P0 + 5);
        }
        for (int hf = 0; hf < 2; ++hf) {
            if (IN(P0 + 6 + 2 * hf)) for (int rep_ = 0; rep_ < NREP(P0 + 6 + 2 * hf); ++rep_) { PHASE_BEGIN();
                pg8::Gemm g{(const bf16_t*)(ws + WS_O), (const bf16_t*)(ws + WS_WB)};
                pg8::StaticOrder<T_ / 512, 16, 1024, 256, 2, 512> S{G, wg, 64 * hf};
                pg8::EpiBf16 E{(bf16_t*)(ws + WS_YH), 4096, 16384 * hf};
                pg8::gemm_phase<1024, 256, 256>(ring, g, S, E);
                SEAM(P0 + 6 + 2 * hf);
            }
            if (IN(P0 + 7 + 2 * hf)) for (int rep_ = 0; rep_ < NREP(P0 + 7 + 2 * hf); ++rep_) { PHASE_BEGIN();
                pg8::Gemm g{(const bf16_t*)(ws + WS_U), (const bf16_t*)(ws + WS_WG)};
                pg8::StaticOrder<T_ / 512, 16, 1024, 1024> S{G, wg, 64 * hf};
                pg8::EpiGate E{(const bf16_t*)(ws + WS_YH), 16384 * hf, (bf16_t*)(ws + WS_O)};
                pg8::gemm_phase<1024, 1024, 1024>(ring, g, S, E);
                SEAM(P0 + 7 + 2 * hf);
            }
        }
        if (IN(P0 + 10)) for (int rep_ = 0; rep_ < NREP(P0 + 10); ++rep_) { PHASE_BEGIN();
            pg8::Gemm g{(const bf16_t*)(ws + WS_O), (const bf16_t*)(ws + WS_WO)};
            pg8::StaticOrder<T_ / 256, 4, 1024, 1024> S{G, wg, 0};
            pg8::EpiRes E{l == 0 ? p.in[0] : p.out, p.out, 1024};
            pg8::gemm_phase<1024, 1024, 1024>(ring, g, S, E);
            SEAM(P0 + 10);
        }
        if (IN(P0 + 11)) for (int rep_ = 0; rep_ < NREP(P0 + 11); ++rep_) { PHASE_BEGIN(); norm_phase<2>(p, l, gw, NGW, lane); SEAM(P0 + 11); }
        if (IN(P0 + 12)) for (int rep_ = 0; rep_ < NREP(P0 + 12); ++rep_) { PHASE_BEGIN();
            pg8::Gemm g{(const bf16_t*)(ws + WS_U), (const bf16_t*)(ws + WS_WR)};
            pg8::StaticOrder<T_ / 256, 1, 1024, 1024> S{G, wg, 0};
            pg8::EpiRouter E{(float*)(ws + WS_LOGIT)};
            pg8::gemm_phase<1024, 1024, 1024>(ring, g, S, E);
            SEAM(P0 + 12);
        }
        if (IN(P0 + 13)) for (int rep_ = 0; rep_ < NREP(P0 + 13); ++rep_) { PHASE_BEGIN(); route_phase(p, l, sm, wg, tid); SEAM(P0 + 13); }
        if (IN(P0 + 14)) for (int rep_ = 0; rep_ < NREP(P0 + 14); ++rep_) { PHASE_BEGIN(); assign_phase(p, sm, wg, tid, wave, lane); SEAM(P0 + 14); }
        if (IN(P0 + 15)) for (int rep_ = 0; rep_ < NREP(P0 + 15); ++rep_) { PHASE_BEGIN();
            const int* blke = (const int*)(ws + WS_BLKE); const int nb = __builtin_amdgcn_readfirstlane(blke[511]);
            pg8::Gemm g{(const bf16_t*)(ws + WS_XS), (const bf16_t*)(ws + WS_E1)};
            pg8::MoeOrder<2> S{blke, nb, G, wg, (size_t)256 * 1024 * 2, (size_t)256 * 1024 * 2, (size_t)512 * 1024 * 2};
            pg8::EpiE1 E{(bf16_t*)(ws + WS_HDN)};
            pg8::gemm_phase<1024, 1024, 1024>(ring, g, S, E);
            SEAM(P0 + 15);
        }
        if (IN(P0 + 16)) for (int rep_ = 0; rep_ < NREP(P0 + 16); ++rep_) { PHASE_BEGIN();
            const int* blke = (const int*)(ws + WS_BLKE); const int nb = __builtin_amdgcn_readfirstlane(blke[511]);
            pg8::Gemm g{(const bf16_t*)(ws + WS_HDN), (const bf16_t*)(ws + WS_E2)};
            pg8::MoeOrder<4> S{blke, nb, G, wg, (size_t)256 * 256 * 2, (size_t)256 * 256 * 2, (size_t)1024 * 256 * 2};
            pg8::EpiE2 E{(bf16_t*)(ws + WS_YS), (const int*)(ws + WS_SDST)};
            pg8::gemm_phase<256, 256, 256>(ring, g, S, E);
            SEAM(P0 + 16);
        }
    }
    if (IN(DEPTH_ * PH_PER_LAYER)) { PHASE_BEGIN(); norm_phase<3>(p, 0, gw, NGW, lane); }
#undef IN
#undef SEAM
}

extern "C" void kernel_launch(void* const* d_in, const int* in_sizes, int n_in, void* d_out, int out_size, void* d_ws, size_t ws_size, hipStream_t stream) {
    static int grid = 0;
    if (grid == 0) {
        if (n_in != 19 || out_size != T_ * D_ || ws_size < WS_END) { fprintf(stderr, "kernel_launch: unexpected shapes (n_in %d, out %d, ws %zu); nothing launched\n", n_in, out_size, ws_size); grid = -1; return; }
        int dev = 0, cus = 0;
        if (hipGetDevice(&dev) != hipSuccess || hipDeviceGetAttribute(&cus, hipDeviceAttributeMultiprocessorCount, dev) != hipSuccess) { grid = -1; return; }
        if (hipFuncSetAttribute((const void*)mega, hipFuncAttributeMaxDynamicSharedMemorySize, LDS_BYTES) != hipSuccess) { fprintf(stderr, "kernel_launch: hipFuncSetAttribute failed\n"); grid = -1; return; }
        int per_cu = 0;
        if (hipOccupancyMaxActiveBlocksPerMultiprocessor(&per_cu, (const void*)mega, NTHREADS, LDS_BYTES) != hipSuccess || per_cu < 1) { fprintf(stderr, "kernel_launch: occupancy query reports %d blocks per CU\n", per_cu); }
        (void)hipGetLastError();
        grid = cus;
    }
    if (grid <= 0) return;
    Params p{};
    for (int i = 0; i < 19; ++i) p.in[i] = (const float*)d_in[i];
    p.out = (float*)d_out; p.ws = (unsigned char*)d_ws;
    for (int f = 0; f < 16; ++f) p.inv_freq[f] = (float)std::pow(10000.0, -(double)f / 16.0);
    for (int h = 0; h < 4; ++h) p.ret_lg2[h] = (float)std::log2(1.0 - std::exp2(-5.0 - (double)h));
    hipMemsetAsync((unsigned char*)d_ws + WS_CTL, 0, CTL_BYTES, stream);
#if MK_PER_PHASE
    for (int ph = 0; ph < N_PHASES; ++ph) { p.ph_lo = ph; p.ph_hi = ph + 1; hipLaunchKernelGGL(mega, dim3(grid), dim3(NTHREADS), LDS_BYTES, stream, p); }
#else
    p.ph_lo = 0; p.ph_hi = N_PHASES;
    hipLaunchKernelGGL(mega, dim3(grid), dim3(NTHREADS), LDS_BYTES, stream, p);
#endif
}
```

```cpp
#include <hip/hip_runtime.h>
#include <cstdio>
#include <cstdint>
#include <cmath>

#define LAS __attribute__((address_space(3)))
#define GAS __attribute__((address_space(1)))
typedef unsigned short bf16_t;
typedef short bf16x8 __attribute__((ext_vector_type(8)));
typedef float f32x4 __attribute__((ext_vector_type(4)));
typedef float f32x2 __attribute__((ext_vector_type(2)));
typedef unsigned u32x4 __attribute__((ext_vector_type(4)));
typedef unsigned u32x2 __attribute__((ext_vector_type(2)));
typedef int i32x4 __attribute__((ext_vector_type(4)));
__device__ __forceinline__ f32x4 tof(const f32x4& v) { return v; }
__device__ __forceinline__ f32x4 tof(const i32x4& v) { return __builtin_convertvector(v, f32x4); }

constexpr int T_ = 32768, D_ = 1024, S_ = 8192, NBATCH = 4, DEPTH_ = 2;
constexpr int ZW = 3072;
constexpr int Z_GQ = 0, Z_GK = 128, Z_GV = 256, Z_GR = 512, Z_GA = 768, Z_SQ = 784, Z_SK = 1040, Z_SV = 1168, Z_MQ = 1296, Z_MK = 1552, Z_MV = 1808,
              Z_RQ = 2064, Z_RK = 2192, Z_RV = 2320, Z_RG = 2576, Z_GATE = 2832, IN_W = 6928;
constexpr float LOG2E = 1.4426950408889634f;
constexpr float C2 = 0.125f * 1.4426950408889634f;
constexpr float RSQ32 = 0.17677669529663687f;
constexpr float NORM_EPS = 1e-6f;
constexpr int NEXP = 32, EHID = 256, MOE_BLK = 256, NSLOTBLK = 288, NSLOT = NSLOTBLK * MOE_BLK;

constexpr size_t MiB = 1u << 20;
constexpr size_t WS_WIN = 0, WS_WG = 6 * MiB, WS_WB = 14 * MiB, WS_WO = 16 * MiB, WS_WR = 18 * MiB, WS_E1 = 19 * MiB, WS_E2 = 51 * MiB;
constexpr size_t WS_YS = 68 * MiB;
constexpr size_t WS_GKV = 68 * MiB, WS_RKV = 84 * MiB, WS_GDEC = 92 * MiB, WS_KMEAN = 93 * MiB, WS_O = 108 * MiB;
constexpr size_t WS_U8 = 197 * MiB;
constexpr size_t WS_SU = 229 * MiB, WS_XSS = WS_SU + 256 * 1024;
constexpr size_t WS_SWIN = 230 * MiB, WS_SWG = WS_SWIN + 16 * 1024, WS_SWE1 = WS_SWG + 16 * 1024;
constexpr size_t WS_Z = 261 * MiB;
constexpr size_t WS_YH = 261 * MiB;
constexpr size_t WS_U2BF = 261 * MiB;
constexpr size_t WS_XS = 325 * MiB, WS_HDN = 397 * MiB;
constexpr size_t WS_LOGIT = 453 * MiB;
constexpr size_t WS_TOKE = 461 * MiB, WS_TOKW = WS_TOKE + 256 * 1024, WS_TOKR = WS_TOKW + 256 * 1024, WS_HIST = WS_TOKR + 256 * 1024,
                 WS_SDST = WS_HIST + 64 * 1024, WS_BLKE = WS_SDST + 512 * 1024;
constexpr size_t WS_MLIST = 94 * MiB, WS_MCNT = 102 * MiB;
constexpr size_t WS_PARTO = 453 * MiB, WS_PARTML = 501 * MiB;
constexpr size_t WS_CTL = 511 * MiB, CTL_BYTES = 256 * 1024;
constexpr size_t WS_SWRAW = WS_CTL + 64 * 1024;
constexpr size_t WS_END = 512 * MiB;
constexpr int YS_TRASH_ROW = 2 * T_;

__device__ __forceinline__ float bf2f(bf16_t v) { return __uint_as_float(((unsigned)v) << 16); }
__device__ __forceinline__ unsigned f2bf(float f) { unsigned u = __float_as_uint(f); return (u + 0x7fffu + ((u >> 16) & 1u)) >> 16; }
__device__ __forceinline__ unsigned pk2(float lo, float hi) { return f2bf(lo) | (f2bf(hi) << 16); }
__device__ __forceinline__ float sigmoidf_(float x) { return __builtin_amdgcn_rcpf(1.0f + __builtin_amdgcn_exp2f(-x * LOG2E)); }

namespace pg8 {
#define PG8_LAS __attribute__((address_space(3)))
constexpr int BM = 256, BK = 64, HALF = 128, HTB = HALF * BK * 2  , STAGE_BYTES = 8 * HTB, NXCD = 8, WGM = 8;

__host__ __device__ __forceinline__ int lds_byte(int r, int c) { const int st = (r >> 4) * 2 + (c >> 5), rr = r & 15, cc = c & 31, ob = rr * 64 + cc * 2; return st * 1024 + (ob ^ (((ob >> 9) & 1) << 5)); }
__host__ __device__ __forceinline__ void stage_rc(int b, int& R, int& C) { const int st = b / 1024, sb = b % 1024, swz = sb ^ (((sb >> 9) & 1) << 5); R = (st >> 1) * 16 + swz / 64; C = (st & 1) * 32 + (swz % 64) / 2; }
__host__ __device__ __forceinline__ int perm32(int rho) { const int n = rho >> 4, i = rho & 15; return 8 * (i >> 2) + 4 * n + (i & 3); }

struct Unit { int pm, pn; size_t aoff, boff; };
struct Gemm { const bf16_t* A; const bf16_t* Bt; };

template <int NM, int NN, int LDAB  , int LDBB, int A_SHIFT = 30, int A_MUL = 0> struct StaticOrder {
    int G, c, pm_base;
    __device__ bool next(int i, Unit& u) const {
        constexpr int nwg = NM * NN; const int L = i * G + c; if (L >= nwg) return false;
        int wgid = L; { constexpr int q = nwg / NXCD, r = nwg % NXCD; const int xcd = wgid % NXCD, off = wgid / NXCD; wgid = (xcd < r ? xcd * (q + 1) : r * (q + 1) + (xcd - r) * q) + off; }
        constexpr int nig = WGM * NN; const int gid = wgid / nig, fm = gid * WGM, gsz = (NM - fm) < WGM ? (NM - fm) : WGM;
        u.pm = pm_base + fm + ((wgid % nig) % gsz); u.pn = (wgid % nig) / gsz;
        u.aoff = (size_t)u.pm * ((size_t)BM * LDAB) + (size_t)(u.pn >> A_SHIFT) * A_MUL; u.boff = (size_t)u.pn * ((size_t)BM * LDBB); return true;
    }
};
template <int NCOL> struct MoeOrder {
    const int* blk_e; int nb, G, c; size_t a_tstep, b_tstep, b_estep;
    __device__ bool next(int i, Unit& u) const {
        const int L = i * G + c; if (L >= nb * NCOL) return false;
        const int rb = L / NCOL, pn = L % NCOL; const int e = __builtin_amdgcn_readfirstlane(blk_e[rb]);
        u.pm = rb; u.pn = pn; u.aoff = (size_t)rb * a_tstep; u.boff = (size_t)e * b_estep + (size_t)pn * b_tstep; return true;
    }
};

__device__ __forceinline__ unsigned cvt_pk_bf16(float lo, float hi) { unsigned r; asm volatile("v_cvt_pk_bf16_f32 %0, %1, %2" : "=v"(r) : "v"(lo), "v"(hi)); return r; }

struct EpiBf16 {
    static constexpr bool PERM = true;
    bf16_t* O; int ldc; int row_sub;
    template <class AT> __device__ __forceinline__ void operator()(const AT (&acc)[2][2][4][2], const Unit& u, int wr, int wc, int fr, int fq) const {
        const int row0 = u.pm * BM + wr * 64 + fr - row_sub; const int col0 = u.pn * BM + wc * 32 + 8 * fq;
#pragma unroll
        for (int ai = 0; ai < 2; ++ai)
#pragma unroll
            for (int m = 0; m < 4; ++m) { bf16_t* rowp = O + (size_t)(row0 + ai * HALF + m * 16) * ldc + col0;
#pragma unroll
                for (int bj = 0; bj < 2; ++bj) { const f32x4 v0 = tof(acc[ai][bj][m][0]), v1 = tof(acc[ai][bj][m][1]);
                    u32x4 w; w.x = cvt_pk_bf16(v0[0], v0[1]); w.y = cvt_pk_bf16(v0[2], v0[3]); w.z = cvt_pk_bf16(v1[0], v1[1]); w.w = cvt_pk_bf16(v1[2], v1[3]);
                    *(u32x4*)(rowp + bj * HALF) = w; } }
    }
};
struct EpiBf16S {
    static constexpr bool PERM = true;
    bf16_t* O; int ldc; const float* srow; const float* scol;
    template <class AT> __device__ __forceinline__ void operator()(const AT (&acc)[2][2][4][2], const Unit& u, int wr, int wc, int fr, int fq) const {
        const int row0 = u.pm * BM + wr * 64 + fr; const int col0 = u.pn * BM + wc * 32 + 8 * fq;
        f32x4 sc[2][2];
#pragma unroll
        for (int bj = 0; bj < 2; ++bj)
#pragma unroll
            for (int n = 0; n < 2; ++n) sc[bj][n] = *(const f32x4*)(scol + col0 + bj * HALF + 4 * n);
#pragma unroll
        for (int ai = 0; ai < 2; ++ai)
#pragma unroll
            for (int m = 0; m < 4; ++m) { const int r = row0 + ai * HALF + m * 16; const float sr = srow[r]; bf16_t* rowp = O + (size_t)r * ldc + col0;
#pragma unroll
                for (int bj = 0; bj < 2; ++bj) { const f32x4 v0 = tof(acc[ai][bj][m][0]) * sc[bj][0] * sr, v1 = tof(acc[ai][bj][m][1]) * sc[bj][1] * sr;
                    u32x4 w; w.x = cvt_pk_bf16(v0[0], v0[1]); w.y = cvt_pk_bf16(v0[2], v0[3]); w.z = cvt_pk_bf16(v1[0], v1[1]); w.w = cvt_pk_bf16(v1[2], v1[3]);
                    *(u32x4*)(rowp + bj * HALF) = w; } }
    }
};
struct EpiRes {
    static constexpr bool PERM = false;
    const float* base; float* C; int ldc;
    template <class AT> __device__ __forceinline__ void operator()(const AT (&acc)[2][2][4][2], const Unit& u, int wr, int wc, int fr, int fq) const {
        const int row0 = u.pm * BM + wr * 64 + fr, col0 = u.pn * BM + wc * 32 + 4 * fq;
#pragma unroll
        for (int ai = 0; ai < 2; ++ai) { f32x4 b[4][2][2];
#pragma unroll
            for (int m = 0; m < 4; ++m) { const size_t off = (size_t)(row0 + ai * HALF + m * 16) * ldc + col0;
#pragma unroll
                for (int bj = 0; bj < 2; ++bj)
#pragma unroll
                    for (int n = 0; n < 2; ++n) b[m][bj][n] = *(const f32x4*)(base + off + bj * HALF + n * 16); }
#pragma unroll
            for (int m = 0; m < 4; ++m) { const size_t off = (size_t)(row0 + ai * HALF + m * 16) * ldc + col0;
#pragma unroll
                for (int bj = 0; bj < 2; ++bj)
#pragma unroll
                    for (int n = 0; n < 2; ++n) *(f32x4*)(C + off + bj * HALF + n * 16) = b[m][bj][n] + tof(acc[ai][bj][m][n]); }
            asm volatile("" ::: "memory"); }
    }
};
struct EpiRouter {
    static constexpr bool PERM = false;
    float* L;
    template <class AT> __device__ __forceinline__ void operator()(const AT (&acc)[2][2][4][2], const Unit& u, int wr, int wc, int fr, int fq) const {
        if (wc >= 2) return;
        const int row0 = u.pm * BM + wr * 64 + fr, col0 = wc * 32 + 4 * fq;
#pragma unroll
        for (int ai = 0; ai < 2; ++ai)
#pragma unroll
            for (int m = 0; m < 4; ++m) { float* rowp = L + (size_t)(row0 + ai * HALF + m * 16) * 64 + col0;
#pragma unroll
                for (int n = 0; n < 2; ++n) *(f32x4*)(rowp + n * 16) = tof(acc[ai][0][m][n]); }
    }
};
struct EpiGate {
    static constexpr bool PERM = false;
    const bf16_t* Y; int y_row_sub; bf16_t* Mg; const float* srow; const float* scol;
    template <class AT> __device__ __forceinline__ void operator()(const AT (&acc)[2][2][4][2], const Unit& u, int wr, int wc, int fr, int fq) const {
        const int row0 = u.pm * BM + wr * 64 + fr, d0 = u.pn * 64 + wc * 16 + fq * 4;
        f32x4 sc[4];
#pragma unroll
        for (int i = 0; i < 4; ++i) sc[i] = *(const f32x4*)(scol + u.pn * BM + (i >> 1) * HALF + wc * 32 + (i & 1) * 16 + 4 * fq) * (-LOG2E);
#pragma unroll
        for (int ai = 0; ai < 2; ++ai) { u32x2 yv[4][4];
#pragma unroll
            for (int m = 0; m < 4; ++m) { const bf16_t* yrow = Y + (size_t)(row0 + ai * HALF + m * 16 - y_row_sub) * 4096 + d0;
#pragma unroll
                for (int i = 0; i < 4; ++i) yv[m][i] = *(const u32x2*)(yrow + 1024 * i); }
#pragma unroll
            for (int m = 0; m < 4; ++m) { const int r = row0 + ai * HALF + m * 16; const float sr = srow[r];
                f32x4 s = (f32x4){0.f, 0.f, 0.f, 0.f};
#pragma unroll
                for (int i = 0; i < 4; ++i) { const f32x4 g = tof(acc[ai][i >> 1][m][i & 1]) * sc[i] * sr;
                    s[0] += __builtin_amdgcn_rcpf(1.0f + __builtin_amdgcn_exp2f(g[0])) * __uint_as_float(yv[m][i].x << 16); s[1] += __builtin_amdgcn_rcpf(1.0f + __builtin_amdgcn_exp2f(g[1])) * __uint_as_float(yv[m][i].x & 0xffff0000u);
                    s[2] += __builtin_amdgcn_rcpf(1.0f + __builtin_amdgcn_exp2f(g[2])) * __uint_as_float(yv[m][i].y << 16); s[3] += __builtin_amdgcn_rcpf(1.0f + __builtin_amdgcn_exp2f(g[3])) * __uint_as_float(yv[m][i].y & 0xffff0000u); }
                u32x2 w; w.x = cvt_pk_bf16(s[0], s[1]); w.y = cvt_pk_bf16(s[2], s[3]);
                *(u32x2*)(Mg + (size_t)r * 1024 + d0) = w; }
            asm volatile("" ::: "memory"); }
    }
};
struct EpiE1 {
    static constexpr bool PERM = true;
    bf16_t* H; const float* srow; const float* scol_all; const int* blk_e;
    template <class AT> __device__ __forceinline__ void operator()(const AT (&acc)[2][2][4][2], const Unit& u, int wr, int wc, int fr, int fq) const {
        const int row0 = u.pm * BM + wr * 64 + fr, col0 = u.pn * 128 + wc * 32 + 8 * fq;
        const float* scol = scol_all + (size_t)__builtin_amdgcn_readfirstlane(blk_e[u.pm]) * 512 + u.pn * BM + wc * 32 + 8 * fq;
        const f32x4 s10 = *(const f32x4*)scol, s11 = *(const f32x4*)(scol + 4), s30 = *(const f32x4*)(scol + HALF), s31 = *(const f32x4*)(scol + HALF + 4);
#pragma unroll
        for (int ai = 0; ai < 2; ++ai)
#pragma unroll
            for (int m = 0; m < 4; ++m) { const int r = row0 + ai * HALF + m * 16; const float sr = srow[r]; bf16_t* rowp = H + (size_t)r * EHID + col0;
                const f32x4 a0 = tof(acc[ai][0][m][0]) * s10 * sr, a1 = tof(acc[ai][0][m][1]) * s11 * sr, b0 = tof(acc[ai][1][m][0]) * s30 * sr, b1 = tof(acc[ai][1][m][1]) * s31 * sr;
                f32x4 v0, v1;
#pragma unroll
                for (int j = 0; j < 4; ++j) { v0[j] = a0[j] * sigmoidf_(a0[j]) * b0[j]; v1[j] = a1[j] * sigmoidf_(a1[j]) * b1[j]; }
                u32x4 w; w.x = cvt_pk_bf16(v0[0], v0[1]); w.y = cvt_pk_bf16(v0[2], v0[3]); w.z = cvt_pk_bf16(v1[0], v1[1]); w.w = cvt_pk_bf16(v1[2], v1[3]);
                *(u32x4*)rowp = w; }
    }
};
struct EpiE2 {
    static constexpr bool PERM = true;
    bf16_t* YS; const int* sdst;
    template <class AT> __device__ __forceinline__ void operator()(const AT (&acc)[2][2][4][2], const Unit& u, int wr, int wc, int fr, int fq) const {
        const int row0 = u.pm * BM + wr * 64 + fr, col0 = u.pn * BM + wc * 32 + 8 * fq;
#pragma unroll
        for (int ai = 0; ai < 2; ++ai)
#pragma unroll
            for (int m = 0; m < 4; ++m) { const int dst = sdst[row0 + ai * HALF + m * 16];
                bf16_t* rowp = YS + (size_t)dst * 1024 + col0;
#pragma unroll
                for (int bj = 0; bj < 2; ++bj) { const f32x4 v0 = tof(acc[ai][bj][m][0]), v1 = tof(acc[ai][bj][m][1]);
                    u32x4 w; w.x = cvt_pk_bf16(v0[0], v0[1]); w.y = cvt_pk_bf16(v0[2], v0[3]); w.z = cvt_pk_bf16(v1[0], v1[1]); w.w = cvt_pk_bf16(v1[2], v1[3]);
                    *(u32x4*)(rowp + bj * HALF) = w; }
                asm volatile("" ::: "memory"); }
    }
};

template <bool I8> struct AccSel { typedef f32x4 type; };
template <> struct AccSel<true> { typedef i32x4 type; };
__device__ __forceinline__ f32x4 mma16(const bf16x8& a, const bf16x8& b, const f32x4& c) { return __builtin_amdgcn_mfma_f32_16x16x32_bf16(a, b, c, 0, 0, 0); }
__device__ __forceinline__ i32x4 mma16(const bf16x8& a, const bf16x8& b, const i32x4& c) { return __builtin_amdgcn_mfma_i32_16x16x64_i8(__builtin_bit_cast(i32x4, a), __builtin_bit_cast(i32x4, b), c, 0, 0, 0); }
template <int LDAB, int LDBB, int KB, bool I8, class Epi, class Sched>
__device__ __forceinline__ void gemm_phase(PG8_LAS unsigned char* lds, const Gemm g, const Sched& S, const Epi& E) {
    int tid = threadIdx.x; asm volatile("" : "+v"(tid));
    const int wid = __builtin_amdgcn_readfirstlane(tid >> 6), lane = tid & 63, wr = wid >> 2, wc = wid & 3, fr = lane & 15, fq = lane >> 4;
    constexpr int nt = KB / (BK * 2);
    unsigned voffA[2], voffB[2];
#pragma unroll
    for (int i = 0; i < 2; ++i) { int R, C; stage_rc(tid * 16 + i * 8192, R, C); const int Rb = Epi::PERM ? ((R & ~31) + perm32(R & 31)) : R;
        voffA[i] = (unsigned)(R * LDAB + C * 2); voffB[i] = (unsigned)(Rb * LDBB + C * 2); }
    constexpr size_t kstep = (size_t)(BK * 2);
    constexpr size_t hstepA = (size_t)HALF * LDAB, hstepB = (size_t)HALF * LDBB;
    const unsigned ldsw = (unsigned)wid * 1024u;
    const int aoff = lds_byte(wr * 64 + fr, fq * 8), boff = lds_byte(wc * 32 + fr, fq * 8);
#define PG8_SA(b, h) (((b) * 2 + (h)) * HTB)
#define PG8_SB(b, h) ((4 + (b) * 2 + (h)) * HTB)
#define PG8_STAGE(bufoff, gbase, voff) do { _Pragma("unroll") for (int _i = 0; _i < 2; ++_i) \
        __builtin_amdgcn_global_load_lds((const unsigned*)((const char*)(gbase) + (voff)[_i]), (PG8_LAS unsigned*)(lds + (bufoff) + ldsw + _i * 8192), 16, 0, 0); } while (0)
#define PG8_LDA(dst, b, h) do { _Pragma("unroll") for (int m = 0; m < 4; ++m) _Pragma("unroll") for (int k = 0; k < 2; ++k) dst[m][k] = *(const PG8_LAS bf16x8*)(lds + PG8_SA(b, h) + aoff + m * 2048 + k * 1024); } while (0)
#define PG8_LDB(dst, b, h) do { _Pragma("unroll") for (int n = 0; n < 2; ++n) _Pragma("unroll") for (int k = 0; k < 2; ++k) dst[n][k] = *(const PG8_LAS bf16x8*)(lds + PG8_SB(b, h) + boff + n * 2048 + k * 1024); } while (0)
#define PG8_MMA(ai, bj, At, Bt) do { __builtin_amdgcn_s_setprio(1); _Pragma("unroll") for (int m = 0; m < 4; ++m) _Pragma("unroll") for (int n = 0; n < 2; ++n) _Pragma("unroll") for (int k = 0; k < 2; ++k) \
        acc[ai][bj][m][n] = mma16(Bt[n][k], At[m][k], acc[ai][bj][m][n]); __builtin_amdgcn_s_setprio(0); } while (0)
#define PG8_WAIT_V(n) asm volatile("s_waitcnt vmcnt(" #n ")" ::: "memory")
#define PG8_WAIT_L(n) asm volatile("s_waitcnt lgkmcnt(" #n ")" ::: "memory")
#define PG8_BAR __builtin_amdgcn_s_barrier()
#define PG8_SCHED __builtin_amdgcn_sched_barrier(0)
    Unit cur, nxt; int ui = 0;
    if (!S.next(0, cur)) return;
    typedef typename AccSel<I8>::type acc_t;
    acc_t acc[2][2][4][2];
#pragma unroll
    for (int a = 0; a < 2; ++a)
#pragma unroll
        for (int b = 0; b < 2; ++b)
#pragma unroll
            for (int m = 0; m < 4; ++m)
#pragma unroll
                for (int n = 0; n < 2; ++n) acc[a][b][m][n] = (acc_t){0, 0, 0, 0};
    bf16x8 At[4][2], B0[2][2], B1[2][2];
    const char* cA = (const char*)g.A + cur.aoff; const char* cB = (const char*)g.Bt + cur.boff;
    PG8_STAGE(PG8_SB(0, 0), cB, voffB); PG8_STAGE(PG8_SA(0, 0), cA, voffA); PG8_STAGE(PG8_SB(0, 1), cB + hstepB, voffB); PG8_STAGE(PG8_SA(0, 1), cA + hstepA, voffA);
    if (wr == 1) PG8_BAR;
    PG8_WAIT_V(4); PG8_BAR;
    PG8_STAGE(PG8_SB(1, 0), cB + kstep, voffB); PG8_STAGE(PG8_SA(1, 0), cA + kstep, voffA); PG8_STAGE(PG8_SB(1, 1), cB + hstepB + kstep, voffB);
    PG8_WAIT_V(6); PG8_BAR;
    for (;;) {
        const bool has_next = S.next(ui + 1, nxt);
        const char* nA = has_next ? (const char*)g.A + nxt.aoff : cA; const char* nB = has_next ? (const char*)g.Bt + nxt.boff : cB;
        for (int t = 0; t < nt; t += 2) {
            const bool last = (t == nt - 2);
            const char* a1 = cA + (size_t)(t + 1) * kstep;
            const char* a2 = last ? nA : cA + (size_t)(t + 2) * kstep; const char* b2 = last ? nB : cB + (size_t)(t + 2) * kstep;
            const char* a3 = a2 + kstep; const char* b3 = b2 + kstep;
            PG8_LDB(B0, 0, 0); PG8_SCHED; PG8_LDA(At, 0, 0); PG8_STAGE(PG8_SA(1, 1), a1 + hstepA, voffA);
            PG8_WAIT_L(8); PG8_BAR; PG8_WAIT_L(0); PG8_MMA(0, 0, At, B0); PG8_BAR; PG8_SCHED;
            PG8_LDB(B1, 0, 1); PG8_STAGE(PG8_SB(0, 0), b2, voffB);
            PG8_BAR; PG8_WAIT_L(0); PG8_MMA(0, 1, At, B1); PG8_BAR;
            PG8_LDA(At, 0, 1); PG8_STAGE(PG8_SA(0, 0), a2, voffA);
            PG8_BAR; PG8_WAIT_L(0); PG8_MMA(1, 0, At, B0); PG8_BAR; PG8_SCHED;
            PG8_STAGE(PG8_SB(0, 1), b2 + hstepB, voffB);
            PG8_WAIT_V(6); PG8_BAR; PG8_MMA(1, 1, At, B1); PG8_BAR;
            PG8_LDB(B0, 1, 0); PG8_SCHED; PG8_LDA(At, 1, 0); PG8_STAGE(PG8_SA(0, 1), a2 + hstepA, voffA);
            PG8_WAIT_L(8); PG8_BAR; PG8_WAIT_L(0); PG8_MMA(0, 0, At, B0); PG8_BAR; PG8_SCHED;
            PG8_LDB(B1, 1, 1); PG8_STAGE(PG8_SB(1, 0), b3, voffB);
            PG8_BAR; PG8_WAIT_L(0); PG8_MMA(0, 1, At, B1); PG8_BAR;
            PG8_LDA(At, 1, 1); PG8_STAGE(PG8_SA(1, 0), a3, voffA);
            PG8_BAR; PG8_WAIT_L(0); PG8_MMA(1, 0, At, B0); PG8_BAR; PG8_SCHED;
            PG8_STAGE(PG8_SB(1, 1), b3 + hstepB, voffB);
            PG8_WAIT_V(6); PG8_BAR; PG8_MMA(1, 1, At, B1); PG8_BAR;
        }
        E(acc, cur, wr, wc, fr, fq);
        if (!has_next) break;
#pragma unroll
        for (int a = 0; a < 2; ++a)
#pragma unroll
            for (int b = 0; b < 2; ++b)
#pragma unroll
                for (int m = 0; m < 4; ++m)
#pragma unroll
                    for (int n = 0; n < 2; ++n) acc[a][b][m][n] = (acc_t){0, 0, 0, 0};
        cur = nxt; cA = nA; cB = nB; ++ui;
    }
    PG8_WAIT_V(0);
    if (wr == 0) PG8_BAR;
    PG8_BAR;
#undef PG8_SA
#undef PG8_SB
#undef PG8_STAGE
#undef PG8_LDA
#undef PG8_LDB
#undef PG8_MMA
#undef PG8_WAIT_V
#undef PG8_WAIT_L
#undef PG8_BAR
#undef PG8_SCHED
}
}

#define XB_TMO      128
#define XB_XCNT(j)  (256  + 64 * (j))
#define XB_XSUB(j)  (1280 + 64 * (j))
#define XB_XGEN(j)  (2304 + 64 * (j))
#define XB_TOP      3328
#define XB_TOPGEN   3392
#define XCD_BAR_WORDS 3456
#define XB_SPIN_CAP (1u << 21)

__device__ __forceinline__ unsigned xb_ld(unsigned* p)              { return __hip_atomic_load(p, __ATOMIC_RELAXED, __HIP_MEMORY_SCOPE_AGENT); }
__device__ __forceinline__ unsigned xb_add(unsigned* p, unsigned v) { return __hip_atomic_fetch_add(p, v, __ATOMIC_RELAXED, __HIP_MEMORY_SCOPE_AGENT); }
__device__ __forceinline__ unsigned xb_xcc_id() { return (unsigned)__builtin_amdgcn_s_getreg((3 << 11) | 20) & 0xFu; }
#define XB_SPIN(cond, bar) do { unsigned _sp = 0; while (cond) { __builtin_amdgcn_s_sleep(1); \
    if ((++_sp & 255u) == 0u) { if (xb_ld(&(bar)[XB_TMO])) break; if (_sp > XB_SPIN_CAP) { atomicAdd(&(bar)[XB_TMO], 1u); break; } } } } while (0)

struct XcdBarrier {
    unsigned* bar; unsigned x;
    volatile LAS unsigned* st;
};

__device__ __forceinline__ XcdBarrier xcd_barrier_post(unsigned* bar, volatile LAS unsigned* st) {
    XcdBarrier b; b.bar = bar; b.x = xb_xcc_id(); b.st = st;
    if (threadIdx.x == 0) (void)xb_add(&bar[XB_XCNT(b.x)], 1u);
    return b;
}
__device__ __forceinline__ void xcd_barrier_complete(unsigned* bar, unsigned x, unsigned& nloc, unsigned& nx) {
    const unsigned G = gridDim.x * gridDim.y * gridDim.z;
    unsigned sum, cnt, mine, sp = 0u;
    for (;;) {
        sum = 0u; cnt = 0u; mine = 0u;
#pragma unroll
        for (unsigned j = 0; j < 16; ++j) { const unsigned c = xb_ld(&bar[XB_XCNT(j)]); sum += c; cnt += (c > 0u) ? 1u : 0u; mine = (j == x) ? c : mine; }
        if (sum == G) break;
        __builtin_amdgcn_s_sleep(1);
        if ((++sp & 255u) == 0u) { if (xb_ld(&bar[XB_TMO])) break; if (sp > XB_SPIN_CAP) { atomicAdd(&bar[XB_TMO], 1u); break; } }
    }
    nloc = mine > 0u ? mine : 1u; nx = cnt > 0u ? cnt : 1u;
}

__device__ __forceinline__ void xcd_barrier(const XcdBarrier& b) {
    asm volatile("s_waitcnt vmcnt(0)" ::: "memory");
    __syncthreads();
    if (threadIdx.x == 0) {
        unsigned* bar = b.bar;
        __builtin_amdgcn_s_waitcnt(0);
        unsigned nloc = b.st[0], nx = b.st[1];
        if (nloc == 0u) { xcd_barrier_complete(bar, b.x, nloc, nx); b.st[0] = nloc; b.st[1] = nx; }
        const unsigned old = xb_add(&bar[XB_XSUB(b.x)], 1u);
        const unsigned gen = old / nloc;
        if (old + 1u == (gen + 1u) * nloc) {
            __builtin_amdgcn_fence(__ATOMIC_RELEASE, "agent");
            asm volatile("s_waitcnt vmcnt(0)" ::: "memory");
            const unsigned og = xb_add(&bar[XB_TOP], 1u);
            const unsigned tg = og / nx;
            if (og + 1u == (tg + 1u) * nx) xb_add(&bar[XB_TOPGEN], 1u);
            else XB_SPIN(xb_ld(&bar[XB_TOPGEN]) == tg, bar);
            __builtin_amdgcn_fence(__ATOMIC_ACQUIRE, "agent");
            xb_add(&bar[XB_XGEN(b.x)], 1u);
            asm volatile("s_waitcnt vmcnt(0)" ::: "memory");
        } else {
            XB_SPIN(xb_ld(&bar[XB_XGEN(b.x)]) == gen, bar);
            __builtin_amdgcn_fence(__ATOMIC_ACQUIRE, "agent");
            asm volatile("s_waitcnt vmcnt(0)" ::: "memory");
        }
    }
    __syncthreads();
}

constexpr int NWAVES = 8, NTHREADS = 512;
constexpr int RING_BYTES = 131072;
constexpr int LDSCTL_OFF = 155648 - 1024, MISC_OFF = LDSCTL_OFF + 320;
constexpr int LDS_BYTES = 155648;

struct Params { const float* in[19]; float* out; unsigned char* ws; float inv_freq[16]; float ret_lg2[4]; int ph_lo, ph_hi; };
typedef const __attribute__((address_space(4))) Params& KPRef;

__device__ __forceinline__ float wave_sum(float v) {
#pragma unroll
    for (int o = 1; o < 64; o <<= 1) v += __shfl_xor(v, o);
    return v;
}
#define LDS_WAIT() asm volatile("s_waitcnt lgkmcnt(0)" ::: "memory")
#define MFMA16(a, b, c) __builtin_amdgcn_mfma_f32_16x16x32_bf16(a, b, c, 0, 0, 0)
typedef short v4i16_t __attribute__((ext_vector_type(4)));
__device__ __forceinline__ v4i16_t lds_tr16(const bf16_t* p) { return __builtin_amdgcn_ds_read_tr16_b64_v4i16((LAS v4i16_t*)(LAS unsigned char*)(unsigned char*)p); }
__device__ __forceinline__ bf16x8 tr_frag(const bf16_t* tile, int stride, int rowa, int rowb, int col0, int lane) {
    const int i = lane & 15, q = i >> 2, pp = i & 3;
    const v4i16_t lo = lds_tr16(tile + (rowa + q) * stride + col0 + 4 * pp), hi = lds_tr16(tile + (rowb + q) * stride + col0 + 4 * pp);
    return (bf16x8){lo[0], lo[1], lo[2], lo[3], hi[0], hi[1], hi[2], hi[3]};
}
__device__ __forceinline__ bf16x8 pack_p(const f32x4& a, const f32x4& b) {
    u32x4 w; w.x = pg8::cvt_pk_bf16(a[0], a[1]); w.y = pg8::cvt_pk_bf16(a[2], a[3]); w.z = pg8::cvt_pk_bf16(b[0], b[1]); w.w = pg8::cvt_pk_bf16(b[2], b[3]); return __builtin_bit_cast(bf16x8, w); }


template <class LD>
__device__ __forceinline__ void conv_item(LD ld, bf16_t* WT, int K, float* scr, int kb, int nb, int lane) {
    const int k0 = 64 * kb, n0 = 32 * nb;
#pragma unroll 8
    for (int i = 0; i < 32; ++i) { const int kk = 2 * i + (lane >> 5); scr[kk * 33 + (lane & 31)] = ld(k0 + kk, n0 + (lane & 31)); }
    LDS_WAIT();
    const int c = lane & 7;
#pragma unroll
    for (int j = 0; j < 4; ++j) { const int n = (lane >> 3) + 8 * j; const float* s = scr + (8 * c) * 33 + n;
        u32x4 o; o.x = pk2(s[0 * 33], s[1 * 33]); o.y = pk2(s[2 * 33], s[3 * 33]); o.z = pk2(s[4 * 33], s[5 * 33]); o.w = pk2(s[6 * 33], s[7 * 33]);
        *(u32x4*)(WT + (size_t)(n0 + n) * K + k0 + 8 * c) = o; }
    LDS_WAIT();
}

template <class LD>
__device__ __forceinline__ void amax_item(LD ld, unsigned* raw, int kb, int nb, int lane) {
    const int k0 = 64 * kb, n0 = 32 * nb; float v[32];
#pragma unroll
    for (int i = 0; i < 32; ++i) v[i] = ld(k0 + 2 * i + (lane >> 5), n0 + (lane & 31));
    float am = 0.f;
#pragma unroll
    for (int i = 0; i < 32; ++i) am = fmaxf(am, fabsf(v[i]));
    am = fmaxf(am, __shfl_xor(am, 32));
    if (lane < 32) atomicMax(raw + n0 + lane, __float_as_uint(am));
}
template <class LD, class SC>
__device__ __forceinline__ void quant_item(LD ld, SC extra, const unsigned* raw, signed char* WT, float* scale, float* scr, int kb, int nb, int lane) {
    const int k0 = 64 * kb, n0 = 32 * nb;
    const float am = __uint_as_float(raw[n0 + (lane & 31)]), qs = (am > 0.f) ? 127.0f / am : 0.f;
    if (kb == 0 && lane < 32) scale[n0 + lane] = am * (1.0f / 127.0f) * extra(n0 + lane);
#pragma unroll 8
    for (int i = 0; i < 32; ++i) { const int kk = 2 * i + (lane >> 5); scr[kk * 33 + (lane & 31)] = rintf(ld(k0 + kk, n0 + (lane & 31)) * qs); }
    LDS_WAIT();
    const int c = lane & 7;
#pragma unroll
    for (int j = 0; j < 4; ++j) { const int n = (lane >> 3) + 8 * j; const float* s = scr + (8 * c) * 33 + n;
        u32x2 o; o.x = ((unsigned)((int)s[0 * 33] & 0xff)) | ((unsigned)((int)s[1 * 33] & 0xff) << 8) | ((unsigned)((int)s[2 * 33] & 0xff) << 16) | ((unsigned)((int)s[3 * 33] & 0xff) << 24);
        o.y = ((unsigned)((int)s[4 * 33] & 0xff)) | ((unsigned)((int)s[5 * 33] & 0xff) << 8) | ((unsigned)((int)s[6 * 33] & 0xff) << 16) | ((unsigned)((int)s[7 * 33] & 0xff) << 24);
        *(u32x2*)(WT + (size_t)(n0 + n) * 1024 + k0 + 8 * c) = o; }
    LDS_WAIT();
}
template <int PASS>
__device__ __forceinline__ void conv8_pass(KPRef p, int l, unsigned char* lds, int gw, int NGW, int wave, int lane) {
    float* scr = (float*)(lds + wave * 16384); unsigned char* ws = p.ws; unsigned* raw = (unsigned*)(ws + WS_SWRAW);
    const float* Win = p.in[2] + (size_t)l * 1024 * IN_W;
    for (int it = gw; it < 16 * 96; it += NGW) { const int kb = it / 96, nb = it % 96;
        auto ld = [&](int k, int n) -> float { return n < Z_GATE ? Win[(size_t)k * IN_W + n] : 0.f; };
        if (PASS == 0) amax_item(ld, raw, kb, nb, lane);
        else quant_item(ld, [&](int n) -> float { float s = 1.f; if (n < Z_GK) s = RSQ32; else if (n >= Z_SQ && n < Z_SK) s = C2; else if (n >= Z_MQ && n < Z_MK) s = C2; else if (n >= Z_RK && n < Z_RV) s = RSQ32; return s; },
                        raw, (signed char*)(ws + WS_WIN), (float*)(ws + WS_SWIN), scr, kb, nb, lane); }
    for (int it = gw; it < 16 * 128; it += NGW) { const int kb = it / 128, nb = it % 128;
        auto ld = [&](int k, int n) -> float { const int pn = n >> 8, c = n & 255, bj = (c >> 7) & 1, wc = (c >> 5) & 3, nn = (c >> 4) & 1, fq = (c >> 2) & 3, j = c & 3;
            const int col = Z_GATE + 1024 * (2 * bj + nn) + 64 * pn + 16 * wc + 4 * fq + j; return Win[(size_t)k * IN_W + col]; };
        if (PASS == 0) amax_item(ld, raw + 3072, kb, nb, lane);
        else quant_item(ld, [&](int) -> float { return 1.f; }, raw + 3072, (signed char*)(ws + WS_WG), (float*)(ws + WS_SWG), scr, kb, nb, lane); }
    for (int it = gw; it < 32 * 256; it += NGW) { const int e = it / 256, r = it % 256, kb = r / 16, nb = r % 16;
        const int n0 = 32 * nb, pn = n0 >> 8, c0 = n0 & 255;
        const float* W = ((c0 < 128) ? p.in[15] : p.in[16]) + (size_t)(l * 32 + e) * 1024 * 256 + 128 * pn + (c0 & 127) - n0;
        auto ld = [&](int k, int n) -> float { return W[(size_t)k * 256 + n]; };
        if (PASS == 0) amax_item(ld, raw + 7168 + e * 512, kb, nb, lane);
        else quant_item(ld, [&](int) -> float { return 1.f; }, raw + 7168 + e * 512, (signed char*)(ws + WS_E1) + (size_t)e * 512 * 1024, (float*)(ws + WS_SWE1) + e * 512, scr, kb, nb, lane); }
}

__device__ __forceinline__ void conv_phase(KPRef p, int l, unsigned char* lds, int gw, int NGW, int wave, int lane) {
    float* scr = (float*)(lds + wave * 16384);
    unsigned char* ws = p.ws;
    {
        for (int it = gw; it < 512; it += NGW) { const int i = it / 128, r = it % 128, kb = r / 32, nb = r % 32;
            const float* W = p.in[8] + (size_t)(l * 4 + i) * 256 * 1024; bf16_t* WT = (bf16_t*)(ws + WS_WB) + (size_t)i * 1024 * 256;
            conv_item([&](int k, int n) -> float { return W[(size_t)k * 1024 + n]; }, WT, 256, scr, kb, nb, lane); }
    }
    {
        const float* W = p.in[9] + (size_t)l * 1024 * 1024; bf16_t* WT = (bf16_t*)(ws + WS_WO);
        for (int it = gw; it < 16 * 32; it += NGW) { const int kb = it / 32, nb = it % 32;
            conv_item([&](int k, int n) -> float { return W[(size_t)k * 1024 + n]; }, WT, 1024, scr, kb, nb, lane); }
    }
    {
        const float* Wg = p.in[11] + (size_t)l * 1024 * 4; const float* We = p.in[13] + (size_t)l * 1024 * 32; bf16_t* WT = (bf16_t*)(ws + WS_WR);
        for (int it = gw; it < 16 * 8; it += NGW) { const int kb = it / 8, nb = it % 8;
            conv_item([&](int k, int n) -> float { if (n < 4) return Wg[k * 4 + n]; if (n < 36) return We[k * 32 + (n - 4)]; return 0.f; }, WT, 1024, scr, kb, nb, lane); }
    }
    {
        for (int it = gw; it < 32 * 128; it += NGW) { const int e = it / 128, r = it % 128, kb = r / 32, nb = r % 32;
            const float* W = p.in[17] + (size_t)(l * 32 + e) * 256 * 1024; bf16_t* WT = (bf16_t*)(ws + WS_E2) + (size_t)e * 1024 * 256;
            conv_item([&](int k, int n) -> float { return W[(size_t)k * 1024 + n]; }, WT, 256, scr, kb, nb, lane); }
    }
}

template <int MODE>
__device__ __forceinline__ void norm_phase(KPRef p, int l, int gw, int NGW, int lane) {
    const float* src = (MODE == 0) ? p.in[0] : p.out;
    const float* gain = (MODE == 3) ? p.in[18] : (MODE == 2 ? p.in[10] + l * 1024 : p.in[1] + l * 1024);
    const bf16_t* ys = (const bf16_t*)(p.ws + WS_YS); const float* tokw = (const float*)(p.ws + WS_TOKW);
    f32x4 gg[4];
#pragma unroll
    for (int j = 0; j < 4; ++j) gg[j] = ((const f32x4*)gain)[lane + 64 * j];
    constexpr int NR = (MODE == 1 || MODE == 3) ? 2 : 4;
    for (int row0 = gw * NR; row0 < T_; row0 += NGW * NR) {
        f32x4 v[NR][4];
#pragma unroll
        for (int r = 0; r < NR; ++r) { const f32x4* xr = (const f32x4*)(src + (size_t)(row0 + r) * 1024) + lane;
#pragma unroll
            for (int j = 0; j < 4; ++j) v[r][j] = xr[64 * j]; }
        if (MODE == 1 || MODE == 3) {
            u32x2 ya[NR][4], yb[NR][4]; float w0[NR], w1[NR];
#pragma unroll
            for (int r = 0; r < NR; ++r) { const int row = row0 + r; w0[r] = tokw[2 * row]; w1[r] = tokw[2 * row + 1];
                const u32x2* y0 = (const u32x2*)(ys + (size_t)(2 * row) * 1024) + lane; const u32x2* y1 = (const u32x2*)(ys + (size_t)(2 * row + 1) * 1024) + lane;
#pragma unroll
                for (int j = 0; j < 4; ++j) { ya[r][j] = y0[64 * j]; yb[r][j] = y1[64 * j]; } }
#pragma unroll
            for (int r = 0; r < NR; ++r) {
#pragma unroll
                for (int j = 0; j < 4; ++j) { const u32x2 a = ya[r][j], b = yb[r][j];
                    v[r][j][0] += w0[r] * __uint_as_float(a.x << 16) + w1[r] * __uint_as_float(b.x << 16); v[r][j][1] += w0[r] * __uint_as_float(a.x & 0xffff0000u) + w1[r] * __uint_as_float(b.x & 0xffff0000u);
                    v[r][j][2] += w0[r] * __uint_as_float(a.y << 16) + w1[r] * __uint_as_float(b.y << 16); v[r][j][3] += w0[r] * __uint_as_float(a.y & 0xffff0000u) + w1[r] * __uint_as_float(b.y & 0xffff0000u); }
                if (MODE == 1) { f32x4* hr = (f32x4*)(p.out + (size_t)(row0 + r) * 1024) + lane;
#pragma unroll
                    for (int j = 0; j < 4; ++j) hr[64 * j] = v[r][j]; } }
        }
#pragma unroll
        for (int r = 0; r < NR; ++r) {
            float s = 0.f;
#pragma unroll
            for (int j = 0; j < 4; ++j) s += (v[r][j][0] * v[r][j][0] + v[r][j][1] * v[r][j][1]) + (v[r][j][2] * v[r][j][2] + v[r][j][3] * v[r][j][3]);
            const float rstd = rsqrtf(wave_sum(s) * (1.0f / 1024.0f) + NORM_EPS);
            if (MODE == 3) { f32x4* orow = (f32x4*)(p.out + (size_t)(row0 + r) * 1024) + lane;
#pragma unroll
                for (int j = 0; j < 4; ++j) orow[64 * j] = v[r][j] * rstd * gg[j];
            } else {
                f32x4 o[4]; float am = 0.f;
#pragma unroll
                for (int j = 0; j < 4; ++j) { o[j] = v[r][j] * rstd * gg[j]; am = fmaxf(fmaxf(am, fmaxf(fabsf(o[j][0]), fabsf(o[j][1]))), fmaxf(fabsf(o[j][2]), fabsf(o[j][3]))); }
#pragma unroll
                for (int of = 1; of < 64; of <<= 1) am = fmaxf(am, __shfl_xor(am, of));
                const float qs = (am > 0.f) ? 127.0f / am : 0.f;
                unsigned* o4 = (unsigned*)(p.ws + WS_U8 + (size_t)(row0 + r) * 1024) + lane;
#pragma unroll
                for (int j = 0; j < 4; ++j) { const int q0 = (int)rintf(o[j][0] * qs), q1 = (int)rintf(o[j][1] * qs), q2 = (int)rintf(o[j][2] * qs), q3 = (int)rintf(o[j][3] * qs);
                    o4[64 * j] = (unsigned)(q0 & 0xff) | ((unsigned)(q1 & 0xff) << 8) | ((unsigned)(q2 & 0xff) << 16) | ((unsigned)(q3 & 0xff) << 24); }
                if (lane == 0) ((float*)(p.ws + WS_SU))[row0 + r] = am * (1.0f / 127.0f);
                if (MODE == 2) { u32x2* o8 = (u32x2*)(p.ws + WS_U2BF + (size_t)(row0 + r) * 2048) + lane;
#pragma unroll
                    for (int j = 0; j < 4; ++j) { u32x2 w; w.x = pk2(o[j][0], o[j][1]); w.y = pk2(o[j][2], o[j][3]); o8[64 * j] = w; } }
            }
        }
    }
}

constexpr int LA_QS = 0, LA_KS = 10240, LA_VS = 20480  , LA_KD = 38912  , LA_PS = 49152  , LA_PW = 58368, LA_PW_WAVE = 4352,
              LA_LA = 93184, LA_AS = 110080, LA_END = 118272;
__device__ __forceinline__ void unpack8f(float (&d)[8], u32x4 kk) {
    d[0] = __uint_as_float(kk.x << 16); d[1] = __uint_as_float(kk.x & 0xffff0000u); d[2] = __uint_as_float(kk.y << 16); d[3] = __uint_as_float(kk.y & 0xffff0000u);
    d[4] = __uint_as_float(kk.z << 16); d[5] = __uint_as_float(kk.z & 0xffff0000u); d[6] = __uint_as_float(kk.w << 16); d[7] = __uint_as_float(kk.w & 0xffff0000u); }
__device__ __forceinline__ u32x4 pack8f(const float (&o)[8]) { u32x4 w; w.x = pk2(o[0], o[1]); w.y = pk2(o[2], o[3]); w.z = pk2(o[4], o[5]); w.w = pk2(o[6], o[7]); return w; }

__device__ __forceinline__ void gla_decay_front(KPRef p, int l, unsigned char* lds, const bf16_t* zrow0, int h, int tid) {
    float* LA = (float*)(lds + LA_LA); float* AS = (float*)(lds + LA_AS);
    const int lane = tid & 63, wave = __builtin_amdgcn_readfirstlane(tid >> 6);
    if (tid < 256) { const int t = tid >> 1, hf = tid & 1; float a[8]; unpack8f(a, *(const u32x4*)(zrow0 + (size_t)t * ZW + Z_GA + 8 * hf));
#pragma unroll
        for (int e = 0; e < 8; ++e) AS[t * 16 + 8 * hf + e] = a[e]; }
    const int d = tid & 31; const float* wa2 = p.in[3] + (size_t)l * 16 * 128 + h * 32 + d; float wcol[16];
#pragma unroll
    for (int r = 0; r < 16; ++r) wcol[r] = wa2[r * 128];
    const float bias = p.in[4][l * 128 + h * 32 + d];
    __syncthreads();
#pragma unroll
    for (int i = 0; i < 8; ++i) { const int t = (tid >> 5) + 16 * i; float x = bias;
#pragma unroll
        for (int r = 0; r < 16; ++r) x += AS[t * 16 + r] * wcol[r];
        LA[t * 33 + d] = (fminf(x, 0.f) - log1pf(expf(-fabsf(x)))) * (1.0f / 16.0f); }
    __syncthreads();
#pragma unroll
    for (int s8 = 0; s8 < 8; ++s8) { const int s = wave * 8 + s8, ch = s >> 5, dd = s & 31; float v = LA[(64 * ch + lane) * 33 + dd];
#pragma unroll
        for (int o = 1; o < 64; o <<= 1) { const float t = __shfl_up(v, o); if (lane >= o) v += t; }
        LA[(64 * ch + lane) * 33 + dd] = v; }
    __syncthreads();
}
__device__ __forceinline__ void la_stage_v(unsigned char* lds, const bf16_t* zrow0, int vcol, int tid) {
    bf16_t* VS = (bf16_t*)(lds + LA_VS);
#pragma unroll
    for (int i = 0; i < 2; ++i) { const int c = tid + 512 * i, t = c >> 3, oct = c & 7; *(u32x4*)(VS + t * 72 + 8 * oct) = *(const u32x4*)(zrow0 + (size_t)t * ZW + vcol + 8 * oct); }
}
__device__ __forceinline__ void la_kv_mfma(unsigned char* lds, float* out0, int nch, int clen, int tid) {
    const bf16_t* KD = (const bf16_t*)(lds + LA_KD); const bf16_t* VS = (const bf16_t*)(lds + LA_VS);
    const int lane = tid & 63, wave = __builtin_amdgcn_readfirstlane(tid >> 6), c16 = lane & 15, g = lane >> 4;
    const int ntile = 8 * nch;
    for (int ti = wave; ti < ntile; ti += 8) { const int ch = ti >> 3, dt = (ti >> 2) & 1, et = ti & 3, tok0 = ch * clen;
        f32x4 acc = (f32x4){0.f, 0.f, 0.f, 0.f};
        for (int s = 0; s < clen / 32; ++s) { const int r0 = tok0 + 32 * s + 8 * g;
            acc = MFMA16(tr_frag(KD, 40, r0, r0 + 4, 16 * dt, lane), tr_frag(VS, 72, r0, r0 + 4, 16 * et, lane), acc); }
        float* o = out0 + (size_t)ch * 2048 + (16 * dt + 4 * g) * 64 + 16 * et + c16;
#pragma unroll
        for (int r = 0; r < 4; ++r) o[r * 64] = acc[r]; }
}
__device__ __forceinline__ void gla_kv_unit(KPRef p, int l, unsigned char* lds, int unit, int tid) {
    const int c = unit & 63, h = (unit >> 6) & 3, b = unit >> 8;
    const bf16_t* zrow0 = (const bf16_t*)(p.ws + WS_Z) + ((size_t)b * S_ + (size_t)c * 128) * ZW;
    gla_decay_front(p, l, lds, zrow0, h, tid);
    const float* LA = (const float*)(lds + LA_LA); bf16_t* KD = (bf16_t*)(lds + LA_KD);
    { const int t = tid >> 2, oct = tid & 3, ch = t >> 6; float k[8]; unpack8f(k, *(const u32x4*)(zrow0 + (size_t)t * ZW + Z_GK + h * 32 + 8 * oct));
#pragma unroll
      for (int e = 0; e < 8; ++e) { const int d = 8 * oct + e; k[e] *= expf(LA[(64 * ch + 63) * 33 + d] - LA[t * 33 + d]); }
      *(u32x4*)(KD + t * 40 + 8 * oct) = pack8f(k); }
    la_stage_v(lds, zrow0, Z_GV + h * 64, tid);
    __syncthreads();
    const int cu = ((b * 4 + h) * 128 + 2 * c);
    la_kv_mfma(lds, (float*)(p.ws + WS_GKV) + (size_t)cu * 2048, 2, 64, tid);
    if (tid < 64) { const int ch = tid >> 5, d = tid & 31; ((float*)(p.ws + WS_GDEC))[(size_t)(cu + ch) * 32 + d] = expf(LA[(64 * ch + 63) * 33 + d]); }
    __syncthreads();
}
__device__ __forceinline__ void la_out_mfma(unsigned char* lds, const bf16_t* zrow0, int gcol, const float* ng, bf16_t* orow0, int ocol, int clen, int tid) {
    const bf16_t* QS = (const bf16_t*)(lds + LA_QS); const bf16_t* KS = (const bf16_t*)(lds + LA_KS); const bf16_t* VS = (const bf16_t*)(lds + LA_VS); const bf16_t* PS = (const bf16_t*)(lds + LA_PS);
    const int lane = tid & 63, wave = __builtin_amdgcn_readfirstlane(tid >> 6), c16 = lane & 15, g = lane >> 4;
    float* PWf = (float*)(lds + LA_PW + wave * LA_PW_WAVE);
    const int ch = (clen == 64) ? (wave >> 2) : 0, kt0 = (clen == 64) ? 4 * ch : 0;
    const bf16x8 qa = *(const bf16x8*)(QS + (16 * wave + c16) * 40 + 8 * g);
    f32x4 O[4];
#pragma unroll
    for (int et = 0; et < 4; ++et) O[et] = MFMA16(qa, tr_frag(PS + ch * 32 * 72, 72, 8 * g, 8 * g + 4, 16 * et, lane), ((f32x4){0.f, 0.f, 0.f, 0.f}));
    for (int s = kt0 >> 1; s <= (wave >> 1); ++s) {
        f32x4 P0, P1;
        { const int kt = 2 * s; P0 = MFMA16(*(const bf16x8*)(KS + (16 * kt + c16) * 40 + 8 * g), qa, ((f32x4){0.f, 0.f, 0.f, 0.f}));
          if (kt == wave) {
#pragma unroll
              for (int r = 0; r < 4; ++r) if (4 * g + r > c16) P0[r] = 0.f; } }
        { const int kt = 2 * s + 1;
          if (kt <= wave) { P1 = MFMA16(*(const bf16x8*)(KS + (16 * kt + c16) * 40 + 8 * g), qa, ((f32x4){0.f, 0.f, 0.f, 0.f}));
            if (kt == wave) {
#pragma unroll
                for (int r = 0; r < 4; ++r) if (4 * g + r > c16) P1[r] = 0.f; } }
          else P1 = (f32x4){0.f, 0.f, 0.f, 0.f}; }
        const bf16x8 pa = pack_p(P0, P1);
#pragma unroll
        for (int et = 0; et < 4; ++et) O[et] = MFMA16(pa, tr_frag(VS, 72, 32 * s + 4 * g, 32 * s + 16 + 4 * g, 16 * et, lane), O[et]); }
    float rs[4];
#pragma unroll
    for (int r = 0; r < 4; ++r) { float ss = O[0][r] * O[0][r] + O[1][r] * O[1][r] + O[2][r] * O[2][r] + O[3][r] * O[3][r];
#pragma unroll
        for (int o = 1; o < 16; o <<= 1) ss += __shfl_xor(ss, o);
        rs[r] = rsqrtf(ss * (1.0f / 64.0f) + NORM_EPS); }
#pragma unroll
    for (int et = 0; et < 4; ++et)
#pragma unroll
        for (int r = 0; r < 4; ++r) PWf[(4 * g + r) * 68 + 16 * et + c16] = O[et][r] * rs[r];
    LDS_WAIT();
#pragma unroll
    for (int i = 0; i < 2; ++i) { const int cidx = lane + 64 * i, row = cidx >> 3, oct = cidx & 7; const int t = 16 * wave + row;
        float gt[8]; unpack8f(gt, *(const u32x4*)(zrow0 + (size_t)t * ZW + gcol + 8 * oct));
        const f32x4 o0 = *(const f32x4*)(PWf + row * 68 + 8 * oct), o1 = *(const f32x4*)(PWf + row * 68 + 8 * oct + 4), n0 = *(const f32x4*)(ng + 8 * oct), n1 = *(const f32x4*)(ng + 8 * oct + 4);
        float o[8];
#pragma unroll
        for (int e = 0; e < 4; ++e) { o[e] = o0[e] * n0[e] * (gt[e] * sigmoidf_(gt[e])); o[4 + e] = o1[e] * n1[e] * (gt[4 + e] * sigmoidf_(gt[4 + e])); }
        *(u32x4*)(orow0 + (size_t)t * 1024 + ocol + 8 * oct) = pack8f(o); }
    LDS_WAIT();
}
__device__ __forceinline__ void gla_out_unit(KPRef p, int l, unsigned char* lds, int unit, int tid) {
    const int c = unit & 63, h = (unit >> 6) & 3, b = unit >> 8;
    const size_t t0 = (size_t)b * S_ + (size_t)c * 128;
    const bf16_t* zrow0 = (const bf16_t*)(p.ws + WS_Z) + t0 * ZW;
    gla_decay_front(p, l, lds, zrow0, h, tid);
    const float* LA = (const float*)(lds + LA_LA); bf16_t* QS = (bf16_t*)(lds + LA_QS); bf16_t* KS = (bf16_t*)(lds + LA_KS); bf16_t* PS = (bf16_t*)(lds + LA_PS);
    { const int t = tid >> 2, oct = tid & 3; float k[8], q[8]; unpack8f(k, *(const u32x4*)(zrow0 + (size_t)t * ZW + Z_GK + h * 32 + 8 * oct)); unpack8f(q, *(const u32x4*)(zrow0 + (size_t)t * ZW + Z_GQ + h * 32 + 8 * oct));
#pragma unroll
      for (int e = 0; e < 8; ++e) { const float bb = LA[t * 33 + 8 * oct + e]; q[e] *= expf(bb); k[e] *= expf(-bb); }
      *(u32x4*)(QS + t * 40 + 8 * oct) = pack8f(q); *(u32x4*)(KS + t * 40 + 8 * oct) = pack8f(k); }
    la_stage_v(lds, zrow0, Z_GV + h * 64, tid);
    const int cu = ((b * 4 + h) * 128 + 2 * c); const float* prev = (const float*)(p.ws + WS_GKV) + (size_t)cu * 2048;
    { const int row = tid >> 3, oct = tid & 7; const f32x4 a = *(const f32x4*)(prev + row * 64 + 8 * oct), bq = *(const f32x4*)(prev + row * 64 + 8 * oct + 4);
      float o[8] = {a[0], a[1], a[2], a[3], bq[0], bq[1], bq[2], bq[3]}; *(u32x4*)(PS + row * 72 + 8 * oct) = pack8f(o); }
    __syncthreads();
    la_out_mfma(lds, zrow0, Z_GR + h * 64, p.in[5] + l * 64, (bf16_t*)(p.ws + WS_O) + t0 * 1024, 0 + h * 64, 64, tid);
    __syncthreads();
}
__device__ __forceinline__ void rope_cs(float pos, float invf, float& c, float& s) {
    const float ang = pos * invf; const double t = (double)ang * 0.15915494309189535; const float fr = (float)(t - floor(t));
    c = __builtin_amdgcn_cosf(fr); s = __builtin_amdgcn_sinf(fr);
}
__device__ __forceinline__ void ret_cs_table(KPRef p, unsigned char* lds, int pos0, int tid) {
    f32x2* CS = (f32x2*)(lds + LA_LA);
#pragma unroll
    for (int i = 0; i < 4; ++i) { const int idx = tid + 512 * i, t = idx >> 4, f = idx & 15; float c, s; rope_cs((float)(pos0 + t), p.inv_freq[f], c, s); CS[idx] = (f32x2){c, s}; }
}
__device__ __forceinline__ void ret_rot8(const unsigned char* lds, const bf16_t* src  , int t, int oct, float (&o)[8]) {
    const f32x2* CS = (const f32x2*)(lds + LA_LA); float own[8], oth[8]; unpack8f(own, *(const u32x4*)(src + 8 * oct)); unpack8f(oth, *(const u32x4*)(src + 8 * (oct ^ 2)));
#pragma unroll
    for (int e = 0; e < 8; ++e) { const f32x2 cs = CS[t * 16 + 8 * (oct & 1) + e]; o[e] = (oct < 2) ? (own[e] * cs[0] - oth[e] * cs[1]) : (oth[e] * cs[1] + own[e] * cs[0]); }
}
__device__ __forceinline__ void ret_kv_unit(KPRef p, unsigned char* lds, int unit, int tid) {
    const int n = unit & 63, bh = unit >> 6, h = bh & 3, b = bh >> 2;
    const bf16_t* zrow0 = (const bf16_t*)(p.ws + WS_Z) + ((size_t)b * S_ + (size_t)n * 128) * ZW;
    ret_cs_table(p, lds, n * 128, tid);
    la_stage_v(lds, zrow0, Z_RV + h * 64, tid);
    __syncthreads();
    bf16_t* KD = (bf16_t*)(lds + LA_KD); const float lg = p.ret_lg2[h];
    { const int t = tid >> 2, oct = tid & 3; float k[8]; ret_rot8(lds, zrow0 + (size_t)t * ZW + Z_RK + h * 32, t, oct, k); const float dk = __builtin_amdgcn_exp2f((float)(127 - t) * lg);
#pragma unroll
      for (int e = 0; e < 8; ++e) k[e] *= dk;
      *(u32x4*)(KD + t * 40 + 8 * oct) = pack8f(k); }
    __syncthreads();
    la_kv_mfma(lds, (float*)(p.ws + WS_RKV) + (size_t)unit * 2048, 1, 128, tid);
    __syncthreads();
}
__device__ __forceinline__ void ret_out_unit(KPRef p, int l, unsigned char* lds, int unit, int tid) {
    const int n = unit & 63, bh = unit >> 6, h = bh & 3, b = bh >> 2;
    const size_t t0 = (size_t)b * S_ + (size_t)n * 128;
    const bf16_t* zrow0 = (const bf16_t*)(p.ws + WS_Z) + t0 * ZW;
    ret_cs_table(p, lds, n * 128, tid);
    la_stage_v(lds, zrow0, Z_RV + h * 64, tid);
    const float lg = p.ret_lg2[h]; bf16_t* PS = (bf16_t*)(lds + LA_PS); const float* prev = (const float*)(p.ws + WS_RKV) + (size_t)unit * 2048; const float g1 = __builtin_amdgcn_exp2f(lg);
    if (tid < 256) { const int row = tid >> 3, oct = tid & 7; const f32x4 a = *(const f32x4*)(prev + row * 64 + 8 * oct), bq = *(const f32x4*)(prev + row * 64 + 8 * oct + 4);
      float o[8] = {a[0] * g1, a[1] * g1, a[2] * g1, a[3] * g1, bq[0] * g1, bq[1] * g1, bq[2] * g1, bq[3] * g1}; *(u32x4*)(PS + row * 72 + 8 * oct) = pack8f(o); }
    __syncthreads();
    bf16_t* QS = (bf16_t*)(lds + LA_QS); bf16_t* KS = (bf16_t*)(lds + LA_KS);
    { const int t = tid >> 2, oct = tid & 3; float k[8], q[8]; ret_rot8(lds, zrow0 + (size_t)t * ZW + Z_RK + h * 32, t, oct, k); ret_rot8(lds, zrow0 + (size_t)t * ZW + Z_RQ + h * 32, t, oct, q);
      const float dq = __builtin_amdgcn_exp2f((float)t * lg), dk = __builtin_amdgcn_exp2f(-(float)t * lg);
#pragma unroll
      for (int e = 0; e < 8; ++e) { q[e] *= dq; k[e] *= dk; }
      *(u32x4*)(QS + t * 40 + 8 * oct) = pack8f(q); *(u32x4*)(KS + t * 40 + 8 * oct) = pack8f(k); }
    __syncthreads();
    la_out_mfma(lds, zrow0, Z_RG + h * 64, p.in[7] + l * 64, (bf16_t*)(p.ws + WS_O) + t0 * 1024, 768 + h * 64, 128, tid);
    __syncthreads();
}

__device__ __forceinline__ void scan_phase(KPRef p, int wg, int tid) {
    if (wg < 64) {
        const int bh = wg >> 2, elem = (wg & 3) * 512 + tid, d = elem >> 6;
        float* base = (float*)(p.ws + WS_GKV) + (size_t)bh * 128 * 2048 + elem; const float* dec = (const float*)(p.ws + WS_GDEC) + (size_t)bh * 128 * 32 + d;
        float s = 0.f;
#pragma unroll 1
        for (int n0 = 0; n0 < 128; n0 += 32) { float kv[32], dc[32];
#pragma unroll
            for (int j = 0; j < 32; ++j) { kv[j] = base[(size_t)(n0 + j) * 2048]; dc[j] = dec[(n0 + j) * 32]; }
#pragma unroll
            for (int j = 0; j < 32; ++j) { base[(size_t)(n0 + j) * 2048] = s; s = dc[j] * s + kv[j]; } }
    } else if (wg < 128) {
        const int w2 = wg - 64, bh = w2 >> 2, h = bh & 3, elem = (w2 & 3) * 512 + tid;
        float* base = (float*)(p.ws + WS_RKV) + (size_t)bh * 64 * 2048 + elem; const float dc = __builtin_amdgcn_exp2f(128.0f * p.ret_lg2[h]);
        float s = 0.f;
#pragma unroll 1
        for (int n0 = 0; n0 < 64; n0 += 32) { float kv[32];
#pragma unroll
            for (int j = 0; j < 32; ++j) kv[j] = base[(size_t)(n0 + j) * 2048];
#pragma unroll
            for (int j = 0; j < 32; ++j) { base[(size_t)(n0 + j) * 2048] = s; s = dc * s + kv[j]; } }
    }
}

__device__ __forceinline__ void kmean_unit(KPRef p, float* sm, int unit, int tid) {
    const bf16_t* z = (const bf16_t*)(p.ws + WS_Z); const size_t t0 = (size_t)unit * 256;
    const int c = tid & 255, part = tid >> 8; float s = 0.f;
#pragma unroll 8
    for (int i = part * 128; i < part * 128 + 128; ++i) s += bf2f(z[(t0 + i) * ZW + Z_MK + c]);
    sm[tid] = s; __syncthreads();
    if (tid < 256) ((float*)(p.ws + WS_KMEAN))[(size_t)unit * 256 + tid] = (sm[tid] + sm[tid + 256]) * (1.0f / 256.0f);
    __syncthreads();
}

constexpr int AT_BUF = 65536  , AT_PW = 131072, AT_PW_WAVE = 2304, AT_WSF = 149504, LDS_MTAB = 151552;
__device__ __forceinline__ void att_dma(unsigned char* lds, int buf, const bf16_t* kg, const bf16_t* vg, int key_lo_valid, int tid) {
    const int lane = tid & 63, wave = __builtin_amdgcn_readfirstlane(tid >> 6);
#pragma unroll
    for (int i = 0; i < 4; ++i) { const int j = wave * 4 + i, row = 8 * j + (lane >> 3), pos = lane & 7; const int srow = row < key_lo_valid ? key_lo_valid : row;
        const size_t goff = (size_t)srow * ZW + 8 * (pos ^ (row & 7));
        __builtin_amdgcn_global_load_lds((const unsigned*)(kg + goff), (LAS unsigned*)(LAS unsigned char*)(lds + buf * AT_BUF + j * 1024), 16, 0, 0);
        __builtin_amdgcn_global_load_lds((const unsigned*)(vg + goff), (LAS unsigned*)(LAS unsigned char*)(lds + buf * AT_BUF + 32768 + j * 1024), 16, 0, 0); }
}
template <class Fn>
__device__ __forceinline__ void att_loadq(bf16x8 (&Q)[2][2], const Fn& F, int tid) {
    const int lane = tid & 63, wave = __builtin_amdgcn_readfirstlane(tid >> 6), c16 = lane & 15, g = lane >> 4;
#pragma unroll
    for (int rt = 0; rt < 2; ++rt) { const bf16_t* qp = F.rowptr(32 * wave + 16 * rt + c16); Q[rt][0] = *(const bf16x8*)(qp + 8 * g); Q[rt][1] = *(const bf16x8*)(qp + 32 + 8 * g); }
}
__device__ __forceinline__ bf16x8 tr_frag_sw(const unsigned char* tile, int rowa, int rowb, int col0, int lane) {
    const int i = lane & 15, q = i >> 2, pp = i & 3, ch = (col0 >> 3) + (pp >> 1), sub = (pp & 1) * 8, ra = rowa + q, rb = rowb + q;
    const v4i16_t lo = lds_tr16((const bf16_t*)(tile + ra * 128 + ((ch ^ (ra & 7)) << 4) + sub)), hi = lds_tr16((const bf16_t*)(tile + rb * 128 + ((ch ^ (rb & 7)) << 4) + sub));
    return (bf16x8){lo[0], lo[1], lo[2], lo[3], hi[0], hi[1], hi[2], hi[3]};
}
template <class Fn>
__device__ __forceinline__ void att_compute(unsigned char* lds, int buf, const Fn& F, bf16x8 (&Q)[2][2], const Fn& Fnext, bool has_next, int tid) {
    const int lane = tid & 63, wave = __builtin_amdgcn_readfirstlane(tid >> 6), c16 = lane & 15, g = lane >> 4;
    const unsigned char* KS = lds + buf * AT_BUF; const unsigned char* VS = KS + 32768; bf16_t* PW = (bf16_t*)(lds + AT_PW + wave * AT_PW_WAVE); float* WSF = (float*)(lds + AT_WSF + wave * 256);
#pragma unroll 1
    for (int rt = 0; rt < 2; ++rt) {
        const int rbase = 32 * wave + 16 * rt;
        const typename Fn::Pre pre = F.prefetch(rbase, lane);
        const bf16x8 qa0 = rt ? Q[1][0] : Q[0][0], qa1 = rt ? Q[1][1] : Q[0][1];
        f32x4 S[16]; float m = -1e30f;
#pragma unroll
        for (int ct = 0; ct < 16; ++ct) {
            if (F.live(rbase, ct)) {
                const int R = 16 * ct + c16; const unsigned char* kp = KS + R * 128;
                const bf16x8 k0 = *(const bf16x8*)(kp + ((g ^ (R & 7)) << 4)), k1 = *(const bf16x8*)(kp + (((4 + g) ^ (R & 7)) << 4));
                f32x4 acc = (f32x4){0.f, 0.f, 0.f, 0.f}; acc = MFMA16(k0, qa0, acc); acc = MFMA16(k1, qa1, acc);
                if (Fn::MASKED) {
#pragma unroll
                    for (int r = 0; r < 4; ++r) { int kk = 16 * ct + 4 * g + r; asm volatile("" : "+v"(kk), "+v"(acc[r]));
                        acc[r] += F.pen(rbase + c16, kk); } }
                m = fmaxf(fmaxf(m, fmaxf(acc[0], acc[1])), fmaxf(acc[2], acc[3])); S[ct] = acc;
            } else S[ct] = (f32x4){-1e30f, -1e30f, -1e30f, -1e30f};
        }
        m = fmaxf(m, __shfl_xor(m, 16)); m = fmaxf(m, __shfl_xor(m, 32));
        float l = 0.f;
#pragma unroll
        for (int ct = 0; ct < 16; ++ct) {
            if (F.live(rbase, ct)) {
#pragma unroll
                for (int r = 0; r < 4; ++r) { const float pr = __builtin_amdgcn_exp2f(S[ct][r] - m); S[ct][r] = pr; l += pr; }
            } else S[ct] = (f32x4){0.f, 0.f, 0.f, 0.f};
        }
        l += __shfl_xor(l, 16); l += __shfl_xor(l, 32);
        f32x4 O[4];
#pragma unroll
        for (int dt = 0; dt < 4; ++dt) O[dt] = (f32x4){0.f, 0.f, 0.f, 0.f};
#pragma unroll
        for (int s8 = 0; s8 < 8; ++s8) if (F.live(rbase, 2 * s8) || F.live(rbase, 2 * s8 + 1)) { const bf16x8 pa = pack_p(S[2 * s8], S[2 * s8 + 1]);
#pragma unroll
            for (int dt = 0; dt < 4; ++dt) O[dt] = MFMA16(pa, tr_frag_sw(VS, 32 * s8 + 4 * g, 32 * s8 + 16 + 4 * g, 16 * dt, lane), O[dt]); }
        if (rt == 1 && has_next) att_loadq(Q, Fnext, tid);
        float f[4];
#pragma unroll
        for (int r = 0; r < 4; ++r) { const float mr = __shfl(m, 4 * g + r), lr = __shfl(l, 4 * g + r); f[r] = F.scale(rbase + 4 * g + r, mr, lr, pre, r, WSF + (4 * g + r) * 4, c16 == 0); }
#pragma unroll
        for (int dt = 0; dt < 4; ++dt)
#pragma unroll
            for (int r = 0; r < 4; ++r) PW[(4 * g + r) * 72 + 16 * dt + c16] = (bf16_t)f2bf(O[dt][r] * f[r]);
        LDS_WAIT();
#pragma unroll
        for (int i = 0; i < 2; ++i) { const int ch = lane + 64 * i, row = ch >> 3, oct = ch & 7;
            const u32x4 v = *(const u32x4*)(PW + row * 72 + 8 * oct); F.store(rbase + row, oct, v, pre, i, WSF + row * 4); }
        LDS_WAIT();
    }
}
template <class Fn, class Gen>
__device__ __forceinline__ void attn_loop(unsigned char* lds, const Gen& G, int tid) {
    Fn Fc, Fx; const bf16_t* kg; const bf16_t* vg; int lo;
    bool have = G.get(0, Fc, kg, vg, lo);
    if (!have) return;
    bf16x8 Q[2][2];
    att_dma(lds, 0, kg, vg, lo, tid); att_loadq(Q, Fc, tid);
    int buf = 0;
    for (int i = 1; have; ++i) {
        asm volatile("s_waitcnt vmcnt(0)" ::: "memory");
        __syncthreads();
        const bool hn = G.get(i, Fx, kg, vg, lo);
        if (hn) att_dma(lds, buf ^ 1, kg, vg, lo, tid);
        att_compute(lds, buf, Fc, Q, Fx, hn, tid);
        Fc = Fx; have = hn; buf ^= 1;
    }
    asm volatile("s_waitcnt vmcnt(0)" ::: "memory");
    __syncthreads();
}
struct NoPre {};

struct SwaFn { typedef NoPre Pre; static constexpr bool MASKED = true;
    __device__ __forceinline__ bool live(int rbase, int ct) const { const int i0 = rbase & 127; return 16 * ct + 15 >= i0 + 1 && 16 * ct <= i0 + 143; } const bf16_t* z; bf16_t* ob; size_t tb; int q0, kvh; float sink2_0, sink2_1;
    __device__ __forceinline__ const bf16_t* rowptr(int row) const { return z + (tb + q0 + (row & 127)) * ZW + Z_SQ + (kvh * 2 + (row >> 7)) * 64; }
    __device__ __forceinline__ float pen(int row, int kk) const { const int d = (row & 127) + 128 - kk; return __int_as_float(((d | (127 - d) | (q0 - 128 + kk)) >> 31) & (int)0xF149F2CAu); }
    __device__ __forceinline__ NoPre prefetch(int, int) const { return NoPre{}; }
    __device__ __forceinline__ float scale(int row, float m, float l, const NoPre&, int, float*, bool) const { const float sk = (row >> 7) ? sink2_1 : sink2_0; const float M = fmaxf(m, sk), w0 = __builtin_amdgcn_exp2f(m - M);
        return w0 / (l * w0 + __builtin_amdgcn_exp2f(sk - M)); }
    __device__ __forceinline__ void store(int row, int oct, u32x4 v, const NoPre&, int, const float*) const { *(u32x4*)(ob + (tb + q0 + (row & 127)) * 1024 + 256 + (kvh * 2 + (row >> 7)) * 64 + 8 * oct) = v; }
};
struct SwaGen { const bf16_t* z; bf16_t* ob; const float* sinks; int wg, G;
    __device__ __forceinline__ bool get(int i, SwaFn& F, const bf16_t*& kg, const bf16_t*& vg, int& lo) const {
        const int unit = wg + i * G; if (unit >= 512) return false;
        const int qb = unit & 63, kvh = (unit >> 6) & 1, b = unit >> 7; const size_t tb = (size_t)b * S_; const int q0 = qb * 128;
        F = SwaFn{z, ob, tb, q0, kvh, sinks[kvh * 2] * LOG2E, sinks[kvh * 2 + 1] * LOG2E};
        const long kb = (long)tb + q0 - 128;
        kg = z + kb * ZW + Z_SK + kvh * 64; vg = z + kb * ZW + Z_SV + kvh * 64; lo = (q0 == 0) ? 128 : 0; return true; }
};

constexpr int ML_PER_BH = 126976;
__device__ __forceinline__ int ml_off(int j) { return 256 * (31 * j - (j * (j - 1)) / 2); }
__device__ __forceinline__ void moba_select(KPRef p, int wg, int tid) {
    const int gid = wg * NTHREADS + tid, t = gid >> 2, h = gid & 3, b = t >> 13, tl = t & 8191, blk = tl >> 8;
    const bf16_t* z = (const bf16_t*)(p.ws + WS_Z);
    float q[64];
    { const bf16_t* qp = z + (size_t)t * ZW + Z_MQ + h * 64;
#pragma unroll
      for (int c = 0; c < 8; ++c) { const u32x4 kk = *(const u32x4*)(qp + 8 * c);
        q[8 * c + 0] = __uint_as_float(kk.x << 16); q[8 * c + 1] = __uint_as_float(kk.x & 0xffff0000u); q[8 * c + 2] = __uint_as_float(kk.y << 16); q[8 * c + 3] = __uint_as_float(kk.y & 0xffff0000u);
        q[8 * c + 4] = __uint_as_float(kk.z << 16); q[8 * c + 5] = __uint_as_float(kk.z & 0xffff0000u); q[8 * c + 6] = __uint_as_float(kk.w << 16); q[8 * c + 7] = __uint_as_float(kk.w & 0xffff0000u); } }
    const float* km = (const float*)(p.ws + WS_KMEAN) + (size_t)b * 32 * 256 + h * 64;
    float v0 = -3e38f, v1 = -3e38f, v2 = -3e38f; int i0 = -1, i1 = -1, i2 = -1;
#pragma unroll 1
    for (int nb = 0; nb < blk; ++nb) { const f32x4* kr = (const f32x4*)(km + nb * 256); float s = 0.f;
#pragma unroll
        for (int c = 0; c < 16; ++c) { const f32x4 kv = kr[c]; s += q[4 * c] * kv[0] + q[4 * c + 1] * kv[1] + q[4 * c + 2] * kv[2] + q[4 * c + 3] * kv[3]; }
        if (s > v0) { v2 = v1; i2 = i1; v1 = v0; i1 = i0; v0 = s; i0 = nb; } else if (s > v1) { v2 = v1; i2 = i1; v1 = s; i1 = nb; } else if (s > v2) { v2 = s; i2 = nb; } }
    int* cnt = (int*)(p.ws + WS_MCNT) + (b * 4 + h) * 32; int* lst = (int*)(p.ws + WS_MLIST) + (size_t)(b * 4 + h) * ML_PER_BH; f32x2* pml = (f32x2*)(p.ws + WS_PARTML) + (size_t)gid * 3;
#pragma unroll
    for (int s3 = 0; s3 < 3; ++s3) { const int sb = (s3 == 0) ? i0 : (s3 == 1 ? i1 : i2);
        if (sb >= 0) { const int pos = atomicAdd(cnt + sb, 1); lst[ml_off(sb) + pos] = tl | (s3 << 13); }
        else pml[s3] = (f32x2){-1e30f, 0.f}; }
}
struct MobaSelFn { typedef NoPre Pre; static constexpr bool MASKED = false;
    __device__ __forceinline__ bool live(int, int) const { return true; } const bf16_t* z; const int* lst; bf16_t* po; f32x2* pml; size_t tb; int h, n_valid;
    __device__ __forceinline__ int entry(int row) const { return lst[row < n_valid ? row : 0]; }
    __device__ __forceinline__ const bf16_t* rowptr(int row) const { return z + (tb + (entry(row) & 8191)) * ZW + Z_MQ + h * 64; }
    __device__ __forceinline__ float pen(int, int) const { return 0.f; }
    __device__ __forceinline__ NoPre prefetch(int, int) const { return NoPre{}; }
    __device__ __forceinline__ size_t pidx(int e) const { return ((tb + (e & 8191)) * 4 + h) * 3 + (e >> 13); }
    __device__ __forceinline__ float scale(int row, float m, float l, const NoPre&, int, float*, bool writer) const { if (writer && row < n_valid) pml[pidx(lst[row])] = (f32x2){m, l}; return 1.0f / l; }
    __device__ __forceinline__ void store(int row, int oct, u32x4 v, const NoPre&, int, const float*) const { if (row < n_valid) *(u32x4*)(po + pidx(lst[row]) * 64 + 8 * oct) = v; }
};
__device__ __forceinline__ void moba_sel_table(KPRef p, unsigned char* lds, int tid) {
    int* tab = (int*)(lds + LDS_MTAB); const int lane = tid & 63, wave = tid >> 6;
    const int cnt = ((const int*)(p.ws + WS_MCNT))[tid]; int v = (cnt + 255) >> 8;
    const int own = v;
#pragma unroll
    for (int o = 1; o < 64; o <<= 1) { const int t = __shfl_up(v, o); if (lane >= o) v += t; }
    if (lane == 63) tab[520 + wave] = v;
    __syncthreads();
    int base = 0;
    for (int w = 0; w < wave; ++w) base += tab[520 + w];
    tab[tid] = base + v - own;
    if (tid == 511) tab[512] = base + v;
    __syncthreads();
}
struct MobaSelGen { const bf16_t* z; const int* lists; const int* cnts; bf16_t* po; f32x2* pml; const int* tab; int wg, G;
    __device__ __forceinline__ bool get(int i, MobaSelFn& F, const bf16_t*& kg, const bf16_t*& vg, int& lo) const {
        const int u = wg + i * G; if (u >= tab[512]) return false;
        int lo_ = 0, hi_ = 511;
        while (lo_ < hi_) { const int mid = (lo_ + hi_ + 1) >> 1; if (tab[mid] <= u) lo_ = mid; else hi_ = mid - 1; }
        const int k = __builtin_amdgcn_readfirstlane(lo_), c = u - tab[k], bh = k >> 5, j = k & 31, b = bh >> 2, h = bh & 3;
        const int cnt = __builtin_amdgcn_readfirstlane(cnts[k]); const int nv = cnt - c * 256; const size_t tb = (size_t)b * S_;
        F = MobaSelFn{z, lists + (size_t)bh * ML_PER_BH + ml_off(j) + c * 256, po, pml, tb, h, nv < 256 ? nv : 256};
        kg = z + (tb + j * 256) * ZW + Z_MK + h * 64; vg = z + (tb + j * 256) * ZW + Z_MV + h * 64; lo = 0; return true; }
};
struct MobaOwnFn { typedef NoPre Pre; static constexpr bool MASKED = true;
    __device__ __forceinline__ bool live(int rbase, int ct) const { return 16 * ct <= rbase + 15; } const bf16_t* z; bf16_t* ob; const bf16_t* po; const f32x2* pml; size_t t0; int h;
    __device__ __forceinline__ const bf16_t* rowptr(int row) const { return z + (t0 + row) * ZW + Z_MQ + h * 64; }
    __device__ __forceinline__ float pen(int row, int kk) const { return __int_as_float(((row - kk) >> 31) & (int)0xF149F2CAu); }
    __device__ __forceinline__ NoPre prefetch(int, int) const { return NoPre{}; }
    __device__ __forceinline__ float scale(int row, float m, float l, const NoPre&, int, float* wsf, bool writer) const {
        const f32x2* ml = pml + ((t0 + row) * 4 + h) * 3; const f32x2 a = ml[0], b = ml[1], c = ml[2];
        const float M = fmaxf(fmaxf(m, a[0]), fmaxf(b[0], c[0]));
        const float w0 = __builtin_amdgcn_exp2f(m - M), wa = a[1] * __builtin_amdgcn_exp2f(a[0] - M), wb = b[1] * __builtin_amdgcn_exp2f(b[0] - M), wc = c[1] * __builtin_amdgcn_exp2f(c[0] - M);
        const float inv = 1.0f / (l * w0 + wa + wb + wc);
        if (writer) { wsf[0] = wa * inv; wsf[1] = wb * inv; wsf[2] = wc * inv; }
        return w0 * inv; }
    __device__ __forceinline__ void store(int row, int oct, u32x4 v, const NoPre&, int, const float* wsf) const {
        float o[8]; unpack8f(o, v); const bf16_t* pr = po + (((t0 + row) * 4 + h) * 3) * 64 + 8 * oct;
        u32x4 pc[3];
#pragma unroll
        for (int s = 0; s < 3; ++s) pc[s] = (wsf[s] != 0.f) ? *(const u32x4*)(pr + s * 64) : (u32x4){0u, 0u, 0u, 0u};
#pragma unroll
        for (int s = 0; s < 3; ++s) { const float w = wsf[s]; float q[8]; unpack8f(q, pc[s]);
#pragma unroll
            for (int e = 0; e < 8; ++e) o[e] += w * q[e]; }
        *(u32x4*)(ob + (t0 + row) * 1024 + 512 + h * 64 + 8 * oct) = pack8f(o); }
};
struct MobaOwnGen { const bf16_t* z; bf16_t* ob; const bf16_t* po; const f32x2* pml; int wg, G;
    __device__ __forceinline__ bool get(int i, MobaOwnFn& F, const bf16_t*& kg, const bf16_t*& vg, int& lo) const {
        const int unit = wg + i * G; if (unit >= 512) return false;
        const int qb = unit & 31, h = (unit >> 5) & 3, b = unit >> 7; const size_t t0 = (size_t)b * S_ + (size_t)qb * 256;
        F = MobaOwnFn{z, ob, po, pml, t0, h}; kg = z + t0 * ZW + Z_MK + h * 64; vg = z + t0 * ZW + Z_MV + h * 64; lo = 0; return true; }
};

__device__ __forceinline__ void route_phase(KPRef p, int l, float* sm, int wg, int tid) {
    int* se = (int*)sm;
    int* toke = (int*)(p.ws + WS_TOKE); float* tokw = (float*)(p.ws + WS_TOKW); int* tokr = (int*)(p.ws + WS_TOKR); int* hist = (int*)(p.ws + WS_HIST); int* sdst = (int*)(p.ws + WS_SDST);
    if (tid < 128) { const int t = wg * 128 + tid; const float* lg = (const float*)(p.ws + WS_LOGIT) + (size_t)t * 64; const float* bg = p.in[12] + l * 4; const float* be = p.in[14] + l * 32;
        float g0 = lg[0] + bg[0], g1 = lg[1] + bg[1], g2 = lg[2] + bg[2], g3 = lg[3] + bg[3];
        int gs = 0; float gm = g0; if (g1 > gm) { gm = g1; gs = 1; } if (g2 > gm) { gm = g2; gs = 2; } if (g3 > gm) { gm = g3; gs = 3; }
        const float gw_ = 1.0f / (expf(g0 - gm) + expf(g1 - gm) + expf(g2 - gm) + expf(g3 - gm));
        float v0 = -3e38f, v1 = -3e38f; int i0 = 0, i1 = 0;
#pragma unroll
        for (int j = 0; j < 8; ++j) { const float s = lg[4 + 8 * gs + j] + be[8 * gs + j]; if (s > v0) { v1 = v0; i1 = i0; v0 = s; i0 = j; } else if (s > v1) { v1 = s; i1 = j; } }
        const float e1 = expf(v1 - v0), w0 = 1.0f / (1.0f + e1), w1 = e1 * w0;
        const int ea = 8 * gs + i0, eb = 8 * gs + i1;
        se[2 * tid] = ea; se[2 * tid + 1] = eb; toke[2 * t] = ea; toke[2 * t + 1] = eb; tokw[2 * t] = w0 * gw_; tokw[2 * t + 1] = w1 * gw_; }
    __syncthreads();
    if (tid < 256) { const int e = se[tid]; int r = 0;
#pragma unroll 4
        for (int a = 0; a < tid; ++a) r += (se[a] == e) ? 1 : 0; tokr[wg * 256 + tid] = r; }
    if (tid >= 256 && tid < 288) { const int e = tid - 256; int c = 0;
#pragma unroll 4
        for (int a = 0; a < 256; ++a) c += (se[a] == e) ? 1 : 0; hist[wg * 32 + e] = c; }
    for (int i = tid; i < NSLOTBLK; i += NTHREADS) sdst[wg * NSLOTBLK + i] = YS_TRASH_ROW;
    __syncthreads();
}
__device__ __forceinline__ void assign_phase(KPRef p, float* sm, int wg, int tid, int wave, int lane) {
    int* cnt = (int*)sm, *bas = cnt + 32, *pend = cnt + 64, *slot_of = cnt + 128;
    const int* hist = (const int*)(p.ws + WS_HIST); const int* toke = (const int*)(p.ws + WS_TOKE); const int* tokr = (const int*)(p.ws + WS_TOKR);
    int* sdst = (int*)(p.ws + WS_SDST); int* blke = (int*)(p.ws + WS_BLKE);
    if (tid < 32) { int c = 0, bb = 0;
#pragma unroll 8
        for (int w = 0; w < 256; ++w) { const int v = hist[w * 32 + tid]; c += v; if (w < wg) bb += v; } cnt[tid] = c; bas[tid] = bb; }
    __syncthreads();
    if (tid == 0) { int run = 0; for (int e = 0; e < 32; ++e) { const int pad = ((cnt[e] + 255) >> 8) << 8; bas[e] += run; run += pad; pend[e] = run; } }
    __syncthreads();
    if (wg == 0) { if (tid < NSLOTBLK) { int e = 0; for (int k = 0; k < 32; ++k) e += (pend[k] <= tid * 256) ? 1 : 0; blke[tid] = e > 31 ? 31 : e; } if (tid == 0) blke[511] = pend[31] >> 8; }
    if (tid < 256) { const int a = wg * 256 + tid; const int e = toke[a]; const int slot = bas[e] + tokr[a]; sdst[slot] = a; slot_of[tid] = slot; }
    __syncthreads();
    const unsigned char* u2 = (const unsigned char*)(p.ws + WS_U8); unsigned char* xs = (unsigned char*)(p.ws + WS_XS);
    const float* su = (const float*)(p.ws + WS_SU); float* xss = (float*)(p.ws + WS_XSS);
    for (int a = wave; a < 256; a += NWAVES) { const int tok = wg * 128 + (a >> 1), slot = slot_of[a];
        ((u32x4*)(xs + (size_t)slot * 1024))[lane] = ((const u32x4*)(u2 + (size_t)tok * 1024))[lane];
        if (lane == 0) xss[slot] = su[tok]; }
    __syncthreads();
}

#ifndef MK_PER_PHASE
#define MK_PER_PHASE 0
#endif
constexpr int PH_PER_LAYER = 18, N_PHASES = DEPTH_ * PH_PER_LAYER + 1;
constexpr int CW_BAR = 1024;

__global__ void __launch_bounds__(NTHREADS, 2) mega(Params p_unused) {
    extern __shared__ __attribute__((aligned(16))) unsigned char lds[];
    const int tid0 = threadIdx.x;
    const int G = gridDim.x, wg = blockIdx.x, NGW = G * NWAVES;
#define SUB_BEGIN() KPRef p = *KP(); unsigned char* ws = p.ws; (void)ws; int tid = threadIdx.x; asm volatile("" : "+v"(tid))
#define PHASE_BEGIN() KPRef p = *KP(); unsigned char* ws = p.ws; (void)ws; int tid = threadIdx.x; asm volatile("" : "+v"(tid)); const int lane = tid & 63, wave = __builtin_amdgcn_readfirstlane(tid >> 6), gw = wg * NWAVES + wave; (void)lane; (void)gw
    volatile LAS unsigned* MISC = (volatile LAS unsigned*)((LAS unsigned char*)lds + MISC_OFF);
    for (int u = tid0; u < (LDS_BYTES - LDSCTL_OFF) / 4; u += NTHREADS) ((LAS unsigned*)((LAS unsigned char*)lds + LDSCTL_OFF))[u] = 0u;
    __syncthreads();
#define KP() ({ const __attribute__((address_space(4))) Params* _k = (const __attribute__((address_space(4))) Params*)__builtin_amdgcn_kernarg_segment_ptr(); asm volatile("" : "+s"(_k)); _k; })
    unsigned* ctl; { const __attribute__((address_space(4))) Params* k0 = KP(); ctl = (unsigned*)(k0->ws + WS_CTL); }
    XcdBarrier bar = xcd_barrier_post(ctl + CW_BAR, MISC + 8);
    int lo, hi; { const __attribute__((address_space(4))) Params* k0 = KP(); lo = k0->ph_lo; hi = k0->ph_hi; }
    float* sm = (float*)lds;
    PG8_LAS unsigned char* ring = (PG8_LAS unsigned char*)lds;
#ifndef PH_MASK
#define PH_MASK 0x7ffffu
#endif
#define IN(k) ((((PH_MASK) >> ((k) == DEPTH_ * PH_PER_LAYER ? 18 : ((k) % PH_PER_LAYER))) & 1u) && lo <= (k) && (k) < hi)
#define SEAM(k) do { if ((k) + 1 < hi) xcd_barrier(bar); } while (0)
#ifndef REPEAT_MASK
#define REPEAT_MASK 0u
#endif
#ifndef URM
#define URM 0u
#endif
#define UREP(bit) for (int ur_ = 0; ur_ < ((((URM) >> (bit)) & 1u) ? 2 : 1); ++ur_)
#ifndef REPEAT_L0
#define REPEAT_L0 0u
#endif
#define NREP(k) (((((REPEAT_MASK) >> ((k) % PH_PER_LAYER)) & 1u) || ((((REPEAT_L0) >> ((k) % PH_PER_LAYER)) & 1u) && (k) < PH_PER_LAYER)) ? 2 : 1)

    for (int l = 0; l < DEPTH_; ++l) {
        const int P0 = l * PH_PER_LAYER;
        if (IN(P0 + 0)) for (int rep_ = 0; rep_ < NREP(P0 + 0); ++rep_) { PHASE_BEGIN();
            UREP(8) conv8_pass<0>(p, l, lds, gw, NGW, wave, lane);
            if (l == 0) norm_phase<0>(p, l, gw, NGW, lane); else norm_phase<1>(p, l, gw, NGW, lane);
            SEAM(P0 + 0);
        }
        if (IN(P0 + 1)) for (int rep_ = 0; rep_ < NREP(P0 + 1); ++rep_) { PHASE_BEGIN();
            conv8_pass<1>(p, l, lds, gw, NGW, wave, lane);
            conv_phase(p, l, lds, gw, NGW, wave, lane);
            SEAM(P0 + 1);
        }
        if (IN(P0 + 2)) for (int rep_ = 0; rep_ < NREP(P0 + 2); ++rep_) { PHASE_BEGIN();
            pg8::Gemm g{(const bf16_t*)(ws + WS_U8), (const bf16_t*)(ws + WS_WIN)};
            pg8::StaticOrder<T_ / 256, ZW / 256, 1024, 1024> S{G, wg, 0};
            pg8::EpiBf16S E{(bf16_t*)(ws + WS_Z), ZW, (const float*)(ws + WS_SU), (const float*)(ws + WS_SWIN)};
            pg8::gemm_phase<1024, 1024, 1024, true>(ring, g, S, E);
            SEAM(P0 + 2);
        }
        if (IN(P0 + 3)) for (int rep_ = 0; rep_ < NREP(P0 + 3); ++rep_) { PHASE_BEGIN();
            if (wg == 0) { int* cnt = (int*)(ws + WS_MCNT); cnt[tid] = 0; }
            UREP(0) { SUB_BEGIN(); for (int u = wg; u < 1024; u += G) gla_kv_unit(p, l, lds, u, tid); }
            UREP(1) { SUB_BEGIN(); for (int u = wg; u < 1024; u += G) ret_kv_unit(p, lds, u, tid); }
            UREP(2) { SUB_BEGIN(); for (int u = wg; u < 128; u += G) kmean_unit(p, sm, u, tid); }
            UREP(3) { SUB_BEGIN(); SwaGen SG{(const bf16_t*)(ws + WS_Z), (bf16_t*)(ws + WS_O), p.in[6] + l * 4, wg, G}; attn_loop<SwaFn>(lds, SG, tid); }
            SEAM(P0 + 3);
        }
        if (IN(P0 + 4)) for (int rep_ = 0; rep_ < NREP(P0 + 4); ++rep_) { PHASE_BEGIN(); moba_select(p, wg, tid); scan_phase(p, wg, tid); SEAM(P0 + 4); }
        if (IN(P0 + 5)) for (int rep_ = 0; rep_ < NREP(P0 + 5); ++rep_) { PHASE_BEGIN();
            UREP(4) { SUB_BEGIN(); for (int u = wg; u < 1024; u += G) gla_out_unit(p, l, lds, u, tid); }
            UREP(5) { SUB_BEGIN(); for (int u = wg; u < 1024; u += G) ret_out_unit(p, l, lds, u, tid); }
            UREP(6) { SUB_BEGIN(); moba_sel_table(p, lds, tid); MobaSelGen MG{(const bf16_t*)(ws + WS_Z), (const int*)(ws + WS_MLIST), (const int*)(ws + WS_MCNT), (bf16_t*)(ws + WS_PARTO), (f32x2*)(ws + WS_PARTML), (const int*)(lds + LDS_MTAB), wg, G}; attn_loop<MobaSelFn>(lds, MG, tid); }
            SEAM(P0 + 5);
        }
        if (IN(P0 + 6)) for (int rep_ = 0; rep_ < NREP(P0 + 6); ++rep_) { PHASE_BEGIN();
            UREP(7) { SUB_BEGIN(); MobaOwnGen OG{(const bf16_t*)(ws + WS_Z), (bf16_t*)(ws + WS_O), (const bf16_t*)(ws + WS_PARTO), (const f32x2*)(ws + WS_PARTML), wg, G}; attn_loop<MobaOwnFn>(lds, OG, tid); }
            SEAM(P0 + 6);
        }
        for (int hf = 0; hf < 2; ++hf) {
            if (IN(P0 + 7 + 2 * hf)) for (int rep_ = 0; rep_ < NREP(P0 + 7 + 2 * hf); ++rep_) { PHASE_BEGIN();
                pg8::Gemm g{(const bf16_t*)(ws + WS_O), (const bf16_t*)(ws + WS_WB)};
                pg8::StaticOrder<T_ / 512, 16, 2048, 512, 2, 512> S{G, wg, 64 * hf};
                pg8::EpiBf16 E{(bf16_t*)(ws + WS_YH), 4096, 16384 * hf};
                pg8::gemm_phase<2048, 512, 512, false>(ring, g, S, E);
                SEAM(P0 + 7 + 2 * hf);
            }
            if (IN(P0 + 8 + 2 * hf)) for (int rep_ = 0; rep_ < NREP(P0 + 8 + 2 * hf); ++rep_) { PHASE_BEGIN();
                pg8::Gemm g{(const bf16_t*)(ws + WS_U8), (const bf16_t*)(ws + WS_WG)};
                pg8::StaticOrder<T_ / 512, 16, 1024, 1024> S{G, wg, 64 * hf};
                pg8::EpiGate E{(const bf16_t*)(ws + WS_YH), 16384 * hf, (bf16_t*)(ws + WS_O), (const float*)(ws + WS_SU), (const float*)(ws + WS_SWG)};
                pg8::gemm_phase<1024, 1024, 1024, true>(ring, g, S, E);
                SEAM(P0 + 8 + 2 * hf);
            }
        }
        if (IN(P0 + 11)) for (int rep_ = 0; rep_ < NREP(P0 + 11); ++rep_) { PHASE_BEGIN();
            pg8::Gemm g{(const bf16_t*)(ws + WS_O), (const bf16_t*)(ws + WS_WO)};
            pg8::StaticOrder<T_ / 256, 4, 2048, 2048> S{G, wg, 0};
            pg8::EpiRes E{l == 0 ? p.in[0] : p.out, p.out, 1024};
            pg8::gemm_phase<2048, 2048, 2048, false>(ring, g, S, E);
            SEAM(P0 + 11);
        }
        if (IN(P0 + 12)) for (int rep_ = 0; rep_ < NREP(P0 + 12); ++rep_) { PHASE_BEGIN(); norm_phase<2>(p, l, gw, NGW, lane); SEAM(P0 + 12); }
        if (IN(P0 + 13)) for (int rep_ = 0; rep_ < NREP(P0 + 13); ++rep_) { PHASE_BEGIN();
            pg8::Gemm g{(const bf16_t*)(ws + WS_U2BF), (const bf16_t*)(ws + WS_WR)};
            pg8::StaticOrder<T_ / 256, 1, 2048, 2048> S{G, wg, 0};
            pg8::EpiRouter E{(float*)(ws + WS_LOGIT)};
            pg8::gemm_phase<2048, 2048, 2048, false>(ring, g, S, E);
            SEAM(P0 + 13);
        }
        if (IN(P0 + 14)) for (int rep_ = 0; rep_ < NREP(P0 + 14); ++rep_) { PHASE_BEGIN(); route_phase(p, l, sm, wg, tid); SEAM(P0 + 14); }
        if (IN(P0 + 15)) for (int rep_ = 0; rep_ < NREP(P0 + 15); ++rep_) { PHASE_BEGIN(); assign_phase(p, sm, wg, tid, wave, lane); SEAM(P0 + 15); }
        if (IN(P0 + 16)) for (int rep_ = 0; rep_ < NREP(P0 + 16); ++rep_) { PHASE_BEGIN();
            const int* blke = (const int*)(ws + WS_BLKE); const int nb = __builtin_amdgcn_readfirstlane(blke[511]);
            pg8::Gemm g{(const bf16_t*)(ws + WS_XS), (const bf16_t*)(ws + WS_E1)};
            pg8::MoeOrder<2> S{blke, nb, G, wg, (size_t)256 * 1024, (size_t)256 * 1024, (size_t)512 * 1024};
            pg8::EpiE1 E{(bf16_t*)(ws + WS_HDN), (const float*)(ws + WS_XSS), (const float*)(ws + WS_SWE1), blke};
            pg8::gemm_phase<1024, 1024, 1024, true>(ring, g, S, E);
            SEAM(P0 + 16);
        }
        if (IN(P0 + 17)) for (int rep_ = 0; rep_ < NREP(P0 + 17); ++rep_) { PHASE_BEGIN();
            const int* blke = (const int*)(ws + WS_BLKE); const int nb = __builtin_amdgcn_readfirstlane(blke[511]);
            pg8::Gemm g{(const bf16_t*)(ws + WS_HDN), (const bf16_t*)(ws + WS_E2)};
            pg8::MoeOrder<4> S{blke, nb, G, wg, (size_t)256 * 256 * 2, (size_t)256 * 256 * 2, (size_t)1024 * 256 * 2};
            { unsigned* raw = (unsigned*)(ws + WS_SWRAW); for (int i = wg * NTHREADS + tid; i < 3072 + 4096 + 32 * 512; i += G * NTHREADS) raw[i] = 0u; }
            pg8::EpiE2 E{(bf16_t*)(ws + WS_YS), (const int*)(ws + WS_SDST)};
            pg8::gemm_phase<512, 512, 512, false>(ring, g, S, E);
            SEAM(P0 + 17);
        }
    }
    if (IN(DEPTH_ * PH_PER_LAYER)) { PHASE_BEGIN(); norm_phase<3>(p, 0, gw, NGW, lane); }
#undef IN
#undef SEAM
}

extern "C" void kernel_launch(void* const* d_in, const int* in_sizes, int n_in, void* d_out, int out_size, void* d_ws, size_t ws_size, hipStream_t stream) {
    static int grid = 0;
    if (grid == 0) {
        if (n_in != 19 || out_size != T_ * D_ || ws_size < WS_END) { fprintf(stderr, "kernel_launch: unexpected shapes (n_in %d, out %d, ws %zu); nothing launched\n", n_in, out_size, ws_size); grid = -1; return; }
        int dev = 0, cus = 0;
        if (hipGetDevice(&dev) != hipSuccess || hipDeviceGetAttribute(&cus, hipDeviceAttributeMultiprocessorCount, dev) != hipSuccess) { grid = -1; return; }
        if (hipFuncSetAttribute((const void*)mega, hipFuncAttributeMaxDynamicSharedMemorySize, LDS_BYTES) != hipSuccess) { fprintf(stderr, "kernel_launch: hipFuncSetAttribute failed\n"); grid = -1; return; }
        int per_cu = 0;
        if (hipOccupancyMaxActiveBlocksPerMultiprocessor(&per_cu, (const void*)mega, NTHREADS, LDS_BYTES) != hipSuccess || per_cu < 1) { fprintf(stderr, "kernel_launch: occupancy query reports %d blocks per CU\n", per_cu); }
        (void)hipGetLastError();
        grid = cus;
    }
    if (grid <= 0) return;
    Params p{};
    for (int i = 0; i < 19; ++i) p.in[i] = (const float*)d_in[i];
    p.out = (float*)d_out; p.ws = (unsigned char*)d_ws;
    for (int f = 0; f < 16; ++f) p.inv_freq[f] = (float)std::pow(10000.0, -(double)f / 16.0);
    for (int h = 0; h < 4; ++h) p.ret_lg2[h] = (float)std::log2(1.0 - std::exp2(-5.0 - (double)h));
    hipMemsetAsync((unsigned char*)d_ws + WS_CTL, 0, CTL_BYTES, stream);
#if MK_PER_PHASE
    for (int ph = 0; ph < N_PHASES; ++ph) { p.ph_lo = ph; p.ph_hi = ph + 1; hipLaunchKernelGGL(mega, dim3(grid), dim3(NTHREADS), LDS_BYTES, stream, p); }
#else
    p.ph_lo = 0; p.ph_hi = N_PHASES;
    hipLaunchKernelGGL(mega, dim3(grid), dim3(NTHREADS), LDS_BYTES, stream, p);
#endif
}
```

```cpp
#include <hip/hip_runtime.h>
#include <cstdio>
#include <cstdint>
#include <cmath>

#define LAS __attribute__((address_space(3)))
#define GAS __attribute__((address_space(1)))
typedef unsigned short bf16_t;
typedef short bf16x8 __attribute__((ext_vector_type(8)));
typedef float f32x4 __attribute__((ext_vector_type(4)));
typedef float f32x2 __attribute__((ext_vector_type(2)));
typedef unsigned u32x4 __attribute__((ext_vector_type(4)));
typedef unsigned u32x2 __attribute__((ext_vector_type(2)));
typedef int i32x4 __attribute__((ext_vector_type(4)));
__device__ __forceinline__ f32x4 tof(const f32x4& v) { return v; }
__device__ __forceinline__ f32x4 tof(const i32x4& v) { return __builtin_convertvector(v, f32x4); }

constexpr int T_ = 32768, D_ = 1024, S_ = 8192, NBATCH = 4, DEPTH_ = 2;
constexpr int ZW = 3072;
constexpr int Z_GQ = 0, Z_GK = 128, Z_GV = 256, Z_GR = 512, Z_GA = 768, Z_SQ = 784, Z_SK = 1040, Z_SV = 1168, Z_MQ = 1296, Z_MK = 1552, Z_MV = 1808,
              Z_RQ = 2064, Z_RK = 2192, Z_RV = 2320, Z_RG = 2576, Z_GATE = 2832, IN_W = 6928;
constexpr float LOG2E = 1.4426950408889634f;
constexpr float C2 = 0.125f * 1.4426950408889634f;
constexpr float RSQ32 = 0.17677669529663687f;
constexpr float NORM_EPS = 1e-6f;
constexpr int NEXP = 32, EHID = 256, MOE_BLK = 256, NSLOTBLK = 288, NSLOT = NSLOTBLK * MOE_BLK;

constexpr size_t MiB = 1u << 20;
constexpr size_t WS_WIN = 0, WS_WG = 6 * MiB, WS_WB = 14 * MiB, WS_WO = 16 * MiB, WS_WR = 18 * MiB, WS_E1 = 19 * MiB, WS_E2 = 51 * MiB;
constexpr size_t WS_YS = 68 * MiB;
constexpr size_t WS_GKV = 68 * MiB, WS_RKV = 84 * MiB, WS_GDEC = 92 * MiB, WS_KMEAN = 93 * MiB, WS_O = 108 * MiB;
constexpr size_t WS_U8 = 197 * MiB;
constexpr size_t WS_SU = 229 * MiB, WS_XSS = WS_SU + 256 * 1024;
constexpr size_t WS_SWIN = 230 * MiB, WS_SWG = WS_SWIN + 16 * 1024, WS_SWE1 = WS_SWG + 16 * 1024;
constexpr size_t WS_Z = 261 * MiB;
constexpr size_t WS_YH = 261 * MiB;
constexpr size_t WS_U2BF = 261 * MiB;
constexpr size_t WS_XS = 325 * MiB, WS_HDN = 397 * MiB;
constexpr size_t WS_LOGIT = 453 * MiB;
constexpr size_t WS_TOKE = 461 * MiB, WS_TOKW = WS_TOKE + 256 * 1024, WS_TOKR = WS_TOKW + 256 * 1024, WS_HIST = WS_TOKR + 256 * 1024,
                 WS_SDST = WS_HIST + 64 * 1024, WS_BLKE = WS_SDST + 512 * 1024;
constexpr size_t WS_MLIST = 94 * MiB, WS_MCNT = 102 * MiB;
constexpr size_t WS_PARTO = 453 * MiB, WS_PARTML = 501 * MiB;
constexpr size_t WS_CTL = 511 * MiB, CTL_BYTES = 256 * 1024;
constexpr size_t WS_SWRAW = WS_CTL + 64 * 1024;
constexpr size_t WS_END = 512 * MiB;
constexpr int YS_TRASH_ROW = 2 * T_;

__device__ __forceinline__ float bf2f(bf16_t v) { return __uint_as_float(((unsigned)v) << 16); }
__device__ __forceinline__ unsigned f2bf(float f) { unsigned u = __float_as_uint(f); return (u + 0x7fffu + ((u >> 16) & 1u)) >> 16; }
__device__ __forceinline__ unsigned pk2(float lo, float hi) { return f2bf(lo) | (f2bf(hi) << 16); }
__device__ __forceinline__ float sigmoidf_(float x) { return __builtin_amdgcn_rcpf(1.0f + __builtin_amdgcn_exp2f(-x * LOG2E)); }

namespace pg8 {
#define PG8_LAS __attribute__((address_space(3)))
constexpr int BM = 256, BK = 64, HALF = 128, HTB = HALF * BK * 2  , STAGE_BYTES = 8 * HTB, NXCD = 8, WGM = 8;

__host__ __device__ __forceinline__ int lds_byte(int r, int c) { const int st = (r >> 4) * 2 + (c >> 5), rr = r & 15, cc = c & 31, ob = rr * 64 + cc * 2; return st * 1024 + (ob ^ (((ob >> 9) & 1) << 5)); }
__host__ __device__ __forceinline__ void stage_rc(int b, int& R, int& C) { const int st = b / 1024, sb = b % 1024, swz = sb ^ (((sb >> 9) & 1) << 5); R = (st >> 1) * 16 + swz / 64; C = (st & 1) * 32 + (swz % 64) / 2; }
__host__ __device__ __forceinline__ int perm32(int rho) { const int n = rho >> 4, i = rho & 15; return 8 * (i >> 2) + 4 * n + (i & 3); }

struct Unit { int pm, pn; size_t aoff, boff; };
struct Gemm { const bf16_t* A; const bf16_t* Bt; };

template <int NM, int NN, int LDAB  , int LDBB, int A_SHIFT = 30, int A_MUL = 0> struct StaticOrder {
    static constexpr bool GATHER = false;
    int G, c, pm_base;
    __device__ bool next(int i, Unit& u) const {
        constexpr int nwg = NM * NN; const int L = i * G + c; if (L >= nwg) return false;
        int wgid = L; { constexpr int q = nwg / NXCD, r = nwg % NXCD; const int xcd = wgid % NXCD, off = wgid / NXCD; wgid = (xcd < r ? xcd * (q + 1) : r * (q + 1) + (xcd - r) * q) + off; }
        static_assert(NM % WGM == 0, "row-tile count must be a multiple of the 8-row group"); constexpr int nig = WGM * NN, gsz = WGM; const int gid = wgid / nig, fm = gid * WGM;
        u.pm = pm_base + fm + ((wgid % nig) % gsz); u.pn = (wgid % nig) / gsz;
        u.aoff = (size_t)u.pm * ((size_t)BM * LDAB) + (size_t)(u.pn >> A_SHIFT) * A_MUL; u.boff = (size_t)u.pn * ((size_t)BM * LDBB); return true;
    }
};
template <int NCOL, bool GATHER_ = false> struct MoeOrder {
    static constexpr bool GATHER = GATHER_;
    const int* blk_e; int nb, G, c; size_t a_tstep, b_tstep, b_estep; const int* rowmap;
    __device__ bool next(int i, Unit& u) const {
        const int L = i * G + c; if (L >= nb * NCOL) return false;
        const int rb = L / NCOL, pn = L % NCOL; const int e = __builtin_amdgcn_readfirstlane(blk_e[rb]);
        u.pm = rb; u.pn = pn; u.aoff = (size_t)rb * a_tstep; u.boff = (size_t)e * b_estep + (size_t)pn * b_tstep; return true;
    }
};

__device__ __forceinline__ unsigned cvt_pk_bf16(float lo, float hi) { unsigned r; asm volatile("v_cvt_pk_bf16_f32 %0, %1, %2" : "=v"(r) : "v"(lo), "v"(hi)); return r; }

struct EpiBf16 {
    static constexpr bool PERM = true;
    bf16_t* O; int ldc; int row_sub;
    template <class AT> __device__ __forceinline__ void operator()(const AT (&acc)[2][2][4][2], const Unit& u, int wr, int wc, int fr, int fq) const {
        const int row0 = u.pm * BM + wr * 64 + fr - row_sub; const int col0 = u.pn * BM + wc * 32 + 8 * fq;
#pragma unroll
        for (int ai = 0; ai < 2; ++ai)
#pragma unroll
            for (int m = 0; m < 4; ++m) { bf16_t* rowp = O + (size_t)(row0 + ai * HALF + m * 16) * ldc + col0;
#pragma unroll
                for (int bj = 0; bj < 2; ++bj) { const f32x4 v0 = tof(acc[ai][bj][m][0]), v1 = tof(acc[ai][bj][m][1]);
                    u32x4 w; w.x = cvt_pk_bf16(v0[0], v0[1]); w.y = cvt_pk_bf16(v0[2], v0[3]); w.z = cvt_pk_bf16(v1[0], v1[1]); w.w = cvt_pk_bf16(v1[2], v1[3]);
                    *(u32x4*)(rowp + bj * HALF) = w; } }
    }
};
struct EpiBf16S {
    static constexpr bool PERM = true;
    bf16_t* O; int ldc; const float* srow; const float* scol;
    template <class AT> __device__ __forceinline__ void operator()(const AT (&acc)[2][2][4][2], const Unit& u, int wr, int wc, int fr, int fq) const {
        const int row0 = u.pm * BM + wr * 64 + fr; const int col0 = u.pn * BM + wc * 32 + 8 * fq;
        f32x4 sc[2][2];
#pragma unroll
        for (int bj = 0; bj < 2; ++bj)
#pragma unroll
            for (int n = 0; n < 2; ++n) sc[bj][n] = *(const f32x4*)(scol + col0 + bj * HALF + 4 * n);
#pragma unroll
        for (int ai = 0; ai < 2; ++ai)
#pragma unroll
            for (int m = 0; m < 4; ++m) { const int r = row0 + ai * HALF + m * 16; const float sr = srow[r]; bf16_t* rowp = O + (size_t)r * ldc + col0;
#pragma unroll
                for (int bj = 0; bj < 2; ++bj) { const f32x4 v0 = tof(acc[ai][bj][m][0]) * sc[bj][0] * sr, v1 = tof(acc[ai][bj][m][1]) * sc[bj][1] * sr;
                    u32x4 w; w.x = cvt_pk_bf16(v0[0], v0[1]); w.y = cvt_pk_bf16(v0[2], v0[3]); w.z = cvt_pk_bf16(v1[0], v1[1]); w.w = cvt_pk_bf16(v1[2], v1[3]);
                    *(u32x4*)(rowp + bj * HALF) = w; } }
    }
};
template <bool BASE_F32> struct EpiRes {
    static constexpr bool PERM = true;
    const void* base; bf16_t* H;
    template <class AT> __device__ __forceinline__ void operator()(const AT (&acc)[2][2][4][2], const Unit& u, int wr, int wc, int fr, int fq) const {
        const int row0 = u.pm * BM + wr * 64 + fr, col0 = u.pn * BM + wc * 32 + 8 * fq;
#pragma unroll
        for (int ai = 0; ai < 2; ++ai) {
            f32x4 b[4][2][2];
#pragma unroll
            for (int m = 0; m < 4; ++m) { const size_t off = (size_t)(row0 + ai * HALF + m * 16) * 1024 + col0;
#pragma unroll
                for (int bj = 0; bj < 2; ++bj) {
                    if (BASE_F32) { b[m][bj][0] = *(const f32x4*)((const float*)base + off + bj * HALF); b[m][bj][1] = *(const f32x4*)((const float*)base + off + bj * HALF + 4); }
                    else { const u32x4 q = *(const u32x4*)((const bf16_t*)base + off + bj * HALF);
                        b[m][bj][0] = (f32x4){__uint_as_float(q.x << 16), __uint_as_float(q.x & 0xffff0000u), __uint_as_float(q.y << 16), __uint_as_float(q.y & 0xffff0000u)};
                        b[m][bj][1] = (f32x4){__uint_as_float(q.z << 16), __uint_as_float(q.z & 0xffff0000u), __uint_as_float(q.w << 16), __uint_as_float(q.w & 0xffff0000u)}; } } }
#pragma unroll
            for (int m = 0; m < 4; ++m) { const size_t off = (size_t)(row0 + ai * HALF + m * 16) * 1024 + col0;
#pragma unroll
                for (int bj = 0; bj < 2; ++bj) { const f32x4 v0 = b[m][bj][0] + tof(acc[ai][bj][m][0]), v1 = b[m][bj][1] + tof(acc[ai][bj][m][1]);
                    u32x4 w; w.x = cvt_pk_bf16(v0[0], v0[1]); w.y = cvt_pk_bf16(v0[2], v0[3]); w.z = cvt_pk_bf16(v1[0], v1[1]); w.w = cvt_pk_bf16(v1[2], v1[3]);
                    *(u32x4*)(H + off + bj * HALF) = w; } }
            asm volatile("" ::: "memory"); }
    }
};
struct EpiRouter {
    static constexpr bool PERM = false;
    float* L;
    template <class AT> __device__ __forceinline__ void operator()(const AT (&acc)[2][2][4][2], const Unit& u, int wr, int wc, int fr, int fq) const {
        if (wc >= 2) return;
        const int row0 = u.pm * BM + wr * 64 + fr, col0 = wc * 32 + 4 * fq;
#pragma unroll
        for (int ai = 0; ai < 2; ++ai)
#pragma unroll
            for (int m = 0; m < 4; ++m) { float* rowp = L + (size_t)(row0 + ai * HALF + m * 16) * 64 + col0;
#pragma unroll
                for (int n = 0; n < 2; ++n) *(f32x4*)(rowp + n * 16) = tof(acc[ai][0][m][n]); }
    }
};
struct EpiGate {
    static constexpr bool PERM = false;
    const bf16_t* Y; int y_row_sub; bf16_t* Mg; const float* srow; const float* scol;
    template <class AT> __device__ __forceinline__ void operator()(const AT (&acc)[2][2][4][2], const Unit& u, int wr, int wc, int fr, int fq) const {
        const int row0 = u.pm * BM + wr * 64 + fr, d0 = u.pn * 64 + wc * 16 + fq * 4;
        f32x4 sc[4];
#pragma unroll
        for (int i = 0; i < 4; ++i) sc[i] = *(const f32x4*)(scol + u.pn * BM + (i >> 1) * HALF + wc * 32 + (i & 1) * 16 + 4 * fq) * (-LOG2E);
#pragma unroll
        for (int ai = 0; ai < 2; ++ai) { u32x2 yv[4][4];
#pragma unroll
            for (int m = 0; m < 4; ++m) { const bf16_t* yrow = Y + (size_t)(row0 + ai * HALF + m * 16 - y_row_sub) * 4096 + d0;
#pragma unroll
                for (int i = 0; i < 4; ++i) yv[m][i] = *(const u32x2*)(yrow + 1024 * i); }
#pragma unroll
            for (int m = 0; m < 4; ++m) { const int r = row0 + ai * HALF + m * 16; const float sr = srow[r];
                f32x4 s = (f32x4){0.f, 0.f, 0.f, 0.f};
#pragma unroll
                for (int i = 0; i < 4; ++i) { const f32x4 g = tof(acc[ai][i >> 1][m][i & 1]) * sc[i] * sr;
                    s[0] += __builtin_amdgcn_rcpf(1.0f + __builtin_amdgcn_exp2f(g[0])) * __uint_as_float(yv[m][i].x << 16); s[1] += __builtin_amdgcn_rcpf(1.0f + __builtin_amdgcn_exp2f(g[1])) * __uint_as_float(yv[m][i].x & 0xffff0000u);
                    s[2] += __builtin_amdgcn_rcpf(1.0f + __builtin_amdgcn_exp2f(g[2])) * __uint_as_float(yv[m][i].y << 16); s[3] += __builtin_amdgcn_rcpf(1.0f + __builtin_amdgcn_exp2f(g[3])) * __uint_as_float(yv[m][i].y & 0xffff0000u); }
                u32x2 w; w.x = cvt_pk_bf16(s[0], s[1]); w.y = cvt_pk_bf16(s[2], s[3]);
                *(u32x2*)(Mg + (size_t)r * 1024 + d0) = w; }
            asm volatile("" ::: "memory"); }
    }
};
struct EpiE1 {
    static constexpr bool PERM = true;
    bf16_t* H; const float* srow; const float* scol_all; const int* blk_e;
    template <class AT> __device__ __forceinline__ void operator()(const AT (&acc)[2][2][4][2], const Unit& u, int wr, int wc, int fr, int fq) const {
        const int row0 = u.pm * BM + wr * 64 + fr, col0 = u.pn * 128 + wc * 32 + 8 * fq;
        const float* scol = scol_all + (size_t)__builtin_amdgcn_readfirstlane(blk_e[u.pm]) * 512 + u.pn * BM + wc * 32 + 8 * fq;
        const f32x4 s10 = *(const f32x4*)scol, s11 = *(const f32x4*)(scol + 4), s30 = *(const f32x4*)(scol + HALF), s31 = *(const f32x4*)(scol + HALF + 4);
#pragma unroll
        for (int ai = 0; ai < 2; ++ai)
#pragma unroll
            for (int m = 0; m < 4; ++m) { const int r = row0 + ai * HALF + m * 16; const float sr = srow[r]; bf16_t* rowp = H + (size_t)r * EHID + col0;
                const f32x4 a0 = tof(acc[ai][0][m][0]) * s10 * sr, a1 = tof(acc[ai][0][m][1]) * s11 * sr, b0 = tof(acc[ai][1][m][0]) * s30 * sr, b1 = tof(acc[ai][1][m][1]) * s31 * sr;
                f32x4 v0, v1;
#pragma unroll
                for (int j = 0; j < 4; ++j) { v0[j] = a0[j] * sigmoidf_(a0[j]) * b0[j]; v1[j] = a1[j] * sigmoidf_(a1[j]) * b1[j]; }
                u32x4 w; w.x = cvt_pk_bf16(v0[0], v0[1]); w.y = cvt_pk_bf16(v0[2], v0[3]); w.z = cvt_pk_bf16(v1[0], v1[1]); w.w = cvt_pk_bf16(v1[2], v1[3]);
                *(u32x4*)rowp = w; }
    }
};
struct EpiE2 {
    static constexpr bool PERM = true;
    bf16_t* YS; const int* sdst;
    template <class AT> __device__ __forceinline__ void operator()(const AT (&acc)[2][2][4][2], const Unit& u, int wr, int wc, int fr, int fq) const {
        const int row0 = u.pm * BM + wr * 64 + fr, col0 = u.pn * BM + wc * 32 + 8 * fq;
#pragma unroll
        for (int ai = 0; ai < 2; ++ai)
#pragma unroll
            for (int m = 0; m < 4; ++m) { const int dst = sdst[row0 + ai * HALF + m * 16];
                bf16_t* rowp = YS + (size_t)dst * 1024 + col0;
#pragma unroll
                for (int bj = 0; bj < 2; ++bj) { const f32x4 v0 = tof(acc[ai][bj][m][0]), v1 = tof(acc[ai][bj][m][1]);
                    u32x4 w; w.x = cvt_pk_bf16(v0[0], v0[1]); w.y = cvt_pk_bf16(v0[2], v0[3]); w.z = cvt_pk_bf16(v1[0], v1[1]); w.w = cvt_pk_bf16(v1[2], v1[3]);
                    *(u32x4*)(rowp + bj * HALF) = w; }
                asm volatile("" ::: "memory"); }
    }
};

template <bool I8> struct AccSel { typedef f32x4 type; };
template <> struct AccSel<true> { typedef i32x4 type; };
__device__ __forceinline__ f32x4 mma16(const bf16x8& a, const bf16x8& b, const f32x4& c) { return __builtin_amdgcn_mfma_f32_16x16x32_bf16(a, b, c, 0, 0, 0); }
__device__ __forceinline__ i32x4 mma16(const bf16x8& a, const bf16x8& b, const i32x4& c) { return __builtin_amdgcn_mfma_i32_16x16x64_i8(__builtin_bit_cast(i32x4, a), __builtin_bit_cast(i32x4, b), c, 0, 0, 0); }
template <int LDAB, int LDBB, int KB, bool I8, class Epi, class Sched>
__device__ __forceinline__ void gemm_phase(PG8_LAS unsigned char* lds, const Gemm g, const Sched& S, const Epi& E) {
    int tid = threadIdx.x; asm volatile("" : "+v"(tid));
    const int wid = __builtin_amdgcn_readfirstlane(tid >> 6), lane = tid & 63, wr = wid >> 2, wc = wid & 3, fr = lane & 15, fq = lane >> 4;
    constexpr int nt = KB / (BK * 2);
    unsigned voffA[2], voffB[2]; int Rr[2]; unsigned cby[2];
#pragma unroll
    for (int i = 0; i < 2; ++i) { int R, C; stage_rc(tid * 16 + i * 8192, R, C); const int Rb = Epi::PERM ? ((R & ~31) + perm32(R & 31)) : R;
        voffA[i] = (unsigned)(R * LDAB + C * 2); voffB[i] = (unsigned)(Rb * LDBB + C * 2); Rr[i] = R; cby[i] = (unsigned)(C * 2); }
    unsigned gc[2][2], gn[2][2];
#define PG8_GATH(u_, o_) do { if constexpr (Sched::GATHER) { _Pragma("unroll") for (int h_ = 0; h_ < 2; ++h_) _Pragma("unroll") for (int i_ = 0; i_ < 2; ++i_) { int tk_ = S.rowmap[(u_).pm * BM + HALF * h_ + Rr[i_]] >> 1; tk_ = tk_ < T_ ? tk_ : T_ - 1; \
        o_[h_][i_] = (unsigned)tk_ * (unsigned)LDAB + cby[i_]; } } } while (0)
#define PG8_STAGE_A(bufoff, ptr, kb, h, nx) do { if constexpr (!Sched::GATHER) { PG8_STAGE(bufoff, ptr, voffA); } else { unsigned vo_[2]; vo_[0] = (nx) ? gn[h][0] : gc[h][0]; vo_[1] = (nx) ? gn[h][1] : gc[h][1]; \
        PG8_STAGE(bufoff, (const char*)g.A + (kb), vo_); } } while (0)
    constexpr size_t kstep = (size_t)(BK * 2);
    constexpr size_t hstepA = (size_t)HALF * LDAB, hstepB = (size_t)HALF * LDBB;
    const unsigned ldsw = (unsigned)wid * 1024u;
    const int aoff = lds_byte(wr * 64 + fr, fq * 8), boff = lds_byte(wc * 32 + fr, fq * 8);
#define PG8_SA(b, h) (((b) * 2 + (h)) * HTB)
#define PG8_SB(b, h) ((4 + (b) * 2 + (h)) * HTB)
#define PG8_STAGE(bufoff, gbase, voff) do { _Pragma("unroll") for (int _i = 0; _i < 2; ++_i) \
        __builtin_amdgcn_global_load_lds((const unsigned*)((const char*)(gbase) + (voff)[_i]), (PG8_LAS unsigned*)(lds + (bufoff) + ldsw + _i * 8192), 16, 0, 0); } while (0)
#define PG8_LDA(dst, b, h) do { _Pragma("unroll") for (int m = 0; m < 4; ++m) _Pragma("unroll") for (int k = 0; k < 2; ++k) dst[m][k] = *(const PG8_LAS bf16x8*)(lds + PG8_SA(b, h) + aoff + m * 2048 + k * 1024); } while (0)
#define PG8_LDB(dst, b, h) do { _Pragma("unroll") for (int n = 0; n < 2; ++n) _Pragma("unroll") for (int k = 0; k < 2; ++k) dst[n][k] = *(const PG8_LAS bf16x8*)(lds + PG8_SB(b, h) + boff + n * 2048 + k * 1024); } while (0)
#define PG8_MMA(ai, bj, At, Bt) do { __builtin_amdgcn_s_setprio(1); _Pragma("unroll") for (int m = 0; m < 4; ++m) _Pragma("unroll") for (int n = 0; n < 2; ++n) _Pragma("unroll") for (int k = 0; k < 2; ++k) \
        acc[ai][bj][m][n] = mma16(Bt[n][k], At[m][k], acc[ai][bj][m][n]); __builtin_amdgcn_s_setprio(0); } while (0)
#define PG8_WAIT_V(n) asm volatile("s_waitcnt vmcnt(" #n ")" ::: "memory")
#define PG8_WAIT_L(n) asm volatile("s_waitcnt lgkmcnt(" #n ")" ::: "memory")
#define PG8_BAR __builtin_amdgcn_s_barrier()
#define PG8_SCHED __builtin_amdgcn_sched_barrier(0)
    Unit cur, nxt; int ui = 0;
    if (!S.next(0, cur)) return;
    typedef typename AccSel<I8>::type acc_t;
    acc_t acc[2][2][4][2];
#pragma unroll
    for (int a = 0; a < 2; ++a)
#pragma unroll
        for (int b = 0; b < 2; ++b)
#pragma unroll
            for (int m = 0; m < 4; ++m)
#pragma unroll
                for (int n = 0; n < 2; ++n) acc[a][b][m][n] = (acc_t){0, 0, 0, 0};
    bf16x8 At[4][2], B0[2][2], B1[2][2];
    const char* cA = (const char*)g.A + cur.aoff; const char* cB = (const char*)g.Bt + cur.boff;
    PG8_GATH(cur, gc);
    PG8_STAGE(PG8_SB(0, 0), cB, voffB); PG8_STAGE_A(PG8_SA(0, 0), cA, 0, 0, false); PG8_STAGE(PG8_SB(0, 1), cB + hstepB, voffB); PG8_STAGE_A(PG8_SA(0, 1), cA + hstepA, 0, 1, false);
    if (wr == 1) PG8_BAR;
    PG8_WAIT_V(4); PG8_BAR;
    PG8_STAGE(PG8_SB(1, 0), cB + kstep, voffB); PG8_STAGE_A(PG8_SA(1, 0), cA + kstep, kstep, 0, false); PG8_STAGE(PG8_SB(1, 1), cB + hstepB + kstep, voffB);
    PG8_WAIT_V(6); PG8_BAR;
    for (;;) {
        const bool has_next = S.next(ui + 1, nxt);
        const char* nA = has_next ? (const char*)g.A + nxt.aoff : cA; const char* nB = has_next ? (const char*)g.Bt + nxt.boff : cB;
        if constexpr (Sched::GATHER) { if (has_next) PG8_GATH(nxt, gn); else { gn[0][0] = gc[0][0]; gn[0][1] = gc[0][1]; gn[1][0] = gc[1][0]; gn[1][1] = gc[1][1]; } }
        for (int t = 0; t < nt; t += 2) {
            const bool last = (t == nt - 2);
            const char* a1 = cA + (size_t)(t + 1) * kstep;
            const char* a2 = last ? nA : cA + (size_t)(t + 2) * kstep; const char* b2 = last ? nB : cB + (size_t)(t + 2) * kstep;
            const char* a3 = a2 + kstep; const char* b3 = b2 + kstep;
            const size_t k2 = last ? 0 : (size_t)(t + 2) * kstep;
            PG8_LDB(B0, 0, 0); PG8_SCHED; PG8_LDA(At, 0, 0); PG8_STAGE_A(PG8_SA(1, 1), a1 + hstepA, (size_t)(t + 1) * kstep, 1, false);
            PG8_WAIT_L(8); PG8_BAR; PG8_WAIT_L(0); PG8_MMA(0, 0, At, B0); PG8_BAR; PG8_SCHED;
            PG8_LDB(B1, 0, 1); PG8_STAGE(PG8_SB(0, 0), b2, voffB);
            PG8_BAR; PG8_WAIT_L(0); PG8_MMA(0, 1, At, B1); PG8_BAR;
            PG8_LDA(At, 0, 1); PG8_STAGE_A(PG8_SA(0, 0), a2, k2, 0, last);
            PG8_BAR; PG8_WAIT_L(0); PG8_MMA(1, 0, At, B0); PG8_BAR; PG8_SCHED;
            PG8_STAGE(PG8_SB(0, 1), b2 + hstepB, voffB);
            PG8_WAIT_V(6); PG8_BAR; PG8_MMA(1, 1, At, B1); PG8_BAR;
            PG8_LDB(B0, 1, 0); PG8_SCHED; PG8_LDA(At, 1, 0); PG8_STAGE_A(PG8_SA(0, 1), a2 + hstepA, k2, 1, last);
            PG8_WAIT_L(8); PG8_BAR; PG8_WAIT_L(0); PG8_MMA(0, 0, At, B0); PG8_BAR; PG8_SCHED;
            PG8_LDB(B1, 1, 1); PG8_STAGE(PG8_SB(1, 0), b3, voffB);
            PG8_BAR; PG8_WAIT_L(0); PG8_MMA(0, 1, At, B1); PG8_BAR;
            PG8_LDA(At, 1, 1); PG8_STAGE_A(PG8_SA(1, 0), a3, k2 + kstep, 0, last);
            PG8_BAR; PG8_WAIT_L(0); PG8_MMA(1, 0, At, B0); PG8_BAR; PG8_SCHED;
            PG8_STAGE(PG8_SB(1, 1), b3 + hstepB, voffB);
            PG8_WAIT_V(6); PG8_BAR; PG8_MMA(1, 1, At, B1); PG8_BAR;
        }
        E(acc, cur, wr, wc, fr, fq);
        if (!has_next) break;
#pragma unroll
        for (int a = 0; a < 2; ++a)
#pragma unroll
            for (int b = 0; b < 2; ++b)
#pragma unroll
                for (int m = 0; m < 4; ++m)
#pragma unroll
                    for (int n = 0; n < 2; ++n) acc[a][b][m][n] = (acc_t){0, 0, 0, 0};
        cur = nxt; cA = nA; cB = nB; ++ui;
        if constexpr (Sched::GATHER) { gc[0][0] = gn[0][0]; gc[0][1] = gn[0][1]; gc[1][0] = gn[1][0]; gc[1][1] = gn[1][1]; }
    }
    PG8_WAIT_V(0);
    if (wr == 0) PG8_BAR;
    PG8_BAR;
#undef PG8_SA
#undef PG8_GATH
#undef PG8_STAGE_A
#undef PG8_SB
#undef PG8_STAGE
#undef PG8_LDA
#undef PG8_LDB
#undef PG8_MMA
#undef PG8_WAIT_V
#undef PG8_WAIT_L
#undef PG8_BAR
#undef PG8_SCHED
}
}

#define XB_TMO      128
#define XB_XCNT(j)  (256  + 64 * (j))
#define XB_XSUB(j)  (1280 + 64 * (j))
#define XB_XGEN(j)  (2304 + 64 * (j))
#define XB_TOP      3328
#define XB_TOPGEN   3392
#define XCD_BAR_WORDS 3456
#define XB_SPIN_CAP (1u << 21)

__device__ __forceinline__ unsigned xb_ld(unsigned* p)              { return __hip_atomic_load(p, __ATOMIC_RELAXED, __HIP_MEMORY_SCOPE_AGENT); }
__device__ __forceinline__ unsigned xb_add(unsigned* p, unsigned v) { return __hip_atomic_fetch_add(p, v, __ATOMIC_RELAXED, __HIP_MEMORY_SCOPE_AGENT); }
__device__ __forceinline__ unsigned xb_xcc_id() { return (unsigned)__builtin_amdgcn_s_getreg((3 << 11) | 20) & 0xFu; }
#define XB_SPIN(cond, bar) do { unsigned _sp = 0; while (cond) { __builtin_amdgcn_s_sleep(1); \
    if ((++_sp & 255u) == 0u) { if (xb_ld(&(bar)[XB_TMO])) break; if (_sp > XB_SPIN_CAP) { atomicAdd(&(bar)[XB_TMO], 1u); break; } } } } while (0)

struct XcdBarrier {
    unsigned* bar; unsigned x;
    volatile LAS unsigned* st;
};

__device__ __forceinline__ XcdBarrier xcd_barrier_post(unsigned* bar, volatile LAS unsigned* st) {
    XcdBarrier b; b.bar = bar; b.x = xb_xcc_id(); b.st = st;
    if (threadIdx.x == 0) (void)xb_add(&bar[XB_XCNT(b.x)], 1u);
    return b;
}
__device__ __forceinline__ void xcd_barrier_complete(unsigned* bar, unsigned x, unsigned& nloc, unsigned& nx) {
    const unsigned G = gridDim.x * gridDim.y * gridDim.z;
    unsigned sum, cnt, mine, sp = 0u;
    for (;;) {
        sum = 0u; cnt = 0u; mine = 0u;
#pragma unroll
        for (unsigned j = 0; j < 16; ++j) { const unsigned c = xb_ld(&bar[XB_XCNT(j)]); sum += c; cnt += (c > 0u) ? 1u : 0u; mine = (j == x) ? c : mine; }
        if (sum == G) break;
        __builtin_amdgcn_s_sleep(1);
        if ((++sp & 255u) == 0u) { if (xb_ld(&bar[XB_TMO])) break; if (sp > XB_SPIN_CAP) { atomicAdd(&bar[XB_TMO], 1u); break; } }
    }
    nloc = mine > 0u ? mine : 1u; nx = cnt > 0u ? cnt : 1u;
}

__device__ __forceinline__ void xcd_barrier(const XcdBarrier& b) {
    asm volatile("s_waitcnt vmcnt(0)" ::: "memory");
    __syncthreads();
    if (threadIdx.x == 0) {
        unsigned* bar = b.bar;
        __builtin_amdgcn_s_waitcnt(0);
        unsigned nloc = b.st[0], nx = b.st[1];
        if (nloc == 0u) { xcd_barrier_complete(bar, b.x, nloc, nx); b.st[0] = nloc; b.st[1] = nx; }
        const unsigned old = xb_add(&bar[XB_XSUB(b.x)], 1u);
        const unsigned gen = old / nloc;
        if (old + 1u == (gen + 1u) * nloc) {
            __builtin_amdgcn_fence(__ATOMIC_RELEASE, "agent");
            asm volatile("s_waitcnt vmcnt(0)" ::: "memory");
            const unsigned og = xb_add(&bar[XB_TOP], 1u);
            const unsigned tg = og / nx;
            if (og + 1u == (tg + 1u) * nx) xb_add(&bar[XB_TOPGEN], 1u);
            else XB_SPIN(xb_ld(&bar[XB_TOPGEN]) == tg, bar);
            __builtin_amdgcn_fence(__ATOMIC_ACQUIRE, "agent");
            xb_add(&bar[XB_XGEN(b.x)], 1u);
            asm volatile("s_waitcnt vmcnt(0)" ::: "memory");
        } else {
            XB_SPIN(xb_ld(&bar[XB_XGEN(b.x)]) == gen, bar);
            __builtin_amdgcn_fence(__ATOMIC_ACQUIRE, "agent");
            asm volatile("s_waitcnt vmcnt(0)" ::: "memory");
        }
    }
    __syncthreads();
}

constexpr int NWAVES = 8, NTHREADS = 512;
constexpr int RING_BYTES = 131072;
constexpr int LDSCTL_OFF = 155648 - 1024, MISC_OFF = LDSCTL_OFF + 320;
constexpr int LDS_BYTES = 155648;

struct Params { const float* in[19]; float* out; unsigned char* ws; float inv_freq[16]; float ret_lg2[4]; int ph_lo, ph_hi; };
typedef const __attribute__((address_space(4))) Params& KPRef;

__device__ __forceinline__ float wave_sum(float v) {
#pragma unroll
    for (int o = 1; o < 64; o <<= 1) v += __shfl_xor(v, o);
    return v;
}
#define LDS_WAIT() asm volatile("s_waitcnt lgkmcnt(0)" ::: "memory")
#define MFMA16(a, b, c) __builtin_amdgcn_mfma_f32_16x16x32_bf16(a, b, c, 0, 0, 0)
typedef short v4i16_t __attribute__((ext_vector_type(4)));
__device__ __forceinline__ v4i16_t lds_tr16(const bf16_t* p) { return __builtin_amdgcn_ds_read_tr16_b64_v4i16((LAS v4i16_t*)(LAS unsigned char*)(unsigned char*)p); }
__device__ __forceinline__ bf16x8 tr_frag(const bf16_t* tile, int stride, int rowa, int rowb, int col0, int lane) {
    const int i = lane & 15, q = i >> 2, pp = i & 3;
    const v4i16_t lo = lds_tr16(tile + (rowa + q) * stride + col0 + 4 * pp), hi = lds_tr16(tile + (rowb + q) * stride + col0 + 4 * pp);
    return (bf16x8){lo[0], lo[1], lo[2], lo[3], hi[0], hi[1], hi[2], hi[3]};
}
__device__ __forceinline__ bf16x8 pack_p(const f32x4& a, const f32x4& b) {
    u32x4 w; w.x = pg8::cvt_pk_bf16(a[0], a[1]); w.y = pg8::cvt_pk_bf16(a[2], a[3]); w.z = pg8::cvt_pk_bf16(b[0], b[1]); w.w = pg8::cvt_pk_bf16(b[2], b[3]); return __builtin_bit_cast(bf16x8, w); }


template <class LD>
__device__ __forceinline__ void conv_item(LD ld, bf16_t* WT, int K, float* scr, int kb, int nb, int lane) {
    const int k0 = 64 * kb, n0 = 32 * nb;
#pragma unroll 8
    for (int i = 0; i < 32; ++i) { const int kk = 2 * i + (lane >> 5); scr[kk * 33 + (lane & 31)] = ld(k0 + kk, n0 + (lane & 31)); }
    LDS_WAIT();
    const int c = lane & 7;
#pragma unroll
    for (int j = 0; j < 4; ++j) { const int n = (lane >> 3) + 8 * j; const float* s = scr + (8 * c) * 33 + n;
        u32x4 o; o.x = pk2(s[0 * 33], s[1 * 33]); o.y = pk2(s[2 * 33], s[3 * 33]); o.z = pk2(s[4 * 33], s[5 * 33]); o.w = pk2(s[6 * 33], s[7 * 33]);
        *(u32x4*)(WT + (size_t)(n0 + n) * K + k0 + 8 * c) = o; }
    LDS_WAIT();
}

template <class LD>
__device__ __forceinline__ void amax_item(LD ld, unsigned* raw, int kb, int nb, int lane) {
    const int k0 = 64 * kb, n0 = 32 * nb; float v[32];
#pragma unroll
    for (int i = 0; i < 32; ++i) v[i] = ld(k0 + 2 * i + (lane >> 5), n0 + (lane & 31));
    float am = 0.f;
#pragma unroll
    for (int i = 0; i < 32; ++i) am = fmaxf(am, fabsf(v[i]));
    am = fmaxf(am, __shfl_xor(am, 32));
    if (lane < 32) atomicMax(raw + n0 + lane, __float_as_uint(am));
}
template <class LD, class SC>
__device__ __forceinline__ void quant_item(LD ld, SC extra, const unsigned* raw, signed char* WT, float* scale, float* scr, int kb, int nb, int lane) {
    const int k0 = 64 * kb, n0 = 32 * nb;
    const float am = __uint_as_float(raw[n0 + (lane & 31)]), qs = (am > 0.f) ? 127.0f / am : 0.f;
    if (kb == 0 && lane < 32) scale[n0 + lane] = am * (1.0f / 127.0f) * extra(n0 + lane);
#pragma unroll 8
    for (int i = 0; i < 32; ++i) { const int kk = 2 * i + (lane >> 5); scr[kk * 33 + (lane & 31)] = rintf(ld(k0 + kk, n0 + (lane & 31)) * qs); }
    LDS_WAIT();
    const int c = lane & 7;
#pragma unroll
    for (int j = 0; j < 4; ++j) { const int n = (lane >> 3) + 8 * j; const float* s = scr + (8 * c) * 33 + n;
        u32x2 o; o.x = ((unsigned)((int)s[0 * 33] & 0xff)) | ((unsigned)((int)s[1 * 33] & 0xff) << 8) | ((unsigned)((int)s[2 * 33] & 0xff) << 16) | ((unsigned)((int)s[3 * 33] & 0xff) << 24);
        o.y = ((unsigned)((int)s[4 * 33] & 0xff)) | ((unsigned)((int)s[5 * 33] & 0xff) << 8) | ((unsigned)((int)s[6 * 33] & 0xff) << 16) | ((unsigned)((int)s[7 * 33] & 0xff) << 24);
        *(u32x2*)(WT + (size_t)(n0 + n) * 1024 + k0 + 8 * c) = o; }
    LDS_WAIT();
}
template <int PASS>
__device__ __forceinline__ void conv8_pass(KPRef p, int l, unsigned char* lds, int gw, int NGW, int wave, int lane) {
    float* scr = (float*)(lds + wave * 16384); unsigned char* ws = p.ws; unsigned* raw = (unsigned*)(ws + WS_SWRAW);
    const float* Win = p.in[2] + (size_t)l * 1024 * IN_W;
    for (int it = gw; it < 16 * 96; it += NGW) { const int kb = it / 96, nb = it % 96;
        auto ld = [&](int k, int n) -> float { return n < Z_GATE ? Win[(size_t)k * IN_W + n] : 0.f; };
        if (PASS == 0) amax_item(ld, raw, kb, nb, lane);
        else quant_item(ld, [&](int n) -> float { float s = 1.f; if (n < Z_GK) s = RSQ32; else if (n >= Z_SQ && n < Z_SK) s = C2; else if (n >= Z_MQ && n < Z_MK) s = C2; else if (n >= Z_RK && n < Z_RV) s = RSQ32; return s; },
                        raw, (signed char*)(ws + WS_WIN), (float*)(ws + WS_SWIN), scr, kb, nb, lane); }
    for (int it = gw; it < 16 * 128; it += NGW) { const int kb = it / 128, nb = it % 128;
        auto ld = [&](int k, int n) -> float { const int pn = n >> 8, c = n & 255, bj = (c >> 7) & 1, wc = (c >> 5) & 3, nn = (c >> 4) & 1, fq = (c >> 2) & 3, j = c & 3;
            const int col = Z_GATE + 1024 * (2 * bj + nn) + 64 * pn + 16 * wc + 4 * fq + j; return Win[(size_t)k * IN_W + col]; };
        if (PASS == 0) amax_item(ld, raw + 3072, kb, nb, lane);
        else quant_item(ld, [&](int) -> float { return 1.f; }, raw + 3072, (signed char*)(ws + WS_WG), (float*)(ws + WS_SWG), scr, kb, nb, lane); }
    for (int it = gw; it < 32 * 256; it += NGW) { const int e = it / 256, r = it % 256, kb = r / 16, nb = r % 16;
        const int n0 = 32 * nb, pn = n0 >> 8, c0 = n0 & 255;
        const float* W = ((c0 < 128) ? p.in[15] : p.in[16]) + (size_t)(l * 32 + e) * 1024 * 256 + 128 * pn + (c0 & 127) - n0;
        auto ld = [&](int k, int n) -> float { return W[(size_t)k * 256 + n]; };
        if (PASS == 0) amax_item(ld, raw + 7168 + e * 512, kb, nb, lane);
        else quant_item(ld, [&](int) -> float { return 1.f; }, raw + 7168 + e * 512, (signed char*)(ws + WS_E1) + (size_t)e * 512 * 1024, (float*)(ws + WS_SWE1) + e * 512, scr, kb, nb, lane); }
}

__device__ __forceinline__ void conv_phase(KPRef p, int l, unsigned char* lds, int gw, int NGW, int wave, int lane) {
    float* scr = (float*)(lds + wave * 16384);
    unsigned char* ws = p.ws;
    {
        for (int it = gw; it < 512; it += NGW) { const int i = it / 128, r = it % 128, kb = r / 32, nb = r % 32;
            const float* W = p.in[8] + (size_t)(l * 4 + i) * 256 * 1024; bf16_t* WT = (bf16_t*)(ws + WS_WB) + (size_t)i * 1024 * 256;
            conv_item([&](int k, int n) -> float { return W[(size_t)k * 1024 + n]; }, WT, 256, scr, kb, nb, lane); }
    }
    {
        const float* W = p.in[9] + (size_t)l * 1024 * 1024; bf16_t* WT = (bf16_t*)(ws + WS_WO);
        for (int it = gw; it < 16 * 32; it += NGW) { const int kb = it / 32, nb = it % 32;
            conv_item([&](int k, int n) -> float { return W[(size_t)k * 1024 + n]; }, WT, 1024, scr, kb, nb, lane); }
    }
    {
        const float* Wg = p.in[11] + (size_t)l * 1024 * 4; const float* We = p.in[13] + (size_t)l * 1024 * 32; bf16_t* WT = (bf16_t*)(ws + WS_WR);
        for (int it = gw; it < 16 * 8; it += NGW) { const int kb = it / 8, nb = it % 8;
            conv_item([&](int k, int n) -> float { if (n < 4) return Wg[k * 4 + n]; if (n < 36) return We[k * 32 + (n - 4)]; return 0.f; }, WT, 1024, scr, kb, nb, lane); }
    }
    {
        for (int it = gw; it < 32 * 128; it += NGW) { const int e = it / 128, r = it % 128, kb = r / 32, nb = r % 32;
            const float* W = p.in[17] + (size_t)(l * 32 + e) * 256 * 1024; bf16_t* WT = (bf16_t*)(ws + WS_E2) + (size_t)e * 1024 * 256;
            conv_item([&](int k, int n) -> float { return W[(size_t)k * 1024 + n]; }, WT, 256, scr, kb, nb, lane); }
    }
}

__device__ __forceinline__ bf16_t* hbf_ptr(KPRef p) { return (bf16_t*)((unsigned char*)p.out + (size_t)64 * MiB); }
template <bool SRC_F32, bool COMBINE>
__device__ __forceinline__ void norm_load_row(KPRef p, int row, int lane, f32x4 (&v)[4]) {
    if (SRC_F32) { const f32x4* xr = (const f32x4*)(p.in[0] + (size_t)row * 1024) + lane;
#pragma unroll
        for (int j = 0; j < 4; ++j) v[j] = xr[64 * j];
    } else { const u32x2* hr = (const u32x2*)(hbf_ptr(p) + (size_t)row * 1024) + lane;
#pragma unroll
        for (int j = 0; j < 4; ++j) { const u32x2 a = hr[64 * j]; v[j] = (f32x4){__uint_as_float(a.x << 16), __uint_as_float(a.x & 0xffff0000u), __uint_as_float(a.y << 16), __uint_as_float(a.y & 0xffff0000u)}; } }
    if (COMBINE) { const bf16_t* ys = (const bf16_t*)(p.ws + WS_YS); const float* tokw = (const float*)(p.ws + WS_TOKW);
        const float w0 = tokw[2 * row], w1 = tokw[2 * row + 1];
        const u32x2* y0 = (const u32x2*)(ys + (size_t)(2 * row) * 1024) + lane; const u32x2* y1 = (const u32x2*)(ys + (size_t)(2 * row + 1) * 1024) + lane;
        u32x2 ya[4], yb[4];
#pragma unroll
        for (int j = 0; j < 4; ++j) { ya[j] = y0[64 * j]; yb[j] = y1[64 * j]; }
#pragma unroll
        for (int j = 0; j < 4; ++j) { const u32x2 a = ya[j], b = yb[j];
            v[j][0] += w0 * __uint_as_float(a.x << 16) + w1 * __uint_as_float(b.x << 16); v[j][1] += w0 * __uint_as_float(a.x & 0xffff0000u) + w1 * __uint_as_float(b.x & 0xffff0000u);
            v[j][2] += w0 * __uint_as_float(a.y << 16) + w1 * __uint_as_float(b.y << 16); v[j][3] += w0 * __uint_as_float(a.y & 0xffff0000u) + w1 * __uint_as_float(b.y & 0xffff0000u); } }
}
__device__ __forceinline__ float row_rstd(const f32x4 (&v)[4]) {
    float s = 0.f;
#pragma unroll
    for (int j = 0; j < 4; ++j) s += (v[j][0] * v[j][0] + v[j][1] * v[j][1]) + (v[j][2] * v[j][2] + v[j][3] * v[j][3]);
    return rsqrtf(wave_sum(s) * (1.0f / 1024.0f) + NORM_EPS);
}
template <int MODE>
__device__ __forceinline__ void norm_phase(KPRef p, int l, int gw, int NGW, int lane) {
    const float* gain = (MODE == 2 ? p.in[10] + l * 1024 : p.in[1] + l * 1024);
    f32x4 gg[4];
#pragma unroll
    for (int j = 0; j < 4; ++j) gg[j] = ((const f32x4*)gain)[lane + 64 * j];
    constexpr int NR = (MODE == 1) ? 2 : 4;
    for (int row0 = gw * NR; row0 < T_; row0 += NGW * NR) {
        f32x4 v[NR][4];
#pragma unroll
        for (int r = 0; r < NR; ++r) norm_load_row<MODE == 0, MODE == 1>(p, row0 + r, lane, v[r]);
#pragma unroll
        for (int r = 0; r < NR; ++r) {
            if (MODE == 1) { u32x2* hr = (u32x2*)(hbf_ptr(p) + (size_t)(row0 + r) * 1024) + lane;
#pragma unroll
                for (int j = 0; j < 4; ++j) { u32x2 w; w.x = pk2(v[r][j][0], v[r][j][1]); w.y = pk2(v[r][j][2], v[r][j][3]); hr[64 * j] = w; } }
            const float rstd = row_rstd(v[r]);
            f32x4 o[4]; float am = 0.f;
#pragma unroll
            for (int j = 0; j < 4; ++j) { o[j] = v[r][j] * rstd * gg[j]; am = fmaxf(fmaxf(am, fmaxf(fabsf(o[j][0]), fabsf(o[j][1]))), fmaxf(fabsf(o[j][2]), fabsf(o[j][3]))); }
#pragma unroll
            for (int of = 1; of < 64; of <<= 1) am = fmaxf(am, __shfl_xor(am, of));
            const float qs = (am > 0.f) ? 127.0f / am : 0.f;
            unsigned* o4 = (unsigned*)(p.ws + WS_U8 + (size_t)(row0 + r) * 1024) + lane;
#pragma unroll
            for (int j = 0; j < 4; ++j) { const int q0 = (int)rintf(o[j][0] * qs), q1 = (int)rintf(o[j][1] * qs), q2 = (int)rintf(o[j][2] * qs), q3 = (int)rintf(o[j][3] * qs);
                o4[64 * j] = (unsigned)(q0 & 0xff) | ((unsigned)(q1 & 0xff) << 8) | ((unsigned)(q2 & 0xff) << 16) | ((unsigned)(q3 & 0xff) << 24); }
            if (lane == 0) ((float*)(p.ws + WS_SU))[row0 + r] = am * (1.0f / 127.0f);
            if (MODE == 2) { u32x2* o8 = (u32x2*)(p.ws + WS_U2BF + (size_t)(row0 + r) * 2048) + lane;
#pragma unroll
                for (int j = 0; j < 4; ++j) { u32x2 w; w.x = pk2(o[j][0], o[j][1]); w.y = pk2(o[j][2], o[j][3]); o8[64 * j] = w; } }
        }
    }
}
struct FinalHold { f32x4 v[8][4]; };
__device__ __forceinline__ void final_a(KPRef p, int gw, int NGW, int lane, FinalHold& Hd) {
    f32x4 gg[4];
#pragma unroll
    for (int j = 0; j < 4; ++j) gg[j] = ((const f32x4*)p.in[18])[lane + 64 * j];
    for (int row0 = gw * 4; row0 < T_ / 2; row0 += NGW * 4) {
        f32x4 v[4][4];
#pragma unroll
        for (int r = 0; r < 4; ++r) norm_load_row<false, true>(p, row0 + r, lane, v[r]);
#pragma unroll
        for (int r = 0; r < 4; ++r) { const float rstd = row_rstd(v[r]); f32x4* orow = (f32x4*)(p.out + (size_t)(row0 + r) * 1024) + lane;
#pragma unroll
            for (int j = 0; j < 4; ++j) orow[64 * j] = v[r][j] * rstd * gg[j]; } }
#pragma unroll
    for (int r = 0; r < 8; ++r) norm_load_row<false, true>(p, T_ / 2 + gw * 8 + r, lane, Hd.v[r]);
}
__device__ __forceinline__ void final_b(KPRef p, int gw, int lane, const FinalHold& Hd) {
    f32x4 gg[4];
#pragma unroll
    for (int j = 0; j < 4; ++j) gg[j] = ((const f32x4*)p.in[18])[lane + 64 * j];
#pragma unroll
    for (int r = 0; r < 8; ++r) { const float rstd = row_rstd(Hd.v[r]); f32x4* orow = (f32x4*)(p.out + (size_t)(T_ / 2 + gw * 8 + r) * 1024) + lane;
#pragma unroll
        for (int j = 0; j < 4; ++j) orow[64 * j] = Hd.v[r][j] * rstd * gg[j]; }
}

constexpr int LA_QS = 0, LA_KS = 10240, LA_VS = 20480  , LA_KD = 38912  , LA_PS = 49152  , LA_PW = 58368, LA_PW_WAVE = 4352,
              LA_LA = 93184, LA_AS = 110080, LA_END = 118272;
__device__ __forceinline__ void unpack8f(float (&d)[8], u32x4 kk) {
    d[0] = __uint_as_float(kk.x << 16); d[1] = __uint_as_float(kk.x & 0xffff0000u); d[2] = __uint_as_float(kk.y << 16); d[3] = __uint_as_float(kk.y & 0xffff0000u);
    d[4] = __uint_as_float(kk.z << 16); d[5] = __uint_as_float(kk.z & 0xffff0000u); d[6] = __uint_as_float(kk.w << 16); d[7] = __uint_as_float(kk.w & 0xffff0000u); }
__device__ __forceinline__ u32x4 pack8f(const float (&o)[8]) { u32x4 w; w.x = pk2(o[0], o[1]); w.y = pk2(o[2], o[3]); w.z = pk2(o[4], o[5]); w.w = pk2(o[6], o[7]); return w; }

struct LaRegs { u32x4 a, k[2], q[2], v[2], g[2]; f32x4 pv[2]; };
__device__ __forceinline__ void gla_decay_front(KPRef p, int l, unsigned char* lds, const u32x4& areg, int h, int tid) {
    float* LA = (float*)(lds + LA_LA); float* AS = (float*)(lds + LA_AS);
    const int lane = tid & 63, wave = __builtin_amdgcn_readfirstlane(tid >> 6);
    if (tid < 256) { const int t = tid >> 1, hf = tid & 1; float a[8]; unpack8f(a, areg);
#pragma unroll
        for (int e = 0; e < 8; ++e) AS[t * 16 + 8 * hf + e] = a[e]; }
    const int d = tid & 31; const float* wa2 = p.in[3] + (size_t)l * 16 * 128 + h * 32 + d; float wcol[16];
#pragma unroll
    for (int r = 0; r < 16; ++r) wcol[r] = wa2[r * 128];
    const float bias = p.in[4][l * 128 + h * 32 + d];
    __syncthreads();
#pragma unroll
    for (int i = 0; i < 8; ++i) { const int t = (tid >> 5) + 16 * i; float x = bias;
#pragma unroll
        for (int r = 0; r < 16; ++r) x += AS[t * 16 + r] * wcol[r];
        LA[t * 33 + d] = (fminf(x, 0.f) - __builtin_amdgcn_logf(1.0f + __builtin_amdgcn_exp2f(-fabsf(x) * LOG2E)) * 0.6931471805599453f) * (1.0f / 16.0f); }
    __syncthreads();
#pragma unroll
    for (int s8 = 0; s8 < 8; ++s8) { const int s = wave * 8 + s8, ch = s >> 5, dd = s & 31; float v = LA[(64 * ch + lane) * 33 + dd];
#pragma unroll
        for (int o = 1; o < 64; o <<= 1) { const float t = __shfl_up(v, o); if (lane >= o) v += t; }
        LA[(64 * ch + lane) * 33 + dd] = v; }
    __syncthreads();
}
__device__ __forceinline__ void la_stage_v(unsigned char* lds, const u32x4 (&v)[2], int tid) {
    bf16_t* VS = (bf16_t*)(lds + LA_VS);
#pragma unroll
    for (int i = 0; i < 2; ++i) { const int c = tid + 512 * i, t = c >> 3, oct = c & 7; *(u32x4*)(VS + t * 72 + 8 * oct) = v[i]; }
}
template <bool OUT, bool GLA>
__device__ __forceinline__ void la_load(LaRegs& R, KPRef p, int unit, int tid) {
    const int lane = tid & 63, wave = __builtin_amdgcn_readfirstlane(tid >> 6);
    int b, h, c128; if (GLA) { c128 = unit & 63; h = (unit >> 6) & 3; b = unit >> 8; } else { c128 = unit & 63; const int bh = unit >> 6; h = bh & 3; b = bh >> 2; }
    const size_t t0 = (size_t)b * S_ + (size_t)c128 * 128; const bf16_t* zrow0 = (const bf16_t*)(p.ws + WS_Z) + t0 * ZW;
    const int kcol = GLA ? Z_GK + h * 32 : Z_RK + h * 32, qcol = GLA ? Z_GQ + h * 32 : Z_RQ + h * 32, vcol = GLA ? Z_GV + h * 64 : Z_RV + h * 64, gcol = GLA ? Z_GR + h * 64 : Z_RG + h * 64;
    if (GLA) { const int t = (tid & 255) >> 1, hf = tid & 1; R.a = *(const u32x4*)(zrow0 + (size_t)t * ZW + Z_GA + 8 * hf); }
    { const int t = tid >> 2, oct = tid & 3; const bf16_t* kr = zrow0 + (size_t)t * ZW + kcol; R.k[0] = *(const u32x4*)(kr + 8 * oct); if (!GLA) R.k[1] = *(const u32x4*)(kr + 8 * (oct ^ 2));
      if (OUT) { const bf16_t* qr = zrow0 + (size_t)t * ZW + qcol; R.q[0] = *(const u32x4*)(qr + 8 * oct); if (!GLA) R.q[1] = *(const u32x4*)(qr + 8 * (oct ^ 2)); } }
#pragma unroll
    for (int i = 0; i < 2; ++i) { const int c = tid + 512 * i, t = c >> 3, oct = c & 7; R.v[i] = *(const u32x4*)(zrow0 + (size_t)t * ZW + vcol + 8 * oct); }
    if (OUT) {
#pragma unroll
        for (int i = 0; i < 2; ++i) { const int cidx = lane + 64 * i, row = cidx >> 3, oct = cidx & 7; R.g[i] = *(const u32x4*)(zrow0 + (size_t)(16 * wave + row) * ZW + gcol + 8 * oct); }
        const float* prev = GLA ? (const float*)(p.ws + WS_GKV) + (size_t)((b * 4 + h) * 128 + 2 * c128) * 2048 : (const float*)(p.ws + WS_RKV) + (size_t)unit * 2048;
        const int row = (GLA ? tid : (tid & 255)) >> 3, oct = tid & 7; R.pv[0] = *(const f32x4*)(prev + row * 64 + 8 * oct); R.pv[1] = *(const f32x4*)(prev + row * 64 + 8 * oct + 4); }
}
__device__ __forceinline__ void la_kv_mfma(unsigned char* lds, float* out0, int nch, int clen, int tid) {
    const bf16_t* KD = (const bf16_t*)(lds + LA_KD); const bf16_t* VS = (const bf16_t*)(lds + LA_VS);
    const int lane = tid & 63, wave = __builtin_amdgcn_readfirstlane(tid >> 6), c16 = lane & 15, g = lane >> 4;
    const int ntile = 8 * nch;
    for (int ti = wave; ti < ntile; ti += 8) { const int ch = ti >> 3, dt = (ti >> 2) & 1, et = ti & 3, tok0 = ch * clen;
        f32x4 acc = (f32x4){0.f, 0.f, 0.f, 0.f};
        for (int s = 0; s < clen / 32; ++s) { const int r0 = tok0 + 32 * s + 8 * g;
            acc = MFMA16(tr_frag(KD, 40, r0, r0 + 4, 16 * dt, lane), tr_frag(VS, 72, r0, r0 + 4, 16 * et, lane), acc); }
        float* o = out0 + (size_t)ch * 2048 + (16 * dt + 4 * g) * 64 + 16 * et + c16;
#pragma unroll
        for (int r = 0; r < 4; ++r) o[r * 64] = acc[r]; }
}
__device__ __forceinline__ void gla_kv_unit(KPRef p, int l, unsigned char* lds, int unit, const LaRegs& R, int tid) {
    const int c = unit & 63, h = (unit >> 6) & 3, b = unit >> 8;
    gla_decay_front(p, l, lds, R.a, h, tid);
    const float* LA = (const float*)(lds + LA_LA); bf16_t* KD = (bf16_t*)(lds + LA_KD);
    { const int t = tid >> 2, oct = tid & 3, ch = t >> 6; float k[8]; unpack8f(k, R.k[0]);
#pragma unroll
      for (int e = 0; e < 8; ++e) { const int d = 8 * oct + e; k[e] *= __builtin_amdgcn_exp2f((LA[(64 * ch + 63) * 33 + d] - LA[t * 33 + d]) * LOG2E); }
      *(u32x4*)(KD + t * 40 + 8 * oct) = pack8f(k); }
    la_stage_v(lds, R.v, tid);
    __syncthreads();
    const int cu = ((b * 4 + h) * 128 + 2 * c);
    la_kv_mfma(lds, (float*)(p.ws + WS_GKV) + (size_t)cu * 2048, 2, 64, tid);
    if (tid < 64) { const int ch = tid >> 5, d = tid & 31; ((float*)(p.ws + WS_GDEC))[(size_t)(cu + ch) * 32 + d] = __builtin_amdgcn_exp2f(LA[(64 * ch + 63) * 33 + d] * LOG2E); }
    __syncthreads();
}
__device__ __forceinline__ void la_out_mfma(unsigned char* lds, const u32x4 (&gate)[2], const float* ng, bf16_t* orow0, int ocol, int clen, int tid) {
    const bf16_t* QS = (const bf16_t*)(lds + LA_QS); const bf16_t* KS = (const bf16_t*)(lds + LA_KS); const bf16_t* VS = (const bf16_t*)(lds + LA_VS); const bf16_t* PS = (const bf16_t*)(lds + LA_PS);
    const int lane = tid & 63, wave = __builtin_amdgcn_readfirstlane(tid >> 6), c16 = lane & 15, g = lane >> 4;
    float* PWf = (float*)(lds + LA_PW + wave * LA_PW_WAVE);
    const int ch = (clen == 64) ? (wave >> 2) : 0, kt0 = (clen == 64) ? 4 * ch : 0;
    const bf16x8 qa = *(const bf16x8*)(QS + (16 * wave + c16) * 40 + 8 * g);
    f32x4 O[4];
#pragma unroll
    for (int et = 0; et < 4; ++et) O[et] = MFMA16(qa, tr_frag(PS + ch * 32 * 72, 72, 8 * g, 8 * g + 4, 16 * et, lane), ((f32x4){0.f, 0.f, 0.f, 0.f}));
    for (int s = kt0 >> 1; s <= (wave >> 1); ++s) {
        f32x4 P0, P1;
        { const int kt = 2 * s; P0 = MFMA16(*(const bf16x8*)(KS + (16 * kt + c16) * 40 + 8 * g), qa, ((f32x4){0.f, 0.f, 0.f, 0.f}));
          if (kt == wave) {
#pragma unroll
              for (int r = 0; r < 4; ++r) if (4 * g + r > c16) P0[r] = 0.f; } }
        { const int kt = 2 * s + 1;
          if (kt <= wave) { P1 = MFMA16(*(const bf16x8*)(KS + (16 * kt + c16) * 40 + 8 * g), qa, ((f32x4){0.f, 0.f, 0.f, 0.f}));
            if (kt == wave) {
#pragma unroll
                for (int r = 0; r < 4; ++r) if (4 * g + r > c16) P1[r] = 0.f; } }
          else P1 = (f32x4){0.f, 0.f, 0.f, 0.f}; }
        const bf16x8 pa = pack_p(P0, P1);
#pragma unroll
        for (int et = 0; et < 4; ++et) O[et] = MFMA16(pa, tr_frag(VS, 72, 32 * s + 4 * g, 32 * s + 16 + 4 * g, 16 * et, lane), O[et]); }
    float rs[4];
#pragma unroll
    for (int r = 0; r < 4; ++r) { float ss = O[0][r] * O[0][r] + O[1][r] * O[1][r] + O[2][r] * O[2][r] + O[3][r] * O[3][r];
#pragma unroll
        for (int o = 1; o < 16; o <<= 1) ss += __shfl_xor(ss, o);
        rs[r] = rsqrtf(ss * (1.0f / 64.0f) + NORM_EPS); }
#pragma unroll
    for (int et = 0; et < 4; ++et)
#pragma unroll
        for (int r = 0; r < 4; ++r) PWf[(4 * g + r) * 68 + 16 * et + c16] = O[et][r] * rs[r];
    LDS_WAIT();
#pragma unroll
    for (int i = 0; i < 2; ++i) { const int cidx = lane + 64 * i, row = cidx >> 3, oct = cidx & 7; const int t = 16 * wave + row;
        float gt[8]; unpack8f(gt, gate[i]);
        const f32x4 o0 = *(const f32x4*)(PWf + row * 68 + 8 * oct), o1 = *(const f32x4*)(PWf + row * 68 + 8 * oct + 4), n0 = *(const f32x4*)(ng + 8 * oct), n1 = *(const f32x4*)(ng + 8 * oct + 4);
        float o[8];
#pragma unroll
        for (int e = 0; e < 4; ++e) { o[e] = o0[e] * n0[e] * (gt[e] * sigmoidf_(gt[e])); o[4 + e] = o1[e] * n1[e] * (gt[4 + e] * sigmoidf_(gt[4 + e])); }
        *(u32x4*)(orow0 + (size_t)t * 1024 + ocol + 8 * oct) = pack8f(o); }
    LDS_WAIT();
}
__device__ __forceinline__ void gla_out_unit(KPRef p, int l, unsigned char* lds, int unit, const LaRegs& R, int tid) {
    const int c = unit & 63, h = (unit >> 6) & 3, b = unit >> 8;
    const size_t t0 = (size_t)b * S_ + (size_t)c * 128;
    gla_decay_front(p, l, lds, R.a, h, tid);
    const float* LA = (const float*)(lds + LA_LA); bf16_t* QS = (bf16_t*)(lds + LA_QS); bf16_t* KS = (bf16_t*)(lds + LA_KS); bf16_t* PS = (bf16_t*)(lds + LA_PS);
    { const int t = tid >> 2, oct = tid & 3; float k[8], q[8]; unpack8f(k, R.k[0]); unpack8f(q, R.q[0]);
#pragma unroll
      for (int e = 0; e < 8; ++e) { const float bb = LA[t * 33 + 8 * oct + e] * LOG2E; q[e] *= __builtin_amdgcn_exp2f(bb); k[e] *= __builtin_amdgcn_exp2f(-bb); }
      *(u32x4*)(QS + t * 40 + 8 * oct) = pack8f(q); *(u32x4*)(KS + t * 40 + 8 * oct) = pack8f(k); }
    la_stage_v(lds, R.v, tid);
    { const int row = tid >> 3, oct = tid & 7; float o[8] = {R.pv[0][0], R.pv[0][1], R.pv[0][2], R.pv[0][3], R.pv[1][0], R.pv[1][1], R.pv[1][2], R.pv[1][3]}; *(u32x4*)(PS + row * 72 + 8 * oct) = pack8f(o); }
    __syncthreads();
    la_out_mfma(lds, R.g, p.in[5] + l * 64, (bf16_t*)(p.ws + WS_O) + t0 * 1024, 0 + h * 64, 64, tid);
    __syncthreads();
}
__device__ __forceinline__ void rope_cs(float pos, float invf, float& c, float& s) {
    const float ang = pos * invf; const double t = (double)ang * 0.15915494309189535; const float fr = (float)(t - floor(t));
    c = __builtin_amdgcn_cosf(fr); s = __builtin_amdgcn_sinf(fr);
}
__device__ __forceinline__ void ret_cs_table(KPRef p, unsigned char* lds, int pos0, int tid) {
    f32x2* CS = (f32x2*)(lds + LA_LA);
#pragma unroll
    for (int i = 0; i < 4; ++i) { const int idx = tid + 512 * i, t = idx >> 4, f = idx & 15; float c, s; rope_cs((float)(pos0 + t), p.inv_freq[f], c, s); CS[idx] = (f32x2){c, s}; }
}
__device__ __forceinline__ void ret_rot8(const unsigned char* lds, const u32x4& own_q, const u32x4& oth_q, int t, int oct, float (&o)[8]) {
    const f32x2* CS = (const f32x2*)(lds + LA_LA); float own[8], oth[8]; unpack8f(own, own_q); unpack8f(oth, oth_q);
#pragma unroll
    for (int e = 0; e < 8; ++e) { const f32x2 cs = CS[t * 16 + 8 * (oct & 1) + e]; o[e] = (oct < 2) ? (own[e] * cs[0] - oth[e] * cs[1]) : (oth[e] * cs[1] + own[e] * cs[0]); }
}
__device__ __forceinline__ void ret_kv_unit(KPRef p, unsigned char* lds, int unit, const LaRegs& R, int tid) {
    const int n = unit & 63, bh = unit >> 6, h = bh & 3;
    ret_cs_table(p, lds, n * 128, tid);
    la_stage_v(lds, R.v, tid);
    __syncthreads();
    bf16_t* KD = (bf16_t*)(lds + LA_KD); const float lg = p.ret_lg2[h];
    { const int t = tid >> 2, oct = tid & 3; float k[8]; ret_rot8(lds, R.k[0], R.k[1], t, oct, k); const float dk = __builtin_amdgcn_exp2f((float)(127 - t) * lg);
#pragma unroll
      for (int e = 0; e < 8; ++e) k[e] *= dk;
      *(u32x4*)(KD + t * 40 + 8 * oct) = pack8f(k); }
    __syncthreads();
    la_kv_mfma(lds, (float*)(p.ws + WS_RKV) + (size_t)unit * 2048, 1, 128, tid);
    __syncthreads();
}
__device__ __forceinline__ void ret_out_unit(KPRef p, int l, unsigned char* lds, int unit, const LaRegs& R, int tid) {
    const int n = unit & 63, bh = unit >> 6, h = bh & 3, b = bh >> 2;
    const size_t t0 = (size_t)b * S_ + (size_t)n * 128;
    ret_cs_table(p, lds, n * 128, tid);
    la_stage_v(lds, R.v, tid);
    const float lg = p.ret_lg2[h]; bf16_t* PS = (bf16_t*)(lds + LA_PS); const float g1 = __builtin_amdgcn_exp2f(lg);
    if (tid < 256) { const int row = tid >> 3, oct = tid & 7;
      float o[8] = {R.pv[0][0] * g1, R.pv[0][1] * g1, R.pv[0][2] * g1, R.pv[0][3] * g1, R.pv[1][0] * g1, R.pv[1][1] * g1, R.pv[1][2] * g1, R.pv[1][3] * g1}; *(u32x4*)(PS + row * 72 + 8 * oct) = pack8f(o); }
    __syncthreads();
    bf16_t* QS = (bf16_t*)(lds + LA_QS); bf16_t* KS = (bf16_t*)(lds + LA_KS);
    { const int t = tid >> 2, oct = tid & 3; float k[8], q[8]; ret_rot8(lds, R.k[0], R.k[1], t, oct, k); ret_rot8(lds, R.q[0], R.q[1], t, oct, q);
      const float dq = __builtin_amdgcn_exp2f((float)t * lg), dk = __builtin_amdgcn_exp2f(-(float)t * lg);
#pragma unroll
      for (int e = 0; e < 8; ++e) { q[e] *= dq; k[e] *= dk; }
      *(u32x4*)(QS + t * 40 + 8 * oct) = pack8f(q); *(u32x4*)(KS + t * 40 + 8 * oct) = pack8f(k); }
    __syncthreads();
    la_out_mfma(lds, R.g, p.in[7] + l * 64, (bf16_t*)(p.ws + WS_O) + t0 * 1024, 768 + h * 64, 128, tid);
    __syncthreads();
}
template <int KIND>
__device__ __forceinline__ void la_loop(KPRef p, int l, unsigned char* lds, int wg, int tid) {
    constexpr bool OUT = KIND >= 2, GLA = (KIND & 1) == 0; constexpr int NU = 1024, G = 256;
    int u = wg; if (u >= NU) return;
    LaRegs R; la_load<OUT, GLA>(R, p, u, tid);
    for (;;) {
        const int un = u + G; const bool hn = un < NU;
        LaRegs Rn; if (hn) la_load<OUT, GLA>(Rn, p, un, tid);
        if (KIND == 0) gla_kv_unit(p, l, lds, u, R, tid); else if (KIND == 1) ret_kv_unit(p, lds, u, R, tid); else if (KIND == 2) gla_out_unit(p, l, lds, u, R, tid); else ret_out_unit(p, l, lds, u, R, tid);
        if (!hn) break;
        R = Rn; u = un;
    }
}

__device__ __forceinline__ void scan_phase(KPRef p, int wg, int tid) {
    if (wg < 64) {
        const int bh = wg >> 2, elem = (wg & 3) * 512 + tid, d = elem >> 6;
        float* base = (float*)(p.ws + WS_GKV) + (size_t)bh * 128 * 2048 + elem; const float* dec = (const float*)(p.ws + WS_GDEC) + (size_t)bh * 128 * 32 + d;
        float s = 0.f;
#pragma unroll 1
        for (int n0 = 0; n0 < 128; n0 += 32) { float kv[32], dc[32];
#pragma unroll
            for (int j = 0; j < 32; ++j) { kv[j] = base[(size_t)(n0 + j) * 2048]; dc[j] = dec[(n0 + j) * 32]; }
#pragma unroll
            for (int j = 0; j < 32; ++j) { base[(size_t)(n0 + j) * 2048] = s; s = dc[j] * s + kv[j]; } }
    } else if (wg < 128) {
        const int w2 = wg - 64, bh = w2 >> 2, h = bh & 3, elem = (w2 & 3) * 512 + tid;
        float* base = (float*)(p.ws + WS_RKV) + (size_t)bh * 64 * 2048 + elem; const float dc = __builtin_amdgcn_exp2f(128.0f * p.ret_lg2[h]);
        float s = 0.f;
#pragma unroll 1
        for (int n0 = 0; n0 < 64; n0 += 32) { float kv[32];
#pragma unroll
            for (int j = 0; j < 32; ++j) kv[j] = base[(size_t)(n0 + j) * 2048];
#pragma unroll
            for (int j = 0; j < 32; ++j) { base[(size_t)(n0 + j) * 2048] = s; s = dc * s + kv[j]; } }
    }
}

__device__ __forceinline__ void kmean_unit(KPRef p, float* sm, int unit, int tid) {
    const bf16_t* z = (const bf16_t*)(p.ws + WS_Z); const size_t t0 = (size_t)unit * 256;
    const int oct = tid & 31, grp = tid >> 5; float s[8] = {0.f, 0.f, 0.f, 0.f, 0.f, 0.f, 0.f, 0.f};
    u32x4 q[16];
#pragma unroll
    for (int i = 0; i < 16; ++i) q[i] = *(const u32x4*)(z + (t0 + grp * 16 + i) * ZW + Z_MK + 8 * oct);
#pragma unroll
    for (int i = 0; i < 16; ++i) { float v[8]; unpack8f(v, q[i]);
#pragma unroll
        for (int e = 0; e < 8; ++e) s[e] += v[e]; }
#pragma unroll
    for (int e = 0; e < 8; ++e) sm[grp * 264 + 8 * oct + e] = s[e];
    __syncthreads();
    if (tid < 256) { float a = 0.f;
#pragma unroll
        for (int g2 = 0; g2 < 16; ++g2) a += sm[g2 * 264 + tid];
        ((float*)(p.ws + WS_KMEAN))[(size_t)unit * 256 + tid] = a * (1.0f / 256.0f); }
    __syncthreads();
}

constexpr int AT_BUF = 65536  , AT_PW = 131072, AT_PW_WAVE = 2304, AT_WSF = 149504, LDS_MTAB = 151552;
__device__ __forceinline__ void att_dma(unsigned char* lds, int buf, const bf16_t* kg, const bf16_t* vg, int key_lo_valid, int tid) {
    const int lane = tid & 63, wave = __builtin_amdgcn_readfirstlane(tid >> 6);
#pragma unroll
    for (int i = 0; i < 4; ++i) { const int j = wave * 4 + i, row = 8 * j + (lane >> 3), pos = lane & 7; const int srow = row < key_lo_valid ? key_lo_valid : row;
        const size_t goff = (size_t)srow * ZW + 8 * (pos ^ (row & 7));
        __builtin_amdgcn_global_load_lds((const unsigned*)(kg + goff), (LAS unsigned*)(LAS unsigned char*)(lds + buf * AT_BUF + j * 1024), 16, 0, 0);
        __builtin_amdgcn_global_load_lds((const unsigned*)(vg + goff), (LAS unsigned*)(LAS unsigned char*)(lds + buf * AT_BUF + 32768 + j * 1024), 16, 0, 0); }
}
template <class Fn>
__device__ __forceinline__ void att_loadq(bf16x8 (&Q)[2][2], const Fn& F, int tid) {
    const int lane = tid & 63, wave = __builtin_amdgcn_readfirstlane(tid >> 6), c16 = lane & 15, g = lane >> 4;
#pragma unroll
    for (int rt = 0; rt < 2; ++rt) { const bf16_t* qp = F.rowptr(32 * wave + 16 * rt + c16); Q[rt][0] = *(const bf16x8*)(qp + 8 * g); Q[rt][1] = *(const bf16x8*)(qp + 32 + 8 * g); }
}
__device__ __forceinline__ bf16x8 tr_frag_sw(const unsigned char* tile, int rowa, int rowb, int col0, int lane) {
    const int i = lane & 15, q = i >> 2, pp = i & 3, ch = (col0 >> 3) + (pp >> 1), sub = (pp & 1) * 8, ra = rowa + q, rb = rowb + q;
    const v4i16_t lo = lds_tr16((const bf16_t*)(tile + ra * 128 + ((ch ^ (ra & 7)) << 4) + sub)), hi = lds_tr16((const bf16_t*)(tile + rb * 128 + ((ch ^ (rb & 7)) << 4) + sub));
    return (bf16x8){lo[0], lo[1], lo[2], lo[3], hi[0], hi[1], hi[2], hi[3]};
}
template <class Fn>
__device__ __forceinline__ void att_compute(unsigned char* lds, int buf, const Fn& F, bf16x8 (&Q)[2][2], const Fn& Fnext, bool has_next, int tid) {
    const int lane = tid & 63, wave = __builtin_amdgcn_readfirstlane(tid >> 6), c16 = lane & 15, g = lane >> 4;
    const unsigned char* KS = lds + buf * AT_BUF; const unsigned char* VS = KS + 32768; bf16_t* PW = (bf16_t*)(lds + AT_PW + wave * AT_PW_WAVE); float* WSF = (float*)(lds + AT_WSF + wave * 256);
#pragma unroll 1
    for (int rt = 0; rt < 2; ++rt) {
        const int rbase = 32 * wave + 16 * rt;
        const typename Fn::Pre pre = F.prefetch(rbase, lane);
        const bf16x8 qa0 = rt ? Q[1][0] : Q[0][0], qa1 = rt ? Q[1][1] : Q[0][1];
        f32x4 S[16]; float m = -1e30f;
#pragma unroll
        for (int ct = 0; ct < 16; ++ct) {
            if (F.live(rbase, ct)) {
                const int R = 16 * ct + c16; const unsigned char* kp = KS + R * 128;
                const bf16x8 k0 = *(const bf16x8*)(kp + ((g ^ (R & 7)) << 4)), k1 = *(const bf16x8*)(kp + (((4 + g) ^ (R & 7)) << 4));
                f32x4 acc = (f32x4){0.f, 0.f, 0.f, 0.f}; acc = MFMA16(k0, qa0, acc); acc = MFMA16(k1, qa1, acc);
                if (Fn::MASKED) {
#pragma unroll
                    for (int r = 0; r < 4; ++r) { int kk = 16 * ct + 4 * g + r; asm volatile("" : "+v"(kk), "+v"(acc[r]));
                        acc[r] += F.pen(rbase + c16, kk); } }
                m = fmaxf(fmaxf(m, fmaxf(acc[0], acc[1])), fmaxf(acc[2], acc[3])); S[ct] = acc;
            } else S[ct] = (f32x4){-1e30f, -1e30f, -1e30f, -1e30f};
        }
        m = fmaxf(m, __shfl_xor(m, 16)); m = fmaxf(m, __shfl_xor(m, 32));
        float l = 0.f;
#pragma unroll
        for (int ct = 0; ct < 16; ++ct) {
            if (F.live(rbase, ct)) {
#pragma unroll
                for (int r = 0; r < 4; ++r) { const float pr = __builtin_amdgcn_exp2f(S[ct][r] - m); S[ct][r] = pr; l += pr; }
            } else S[ct] = (f32x4){0.f, 0.f, 0.f, 0.f};
        }
        l += __shfl_xor(l, 16); l += __shfl_xor(l, 32);
        f32x4 O[4];
#pragma unroll
        for (int dt = 0; dt < 4; ++dt) O[dt] = (f32x4){0.f, 0.f, 0.f, 0.f};
#pragma unroll
        for (int s8 = 0; s8 < 8; ++s8) if (F.live(rbase, 2 * s8) || F.live(rbase, 2 * s8 + 1)) { const bf16x8 pa = pack_p(S[2 * s8], S[2 * s8 + 1]);
#pragma unroll
            for (int dt = 0; dt < 4; ++dt) O[dt] = MFMA16(pa, tr_frag_sw(VS, 32 * s8 + 4 * g, 32 * s8 + 16 + 4 * g, 16 * dt, lane), O[dt]); }
        if (rt == 1 && has_next) att_loadq(Q, Fnext, tid);
        float f[4];
#pragma unroll
        for (int r = 0; r < 4; ++r) { const float mr = __shfl(m, 4 * g + r), lr = __shfl(l, 4 * g + r); f[r] = F.scale(rbase + 4 * g + r, mr, lr, pre, r, WSF + (4 * g + r) * 4, c16 == 0); }
#pragma unroll
        for (int dt = 0; dt < 4; ++dt)
#pragma unroll
            for (int r = 0; r < 4; ++r) PW[(4 * g + r) * 72 + 16 * dt + c16] = (bf16_t)f2bf(O[dt][r] * f[r]);
        LDS_WAIT();
#pragma unroll
        for (int i = 0; i < 2; ++i) { const int ch = lane + 64 * i, row = ch >> 3, oct = ch & 7;
            const u32x4 v = *(const u32x4*)(PW + row * 72 + 8 * oct); F.store(rbase + row, oct, v, pre, i, WSF + row * 4); }
        LDS_WAIT();
    }
}
template <class Fn, class Gen>
__device__ __forceinline__ void attn_loop(unsigned char* lds, const Gen& G, int tid) {
    Fn Fc, Fx; const bf16_t* kg; const bf16_t* vg; int lo;
    bool have = G.get(0, Fc, kg, vg, lo);
    if (!have) return;
    bf16x8 Q[2][2];
    att_dma(lds, 0, kg, vg, lo, tid); att_loadq(Q, Fc, tid);
    int buf = 0;
    for (int i = 1; have; ++i) {
        asm volatile("s_waitcnt vmcnt(0)" ::: "memory");
        __syncthreads();
        const bool hn = G.get(i, Fx, kg, vg, lo);
        if (hn) att_dma(lds, buf ^ 1, kg, vg, lo, tid);
        att_compute(lds, buf, Fc, Q, Fx, hn, tid);
        Fc = Fx; have = hn; buf ^= 1;
    }
    asm volatile("s_waitcnt vmcnt(0)" ::: "memory");
    __syncthreads();
}
struct NoPre {};

struct SwaFn { typedef NoPre Pre; static constexpr bool MASKED = true;
    __device__ __forceinline__ bool live(int rbase, int ct) const { const int i0 = rbase & 127; return 16 * ct + 15 >= i0 + 1 && 16 * ct <= i0 + 143; } const bf16_t* z; bf16_t* ob; size_t tb; int q0, kvh; float sink2_0, sink2_1;
    __device__ __forceinline__ const bf16_t* rowptr(int row) const { return z + (tb + q0 + (row & 127)) * ZW + Z_SQ + (kvh * 2 + (row >> 7)) * 64; }
    __device__ __forceinline__ float pen(int row, int kk) const { const int d = (row & 127) + 128 - kk; return __int_as_float(((d | (127 - d) | (q0 - 128 + kk)) >> 31) & (int)0xF149F2CAu); }
    __device__ __forceinline__ NoPre prefetch(int, int) const { return NoPre{}; }
    __device__ __forceinline__ float scale(int row, float m, float l, const NoPre&, int, float*, bool) const { const float sk = (row >> 7) ? sink2_1 : sink2_0; const float M = fmaxf(m, sk), w0 = __builtin_amdgcn_exp2f(m - M);
        return w0 / (l * w0 + __builtin_amdgcn_exp2f(sk - M)); }
    __device__ __forceinline__ void store(int row, int oct, u32x4 v, const NoPre&, int, const float*) const { *(u32x4*)(ob + (tb + q0 + (row & 127)) * 1024 + 256 + (kvh * 2 + (row >> 7)) * 64 + 8 * oct) = v; }
};
struct SwaGen { const bf16_t* z; bf16_t* ob; const float* sinks; int wg, G;
    __device__ __forceinline__ bool get(int i, SwaFn& F, const bf16_t*& kg, const bf16_t*& vg, int& lo) const {
        const int unit = wg + i * G; if (unit >= 512) return false;
        const int qb = unit & 63, kvh = (unit >> 6) & 1, b = unit >> 7; const size_t tb = (size_t)b * S_; const int q0 = qb * 128;
        F = SwaFn{z, ob, tb, q0, kvh, sinks[kvh * 2] * LOG2E, sinks[kvh * 2 + 1] * LOG2E};
        const long kb = (long)tb + q0 - 128;
        kg = z + kb * ZW + Z_SK + kvh * 64; vg = z + kb * ZW + Z_SV + kvh * 64; lo = (q0 == 0) ? 128 : 0; return true; }
};

constexpr int ML_PER_BH = 126976;
__device__ __forceinline__ int ml_off(int j) { return 256 * (31 * j - (j * (j - 1)) / 2); }
__device__ __forceinline__ void moba_select(KPRef p, int wg, int tid) {
    const int gid = wg * NTHREADS + tid, t = gid >> 2, h = gid & 3, b = t >> 13, tl = t & 8191, blk = tl >> 8;
    const bf16_t* z = (const bf16_t*)(p.ws + WS_Z);
    float q[64];
    { const bf16_t* qp = z + (size_t)t * ZW + Z_MQ + h * 64;
#pragma unroll
      for (int c = 0; c < 8; ++c) { const u32x4 kk = *(const u32x4*)(qp + 8 * c);
        q[8 * c + 0] = __uint_as_float(kk.x << 16); q[8 * c + 1] = __uint_as_float(kk.x & 0xffff0000u); q[8 * c + 2] = __uint_as_float(kk.y << 16); q[8 * c + 3] = __uint_as_float(kk.y & 0xffff0000u);
        q[8 * c + 4] = __uint_as_float(kk.z << 16); q[8 * c + 5] = __uint_as_float(kk.z & 0xffff0000u); q[8 * c + 6] = __uint_as_float(kk.w << 16); q[8 * c + 7] = __uint_as_float(kk.w & 0xffff0000u); } }
    const float* km = (const float*)(p.ws + WS_KMEAN) + (size_t)b * 32 * 256 + h * 64;
    float v0 = -3e38f, v1 = -3e38f, v2 = -3e38f; int i0 = -1, i1 = -1, i2 = -1;
#pragma unroll 1
    for (int nb = 0; nb < blk; ++nb) { const f32x4* kr = (const f32x4*)(km + nb * 256); float s = 0.f;
#pragma unroll
        for (int c = 0; c < 16; ++c) { const f32x4 kv = kr[c]; s += q[4 * c] * kv[0] + q[4 * c + 1] * kv[1] + q[4 * c + 2] * kv[2] + q[4 * c + 3] * kv[3]; }
        if (s > v0) { v2 = v1; i2 = i1; v1 = v0; i1 = i0; v0 = s; i0 = nb; } else if (s > v1) { v2 = v1; i2 = i1; v1 = s; i1 = nb; } else if (s > v2) { v2 = s; i2 = nb; } }
    int* cnt = (int*)(p.ws + WS_MCNT) + (b * 4 + h) * 32; int* lst = (int*)(p.ws + WS_MLIST) + (size_t)(b * 4 + h) * ML_PER_BH; f32x2* pml = (f32x2*)(p.ws + WS_PARTML) + (size_t)gid * 3;
#pragma unroll
    for (int s3 = 0; s3 < 3; ++s3) { const int sb = (s3 == 0) ? i0 : (s3 == 1 ? i1 : i2);
        if (sb >= 0) { const int pos = atomicAdd(cnt + sb, 1); lst[ml_off(sb) + pos] = tl | (s3 << 13); }
        else pml[s3] = (f32x2){-1e30f, 0.f}; }
}
struct MobaSelFn { typedef NoPre Pre; static constexpr bool MASKED = false;
    __device__ __forceinline__ bool live(int, int) const { return true; } const bf16_t* z; const int* lst; bf16_t* po; f32x2* pml; size_t tb; int h, n_valid;
    __device__ __forceinline__ int entry(int row) const { return lst[row < n_valid ? row : 0]; }
    __device__ __forceinline__ const bf16_t* rowptr(int row) const { return z + (tb + (entry(row) & 8191)) * ZW + Z_MQ + h * 64; }
    __device__ __forceinline__ float pen(int, int) const { return 0.f; }
    __device__ __forceinline__ NoPre prefetch(int, int) const { return NoPre{}; }
    __device__ __forceinline__ size_t pidx(int e) const { return ((tb + (e & 8191)) * 4 + h) * 3 + (e >> 13); }
    __device__ __forceinline__ float scale(int row, float m, float l, const NoPre&, int, float*, bool writer) const { if (writer && row < n_valid) pml[pidx(lst[row])] = (f32x2){m, l}; return 1.0f / l; }
    __device__ __forceinline__ void store(int row, int oct, u32x4 v, const NoPre&, int, const float*) const { if (row < n_valid) *(u32x4*)(po + pidx(lst[row]) * 64 + 8 * oct) = v; }
};
__device__ __forceinline__ void moba_sel_table(KPRef p, unsigned char* lds, int tid) {
    int* tab = (int*)(lds + LDS_MTAB); const int lane = tid & 63, wave = tid >> 6;
    const int cnt = ((const int*)(p.ws + WS_MCNT))[tid]; int v = (cnt + 255) >> 8;
    const int own = v;
#pragma unroll
    for (int o = 1; o < 64; o <<= 1) { const int t = __shfl_up(v, o); if (lane >= o) v += t; }
    if (lane == 63) tab[520 + wave] = v;
    __syncthreads();
    int base = 0;
    for (int w = 0; w < wave; ++w) base += tab[520 + w];
    tab[tid] = base + v - own;
    if (tid == 511) tab[512] = base + v;
    __syncthreads();
}
struct MobaSelGen { const bf16_t* z; const int* lists; const int* cnts; bf16_t* po; f32x2* pml; const int* tab; int wg, G;
    __device__ __forceinline__ bool get(int i, MobaSelFn& F, const bf16_t*& kg, const bf16_t*& vg, int& lo) const {
        const int u = wg + i * G; if (u >= tab[512]) return false;
        int lo_ = 0, hi_ = 511;
        while (lo_ < hi_) { const int mid = (lo_ + hi_ + 1) >> 1; if (tab[mid] <= u) lo_ = mid; else hi_ = mid - 1; }
        const int k = __builtin_amdgcn_readfirstlane(lo_), c = u - tab[k], bh = k >> 5, j = k & 31, b = bh >> 2, h = bh & 3;
        const int cnt = __builtin_amdgcn_readfirstlane(cnts[k]); const int nv = cnt - c * 256; const size_t tb = (size_t)b * S_;
        F = MobaSelFn{z, lists + (size_t)bh * ML_PER_BH + ml_off(j) + c * 256, po, pml, tb, h, nv < 256 ? nv : 256};
        kg = z + (tb + j * 256) * ZW + Z_MK + h * 64; vg = z + (tb + j * 256) * ZW + Z_MV + h * 64; lo = 0; return true; }
};
struct MobaOwnFn { typedef NoPre Pre; static constexpr bool MASKED = true;
    __device__ __forceinline__ bool live(int rbase, int ct) const { return 16 * ct <= rbase + 15; } const bf16_t* z; bf16_t* ob; const bf16_t* po; const f32x2* pml; size_t t0; int h;
    __device__ __forceinline__ const bf16_t* rowptr(int row) const { return z + (t0 + row) * ZW + Z_MQ + h * 64; }
    __device__ __forceinline__ float pen(int row, int kk) const { return __int_as_float(((row - kk) >> 31) & (int)0xF149F2CAu); }
    __device__ __forceinline__ NoPre prefetch(int, int) const { return NoPre{}; }
    __device__ __forceinline__ float scale(int row, float m, float l, const NoPre&, int, float* wsf, bool writer) const {
        const f32x2* ml = pml + ((t0 + row) * 4 + h) * 3; const f32x2 a = ml[0], b = ml[1], c = ml[2];
        const float M = fmaxf(fmaxf(m, a[0]), fmaxf(b[0], c[0]));
        const float w0 = __builtin_amdgcn_exp2f(m - M), wa = a[1] * __builtin_amdgcn_exp2f(a[0] - M), wb = b[1] * __builtin_amdgcn_exp2f(b[0] - M), wc = c[1] * __builtin_amdgcn_exp2f(c[0] - M);
        const float inv = 1.0f / (l * w0 + wa + wb + wc);
        if (writer) { wsf[0] = wa * inv; wsf[1] = wb * inv; wsf[2] = wc * inv; }
        return w0 * inv; }
    __device__ __forceinline__ void store(int row, int oct, u32x4 v, const NoPre&, int, const float* wsf) const {
        float o[8]; unpack8f(o, v); const bf16_t* pr = po + (((t0 + row) * 4 + h) * 3) * 64 + 8 * oct;
        u32x4 pc[3];
#pragma unroll
        for (int s = 0; s < 3; ++s) pc[s] = (wsf[s] != 0.f) ? *(const u32x4*)(pr + s * 64) : (u32x4){0u, 0u, 0u, 0u};
#pragma unroll
        for (int s = 0; s < 3; ++s) { const float w = wsf[s]; float q[8]; unpack8f(q, pc[s]);
#pragma unroll
            for (int e = 0; e < 8; ++e) o[e] += w * q[e]; }
        *(u32x4*)(ob + (t0 + row) * 1024 + 512 + h * 64 + 8 * oct) = pack8f(o); }
};
struct MobaOwnGen { const bf16_t* z; bf16_t* ob; const bf16_t* po; const f32x2* pml; int wg, G;
    __device__ __forceinline__ bool get(int i, MobaOwnFn& F, const bf16_t*& kg, const bf16_t*& vg, int& lo) const {
        const int unit = wg + i * G; if (unit >= 512) return false;
        const int qb = unit & 31, h = (unit >> 5) & 3, b = unit >> 7; const size_t t0 = (size_t)b * S_ + (size_t)qb * 256;
        F = MobaOwnFn{z, ob, po, pml, t0, h}; kg = z + t0 * ZW + Z_MK + h * 64; vg = z + t0 * ZW + Z_MV + h * 64; lo = 0; return true; }
};

__device__ __forceinline__ void route_phase(KPRef p, int l, float* sm, int wg, int tid) {
    int* se = (int*)sm;
    int* toke = (int*)(p.ws + WS_TOKE); float* tokw = (float*)(p.ws + WS_TOKW); int* tokr = (int*)(p.ws + WS_TOKR); int* hist = (int*)(p.ws + WS_HIST); int* sdst = (int*)(p.ws + WS_SDST);
    if (tid < 128) { const int t = wg * 128 + tid; const float* lg = (const float*)(p.ws + WS_LOGIT) + (size_t)t * 64; const float* bg = p.in[12] + l * 4; const float* be = p.in[14] + l * 32;
        float g0 = lg[0] + bg[0], g1 = lg[1] + bg[1], g2 = lg[2] + bg[2], g3 = lg[3] + bg[3];
        int gs = 0; float gm = g0; if (g1 > gm) { gm = g1; gs = 1; } if (g2 > gm) { gm = g2; gs = 2; } if (g3 > gm) { gm = g3; gs = 3; }
        const float gw_ = 1.0f / (expf(g0 - gm) + expf(g1 - gm) + expf(g2 - gm) + expf(g3 - gm));
        float v0 = -3e38f, v1 = -3e38f; int i0 = 0, i1 = 0;
#pragma unroll
        for (int j = 0; j < 8; ++j) { const float s = lg[4 + 8 * gs + j] + be[8 * gs + j]; if (s > v0) { v1 = v0; i1 = i0; v0 = s; i0 = j; } else if (s > v1) { v1 = s; i1 = j; } }
        const float e1 = expf(v1 - v0), w0 = 1.0f / (1.0f + e1), w1 = e1 * w0;
        const int ea = 8 * gs + i0, eb = 8 * gs + i1;
        se[2 * tid] = ea; se[2 * tid + 1] = eb; toke[2 * t] = ea; toke[2 * t + 1] = eb; tokw[2 * t] = w0 * gw_; tokw[2 * t + 1] = w1 * gw_; }
    __syncthreads();
    if (tid < 256) { const int e = se[tid]; int r = 0;
#pragma unroll 4
        for (int a = 0; a < tid; ++a) r += (se[a] == e) ? 1 : 0; tokr[wg * 256 + tid] = r; }
    if (tid >= 256 && tid < 288) { const int e = tid - 256; int c = 0;
#pragma unroll 4
        for (int a = 0; a < 256; ++a) c += (se[a] == e) ? 1 : 0; hist[wg * 32 + e] = c; }
    for (int i = tid; i < NSLOTBLK; i += NTHREADS) sdst[wg * NSLOTBLK + i] = YS_TRASH_ROW;
    __syncthreads();
}
__device__ __forceinline__ void assign_phase(KPRef p, float* sm, int wg, int tid, int wave, int lane) {
    int* cnt = (int*)sm, *bas = cnt + 32, *pend = cnt + 64, *slot_of = cnt + 128;
    const int* hist = (const int*)(p.ws + WS_HIST); const int* toke = (const int*)(p.ws + WS_TOKE); const int* tokr = (const int*)(p.ws + WS_TOKR);
    int* sdst = (int*)(p.ws + WS_SDST); int* blke = (int*)(p.ws + WS_BLKE);
    if (tid < 32) { int c = 0, bb = 0;
#pragma unroll 8
        for (int w = 0; w < 256; ++w) { const int v = hist[w * 32 + tid]; c += v; if (w < wg) bb += v; } cnt[tid] = c; bas[tid] = bb; }
    __syncthreads();
    if (tid == 0) { int run = 0; for (int e = 0; e < 32; ++e) { const int pad = ((cnt[e] + 255) >> 8) << 8; bas[e] += run; run += pad; pend[e] = run; } }
    __syncthreads();
    if (wg == 0) { if (tid < NSLOTBLK) { int e = 0; for (int k = 0; k < 32; ++k) e += (pend[k] <= tid * 256) ? 1 : 0; blke[tid] = e > 31 ? 31 : e; } if (tid == 0) blke[511] = pend[31] >> 8; }
    if (tid < 256) { const int a = wg * 256 + tid; const int e = toke[a]; const int slot = bas[e] + tokr[a]; sdst[slot] = a; slot_of[tid] = slot; }
    __syncthreads();
    const float* su = (const float*)(p.ws + WS_SU); float* xss = (float*)(p.ws + WS_XSS);
    if (tid < 256) xss[slot_of[tid]] = su[wg * 128 + (tid >> 1)];
    __syncthreads();
}

#ifndef MK_PER_PHASE
#define MK_PER_PHASE 0
#endif
constexpr int PH_PER_LAYER = 18, N_PHASES = DEPTH_ * PH_PER_LAYER + 1;
constexpr int CW_BAR = 1024;

__global__ void __launch_bounds__(NTHREADS, 2) mega(Params p_unused) {
    extern __shared__ __attribute__((aligned(16))) unsigned char lds[];
    const int tid0 = threadIdx.x;
    constexpr int G = 256, NGW = G * NWAVES;
    const int wg = blockIdx.x;
#define SUB_BEGIN() KPRef p = *KP(); unsigned char* ws = p.ws; (void)ws; int tid = threadIdx.x; asm volatile("" : "+v"(tid))
#define PHASE_BEGIN() KPRef p = *KP(); unsigned char* ws = p.ws; (void)ws; int tid = threadIdx.x; asm volatile("" : "+v"(tid)); const int lane = tid & 63, wave = __builtin_amdgcn_readfirstlane(tid >> 6), gw = wg * NWAVES + wave; (void)lane; (void)gw
    volatile LAS unsigned* MISC = (volatile LAS unsigned*)((LAS unsigned char*)lds + MISC_OFF);
    for (int u = tid0; u < (LDS_BYTES - LDSCTL_OFF) / 4; u += NTHREADS) ((LAS unsigned*)((LAS unsigned char*)lds + LDSCTL_OFF))[u] = 0u;
    __syncthreads();
#define KP() ({ const __attribute__((address_space(4))) Params* _k = (const __attribute__((address_space(4))) Params*)__builtin_amdgcn_kernarg_segment_ptr(); asm volatile("" : "+s"(_k)); _k; })
    unsigned* ctl; { const __attribute__((address_space(4))) Params* k0 = KP(); ctl = (unsigned*)(k0->ws + WS_CTL); }
    XcdBarrier bar = xcd_barrier_post(ctl + CW_BAR, MISC + 8);
    int lo, hi; { const __attribute__((address_space(4))) Params* k0 = KP(); lo = k0->ph_lo; hi = k0->ph_hi; }
    float* sm = (float*)lds;
    PG8_LAS unsigned char* ring = (PG8_LAS unsigned char*)lds;
#ifndef PH_MASK
#define PH_MASK 0x7ffffu
#endif
#define IN(k) ((((PH_MASK) >> ((k) == DEPTH_ * PH_PER_LAYER ? 18 : ((k) % PH_PER_LAYER))) & 1u) && lo <= (k) && (k) < hi)
#define SEAM(k) do { if ((k) + 1 < hi) xcd_barrier(bar); } while (0)
#ifndef REPEAT_MASK
#define REPEAT_MASK 0u
#endif
#ifndef URM
#define URM 0u
#endif
#define UREP(bit) for (int ur_ = 0; ur_ < ((((URM) >> (bit)) & 1u) ? 2 : 1); ++ur_)
#ifndef REPEAT_L0
#define REPEAT_L0 0u
#endif
#define NREP(k) (((((REPEAT_MASK) >> ((k) % PH_PER_LAYER)) & 1u) || ((((REPEAT_L0) >> ((k) % PH_PER_LAYER)) & 1u) && (k) < PH_PER_LAYER)) ? 2 : 1)

    for (int l = 0; l < DEPTH_; ++l) {
        const int P0 = l * PH_PER_LAYER;
        if (IN(P0 + 0)) for (int rep_ = 0; rep_ < NREP(P0 + 0); ++rep_) { PHASE_BEGIN();
            UREP(8) conv8_pass<0>(p, l, lds, gw, NGW, wave, lane);
            if (l == 0) norm_phase<0>(p, l, gw, NGW, lane); else norm_phase<1>(p, l, gw, NGW, lane);
            SEAM(P0 + 0);
        }
        if (IN(P0 + 1)) for (int rep_ = 0; rep_ < NREP(P0 + 1); ++rep_) { PHASE_BEGIN();
            conv8_pass<1>(p, l, lds, gw, NGW, wave, lane);
            conv_phase(p, l, lds, gw, NGW, wave, lane);
            SEAM(P0 + 1);
        }
        if (IN(P0 + 2)) for (int rep_ = 0; rep_ < NREP(P0 + 2); ++rep_) { PHASE_BEGIN();
            pg8::Gemm g{(const bf16_t*)(ws + WS_U8), (const bf16_t*)(ws + WS_WIN)};
            pg8::StaticOrder<T_ / 256, ZW / 256, 1024, 1024> S{G, wg, 0};
            pg8::EpiBf16S E{(bf16_t*)(ws + WS_Z), ZW, (const float*)(ws + WS_SU), (const float*)(ws + WS_SWIN)};
            pg8::gemm_phase<1024, 1024, 1024, true>(ring, g, S, E);
            SEAM(P0 + 2);
        }
        if (IN(P0 + 3)) for (int rep_ = 0; rep_ < NREP(P0 + 3); ++rep_) { PHASE_BEGIN();
            if (wg == 0) { int* cnt = (int*)(ws + WS_MCNT); cnt[tid] = 0; }
            UREP(0) { SUB_BEGIN(); la_loop<0>(p, l, lds, wg, tid); }
            UREP(1) { SUB_BEGIN(); la_loop<1>(p, l, lds, wg, tid); }
            UREP(2) { SUB_BEGIN(); for (int u = wg; u < 128; u += G) kmean_unit(p, sm, u, tid); }
            UREP(3) { SUB_BEGIN(); SwaGen SG{(const bf16_t*)(ws + WS_Z), (bf16_t*)(ws + WS_O), p.in[6] + l * 4, wg, G}; attn_loop<SwaFn>(lds, SG, tid); }
            SEAM(P0 + 3);
        }
        if (IN(P0 + 4)) for (int rep_ = 0; rep_ < NREP(P0 + 4); ++rep_) { PHASE_BEGIN(); moba_select(p, wg, tid); scan_phase(p, wg, tid); SEAM(P0 + 4); }
        if (IN(P0 + 5)) for (int rep_ = 0; rep_ < NREP(P0 + 5); ++rep_) { PHASE_BEGIN();
            UREP(4) { SUB_BEGIN(); la_loop<2>(p, l, lds, wg, tid); }
            UREP(5) { SUB_BEGIN(); la_loop<3>(p, l, lds, wg, tid); }
            UREP(6) { SUB_BEGIN(); moba_sel_table(p, lds, tid); MobaSelGen MG{(const bf16_t*)(ws + WS_Z), (const int*)(ws + WS_MLIST), (const int*)(ws + WS_MCNT), (bf16_t*)(ws + WS_PARTO), (f32x2*)(ws + WS_PARTML), (const int*)(lds + LDS_MTAB), wg, G}; attn_loop<MobaSelFn>(lds, MG, tid); }
            SEAM(P0 + 5);
        }
        if (IN(P0 + 6)) for (int rep_ = 0; rep_ < NREP(P0 + 6); ++rep_) { PHASE_BEGIN();
            UREP(7) { SUB_BEGIN(); MobaOwnGen OG{(const bf16_t*)(ws + WS_Z), (bf16_t*)(ws + WS_O), (const bf16_t*)(ws + WS_PARTO), (const f32x2*)(ws + WS_PARTML), wg, G}; attn_loop<MobaOwnFn>(lds, OG, tid); }
            SEAM(P0 + 6);
        }
        for (int hf = 0; hf < 2; ++hf) {
            if (IN(P0 + 7 + 2 * hf)) for (int rep_ = 0; rep_ < NREP(P0 + 7 + 2 * hf); ++rep_) { PHASE_BEGIN();
                pg8::Gemm g{(const bf16_t*)(ws + WS_O), (const bf16_t*)(ws + WS_WB)};
                pg8::StaticOrder<T_ / 512, 16, 2048, 512, 2, 512> S{G, wg, 64 * hf};
                pg8::EpiBf16 E{(bf16_t*)(ws + WS_YH), 4096, 16384 * hf};
                pg8::gemm_phase<2048, 512, 512, false>(ring, g, S, E);
                SEAM(P0 + 7 + 2 * hf);
            }
            if (IN(P0 + 8 + 2 * hf)) for (int rep_ = 0; rep_ < NREP(P0 + 8 + 2 * hf); ++rep_) { PHASE_BEGIN();
                pg8::Gemm g{(const bf16_t*)(ws + WS_U8), (const bf16_t*)(ws + WS_WG)};
                pg8::StaticOrder<T_ / 512, 16, 1024, 1024> S{G, wg, 64 * hf};
                pg8::EpiGate E{(const bf16_t*)(ws + WS_YH), 16384 * hf, (bf16_t*)(ws + WS_O), (const float*)(ws + WS_SU), (const float*)(ws + WS_SWG)};
                pg8::gemm_phase<1024, 1024, 1024, true>(ring, g, S, E);
                SEAM(P0 + 8 + 2 * hf);
            }
        }
        if (IN(P0 + 11)) for (int rep_ = 0; rep_ < NREP(P0 + 11); ++rep_) { PHASE_BEGIN();
            pg8::Gemm g{(const bf16_t*)(ws + WS_O), (const bf16_t*)(ws + WS_WO)};
            pg8::StaticOrder<T_ / 256, 4, 2048, 2048> S{G, wg, 0};
            if (l == 0) { pg8::EpiRes<true> E{(const void*)p.in[0], hbf_ptr(p)}; pg8::gemm_phase<2048, 2048, 2048, false>(ring, g, S, E); }
            else { pg8::EpiRes<false> E{(const void*)hbf_ptr(p), hbf_ptr(p)}; pg8::gemm_phase<2048, 2048, 2048, false>(ring, g, S, E); }
            SEAM(P0 + 11);
        }
        if (IN(P0 + 12)) for (int rep_ = 0; rep_ < NREP(P0 + 12); ++rep_) { PHASE_BEGIN(); norm_phase<2>(p, l, gw, NGW, lane); SEAM(P0 + 12); }
        if (IN(P0 + 13)) for (int rep_ = 0; rep_ < NREP(P0 + 13); ++rep_) { PHASE_BEGIN();
            pg8::Gemm g{(const bf16_t*)(ws + WS_U2BF), (const bf16_t*)(ws + WS_WR)};
            pg8::StaticOrder<T_ / 256, 1, 2048, 2048> S{G, wg, 0};
            pg8::EpiRouter E{(float*)(ws + WS_LOGIT)};
            pg8::gemm_phase<2048, 2048, 2048, false>(ring, g, S, E);
            SEAM(P0 + 13);
        }
        if (IN(P0 + 14)) for (int rep_ = 0; rep_ < NREP(P0 + 14); ++rep_) { PHASE_BEGIN(); route_phase(p, l, sm, wg, tid); SEAM(P0 + 14); }
        if (IN(P0 + 15)) for (int rep_ = 0; rep_ < NREP(P0 + 15); ++rep_) { PHASE_BEGIN(); assign_phase(p, sm, wg, tid, wave, lane); SEAM(P0 + 15); }
        if (IN(P0 + 16)) for (int rep_ = 0; rep_ < NREP(P0 + 16); ++rep_) { PHASE_BEGIN();
            const int* blke = (const int*)(ws + WS_BLKE); const int nb = __builtin_amdgcn_readfirstlane(blke[511]);
            pg8::Gemm g{(const bf16_t*)(ws + WS_U8), (const bf16_t*)(ws + WS_E1)};
            pg8::MoeOrder<2, true> S{blke, nb, G, wg, (size_t)0, (size_t)256 * 1024, (size_t)512 * 1024, (const int*)(ws + WS_SDST)};
            pg8::EpiE1 E{(bf16_t*)(ws + WS_HDN), (const float*)(ws + WS_XSS), (const float*)(ws + WS_SWE1), blke};
            pg8::gemm_phase<1024, 1024, 1024, true>(ring, g, S, E);
            SEAM(P0 + 16);
        }
        if (IN(P0 + 17)) for (int rep_ = 0; rep_ < NREP(P0 + 17); ++rep_) { PHASE_BEGIN();
            const int* blke = (const int*)(ws + WS_BLKE); const int nb = __builtin_amdgcn_readfirstlane(blke[511]);
            pg8::Gemm g{(const bf16_t*)(ws + WS_HDN), (const bf16_t*)(ws + WS_E2)};
            pg8::MoeOrder<4> S{blke, nb, G, wg, (size_t)256 * 256 * 2, (size_t)256 * 256 * 2, (size_t)1024 * 256 * 2, nullptr};
            { unsigned* raw = (unsigned*)(ws + WS_SWRAW); for (int i = wg * NTHREADS + tid; i < 3072 + 4096 + 32 * 512; i += G * NTHREADS) raw[i] = 0u; }
            pg8::EpiE2 E{(bf16_t*)(ws + WS_YS), (const int*)(ws + WS_SDST)};
            pg8::gemm_phase<512, 512, 512, false>(ring, g, S, E);
            SEAM(P0 + 17);
        }
    }
    if (IN(DEPTH_ * PH_PER_LAYER)) { PHASE_BEGIN(); FinalHold Hd; final_a(p, gw, NGW, lane, Hd); xcd_barrier(bar); final_b(p, gw, lane, Hd); }
#undef IN
#undef SEAM
}

extern "C" void kernel_launch(void* const* d_in, const int* in_sizes, int n_in, void* d_out, int out_size, void* d_ws, size_t ws_size, hipStream_t stream) {
    static int grid = 0;
    if (grid == 0) {
        if (n_in != 19 || out_size != T_ * D_ || ws_size < WS_END) { fprintf(stderr, "kernel_launch: unexpected shapes (n_in %d, out %d, ws %zu); nothing launched\n", n_in, out_size, ws_size); grid = -1; return; }
        int dev = 0, cus = 0;
        if (hipGetDevice(&dev) != hipSuccess || hipDeviceGetAttribute(&cus, hipDeviceAttributeMultiprocessorCount, dev) != hipSuccess) { grid = -1; return; }
        if (hipFuncSetAttribute((const void*)mega, hipFuncAttributeMaxDynamicSharedMemorySize, LDS_BYTES) != hipSuccess) { fprintf(stderr, "kernel_launch: hipFuncSetAttribute failed\n"); grid = -1; return; }
        int per_cu = 0;
        if (hipOccupancyMaxActiveBlocksPerMultiprocessor(&per_cu, (const void*)mega, NTHREADS, LDS_BYTES) != hipSuccess || per_cu < 1) { fprintf(stderr, "kernel_launch: occupancy query reports %d blocks per CU\n", per_cu); }
        (void)hipGetLastError();
        if (cus != 256) { fprintf(stderr, "kernel_launch: built for a 256-CU device (got %d); nothing launched\n", cus); grid = -1; return; }
        grid = cus;
    }
    if (grid <= 0) return;
    Params p{};
    for (int i = 0; i < 19; ++i) p.in[i] = (const float*)d_in[i];
    p.out = (float*)d_out; p.ws = (unsigned char*)d_ws;
    for (int f = 0; f < 16; ++f) p.inv_freq[f] = (float)std::pow(10000.0, -(double)f / 16.0);
    for (int h = 0; h < 4; ++h) p.ret_lg2[h] = (float)std::log2(1.0 - std::exp2(-5.0 - (double)h));
    hipMemsetAsync((unsigned char*)d_ws + WS_CTL, 0, CTL_BYTES, stream);
#if MK_PER_PHASE
    for (int ph = 0; ph < N_PHASES; ++ph) { p.ph_lo = ph; p.ph_hi = ph + 1; hipLaunchKernelGGL(mega, dim3(grid), dim3(NTHREADS), LDS_BYTES, stream, p); }
#else
    p.ph_lo = 0; p.ph_hi = N_PHASES;
    hipLaunchKernelGGL(mega, dim3(grid), dim3(NTHREADS), LDS_BYTES, stream, p);
#endif
}
```

```cpp
#include <hip/hip_runtime.h>
#include <cstdio>
#include <cstdint>
#include <cmath>

#define LAS __attribute__((address_space(3)))
#define GAS __attribute__((address_space(1)))
typedef unsigned short bf16_t;
typedef short bf16x8 __attribute__((ext_vector_type(8)));
typedef float f32x4 __attribute__((ext_vector_type(4)));
typedef float f32x2 __attribute__((ext_vector_type(2)));
typedef unsigned u32x4 __attribute__((ext_vector_type(4)));
typedef unsigned u32x2 __attribute__((ext_vector_type(2)));
typedef int i32x4 __attribute__((ext_vector_type(4)));
__device__ __forceinline__ f32x4 tof(const f32x4& v) { return v; }
__device__ __forceinline__ f32x4 tof(const i32x4& v) { return __builtin_convertvector(v, f32x4); }

constexpr int T_ = 32768, D_ = 1024, S_ = 8192, NBATCH = 4, DEPTH_ = 2;
constexpr int ZW = 3072;
constexpr int Z_GQ = 0, Z_GK = 128, Z_GV = 256, Z_GR = 512, Z_GA = 768, Z_SQ = 784, Z_SK = 1040, Z_SV = 1168, Z_MQ = 1296, Z_MK = 1552, Z_MV = 1808,
              Z_RQ = 2064, Z_RK = 2192, Z_RV = 2320, Z_RG = 2576, Z_GATE = 2832, IN_W = 6928;
constexpr float LOG2E = 1.4426950408889634f;
constexpr float C2 = 0.125f * 1.4426950408889634f;
constexpr float RSQ32 = 0.17677669529663687f;
constexpr float NORM_EPS = 1e-6f;
constexpr int NEXP = 32, EHID = 256, MOE_BLK = 256, NSLOTBLK = 288, NSLOT = NSLOTBLK * MOE_BLK;

constexpr size_t MiB = 1u << 20;
constexpr size_t WS_WIN = 0, WS_WG = 3 * MiB, WS_WB = 7 * MiB, WS_WO = 9 * MiB, WS_WR = 11 * MiB, WS_E1 = 12 * MiB, WS_E2 = 28 * MiB;
constexpr size_t WS_YS = 68 * MiB;
constexpr size_t WS_GKV = 68 * MiB, WS_RKV = 84 * MiB, WS_GDEC = 92 * MiB, WS_KMEAN = 93 * MiB, WS_O = 108 * MiB;
constexpr size_t WS_U8 = 197 * MiB;
constexpr size_t WS_SU = 229 * MiB, WS_XSS = WS_SU + 256 * 1024;
constexpr size_t WS_SWIN = 230 * MiB, WS_SWG = WS_SWIN + 16 * 1024, WS_SWE1 = WS_SWG + 16 * 1024;
constexpr size_t WS_Z = 261 * MiB;
constexpr size_t WS_YH = 261 * MiB;
constexpr size_t WS_U2BF = 261 * MiB;
constexpr size_t WS_XS = 325 * MiB, WS_HDN = 397 * MiB;
constexpr size_t WS_LOGIT = 453 * MiB;
constexpr size_t WS_TOKE = 461 * MiB, WS_TOKW = WS_TOKE + 256 * 1024, WS_TOKR = WS_TOKW + 256 * 1024, WS_HIST = WS_TOKR + 256 * 1024,
                 WS_SDST = WS_HIST + 64 * 1024, WS_BLKE = WS_SDST + 512 * 1024;
constexpr size_t WS_MLIST = 94 * MiB, WS_MCNT = 102 * MiB;
constexpr size_t WS_PARTO = 453 * MiB, WS_PARTML = 501 * MiB;
constexpr size_t WS_CTL = 511 * MiB, CTL_BYTES = 256 * 1024;
constexpr size_t WS_SWRAW = WS_CTL + 64 * 1024, SWRAW_LSTEP = 96 * 1024;
constexpr size_t SW_LSTEP = 128 * 1024;
constexpr size_t WS_END = 512 * MiB;
constexpr int YS_TRASH_ROW = 2 * T_;

__device__ __forceinline__ float bf2f(bf16_t v) { return __uint_as_float(((unsigned)v) << 16); }
__device__ __forceinline__ unsigned f2bf(float f) { unsigned u = __float_as_uint(f); return (u + 0x7fffu + ((u >> 16) & 1u)) >> 16; }
__device__ __forceinline__ unsigned pk2(float lo, float hi) { return f2bf(lo) | (f2bf(hi) << 16); }
__device__ __forceinline__ float sigmoidf_(float x) { return __builtin_amdgcn_rcpf(1.0f + __builtin_amdgcn_exp2f(-x * LOG2E)); }

namespace pg8 {
#define PG8_LAS __attribute__((address_space(3)))
constexpr int BM = 256, BK = 64, HALF = 128, HTB = HALF * BK * 2  , STAGE_BYTES = 8 * HTB, NXCD = 8, WGM = 8;

__host__ __device__ __forceinline__ int lds_byte(int r, int c) { const int st = (r >> 4) * 2 + (c >> 5), rr = r & 15, cc = c & 31, ob = rr * 64 + cc * 2; return st * 1024 + (ob ^ (((ob >> 9) & 1) << 5)); }
__host__ __device__ __forceinline__ void stage_rc(int b, int& R, int& C) { const int st = b / 1024, sb = b % 1024, swz = sb ^ (((sb >> 9) & 1) << 5); R = (st >> 1) * 16 + swz / 64; C = (st & 1) * 32 + (swz % 64) / 2; }
__host__ __device__ __forceinline__ int perm32(int rho) { const int n = rho >> 4, i = rho & 15; return 8 * (i >> 2) + 4 * n + (i & 3); }

struct Unit { int pm, pn; size_t aoff, boff; };
struct Gemm { const bf16_t* A; const bf16_t* Bt; };

template <int NM, int NN, int LDAB  , int LDBB, int A_SHIFT = 30, int A_MUL = 0> struct StaticOrder {
    static constexpr bool GATHER = false;
    int G, c, pm_base;
    __device__ bool next(int i, Unit& u) const {
        constexpr int nwg = NM * NN; const int L = i * G + c; if (L >= nwg) return false;
        int wgid = L; { constexpr int q = nwg / NXCD, r = nwg % NXCD; const int xcd = wgid % NXCD, off = wgid / NXCD; wgid = (xcd < r ? xcd * (q + 1) : r * (q + 1) + (xcd - r) * q) + off; }
        static_assert(NM % WGM == 0, "row-tile count must be a multiple of the 8-row group"); constexpr int nig = WGM * NN, gsz = WGM; const int gid = wgid / nig, fm = gid * WGM;
        u.pm = pm_base + fm + ((wgid % nig) % gsz); u.pn = (wgid % nig) / gsz;
        u.aoff = (size_t)u.pm * ((size_t)BM * LDAB) + (size_t)(u.pn >> A_SHIFT) * A_MUL; u.boff = (size_t)u.pn * ((size_t)BM * LDBB); return true;
    }
};
template <int NCOL, bool GATHER_ = false> struct MoeOrder {
    static constexpr bool GATHER = GATHER_;
    const int* blk_e; int nb, G, c; size_t a_tstep, b_tstep, b_estep; const int* rowmap;
    __device__ bool next(int i, Unit& u) const {
        const int L = i * G + c; if (L >= nb * NCOL) return false;
        const int rb = L / NCOL, pn = L % NCOL; const int e = __builtin_amdgcn_readfirstlane(blk_e[rb]);
        u.pm = rb; u.pn = pn; u.aoff = (size_t)rb * a_tstep; u.boff = (size_t)e * b_estep + (size_t)pn * b_tstep; return true;
    }
};

__device__ __forceinline__ unsigned cvt_pk_bf16(float lo, float hi) { unsigned r; asm volatile("v_cvt_pk_bf16_f32 %0, %1, %2" : "=v"(r) : "v"(lo), "v"(hi)); return r; }

struct EpiBf16 {
    static constexpr bool PERM = true;
    bf16_t* O; int ldc; int row_sub;
    template <class AT> __device__ __forceinline__ void operator()(const AT (&acc)[2][2][4][2], const Unit& u, int wr, int wc, int fr, int fq) const {
        const int row0 = u.pm * BM + wr * 64 + fr - row_sub; const int col0 = u.pn * BM + wc * 32 + 8 * fq;
#pragma unroll
        for (int ai = 0; ai < 2; ++ai)
#pragma unroll
            for (int m = 0; m < 4; ++m) { bf16_t* rowp = O + (size_t)(row0 + ai * HALF + m * 16) * ldc + col0;
#pragma unroll
                for (int bj = 0; bj < 2; ++bj) { const f32x4 v0 = tof(acc[ai][bj][m][0]), v1 = tof(acc[ai][bj][m][1]);
                    u32x4 w; w.x = cvt_pk_bf16(v0[0], v0[1]); w.y = cvt_pk_bf16(v0[2], v0[3]); w.z = cvt_pk_bf16(v1[0], v1[1]); w.w = cvt_pk_bf16(v1[2], v1[3]);
                    *(u32x4*)(rowp + bj * HALF) = w; } }
    }
};
struct EpiBf16S {
    static constexpr bool PERM = true;
    bf16_t* O; int ldc; const float* srow; const float* scol;
    template <class AT> __device__ __forceinline__ void operator()(const AT (&acc)[2][2][4][2], const Unit& u, int wr, int wc, int fr, int fq) const {
        const int row0 = u.pm * BM + wr * 64 + fr; const int col0 = u.pn * BM + wc * 32 + 8 * fq;
        f32x4 sc[2][2];
#pragma unroll
        for (int bj = 0; bj < 2; ++bj)
#pragma unroll
            for (int n = 0; n < 2; ++n) sc[bj][n] = *(const f32x4*)(scol + col0 + bj * HALF + 4 * n);
#pragma unroll
        for (int ai = 0; ai < 2; ++ai)
#pragma unroll
            for (int m = 0; m < 4; ++m) { const int r = row0 + ai * HALF + m * 16; const float sr = srow[r]; bf16_t* rowp = O + (size_t)r * ldc + col0;
#pragma unroll
                for (int bj = 0; bj < 2; ++bj) { const f32x4 v0 = tof(acc[ai][bj][m][0]) * sc[bj][0] * sr, v1 = tof(acc[ai][bj][m][1]) * sc[bj][1] * sr;
                    u32x4 w; w.x = cvt_pk_bf16(v0[0], v0[1]); w.y = cvt_pk_bf16(v0[2], v0[3]); w.z = cvt_pk_bf16(v1[0], v1[1]); w.w = cvt_pk_bf16(v1[2], v1[3]);
                    *(u32x4*)(rowp + bj * HALF) = w; } }
    }
};
template <bool BASE_F32> struct EpiRes {
    static constexpr bool PERM = true;
    const void* base; bf16_t* H;
    template <class AT> __device__ __forceinline__ void operator()(const AT (&acc)[2][2][4][2], const Unit& u, int wr, int wc, int fr, int fq) const {
        const int row0 = u.pm * BM + wr * 64 + fr, col0 = u.pn * BM + wc * 32 + 8 * fq;
#pragma unroll
        for (int ai = 0; ai < 2; ++ai) {
            f32x4 b[4][2][2];
#pragma unroll
            for (int m = 0; m < 4; ++m) { const size_t off = (size_t)(row0 + ai * HALF + m * 16) * 1024 + col0;
#pragma unroll
                for (int bj = 0; bj < 2; ++bj) {
                    if (BASE_F32) { b[m][bj][0] = *(const f32x4*)((const float*)base + off + bj * HALF); b[m][bj][1] = *(const f32x4*)((const float*)base + off + bj * HALF + 4); }
                    else { const u32x4 q = *(const u32x4*)((const bf16_t*)base + off + bj * HALF);
                        b[m][bj][0] = (f32x4){__uint_as_float(q.x << 16), __uint_as_float(q.x & 0xffff0000u), __uint_as_float(q.y << 16), __uint_as_float(q.y & 0xffff0000u)};
                        b[m][bj][1] = (f32x4){__uint_as_float(q.z << 16), __uint_as_float(q.z & 0xffff0000u), __uint_as_float(q.w << 16), __uint_as_float(q.w & 0xffff0000u)}; } } }
#pragma unroll
            for (int m = 0; m < 4; ++m) { const size_t off = (size_t)(row0 + ai * HALF + m * 16) * 1024 + col0;
#pragma unroll
                for (int bj = 0; bj < 2; ++bj) { const f32x4 v0 = b[m][bj][0] + tof(acc[ai][bj][m][0]), v1 = b[m][bj][1] + tof(acc[ai][bj][m][1]);
                    u32x4 w; w.x = cvt_pk_bf16(v0[0], v0[1]); w.y = cvt_pk_bf16(v0[2], v0[3]); w.z = cvt_pk_bf16(v1[0], v1[1]); w.w = cvt_pk_bf16(v1[2], v1[3]);
                    *(u32x4*)(H + off + bj * HALF) = w; } }
            asm volatile("" ::: "memory"); }
    }
};
struct EpiRouter {
    static constexpr bool PERM = false;
    float* L;
    template <class AT> __device__ __forceinline__ void operator()(const AT (&acc)[2][2][4][2], const Unit& u, int wr, int wc, int fr, int fq) const {
        if (wc >= 2) return;
        const int row0 = u.pm * BM + wr * 64 + fr, col0 = wc * 32 + 4 * fq;
#pragma unroll
        for (int ai = 0; ai < 2; ++ai)
#pragma unroll
            for (int m = 0; m < 4; ++m) { float* rowp = L + (size_t)(row0 + ai * HALF + m * 16) * 64 + col0;
#pragma unroll
                for (int n = 0; n < 2; ++n) *(f32x4*)(rowp + n * 16) = tof(acc[ai][0][m][n]); }
    }
};
struct EpiGate {
    static constexpr bool PERM = false;
    const bf16_t* Y; int y_row_sub; bf16_t* Mg; const float* srow; const float* scol;
    template <class AT> __device__ __forceinline__ void operator()(const AT (&acc)[2][2][4][2], const Unit& u, int wr, int wc, int fr, int fq) const {
        const int row0 = u.pm * BM + wr * 64 + fr, d0 = u.pn * 64 + wc * 16 + fq * 4;
        f32x4 sc[4];
#pragma unroll
        for (int i = 0; i < 4; ++i) sc[i] = *(const f32x4*)(scol + u.pn * BM + (i >> 1) * HALF + wc * 32 + (i & 1) * 16 + 4 * fq) * (-LOG2E);
#pragma unroll
        for (int ai = 0; ai < 2; ++ai) { u32x2 yv[4][4];
#pragma unroll
            for (int m = 0; m < 4; ++m) { const bf16_t* yrow = Y + (size_t)(row0 + ai * HALF + m * 16 - y_row_sub) * 4096 + d0;
#pragma unroll
                for (int i = 0; i < 4; ++i) yv[m][i] = *(const u32x2*)(yrow + 1024 * i); }
#pragma unroll
            for (int m = 0; m < 4; ++m) { const int r = row0 + ai * HALF + m * 16; const float sr = srow[r];
                f32x4 s = (f32x4){0.f, 0.f, 0.f, 0.f};
#pragma unroll
                for (int i = 0; i < 4; ++i) { const f32x4 g = tof(acc[ai][i >> 1][m][i & 1]) * sc[i] * sr;
                    s[0] += __builtin_amdgcn_rcpf(1.0f + __builtin_amdgcn_exp2f(g[0])) * __uint_as_float(yv[m][i].x << 16); s[1] += __builtin_amdgcn_rcpf(1.0f + __builtin_amdgcn_exp2f(g[1])) * __uint_as_float(yv[m][i].x & 0xffff0000u);
                    s[2] += __builtin_amdgcn_rcpf(1.0f + __builtin_amdgcn_exp2f(g[2])) * __uint_as_float(yv[m][i].y << 16); s[3] += __builtin_amdgcn_rcpf(1.0f + __builtin_amdgcn_exp2f(g[3])) * __uint_as_float(yv[m][i].y & 0xffff0000u); }
                u32x2 w; w.x = cvt_pk_bf16(s[0], s[1]); w.y = cvt_pk_bf16(s[2], s[3]);
                *(u32x2*)(Mg + (size_t)r * 1024 + d0) = w; }
            asm volatile("" ::: "memory"); }
    }
};
struct EpiE1 {
    static constexpr bool PERM = true;
    bf16_t* H; const float* srow; const float* scol_all; const int* blk_e;
    template <class AT> __device__ __forceinline__ void operator()(const AT (&acc)[2][2][4][2], const Unit& u, int wr, int wc, int fr, int fq) const {
        const int row0 = u.pm * BM + wr * 64 + fr, col0 = u.pn * 128 + wc * 32 + 8 * fq;
        const float* scol = scol_all + (size_t)__builtin_amdgcn_readfirstlane(blk_e[u.pm]) * 512 + u.pn * BM + wc * 32 + 8 * fq;
        const f32x4 s10 = *(const f32x4*)scol, s11 = *(const f32x4*)(scol + 4), s30 = *(const f32x4*)(scol + HALF), s31 = *(const f32x4*)(scol + HALF + 4);
#pragma unroll
        for (int ai = 0; ai < 2; ++ai)
#pragma unroll
            for (int m = 0; m < 4; ++m) { const int r = row0 + ai * HALF + m * 16; const float sr = srow[r]; bf16_t* rowp = H + (size_t)r * EHID + col0;
                const f32x4 a0 = tof(acc[ai][0][m][0]) * s10 * sr, a1 = tof(acc[ai][0][m][1]) * s11 * sr, b0 = tof(acc[ai][1][m][0]) * s30 * sr, b1 = tof(acc[ai][1][m][1]) * s31 * sr;
                f32x4 v0, v1;
#pragma unroll
                for (int j = 0; j < 4; ++j) { v0[j] = a0[j] * sigmoidf_(a0[j]) * b0[j]; v1[j] = a1[j] * sigmoidf_(a1[j]) * b1[j]; }
                u32x4 w; w.x = cvt_pk_bf16(v0[0], v0[1]); w.y = cvt_pk_bf16(v0[2], v0[3]); w.z = cvt_pk_bf16(v1[0], v1[1]); w.w = cvt_pk_bf16(v1[2], v1[3]);
                *(u32x4*)rowp = w; }
    }
};
struct EpiE2 {
    static constexpr bool PERM = true;
    bf16_t* YS; const int* sdst;
    template <class AT> __device__ __forceinline__ void operator()(const AT (&acc)[2][2][4][2], const Unit& u, int wr, int wc, int fr, int fq) const {
        const int row0 = u.pm * BM + wr * 64 + fr, col0 = u.pn * BM + wc * 32 + 8 * fq;
#pragma unroll
        for (int ai = 0; ai < 2; ++ai)
#pragma unroll
            for (int m = 0; m < 4; ++m) { const int dst = sdst[row0 + ai * HALF + m * 16];
                bf16_t* rowp = YS + (size_t)dst * 1024 + col0;
#pragma unroll
                for (int bj = 0; bj < 2; ++bj) { const f32x4 v0 = tof(acc[ai][bj][m][0]), v1 = tof(acc[ai][bj][m][1]);
                    u32x4 w; w.x = cvt_pk_bf16(v0[0], v0[1]); w.y = cvt_pk_bf16(v0[2], v0[3]); w.z = cvt_pk_bf16(v1[0], v1[1]); w.w = cvt_pk_bf16(v1[2], v1[3]);
                    *(u32x4*)(rowp + bj * HALF) = w; }
                asm volatile("" ::: "memory"); }
    }
};

template <bool I8> struct AccSel { typedef f32x4 type; };
template <> struct AccSel<true> { typedef i32x4 type; };
__device__ __forceinline__ f32x4 mma16(const bf16x8& a, const bf16x8& b, const f32x4& c) { return __builtin_amdgcn_mfma_f32_16x16x32_bf16(a, b, c, 0, 0, 0); }
__device__ __forceinline__ i32x4 mma16(const bf16x8& a, const bf16x8& b, const i32x4& c) { return __builtin_amdgcn_mfma_i32_16x16x64_i8(__builtin_bit_cast(i32x4, a), __builtin_bit_cast(i32x4, b), c, 0, 0, 0); }
template <int LDAB, int LDBB, int KB, bool I8, bool ALIGN_EPI = false, class Epi, class Sched>
__device__ __forceinline__ void gemm_phase(PG8_LAS unsigned char* lds, const Gemm g, const Sched& S, const Epi& E) {
    int tid = threadIdx.x; asm volatile("" : "+v"(tid));
    const int wid = __builtin_amdgcn_readfirstlane(tid >> 6), lane = tid & 63, wr = wid >> 2, wc = wid & 3, fr = lane & 15, fq = lane >> 4;
    constexpr int nt = KB / (BK * 2);
    unsigned voffA[2], voffB[2]; int Rr[2]; unsigned cby[2];
#pragma unroll
    for (int i = 0; i < 2; ++i) { int R, C; stage_rc(tid * 16 + i * 8192, R, C); const int Rb = Epi::PERM ? ((R & ~31) + perm32(R & 31)) : R;
        voffA[i] = (unsigned)(R * LDAB + C * 2); voffB[i] = (unsigned)(Rb * LDBB + C * 2); Rr[i] = R; cby[i] = (unsigned)(C * 2); }
    unsigned gc[2][2], gn[2][2];
#define PG8_GATH(u_, o_) do { if constexpr (Sched::GATHER) { _Pragma("unroll") for (int h_ = 0; h_ < 2; ++h_) _Pragma("unroll") for (int i_ = 0; i_ < 2; ++i_) { int tk_ = S.rowmap[(u_).pm * BM + HALF * h_ + Rr[i_]] >> 1; tk_ = tk_ < T_ ? tk_ : T_ - 1; \
        o_[h_][i_] = (unsigned)tk_ * (unsigned)LDAB + cby[i_]; } } } while (0)
#define PG8_STAGE_A(bufoff, ptr, kb, h, nx) do { if constexpr (!Sched::GATHER) { PG8_STAGE(bufoff, ptr, voffA); } else { unsigned vo_[2]; vo_[0] = (nx) ? gn[h][0] : gc[h][0]; vo_[1] = (nx) ? gn[h][1] : gc[h][1]; \
        PG8_STAGE(bufoff, (const char*)g.A + (kb), vo_); } } while (0)
    constexpr size_t kstep = (size_t)(BK * 2);
    constexpr size_t hstepA = (size_t)HALF * LDAB, hstepB = (size_t)HALF * LDBB;
    const unsigned ldsw = (unsigned)wid * 1024u;
    const int aoff = lds_byte(wr * 64 + fr, fq * 8), boff = lds_byte(wc * 32 + fr, fq * 8);
#define PG8_SA(b, h) (((b) * 2 + (h)) * HTB)
#define PG8_SB(b, h) ((4 + (b) * 2 + (h)) * HTB)
#define PG8_STAGE(bufoff, gbase, voff) do { _Pragma("unroll") for (int _i = 0; _i < 2; ++_i) \
        __builtin_amdgcn_global_load_lds((const unsigned*)((const char*)(gbase) + (voff)[_i]), (PG8_LAS unsigned*)(lds + (bufoff) + ldsw + _i * 8192), 16, 0, 0); } while (0)
#define PG8_LDA(dst, b, h) do { _Pragma("unroll") for (int m = 0; m < 4; ++m) _Pragma("unroll") for (int k = 0; k < 2; ++k) dst[m][k] = *(const PG8_LAS bf16x8*)(lds + PG8_SA(b, h) + aoff + m * 2048 + k * 1024); } while (0)
#define PG8_LDB(dst, b, h) do { _Pragma("unroll") for (int n = 0; n < 2; ++n) _Pragma("unroll") for (int k = 0; k < 2; ++k) dst[n][k] = *(const PG8_LAS bf16x8*)(lds + PG8_SB(b, h) + boff + n * 2048 + k * 1024); } while (0)
#define PG8_MMA(ai, bj, At, Bt) do { __builtin_amdgcn_s_setprio(1); _Pragma("unroll") for (int m = 0; m < 4; ++m) _Pragma("unroll") for (int n = 0; n < 2; ++n) _Pragma("unroll") for (int k = 0; k < 2; ++k) \
        acc[ai][bj][m][n] = mma16(Bt[n][k], At[m][k], acc[ai][bj][m][n]); __builtin_amdgcn_s_setprio(0); } while (0)
#define PG8_WAIT_V(n) asm volatile("s_waitcnt vmcnt(" #n ")" ::: "memory")
#define PG8_WAIT_L(n) asm volatile("s_waitcnt lgkmcnt(" #n ")" ::: "memory")
#define PG8_BAR __builtin_amdgcn_s_barrier()
#define PG8_SCHED __builtin_amdgcn_sched_barrier(0)
    Unit cur, nxt; int ui = 0;
    if (!S.next(0, cur)) return;
    typedef typename AccSel<I8>::type acc_t;
    acc_t acc[2][2][4][2];
#pragma unroll
    for (int a = 0; a < 2; ++a)
#pragma unroll
        for (int b = 0; b < 2; ++b)
#pragma unroll
            for (int m = 0; m < 4; ++m)
#pragma unroll
                for (int n = 0; n < 2; ++n) acc[a][b][m][n] = (acc_t){0, 0, 0, 0};
    bf16x8 At[4][2], B0[2][2], B1[2][2];
    const char* cA = (const char*)g.A + cur.aoff; const char* cB = (const char*)g.Bt + cur.boff;
    PG8_GATH(cur, gc);
    PG8_STAGE(PG8_SB(0, 0), cB, voffB); PG8_STAGE_A(PG8_SA(0, 0), cA, 0, 0, false); PG8_STAGE(PG8_SB(0, 1), cB + hstepB, voffB); PG8_STAGE_A(PG8_SA(0, 1), cA + hstepA, 0, 1, false);
    if (wr == 1) PG8_BAR;
    PG8_WAIT_V(4); PG8_BAR;
    PG8_STAGE(PG8_SB(1, 0), cB + kstep, voffB); PG8_STAGE_A(PG8_SA(1, 0), cA + kstep, kstep, 0, false); PG8_STAGE(PG8_SB(1, 1), cB + hstepB + kstep, voffB);
    PG8_WAIT_V(6); PG8_BAR;
    for (;;) {
        const bool has_next = S.next(ui + 1, nxt);
        const char* nA = has_next ? (const char*)g.A + nxt.aoff : cA; const char* nB = has_next ? (const char*)g.Bt + nxt.boff : cB;
        if constexpr (Sched::GATHER) { if (has_next) PG8_GATH(nxt, gn); else { gn[0][0] = gc[0][0]; gn[0][1] = gc[0][1]; gn[1][0] = gc[1][0]; gn[1][1] = gc[1][1]; } }
        for (int t = 0; t < nt; t += 2) {
            const bool last = (t == nt - 2);
            const char* a1 = cA + (size_t)(t + 1) * kstep;
            const char* a2 = last ? nA : cA + (size_t)(t + 2) * kstep; const char* b2 = last ? nB : cB + (size_t)(t + 2) * kstep;
            const char* a3 = a2 + kstep; const char* b3 = b2 + kstep;
            const size_t k2 = last ? 0 : (size_t)(t + 2) * kstep;
            PG8_LDB(B0, 0, 0); PG8_SCHED; PG8_LDA(At, 0, 0); PG8_STAGE_A(PG8_SA(1, 1), a1 + hstepA, (size_t)(t + 1) * kstep, 1, false);
            PG8_WAIT_L(8); PG8_BAR; PG8_WAIT_L(0); PG8_MMA(0, 0, At, B0); PG8_BAR; PG8_SCHED;
            PG8_LDB(B1, 0, 1); PG8_STAGE(PG8_SB(0, 0), b2, voffB);
            PG8_BAR; PG8_WAIT_L(0); PG8_MMA(0, 1, At, B1); PG8_BAR;
            PG8_LDA(At, 0, 1); PG8_STAGE_A(PG8_SA(0, 0), a2, k2, 0, last);
            PG8_BAR; PG8_WAIT_L(0); PG8_MMA(1, 0, At, B0); PG8_BAR; PG8_SCHED;
            PG8_STAGE(PG8_SB(0, 1), b2 + hstepB, voffB);
            PG8_WAIT_V(6); PG8_BAR; PG8_MMA(1, 1, At, B1); PG8_BAR;
            PG8_LDB(B0, 1, 0); PG8_SCHED; PG8_LDA(At, 1, 0); PG8_STAGE_A(PG8_SA(0, 1), a2 + hstepA, k2, 1, last);
            PG8_WAIT_L(8); PG8_BAR; PG8_WAIT_L(0); PG8_MMA(0, 0, At, B0); PG8_BAR; PG8_SCHED;
            PG8_LDB(B1, 1, 1); PG8_STAGE(PG8_SB(1, 0), b3, voffB);
            PG8_BAR; PG8_WAIT_L(0); PG8_MMA(0, 1, At, B1); PG8_BAR;
            PG8_LDA(At, 1, 1); PG8_STAGE_A(PG8_SA(1, 0), a3, k2 + kstep, 0, last);
            PG8_BAR; PG8_WAIT_L(0); PG8_MMA(1, 0, At, B0); PG8_BAR; PG8_SCHED;
            PG8_STAGE(PG8_SB(1, 1), b3 + hstepB, voffB);
            PG8_WAIT_V(6); PG8_BAR; PG8_MMA(1, 1, At, B1); PG8_BAR;
        }
        if constexpr (ALIGN_EPI) { if (wr == 0) PG8_BAR; }
        E(acc, cur, wr, wc, fr, fq);
        if (!has_next) break;
#pragma unroll
        for (int a = 0; a < 2; ++a)
#pragma unroll
            for (int b = 0; b < 2; ++b)
#pragma unroll
                for (int m = 0; m < 4; ++m)
#pragma unroll
                    for (int n = 0; n < 2; ++n) acc[a][b][m][n] = (acc_t){0, 0, 0, 0};
        cur = nxt; cA = nA; cB = nB; ++ui;
        if constexpr (Sched::GATHER) { gc[0][0] = gn[0][0]; gc[0][1] = gn[0][1]; gc[1][0] = gn[1][0]; gc[1][1] = gn[1][1]; }
        if constexpr (ALIGN_EPI) { if (wr == 1) PG8_BAR; }
    }
    PG8_WAIT_V(0);
    if constexpr (!ALIGN_EPI) { if (wr == 0) PG8_BAR; }
    PG8_BAR;
#undef PG8_SA
#undef PG8_GATH
#undef PG8_STAGE_A
#undef PG8_SB
#undef PG8_STAGE
#undef PG8_LDA
#undef PG8_LDB
#undef PG8_MMA
#undef PG8_WAIT_V
#undef PG8_WAIT_L
#undef PG8_BAR
#undef PG8_SCHED
}
}

#define XB_TMO      128
#define XB_XCNT(j)  (256  + 64 * (j))
#define XB_XSUB(j)  (1280 + 64 * (j))
#define XB_XGEN(j)  (2304 + 64 * (j))
#define XB_TOP      3328
#define XB_TOPGEN   3392
#define XCD_BAR_WORDS 3456
#define XB_SPIN_CAP (1u << 21)

__device__ __forceinline__ unsigned xb_ld(unsigned* p)              { return __hip_atomic_load(p, __ATOMIC_RELAXED, __HIP_MEMORY_SCOPE_AGENT); }
__device__ __forceinline__ unsigned xb_add(unsigned* p, unsigned v) { return __hip_atomic_fetch_add(p, v, __ATOMIC_RELAXED, __HIP_MEMORY_SCOPE_AGENT); }
__device__ __forceinline__ unsigned xb_xcc_id() { return (unsigned)__builtin_amdgcn_s_getreg((3 << 11) | 20) & 0xFu; }
#define XB_SPIN(cond, bar) do { unsigned _sp = 0; while (cond) { __builtin_amdgcn_s_sleep(1); \
    if ((++_sp & 255u) == 0u) { if (xb_ld(&(bar)[XB_TMO])) break; if (_sp > XB_SPIN_CAP) { atomicAdd(&(bar)[XB_TMO], 1u); break; } } } } while (0)

struct XcdBarrier {
    unsigned* bar; unsigned x;
    volatile LAS unsigned* st;
};

__device__ __forceinline__ XcdBarrier xcd_barrier_post(unsigned* bar, volatile LAS unsigned* st) {
    XcdBarrier b; b.bar = bar; b.x = xb_xcc_id(); b.st = st;
    if (threadIdx.x == 0) (void)xb_add(&bar[XB_XCNT(b.x)], 1u);
    return b;
}
__device__ __forceinline__ void xcd_barrier_complete(unsigned* bar, unsigned x, unsigned& nloc, unsigned& nx) {
    const unsigned G = gridDim.x * gridDim.y * gridDim.z;
    unsigned sum, cnt, mine, sp = 0u;
    for (;;) {
        sum = 0u; cnt = 0u; mine = 0u;
#pragma unroll
        for (unsigned j = 0; j < 16; ++j) { const unsigned c = xb_ld(&bar[XB_XCNT(j)]); sum += c; cnt += (c > 0u) ? 1u : 0u; mine = (j == x) ? c : mine; }
        if (sum == G) break;
        __builtin_amdgcn_s_sleep(1);
        if ((++sp & 255u) == 0u) { if (xb_ld(&bar[XB_TMO])) break; if (sp > XB_SPIN_CAP) { atomicAdd(&bar[XB_TMO], 1u); break; } }
    }
    nloc = mine > 0u ? mine : 1u; nx = cnt > 0u ? cnt : 1u;
}

__device__ __forceinline__ void xcd_barrier(const XcdBarrier& b) {
    asm volatile("s_waitcnt vmcnt(0)" ::: "memory");
    __syncthreads();
    if (threadIdx.x == 0) {
        unsigned* bar = b.bar;
        __builtin_amdgcn_s_waitcnt(0);
        unsigned nloc = b.st[0], nx = b.st[1];
        if (nloc == 0u) { xcd_barrier_complete(bar, b.x, nloc, nx); b.st[0] = nloc; b.st[1] = nx; }
        const unsigned old = xb_add(&bar[XB_XSUB(b.x)], 1u);
        const unsigned gen = old / nloc;
        if (old + 1u == (gen + 1u) * nloc) {
            __builtin_amdgcn_fence(__ATOMIC_RELEASE, "agent");
            asm volatile("s_waitcnt vmcnt(0)" ::: "memory");
            const unsigned og = xb_add(&bar[XB_TOP], 1u);
            const unsigned tg = og / nx;
            if (og + 1u == (tg + 1u) * nx) xb_add(&bar[XB_TOPGEN], 1u);
            else XB_SPIN(xb_ld(&bar[XB_TOPGEN]) == tg, bar);
            __builtin_amdgcn_fence(__ATOMIC_ACQUIRE, "agent");
            xb_add(&bar[XB_XGEN(b.x)], 1u);
            asm volatile("s_waitcnt vmcnt(0)" ::: "memory");
        } else {
            XB_SPIN(xb_ld(&bar[XB_XGEN(b.x)]) == gen, bar);
            __builtin_amdgcn_fence(__ATOMIC_ACQUIRE, "agent");
            asm volatile("s_waitcnt vmcnt(0)" ::: "memory");
        }
    }
    __syncthreads();
}

constexpr int NWAVES = 8, NTHREADS = 512;
constexpr int RING_BYTES = 131072;
constexpr int LDSCTL_OFF = 163840 - 1024, MISC_OFF = LDSCTL_OFF + 320;
constexpr int LDS_BYTES = 163840;

struct Params { const float* in[19]; float* out; unsigned char* ws; float inv_freq[16]; float ret_lg2[4]; int ph_lo, ph_hi; };
typedef const __attribute__((address_space(4))) Params& KPRef;

__device__ __forceinline__ float wave_sum(float v) {
#pragma unroll
    for (int o = 1; o < 64; o <<= 1) v += __shfl_xor(v, o);
    return v;
}
#define LDS_WAIT() asm volatile("s_waitcnt lgkmcnt(0)" ::: "memory")
#define MFMA16(a, b, c) __builtin_amdgcn_mfma_f32_16x16x32_bf16(a, b, c, 0, 0, 0)
typedef short v4i16_t __attribute__((ext_vector_type(4)));
__device__ __forceinline__ v4i16_t lds_tr16(const bf16_t* p) { return __builtin_amdgcn_ds_read_tr16_b64_v4i16((LAS v4i16_t*)(LAS unsigned char*)(unsigned char*)p); }
__device__ __forceinline__ bf16x8 tr_frag(const bf16_t* tile, int stride, int rowa, int rowb, int col0, int lane) {
    const int i = lane & 15, q = i >> 2, pp = i & 3;
    const v4i16_t lo = lds_tr16(tile + (rowa + q) * stride + col0 + 4 * pp), hi = lds_tr16(tile + (rowb + q) * stride + col0 + 4 * pp);
    return (bf16x8){lo[0], lo[1], lo[2], lo[3], hi[0], hi[1], hi[2], hi[3]};
}
__device__ __forceinline__ bf16x8 pack_p(const f32x4& a, const f32x4& b) {
    u32x4 w; w.x = pg8::cvt_pk_bf16(a[0], a[1]); w.y = pg8::cvt_pk_bf16(a[2], a[3]); w.z = pg8::cvt_pk_bf16(b[0], b[1]); w.w = pg8::cvt_pk_bf16(b[2], b[3]); return __builtin_bit_cast(bf16x8, w); }


template <class LD>
__device__ __forceinline__ void conv_item(LD ld, bf16_t* WT, int K, float* scr, int kb, int nb, int lane) {
    const int k0 = 64 * kb, n0 = 32 * nb;
    float wv[32];
#pragma unroll
    for (int i = 0; i < 32; ++i) wv[i] = ld(k0 + 2 * i + (lane >> 5), n0 + (lane & 31));
#pragma unroll
    for (int i = 0; i < 32; ++i) { const int kk = 2 * i + (lane >> 5); scr[kk * 33 + (lane & 31)] = wv[i]; }
    LDS_WAIT();
    const int c = lane & 7;
#pragma unroll
    for (int j = 0; j < 4; ++j) { const int n = (lane >> 3) + 8 * j; const float* s = scr + (8 * c) * 33 + n;
        u32x4 o; o.x = pk2(s[0 * 33], s[1 * 33]); o.y = pk2(s[2 * 33], s[3 * 33]); o.z = pk2(s[4 * 33], s[5 * 33]); o.w = pk2(s[6 * 33], s[7 * 33]);
        *(u32x4*)(WT + (size_t)(n0 + n) * K + k0 + 8 * c) = o; }
    LDS_WAIT();
}

template <class LD>
__device__ __forceinline__ void amax_item(LD ld, unsigned* raw, int kb, int nb, int lane) {
    const int k0 = 64 * kb, n0 = 32 * nb; float v[32];
#pragma unroll
    for (int i = 0; i < 32; ++i) v[i] = ld(k0 + 2 * i + (lane >> 5), n0 + (lane & 31));
    float am = 0.f;
#pragma unroll
    for (int i = 0; i < 32; ++i) am = fmaxf(am, fabsf(v[i]));
    am = fmaxf(am, __shfl_xor(am, 32));
    if (lane < 32) atomicMax(raw + n0 + lane, __float_as_uint(am));
}
template <class LD, class SC>
__device__ __forceinline__ void quant_item(LD ld, SC extra, const unsigned* raw, signed char* WT, float* scale, float* scr, int kb, int nb, int lane) {
    const int k0 = 64 * kb, n0 = 32 * nb;
    const float am = __uint_as_float(raw[n0 + (lane & 31)]), qs = (am > 0.f) ? 127.0f / am : 0.f;
    if (kb == 0 && lane < 32) scale[n0 + lane] = am * (1.0f / 127.0f) * extra(n0 + lane);
    float wv[32];
#pragma unroll
    for (int i = 0; i < 32; ++i) wv[i] = ld(k0 + 2 * i + (lane >> 5), n0 + (lane & 31));
#pragma unroll
    for (int i = 0; i < 32; ++i) { const int kk = 2 * i + (lane >> 5); scr[kk * 33 + (lane & 31)] = rintf(wv[i] * qs); }
    LDS_WAIT();
    const int c = lane & 7;
#pragma unroll
    for (int j = 0; j < 4; ++j) { const int n = (lane >> 3) + 8 * j; const float* s = scr + (8 * c) * 33 + n;
        u32x2 o; o.x = ((unsigned)((int)s[0 * 33] & 0xff)) | ((unsigned)((int)s[1 * 33] & 0xff) << 8) | ((unsigned)((int)s[2 * 33] & 0xff) << 16) | ((unsigned)((int)s[3 * 33] & 0xff) << 24);
        o.y = ((unsigned)((int)s[4 * 33] & 0xff)) | ((unsigned)((int)s[5 * 33] & 0xff) << 8) | ((unsigned)((int)s[6 * 33] & 0xff) << 16) | ((unsigned)((int)s[7 * 33] & 0xff) << 24);
        *(u32x2*)(WT + (size_t)(n0 + n) * 1024 + k0 + 8 * c) = o; }
    LDS_WAIT();
}
template <int PASS>
__device__ __forceinline__ void conv8_pass(KPRef p, int l, unsigned char* wd, unsigned char* lds, int gw, int NGW, int wave, int lane) {
    float* scr = (float*)(lds + wave * 16384); unsigned char* ws = p.ws; unsigned* raw = (unsigned*)(ws + WS_SWRAW + (size_t)l * SWRAW_LSTEP); const size_t sl = (size_t)l * SW_LSTEP;
    const float* Win = p.in[2] + (size_t)l * 1024 * IN_W;
    for (int it = gw; it < 16 * 96; it += NGW) { const int kb = it / 96, nb = it % 96;
        auto ld = [&](int k, int n) -> float { return n < Z_GATE ? Win[(size_t)k * IN_W + n] : 0.f; };
        if (PASS == 0) amax_item(ld, raw, kb, nb, lane);
        else quant_item(ld, [&](int n) -> float { float s = 1.f; if (n < Z_GK) s = RSQ32; else if (n >= Z_SQ && n < Z_SK) s = C2; else if (n >= Z_MQ && n < Z_MK) s = C2; else if (n >= Z_RK && n < Z_RV) s = RSQ32; return s; },
                        raw, (signed char*)(wd + WS_WIN), (float*)(ws + WS_SWIN + sl), scr, kb, nb, lane); }
    for (int it = gw; it < 16 * 128; it += NGW) { const int kb = it / 128, nb = it % 128;
        auto ld = [&](int k, int n) -> float { const int pn = n >> 8, c = n & 255, bj = (c >> 7) & 1, wc = (c >> 5) & 3, nn = (c >> 4) & 1, fq = (c >> 2) & 3, j = c & 3;
            const int col = Z_GATE + 1024 * (2 * bj + nn) + 64 * pn + 16 * wc + 4 * fq + j; return Win[(size_t)k * IN_W + col]; };
        if (PASS == 0) amax_item(ld, raw + 3072, kb, nb, lane);
        else quant_item(ld, [&](int) -> float { return 1.f; }, raw + 3072, (signed char*)(wd + WS_WG), (float*)(ws + WS_SWG + sl), scr, kb, nb, lane); }
    for (int it = gw; it < 32 * 256; it += NGW) { const int e = it / 256, r = it % 256, kb = r / 16, nb = r % 16;
        const int n0 = 32 * nb, pn = n0 >> 8, c0 = n0 & 255;
        const float* W = ((c0 < 128) ? p.in[15] : p.in[16]) + (size_t)(l * 32 + e) * 1024 * 256 + 128 * pn + (c0 & 127) - n0;
        auto ld = [&](int k, int n) -> float { return W[(size_t)k * 256 + n]; };
        if (PASS == 0) amax_item(ld, raw + 7168 + e * 512, kb, nb, lane);
        else quant_item(ld, [&](int) -> float { return 1.f; }, raw + 7168 + e * 512, (signed char*)(wd + WS_E1) + (size_t)e * 512 * 1024, (float*)(ws + WS_SWE1 + sl) + e * 512, scr, kb, nb, lane); }
}

__device__ __forceinline__ void conv_phase(KPRef p, int l, unsigned char* wd, unsigned char* lds, int gw, int NGW, int wave, int lane) {
    float* scr = (float*)(lds + wave * 16384);
    unsigned char* ws = wd;
    {
        for (int it = gw; it < 512; it += NGW) { const int i = it / 128, r = it % 128, kb = r / 32, nb = r % 32;
            const float* W = p.in[8] + (size_t)(l * 4 + i) * 256 * 1024; bf16_t* WT = (bf16_t*)(ws + WS_WB) + (size_t)i * 1024 * 256;
            conv_item([&](int k, int n) -> float { return W[(size_t)k * 1024 + n]; }, WT, 256, scr, kb, nb, lane); }
    }
    {
        const float* W = p.in[9] + (size_t)l * 1024 * 1024; bf16_t* WT = (bf16_t*)(ws + WS_WO);
        for (int it = gw; it < 16 * 32; it += NGW) { const int kb = it / 32, nb = it % 32;
            conv_item([&](int k, int n) -> float { return W[(size_t)k * 1024 + n]; }, WT, 1024, scr, kb, nb, lane); }
    }
    {
        const float* Wg = p.in[11] + (size_t)l * 1024 * 4; const float* We = p.in[13] + (size_t)l * 1024 * 32; bf16_t* WT = (bf16_t*)(ws + WS_WR);
        for (int it = gw; it < 16 * 8; it += NGW) { const int kb = it / 8, nb = it % 8;
            conv_item([&](int k, int n) -> float { if (n < 4) return Wg[k * 4 + n]; if (n < 36) return We[k * 32 + (n - 4)]; return 0.f; }, WT, 1024, scr, kb, nb, lane); }
    }
    {
        for (int it = gw; it < 32 * 128; it += NGW) { const int e = it / 128, r = it % 128, kb = r / 32, nb = r % 32;
            const float* W = p.in[17] + (size_t)(l * 32 + e) * 256 * 1024; bf16_t* WT = (bf16_t*)(ws + WS_E2) + (size_t)e * 1024 * 256;
            conv_item([&](int k, int n) -> float { return W[(size_t)k * 1024 + n]; }, WT, 256, scr, kb, nb, lane); }
    }
}

__device__ __forceinline__ bf16_t* hbf_ptr(KPRef p) { return (bf16_t*)((unsigned char*)p.out + (size_t)64 * MiB); }
template <bool SRC_F32, bool COMBINE>
__device__ __forceinline__ void norm_load_row(KPRef p, int row, int lane, f32x4 (&v)[4]) {
    if (SRC_F32) { const f32x4* xr = (const f32x4*)(p.in[0] + (size_t)row * 1024) + lane;
#pragma unroll
        for (int j = 0; j < 4; ++j) v[j] = xr[64 * j];
    } else { const u32x2* hr = (const u32x2*)(hbf_ptr(p) + (size_t)row * 1024) + lane;
#pragma unroll
        for (int j = 0; j < 4; ++j) { const u32x2 a = hr[64 * j]; v[j] = (f32x4){__uint_as_float(a.x << 16), __uint_as_float(a.x & 0xffff0000u), __uint_as_float(a.y << 16), __uint_as_float(a.y & 0xffff0000u)}; } }
    if (COMBINE) { const bf16_t* ys = (const bf16_t*)(p.ws + WS_YS); const float* tokw = (const float*)(p.ws + WS_TOKW);
        const float w0 = tokw[2 * row], w1 = tokw[2 * row + 1];
        const u32x2* y0 = (const u32x2*)(ys + (size_t)(2 * row) * 1024) + lane; const u32x2* y1 = (const u32x2*)(ys + (size_t)(2 * row + 1) * 1024) + lane;
        u32x2 ya[4], yb[4];
#pragma unroll
        for (int j = 0; j < 4; ++j) { ya[j] = y0[64 * j]; yb[j] = y1[64 * j]; }
#pragma unroll
        for (int j = 0; j < 4; ++j) { const u32x2 a = ya[j], b = yb[j];
            v[j][0] += w0 * __uint_as_float(a.x << 16) + w1 * __uint_as_float(b.x << 16); v[j][1] += w0 * __uint_as_float(a.x & 0xffff0000u) + w1 * __uint_as_float(b.x & 0xffff0000u);
            v[j][2] += w0 * __uint_as_float(a.y << 16) + w1 * __uint_as_float(b.y << 16); v[j][3] += w0 * __uint_as_float(a.y & 0xffff0000u) + w1 * __uint_as_float(b.y & 0xffff0000u); } }
}
__device__ __forceinline__ float row_rstd(const f32x4 (&v)[4]) {
    float s = 0.f;
#pragma unroll
    for (int j = 0; j < 4; ++j) s += (v[j][0] * v[j][0] + v[j][1] * v[j][1]) + (v[j][2] * v[j][2] + v[j][3] * v[j][3]);
    return rsqrtf(wave_sum(s) * (1.0f / 1024.0f) + NORM_EPS);
}
template <int MODE>
__device__ __forceinline__ void norm_phase(KPRef p, int l, int gw, int NGW, int lane) {
    const float* gain = (MODE == 2 ? p.in[10] + l * 1024 : p.in[1] + l * 1024);
    f32x4 gg[4];
#pragma unroll
    for (int j = 0; j < 4; ++j) gg[j] = ((const f32x4*)gain)[lane + 64 * j];
    constexpr int NR = (MODE == 1) ? 2 : 4;
    for (int row0 = gw * NR; row0 < T_; row0 += NGW * NR) {
        f32x4 v[NR][4];
#pragma unroll
        for (int r = 0; r < NR; ++r) norm_load_row<MODE == 0, MODE == 1>(p, row0 + r, lane, v[r]);
#pragma unroll
        for (int r = 0; r < NR; ++r) {
            if (MODE == 1) { u32x2* hr = (u32x2*)(hbf_ptr(p) + (size_t)(row0 + r) * 1024) + lane;
#pragma unroll
                for (int j = 0; j < 4; ++j) { u32x2 w; w.x = pk2(v[r][j][0], v[r][j][1]); w.y = pk2(v[r][j][2], v[r][j][3]); hr[64 * j] = w; } }
            const float rstd = row_rstd(v[r]);
            f32x4 o[4]; float am = 0.f;
#pragma unroll
            for (int j = 0; j < 4; ++j) { o[j] = v[r][j] * rstd * gg[j]; am = fmaxf(fmaxf(am, fmaxf(fabsf(o[j][0]), fabsf(o[j][1]))), fmaxf(fabsf(o[j][2]), fabsf(o[j][3]))); }
#pragma unroll
            for (int of = 1; of < 64; of <<= 1) am = fmaxf(am, __shfl_xor(am, of));
            const float qs = (am > 0.f) ? 127.0f / am : 0.f;
            unsigned* o4 = (unsigned*)(p.ws + WS_U8 + (size_t)(row0 + r) * 1024) + lane;
#pragma unroll
            for (int j = 0; j < 4; ++j) { const int q0 = (int)rintf(o[j][0] * qs), q1 = (int)rintf(o[j][1] * qs), q2 = (int)rintf(o[j][2] * qs), q3 = (int)rintf(o[j][3] * qs);
                o4[64 * j] = (unsigned)(q0 & 0xff) | ((unsigned)(q1 & 0xff) << 8) | ((unsigned)(q2 & 0xff) << 16) | ((unsigned)(q3 & 0xff) << 24); }
            if (lane == 0) ((float*)(p.ws + WS_SU))[row0 + r] = am * (1.0f / 127.0f);
            if (MODE == 2) { u32x2* o8 = (u32x2*)(p.ws + WS_U2BF + (size_t)(row0 + r) * 2048) + lane;
#pragma unroll
                for (int j = 0; j < 4; ++j) { u32x2 w; w.x = pk2(o[j][0], o[j][1]); w.y = pk2(o[j][2], o[j][3]); o8[64 * j] = w; } }
        }
    }
}
struct FinalHold { f32x4 v[8][4]; };
__device__ __forceinline__ void final_a(KPRef p, int gw, int NGW, int lane, FinalHold& Hd) {
    f32x4 gg[4];
#pragma unroll
    for (int j = 0; j < 4; ++j) gg[j] = ((const f32x4*)p.in[18])[lane + 64 * j];
    for (int row0 = gw * 4; row0 < T_ / 2; row0 += NGW * 4) {
        f32x4 v[4][4];
#pragma unroll
        for (int r = 0; r < 4; ++r) norm_load_row<false, true>(p, row0 + r, lane, v[r]);
#pragma unroll
        for (int r = 0; r < 4; ++r) { const float rstd = row_rstd(v[r]); f32x4* orow = (f32x4*)(p.out + (size_t)(row0 + r) * 1024) + lane;
#pragma unroll
            for (int j = 0; j < 4; ++j) orow[64 * j] = v[r][j] * rstd * gg[j]; } }
#pragma unroll
    for (int r = 0; r < 8; ++r) norm_load_row<false, true>(p, T_ / 2 + gw * 8 + r, lane, Hd.v[r]);
}
__device__ __forceinline__ void final_b(KPRef p, int gw, int lane, const FinalHold& Hd) {
    f32x4 gg[4];
#pragma unroll
    for (int j = 0; j < 4; ++j) gg[j] = ((const f32x4*)p.in[18])[lane + 64 * j];
#pragma unroll
    for (int r = 0; r < 8; ++r) { const float rstd = row_rstd(Hd.v[r]); f32x4* orow = (f32x4*)(p.out + (size_t)(T_ / 2 + gw * 8 + r) * 1024) + lane;
#pragma unroll
        for (int j = 0; j < 4; ++j) orow[64 * j] = Hd.v[r][j] * rstd * gg[j]; }
}

constexpr int LA_QS = 0, LA_KS = 10240, LA_VS = 20480  , LA_KD = 38912  , LA_PS = 49152  , LA_PW = 58368, LA_PW_WAVE = 4352,
              LA_LA = 93184, LA_AS = 110080, LA_END = 118272;
__device__ __forceinline__ void unpack8f(float (&d)[8], u32x4 kk) {
    d[0] = __uint_as_float(kk.x << 16); d[1] = __uint_as_float(kk.x & 0xffff0000u); d[2] = __uint_as_float(kk.y << 16); d[3] = __uint_as_float(kk.y & 0xffff0000u);
    d[4] = __uint_as_float(kk.z << 16); d[5] = __uint_as_float(kk.z & 0xffff0000u); d[6] = __uint_as_float(kk.w << 16); d[7] = __uint_as_float(kk.w & 0xffff0000u); }
__device__ __forceinline__ u32x4 pack8f(const float (&o)[8]) { u32x4 w; w.x = pk2(o[0], o[1]); w.y = pk2(o[2], o[3]); w.z = pk2(o[4], o[5]); w.w = pk2(o[6], o[7]); return w; }

struct LaRegs { u32x4 a, k[2], q[2], v[2], g[2]; f32x4 pv[2]; };
__device__ __forceinline__ void gla_decay_front(KPRef p, int l, unsigned char* lds, const u32x4& areg, int h, int tid) {
    float* LA = (float*)(lds + LA_LA); float* AS = (float*)(lds + LA_AS);
    const int lane = tid & 63, wave = __builtin_amdgcn_readfirstlane(tid >> 6);
    if (tid < 256) { const int t = tid >> 1, hf = tid & 1; float a[8]; unpack8f(a, areg);
#pragma unroll
        for (int e = 0; e < 8; ++e) AS[t * 16 + 8 * hf + e] = a[e]; }
    const int d = tid & 31; const float* wa2 = p.in[3] + (size_t)l * 16 * 128 + h * 32 + d; float wcol[16];
#pragma unroll
    for (int r = 0; r < 16; ++r) wcol[r] = wa2[r * 128];
    const float bias = p.in[4][l * 128 + h * 32 + d];
    __syncthreads();
#pragma unroll
    for (int i = 0; i < 8; ++i) { const int t = (tid >> 5) + 16 * i; float x = bias;
#pragma unroll
        for (int r = 0; r < 16; ++r) x += AS[t * 16 + r] * wcol[r];
        LA[t * 33 + d] = (fminf(x, 0.f) - __builtin_amdgcn_logf(1.0f + __builtin_amdgcn_exp2f(-fabsf(x) * LOG2E)) * 0.6931471805599453f) * (1.0f / 16.0f); }
    __syncthreads();
#pragma unroll
    for (int s8 = 0; s8 < 8; ++s8) { const int s = wave * 8 + s8, ch = s >> 5, dd = s & 31; float v = LA[(64 * ch + lane) * 33 + dd];
#pragma unroll
        for (int o = 1; o < 64; o <<= 1) { const float t = __shfl_up(v, o); if (lane >= o) v += t; }
        LA[(64 * ch + lane) * 33 + dd] = v; }
    __syncthreads();
}
__device__ __forceinline__ void la_stage_v(unsigned char* lds, const u32x4 (&v)[2], int tid) {
    bf16_t* VS = (bf16_t*)(lds + LA_VS);
#pragma unroll
    for (int i = 0; i < 2; ++i) { const int c = tid + 512 * i, t = c >> 3, oct = c & 7; *(u32x4*)(VS + t * 72 + 8 * oct) = v[i]; }
}
template <bool OUT, bool GLA>
__device__ __forceinline__ void la_load(LaRegs& R, KPRef p, int unit, int tid) {
    const int lane = tid & 63, wave = __builtin_amdgcn_readfirstlane(tid >> 6);
    int b, h, c128; if (GLA) { c128 = unit & 63; h = (unit >> 6) & 3; b = unit >> 8; } else { c128 = unit & 63; const int bh = unit >> 6; h = bh & 3; b = bh >> 2; }
    const size_t t0 = (size_t)b * S_ + (size_t)c128 * 128; const bf16_t* zrow0 = (const bf16_t*)(p.ws + WS_Z) + t0 * ZW;
    const int kcol = GLA ? Z_GK + h * 32 : Z_RK + h * 32, qcol = GLA ? Z_GQ + h * 32 : Z_RQ + h * 32, vcol = GLA ? Z_GV + h * 64 : Z_RV + h * 64, gcol = GLA ? Z_GR + h * 64 : Z_RG + h * 64;
    if (GLA) { const int t = (tid & 255) >> 1, hf = tid & 1; R.a = *(const u32x4*)(zrow0 + (size_t)t * ZW + Z_GA + 8 * hf); }
    { const int t = tid >> 2, oct = tid & 3; const bf16_t* kr = zrow0 + (size_t)t * ZW + kcol; R.k[0] = *(const u32x4*)(kr + 8 * oct); if (!GLA) R.k[1] = *(const u32x4*)(kr + 8 * (oct ^ 2));
      if (OUT) { const bf16_t* qr = zrow0 + (size_t)t * ZW + qcol; R.q[0] = *(const u32x4*)(qr + 8 * oct); if (!GLA) R.q[1] = *(const u32x4*)(qr + 8 * (oct ^ 2)); } }
#pragma unroll
    for (int i = 0; i < 2; ++i) { const int c = tid + 512 * i, t = c >> 3, oct = c & 7; R.v[i] = *(const u32x4*)(zrow0 + (size_t)t * ZW + vcol + 8 * oct); }
    if (OUT) {
#pragma unroll
        for (int i = 0; i < 2; ++i) { const int cidx = lane + 64 * i, row = cidx >> 3, oct = cidx & 7; R.g[i] = *(const u32x4*)(zrow0 + (size_t)(16 * wave + row) * ZW + gcol + 8 * oct); }
        const float* prev = GLA ? (const float*)(p.ws + WS_GKV) + (size_t)((b * 4 + h) * 128 + 2 * c128) * 2048 : (const float*)(p.ws + WS_RKV) + (size_t)unit * 2048;
        const int row = (GLA ? tid : (tid & 255)) >> 3, oct = tid & 7; R.pv[0] = *(const f32x4*)(prev + row * 64 + 8 * oct); R.pv[1] = *(const f32x4*)(prev + row * 64 + 8 * oct + 4); }
}
__device__ __forceinline__ void la_kv_mfma(unsigned char* lds, float* out0, int nch, int clen, int tid) {
    const bf16_t* KD = (const bf16_t*)(lds + LA_KD); const bf16_t* VS = (const bf16_t*)(lds + LA_VS);
    const int lane = tid & 63, wave = __builtin_amdgcn_readfirstlane(tid >> 6), c16 = lane & 15, g = lane >> 4;
    const int ntile = 8 * nch;
    for (int ti = wave; ti < ntile; ti += 8) { const int ch = ti >> 3, dt = (ti >> 2) & 1, et = ti & 3, tok0 = ch * clen;
        f32x4 acc = (f32x4){0.f, 0.f, 0.f, 0.f};
        for (int s = 0; s < clen / 32; ++s) { const int r0 = tok0 + 32 * s + 8 * g;
            acc = MFMA16(tr_frag(KD, 40, r0, r0 + 4, 16 * dt, lane), tr_frag(VS, 72, r0, r0 + 4, 16 * et, lane), acc); }
        float* o = out0 + (size_t)ch * 2048 + (16 * dt + 4 * g) * 64 + 16 * et + c16;
#pragma unroll
        for (int r = 0; r < 4; ++r) o[r * 64] = acc[r]; }
}
__device__ __forceinline__ void gla_kv_unit(KPRef p, int l, unsigned char* lds, int unit, const LaRegs& R, int tid) {
    const int c = unit & 63, h = (unit >> 6) & 3, b = unit >> 8;
    gla_decay_front(p, l, lds, R.a, h, tid);
    const float* LA = (const float*)(lds + LA_LA); bf16_t* KD = (bf16_t*)(lds + LA_KD);
    { const int t = tid >> 2, oct = tid & 3, ch = t >> 6; float k[8]; unpack8f(k, R.k[0]);
#pragma unroll
      for (int e = 0; e < 8; ++e) { const int d = 8 * oct + e; k[e] *= __builtin_amdgcn_exp2f((LA[(64 * ch + 63) * 33 + d] - LA[t * 33 + d]) * LOG2E); }
      *(u32x4*)(KD + t * 40 + 8 * oct) = pack8f(k); }
    la_stage_v(lds, R.v, tid);
    __syncthreads();
    const int cu = ((b * 4 + h) * 128 + 2 * c);
    la_kv_mfma(lds, (float*)(p.ws + WS_GKV) + (size_t)cu * 2048, 2, 64, tid);
    if (tid < 64) { const int ch = tid >> 5, d = tid & 31; ((float*)(p.ws + WS_GDEC))[(size_t)(cu + ch) * 32 + d] = __builtin_amdgcn_exp2f(LA[(64 * ch + 63) * 33 + d] * LOG2E); }
    __syncthreads();
}
__device__ __forceinline__ void la_out_mfma(unsigned char* lds, const u32x4 (&gate)[2], const float* ng, bf16_t* orow0, int ocol, int clen, int tid) {
    const bf16_t* QS = (const bf16_t*)(lds + LA_QS); const bf16_t* KS = (const bf16_t*)(lds + LA_KS); const bf16_t* VS = (const bf16_t*)(lds + LA_VS); const bf16_t* PS = (const bf16_t*)(lds + LA_PS);
    const int lane = tid & 63, wave = __builtin_amdgcn_readfirstlane(tid >> 6), c16 = lane & 15, g = lane >> 4;
    float* PWf = (float*)(lds + LA_PW + wave * LA_PW_WAVE);
    const int ch = (clen == 64) ? (wave >> 2) : 0, kt0 = (clen == 64) ? 4 * ch : 0;
    const bf16x8 qa = *(const bf16x8*)(QS + (16 * wave + c16) * 40 + 8 * g);
    f32x4 O[4];
#pragma unroll
    for (int et = 0; et < 4; ++et) O[et] = MFMA16(qa, tr_frag(PS + ch * 32 * 72, 72, 8 * g, 8 * g + 4, 16 * et, lane), ((f32x4){0.f, 0.f, 0.f, 0.f}));
    for (int s = kt0 >> 1; s <= (wave >> 1); ++s) {
        f32x4 P0, P1;
        { const int kt = 2 * s; P0 = MFMA16(*(const bf16x8*)(KS + (16 * kt + c16) * 40 + 8 * g), qa, ((f32x4){0.f, 0.f, 0.f, 0.f}));
          if (kt == wave) {
#pragma unroll
              for (int r = 0; r < 4; ++r) if (4 * g + r > c16) P0[r] = 0.f; } }
        { const int kt = 2 * s + 1;
          if (kt <= wave) { P1 = MFMA16(*(const bf16x8*)(KS + (16 * kt + c16) * 40 + 8 * g), qa, ((f32x4){0.f, 0.f, 0.f, 0.f}));
            if (kt == wave) {
#pragma unroll
                for (int r = 0; r < 4; ++r) if (4 * g + r > c16) P1[r] = 0.f; } }
          else P1 = (f32x4){0.f, 0.f, 0.f, 0.f}; }
        const bf16x8 pa = pack_p(P0, P1);
#pragma unroll
        for (int et = 0; et < 4; ++et) O[et] = MFMA16(pa, tr_frag(VS, 72, 32 * s + 4 * g, 32 * s + 16 + 4 * g, 16 * et, lane), O[et]); }
    float rs[4];
#pragma unroll
    for (int r = 0; r < 4; ++r) { float ss = O[0][r] * O[0][r] + O[1][r] * O[1][r] + O[2][r] * O[2][r] + O[3][r] * O[3][r];
#pragma unroll
        for (int o = 1; o < 16; o <<= 1) ss += __shfl_xor(ss, o);
        rs[r] = rsqrtf(ss * (1.0f / 64.0f) + NORM_EPS); }
#pragma unroll
    for (int et = 0; et < 4; ++et)
#pragma unroll
        for (int r = 0; r < 4; ++r) PWf[(4 * g + r) * 68 + 16 * et + c16] = O[et][r] * rs[r];
    LDS_WAIT();
#pragma unroll
    for (int i = 0; i < 2; ++i) { const int cidx = lane + 64 * i, row = cidx >> 3, oct = cidx & 7; const int t = 16 * wave + row;
        float gt[8]; unpack8f(gt, gate[i]);
        const f32x4 o0 = *(const f32x4*)(PWf + row * 68 + 8 * oct), o1 = *(const f32x4*)(PWf + row * 68 + 8 * oct + 4), n0 = *(const f32x4*)(ng + 8 * oct), n1 = *(const f32x4*)(ng + 8 * oct + 4);
        float o[8];
#pragma unroll
        for (int e = 0; e < 4; ++e) { o[e] = o0[e] * n0[e] * (gt[e] * sigmoidf_(gt[e])); o[4 + e] = o1[e] * n1[e] * (gt[4 + e] * sigmoidf_(gt[4 + e])); }
        *(u32x4*)(orow0 + (size_t)t * 1024 + ocol + 8 * oct) = pack8f(o); }
    LDS_WAIT();
}
__device__ __forceinline__ void gla_out_unit(KPRef p, int l, unsigned char* lds, int unit, const LaRegs& R, int tid) {
    const int c = unit & 63, h = (unit >> 6) & 3, b = unit >> 8;
    const size_t t0 = (size_t)b * S_ + (size_t)c * 128;
    gla_decay_front(p, l, lds, R.a, h, tid);
    const float* LA = (const float*)(lds + LA_LA); bf16_t* QS = (bf16_t*)(lds + LA_QS); bf16_t* KS = (bf16_t*)(lds + LA_KS); bf16_t* PS = (bf16_t*)(lds + LA_PS);
    { const int t = tid >> 2, oct = tid & 3; float k[8], q[8]; unpack8f(k, R.k[0]); unpack8f(q, R.q[0]);
#pragma unroll
      for (int e = 0; e < 8; ++e) { const float bb = LA[t * 33 + 8 * oct + e] * LOG2E; q[e] *= __builtin_amdgcn_exp2f(bb); k[e] *= __builtin_amdgcn_exp2f(-bb); }
      *(u32x4*)(QS + t * 40 + 8 * oct) = pack8f(q); *(u32x4*)(KS + t * 40 + 8 * oct) = pack8f(k); }
    la_stage_v(lds, R.v, tid);
    { const int row = tid >> 3, oct = tid & 7; float o[8] = {R.pv[0][0], R.pv[0][1], R.pv[0][2], R.pv[0][3], R.pv[1][0], R.pv[1][1], R.pv[1][2], R.pv[1][3]}; *(u32x4*)(PS + row * 72 + 8 * oct) = pack8f(o); }
    __syncthreads();
    la_out_mfma(lds, R.g, p.in[5] + l * 64, (bf16_t*)(p.ws + WS_O) + t0 * 1024, 0 + h * 64, 64, tid);
    __syncthreads();
}
__device__ __forceinline__ void rope_cs(float pos, float invf, float& c, float& s) {
    const float ang = pos * invf; const double t = (double)ang * 0.15915494309189535; const float fr = (float)(t - floor(t));
    c = __builtin_amdgcn_cosf(fr); s = __builtin_amdgcn_sinf(fr);
}
__device__ __forceinline__ void ret_cs_table(KPRef p, unsigned char* lds, int pos0, int tid) {
    f32x2* CS = (f32x2*)(lds + LA_LA);
#pragma unroll
    for (int i = 0; i < 4; ++i) { const int idx = tid + 512 * i, t = idx >> 4, f = idx & 15; float c, s; rope_cs((float)(pos0 + t), p.inv_freq[f], c, s); CS[idx] = (f32x2){c, s}; }
}
__device__ __forceinline__ void ret_rot8(const unsigned char* lds, const u32x4& own_q, const u32x4& oth_q, int t, int oct, float (&o)[8]) {
    const f32x2* CS = (const f32x2*)(lds + LA_LA); float own[8], oth[8]; unpack8f(own, own_q); unpack8f(oth, oth_q);
#pragma unroll
    for (int e = 0; e < 8; ++e) { const f32x2 cs = CS[t * 16 + 8 * (oct & 1) + e]; o[e] = (oct < 2) ? (own[e] * cs[0] - oth[e] * cs[1]) : (oth[e] * cs[1] + own[e] * cs[0]); }
}
__device__ __forceinline__ void ret_kv_unit(KPRef p, unsigned char* lds, int unit, const LaRegs& R, int tid) {
    const int n = unit & 63, bh = unit >> 6, h = bh & 3;
    ret_cs_table(p, lds, n * 128, tid);
    la_stage_v(lds, R.v, tid);
    __syncthreads();
    bf16_t* KD = (bf16_t*)(lds + LA_KD); const float lg = p.ret_lg2[h];
    { const int t = tid >> 2, oct = tid & 3; float k[8]; ret_rot8(lds, R.k[0], R.k[1], t, oct, k); const float dk = __builtin_amdgcn_exp2f((float)(127 - t) * lg);
#pragma unroll
      for (int e = 0; e < 8; ++e) k[e] *= dk;
      *(u32x4*)(KD + t * 40 + 8 * oct) = pack8f(k); }
    __syncthreads();
    la_kv_mfma(lds, (float*)(p.ws + WS_RKV) + (size_t)unit * 2048, 1, 128, tid);
    __syncthreads();
}
__device__ __forceinline__ void ret_out_unit(KPRef p, int l, unsigned char* lds, int unit, const LaRegs& R, int tid) {
    const int n = unit & 63, bh = unit >> 6, h = bh & 3, b = bh >> 2;
    const size_t t0 = (size_t)b * S_ + (size_t)n * 128;
    ret_cs_table(p, lds, n * 128, tid);
    la_stage_v(lds, R.v, tid);
    const float lg = p.ret_lg2[h]; bf16_t* PS = (bf16_t*)(lds + LA_PS); const float g1 = __builtin_amdgcn_exp2f(lg);
    if (tid < 256) { const int row = tid >> 3, oct = tid & 7;
      float o[8] = {R.pv[0][0] * g1, R.pv[0][1] * g1, R.pv[0][2] * g1, R.pv[0][3] * g1, R.pv[1][0] * g1, R.pv[1][1] * g1, R.pv[1][2] * g1, R.pv[1][3] * g1}; *(u32x4*)(PS + row * 72 + 8 * oct) = pack8f(o); }
    __syncthreads();
    bf16_t* QS = (bf16_t*)(lds + LA_QS); bf16_t* KS = (bf16_t*)(lds + LA_KS);
    { const int t = tid >> 2, oct = tid & 3; float k[8], q[8]; ret_rot8(lds, R.k[0], R.k[1], t, oct, k); ret_rot8(lds, R.q[0], R.q[1], t, oct, q);
      const float dq = __builtin_amdgcn_exp2f((float)t * lg), dk = __builtin_amdgcn_exp2f(-(float)t * lg);
#pragma unroll
      for (int e = 0; e < 8; ++e) { q[e] *= dq; k[e] *= dk; }
      *(u32x4*)(QS + t * 40 + 8 * oct) = pack8f(q); *(u32x4*)(KS + t * 40 + 8 * oct) = pack8f(k); }
    __syncthreads();
    la_out_mfma(lds, R.g, p.in[7] + l * 64, (bf16_t*)(p.ws + WS_O) + t0 * 1024, 768 + h * 64, 128, tid);
    __syncthreads();
}
template <int KIND>
__device__ __forceinline__ void la_loop(KPRef p, int l, unsigned char* lds, int wg, int tid) {
    constexpr bool OUT = KIND >= 2, GLA = (KIND & 1) == 0; constexpr int NU = 1024, G = 256;
    int u = wg; if (u >= NU) return;
    LaRegs R; la_load<OUT, GLA>(R, p, u, tid);
    for (;;) {
        const int un = u + G; const bool hn = un < NU;
        LaRegs Rn; if (hn) la_load<OUT, GLA>(Rn, p, un, tid);
        if (KIND == 0) gla_kv_unit(p, l, lds, u, R, tid); else if (KIND == 1) ret_kv_unit(p, lds, u, R, tid); else if (KIND == 2) gla_out_unit(p, l, lds, u, R, tid); else ret_out_unit(p, l, lds, u, R, tid);
        if (!hn) break;
        R = Rn; u = un;
    }
}

__device__ __forceinline__ void scan_phase(KPRef p, int wg, int tid) {
    if (wg < 64) {
        const int bh = wg >> 2, elem = (wg & 3) * 512 + tid, d = elem >> 6;
        float* base = (float*)(p.ws + WS_GKV) + (size_t)bh * 128 * 2048 + elem; const float* dec = (const float*)(p.ws + WS_GDEC) + (size_t)bh * 128 * 32 + d;
        float s = 0.f;
#pragma unroll 1
        for (int n0 = 0; n0 < 128; n0 += 32) { float kv[32], dc[32];
#pragma unroll
            for (int j = 0; j < 32; ++j) { kv[j] = base[(size_t)(n0 + j) * 2048]; dc[j] = dec[(n0 + j) * 32]; }
#pragma unroll
            for (int j = 0; j < 32; ++j) { base[(size_t)(n0 + j) * 2048] = s; s = dc[j] * s + kv[j]; } }
    } else if (wg < 128) {
        const int w2 = wg - 64, bh = w2 >> 2, h = bh & 3, elem = (w2 & 3) * 512 + tid;
        float* base = (float*)(p.ws + WS_RKV) + (size_t)bh * 64 * 2048 + elem; const float dc = __builtin_amdgcn_exp2f(128.0f * p.ret_lg2[h]);
        float s = 0.f;
#pragma unroll 1
        for (int n0 = 0; n0 < 64; n0 += 32) { float kv[32];
#pragma unroll
            for (int j = 0; j < 32; ++j) kv[j] = base[(size_t)(n0 + j) * 2048];
#pragma unroll
            for (int j = 0; j < 32; ++j) { base[(size_t)(n0 + j) * 2048] = s; s = dc * s + kv[j]; } }
    }
}

__device__ __forceinline__ void kmean_unit(KPRef p, float* sm, int unit, int tid) {
    const bf16_t* z = (const bf16_t*)(p.ws + WS_Z); const size_t t0 = (size_t)unit * 256;
    const int oct = tid & 31, grp = tid >> 5; float s[8] = {0.f, 0.f, 0.f, 0.f, 0.f, 0.f, 0.f, 0.f};
    u32x4 q[16];
#pragma unroll
    for (int i = 0; i < 16; ++i) q[i] = *(const u32x4*)(z + (t0 + grp * 16 + i) * ZW + Z_MK + 8 * oct);
#pragma unroll
    for (int i = 0; i < 16; ++i) { float v[8]; unpack8f(v, q[i]);
#pragma unroll
        for (int e = 0; e < 8; ++e) s[e] += v[e]; }
#pragma unroll
    for (int e = 0; e < 8; ++e) sm[grp * 264 + 8 * oct + e] = s[e];
    __syncthreads();
    if (tid < 256) { float a = 0.f;
#pragma unroll
        for (int g2 = 0; g2 < 16; ++g2) a += sm[g2 * 264 + tid];
        ((float*)(p.ws + WS_KMEAN))[(size_t)unit * 256 + tid] = a * (1.0f / 256.0f); }
    __syncthreads();
}

constexpr int AT_BUF = 65536  , AT_PW = 131072, AT_PW_WAVE = 2304, AT_WSF = 149504, LDS_MTAB = 151552;
__device__ __forceinline__ void att_dma(unsigned char* lds, int buf, const bf16_t* kg, const bf16_t* vg, int key_lo_valid, int tid) {
    const int lane = tid & 63, wave = __builtin_amdgcn_readfirstlane(tid >> 6);
#pragma unroll
    for (int i = 0; i < 4; ++i) { const int j = wave * 4 + i, row = 8 * j + (lane >> 3), pos = lane & 7; const int srow = row < key_lo_valid ? key_lo_valid : row;
        const size_t goff = (size_t)srow * ZW + 8 * (pos ^ (row & 7));
        __builtin_amdgcn_global_load_lds((const unsigned*)(kg + goff), (LAS unsigned*)(LAS unsigned char*)(lds + buf * AT_BUF + j * 1024), 16, 0, 0);
        __builtin_amdgcn_global_load_lds((const unsigned*)(vg + goff), (LAS unsigned*)(LAS unsigned char*)(lds + buf * AT_BUF + 32768 + j * 1024), 16, 0, 0); }
}
template <class Fn>
__device__ __forceinline__ void att_loadq(bf16x8 (&Q)[2][2], const Fn& F, int tid) {
    const int lane = tid & 63, wave = __builtin_amdgcn_readfirstlane(tid >> 6), c16 = lane & 15, g = lane >> 4;
#pragma unroll
    for (int rt = 0; rt < 2; ++rt) { const bf16_t* qp = F.rowptr(32 * wave + 16 * rt + c16); Q[rt][0] = *(const bf16x8*)(qp + 8 * g); Q[rt][1] = *(const bf16x8*)(qp + 32 + 8 * g); }
}
__device__ __forceinline__ bf16x8 tr_frag_sw(const unsigned char* tile, int rowa, int rowb, int col0, int lane) {
    const int i = lane & 15, q = i >> 2, pp = i & 3, ch = (col0 >> 3) + (pp >> 1), sub = (pp & 1) * 8, ra = rowa + q, rb = rowb + q;
    const v4i16_t lo = lds_tr16((const bf16_t*)(tile + ra * 128 + ((ch ^ (ra & 7)) << 4) + sub)), hi = lds_tr16((const bf16_t*)(tile + rb * 128 + ((ch ^ (rb & 7)) << 4) + sub));
    return (bf16x8){lo[0], lo[1], lo[2], lo[3], hi[0], hi[1], hi[2], hi[3]};
}
template <class Fn>
__device__ __forceinline__ void att_compute(unsigned char* lds, int buf, const Fn& F, bf16x8 (&Q)[2][2], const Fn& Fnext, bool has_next, int tid) {
    const int lane = tid & 63, wave = __builtin_amdgcn_readfirstlane(tid >> 6), c16 = lane & 15, g = lane >> 4;
    const unsigned char* KS = lds + buf * AT_BUF; const unsigned char* VS = KS + 32768; bf16_t* PW = (bf16_t*)(lds + AT_PW + wave * AT_PW_WAVE); float* WSF = (float*)(lds + AT_WSF + wave * 256);
#pragma unroll 1
    for (int rt = 0; rt < 2; ++rt) {
        const int rbase = 32 * wave + 16 * rt;
        const typename Fn::Pre pre = F.prefetch(rbase, lane);
        const bf16x8 qa0 = rt ? Q[1][0] : Q[0][0], qa1 = rt ? Q[1][1] : Q[0][1];
        f32x4 S[16]; float m = -1e30f;
#pragma unroll
        for (int ct = 0; ct < 16; ++ct) {
            if (F.live(rbase, ct)) {
                const int R = 16 * ct + c16; const unsigned char* kp = KS + R * 128;
                const bf16x8 k0 = *(const bf16x8*)(kp + ((g ^ (R & 7)) << 4)), k1 = *(const bf16x8*)(kp + (((4 + g) ^ (R & 7)) << 4));
                f32x4 acc = (f32x4){0.f, 0.f, 0.f, 0.f}; acc = MFMA16(k0, qa0, acc); acc = MFMA16(k1, qa1, acc);
                if (Fn::MASKED) {
#pragma unroll
                    for (int r = 0; r < 4; ++r) { int kk = 16 * ct + 4 * g + r; asm volatile("" : "+v"(kk), "+v"(acc[r]));
                        acc[r] += F.pen(rbase + c16, kk); } }
                m = fmaxf(fmaxf(m, fmaxf(acc[0], acc[1])), fmaxf(acc[2], acc[3])); S[ct] = acc;
            } else S[ct] = (f32x4){-1e30f, -1e30f, -1e30f, -1e30f};
        }
        m = fmaxf(m, __shfl_xor(m, 16)); m = fmaxf(m, __shfl_xor(m, 32));
        float l = 0.f;
#pragma unroll
        for (int ct = 0; ct < 16; ++ct) {
            if (F.live(rbase, ct)) {
#pragma unroll
                for (int r = 0; r < 4; ++r) { const float pr = __builtin_amdgcn_exp2f(S[ct][r] - m); S[ct][r] = pr; l += pr; }
            } else S[ct] = (f32x4){0.f, 0.f, 0.f, 0.f};
        }
        l += __shfl_xor(l, 16); l += __shfl_xor(l, 32);
        f32x4 O[4];
#pragma unroll
        for (int dt = 0; dt < 4; ++dt) O[dt] = (f32x4){0.f, 0.f, 0.f, 0.f};
#pragma unroll
        for (int s8 = 0; s8 < 8; ++s8) if (F.live(rbase, 2 * s8) || F.live(rbase, 2 * s8 + 1)) { const bf16x8 pa = pack_p(S[2 * s8], S[2 * s8 + 1]);
#pragma unroll
            for (int dt = 0; dt < 4; ++dt) O[dt] = MFMA16(pa, tr_frag_sw(VS, 32 * s8 + 4 * g, 32 * s8 + 16 + 4 * g, 16 * dt, lane), O[dt]); }
        if (rt == 1 && has_next) att_loadq(Q, Fnext, tid);
        float f[4];
#pragma unroll
        for (int r = 0; r < 4; ++r) { const float mr = __shfl(m, 4 * g + r), lr = __shfl(l, 4 * g + r); f[r] = F.scale(rbase + 4 * g + r, mr, lr, pre, r, WSF + (4 * g + r) * 4, c16 == 0); }
#pragma unroll
        for (int dt = 0; dt < 4; ++dt)
#pragma unroll
            for (int r = 0; r < 4; ++r) PW[(4 * g + r) * 72 + 16 * dt + c16] = (bf16_t)f2bf(O[dt][r] * f[r]);
        LDS_WAIT();
#pragma unroll
        for (int i = 0; i < 2; ++i) { const int ch = lane + 64 * i, row = ch >> 3, oct = ch & 7;
            const u32x4 v = *(const u32x4*)(PW + row * 72 + 8 * oct); F.store(rbase + row, oct, v, pre, i, WSF + row * 4); }
        LDS_WAIT();
    }
}
template <class Fn, class Gen>
__device__ __forceinline__ void attn_loop(unsigned char* lds, const Gen& G, int tid) {
    Fn Fc, Fx; const bf16_t* kg; const bf16_t* vg; int lo;
    bool have = G.get(0, Fc, kg, vg, lo);
    if (!have) return;
    bf16x8 Q[2][2];
    att_dma(lds, 0, kg, vg, lo, tid); att_loadq(Q, Fc, tid);
    int buf = 0;
    for (int i = 1; have; ++i) {
        asm volatile("s_waitcnt vmcnt(0)" ::: "memory");
        __syncthreads();
        const bool hn = G.get(i, Fx, kg, vg, lo);
        if (hn) att_dma(lds, buf ^ 1, kg, vg, lo, tid);
        att_compute(lds, buf, Fc, Q, Fx, hn, tid);
        Fc = Fx; have = hn; buf ^= 1;
    }
    asm volatile("s_waitcnt vmcnt(0)" ::: "memory");
    __syncthreads();
}
struct NoPre {};

struct SwaFn { typedef NoPre Pre; static constexpr bool MASKED = true;
    __device__ __forceinline__ bool live(int rbase, int ct) const { const int i0 = rbase & 127; return 16 * ct + 15 >= i0 + 1 && 16 * ct <= i0 + 143; } const bf16_t* z; bf16_t* ob; size_t tb; int q0, kvh; float sink2_0, sink2_1;
    __device__ __forceinline__ const bf16_t* rowptr(int row) const { return z + (tb + q0 + (row & 127)) * ZW + Z_SQ + (kvh * 2 + (row >> 7)) * 64; }
    __device__ __forceinline__ float pen(int row, int kk) const { const int d = (row & 127) + 128 - kk; return __int_as_float(((d | (127 - d) | (q0 - 128 + kk)) >> 31) & (int)0xF149F2CAu); }
    __device__ __forceinline__ NoPre prefetch(int, int) const { return NoPre{}; }
    __device__ __forceinline__ float scale(int row, float m, float l, const NoPre&, int, float*, bool) const { const float sk = (row >> 7) ? sink2_1 : sink2_0; const float M = fmaxf(m, sk), w0 = __builtin_amdgcn_exp2f(m - M);
        return w0 / (l * w0 + __builtin_amdgcn_exp2f(sk - M)); }
    __device__ __forceinline__ void store(int row, int oct, u32x4 v, const NoPre&, int, const float*) const { *(u32x4*)(ob + (tb + q0 + (row & 127)) * 1024 + 256 + (kvh * 2 + (row >> 7)) * 64 + 8 * oct) = v; }
};
struct SwaGen { const bf16_t* z; bf16_t* ob; const float* sinks; int wg, G;
    __device__ __forceinline__ bool get(int i, SwaFn& F, const bf16_t*& kg, const bf16_t*& vg, int& lo) const {
        const int unit = wg + i * G; if (unit >= 512) return false;
        const int qb = unit & 63, kvh = (unit >> 6) & 1, b = unit >> 7; const size_t tb = (size_t)b * S_; const int q0 = qb * 128;
        F = SwaFn{z, ob, tb, q0, kvh, sinks[kvh * 2] * LOG2E, sinks[kvh * 2 + 1] * LOG2E};
        const long kb = (long)tb + q0 - 128;
        kg = z + kb * ZW + Z_SK + kvh * 64; vg = z + kb * ZW + Z_SV + kvh * 64; lo = (q0 == 0) ? 128 : 0; return true; }
};

constexpr int ML_PER_BH = 126976;
__device__ __forceinline__ int ml_off(int j) { return 256 * (31 * j - (j * (j - 1)) / 2); }
__device__ __forceinline__ void moba_select(KPRef p, unsigned char* lds, int wg, int tid) {
    const int gid = wg * NTHREADS + tid, t = gid >> 2, h = gid & 3, b = t >> 13, tl = t & 8191, blk = tl >> 8;
    const bf16_t* z = (const bf16_t*)(p.ws + WS_Z);
    f32x4* kml = (f32x4*)lds; const f32x4* kmg = (const f32x4*)((const float*)(p.ws + WS_KMEAN) + (size_t)b * 32 * 256);
    for (int i = tid; i < blk * 64; i += NTHREADS) kml[i] = kmg[i];
    float q[64];
    { const bf16_t* qp = z + (size_t)t * ZW + Z_MQ + h * 64;
#pragma unroll
      for (int c = 0; c < 8; ++c) { const u32x4 kk = *(const u32x4*)(qp + 8 * c);
        q[8 * c + 0] = __uint_as_float(kk.x << 16); q[8 * c + 1] = __uint_as_float(kk.x & 0xffff0000u); q[8 * c + 2] = __uint_as_float(kk.y << 16); q[8 * c + 3] = __uint_as_float(kk.y & 0xffff0000u);
        q[8 * c + 4] = __uint_as_float(kk.z << 16); q[8 * c + 5] = __uint_as_float(kk.z & 0xffff0000u); q[8 * c + 6] = __uint_as_float(kk.w << 16); q[8 * c + 7] = __uint_as_float(kk.w & 0xffff0000u); } }
    __syncthreads();
    float v0 = -3e38f, v1 = -3e38f, v2 = -3e38f; int i0 = -1, i1 = -1, i2 = -1;
#pragma unroll 1
    for (int nb = 0; nb < blk; ++nb) { const f32x4* kr = kml + nb * 64 + h * 16; float s = 0.f;
#pragma unroll
        for (int c = 0; c < 16; ++c) { const f32x4 kv = kr[c]; s += q[4 * c] * kv[0] + q[4 * c + 1] * kv[1] + q[4 * c + 2] * kv[2] + q[4 * c + 3] * kv[3]; }
        if (s > v0) { v2 = v1; i2 = i1; v1 = v0; i1 = i0; v0 = s; i0 = nb; } else if (s > v1) { v2 = v1; i2 = i1; v1 = s; i1 = nb; } else if (s > v2) { v2 = s; i2 = nb; } }
    int* cnt = (int*)(p.ws + WS_MCNT) + (b * 4 + h) * 32; int* lst = (int*)(p.ws + WS_MLIST) + (size_t)(b * 4 + h) * ML_PER_BH; f32x2* pml = (f32x2*)(p.ws + WS_PARTML) + (size_t)gid * 3;
#pragma unroll
    for (int s3 = 0; s3 < 3; ++s3) { const int sb = (s3 == 0) ? i0 : (s3 == 1 ? i1 : i2);
        if (sb >= 0) { const int pos = atomicAdd(cnt + sb, 1); lst[ml_off(sb) + pos] = tl | (s3 << 13); }
        else pml[s3] = (f32x2){-1e30f, 0.f}; }
    __syncthreads();
}
struct MobaSelFn { typedef NoPre Pre; static constexpr bool MASKED = false;
    __device__ __forceinline__ bool live(int, int) const { return true; } const bf16_t* z; const int* lst; bf16_t* po; f32x2* pml; size_t tb; int h, n_valid;
    __device__ __forceinline__ int entry(int row) const { return lst[row < n_valid ? row : 0]; }
    __device__ __forceinline__ const bf16_t* rowptr(int row) const { return z + (tb + (entry(row) & 8191)) * ZW + Z_MQ + h * 64; }
    __device__ __forceinline__ float pen(int, int) const { return 0.f; }
    __device__ __forceinline__ NoPre prefetch(int, int) const { return NoPre{}; }
    __device__ __forceinline__ size_t pidx(int e) const { return ((tb + (e & 8191)) * 4 + h) * 3 + (e >> 13); }
    __device__ __forceinline__ float scale(int row, float m, float l, const NoPre&, int, float*, bool writer) const { if (writer && row < n_valid) pml[pidx(lst[row])] = (f32x2){m, l}; return 1.0f / l; }
    __device__ __forceinline__ void store(int row, int oct, u32x4 v, const NoPre&, int, const float*) const { if (row < n_valid) *(u32x4*)(po + pidx(lst[row]) * 64 + 8 * oct) = v; }
};
__device__ __forceinline__ void moba_sel_table(KPRef p, unsigned char* lds, int tid) {
    int* tab = (int*)(lds + LDS_MTAB); const int lane = tid & 63, wave = tid >> 6;
    const int cnt = ((const int*)(p.ws + WS_MCNT))[tid]; int v = (cnt + 255) >> 8;
    const int own = v;
#pragma unroll
    for (int o = 1; o < 64; o <<= 1) { const int t = __shfl_up(v, o); if (lane >= o) v += t; }
    if (lane == 63) tab[520 + wave] = v;
    __syncthreads();
    int base = 0;
    for (int w = 0; w < wave; ++w) base += tab[520 + w];
    tab[tid] = base + v - own;
    tab[544 + tid] = cnt;
    if (tid == 511) tab[512] = base + v;
    __syncthreads();
}
struct MobaSelGen { const bf16_t* z; const int* lists; const int* cnts; bf16_t* po; f32x2* pml; const int* tab; int wg, G;
    __device__ __forceinline__ bool get(int i, MobaSelFn& F, const bf16_t*& kg, const bf16_t*& vg, int& lo) const {
        const int u = wg + i * G; if (u >= tab[512]) return false;
        int lo_ = 0, hi_ = 511;
        while (lo_ < hi_) { const int mid = (lo_ + hi_ + 1) >> 1; if (tab[mid] <= u) lo_ = mid; else hi_ = mid - 1; }
        const int k = __builtin_amdgcn_readfirstlane(lo_), c = u - tab[k], bh = k >> 5, j = k & 31, b = bh >> 2, h = bh & 3;
        const int cnt = tab[544 + k]; const int nv = cnt - c * 256; const size_t tb = (size_t)b * S_;
        F = MobaSelFn{z, lists + (size_t)bh * ML_PER_BH + ml_off(j) + c * 256, po, pml, tb, h, nv < 256 ? nv : 256};
        kg = z + (tb + j * 256) * ZW + Z_MK + h * 64; vg = z + (tb + j * 256) * ZW + Z_MV + h * 64; lo = 0; return true; }
};
struct MobaOwnFn { typedef NoPre Pre; static constexpr bool MASKED = true;
    __device__ __forceinline__ bool live(int rbase, int ct) const { return 16 * ct <= rbase + 15; } const bf16_t* z; bf16_t* ob; const bf16_t* po; const f32x2* pml; size_t t0; int h;
    __device__ __forceinline__ const bf16_t* rowptr(int row) const { return z + (t0 + row) * ZW + Z_MQ + h * 64; }
    __device__ __forceinline__ float pen(int row, int kk) const { return __int_as_float(((row - kk) >> 31) & (int)0xF149F2CAu); }
    __device__ __forceinline__ NoPre prefetch(int, int) const { return NoPre{}; }
    __device__ __forceinline__ float scale(int row, float m, float l, const NoPre&, int, float* wsf, bool writer) const {
        const f32x2* ml = pml + ((t0 + row) * 4 + h) * 3; const f32x2 a = ml[0], b = ml[1], c = ml[2];
        const float M = fmaxf(fmaxf(m, a[0]), fmaxf(b[0], c[0]));
        const float w0 = __builtin_amdgcn_exp2f(m - M), wa = a[1] * __builtin_amdgcn_exp2f(a[0] - M), wb = b[1] * __builtin_amdgcn_exp2f(b[0] - M), wc = c[1] * __builtin_amdgcn_exp2f(c[0] - M);
        const float inv = 1.0f / (l * w0 + wa + wb + wc);
        if (writer) { wsf[0] = wa * inv; wsf[1] = wb * inv; wsf[2] = wc * inv; }
        return w0 * inv; }
    __device__ __forceinline__ void store(int row, int oct, u32x4 v, const NoPre&, int, const float* wsf) const {
        float o[8]; unpack8f(o, v); const bf16_t* pr = po + (((t0 + row) * 4 + h) * 3) * 64 + 8 * oct;
        u32x4 pc[3];
#pragma unroll
        for (int s = 0; s < 3; ++s) pc[s] = (wsf[s] != 0.f) ? *(const u32x4*)(pr + s * 64) : (u32x4){0u, 0u, 0u, 0u};
#pragma unroll
        for (int s = 0; s < 3; ++s) { const float w = wsf[s]; float q[8]; unpack8f(q, pc[s]);
#pragma unroll
            for (int e = 0; e < 8; ++e) o[e] += w * q[e]; }
        *(u32x4*)(ob + (t0 + row) * 1024 + 512 + h * 64 + 8 * oct) = pack8f(o); }
};
struct MobaOwnGen { const bf16_t* z; bf16_t* ob; const bf16_t* po; const f32x2* pml; int wg, G;
    __device__ __forceinline__ bool get(int i, MobaOwnFn& F, const bf16_t*& kg, const bf16_t*& vg, int& lo) const {
        const int unit = wg + i * G; if (unit >= 512) return false;
        const int qb = unit & 31, h = (unit >> 5) & 3, b = unit >> 7; const size_t t0 = (size_t)b * S_ + (size_t)qb * 256;
        F = MobaOwnFn{z, ob, po, pml, t0, h}; kg = z + t0 * ZW + Z_MK + h * 64; vg = z + t0 * ZW + Z_MV + h * 64; lo = 0; return true; }
};

__device__ __forceinline__ void route_phase(KPRef p, int l, float* sm, int wg, int tid) {
    int* se = (int*)sm;
    int* toke = (int*)(p.ws + WS_TOKE); float* tokw = (float*)(p.ws + WS_TOKW); int* tokr = (int*)(p.ws + WS_TOKR); int* hist = (int*)(p.ws + WS_HIST); int* sdst = (int*)(p.ws + WS_SDST);
    if (tid < 128) { const int t = wg * 128 + tid; const float* lg = (const float*)(p.ws + WS_LOGIT) + (size_t)t * 64; const float* bg = p.in[12] + l * 4; const float* be = p.in[14] + l * 32;
        float g0 = lg[0] + bg[0], g1 = lg[1] + bg[1], g2 = lg[2] + bg[2], g3 = lg[3] + bg[3];
        int gs = 0; float gm = g0; if (g1 > gm) { gm = g1; gs = 1; } if (g2 > gm) { gm = g2; gs = 2; } if (g3 > gm) { gm = g3; gs = 3; }
        const float gw_ = 1.0f / (expf(g0 - gm) + expf(g1 - gm) + expf(g2 - gm) + expf(g3 - gm));
        float v0 = -3e38f, v1 = -3e38f; int i0 = 0, i1 = 0;
#pragma unroll
        for (int j = 0; j < 8; ++j) { const float s = lg[4 + 8 * gs + j] + be[8 * gs + j]; if (s > v0) { v1 = v0; i1 = i0; v0 = s; i0 = j; } else if (s > v1) { v1 = s; i1 = j; } }
        const float e1 = expf(v1 - v0), w0 = 1.0f / (1.0f + e1), w1 = e1 * w0;
        const int ea = 8 * gs + i0, eb = 8 * gs + i1;
        se[2 * tid] = ea; se[2 * tid + 1] = eb; toke[2 * t] = ea; toke[2 * t + 1] = eb; tokw[2 * t] = w0 * gw_; tokw[2 * t + 1] = w1 * gw_; }
    __syncthreads();
    if (tid < 256) { const int e = se[tid]; int r = 0;
#pragma unroll 4
        for (int a = 0; a < tid; ++a) r += (se[a] == e) ? 1 : 0; tokr[wg * 256 + tid] = r; }
    if (tid >= 256 && tid < 288) { const int e = tid - 256; int c = 0;
#pragma unroll 4
        for (int a = 0; a < 256; ++a) c += (se[a] == e) ? 1 : 0; hist[wg * 32 + e] = c; }
    for (int i = tid; i < NSLOTBLK; i += NTHREADS) sdst[wg * NSLOTBLK + i] = YS_TRASH_ROW;
    __syncthreads();
}
__device__ __forceinline__ void assign_phase(KPRef p, float* sm, int wg, int tid, int wave, int lane) {
    int* cnt = (int*)sm, *bas = cnt + 32, *pend = cnt + 64, *slot_of = cnt + 128;
    const int* hist = (const int*)(p.ws + WS_HIST); const int* toke = (const int*)(p.ws + WS_TOKE); const int* tokr = (const int*)(p.ws + WS_TOKR);
    int* sdst = (int*)(p.ws + WS_SDST); int* blke = (int*)(p.ws + WS_BLKE);
    {
        int* part = cnt + 512;
        const int e = tid & 31, grp = tid >> 5; int c = 0, bb = 0; int v[16];
#pragma unroll
        for (int i = 0; i < 16; ++i) v[i] = hist[(grp * 16 + i) * 32 + e];
#pragma unroll
        for (int i = 0; i < 16; ++i) { c += v[i]; if (grp * 16 + i < wg) bb += v[i]; }
        part[grp * 64 + e] = c; part[grp * 64 + 32 + e] = bb;
        __syncthreads();
        if (tid < 32) { int cs = 0, bs = 0;
#pragma unroll
            for (int g2 = 0; g2 < 16; ++g2) { cs += part[g2 * 64 + tid]; bs += part[g2 * 64 + 32 + tid]; }
            cnt[tid] = cs; bas[tid] = bs; }
    }
    __syncthreads();
    if (tid == 0) { int run = 0; for (int e = 0; e < 32; ++e) { const int pad = ((cnt[e] + 255) >> 8) << 8; bas[e] += run; run += pad; pend[e] = run; } }
    __syncthreads();
    if (wg == 0) { if (tid < NSLOTBLK) { int e = 0; for (int k = 0; k < 32; ++k) e += (pend[k] <= tid * 256) ? 1 : 0; blke[tid] = e > 31 ? 31 : e; } if (tid == 0) blke[511] = pend[31] >> 8; }
    if (tid < 256) { const int a = wg * 256 + tid; const int e = toke[a]; const int slot = bas[e] + tokr[a]; sdst[slot] = a; slot_of[tid] = slot; }
    __syncthreads();
    const float* su = (const float*)(p.ws + WS_SU); float* xss = (float*)(p.ws + WS_XSS);
    if (tid < 256) xss[slot_of[tid]] = su[wg * 128 + (tid >> 1)];
    __syncthreads();
}

#ifndef MK_PER_PHASE
#define MK_PER_PHASE 0
#endif
constexpr int PH_PER_LAYER = 18, N_PHASES = DEPTH_ * PH_PER_LAYER + 1;
constexpr int CW_BAR = 1024;

__global__ void __launch_bounds__(NTHREADS, 2) mega(Params p_unused) {
    extern __shared__ __attribute__((aligned(16))) unsigned char lds[];
    const int tid0 = threadIdx.x;
    constexpr int G = 256, NGW = G * NWAVES;
    const int wg = blockIdx.x;
#define SUB_BEGIN() KPRef p = *KP(); unsigned char* ws = p.ws; (void)ws; int tid = threadIdx.x; asm volatile("" : "+v"(tid))
#define PHASE_BEGIN() KPRef p = *KP(); unsigned char* ws = p.ws; (void)ws; unsigned char* wl = (l == 0) ? p.ws : (unsigned char*)p.out; (void)wl; const size_t sl = (size_t)l * SW_LSTEP; (void)sl; int tid = threadIdx.x; asm volatile("" : "+v"(tid)); const int lane = tid & 63, wave = __builtin_amdgcn_readfirstlane(tid >> 6), gw = wg * NWAVES + wave; (void)lane; (void)gw
    volatile LAS unsigned* MISC = (volatile LAS unsigned*)((LAS unsigned char*)lds + MISC_OFF);
    for (int u = tid0; u < (LDS_BYTES - LDSCTL_OFF) / 4; u += NTHREADS) ((LAS unsigned*)((LAS unsigned char*)lds + LDSCTL_OFF))[u] = 0u;
    __syncthreads();
#define KP() ({ const __attribute__((address_space(4))) Params* _k = (const __attribute__((address_space(4))) Params*)__builtin_amdgcn_kernarg_segment_ptr(); asm volatile("" : "+s"(_k)); _k; })
    unsigned* ctl; { const __attribute__((address_space(4))) Params* k0 = KP(); ctl = (unsigned*)(k0->ws + WS_CTL); }
    XcdBarrier bar = xcd_barrier_post(ctl + CW_BAR, MISC + 8);
    int lo, hi; { const __attribute__((address_space(4))) Params* k0 = KP(); lo = k0->ph_lo; hi = k0->ph_hi; }
    float* sm = (float*)lds;
    PG8_LAS unsigned char* ring = (PG8_LAS unsigned char*)lds;
#ifndef PH_MASK
#define PH_MASK 0x7ffffu
#endif
#define IN(k) ((((PH_MASK) >> ((k) == DEPTH_ * PH_PER_LAYER ? 18 : ((k) % PH_PER_LAYER))) & 1u) && lo <= (k) && (k) < hi)
#define SEAM(k) do { if ((k) + 1 < hi) xcd_barrier(bar); } while (0)
#ifndef REPEAT_MASK
#define REPEAT_MASK 0u
#endif
#ifndef URM
#define URM 0u
#endif
#define UREP(bit) for (int ur_ = 0; ur_ < ((((URM) >> (bit)) & 1u) ? 2 : 1); ++ur_)
#ifndef REPEAT_L0
#define REPEAT_L0 0u
#endif
#define NREP(k) (((((REPEAT_MASK) >> ((k) % PH_PER_LAYER)) & 1u) || ((((REPEAT_L0) >> ((k) % PH_PER_LAYER)) & 1u) && (k) < PH_PER_LAYER)) ? 2 : 1)

    for (int l = 0; l < DEPTH_; ++l) {
        const int P0 = l * PH_PER_LAYER;
        if (IN(P0 + 0)) for (int rep_ = 0; rep_ < NREP(P0 + 0); ++rep_) { PHASE_BEGIN();
            if (l == 0) { UREP(8) { conv8_pass<0>(p, 0, ws, lds, gw, NGW, wave, lane); conv8_pass<0>(p, 1, ws, lds, gw, NGW, wave, lane); } }
            if (l == 0) norm_phase<0>(p, l, gw, NGW, lane); else norm_phase<1>(p, l, gw, NGW, lane);
            SEAM(P0 + 0);
        }
        if (l == 0 && IN(P0 + 1)) for (int rep_ = 0; rep_ < NREP(P0 + 1); ++rep_) { PHASE_BEGIN();
            conv8_pass<1>(p, 0, ws, lds, gw, NGW, wave, lane);
            conv_phase(p, 0, ws, lds, gw, NGW, wave, lane);
            SEAM(P0 + 1);
        }
        if (IN(P0 + 2)) for (int rep_ = 0; rep_ < NREP(P0 + 2); ++rep_) { PHASE_BEGIN();
            pg8::Gemm g{(const bf16_t*)(ws + WS_U8), (const bf16_t*)(wl + WS_WIN)};
            pg8::StaticOrder<T_ / 256, ZW / 256, 1024, 1024> S{G, wg, 0};
            pg8::EpiBf16S E{(bf16_t*)(ws + WS_Z), ZW, (const float*)(ws + WS_SU), (const float*)(ws + WS_SWIN + sl)};
            pg8::gemm_phase<1024, 1024, 1024, true, true>(ring, g, S, E);
            SEAM(P0 + 2);
        }
        if (IN(P0 + 3)) for (int rep_ = 0; rep_ < NREP(P0 + 3); ++rep_) { PHASE_BEGIN();
            if (wg == 0) { int* cnt = (int*)(ws + WS_MCNT); cnt[tid] = 0; }
            UREP(0) { SUB_BEGIN(); la_loop<0>(p, l, lds, wg, tid); }
            UREP(1) { SUB_BEGIN(); la_loop<1>(p, l, lds, wg, tid); }
            UREP(2) { SUB_BEGIN(); for (int u = wg; u < 128; u += G) kmean_unit(p, sm, u, tid); }
            UREP(3) { SUB_BEGIN(); SwaGen SG{(const bf16_t*)(ws + WS_Z), (bf16_t*)(ws + WS_O), p.in[6] + l * 4, wg, G}; attn_loop<SwaFn>(lds, SG, tid); }
            SEAM(P0 + 3);
        }
        if (IN(P0 + 4)) for (int rep_ = 0; rep_ < NREP(P0 + 4); ++rep_) { PHASE_BEGIN(); moba_select(p, lds, wg, tid); { const int s = ((wg & 63) < 32) ? (wg >> 6) * 32 + (wg & 31) : 255; scan_phase(p, s, tid); }   SEAM(P0 + 4); }
        if (IN(P0 + 5)) for (int rep_ = 0; rep_ < NREP(P0 + 5); ++rep_) { PHASE_BEGIN();
            UREP(4) { SUB_BEGIN(); la_loop<2>(p, l, lds, wg, tid); }
            UREP(5) { SUB_BEGIN(); la_loop<3>(p, l, lds, wg, tid); }
            UREP(6) { SUB_BEGIN(); moba_sel_table(p, lds, tid); MobaSelGen MG{(const bf16_t*)(ws + WS_Z), (const int*)(ws + WS_MLIST), (const int*)(ws + WS_MCNT), (bf16_t*)(ws + WS_PARTO), (f32x2*)(ws + WS_PARTML), (const int*)(lds + LDS_MTAB), wg, G}; attn_loop<MobaSelFn>(lds, MG, tid); }
            SEAM(P0 + 5);
        }
        if (IN(P0 + 6)) for (int rep_ = 0; rep_ < NREP(P0 + 6); ++rep_) { PHASE_BEGIN();
            UREP(7) { SUB_BEGIN(); MobaOwnGen OG{(const bf16_t*)(ws + WS_Z), (bf16_t*)(ws + WS_O), (const bf16_t*)(ws + WS_PARTO), (const f32x2*)(ws + WS_PARTML), wg, G}; attn_loop<MobaOwnFn>(lds, OG, tid); }
            SEAM(P0 + 6);
        }
        for (int hf = 0; hf < 2; ++hf) {
            if (IN(P0 + 7 + 2 * hf)) for (int rep_ = 0; rep_ < NREP(P0 + 7 + 2 * hf); ++rep_) { PHASE_BEGIN();
                pg8::Gemm g{(const bf16_t*)(ws + WS_O), (const bf16_t*)(wl + WS_WB)};
                pg8::StaticOrder<T_ / 512, 16, 2048, 512, 2, 512> S{G, wg, 64 * hf};
                pg8::EpiBf16 E{(bf16_t*)(ws + WS_YH), 4096, 16384 * hf};
                pg8::gemm_phase<2048, 512, 512, false>(ring, g, S, E);
                SEAM(P0 + 7 + 2 * hf);
            }
            if (IN(P0 + 8 + 2 * hf)) for (int rep_ = 0; rep_ < NREP(P0 + 8 + 2 * hf); ++rep_) { PHASE_BEGIN();
                pg8::Gemm g{(const bf16_t*)(ws + WS_U8), (const bf16_t*)(wl + WS_WG)};
                pg8::StaticOrder<T_ / 512, 16, 1024, 1024> S{G, wg, 64 * hf};
                pg8::EpiGate E{(const bf16_t*)(ws + WS_YH), 16384 * hf, (bf16_t*)(ws + WS_O), (const float*)(ws + WS_SU), (const float*)(ws + WS_SWG + sl)};
                pg8::gemm_phase<1024, 1024, 1024, true, true>(ring, g, S, E);
                SEAM(P0 + 8 + 2 * hf);
            }
        }
        if (IN(P0 + 11)) for (int rep_ = 0; rep_ < NREP(P0 + 11); ++rep_) { PHASE_BEGIN();
            pg8::Gemm g{(const bf16_t*)(ws + WS_O), (const bf16_t*)(wl + WS_WO)};
            pg8::StaticOrder<T_ / 256, 4, 2048, 2048> S{G, wg, 0};
            if (l == 0) { pg8::EpiRes<true> E{(const void*)p.in[0], hbf_ptr(p)}; pg8::gemm_phase<2048, 2048, 2048, false>(ring, g, S, E); }
            else { pg8::EpiRes<false> E{(const void*)hbf_ptr(p), hbf_ptr(p)}; pg8::gemm_phase<2048, 2048, 2048, false>(ring, g, S, E); }
            SEAM(P0 + 11);
        }
        if (IN(P0 + 12)) for (int rep_ = 0; rep_ < NREP(P0 + 12); ++rep_) { PHASE_BEGIN(); norm_phase<2>(p, l, gw, NGW, lane); SEAM(P0 + 12); }
        if (IN(P0 + 13)) for (int rep_ = 0; rep_ < NREP(P0 + 13); ++rep_) { PHASE_BEGIN();
            pg8::Gemm g{(const bf16_t*)(ws + WS_U2BF), (const bf16_t*)(wl + WS_WR)};
            pg8::StaticOrder<T_ / 256, 1, 2048, 2048> S{G, wg, 0};
            pg8::EpiRouter E{(float*)(ws + WS_LOGIT)};
            pg8::gemm_phase<2048, 2048, 2048, false>(ring, g, S, E);
            if (l == 0 && wg >= 128) { const int gw2 = (wg - 128) * NWAVES + wave; unsigned char* w1 = (unsigned char*)p.out;
                conv8_pass<1>(p, 1, w1, lds, gw2, 128 * NWAVES, wave, lane); conv_phase(p, 1, w1, lds, gw2, 128 * NWAVES, wave, lane); }
            SEAM(P0 + 13);
        }
        if (IN(P0 + 14)) for (int rep_ = 0; rep_ < NREP(P0 + 14); ++rep_) { PHASE_BEGIN(); route_phase(p, l, sm, wg, tid); SEAM(P0 + 14); }
        if (IN(P0 + 15)) for (int rep_ = 0; rep_ < NREP(P0 + 15); ++rep_) { PHASE_BEGIN(); assign_phase(p, sm, wg, tid, wave, lane); SEAM(P0 + 15); }
        if (IN(P0 + 16)) for (int rep_ = 0; rep_ < NREP(P0 + 16); ++rep_) { PHASE_BEGIN();
            const int* blke = (const int*)(ws + WS_BLKE); const int nb = __builtin_amdgcn_readfirstlane(blke[511]);
            pg8::Gemm g{(const bf16_t*)(ws + WS_U8), (const bf16_t*)(wl + WS_E1)};
            pg8::MoeOrder<2, true> S{blke, nb, G, wg, (size_t)0, (size_t)256 * 1024, (size_t)512 * 1024, (const int*)(ws + WS_SDST)};
            pg8::EpiE1 E{(bf16_t*)(ws + WS_HDN), (const float*)(ws + WS_XSS), (const float*)(ws + WS_SWE1 + sl), blke};
            pg8::gemm_phase<1024, 1024, 1024, true, true>(ring, g, S, E);
            SEAM(P0 + 16);
        }
        if (IN(P0 + 17)) for (int rep_ = 0; rep_ < NREP(P0 + 17); ++rep_) { PHASE_BEGIN();
            const int* blke = (const int*)(ws + WS_BLKE); const int nb = __builtin_amdgcn_readfirstlane(blke[511]);
            pg8::Gemm g{(const bf16_t*)(ws + WS_HDN), (const bf16_t*)(wl + WS_E2)};
            pg8::MoeOrder<4> S{blke, nb, G, wg, (size_t)256 * 256 * 2, (size_t)256 * 256 * 2, (size_t)1024 * 256 * 2, nullptr};
            pg8::EpiE2 E{(bf16_t*)(ws + WS_YS), (const int*)(ws + WS_SDST)};
            pg8::gemm_phase<512, 512, 512, false>(ring, g, S, E);
            SEAM(P0 + 17);
        }
    }
    if (IN(DEPTH_ * PH_PER_LAYER)) { constexpr int l = 0; PHASE_BEGIN(); FinalHold Hd; final_a(p, gw, NGW, lane, Hd); xcd_barrier(bar); final_b(p, gw, lane, Hd); }
#undef IN
#undef SEAM
}

extern "C" void kernel_launch(void* const* d_in, const int* in_sizes, int n_in, void* d_out, int out_size, void* d_ws, size_t ws_size, hipStream_t stream) {
    static int grid = 0;
    if (grid == 0) {
        if (n_in != 19 || out_size != T_ * D_ || ws_size < WS_END) { fprintf(stderr, "kernel_launch: unexpected shapes (n_in %d, out %d, ws %zu); nothing launched\n", n_in, out_size, ws_size); grid = -1; return; }
        int dev = 0, cus = 0;
        if (hipGetDevice(&dev) != hipSuccess || hipDeviceGetAttribute(&cus, hipDeviceAttributeMultiprocessorCount, dev) != hipSuccess) { grid = -1; return; }
        if (hipFuncSetAttribute((const void*)mega, hipFuncAttributeMaxDynamicSharedMemorySize, LDS_BYTES) != hipSuccess) { fprintf(stderr, "kernel_launch: hipFuncSetAttribute failed\n"); grid = -1; return; }
        int per_cu = 0;
        if (hipOccupancyMaxActiveBlocksPerMultiprocessor(&per_cu, (const void*)mega, NTHREADS, LDS_BYTES) != hipSuccess || per_cu < 1) { fprintf(stderr, "kernel_launch: occupancy query reports %d blocks per CU\n", per_cu); }
        (void)hipGetLastError();
        if (cus != 256) { fprintf(stderr, "kernel_launch: built for a 256-CU device (got %d); nothing launched\n", cus); grid = -1; return; }
        grid = cus;
    }
    if (grid <= 0) return;
    Params p{};
    for (int i = 0; i < 19; ++i) p.in[i] = (const float*)d_in[i];
    p.out = (float*)d_out; p.ws = (unsigned char*)d_ws;
    for (int f = 0; f < 16; ++f) p.inv_freq[f] = (float)std::pow(10000.0, -(double)f / 16.0);
    for (int h = 0; h < 4; ++h) p.ret_lg2[h] = (float)std::log2(1.0 - std::exp2(-5.0 - (double)h));
    hipMemsetAsync((unsigned char*)d_ws + WS_CTL, 0, CTL_BYTES, stream);
#if MK_PER_PHASE
    for (int ph = 0; ph < N_PHASES; ++ph) { p.ph_lo = ph; p.ph_hi = ph + 1; hipLaunchKernelGGL(mega, dim3(grid), dim3(NTHREADS), LDS_BYTES, stream, p); }
#else
    p.ph_lo = 0; p.ph_hi = N_PHASES;
    hipLaunchKernelGGL(mega, dim3(grid), dim3(NTHREADS), LDS_BYTES, stream, p);
#endif
}
```

```cpp
#include <hip/hip_runtime.h>
#include <cstdio>
#include <cstdint>
#include <cmath>

#define LAS __attribute__((address_space(3)))
#define GAS __attribute__((address_space(1)))
typedef unsigned short bf16_t;
typedef short bf16x8 __attribute__((ext_vector_type(8)));
typedef float f32x4 __attribute__((ext_vector_type(4)));
typedef float f32x2 __attribute__((ext_vector_type(2)));
typedef unsigned u32x4 __attribute__((ext_vector_type(4)));
typedef unsigned u32x2 __attribute__((ext_vector_type(2)));
typedef int i32x4 __attribute__((ext_vector_type(4)));
__device__ __forceinline__ f32x4 tof(const f32x4& v) { return v; }
__device__ __forceinline__ f32x4 tof(const i32x4& v) { return __builtin_convertvector(v, f32x4); }

constexpr int T_ = 32768, D_ = 1024, S_ = 8192, NBATCH = 4, DEPTH_ = 2;
constexpr int ZW = 3072;
constexpr int Z_GQ = 0, Z_GK = 128, Z_GV = 256, Z_GR = 512, Z_GA = 768, Z_SQ = 784, Z_SK = 1040, Z_SV = 1168, Z_MQ = 1296, Z_MK = 1552, Z_MV = 1808,
              Z_RQ = 2064, Z_RK = 2192, Z_RV = 2320, Z_RG = 2576, Z_GATE = 2832, IN_W = 6928;
constexpr float LOG2E = 1.4426950408889634f;
constexpr float C2 = 0.125f * 1.4426950408889634f;
constexpr float RSQ32 = 0.17677669529663687f;
constexpr float NORM_EPS = 1e-6f;
constexpr int NEXP = 32, EHID = 256, MOE_BLK = 256, NSLOTBLK = 288, NSLOT = NSLOTBLK * MOE_BLK;

constexpr size_t MiB = 1u << 20;
constexpr size_t WS_WIN = 0, WS_WG = 3 * MiB, WS_WB = 7 * MiB, WS_WO = 9 * MiB, WS_WR = 11 * MiB, WS_E1 = 12 * MiB, WS_E2 = 28 * MiB;
constexpr size_t WS_YS = 68 * MiB;
constexpr size_t WS_GKV = 68 * MiB, WS_RKV = 84 * MiB, WS_GDEC = 92 * MiB, WS_KMEAN = 93 * MiB, WS_O = 108 * MiB;
constexpr size_t WS_U8 = 197 * MiB;
constexpr size_t WS_SU = 229 * MiB, WS_XSS = WS_SU + 256 * 1024;
constexpr size_t WS_SWIN = 230 * MiB, WS_SWG = WS_SWIN + 16 * 1024, WS_SWE1 = WS_SWG + 16 * 1024;
constexpr size_t WS_Z = 261 * MiB;
constexpr size_t WS_YH = 261 * MiB;
constexpr size_t WS_U2BF = 261 * MiB;
constexpr size_t WS_XS = 325 * MiB, WS_HDN = 397 * MiB;
constexpr size_t WS_LOGIT = 453 * MiB;
constexpr size_t WS_TOKE = 461 * MiB, WS_TOKW = WS_TOKE + 256 * 1024, WS_TOKR = WS_TOKW + 256 * 1024, WS_HIST = WS_TOKR + 256 * 1024,
                 WS_SDST = WS_HIST + 64 * 1024, WS_BLKE = WS_SDST + 512 * 1024;
constexpr size_t WS_MLIST = 94 * MiB, WS_MCNT = 102 * MiB;
constexpr size_t WS_PARTO = 453 * MiB, WS_PARTML = 501 * MiB;
constexpr size_t WS_CTL = 511 * MiB, CTL_BYTES = 256 * 1024;
constexpr size_t WS_SWRAW = WS_CTL + 64 * 1024, SWRAW_LSTEP = 96 * 1024;
constexpr size_t SW_LSTEP = 128 * 1024;
constexpr size_t WS_END = 512 * MiB;
constexpr int YS_TRASH_ROW = 2 * T_;

__device__ __forceinline__ float bf2f(bf16_t v) { return __uint_as_float(((unsigned)v) << 16); }
__device__ __forceinline__ unsigned f2bf(float f) { unsigned u = __float_as_uint(f); return (u + 0x7fffu + ((u >> 16) & 1u)) >> 16; }
__device__ __forceinline__ unsigned pk2(float lo, float hi) { return f2bf(lo) | (f2bf(hi) << 16); }
__device__ __forceinline__ float sigmoidf_(float x) { return __builtin_amdgcn_rcpf(1.0f + __builtin_amdgcn_exp2f(-x * LOG2E)); }

namespace pg8 {
#define PG8_LAS __attribute__((address_space(3)))
constexpr int BM = 256, BK = 64, HALF = 128, HTB = HALF * BK * 2  , STAGE_BYTES = 8 * HTB, NXCD = 8, WGM = 8;

__host__ __device__ __forceinline__ int lds_byte(int r, int c) { const int st = (r >> 4) * 2 + (c >> 5), rr = r & 15, cc = c & 31, ob = rr * 64 + cc * 2; return st * 1024 + (ob ^ (((ob >> 9) & 1) << 5)); }
__host__ __device__ __forceinline__ void stage_rc(int b, int& R, int& C) { const int st = b / 1024, sb = b % 1024, swz = sb ^ (((sb >> 9) & 1) << 5); R = (st >> 1) * 16 + swz / 64; C = (st & 1) * 32 + (swz % 64) / 2; }
__host__ __device__ __forceinline__ int perm32(int rho) { const int n = rho >> 4, i = rho & 15; return 8 * (i >> 2) + 4 * n + (i & 3); }

struct Unit { int pm, pn; size_t aoff, boff; };
struct Gemm { const bf16_t* A; const bf16_t* Bt; };

template <int NM, int NN, int LDAB  , int LDBB, int A_SHIFT = 30, int A_MUL = 0> struct StaticOrder {
    static constexpr bool GATHER = false;
    int G, c, pm_base;
    __device__ bool next(int i, Unit& u) const {
        constexpr int nwg = NM * NN; const int L = i * G + c; if (L >= nwg) return false;
        int wgid = L; { constexpr int q = nwg / NXCD, r = nwg % NXCD; const int xcd = wgid % NXCD, off = wgid / NXCD; wgid = (xcd < r ? xcd * (q + 1) : r * (q + 1) + (xcd - r) * q) + off; }
        static_assert(NM % WGM == 0, "row-tile count must be a multiple of the 8-row group"); constexpr int nig = WGM * NN, gsz = WGM; const int gid = wgid / nig, fm = gid * WGM;
        u.pm = pm_base + fm + ((wgid % nig) % gsz); u.pn = (wgid % nig) / gsz;
        u.aoff = (size_t)u.pm * ((size_t)BM * LDAB) + (size_t)(u.pn >> A_SHIFT) * A_MUL; u.boff = (size_t)u.pn * ((size_t)BM * LDBB); return true;
    }
};
template <int NCOL, bool GATHER_ = false> struct MoeOrder {
    static constexpr bool GATHER = GATHER_;
    const int* blk_e; int nb, G, c; size_t a_tstep, b_tstep, b_estep; const int* rowmap;
    __device__ bool next(int i, Unit& u) const {
        const int L = i * G + c; if (L >= nb * NCOL) return false;
        const int rb = L / NCOL, pn = L % NCOL; const int e = __builtin_amdgcn_readfirstlane(blk_e[rb]);
        u.pm = rb; u.pn = pn; u.aoff = (size_t)rb * a_tstep; u.boff = (size_t)e * b_estep + (size_t)pn * b_tstep; return true;
    }
};

__device__ __forceinline__ unsigned cvt_pk_bf16(float lo, float hi) { unsigned r; asm volatile("v_cvt_pk_bf16_f32 %0, %1, %2" : "=v"(r) : "v"(lo), "v"(hi)); return r; }

struct EpiBf16 {
    static constexpr bool PERM = true;
    bf16_t* O; int ldc; int row_sub;
    template <class AT> __device__ __forceinline__ void operator()(const AT (&acc)[2][2][4][2], const Unit& u, int wr, int wc, int fr, int fq) const {
        const int row0 = u.pm * BM + wr * 64 + fr - row_sub; const int col0 = u.pn * BM + wc * 32 + 8 * fq;
#pragma unroll
        for (int ai = 0; ai < 2; ++ai)
#pragma unroll
            for (int m = 0; m < 4; ++m) { bf16_t* rowp = O + (size_t)(row0 + ai * HALF + m * 16) * ldc + col0;
#pragma unroll
                for (int bj = 0; bj < 2; ++bj) { const f32x4 v0 = tof(acc[ai][bj][m][0]), v1 = tof(acc[ai][bj][m][1]);
                    u32x4 w; w.x = cvt_pk_bf16(v0[0], v0[1]); w.y = cvt_pk_bf16(v0[2], v0[3]); w.z = cvt_pk_bf16(v1[0], v1[1]); w.w = cvt_pk_bf16(v1[2], v1[3]);
                    *(u32x4*)(rowp + bj * HALF) = w; } }
    }
};
struct EpiBf16S {
    static constexpr bool PERM = true;
    bf16_t* O; int ldc; const float* srow; const float* scol;
    template <class AT> __device__ __forceinline__ void operator()(const AT (&acc)[2][2][4][2], const Unit& u, int wr, int wc, int fr, int fq) const {
        const int row0 = u.pm * BM + wr * 64 + fr; const int col0 = u.pn * BM + wc * 32 + 8 * fq;
        f32x4 sc[2][2];
#pragma unroll
        for (int bj = 0; bj < 2; ++bj)
#pragma unroll
            for (int n = 0; n < 2; ++n) sc[bj][n] = *(const f32x4*)(scol + col0 + bj * HALF + 4 * n);
#pragma unroll
        for (int ai = 0; ai < 2; ++ai)
#pragma unroll
            for (int m = 0; m < 4; ++m) { const int r = row0 + ai * HALF + m * 16; const float sr = srow[r]; bf16_t* rowp = O + (size_t)r * ldc + col0;
#pragma unroll
                for (int bj = 0; bj < 2; ++bj) { const f32x4 v0 = tof(acc[ai][bj][m][0]) * sc[bj][0] * sr, v1 = tof(acc[ai][bj][m][1]) * sc[bj][1] * sr;
                    u32x4 w; w.x = cvt_pk_bf16(v0[0], v0[1]); w.y = cvt_pk_bf16(v0[2], v0[3]); w.z = cvt_pk_bf16(v1[0], v1[1]); w.w = cvt_pk_bf16(v1[2], v1[3]);
                    *(u32x4*)(rowp + bj * HALF) = w; } }
    }
};
template <bool BASE_F32> struct EpiRes {
    static constexpr bool PERM = true;
    const void* base; bf16_t* H;
    template <class AT> __device__ __forceinline__ void operator()(const AT (&acc)[2][2][4][2], const Unit& u, int wr, int wc, int fr, int fq) const {
        const int row0 = u.pm * BM + wr * 64 + fr, col0 = u.pn * BM + wc * 32 + 8 * fq;
#pragma unroll
        for (int ai = 0; ai < 2; ++ai) {
            f32x4 b[4][2][2];
#pragma unroll
            for (int m = 0; m < 4; ++m) { const size_t off = (size_t)(row0 + ai * HALF + m * 16) * 1024 + col0;
#pragma unroll
                for (int bj = 0; bj < 2; ++bj) {
                    if (BASE_F32) { b[m][bj][0] = *(const f32x4*)((const float*)base + off + bj * HALF); b[m][bj][1] = *(const f32x4*)((const float*)base + off + bj * HALF + 4); }
                    else { const u32x4 q = *(const u32x4*)((const bf16_t*)base + off + bj * HALF);
                        b[m][bj][0] = (f32x4){__uint_as_float(q.x << 16), __uint_as_float(q.x & 0xffff0000u), __uint_as_float(q.y << 16), __uint_as_float(q.y & 0xffff0000u)};
                        b[m][bj][1] = (f32x4){__uint_as_float(q.z << 16), __uint_as_float(q.z & 0xffff0000u), __uint_as_float(q.w << 16), __uint_as_float(q.w & 0xffff0000u)}; } } }
#pragma unroll
            for (int m = 0; m < 4; ++m) { const size_t off = (size_t)(row0 + ai * HALF + m * 16) * 1024 + col0;
#pragma unroll
                for (int bj = 0; bj < 2; ++bj) { const f32x4 v0 = b[m][bj][0] + tof(acc[ai][bj][m][0]), v1 = b[m][bj][1] + tof(acc[ai][bj][m][1]);
                    u32x4 w; w.x = cvt_pk_bf16(v0[0], v0[1]); w.y = cvt_pk_bf16(v0[2], v0[3]); w.z = cvt_pk_bf16(v1[0], v1[1]); w.w = cvt_pk_bf16(v1[2], v1[3]);
                    *(u32x4*)(H + off + bj * HALF) = w; } }
            asm volatile("" ::: "memory"); }
    }
};
struct EpiRouter {
    static constexpr bool PERM = false;
    float* L;
    template <class AT> __device__ __forceinline__ void operator()(const AT (&acc)[2][2][4][2], const Unit& u, int wr, int wc, int fr, int fq) const {
        if (wc >= 2) return;
        const int row0 = u.pm * BM + wr * 64 + fr, col0 = wc * 32 + 4 * fq;
#pragma unroll
        for (int ai = 0; ai < 2; ++ai)
#pragma unroll
            for (int m = 0; m < 4; ++m) { float* rowp = L + (size_t)(row0 + ai * HALF + m * 16) * 64 + col0;
#pragma unroll
                for (int n = 0; n < 2; ++n) *(f32x4*)(rowp + n * 16) = tof(acc[ai][0][m][n]); }
    }
};
struct EpiGate {
    static constexpr bool PERM = false;
    const bf16_t* Y; int y_row_sub; bf16_t* Mg; const float* srow; const float* scol;
    template <class AT> __device__ __forceinline__ void operator()(const AT (&acc)[2][2][4][2], const Unit& u, int wr, int wc, int fr, int fq) const {
        const int row0 = u.pm * BM + wr * 64 + fr, d0 = u.pn * 64 + wc * 16 + fq * 4;
        f32x4 sc[4];
#pragma unroll
        for (int i = 0; i < 4; ++i) sc[i] = *(const f32x4*)(scol + u.pn * BM + (i >> 1) * HALF + wc * 32 + (i & 1) * 16 + 4 * fq) * (-LOG2E);
#pragma unroll
        for (int ai = 0; ai < 2; ++ai) { u32x2 yv[4][4];
#pragma unroll
            for (int m = 0; m < 4; ++m) { const bf16_t* yrow = Y + (size_t)(row0 + ai * HALF + m * 16 - y_row_sub) * 4096 + d0;
#pragma unroll
                for (int i = 0; i < 4; ++i) yv[m][i] = *(const u32x2*)(yrow + 1024 * i); }
#pragma unroll
            for (int m = 0; m < 4; ++m) { const int r = row0 + ai * HALF + m * 16; const float sr = srow[r];
                f32x4 s = (f32x4){0.f, 0.f, 0.f, 0.f};
#pragma unroll
                for (int i = 0; i < 4; ++i) { const f32x4 g = tof(acc[ai][i >> 1][m][i & 1]) * sc[i] * sr;
                    s[0] += __builtin_amdgcn_rcpf(1.0f + __builtin_amdgcn_exp2f(g[0])) * __uint_as_float(yv[m][i].x << 16); s[1] += __builtin_amdgcn_rcpf(1.0f + __builtin_amdgcn_exp2f(g[1])) * __uint_as_float(yv[m][i].x & 0xffff0000u);
                    s[2] += __builtin_amdgcn_rcpf(1.0f + __builtin_amdgcn_exp2f(g[2])) * __uint_as_float(yv[m][i].y << 16); s[3] += __builtin_amdgcn_rcpf(1.0f + __builtin_amdgcn_exp2f(g[3])) * __uint_as_float(yv[m][i].y & 0xffff0000u); }
                u32x2 w; w.x = cvt_pk_bf16(s[0], s[1]); w.y = cvt_pk_bf16(s[2], s[3]);
                *(u32x2*)(Mg + (size_t)r * 1024 + d0) = w; }
            asm volatile("" ::: "memory"); }
    }
};
struct EpiE1 {
    static constexpr bool PERM = true;
    bf16_t* H; const float* srow; const float* scol_all; const int* blk_e;
    template <class AT> __device__ __forceinline__ void operator()(const AT (&acc)[2][2][4][2], const Unit& u, int wr, int wc, int fr, int fq) const {
        const int row0 = u.pm * BM + wr * 64 + fr, col0 = u.pn * 128 + wc * 32 + 8 * fq;
        const float* scol = scol_all + (size_t)__builtin_amdgcn_readfirstlane(blk_e[u.pm]) * 512 + u.pn * BM + wc * 32 + 8 * fq;
        const f32x4 s10 = *(const f32x4*)scol, s11 = *(const f32x4*)(scol + 4), s30 = *(const f32x4*)(scol + HALF), s31 = *(const f32x4*)(scol + HALF + 4);
#pragma unroll
        for (int ai = 0; ai < 2; ++ai)
#pragma unroll
            for (int m = 0; m < 4; ++m) { const int r = row0 + ai * HALF + m * 16; const float sr = srow[r]; bf16_t* rowp = H + (size_t)r * EHID + col0;
                const f32x4 a0 = tof(acc[ai][0][m][0]) * s10 * sr, a1 = tof(acc[ai][0][m][1]) * s11 * sr, b0 = tof(acc[ai][1][m][0]) * s30 * sr, b1 = tof(acc[ai][1][m][1]) * s31 * sr;
                f32x4 v0, v1;
#pragma unroll
                for (int j = 0; j < 4; ++j) { v0[j] = a0[j] * sigmoidf_(a0[j]) * b0[j]; v1[j] = a1[j] * sigmoidf_(a1[j]) * b1[j]; }
                u32x4 w; w.x = cvt_pk_bf16(v0[0], v0[1]); w.y = cvt_pk_bf16(v0[2], v0[3]); w.z = cvt_pk_bf16(v1[0], v1[1]); w.w = cvt_pk_bf16(v1[2], v1[3]);
                *(u32x4*)rowp = w; }
    }
};
struct EpiE2 {
    static constexpr bool PERM = true;
    bf16_t* YS; const int* sdst;
    template <class AT> __device__ __forceinline__ void operator()(const AT (&acc)[2][2][4][2], const Unit& u, int wr, int wc, int fr, int fq) const {
        const int row0 = u.pm * BM + wr * 64 + fr, col0 = u.pn * BM + wc * 32 + 8 * fq;
#pragma unroll
        for (int ai = 0; ai < 2; ++ai)
#pragma unroll
            for (int m = 0; m < 4; ++m) { const int dst = sdst[row0 + ai * HALF + m * 16];
                bf16_t* rowp = YS + (size_t)dst * 1024 + col0;
#pragma unroll
                for (int bj = 0; bj < 2; ++bj) { const f32x4 v0 = tof(acc[ai][bj][m][0]), v1 = tof(acc[ai][bj][m][1]);
                    u32x4 w; w.x = cvt_pk_bf16(v0[0], v0[1]); w.y = cvt_pk_bf16(v0[2], v0[3]); w.z = cvt_pk_bf16(v1[0], v1[1]); w.w = cvt_pk_bf16(v1[2], v1[3]);
                    *(u32x4*)(rowp + bj * HALF) = w; }
                asm volatile("" ::: "memory"); }
    }
};

template <bool I8> struct AccSel { typedef f32x4 type; };
template <> struct AccSel<true> { typedef i32x4 type; };
__device__ __forceinline__ f32x4 mma16(const bf16x8& a, const bf16x8& b, const f32x4& c) { return __builtin_amdgcn_mfma_f32_16x16x32_bf16(a, b, c, 0, 0, 0); }
__device__ __forceinline__ i32x4 mma16(const bf16x8& a, const bf16x8& b, const i32x4& c) { return __builtin_amdgcn_mfma_i32_16x16x64_i8(__builtin_bit_cast(i32x4, a), __builtin_bit_cast(i32x4, b), c, 0, 0, 0); }
template <int LDAB, int LDBB, int KB, bool I8, bool ALIGN_EPI = false, class Epi, class Sched>
__device__ __forceinline__ void gemm_phase(PG8_LAS unsigned char* lds, const Gemm g, const Sched& S, const Epi& E) {
    int tid = threadIdx.x; asm volatile("" : "+v"(tid));
    const int wid = __builtin_amdgcn_readfirstlane(tid >> 6), lane = tid & 63, wr = wid >> 2, wc = wid & 3, fr = lane & 15, fq = lane >> 4;
    constexpr int nt = KB / (BK * 2);
    unsigned voffA[2], voffB[2]; int Rr[2]; unsigned cby[2];
#pragma unroll
    for (int i = 0; i < 2; ++i) { int R, C; stage_rc(tid * 16 + i * 8192, R, C); const int Rb = Epi::PERM ? ((R & ~31) + perm32(R & 31)) : R;
        voffA[i] = (unsigned)(R * LDAB + C * 2); voffB[i] = (unsigned)(Rb * LDBB + C * 2); Rr[i] = R; cby[i] = (unsigned)(C * 2); }
    unsigned gc[2][2], gn[2][2];
#define PG8_GATH(u_, o_) do { if constexpr (Sched::GATHER) { _Pragma("unroll") for (int h_ = 0; h_ < 2; ++h_) _Pragma("unroll") for (int i_ = 0; i_ < 2; ++i_) { int tk_ = S.rowmap[(u_).pm * BM + HALF * h_ + Rr[i_]] >> 1; tk_ = tk_ < T_ ? tk_ : T_ - 1; \
        o_[h_][i_] = (unsigned)tk_ * (unsigned)LDAB + cby[i_]; } } } while (0)
#define PG8_STAGE_A(bufoff, ptr, kb, h, nx) do { if constexpr (!Sched::GATHER) { PG8_STAGE(bufoff, ptr, voffA); } else { unsigned vo_[2]; vo_[0] = (nx) ? gn[h][0] : gc[h][0]; vo_[1] = (nx) ? gn[h][1] : gc[h][1]; \
        PG8_STAGE(bufoff, (const char*)g.A + (kb), vo_); } } while (0)
    constexpr size_t kstep = (size_t)(BK * 2);
    constexpr size_t hstepA = (size_t)HALF * LDAB, hstepB = (size_t)HALF * LDBB;
    const unsigned ldsw = (unsigned)wid * 1024u;
    const int aoff = lds_byte(wr * 64 + fr, fq * 8), boff = lds_byte(wc * 32 + fr, fq * 8);
#define PG8_SA(b, h) (((b) * 2 + (h)) * HTB)
#define PG8_SB(b, h) ((4 + (b) * 2 + (h)) * HTB)
#define PG8_STAGE(bufoff, gbase, voff) do { _Pragma("unroll") for (int _i = 0; _i < 2; ++_i) \
        __builtin_amdgcn_global_load_lds((const unsigned*)((const char*)(gbase) + (voff)[_i]), (PG8_LAS unsigned*)(lds + (bufoff) + ldsw + _i * 8192), 16, 0, 0); } while (0)
#define PG8_LDA(dst, b, h) do { _Pragma("unroll") for (int m = 0; m < 4; ++m) _Pragma("unroll") for (int k = 0; k < 2; ++k) dst[m][k] = *(const PG8_LAS bf16x8*)(lds + PG8_SA(b, h) + aoff + m * 2048 + k * 1024); } while (0)
#define PG8_LDB(dst, b, h) do { _Pragma("unroll") for (int n = 0; n < 2; ++n) _Pragma("unroll") for (int k = 0; k < 2; ++k) dst[n][k] = *(const PG8_LAS bf16x8*)(lds + PG8_SB(b, h) + boff + n * 2048 + k * 1024); } while (0)
#define PG8_MMA(ai, bj, At, Bt) do { __builtin_amdgcn_s_setprio(1); _Pragma("unroll") for (int m = 0; m < 4; ++m) _Pragma("unroll") for (int n = 0; n < 2; ++n) _Pragma("unroll") for (int k = 0; k < 2; ++k) \
        acc[ai][bj][m][n] = mma16(Bt[n][k], At[m][k], acc[ai][bj][m][n]); __builtin_amdgcn_s_setprio(0); } while (0)
#define PG8_WAIT_V(n) asm volatile("s_waitcnt vmcnt(" #n ")" ::: "memory")
#define PG8_WAIT_L(n) asm volatile("s_waitcnt lgkmcnt(" #n ")" ::: "memory")
#define PG8_BAR __builtin_amdgcn_s_barrier()
#define PG8_SCHED __builtin_amdgcn_sched_barrier(0)
    Unit cur, nxt; int ui = 0;
    if (!S.next(0, cur)) return;
    typedef typename AccSel<I8>::type acc_t;
    acc_t acc[2][2][4][2];
#pragma unroll
    for (int a = 0; a < 2; ++a)
#pragma unroll
        for (int b = 0; b < 2; ++b)
#pragma unroll
            for (int m = 0; m < 4; ++m)
#pragma unroll
                for (int n = 0; n < 2; ++n) acc[a][b][m][n] = (acc_t){0, 0, 0, 0};
    bf16x8 At[4][2], B0[2][2], B1[2][2];
    const char* cA = (const char*)g.A + cur.aoff; const char* cB = (const char*)g.Bt + cur.boff;
    PG8_GATH(cur, gc);
    PG8_STAGE(PG8_SB(0, 0), cB, voffB); PG8_STAGE_A(PG8_SA(0, 0), cA, 0, 0, false); PG8_STAGE(PG8_SB(0, 1), cB + hstepB, voffB); PG8_STAGE_A(PG8_SA(0, 1), cA + hstepA, 0, 1, false);
    if (wr == 1) PG8_BAR;
    PG8_WAIT_V(4); PG8_BAR;
    PG8_STAGE(PG8_SB(1, 0), cB + kstep, voffB); PG8_STAGE_A(PG8_SA(1, 0), cA + kstep, kstep, 0, false); PG8_STAGE(PG8_SB(1, 1), cB + hstepB + kstep, voffB);
    PG8_WAIT_V(6); PG8_BAR;
    for (;;) {
        const bool has_next = S.next(ui + 1, nxt);
        const char* nA = has_next ? (const char*)g.A + nxt.aoff : cA; const char* nB = has_next ? (const char*)g.Bt + nxt.boff : cB;
        if constexpr (Sched::GATHER) { if (has_next) PG8_GATH(nxt, gn); else { gn[0][0] = gc[0][0]; gn[0][1] = gc[0][1]; gn[1][0] = gc[1][0]; gn[1][1] = gc[1][1]; } }
#pragma unroll 1
        for (int t = 0; t < nt; t += 2) {
            const bool last = (t == nt - 2);
            const char* a1 = cA + (size_t)(t + 1) * kstep;
            const char* a2 = last ? nA : cA + (size_t)(t + 2) * kstep; const char* b2 = last ? nB : cB + (size_t)(t + 2) * kstep;
            const char* a3 = a2 + kstep; const char* b3 = b2 + kstep;
            const size_t k2 = last ? 0 : (size_t)(t + 2) * kstep;
            PG8_LDB(B0, 0, 0); PG8_SCHED; PG8_LDA(At, 0, 0); PG8_STAGE_A(PG8_SA(1, 1), a1 + hstepA, (size_t)(t + 1) * kstep, 1, false);
            PG8_WAIT_L(8); PG8_BAR; PG8_WAIT_L(0); PG8_MMA(0, 0, At, B0); PG8_BAR; PG8_SCHED;
            PG8_LDB(B1, 0, 1); PG8_STAGE(PG8_SB(0, 0), b2, voffB);
            PG8_BAR; PG8_WAIT_L(0); PG8_MMA(0, 1, At, B1); PG8_BAR;
            PG8_LDA(At, 0, 1); PG8_STAGE_A(PG8_SA(0, 0), a2, k2, 0, last);
            PG8_BAR; PG8_WAIT_L(0); PG8_MMA(1, 0, At, B0); PG8_BAR; PG8_SCHED;
            PG8_STAGE(PG8_SB(0, 1), b2 + hstepB, voffB);
            PG8_WAIT_V(6); PG8_BAR; PG8_MMA(1, 1, At, B1); PG8_BAR;
            PG8_LDB(B0, 1, 0); PG8_SCHED; PG8_LDA(At, 1, 0); PG8_STAGE_A(PG8_SA(0, 1), a2 + hstepA, k2, 1, last);
            PG8_WAIT_L(8); PG8_BAR; PG8_WAIT_L(0); PG8_MMA(0, 0, At, B0); PG8_BAR; PG8_SCHED;
            PG8_LDB(B1, 1, 1); PG8_STAGE(PG8_SB(1, 0), b3, voffB);
            PG8_BAR; PG8_WAIT_L(0); PG8_MMA(0, 1, At, B1); PG8_BAR;
            PG8_LDA(At, 1, 1); PG8_STAGE_A(PG8_SA(1, 0), a3, k2 + kstep, 0, last);
            PG8_BAR; PG8_WAIT_L(0); PG8_MMA(1, 0, At, B0); PG8_BAR; PG8_SCHED;
            PG8_STAGE(PG8_SB(1, 1), b3 + hstepB, voffB);
            PG8_WAIT_V(6); PG8_BAR; PG8_MMA(1, 1, At, B1); PG8_BAR;
        }
        if constexpr (ALIGN_EPI) { if (wr == 0) PG8_BAR; }
        E(acc, cur, wr, wc, fr, fq);
        if (!has_next) break;
#pragma unroll
        for (int a = 0; a < 2; ++a)
#pragma unroll
            for (int b = 0; b < 2; ++b)
#pragma unroll
                for (int m = 0; m < 4; ++m)
#pragma unroll
                    for (int n = 0; n < 2; ++n) acc[a][b][m][n] = (acc_t){0, 0, 0, 0};
        cur = nxt; cA = nA; cB = nB; ++ui;
        if constexpr (Sched::GATHER) { gc[0][0] = gn[0][0]; gc[0][1] = gn[0][1]; gc[1][0] = gn[1][0]; gc[1][1] = gn[1][1]; }
        if constexpr (ALIGN_EPI) { if (wr == 1) PG8_BAR; }
    }
    PG8_WAIT_V(0);
    if constexpr (!ALIGN_EPI) { if (wr == 0) PG8_BAR; }
    PG8_BAR;
#undef PG8_SA
#undef PG8_GATH
#undef PG8_STAGE_A
#undef PG8_SB
#undef PG8_STAGE
#undef PG8_LDA
#undef PG8_LDB
#undef PG8_MMA
#undef PG8_WAIT_V
#undef PG8_WAIT_L
#undef PG8_BAR
#undef PG8_SCHED
}
}

#define XB_TMO      128
#define XB_XCNT(j)  (256  + 64 * (j))
#define XB_XSUB(j)  (1280 + 64 * (j))
#define XB_XGEN(j)  (2304 + 64 * (j))
#define XB_TOP      3328
#define XB_TOPGEN   3392
#define XCD_BAR_WORDS 3456
#define XB_SPIN_CAP (1u << 21)

__device__ __forceinline__ unsigned xb_ld(unsigned* p)              { return __hip_atomic_load(p, __ATOMIC_RELAXED, __HIP_MEMORY_SCOPE_AGENT); }
__device__ __forceinline__ unsigned xb_add(unsigned* p, unsigned v) { return __hip_atomic_fetch_add(p, v, __ATOMIC_RELAXED, __HIP_MEMORY_SCOPE_AGENT); }
__device__ __forceinline__ unsigned xb_xcc_id() { return (unsigned)__builtin_amdgcn_s_getreg((3 << 11) | 20) & 0xFu; }
#define XB_SPIN(cond, bar) do { unsigned _sp = 0; while (cond) { __builtin_amdgcn_s_sleep(1); \
    if ((++_sp & 255u) == 0u) { if (xb_ld(&(bar)[XB_TMO])) break; if (_sp > XB_SPIN_CAP) { atomicAdd(&(bar)[XB_TMO], 1u); break; } } } } while (0)

struct XcdBarrier {
    unsigned* bar; unsigned x;
    volatile LAS unsigned* st;
};

__device__ __forceinline__ XcdBarrier xcd_barrier_post(unsigned* bar, volatile LAS unsigned* st) {
    XcdBarrier b; b.bar = bar; b.x = xb_xcc_id(); b.st = st;
    if (threadIdx.x == 0) (void)xb_add(&bar[XB_XCNT(b.x)], 1u);
    return b;
}
__device__ __forceinline__ void xcd_barrier_complete(unsigned* bar, unsigned x, unsigned& nloc, unsigned& nx) {
    const unsigned G = gridDim.x * gridDim.y * gridDim.z;
    unsigned sum, cnt, mine, sp = 0u;
    for (;;) {
        sum = 0u; cnt = 0u; mine = 0u;
#pragma unroll
        for (unsigned j = 0; j < 16; ++j) { const unsigned c = xb_ld(&bar[XB_XCNT(j)]); sum += c; cnt += (c > 0u) ? 1u : 0u; mine = (j == x) ? c : mine; }
        if (sum == G) break;
        __builtin_amdgcn_s_sleep(1);
        if ((++sp & 255u) == 0u) { if (xb_ld(&bar[XB_TMO])) break; if (sp > XB_SPIN_CAP) { atomicAdd(&bar[XB_TMO], 1u); break; } }
    }
    nloc = mine > 0u ? mine : 1u; nx = cnt > 0u ? cnt : 1u;
}

__device__ __forceinline__ void xcd_barrier(const XcdBarrier& b) {
    asm volatile("s_waitcnt vmcnt(0)" ::: "memory");
    __syncthreads();
    if (threadIdx.x == 0) {
        unsigned* bar = b.bar;
        __builtin_amdgcn_s_waitcnt(0);
        unsigned nloc = b.st[0], nx = b.st[1];
        if (nloc == 0u) { xcd_barrier_complete(bar, b.x, nloc, nx); b.st[0] = nloc; b.st[1] = nx; }
        const unsigned old = xb_add(&bar[XB_XSUB(b.x)], 1u);
        const unsigned gen = old / nloc;
        if (old + 1u == (gen + 1u) * nloc) {
            __builtin_amdgcn_fence(__ATOMIC_RELEASE, "agent");
            asm volatile("s_waitcnt vmcnt(0)" ::: "memory");
            const unsigned og = xb_add(&bar[XB_TOP], 1u);
            const unsigned tg = og / nx;
            if (og + 1u == (tg + 1u) * nx) xb_add(&bar[XB_TOPGEN], 1u);
            else XB_SPIN(xb_ld(&bar[XB_TOPGEN]) == tg, bar);
            __builtin_amdgcn_fence(__ATOMIC_ACQUIRE, "agent");
            xb_add(&bar[XB_XGEN(b.x)], 1u);
            asm volatile("s_waitcnt vmcnt(0)" ::: "memory");
        } else {
            XB_SPIN(xb_ld(&bar[XB_XGEN(b.x)]) == gen, bar);
            __builtin_amdgcn_fence(__ATOMIC_ACQUIRE, "agent");
            asm volatile("s_waitcnt vmcnt(0)" ::: "memory");
        }
    }
    __syncthreads();
}

constexpr int NWAVES = 8, NTHREADS = 512;
constexpr int RING_BYTES = 131072;
constexpr int LDSCTL_OFF = 163840 - 1024, MISC_OFF = LDSCTL_OFF + 320;
constexpr int LDS_BYTES = 163840;

struct Params { const float* in[19]; float* out; unsigned char* ws; float inv_freq[16]; float ret_lg2[4]; int ph_lo, ph_hi; };
typedef const __attribute__((address_space(4))) Params& KPRef;

__device__ __forceinline__ float wave_sum(float v) {
#pragma unroll
    for (int o = 1; o < 64; o <<= 1) v += __shfl_xor(v, o);
    return v;
}
#define LDS_WAIT() asm volatile("s_waitcnt lgkmcnt(0)" ::: "memory")
#define MFMA16(a, b, c) __builtin_amdgcn_mfma_f32_16x16x32_bf16(a, b, c, 0, 0, 0)
typedef short v4i16_t __attribute__((ext_vector_type(4)));
__device__ __forceinline__ v4i16_t lds_tr16(const bf16_t* p) { return __builtin_amdgcn_ds_read_tr16_b64_v4i16((LAS v4i16_t*)(LAS unsigned char*)(unsigned char*)p); }
__device__ __forceinline__ bf16x8 tr_frag(const bf16_t* tile, int stride, int rowa, int rowb, int col0, int lane) {
    const int i = lane & 15, q = i >> 2, pp = i & 3;
    const v4i16_t lo = lds_tr16(tile + (rowa + q) * stride + col0 + 4 * pp), hi = lds_tr16(tile + (rowb + q) * stride + col0 + 4 * pp);
    return (bf16x8){lo[0], lo[1], lo[2], lo[3], hi[0], hi[1], hi[2], hi[3]};
}
__device__ __forceinline__ bf16x8 pack_p(const f32x4& a, const f32x4& b) {
    u32x4 w; w.x = pg8::cvt_pk_bf16(a[0], a[1]); w.y = pg8::cvt_pk_bf16(a[2], a[3]); w.z = pg8::cvt_pk_bf16(b[0], b[1]); w.w = pg8::cvt_pk_bf16(b[2], b[3]); return __builtin_bit_cast(bf16x8, w); }


template <class LD>
__device__ __forceinline__ void conv_item(LD ld, bf16_t* WT, int K, float* scr, int kb, int nb, int lane) {
    const int k0 = 64 * kb, n0 = 32 * nb;
    float wv[32];
#pragma unroll
    for (int i = 0; i < 32; ++i) wv[i] = ld(k0 + 2 * i + (lane >> 5), n0 + (lane & 31));
#pragma unroll
    for (int i = 0; i < 32; ++i) { const int kk = 2 * i + (lane >> 5); scr[kk * 33 + (lane & 31)] = wv[i]; }
    LDS_WAIT();
    const int c = lane & 7;
#pragma unroll
    for (int j = 0; j < 4; ++j) { const int n = (lane >> 3) + 8 * j; const float* s = scr + (8 * c) * 33 + n;
        u32x4 o; o.x = pk2(s[0 * 33], s[1 * 33]); o.y = pk2(s[2 * 33], s[3 * 33]); o.z = pk2(s[4 * 33], s[5 * 33]); o.w = pk2(s[6 * 33], s[7 * 33]);
        *(u32x4*)(WT + (size_t)(n0 + n) * K + k0 + 8 * c) = o; }
    LDS_WAIT();
}

template <class LD>
__device__ __forceinline__ void amax_item(LD ld, unsigned* raw, int kb, int nb, int lane) {
    const int k0 = 64 * kb, n0 = 32 * nb; float v[32];
#pragma unroll
    for (int i = 0; i < 32; ++i) v[i] = ld(k0 + 2 * i + (lane >> 5), n0 + (lane & 31));
    float am = 0.f;
#pragma unroll
    for (int i = 0; i < 32; ++i) am = fmaxf(am, fabsf(v[i]));
    am = fmaxf(am, __shfl_xor(am, 32));
    if (lane < 32) atomicMax(raw + n0 + lane, __float_as_uint(am));
}
template <class LD, class SC>
__device__ __forceinline__ void quant_item(LD ld, SC extra, const unsigned* raw, signed char* WT, float* scale, float* scr, int kb, int nb, int lane) {
    const int k0 = 64 * kb, n0 = 32 * nb;
    const float am = __uint_as_float(raw[n0 + (lane & 31)]), qs = (am > 0.f) ? 127.0f / am : 0.f;
    if (kb == 0 && lane < 32) scale[n0 + lane] = am * (1.0f / 127.0f) * extra(n0 + lane);
    float wv[32];
#pragma unroll
    for (int i = 0; i < 32; ++i) wv[i] = ld(k0 + 2 * i + (lane >> 5), n0 + (lane & 31));
#pragma unroll
    for (int i = 0; i < 32; ++i) { const int kk = 2 * i + (lane >> 5); scr[kk * 33 + (lane & 31)] = rintf(wv[i] * qs); }
    LDS_WAIT();
    const int c = lane & 7;
#pragma unroll
    for (int j = 0; j < 4; ++j) { const int n = (lane >> 3) + 8 * j; const float* s = scr + (8 * c) * 33 + n;
        u32x2 o; o.x = ((unsigned)((int)s[0 * 33] & 0xff)) | ((unsigned)((int)s[1 * 33] & 0xff) << 8) | ((unsigned)((int)s[2 * 33] & 0xff) << 16) | ((unsigned)((int)s[3 * 33] & 0xff) << 24);
        o.y = ((unsigned)((int)s[4 * 33] & 0xff)) | ((unsigned)((int)s[5 * 33] & 0xff) << 8) | ((unsigned)((int)s[6 * 33] & 0xff) << 16) | ((unsigned)((int)s[7 * 33] & 0xff) << 24);
        *(u32x2*)(WT + (size_t)(n0 + n) * 1024 + k0 + 8 * c) = o; }
    LDS_WAIT();
}
template <int PASS>
__device__ __forceinline__ void conv8_pass(KPRef p, int l, unsigned char* wd, unsigned char* lds, int gw, int NGW, int wave, int lane) {
    float* scr = (float*)(lds + wave * 16384); unsigned char* ws = p.ws; unsigned* raw = (unsigned*)(ws + WS_SWRAW + (size_t)l * SWRAW_LSTEP); const size_t sl = (size_t)l * SW_LSTEP;
    const float* Win = p.in[2] + (size_t)l * 1024 * IN_W;
    for (int it = gw; it < 16 * 96; it += NGW) { const int kb = it / 96, nb = it % 96;
        auto ld = [&](int k, int n) -> float { return n < Z_GATE ? Win[(size_t)k * IN_W + n] : 0.f; };
        if (PASS == 0) amax_item(ld, raw, kb, nb, lane);
        else quant_item(ld, [&](int n) -> float { float s = 1.f; if (n < Z_GK) s = RSQ32; else if (n >= Z_SQ && n < Z_SK) s = C2; else if (n >= Z_MQ && n < Z_MK) s = C2; else if (n >= Z_RK && n < Z_RV) s = RSQ32; return s; },
                        raw, (signed char*)(wd + WS_WIN), (float*)(ws + WS_SWIN + sl), scr, kb, nb, lane); }
    for (int it = gw; it < 16 * 128; it += NGW) { const int kb = it / 128, nb = it % 128;
        auto ld = [&](int k, int n) -> float { const int pn = n >> 8, c = n & 255, bj = (c >> 7) & 1, wc = (c >> 5) & 3, nn = (c >> 4) & 1, fq = (c >> 2) & 3, j = c & 3;
            const int col = Z_GATE + 1024 * (2 * bj + nn) + 64 * pn + 16 * wc + 4 * fq + j; return Win[(size_t)k * IN_W + col]; };
        if (PASS == 0) amax_item(ld, raw + 3072, kb, nb, lane);
        else quant_item(ld, [&](int) -> float { return 1.f; }, raw + 3072, (signed char*)(wd + WS_WG), (float*)(ws + WS_SWG + sl), scr, kb, nb, lane); }
    for (int it = gw; it < 32 * 256; it += NGW) { const int e = it / 256, r = it % 256, kb = r / 16, nb = r % 16;
        const int n0 = 32 * nb, pn = n0 >> 8, c0 = n0 & 255;
        const float* W = ((c0 < 128) ? p.in[15] : p.in[16]) + (size_t)(l * 32 + e) * 1024 * 256 + 128 * pn + (c0 & 127) - n0;
        auto ld = [&](int k, int n) -> float { return W[(size_t)k * 256 + n]; };
        if (PASS == 0) amax_item(ld, raw + 7168 + e * 512, kb, nb, lane);
        else quant_item(ld, [&](int) -> float { return 1.f; }, raw + 7168 + e * 512, (signed char*)(wd + WS_E1) + (size_t)e * 512 * 1024, (float*)(ws + WS_SWE1 + sl) + e * 512, scr, kb, nb, lane); }
}

__device__ __forceinline__ void conv_phase(KPRef p, int l, unsigned char* wd, unsigned char* lds, int gw, int NGW, int wave, int lane) {
    float* scr = (float*)(lds + wave * 16384);
    unsigned char* ws = wd;
    {
        for (int it = gw; it < 512; it += NGW) { const int i = it / 128, r = it % 128, kb = r / 32, nb = r % 32;
            const float* W = p.in[8] + (size_t)(l * 4 + i) * 256 * 1024; bf16_t* WT = (bf16_t*)(ws + WS_WB) + (size_t)i * 1024 * 256;
            conv_item([&](int k, int n) -> float { return W[(size_t)k * 1024 + n]; }, WT, 256, scr, kb, nb, lane); }
    }
    {
        const float* W = p.in[9] + (size_t)l * 1024 * 1024; bf16_t* WT = (bf16_t*)(ws + WS_WO);
        for (int it = gw; it < 16 * 32; it += NGW) { const int kb = it / 32, nb = it % 32;
            conv_item([&](int k, int n) -> float { return W[(size_t)k * 1024 + n]; }, WT, 1024, scr, kb, nb, lane); }
    }
    {
        const float* Wg = p.in[11] + (size_t)l * 1024 * 4; const float* We = p.in[13] + (size_t)l * 1024 * 32; bf16_t* WT = (bf16_t*)(ws + WS_WR);
        for (int it = gw; it < 16 * 8; it += NGW) { const int kb = it / 8, nb = it % 8;
            conv_item([&](int k, int n) -> float { if (n < 4) return Wg[k * 4 + n]; if (n < 36) return We[k * 32 + (n - 4)]; return 0.f; }, WT, 1024, scr, kb, nb, lane); }
    }
    {
        for (int it = gw; it < 32 * 128; it += NGW) { const int e = it / 128, r = it % 128, kb = r / 32, nb = r % 32;
            const float* W = p.in[17] + (size_t)(l * 32 + e) * 256 * 1024; bf16_t* WT = (bf16_t*)(ws + WS_E2) + (size_t)e * 1024 * 256;
            conv_item([&](int k, int n) -> float { return W[(size_t)k * 1024 + n]; }, WT, 256, scr, kb, nb, lane); }
    }
}

__device__ __forceinline__ bf16_t* hbf_ptr(KPRef p) { return (bf16_t*)((unsigned char*)p.out + (size_t)64 * MiB); }
template <bool SRC_F32, bool COMBINE>
__device__ __forceinline__ void norm_load_row(KPRef p, int row, int lane, f32x4 (&v)[4]) {
    if (SRC_F32) { const f32x4* xr = (const f32x4*)(p.in[0] + (size_t)row * 1024) + lane;
#pragma unroll
        for (int j = 0; j < 4; ++j) v[j] = xr[64 * j];
    } else { const u32x2* hr = (const u32x2*)(hbf_ptr(p) + (size_t)row * 1024) + lane;
#pragma unroll
        for (int j = 0; j < 4; ++j) { const u32x2 a = hr[64 * j]; v[j] = (f32x4){__uint_as_float(a.x << 16), __uint_as_float(a.x & 0xffff0000u), __uint_as_float(a.y << 16), __uint_as_float(a.y & 0xffff0000u)}; } }
    if (COMBINE) { const bf16_t* ys = (const bf16_t*)(p.ws + WS_YS); const float* tokw = (const float*)(p.ws + WS_TOKW);
        const float w0 = tokw[2 * row], w1 = tokw[2 * row + 1];
        const u32x2* y0 = (const u32x2*)(ys + (size_t)(2 * row) * 1024) + lane; const u32x2* y1 = (const u32x2*)(ys + (size_t)(2 * row + 1) * 1024) + lane;
        u32x2 ya[4], yb[4];
#pragma unroll
        for (int j = 0; j < 4; ++j) { ya[j] = y0[64 * j]; yb[j] = y1[64 * j]; }
#pragma unroll
        for (int j = 0; j < 4; ++j) { const u32x2 a = ya[j], b = yb[j];
            v[j][0] += w0 * __uint_as_float(a.x << 16) + w1 * __uint_as_float(b.x << 16); v[j][1] += w0 * __uint_as_float(a.x & 0xffff0000u) + w1 * __uint_as_float(b.x & 0xffff0000u);
            v[j][2] += w0 * __uint_as_float(a.y << 16) + w1 * __uint_as_float(b.y << 16); v[j][3] += w0 * __uint_as_float(a.y & 0xffff0000u) + w1 * __uint_as_float(b.y & 0xffff0000u); } }
}
__device__ __forceinline__ float row_rstd(const f32x4 (&v)[4]) {
    float s = 0.f;
#pragma unroll
    for (int j = 0; j < 4; ++j) s += (v[j][0] * v[j][0] + v[j][1] * v[j][1]) + (v[j][2] * v[j][2] + v[j][3] * v[j][3]);
    return rsqrtf(wave_sum(s) * (1.0f / 1024.0f) + NORM_EPS);
}
template <int MODE>
__device__ __forceinline__ void norm_phase(KPRef p, int l, int gw, int NGW, int lane) {
    const float* gain = (MODE == 2 ? p.in[10] + l * 1024 : p.in[1] + l * 1024);
    f32x4 gg[4];
#pragma unroll
    for (int j = 0; j < 4; ++j) gg[j] = ((const f32x4*)gain)[lane + 64 * j];
    constexpr int NR = (MODE == 1) ? 2 : 4;
    for (int row0 = gw * NR; row0 < T_; row0 += NGW * NR) {
        f32x4 v[NR][4];
#pragma unroll
        for (int r = 0; r < NR; ++r) norm_load_row<MODE == 0, MODE == 1>(p, row0 + r, lane, v[r]);
#pragma unroll
        for (int r = 0; r < NR; ++r) {
            if (MODE == 1) { u32x2* hr = (u32x2*)(hbf_ptr(p) + (size_t)(row0 + r) * 1024) + lane;
#pragma unroll
                for (int j = 0; j < 4; ++j) { u32x2 w; w.x = pk2(v[r][j][0], v[r][j][1]); w.y = pk2(v[r][j][2], v[r][j][3]); hr[64 * j] = w; } }
            const float rstd = row_rstd(v[r]);
            f32x4 o[4]; float am = 0.f;
#pragma unroll
            for (int j = 0; j < 4; ++j) { o[j] = v[r][j] * rstd * gg[j]; am = fmaxf(fmaxf(am, fmaxf(fabsf(o[j][0]), fabsf(o[j][1]))), fmaxf(fabsf(o[j][2]), fabsf(o[j][3]))); }
#pragma unroll
            for (int of = 1; of < 64; of <<= 1) am = fmaxf(am, __shfl_xor(am, of));
            const float qs = (am > 0.f) ? 127.0f / am : 0.f;
            unsigned* o4 = (unsigned*)(p.ws + WS_U8 + (size_t)(row0 + r) * 1024) + lane;
#pragma unroll
            for (int j = 0; j < 4; ++j) { const int q0 = (int)rintf(o[j][0] * qs), q1 = (int)rintf(o[j][1] * qs), q2 = (int)rintf(o[j][2] * qs), q3 = (int)rintf(o[j][3] * qs);
                o4[64 * j] = (unsigned)(q0 & 0xff) | ((unsigned)(q1 & 0xff) << 8) | ((unsigned)(q2 & 0xff) << 16) | ((unsigned)(q3 & 0xff) << 24); }
            if (lane == 0) ((float*)(p.ws + WS_SU))[row0 + r] = am * (1.0f / 127.0f);
            if (MODE == 2) { u32x2* o8 = (u32x2*)(p.ws + WS_U2BF + (size_t)(row0 + r) * 2048) + lane;
#pragma unroll
                for (int j = 0; j < 4; ++j) { u32x2 w; w.x = pk2(o[j][0], o[j][1]); w.y = pk2(o[j][2], o[j][3]); o8[64 * j] = w; } }
        }
    }
}
struct FinalHold { f32x4 v[8][4]; };
__device__ __forceinline__ void final_a(KPRef p, int gw, int NGW, int lane, FinalHold& Hd) {
    f32x4 gg[4];
#pragma unroll
    for (int j = 0; j < 4; ++j) gg[j] = ((const f32x4*)p.in[18])[lane + 64 * j];
    for (int row0 = gw * 4; row0 < T_ / 2; row0 += NGW * 4) {
        f32x4 v[4][4];
#pragma unroll
        for (int r = 0; r < 4; ++r) norm_load_row<false, true>(p, row0 + r, lane, v[r]);
#pragma unroll
        for (int r = 0; r < 4; ++r) { const float rstd = row_rstd(v[r]); f32x4* orow = (f32x4*)(p.out + (size_t)(row0 + r) * 1024) + lane;
#pragma unroll
            for (int j = 0; j < 4; ++j) orow[64 * j] = v[r][j] * rstd * gg[j]; } }
#pragma unroll
    for (int r = 0; r < 8; ++r) norm_load_row<false, true>(p, T_ / 2 + gw * 8 + r, lane, Hd.v[r]);
}
__device__ __forceinline__ void final_b(KPRef p, int gw, int lane, const FinalHold& Hd) {
    f32x4 gg[4];
#pragma unroll
    for (int j = 0; j < 4; ++j) gg[j] = ((const f32x4*)p.in[18])[lane + 64 * j];
#pragma unroll
    for (int r = 0; r < 8; ++r) { const float rstd = row_rstd(Hd.v[r]); f32x4* orow = (f32x4*)(p.out + (size_t)(T_ / 2 + gw * 8 + r) * 1024) + lane;
#pragma unroll
        for (int j = 0; j < 4; ++j) orow[64 * j] = Hd.v[r][j] * rstd * gg[j]; }
}

constexpr int LA_QS = 0, LA_KS = 10240, LA_VS = 20480  , LA_KD = 38912  , LA_PS = 49152  , LA_PW = 58368, LA_PW_WAVE = 4352,
              LA_LA = 93184, LA_AS = 110080, LA_END = 118272;
__device__ __forceinline__ void unpack8f(float (&d)[8], u32x4 kk) {
    d[0] = __uint_as_float(kk.x << 16); d[1] = __uint_as_float(kk.x & 0xffff0000u); d[2] = __uint_as_float(kk.y << 16); d[3] = __uint_as_float(kk.y & 0xffff0000u);
    d[4] = __uint_as_float(kk.z << 16); d[5] = __uint_as_float(kk.z & 0xffff0000u); d[6] = __uint_as_float(kk.w << 16); d[7] = __uint_as_float(kk.w & 0xffff0000u); }
__device__ __forceinline__ u32x4 pack8f(const float (&o)[8]) { u32x4 w; w.x = pk2(o[0], o[1]); w.y = pk2(o[2], o[3]); w.z = pk2(o[4], o[5]); w.w = pk2(o[6], o[7]); return w; }

struct LaRegs { u32x4 a, k[2], q[2], v[2], g[2]; f32x4 pv[2]; };
__device__ __forceinline__ void gla_decay_front(KPRef p, int l, unsigned char* lds, const u32x4& areg, int h, int tid) {
    float* LA = (float*)(lds + LA_LA); float* AS = (float*)(lds + LA_AS);
    const int lane = tid & 63, wave = __builtin_amdgcn_readfirstlane(tid >> 6);
    if (tid < 256) { const int t = tid >> 1, hf = tid & 1; float a[8]; unpack8f(a, areg);
#pragma unroll
        for (int e = 0; e < 8; ++e) AS[t * 16 + 8 * hf + e] = a[e]; }
    const int d = tid & 31; const float* wa2 = p.in[3] + (size_t)l * 16 * 128 + h * 32 + d; float wcol[16];
#pragma unroll
    for (int r = 0; r < 16; ++r) wcol[r] = wa2[r * 128];
    const float bias = p.in[4][l * 128 + h * 32 + d];
    __syncthreads();
#pragma unroll
    for (int i = 0; i < 8; ++i) { const int t = (tid >> 5) + 16 * i; float x = bias;
#pragma unroll
        for (int r = 0; r < 16; ++r) x += AS[t * 16 + r] * wcol[r];
        LA[t * 33 + d] = (fminf(x, 0.f) - __builtin_amdgcn_logf(1.0f + __builtin_amdgcn_exp2f(-fabsf(x) * LOG2E)) * 0.6931471805599453f) * (1.0f / 16.0f); }
    __syncthreads();
#pragma unroll
    for (int s8 = 0; s8 < 8; ++s8) { const int s = wave * 8 + s8, ch = s >> 5, dd = s & 31; float v = LA[(64 * ch + lane) * 33 + dd];
#pragma unroll
        for (int o = 1; o < 64; o <<= 1) { const float t = __shfl_up(v, o); if (lane >= o) v += t; }
        LA[(64 * ch + lane) * 33 + dd] = v; }
    __syncthreads();
}
__device__ __forceinline__ void la_stage_v(unsigned char* lds, const u32x4 (&v)[2], int tid) {
    bf16_t* VS = (bf16_t*)(lds + LA_VS);
#pragma unroll
    for (int i = 0; i < 2; ++i) { const int c = tid + 512 * i, t = c >> 3, oct = c & 7; *(u32x4*)(VS + t * 72 + 8 * oct) = v[i]; }
}
template <bool OUT, bool GLA>
__device__ __forceinline__ void la_load(LaRegs& R, KPRef p, int unit, int tid) {
    const int lane = tid & 63, wave = __builtin_amdgcn_readfirstlane(tid >> 6);
    int b, h, c128; if (GLA) { c128 = unit & 63; h = (unit >> 6) & 3; b = unit >> 8; } else { c128 = unit & 63; const int bh = unit >> 6; h = bh & 3; b = bh >> 2; }
    const size_t t0 = (size_t)b * S_ + (size_t)c128 * 128; const bf16_t* zrow0 = (const bf16_t*)(p.ws + WS_Z) + t0 * ZW;
    const int kcol = GLA ? Z_GK + h * 32 : Z_RK + h * 32, qcol = GLA ? Z_GQ + h * 32 : Z_RQ + h * 32, vcol = GLA ? Z_GV + h * 64 : Z_RV + h * 64, gcol = GLA ? Z_GR + h * 64 : Z_RG + h * 64;
    if (GLA) { const int t = (tid & 255) >> 1, hf = tid & 1; R.a = *(const u32x4*)(zrow0 + (size_t)t * ZW + Z_GA + 8 * hf); }
    { const int t = tid >> 2, oct = tid & 3; const bf16_t* kr = zrow0 + (size_t)t * ZW + kcol; R.k[0] = *(const u32x4*)(kr + 8 * oct); if (!GLA) R.k[1] = *(const u32x4*)(kr + 8 * (oct ^ 2));
      if (OUT) { const bf16_t* qr = zrow0 + (size_t)t * ZW + qcol; R.q[0] = *(const u32x4*)(qr + 8 * oct); if (!GLA) R.q[1] = *(const u32x4*)(qr + 8 * (oct ^ 2)); } }
#pragma unroll
    for (int i = 0; i < 2; ++i) { const int c = tid + 512 * i, t = c >> 3, oct = c & 7; R.v[i] = *(const u32x4*)(zrow0 + (size_t)t * ZW + vcol + 8 * oct); }
    if (OUT) {
#pragma unroll
        for (int i = 0; i < 2; ++i) { const int cidx = lane + 64 * i, row = cidx >> 3, oct = cidx & 7; R.g[i] = *(const u32x4*)(zrow0 + (size_t)(16 * wave + row) * ZW + gcol + 8 * oct); }
        const float* prev = GLA ? (const float*)(p.ws + WS_GKV) + (size_t)((b * 4 + h) * 128 + 2 * c128) * 2048 : (const float*)(p.ws + WS_RKV) + (size_t)unit * 2048;
        const int row = (GLA ? tid : (tid & 255)) >> 3, oct = tid & 7; R.pv[0] = *(const f32x4*)(prev + row * 64 + 8 * oct); R.pv[1] = *(const f32x4*)(prev + row * 64 + 8 * oct + 4); }
}
__device__ __forceinline__ void la_kv_mfma(unsigned char* lds, float* out0, int nch, int clen, int tid) {
    const bf16_t* KD = (const bf16_t*)(lds + LA_KD); const bf16_t* VS = (const bf16_t*)(lds + LA_VS);
    const int lane = tid & 63, wave = __builtin_amdgcn_readfirstlane(tid >> 6), c16 = lane & 15, g = lane >> 4;
    const int ntile = 8 * nch;
    for (int ti = wave; ti < ntile; ti += 8) { const int ch = ti >> 3, dt = (ti >> 2) & 1, et = ti & 3, tok0 = ch * clen;
        f32x4 acc = (f32x4){0.f, 0.f, 0.f, 0.f};
        for (int s = 0; s < clen / 32; ++s) { const int r0 = tok0 + 32 * s + 8 * g;
            acc = MFMA16(tr_frag(KD, 40, r0, r0 + 4, 16 * dt, lane), tr_frag(VS, 72, r0, r0 + 4, 16 * et, lane), acc); }
        float* o = out0 + (size_t)ch * 2048 + (16 * dt + 4 * g) * 64 + 16 * et + c16;
#pragma unroll
        for (int r = 0; r < 4; ++r) o[r * 64] = acc[r]; }
}
__device__ __forceinline__ void gla_kv_unit(KPRef p, int l, unsigned char* lds, int unit, const LaRegs& R, int tid) {
    const int c = unit & 63, h = (unit >> 6) & 3, b = unit >> 8;
    gla_decay_front(p, l, lds, R.a, h, tid);
    const float* LA = (const float*)(lds + LA_LA); bf16_t* KD = (bf16_t*)(lds + LA_KD);
    { const int t = tid >> 2, oct = tid & 3, ch = t >> 6; float k[8]; unpack8f(k, R.k[0]);
#pragma unroll
      for (int e = 0; e < 8; ++e) { const int d = 8 * oct + e; k[e] *= __builtin_amdgcn_exp2f((LA[(64 * ch + 63) * 33 + d] - LA[t * 33 + d]) * LOG2E); }
      *(u32x4*)(KD + t * 40 + 8 * oct) = pack8f(k); }
    la_stage_v(lds, R.v, tid);
    __syncthreads();
    const int cu = ((b * 4 + h) * 128 + 2 * c);
    la_kv_mfma(lds, (float*)(p.ws + WS_GKV) + (size_t)cu * 2048, 2, 64, tid);
    if (tid < 64) { const int ch = tid >> 5, d = tid & 31; ((float*)(p.ws + WS_GDEC))[(size_t)(cu + ch) * 32 + d] = __builtin_amdgcn_exp2f(LA[(64 * ch + 63) * 33 + d] * LOG2E); }
    __syncthreads();
}
__device__ __forceinline__ void la_out_mfma(unsigned char* lds, const u32x4 (&gate)[2], const float* ng, bf16_t* orow0, int ocol, int clen, int tid) {
    const bf16_t* QS = (const bf16_t*)(lds + LA_QS); const bf16_t* KS = (const bf16_t*)(lds + LA_KS); const bf16_t* VS = (const bf16_t*)(lds + LA_VS); const bf16_t* PS = (const bf16_t*)(lds + LA_PS);
    const int lane = tid & 63, wave = __builtin_amdgcn_readfirstlane(tid >> 6), c16 = lane & 15, g = lane >> 4;
    float* PWf = (float*)(lds + LA_PW + wave * LA_PW_WAVE);
    const int ch = (clen == 64) ? (wave >> 2) : 0, kt0 = (clen == 64) ? 4 * ch : 0;
    const bf16x8 qa = *(const bf16x8*)(QS + (16 * wave + c16) * 40 + 8 * g);
    f32x4 O[4];
#pragma unroll
    for (int et = 0; et < 4; ++et) O[et] = MFMA16(qa, tr_frag(PS + ch * 32 * 72, 72, 8 * g, 8 * g + 4, 16 * et, lane), ((f32x4){0.f, 0.f, 0.f, 0.f}));
    for (int s = kt0 >> 1; s <= (wave >> 1); ++s) {
        f32x4 P0, P1;
        { const int kt = 2 * s; P0 = MFMA16(*(const bf16x8*)(KS + (16 * kt + c16) * 40 + 8 * g), qa, ((f32x4){0.f, 0.f, 0.f, 0.f}));
          if (kt == wave) {
#pragma unroll
              for (int r = 0; r < 4; ++r) if (4 * g + r > c16) P0[r] = 0.f; } }
        { const int kt = 2 * s + 1;
          if (kt <= wave) { P1 = MFMA16(*(const bf16x8*)(KS + (16 * kt + c16) * 40 + 8 * g), qa, ((f32x4){0.f, 0.f, 0.f, 0.f}));
            if (kt == wave) {
#pragma unroll
                for (int r = 0; r < 4; ++r) if (4 * g + r > c16) P1[r] = 0.f; } }
          else P1 = (f32x4){0.f, 0.f, 0.f, 0.f}; }
        const bf16x8 pa = pack_p(P0, P1);
#pragma unroll
        for (int et = 0; et < 4; ++et) O[et] = MFMA16(pa, tr_frag(VS, 72, 32 * s + 4 * g, 32 * s + 16 + 4 * g, 16 * et, lane), O[et]); }
    float rs[4];
#pragma unroll
    for (int r = 0; r < 4; ++r) { float ss = O[0][r] * O[0][r] + O[1][r] * O[1][r] + O[2][r] * O[2][r] + O[3][r] * O[3][r];
#pragma unroll
        for (int o = 1; o < 16; o <<= 1) ss += __shfl_xor(ss, o);
        rs[r] = rsqrtf(ss * (1.0f / 64.0f) + NORM_EPS); }
#pragma unroll
    for (int et = 0; et < 4; ++et)
#pragma unroll
        for (int r = 0; r < 4; ++r) PWf[(4 * g + r) * 68 + 16 * et + c16] = O[et][r] * rs[r];
    LDS_WAIT();
#pragma unroll
    for (int i = 0; i < 2; ++i) { const int cidx = lane + 64 * i, row = cidx >> 3, oct = cidx & 7; const int t = 16 * wave + row;
        float gt[8]; unpack8f(gt, gate[i]);
        const f32x4 o0 = *(const f32x4*)(PWf + row * 68 + 8 * oct), o1 = *(const f32x4*)(PWf + row * 68 + 8 * oct + 4), n0 = *(const f32x4*)(ng + 8 * oct), n1 = *(const f32x4*)(ng + 8 * oct + 4);
        float o[8];
#pragma unroll
        for (int e = 0; e < 4; ++e) { o[e] = o0[e] * n0[e] * (gt[e] * sigmoidf_(gt[e])); o[4 + e] = o1[e] * n1[e] * (gt[4 + e] * sigmoidf_(gt[4 + e])); }
        *(u32x4*)(orow0 + (size_t)t * 1024 + ocol + 8 * oct) = pack8f(o); }
    LDS_WAIT();
}
__device__ __forceinline__ void gla_out_unit(KPRef p, int l, unsigned char* lds, int unit, const LaRegs& R, int tid) {
    const int c = unit & 63, h = (unit >> 6) & 3, b = unit >> 8;
    const size_t t0 = (size_t)b * S_ + (size_t)c * 128;
    gla_decay_front(p, l, lds, R.a, h, tid);
    const float* LA = (const float*)(lds + LA_LA); bf16_t* QS = (bf16_t*)(lds + LA_QS); bf16_t* KS = (bf16_t*)(lds + LA_KS); bf16_t* PS = (bf16_t*)(lds + LA_PS);
    { const int t = tid >> 2, oct = tid & 3; float k[8], q[8]; unpack8f(k, R.k[0]); unpack8f(q, R.q[0]);
#pragma unroll
      for (int e = 0; e < 8; ++e) { const float bb = LA[t * 33 + 8 * oct + e] * LOG2E; q[e] *= __builtin_amdgcn_exp2f(bb); k[e] *= __builtin_amdgcn_exp2f(-bb); }
      *(u32x4*)(QS + t * 40 + 8 * oct) = pack8f(q); *(u32x4*)(KS + t * 40 + 8 * oct) = pack8f(k); }
    la_stage_v(lds, R.v, tid);
    { const int row = tid >> 3, oct = tid & 7; float o[8] = {R.pv[0][0], R.pv[0][1], R.pv[0][2], R.pv[0][3], R.pv[1][0], R.pv[1][1], R.pv[1][2], R.pv[1][3]}; *(u32x4*)(PS + row * 72 + 8 * oct) = pack8f(o); }
    __syncthreads();
    la_out_mfma(lds, R.g, p.in[5] + l * 64, (bf16_t*)(p.ws + WS_O) + t0 * 1024, 0 + h * 64, 64, tid);
    __syncthreads();
}
__device__ __forceinline__ void rope_cs(float pos, float invf, float& c, float& s) {
    const float ang = pos * invf; const double t = (double)ang * 0.15915494309189535; const float fr = (float)(t - floor(t));
    c = __builtin_amdgcn_cosf(fr); s = __builtin_amdgcn_sinf(fr);
}
__device__ __forceinline__ void ret_cs_table(KPRef p, unsigned char* lds, int pos0, int tid) {
    f32x2* CS = (f32x2*)(lds + LA_LA);
#pragma unroll
    for (int i = 0; i < 4; ++i) { const int idx = tid + 512 * i, t = idx >> 4, f = idx & 15; float c, s; rope_cs((float)(pos0 + t), p.inv_freq[f], c, s); CS[idx] = (f32x2){c, s}; }
}
__device__ __forceinline__ void ret_rot8(const unsigned char* lds, const u32x4& own_q, const u32x4& oth_q, int t, int oct, float (&o)[8]) {
    const f32x2* CS = (const f32x2*)(lds + LA_LA); float own[8], oth[8]; unpack8f(own, own_q); unpack8f(oth, oth_q);
#pragma unroll
    for (int e = 0; e < 8; ++e) { const f32x2 cs = CS[t * 16 + 8 * (oct & 1) + e]; o[e] = (oct < 2) ? (own[e] * cs[0] - oth[e] * cs[1]) : (oth[e] * cs[1] + own[e] * cs[0]); }
}
__device__ __forceinline__ void ret_kv_unit(KPRef p, unsigned char* lds, int unit, const LaRegs& R, int tid) {
    const int n = unit & 63, bh = unit >> 6, h = bh & 3;
    ret_cs_table(p, lds, n * 128, tid);
    la_stage_v(lds, R.v, tid);
    __syncthreads();
    bf16_t* KD = (bf16_t*)(lds + LA_KD); const float lg = p.ret_lg2[h];
    { const int t = tid >> 2, oct = tid & 3; float k[8]; ret_rot8(lds, R.k[0], R.k[1], t, oct, k); const float dk = __builtin_amdgcn_exp2f((float)(127 - t) * lg);
#pragma unroll
      for (int e = 0; e < 8; ++e) k[e] *= dk;
      *(u32x4*)(KD + t * 40 + 8 * oct) = pack8f(k); }
    __syncthreads();
    la_kv_mfma(lds, (float*)(p.ws + WS_RKV) + (size_t)unit * 2048, 1, 128, tid);
    __syncthreads();
}
__device__ __forceinline__ void ret_out_unit(KPRef p, int l, unsigned char* lds, int unit, const LaRegs& R, int tid) {
    const int n = unit & 63, bh = unit >> 6, h = bh & 3, b = bh >> 2;
    const size_t t0 = (size_t)b * S_ + (size_t)n * 128;
    ret_cs_table(p, lds, n * 128, tid);
    la_stage_v(lds, R.v, tid);
    const float lg = p.ret_lg2[h]; bf16_t* PS = (bf16_t*)(lds + LA_PS); const float g1 = __builtin_amdgcn_exp2f(lg);
    if (tid < 256) { const int row = tid >> 3, oct = tid & 7;
      float o[8] = {R.pv[0][0] * g1, R.pv[0][1] * g1, R.pv[0][2] * g1, R.pv[0][3] * g1, R.pv[1][0] * g1, R.pv[1][1] * g1, R.pv[1][2] * g1, R.pv[1][3] * g1}; *(u32x4*)(PS + row * 72 + 8 * oct) = pack8f(o); }
    __syncthreads();
    bf16_t* QS = (bf16_t*)(lds + LA_QS); bf16_t* KS = (bf16_t*)(lds + LA_KS);
    { const int t = tid >> 2, oct = tid & 3; float k[8], q[8]; ret_rot8(lds, R.k[0], R.k[1], t, oct, k); ret_rot8(lds, R.q[0], R.q[1], t, oct, q);
      const float dq = __builtin_amdgcn_exp2f((float)t * lg), dk = __builtin_amdgcn_exp2f(-(float)t * lg);
#pragma unroll
      for (int e = 0; e < 8; ++e) { q[e] *= dq; k[e] *= dk; }
      *(u32x4*)(QS + t * 40 + 8 * oct) = pack8f(q); *(u32x4*)(KS + t * 40 + 8 * oct) = pack8f(k); }
    __syncthreads();
    la_out_mfma(lds, R.g, p.in[7] + l * 64, (bf16_t*)(p.ws + WS_O) + t0 * 1024, 768 + h * 64, 128, tid);
    __syncthreads();
}
template <int KIND>
__device__ __forceinline__ void la_loop(KPRef p, int l, unsigned char* lds, int wg, int tid) {
    constexpr bool OUT = KIND >= 2, GLA = (KIND & 1) == 0; constexpr int NU = 1024, G = 256;
    int u = wg; if (u >= NU) return;
    LaRegs R; la_load<OUT, GLA>(R, p, u, tid);
    for (;;) {
        const int un = u + G; const bool hn = un < NU;
        LaRegs Rn; if (hn) la_load<OUT, GLA>(Rn, p, un, tid);
        if (KIND == 0) gla_kv_unit(p, l, lds, u, R, tid); else if (KIND == 1) ret_kv_unit(p, lds, u, R, tid); else if (KIND == 2) gla_out_unit(p, l, lds, u, R, tid); else ret_out_unit(p, l, lds, u, R, tid);
        if (!hn) break;
        R = Rn; u = un;
    }
}

__device__ __forceinline__ void scan_phase(KPRef p, int wg, int tid) {
    if (wg < 64) {
        const int bh = wg >> 2, elem = (wg & 3) * 512 + tid, d = elem >> 6;
        float* base = (float*)(p.ws + WS_GKV) + (size_t)bh * 128 * 2048 + elem; const float* dec = (const float*)(p.ws + WS_GDEC) + (size_t)bh * 128 * 32 + d;
        float s = 0.f;
#pragma unroll 1
        for (int n0 = 0; n0 < 128; n0 += 32) { float kv[32], dc[32];
#pragma unroll
            for (int j = 0; j < 32; ++j) { kv[j] = base[(size_t)(n0 + j) * 2048]; dc[j] = dec[(n0 + j) * 32]; }
#pragma unroll
            for (int j = 0; j < 32; ++j) { base[(size_t)(n0 + j) * 2048] = s; s = dc[j] * s + kv[j]; } }
    } else if (wg < 128) {
        const int w2 = wg - 64, bh = w2 >> 2, h = bh & 3, elem = (w2 & 3) * 512 + tid;
        float* base = (float*)(p.ws + WS_RKV) + (size_t)bh * 64 * 2048 + elem; const float dc = __builtin_amdgcn_exp2f(128.0f * p.ret_lg2[h]);
        float s = 0.f;
#pragma unroll 1
        for (int n0 = 0; n0 < 64; n0 += 32) { float kv[32];
#pragma unroll
            for (int j = 0; j < 32; ++j) kv[j] = base[(size_t)(n0 + j) * 2048];
#pragma unroll
            for (int j = 0; j < 32; ++j) { base[(size_t)(n0 + j) * 2048] = s; s = dc * s + kv[j]; } }
    }
}

__device__ __forceinline__ void kmean_unit(KPRef p, float* sm, int unit, int tid) {
    const bf16_t* z = (const bf16_t*)(p.ws + WS_Z); const size_t t0 = (size_t)unit * 256;
    const int oct = tid & 31, grp = tid >> 5; float s[8] = {0.f, 0.f, 0.f, 0.f, 0.f, 0.f, 0.f, 0.f};
    u32x4 q[16];
#pragma unroll
    for (int i = 0; i < 16; ++i) q[i] = *(const u32x4*)(z + (t0 + grp * 16 + i) * ZW + Z_MK + 8 * oct);
#pragma unroll
    for (int i = 0; i < 16; ++i) { float v[8]; unpack8f(v, q[i]);
#pragma unroll
        for (int e = 0; e < 8; ++e) s[e] += v[e]; }
#pragma unroll
    for (int e = 0; e < 8; ++e) sm[grp * 264 + 8 * oct + e] = s[e];
    __syncthreads();
    if (tid < 256) { float a = 0.f;
#pragma unroll
        for (int g2 = 0; g2 < 16; ++g2) a += sm[g2 * 264 + tid];
        ((float*)(p.ws + WS_KMEAN))[(size_t)unit * 256 + tid] = a * (1.0f / 256.0f); }
    __syncthreads();
}

constexpr int AT_BUF = 65536  , AT_PW = 131072, AT_PW_WAVE = 2304, AT_WSF = 149504, LDS_MTAB = 151552;
__device__ __forceinline__ void att_dma(unsigned char* lds, int buf, const bf16_t* kg, const bf16_t* vg, int key_lo_valid, int tid) {
    const int lane = tid & 63, wave = __builtin_amdgcn_readfirstlane(tid >> 6);
#pragma unroll
    for (int i = 0; i < 4; ++i) { const int j = wave * 4 + i, row = 8 * j + (lane >> 3), pos = lane & 7; const int srow = row < key_lo_valid ? key_lo_valid : row;
        const size_t goff = (size_t)srow * ZW + 8 * (pos ^ (row & 7));
        __builtin_amdgcn_global_load_lds((const unsigned*)(kg + goff), (LAS unsigned*)(LAS unsigned char*)(lds + buf * AT_BUF + j * 1024), 16, 0, 0);
        __builtin_amdgcn_global_load_lds((const unsigned*)(vg + goff), (LAS unsigned*)(LAS unsigned char*)(lds + buf * AT_BUF + 32768 + j * 1024), 16, 0, 0); }
}
struct QPtrs { const bf16_t* p[2]; };
template <class Fn>
__device__ __forceinline__ QPtrs att_qptrs(const Fn& F, int tid) {
    const int lane = tid & 63, wave = __builtin_amdgcn_readfirstlane(tid >> 6), c16 = lane & 15; QPtrs q;
#pragma unroll
    for (int rt = 0; rt < 2; ++rt) q.p[rt] = F.rowptr(32 * wave + 16 * rt + c16);
    return q;
}
__device__ __forceinline__ void att_loadq(bf16x8 (&Q)[2][2], const QPtrs& qp, int tid) {
    const int g = (tid & 63) >> 4;
#pragma unroll
    for (int rt = 0; rt < 2; ++rt) { Q[rt][0] = *(const bf16x8*)(qp.p[rt] + 8 * g); Q[rt][1] = *(const bf16x8*)(qp.p[rt] + 32 + 8 * g); }
}
__device__ __forceinline__ bf16x8 tr_frag_sw(const unsigned char* tile, int rowa, int rowb, int col0, int lane) {
    const int i = lane & 15, q = i >> 2, pp = i & 3, ch = (col0 >> 3) + (pp >> 1), sub = (pp & 1) * 8, ra = rowa + q, rb = rowb + q;
    const v4i16_t lo = lds_tr16((const bf16_t*)(tile + ra * 128 + ((ch ^ (ra & 7)) << 4) + sub)), hi = lds_tr16((const bf16_t*)(tile + rb * 128 + ((ch ^ (rb & 7)) << 4) + sub));
    return (bf16x8){lo[0], lo[1], lo[2], lo[3], hi[0], hi[1], hi[2], hi[3]};
}
template <class Fn>
__device__ __forceinline__ void att_compute(unsigned char* lds, int buf, const Fn& F, bf16x8 (&Q)[2][2], const QPtrs& qnext, bool has_next, int tid) {
    const int lane = tid & 63, wave = __builtin_amdgcn_readfirstlane(tid >> 6), c16 = lane & 15, g = lane >> 4;
    const unsigned char* KS = lds + buf * AT_BUF; const unsigned char* VS = KS + 32768; bf16_t* PW = (bf16_t*)(lds + AT_PW + wave * AT_PW_WAVE); float* WSF = (float*)(lds + AT_WSF + wave * 256);
#pragma unroll 1
    for (int rt = 0; rt < 2; ++rt) {
        const int rbase = 32 * wave + 16 * rt;
        const typename Fn::Pre pre = F.prefetch(rbase, lane);
        const bf16x8 qa0 = rt ? Q[1][0] : Q[0][0], qa1 = rt ? Q[1][1] : Q[0][1];
        f32x4 S[16]; float m = -1e30f;
#pragma unroll
        for (int ct = 0; ct < 16; ++ct) {
            if (F.live(rbase, ct)) {
                const int R = 16 * ct + c16; const unsigned char* kp = KS + R * 128;
                const bf16x8 k0 = *(const bf16x8*)(kp + ((g ^ (R & 7)) << 4)), k1 = *(const bf16x8*)(kp + (((4 + g) ^ (R & 7)) << 4));
                f32x4 acc = (f32x4){0.f, 0.f, 0.f, 0.f}; acc = MFMA16(k0, qa0, acc); acc = MFMA16(k1, qa1, acc);
                if (Fn::MASKED) {
#pragma unroll
                    for (int r = 0; r < 4; ++r) { int kk = 16 * ct + 4 * g + r; asm volatile("" : "+v"(kk), "+v"(acc[r]));
                        acc[r] += F.pen(rbase + c16, kk); } }
                m = fmaxf(fmaxf(m, fmaxf(acc[0], acc[1])), fmaxf(acc[2], acc[3])); S[ct] = acc;
            } else S[ct] = (f32x4){-1e30f, -1e30f, -1e30f, -1e30f};
        }
        if (rt == 1 && has_next) att_loadq(Q, qnext, tid);
        m = fmaxf(m, __shfl_xor(m, 16)); m = fmaxf(m, __shfl_xor(m, 32));
        float l = 0.f;
#pragma unroll
        for (int ct = 0; ct < 16; ++ct) {
            if (F.live(rbase, ct)) {
#pragma unroll
                for (int r = 0; r < 4; ++r) { const float pr = __builtin_amdgcn_exp2f(S[ct][r] - m); S[ct][r] = pr; l += pr; }
            } else S[ct] = (f32x4){0.f, 0.f, 0.f, 0.f};
        }
        l += __shfl_xor(l, 16); l += __shfl_xor(l, 32);
        f32x4 O[4];
#pragma unroll
        for (int dt = 0; dt < 4; ++dt) O[dt] = (f32x4){0.f, 0.f, 0.f, 0.f};
#pragma unroll
        for (int s8 = 0; s8 < 8; ++s8) if (F.live(rbase, 2 * s8) || F.live(rbase, 2 * s8 + 1)) { const bf16x8 pa = pack_p(S[2 * s8], S[2 * s8 + 1]);
#pragma unroll
            for (int dt = 0; dt < 4; ++dt) O[dt] = MFMA16(pa, tr_frag_sw(VS, 32 * s8 + 4 * g, 32 * s8 + 16 + 4 * g, 16 * dt, lane), O[dt]); }
        float f[4];
#pragma unroll
        for (int r = 0; r < 4; ++r) { const float mr = __shfl(m, 4 * g + r), lr = __shfl(l, 4 * g + r); f[r] = F.scale(rbase + 4 * g + r, mr, lr, pre, r, WSF + (4 * g + r) * 4, c16 == 0); }
#pragma unroll
        for (int dt = 0; dt < 4; ++dt)
#pragma unroll
            for (int r = 0; r < 4; ++r) PW[(4 * g + r) * 72 + 16 * dt + c16] = (bf16_t)f2bf(O[dt][r] * f[r]);
        LDS_WAIT();
#pragma unroll
        for (int i = 0; i < 2; ++i) { const int ch = lane + 64 * i, row = ch >> 3, oct = ch & 7;
            const u32x4 v = *(const u32x4*)(PW + row * 72 + 8 * oct); F.store(rbase + row, oct, v, pre, i, WSF + row * 4); }
        LDS_WAIT();
    }
}
template <class Fn, class Gen>
__device__ __forceinline__ void attn_loop(unsigned char* lds, const Gen& G, int tid) {
    Fn Fc, Fx; const bf16_t* kg; const bf16_t* vg; int lo;
    bool have = G.get(0, Fc, kg, vg, lo);
    if (!have) return;
    bf16x8 Q[2][2];
    att_dma(lds, 0, kg, vg, lo, tid); { const QPtrs q0 = att_qptrs(Fc, tid); att_loadq(Q, q0, tid); }
    int buf = 0;
    for (int i = 1; have; ++i) {
        asm volatile("s_waitcnt vmcnt(0)" ::: "memory");
        __syncthreads();
        const bool hn = G.get(i, Fx, kg, vg, lo);
        QPtrs qn; qn.p[0] = nullptr; qn.p[1] = nullptr;
        if (hn) { att_dma(lds, buf ^ 1, kg, vg, lo, tid); qn = att_qptrs(Fx, tid); }
        att_compute(lds, buf, Fc, Q, qn, hn, tid);
        Fc = Fx; have = hn; buf ^= 1;
    }
    asm volatile("s_waitcnt vmcnt(0)" ::: "memory");
    __syncthreads();
}
struct NoPre {};

struct SwaFn { typedef NoPre Pre; static constexpr bool MASKED = true;
    __device__ __forceinline__ bool live(int rbase, int ct) const { const int i0 = rbase & 127; return 16 * ct + 15 >= i0 + 1 && 16 * ct <= i0 + 143; } const bf16_t* z; bf16_t* ob; size_t tb; int q0, kvh; float sink2_0, sink2_1;
    __device__ __forceinline__ const bf16_t* rowptr(int row) const { return z + (tb + q0 + (row & 127)) * ZW + Z_SQ + (kvh * 2 + (row >> 7)) * 64; }
    __device__ __forceinline__ float pen(int row, int kk) const { const int d = (row & 127) + 128 - kk; return __int_as_float(((d | (127 - d) | (q0 - 128 + kk)) >> 31) & (int)0xF149F2CAu); }
    __device__ __forceinline__ NoPre prefetch(int, int) const { return NoPre{}; }
    __device__ __forceinline__ float scale(int row, float m, float l, const NoPre&, int, float*, bool) const { const float sk = (row >> 7) ? sink2_1 : sink2_0; const float M = fmaxf(m, sk), w0 = __builtin_amdgcn_exp2f(m - M);
        return w0 / (l * w0 + __builtin_amdgcn_exp2f(sk - M)); }
    __device__ __forceinline__ void store(int row, int oct, u32x4 v, const NoPre&, int, const float*) const { *(u32x4*)(ob + (tb + q0 + (row & 127)) * 1024 + 256 + (kvh * 2 + (row >> 7)) * 64 + 8 * oct) = v; }
};
struct SwaGen { const bf16_t* z; bf16_t* ob; const float* sinks; int wg, G;
    __device__ __forceinline__ bool get(int i, SwaFn& F, const bf16_t*& kg, const bf16_t*& vg, int& lo) const {
        const int unit = wg + i * G; if (unit >= 512) return false;
        const int qb = unit & 63, kvh = (unit >> 6) & 1, b = unit >> 7; const size_t tb = (size_t)b * S_; const int q0 = qb * 128;
        F = SwaFn{z, ob, tb, q0, kvh, sinks[kvh * 2] * LOG2E, sinks[kvh * 2 + 1] * LOG2E};
        const long kb = (long)tb + q0 - 128;
        kg = z + kb * ZW + Z_SK + kvh * 64; vg = z + kb * ZW + Z_SV + kvh * 64; lo = (q0 == 0) ? 128 : 0; return true; }
};

constexpr int ML_PER_BH = 126976;
__device__ __forceinline__ int ml_off(int j) { return 256 * (31 * j - (j * (j - 1)) / 2); }
__device__ __forceinline__ void moba_select(KPRef p, unsigned char* lds, int wg, int tid) {
    const int gid = wg * NTHREADS + tid, t = gid >> 2, h = gid & 3, b = t >> 13, tl = t & 8191, blk = tl >> 8;
    const bf16_t* z = (const bf16_t*)(p.ws + WS_Z);
    f32x4* kml = (f32x4*)lds; const f32x4* kmg = (const f32x4*)((const float*)(p.ws + WS_KMEAN) + (size_t)b * 32 * 256);
    for (int i = tid; i < blk * 64; i += NTHREADS) kml[i] = kmg[i];
    float q[64];
    { const bf16_t* qp = z + (size_t)t * ZW + Z_MQ + h * 64;
#pragma unroll
      for (int c = 0; c < 8; ++c) { const u32x4 kk = *(const u32x4*)(qp + 8 * c);
        q[8 * c + 0] = __uint_as_float(kk.x << 16); q[8 * c + 1] = __uint_as_float(kk.x & 0xffff0000u); q[8 * c + 2] = __uint_as_float(kk.y << 16); q[8 * c + 3] = __uint_as_float(kk.y & 0xffff0000u);
        q[8 * c + 4] = __uint_as_float(kk.z << 16); q[8 * c + 5] = __uint_as_float(kk.z & 0xffff0000u); q[8 * c + 6] = __uint_as_float(kk.w << 16); q[8 * c + 7] = __uint_as_float(kk.w & 0xffff0000u); } }
    __syncthreads();
    float v0 = -3e38f, v1 = -3e38f, v2 = -3e38f; int i0 = -1, i1 = -1, i2 = -1;
#pragma unroll 1
    for (int nb = 0; nb < blk; ++nb) { const f32x4* kr = kml + nb * 64 + h * 16; float s = 0.f;
#pragma unroll
        for (int c = 0; c < 16; ++c) { const f32x4 kv = kr[c]; s += q[4 * c] * kv[0] + q[4 * c + 1] * kv[1] + q[4 * c + 2] * kv[2] + q[4 * c + 3] * kv[3]; }
        if (s > v0) { v2 = v1; i2 = i1; v1 = v0; i1 = i0; v0 = s; i0 = nb; } else if (s > v1) { v2 = v1; i2 = i1; v1 = s; i1 = nb; } else if (s > v2) { v2 = s; i2 = nb; } }
    int* cnt = (int*)(p.ws + WS_MCNT) + (b * 4 + h) * 32; int* lst = (int*)(p.ws + WS_MLIST) + (size_t)(b * 4 + h) * ML_PER_BH; f32x2* pml = (f32x2*)(p.ws + WS_PARTML) + (size_t)gid * 3;
#pragma unroll
    for (int s3 = 0; s3 < 3; ++s3) { const int sb = (s3 == 0) ? i0 : (s3 == 1 ? i1 : i2);
        if (sb >= 0) { const int pos = atomicAdd(cnt + sb, 1); lst[ml_off(sb) + pos] = tl | (s3 << 13); }
        else pml[s3] = (f32x2){-1e30f, 0.f}; }
    __syncthreads();
}
struct MobaSelFn { typedef NoPre Pre; static constexpr bool MASKED = false;
    __device__ __forceinline__ bool live(int, int) const { return true; } const bf16_t* z; const int* lst; bf16_t* po; f32x2* pml; size_t tb; int h, n_valid;
    __device__ __forceinline__ int entry(int row) const { return lst[row < n_valid ? row : 0]; }
    __device__ __forceinline__ const bf16_t* rowptr(int row) const { return z + (tb + (entry(row) & 8191)) * ZW + Z_MQ + h * 64; }
    __device__ __forceinline__ float pen(int, int) const { return 0.f; }
    __device__ __forceinline__ NoPre prefetch(int, int) const { return NoPre{}; }
    __device__ __forceinline__ size_t pidx(int e) const { return ((tb + (e & 8191)) * 4 + h) * 3 + (e >> 13); }
    __device__ __forceinline__ float scale(int row, float m, float l, const NoPre&, int, float*, bool writer) const { if (writer && row < n_valid) pml[pidx(lst[row])] = (f32x2){m, l}; return 1.0f / l; }
    __device__ __forceinline__ void store(int row, int oct, u32x4 v, const NoPre&, int, const float*) const { if (row < n_valid) *(u32x4*)(po + pidx(lst[row]) * 64 + 8 * oct) = v; }
};
__device__ __forceinline__ void moba_sel_table(KPRef p, unsigned char* lds, int tid) {
    int* tab = (int*)(lds + LDS_MTAB); const int lane = tid & 63, wave = tid >> 6;
    const int cnt = ((const int*)(p.ws + WS_MCNT))[tid]; int v = (cnt + 255) >> 8;
    const int own = v;
#pragma unroll
    for (int o = 1; o < 64; o <<= 1) { const int t = __shfl_up(v, o); if (lane >= o) v += t; }
    if (lane == 63) tab[520 + wave] = v;
    __syncthreads();
    int base = 0;
    for (int w = 0; w < wave; ++w) base += tab[520 + w];
    tab[tid] = base + v - own;
    tab[544 + tid] = cnt;
    if (tid == 511) tab[512] = base + v;
    __syncthreads();
}
struct MobaSelGen { const bf16_t* z; const int* lists; const int* cnts; bf16_t* po; f32x2* pml; const int* tab; int wg, G;
    __device__ __forceinline__ bool get(int i, MobaSelFn& F, const bf16_t*& kg, const bf16_t*& vg, int& lo) const {
        const int u = wg + i * G; if (u >= tab[512]) return false;
        int lo_ = 0, hi_ = 511;
        while (lo_ < hi_) { const int mid = (lo_ + hi_ + 1) >> 1; if (tab[mid] <= u) lo_ = mid; else hi_ = mid - 1; }
        const int k = __builtin_amdgcn_readfirstlane(lo_), c = u - tab[k], bh = k >> 5, j = k & 31, b = bh >> 2, h = bh & 3;
        const int cnt = tab[544 + k]; const int nv = cnt - c * 256; const size_t tb = (size_t)b * S_;
        F = MobaSelFn{z, lists + (size_t)bh * ML_PER_BH + ml_off(j) + c * 256, po, pml, tb, h, nv < 256 ? nv : 256};
        kg = z + (tb + j * 256) * ZW + Z_MK + h * 64; vg = z + (tb + j * 256) * ZW + Z_MV + h * 64; lo = 0; return true; }
};
struct MobaOwnFn { typedef NoPre Pre; static constexpr bool MASKED = true;
    __device__ __forceinline__ bool live(int rbase, int ct) const { return 16 * ct <= rbase + 15; } const bf16_t* z; bf16_t* ob; const bf16_t* po; const f32x2* pml; size_t t0; int h;
    __device__ __forceinline__ const bf16_t* rowptr(int row) const { return z + (t0 + row) * ZW + Z_MQ + h * 64; }
    __device__ __forceinline__ float pen(int row, int kk) const { return __int_as_float(((row - kk) >> 31) & (int)0xF149F2CAu); }
    __device__ __forceinline__ NoPre prefetch(int, int) const { return NoPre{}; }
    __device__ __forceinline__ float scale(int row, float m, float l, const NoPre&, int, float* wsf, bool writer) const {
        const f32x2* ml = pml + ((t0 + row) * 4 + h) * 3; const f32x2 a = ml[0], b = ml[1], c = ml[2];
        const float M = fmaxf(fmaxf(m, a[0]), fmaxf(b[0], c[0]));
        const float w0 = __builtin_amdgcn_exp2f(m - M), wa = a[1] * __builtin_amdgcn_exp2f(a[0] - M), wb = b[1] * __builtin_amdgcn_exp2f(b[0] - M), wc = c[1] * __builtin_amdgcn_exp2f(c[0] - M);
        const float inv = 1.0f / (l * w0 + wa + wb + wc);
        if (writer) { wsf[0] = wa * inv; wsf[1] = wb * inv; wsf[2] = wc * inv; }
        return w0 * inv; }
    __device__ __forceinline__ void store(int row, int oct, u32x4 v, const NoPre&, int, const float* wsf) const {
        float o[8]; unpack8f(o, v); const bf16_t* pr = po + (((t0 + row) * 4 + h) * 3) * 64 + 8 * oct;
        u32x4 pc[3];
#pragma unroll
        for (int s = 0; s < 3; ++s) pc[s] = (wsf[s] != 0.f) ? *(const u32x4*)(pr + s * 64) : (u32x4){0u, 0u, 0u, 0u};
#pragma unroll
        for (int s = 0; s < 3; ++s) { const float w = wsf[s]; float q[8]; unpack8f(q, pc[s]);
#pragma unroll
            for (int e = 0; e < 8; ++e) o[e] += w * q[e]; }
        *(u32x4*)(ob + (t0 + row) * 1024 + 512 + h * 64 + 8 * oct) = pack8f(o); }
};
struct MobaOwnGen { const bf16_t* z; bf16_t* ob; const bf16_t* po; const f32x2* pml; int wg, G;
    __device__ __forceinline__ bool get(int i, MobaOwnFn& F, const bf16_t*& kg, const bf16_t*& vg, int& lo) const {
        const int unit = wg + i * G; if (unit >= 512) return false;
        const int qb = unit & 31, h = (unit >> 5) & 3, b = unit >> 7; const size_t t0 = (size_t)b * S_ + (size_t)qb * 256;
        F = MobaOwnFn{z, ob, po, pml, t0, h}; kg = z + t0 * ZW + Z_MK + h * 64; vg = z + t0 * ZW + Z_MV + h * 64; lo = 0; return true; }
};

__device__ __forceinline__ void route_phase(KPRef p, int l, float* sm, int wg, int tid) {
    int* se = (int*)sm;
    int* toke = (int*)(p.ws + WS_TOKE); float* tokw = (float*)(p.ws + WS_TOKW); int* tokr = (int*)(p.ws + WS_TOKR); int* hist = (int*)(p.ws + WS_HIST); int* sdst = (int*)(p.ws + WS_SDST);
    if (tid < 128) { const int t = wg * 128 + tid; const float* lg = (const float*)(p.ws + WS_LOGIT) + (size_t)t * 64; const float* bg = p.in[12] + l * 4; const float* be = p.in[14] + l * 32;
        float g0 = lg[0] + bg[0], g1 = lg[1] + bg[1], g2 = lg[2] + bg[2], g3 = lg[3] + bg[3];
        int gs = 0; float gm = g0; if (g1 > gm) { gm = g1; gs = 1; } if (g2 > gm) { gm = g2; gs = 2; } if (g3 > gm) { gm = g3; gs = 3; }
        const float gw_ = 1.0f / (expf(g0 - gm) + expf(g1 - gm) + expf(g2 - gm) + expf(g3 - gm));
        float v0 = -3e38f, v1 = -3e38f; int i0 = 0, i1 = 0;
#pragma unroll
        for (int j = 0; j < 8; ++j) { const float s = lg[4 + 8 * gs + j] + be[8 * gs + j]; if (s > v0) { v1 = v0; i1 = i0; v0 = s; i0 = j; } else if (s > v1) { v1 = s; i1 = j; } }
        const float e1 = expf(v1 - v0), w0 = 1.0f / (1.0f + e1), w1 = e1 * w0;
        const int ea = 8 * gs + i0, eb = 8 * gs + i1;
        se[2 * tid] = ea; se[2 * tid + 1] = eb; toke[2 * t] = ea; toke[2 * t + 1] = eb; tokw[2 * t] = w0 * gw_; tokw[2 * t + 1] = w1 * gw_; }
    __syncthreads();
    if (tid < 256) { const int e = se[tid]; int r = 0;
#pragma unroll 4
        for (int a = 0; a < tid; ++a) r += (se[a] == e) ? 1 : 0; tokr[wg * 256 + tid] = r; }
    if (tid >= 256 && tid < 288) { const int e = tid - 256; int c = 0;
#pragma unroll 4
        for (int a = 0; a < 256; ++a) c += (se[a] == e) ? 1 : 0; hist[wg * 32 + e] = c; }
    for (int i = tid; i < NSLOTBLK; i += NTHREADS) sdst[wg * NSLOTBLK + i] = YS_TRASH_ROW;
    __syncthreads();
}
__device__ __forceinline__ void assign_phase(KPRef p, float* sm, int wg, int tid, int wave, int lane) {
    int* cnt = (int*)sm, *bas = cnt + 32, *pend = cnt + 64, *slot_of = cnt + 128;
    const int* hist = (const int*)(p.ws + WS_HIST); const int* toke = (const int*)(p.ws + WS_TOKE); const int* tokr = (const int*)(p.ws + WS_TOKR);
    int* sdst = (int*)(p.ws + WS_SDST); int* blke = (int*)(p.ws + WS_BLKE);
    {
        int* part = cnt + 512;
        const int e = tid & 31, grp = tid >> 5; int c = 0, bb = 0; int v[16];
#pragma unroll
        for (int i = 0; i < 16; ++i) v[i] = hist[(grp * 16 + i) * 32 + e];
#pragma unroll
        for (int i = 0; i < 16; ++i) { c += v[i]; if (grp * 16 + i < wg) bb += v[i]; }
        part[grp * 64 + e] = c; part[grp * 64 + 32 + e] = bb;
        __syncthreads();
        if (tid < 32) { int cs = 0, bs = 0;
#pragma unroll
            for (int g2 = 0; g2 < 16; ++g2) { cs += part[g2 * 64 + tid]; bs += part[g2 * 64 + 32 + tid]; }
            cnt[tid] = cs; bas[tid] = bs; }
    }
    __syncthreads();
    if (tid == 0) { int run = 0; for (int e = 0; e < 32; ++e) { const int pad = ((cnt[e] + 255) >> 8) << 8; bas[e] += run; run += pad; pend[e] = run; } }
    __syncthreads();
    if (wg == 0) { if (tid < NSLOTBLK) { int e = 0; for (int k = 0; k < 32; ++k) e += (pend[k] <= tid * 256) ? 1 : 0; blke[tid] = e > 31 ? 31 : e; } if (tid == 0) blke[511] = pend[31] >> 8; }
    if (tid < 256) { const int a = wg * 256 + tid; const int e = toke[a]; const int slot = bas[e] + tokr[a]; sdst[slot] = a; slot_of[tid] = slot; }
    __syncthreads();
    const float* su = (const float*)(p.ws + WS_SU); float* xss = (float*)(p.ws + WS_XSS);
    if (tid < 256) xss[slot_of[tid]] = su[wg * 128 + (tid >> 1)];
    __syncthreads();
}

#ifndef MK_PER_PHASE
#define MK_PER_PHASE 0
#endif
constexpr int PH_PER_LAYER = 18, N_PHASES = DEPTH_ * PH_PER_LAYER + 1;
constexpr int CW_BAR = 1024;

__global__ void __launch_bounds__(NTHREADS, 2) mega(Params p_unused) {
    extern __shared__ __attribute__((aligned(16))) unsigned char lds[];
    const int tid0 = threadIdx.x;
    constexpr int G = 256, NGW = G * NWAVES;
    const int wg = blockIdx.x;
#define SUB_BEGIN() KPRef p = *KP(); unsigned char* ws = p.ws; (void)ws; int tid = threadIdx.x; asm volatile("" : "+v"(tid))
#define PHASE_BEGIN() KPRef p = *KP(); unsigned char* ws = p.ws; (void)ws; unsigned char* wl = (l == 0) ? p.ws : (unsigned char*)p.out; (void)wl; const size_t sl = (size_t)l * SW_LSTEP; (void)sl; int tid = threadIdx.x; asm volatile("" : "+v"(tid)); const int lane = tid & 63, wave = __builtin_amdgcn_readfirstlane(tid >> 6), gw = wg * NWAVES + wave; (void)lane; (void)gw
    volatile LAS unsigned* MISC = (volatile LAS unsigned*)((LAS unsigned char*)lds + MISC_OFF);
    for (int u = tid0; u < (LDS_BYTES - LDSCTL_OFF) / 4; u += NTHREADS) ((LAS unsigned*)((LAS unsigned char*)lds + LDSCTL_OFF))[u] = 0u;
    __syncthreads();
#define KP() ({ const __attribute__((address_space(4))) Params* _k = (const __attribute__((address_space(4))) Params*)__builtin_amdgcn_kernarg_segment_ptr(); asm volatile("" : "+s"(_k)); _k; })
    unsigned* ctl; { const __attribute__((address_space(4))) Params* k0 = KP(); ctl = (unsigned*)(k0->ws + WS_CTL); }
    XcdBarrier bar = xcd_barrier_post(ctl + CW_BAR, MISC + 8);
    int lo, hi; { const __attribute__((address_space(4))) Params* k0 = KP(); lo = k0->ph_lo; hi = k0->ph_hi; }
    float* sm = (float*)lds;
    PG8_LAS unsigned char* ring = (PG8_LAS unsigned char*)lds;
#ifndef PH_MASK
#define PH_MASK 0x7ffffu
#endif
#define IN(k) ((((PH_MASK) >> ((k) == DEPTH_ * PH_PER_LAYER ? 18 : ((k) % PH_PER_LAYER))) & 1u) && lo <= (k) && (k) < hi)
#define SEAM(k) do { if ((k) + 1 < hi) xcd_barrier(bar); } while (0)
#ifndef REPEAT_MASK
#define REPEAT_MASK 0u
#endif
#ifndef URM
#define URM 0u
#endif
#define UREP(bit) for (int ur_ = 0; ur_ < ((((URM) >> (bit)) & 1u) ? 2 : 1); ++ur_)
#ifndef REPEAT_L0
#define REPEAT_L0 0u
#endif
#define NREP(k) (((((REPEAT_MASK) >> ((k) % PH_PER_LAYER)) & 1u) || ((((REPEAT_L0) >> ((k) % PH_PER_LAYER)) & 1u) && (k) < PH_PER_LAYER)) ? 2 : 1)

    for (int l = 0; l < DEPTH_; ++l) {
        const int P0 = l * PH_PER_LAYER;
        if (IN(P0 + 0)) for (int rep_ = 0; rep_ < NREP(P0 + 0); ++rep_) { PHASE_BEGIN();
            if (l == 0) { UREP(8) { conv8_pass<0>(p, 0, ws, lds, gw, NGW, wave, lane); conv8_pass<0>(p, 1, ws, lds, gw, NGW, wave, lane); } }
            if (l == 0) norm_phase<0>(p, l, gw, NGW, lane); else norm_phase<1>(p, l, gw, NGW, lane);
            SEAM(P0 + 0);
        }
        if (l == 0 && IN(P0 + 1)) for (int rep_ = 0; rep_ < NREP(P0 + 1); ++rep_) { PHASE_BEGIN();
            conv8_pass<1>(p, 0, ws, lds, gw, NGW, wave, lane);
            conv_phase(p, 0, ws, lds, gw, NGW, wave, lane);
            SEAM(P0 + 1);
        }
        if (IN(P0 + 2)) for (int rep_ = 0; rep_ < NREP(P0 + 2); ++rep_) { PHASE_BEGIN();
            pg8::Gemm g{(const bf16_t*)(ws + WS_U8), (const bf16_t*)(wl + WS_WIN)};
            pg8::StaticOrder<T_ / 256, ZW / 256, 1024, 1024> S{G, wg, 0};
            pg8::EpiBf16S E{(bf16_t*)(ws + WS_Z), ZW, (const float*)(ws + WS_SU), (const float*)(ws + WS_SWIN + sl)};
            pg8::gemm_phase<1024, 1024, 1024, true, true>(ring, g, S, E);
            SEAM(P0 + 2);
        }
        if (IN(P0 + 3)) for (int rep_ = 0; rep_ < NREP(P0 + 3); ++rep_) { PHASE_BEGIN();
            if (wg == 0) { int* cnt = (int*)(ws + WS_MCNT); cnt[tid] = 0; }
            UREP(0) { SUB_BEGIN(); la_loop<0>(p, l, lds, wg, tid); }
            UREP(1) { SUB_BEGIN(); la_loop<1>(p, l, lds, wg, tid); }
            UREP(2) { SUB_BEGIN(); for (int u = wg; u < 128; u += G) kmean_unit(p, sm, u, tid); }
            UREP(3) { SUB_BEGIN(); SwaGen SG{(const bf16_t*)(ws + WS_Z), (bf16_t*)(ws + WS_O), p.in[6] + l * 4, wg, G}; attn_loop<SwaFn>(lds, SG, tid); }
            SEAM(P0 + 3);
        }
        if (IN(P0 + 4)) for (int rep_ = 0; rep_ < NREP(P0 + 4); ++rep_) { PHASE_BEGIN(); moba_select(p, lds, wg, tid); { const int s = ((wg & 63) < 32) ? (wg >> 6) * 32 + (wg & 31) : 255; scan_phase(p, s, tid); }   SEAM(P0 + 4); }
        if (IN(P0 + 5)) for (int rep_ = 0; rep_ < NREP(P0 + 5); ++rep_) { PHASE_BEGIN();
            UREP(4) { SUB_BEGIN(); la_loop<2>(p, l, lds, wg, tid); }
            UREP(5) { SUB_BEGIN(); la_loop<3>(p, l, lds, wg, tid); }
            UREP(6) { SUB_BEGIN(); moba_sel_table(p, lds, tid); MobaSelGen MG{(const bf16_t*)(ws + WS_Z), (const int*)(ws + WS_MLIST), (const int*)(ws + WS_MCNT), (bf16_t*)(ws + WS_PARTO), (f32x2*)(ws + WS_PARTML), (const int*)(lds + LDS_MTAB), wg, G}; attn_loop<MobaSelFn>(lds, MG, tid); }
            SEAM(P0 + 5);
        }
        if (IN(P0 + 6)) for (int rep_ = 0; rep_ < NREP(P0 + 6); ++rep_) { PHASE_BEGIN();
            UREP(7) { SUB_BEGIN(); MobaOwnGen OG{(const bf16_t*)(ws + WS_Z), (bf16_t*)(ws + WS_O), (const bf16_t*)(ws + WS_PARTO), (const f32x2*)(ws + WS_PARTML), wg, G}; attn_loop<MobaOwnFn>(lds, OG, tid); }
            SEAM(P0 + 6);
        }
        for (int hf = 0; hf < 2; ++hf) {
            if (IN(P0 + 7 + 2 * hf)) for (int rep_ = 0; rep_ < NREP(P0 + 7 + 2 * hf); ++rep_) { PHASE_BEGIN();
                pg8::Gemm g{(const bf16_t*)(ws + WS_O), (const bf16_t*)(wl + WS_WB)};
                pg8::StaticOrder<T_ / 512, 16, 2048, 512, 2, 512> S{G, wg, 64 * hf};
                pg8::EpiBf16 E{(bf16_t*)(ws + WS_YH), 4096, 16384 * hf};
                pg8::gemm_phase<2048, 512, 512, false, true>(ring, g, S, E);
                SEAM(P0 + 7 + 2 * hf);
            }
            if (IN(P0 + 8 + 2 * hf)) for (int rep_ = 0; rep_ < NREP(P0 + 8 + 2 * hf); ++rep_) { PHASE_BEGIN();
                pg8::Gemm g{(const bf16_t*)(ws + WS_U8), (const bf16_t*)(wl + WS_WG)};
                pg8::StaticOrder<T_ / 512, 16, 1024, 1024> S{G, wg, 64 * hf};
                pg8::EpiGate E{(const bf16_t*)(ws + WS_YH), 16384 * hf, (bf16_t*)(ws + WS_O), (const float*)(ws + WS_SU), (const float*)(ws + WS_SWG + sl)};
                pg8::gemm_phase<1024, 1024, 1024, true, true>(ring, g, S, E);
                SEAM(P0 + 8 + 2 * hf);
            }
        }
        if (IN(P0 + 11)) for (int rep_ = 0; rep_ < NREP(P0 + 11); ++rep_) { PHASE_BEGIN();
            pg8::Gemm g{(const bf16_t*)(ws + WS_O), (const bf16_t*)(wl + WS_WO)};
            pg8::StaticOrder<T_ / 256, 4, 2048, 2048> S{G, wg, 0};
            if (l == 0) { pg8::EpiRes<true> E{(const void*)p.in[0], hbf_ptr(p)}; pg8::gemm_phase<2048, 2048, 2048, false, true>(ring, g, S, E); }
            else { pg8::EpiRes<false> E{(const void*)hbf_ptr(p), hbf_ptr(p)}; pg8::gemm_phase<2048, 2048, 2048, false, true>(ring, g, S, E); }
            SEAM(P0 + 11);
        }
        if (IN(P0 + 12)) for (int rep_ = 0; rep_ < NREP(P0 + 12); ++rep_) { PHASE_BEGIN(); norm_phase<2>(p, l, gw, NGW, lane); SEAM(P0 + 12); }
        if (IN(P0 + 13)) for (int rep_ = 0; rep_ < NREP(P0 + 13); ++rep_) { PHASE_BEGIN();
            pg8::Gemm g{(const bf16_t*)(ws + WS_U2BF), (const bf16_t*)(wl + WS_WR)};
            pg8::StaticOrder<T_ / 256, 1, 2048, 2048> S{G, wg, 0};
            pg8::EpiRouter E{(float*)(ws + WS_LOGIT)};
            pg8::gemm_phase<2048, 2048, 2048, false>(ring, g, S, E);
            if (l == 0 && wg >= 128) { const int gw2 = (wg - 128) * NWAVES + wave; unsigned char* w1 = (unsigned char*)p.out;
                conv8_pass<1>(p, 1, w1, lds, gw2, 128 * NWAVES, wave, lane); conv_phase(p, 1, w1, lds, gw2, 128 * NWAVES, wave, lane); }
            SEAM(P0 + 13);
        }
        if (IN(P0 + 14)) for (int rep_ = 0; rep_ < NREP(P0 + 14); ++rep_) { PHASE_BEGIN(); route_phase(p, l, sm, wg, tid); SEAM(P0 + 14); }
        if (IN(P0 + 15)) for (int rep_ = 0; rep_ < NREP(P0 + 15); ++rep_) { PHASE_BEGIN(); assign_phase(p, sm, wg, tid, wave, lane); SEAM(P0 + 15); }
        if (IN(P0 + 16)) for (int rep_ = 0; rep_ < NREP(P0 + 16); ++rep_) { PHASE_BEGIN();
            const int* blke = (const int*)(ws + WS_BLKE); const int nb = __builtin_amdgcn_readfirstlane(blke[511]);
            pg8::Gemm g{(const bf16_t*)(ws + WS_U8), (const bf16_t*)(wl + WS_E1)};
            pg8::MoeOrder<2, true> S{blke, nb, G, wg, (size_t)0, (size_t)256 * 1024, (size_t)512 * 1024, (const int*)(ws + WS_SDST)};
            pg8::EpiE1 E{(bf16_t*)(ws + WS_HDN), (const float*)(ws + WS_XSS), (const float*)(ws + WS_SWE1 + sl), blke};
            pg8::gemm_phase<1024, 1024, 1024, true, true>(ring, g, S, E);
            SEAM(P0 + 16);
        }
        if (IN(P0 + 17)) for (int rep_ = 0; rep_ < NREP(P0 + 17); ++rep_) { PHASE_BEGIN();
            const int* blke = (const int*)(ws + WS_BLKE); const int nb = __builtin_amdgcn_readfirstlane(blke[511]);
            pg8::Gemm g{(const bf16_t*)(ws + WS_HDN), (const bf16_t*)(wl + WS_E2)};
            pg8::MoeOrder<4> S{blke, nb, G, wg, (size_t)256 * 256 * 2, (size_t)256 * 256 * 2, (size_t)1024 * 256 * 2, nullptr};
            pg8::EpiE2 E{(bf16_t*)(ws + WS_YS), (const int*)(ws + WS_SDST)};
            pg8::gemm_phase<512, 512, 512, false, true>(ring, g, S, E);
            SEAM(P0 + 17);
        }
    }
    if (IN(DEPTH_ * PH_PER_LAYER)) { constexpr int l = 0; PHASE_BEGIN(); FinalHold Hd; final_a(p, gw, NGW, lane, Hd); xcd_barrier(bar); final_b(p, gw, lane, Hd); }
#undef IN
#undef SEAM
}

extern "C" void kernel_launch(void* const* d_in, const int* in_sizes, int n_in, void* d_out, int out_size, void* d_ws, size_t ws_size, hipStream_t stream) {
    static int grid = 0;
    if (grid == 0) {
        if (n_in != 19 || out_size != T_ * D_ || ws_size < WS_END) { fprintf(stderr, "kernel_launch: unexpected shapes (n_in %d, out %d, ws %zu); nothing launched\n", n_in, out_size, ws_size); grid = -1; return; }
        int dev = 0, cus = 0;
        if (hipGetDevice(&dev) != hipSuccess || hipDeviceGetAttribute(&cus, hipDeviceAttributeMultiprocessorCount, dev) != hipSuccess) { grid = -1; return; }
        if (hipFuncSetAttribute((const void*)mega, hipFuncAttributeMaxDynamicSharedMemorySize, LDS_BYTES) != hipSuccess) { fprintf(stderr, "kernel_launch: hipFuncSetAttribute failed\n"); grid = -1; return; }
        int per_cu = 0;
        if (hipOccupancyMaxActiveBlocksPerMultiprocessor(&per_cu, (const void*)mega, NTHREADS, LDS_BYTES) != hipSuccess || per_cu < 1) { fprintf(stderr, "kernel_launch: occupancy query reports %d blocks per CU\n", per_cu); }
        (void)hipGetLastError();
        if (cus != 256) { fprintf(stderr, "kernel_launch: built for a 256-CU device (got %d); nothing launched\n", cus); grid = -1; return; }
        grid = cus;
    }
    if (grid <= 0) return;
    Params p{};
    for (int i = 0; i < 19; ++i) p.in[i] = (const float*)d_in[i];
    p.out = (float*)d_out; p.ws = (unsigned char*)d_ws;
    for (int f = 0; f < 16; ++f) p.inv_freq[f] = (float)std::pow(10000.0, -(double)f / 16.0);
    for (int h = 0; h < 4; ++h) p.ret_lg2[h] = (float)std::log2(1.0 - std::exp2(-5.0 - (double)h));
    hipMemsetAsync((unsigned char*)d_ws + WS_CTL, 0, CTL_BYTES, stream);
#if MK_PER_PHASE
    for (int ph = 0; ph < N_PHASES; ++ph) { p.ph_lo = ph; p.ph_hi = ph + 1; hipLaunchKernelGGL(mega, dim3(grid), dim3(NTHREADS), LDS_BYTES, stream, p); }
#else
    p.ph_lo = 0; p.ph_hi = N_PHASES;
    hipLaunchKernelGGL(mega, dim3(grid), dim3(NTHREADS), LDS_BYTES, stream, p);
#endif
}
```

```cpp
#include <hip/hip_runtime.h>
#include <cstdio>
#include <cstdint>
#include <cmath>

#define LAS __attribute__((address_space(3)))
#define GAS __attribute__((address_space(1)))
typedef unsigned short bf16_t;
typedef short bf16x8 __attribute__((ext_vector_type(8)));
typedef float f32x4 __attribute__((ext_vector_type(4)));
typedef float f32x2 __attribute__((ext_vector_type(2)));
typedef unsigned u32x4 __attribute__((ext_vector_type(4)));
typedef unsigned u32x2 __attribute__((ext_vector_type(2)));
typedef int i32x4 __attribute__((ext_vector_type(4)));
__device__ __forceinline__ f32x4 tof(const f32x4& v) { return v; }
__device__ __forceinline__ f32x4 tof(const i32x4& v) { return __builtin_convertvector(v, f32x4); }

constexpr int T_ = 32768, D_ = 1024, S_ = 8192, NBATCH = 4, DEPTH_ = 2;
constexpr int ZW = 3072;
constexpr int OLD = 1024 + 64;
constexpr int ZLD = ZW + 64;
constexpr int Z_GQ = 0, Z_GK = 128, Z_GV = 256, Z_GR = 512, Z_GA = 768, Z_SQ = 784, Z_SK = 1040, Z_SV = 1168, Z_MQ = 1296, Z_MK = 1552, Z_MV = 1808,
              Z_RQ = 2064, Z_RK = 2192, Z_RV = 2320, Z_RG = 2576, Z_GATE = 2832, IN_W = 6928;
constexpr float LOG2E = 1.4426950408889634f;
constexpr float C2 = 0.125f * 1.4426950408889634f;
constexpr float RSQ32 = 0.17677669529663687f;
constexpr float NORM_EPS = 1e-6f;
constexpr int NEXP = 32, EHID = 256, MOE_BLK = 256, NSLOTBLK = 288, NSLOT = NSLOTBLK * MOE_BLK;

constexpr size_t MiB = 1u << 20;
constexpr size_t WS_WIN = 0, WS_WG = 3 * MiB, WS_WB = 7 * MiB, WS_WO = 9 * MiB, WS_WR = 11 * MiB, WS_E1 = 12 * MiB, WS_E2 = 28 * MiB;
constexpr size_t WS_YS = 68 * MiB;
constexpr size_t WS_GKV = 68 * MiB, WS_RKV = 84 * MiB, WS_GDEC = 92 * MiB, WS_KMEAN = 93 * MiB, WS_O = 108 * MiB;
constexpr size_t WS_U8 = 197 * MiB;
constexpr size_t WS_SU = 229 * MiB, WS_RSTD = WS_SU + 128 * 1024  , WS_XSS = WS_SU + 256 * 1024;
constexpr size_t WS_SWIN = 230 * MiB, WS_SWG = WS_SWIN + 16 * 1024, WS_SWE1 = WS_SWG + 16 * 1024;
constexpr size_t WS_Z = 261 * MiB;
constexpr size_t WS_YH = 261 * MiB;
constexpr size_t WS_U2BF = 261 * MiB;
constexpr size_t WS_XS = 325 * MiB, WS_HDN = 397 * MiB;
constexpr size_t WS_LOGIT = 453 * MiB;
constexpr size_t WS_TOKE = 461 * MiB, WS_TOKW = WS_TOKE + 256 * 1024, WS_TOKR = WS_TOKW + 256 * 1024, WS_HIST = WS_TOKR + 256 * 1024,
                 WS_SDST = WS_HIST + 64 * 1024, WS_BLKE = WS_SDST + 512 * 1024;
constexpr size_t WS_MLIST = 94 * MiB, WS_MCNT = 102 * MiB;
constexpr size_t WS_PARTO = 457 * MiB, WS_PARTML = 505 * MiB;
constexpr size_t WS_CTL = 511 * MiB, CTL_BYTES = 256 * 1024;
constexpr size_t WS_SWRAW = WS_CTL + 64 * 1024, SWRAW_LSTEP = 96 * 1024;
constexpr size_t SW_LSTEP = 128 * 1024;
constexpr size_t WS_END = 512 * MiB;
constexpr int YS_TRASH_ROW = 2 * T_;

__device__ __forceinline__ float bf2f(bf16_t v) { return __uint_as_float(((unsigned)v) << 16); }
__device__ __forceinline__ unsigned f2bf(float f) { unsigned u = __float_as_uint(f); return (u + 0x7fffu + ((u >> 16) & 1u)) >> 16; }
__device__ __forceinline__ unsigned pk2(float lo, float hi) { return f2bf(lo) | (f2bf(hi) << 16); }
__device__ __forceinline__ float sigmoidf_(float x) { return __builtin_amdgcn_rcpf(1.0f + __builtin_amdgcn_exp2f(-x * LOG2E)); }

namespace pg8 {
#define PG8_LAS __attribute__((address_space(3)))
constexpr int BM = 256, BK = 64, HALF = 128, HTB = HALF * BK * 2  , STAGE_BYTES = 8 * HTB, NXCD = 8, WGM = 8;

__host__ __device__ __forceinline__ int lds_byte(int r, int c) { const int st = (r >> 4) * 2 + (c >> 5), rr = r & 15, cc = c & 31, ob = rr * 64 + cc * 2; return st * 1024 + (ob ^ (((ob >> 9) & 1) << 5)); }
__host__ __device__ __forceinline__ void stage_rc(int b, int& R, int& C) { const int st = b / 1024, sb = b % 1024, swz = sb ^ (((sb >> 9) & 1) << 5); R = (st >> 1) * 16 + swz / 64; C = (st & 1) * 32 + (swz % 64) / 2; }
__host__ __device__ __forceinline__ int perm32(int rho) { const int n = rho >> 4, i = rho & 15; return 8 * (i >> 2) + 4 * n + (i & 3); }

struct Unit { int pm, pn; size_t aoff, boff; };
struct Gemm { const bf16_t* A; const bf16_t* Bt; };

template <int NM, int NN, int LDAB  , int LDBB, int A_SHIFT = 30, int A_MUL = 0> struct StaticOrder {
    static constexpr bool GATHER = false;
    int G, c, pm_base;
    __device__ bool next(int i, Unit& u) const {
        constexpr int nwg = NM * NN; const int L = i * G + c; if (L >= nwg) return false;
        int wgid = L; { constexpr int q = nwg / NXCD, r = nwg % NXCD; const int xcd = wgid % NXCD, off = wgid / NXCD; wgid = (xcd < r ? xcd * (q + 1) : r * (q + 1) + (xcd - r) * q) + off; }
        static_assert(NM % WGM == 0, "row-tile count must be a multiple of the 8-row group"); constexpr int nig = WGM * NN, gsz = WGM; const int gid = wgid / nig, fm = gid * WGM;
        u.pm = pm_base + fm + ((wgid % nig) % gsz); u.pn = (wgid % nig) / gsz;
        u.aoff = (size_t)u.pm * ((size_t)BM * LDAB) + (size_t)(u.pn >> A_SHIFT) * A_MUL; u.boff = (size_t)u.pn * ((size_t)BM * LDBB); return true;
    }
};
template <int NCOL, bool GATHER_ = false> struct MoeOrder {
    static constexpr bool GATHER = GATHER_;
    const int* blk_e; int nb, G, c; size_t a_tstep, b_tstep, b_estep; const int* rowmap;
    __device__ bool next(int i, Unit& u) const {
        const int L = i * G + c; if (L >= nb * NCOL) return false;
        const int rb = L / NCOL, pn = L % NCOL; const int e = __builtin_amdgcn_readfirstlane(blk_e[rb]);
        u.pm = rb; u.pn = pn; u.aoff = (size_t)rb * a_tstep; u.boff = (size_t)e * b_estep + (size_t)pn * b_tstep; return true;
    }
};

typedef __bf16 bf16x2c_t __attribute__((ext_vector_type(2)));
__device__ __forceinline__ unsigned cvt_pk_bf16(float lo, float hi) { const f32x2 v = {lo, hi}; const bf16x2c_t q = __builtin_convertvector(v, bf16x2c_t); return __builtin_bit_cast(unsigned, q); }

struct EpiBf16 {
    static constexpr bool PERM = true;
    bf16_t* O; int ldc; int row_sub;
    template <class AT> __device__ __forceinline__ void operator()(const AT (&acc)[2][2][4][2], const Unit& u, int wr, int wc, int fr, int fq) const {
        const int row0 = u.pm * BM + wr * 64 + fr - row_sub; const int col0 = u.pn * BM + wc * 32 + 8 * fq;
#pragma unroll
        for (int ai = 0; ai < 2; ++ai)
#pragma unroll
            for (int m = 0; m < 4; ++m) { bf16_t* rowp = O + (size_t)(row0 + ai * HALF + m * 16) * ldc + col0;
#pragma unroll
                for (int bj = 0; bj < 2; ++bj) { const f32x4 v0 = tof(acc[ai][bj][m][0]), v1 = tof(acc[ai][bj][m][1]);
                    u32x4 w; w.x = cvt_pk_bf16(v0[0], v0[1]); w.y = cvt_pk_bf16(v0[2], v0[3]); w.z = cvt_pk_bf16(v1[0], v1[1]); w.w = cvt_pk_bf16(v1[2], v1[3]);
                    *(u32x4*)(rowp + bj * HALF) = w; } }
    }
};
struct EpiBf16S {
    static constexpr bool PERM = true;
    bf16_t* O; int ldc; const float* srow; const float* scol;
    template <class AT> __device__ __forceinline__ void operator()(const AT (&acc)[2][2][4][2], const Unit& u, int wr, int wc, int fr, int fq) const {
        const int row0 = u.pm * BM + wr * 64 + fr; const int col0 = u.pn * BM + wc * 32 + 8 * fq;
        f32x4 sc[2][2];
#pragma unroll
        for (int bj = 0; bj < 2; ++bj)
#pragma unroll
            for (int n = 0; n < 2; ++n) sc[bj][n] = *(const f32x4*)(scol + col0 + bj * HALF + 4 * n);
        float srv[2][4];
#pragma unroll
        for (int ai = 0; ai < 2; ++ai)
#pragma unroll
            for (int m = 0; m < 4; ++m) srv[ai][m] = srow[row0 + ai * HALF + m * 16];
#pragma unroll
        for (int ai = 0; ai < 2; ++ai)
#pragma unroll
            for (int m = 0; m < 4; ++m) { const int r = row0 + ai * HALF + m * 16; const float sr = srv[ai][m]; bf16_t* rowp = O + (size_t)r * ldc + col0;
#pragma unroll
                for (int bj = 0; bj < 2; ++bj) { const f32x4 v0 = tof(acc[ai][bj][m][0]) * sc[bj][0] * sr, v1 = tof(acc[ai][bj][m][1]) * sc[bj][1] * sr;
                    u32x4 w; w.x = cvt_pk_bf16(v0[0], v0[1]); w.y = cvt_pk_bf16(v0[2], v0[3]); w.z = cvt_pk_bf16(v1[0], v1[1]); w.w = cvt_pk_bf16(v1[2], v1[3]);
                    *(u32x4*)(rowp + bj * HALF) = w; } }
    }
};
template <bool BASE_F32> struct EpiRes {
    static constexpr bool PERM = true;
    const void* base; bf16_t* H;
    template <class AT> __device__ __forceinline__ void operator()(const AT (&acc)[2][2][4][2], const Unit& u, int wr, int wc, int fr, int fq) const {
        const int row0 = u.pm * BM + wr * 64 + fr, col0 = u.pn * BM + wc * 32 + 8 * fq;
#pragma unroll
        for (int ai = 0; ai < 2; ++ai) {
            f32x4 b[4][2][2];
#pragma unroll
            for (int m = 0; m < 4; ++m) { const size_t off = (size_t)(row0 + ai * HALF + m * 16) * 1024 + col0;
#pragma unroll
                for (int bj = 0; bj < 2; ++bj) {
                    if (BASE_F32) { b[m][bj][0] = *(const f32x4*)((const float*)base + off + bj * HALF); b[m][bj][1] = *(const f32x4*)((const float*)base + off + bj * HALF + 4); }
                    else { const u32x4 q = *(const u32x4*)((const bf16_t*)base + off + bj * HALF);
                        b[m][bj][0] = (f32x4){__uint_as_float(q.x << 16), __uint_as_float(q.x & 0xffff0000u), __uint_as_float(q.y << 16), __uint_as_float(q.y & 0xffff0000u)};
                        b[m][bj][1] = (f32x4){__uint_as_float(q.z << 16), __uint_as_float(q.z & 0xffff0000u), __uint_as_float(q.w << 16), __uint_as_float(q.w & 0xffff0000u)}; } } }
#pragma unroll
            for (int m = 0; m < 4; ++m) { const size_t off = (size_t)(row0 + ai * HALF + m * 16) * 1024 + col0;
#pragma unroll
                for (int bj = 0; bj < 2; ++bj) { const f32x4 v0 = b[m][bj][0] + tof(acc[ai][bj][m][0]), v1 = b[m][bj][1] + tof(acc[ai][bj][m][1]);
                    u32x4 w; w.x = cvt_pk_bf16(v0[0], v0[1]); w.y = cvt_pk_bf16(v0[2], v0[3]); w.z = cvt_pk_bf16(v1[0], v1[1]); w.w = cvt_pk_bf16(v1[2], v1[3]);
                    *(u32x4*)(H + off + bj * HALF) = w; } }
            asm volatile("" ::: "memory"); }
    }
};
struct EpiRouter {
    static constexpr bool PERM = false; static constexpr bool NARROW = true;
    float* L; const float* rstd;
    template <class AT> __device__ __forceinline__ void operator()(const AT (&acc)[2][2][4][2], const Unit& u, int wr, int wc, int fr, int fq) const {
        if (wc >= 2) return;
        const int row0 = u.pm * BM + wr * 64 + fr, col0 = wc * 32 + 4 * fq;
        float rs[2][4];
#pragma unroll
        for (int ai = 0; ai < 2; ++ai)
#pragma unroll
            for (int m = 0; m < 4; ++m) rs[ai][m] = rstd[row0 + ai * HALF + m * 16];
#pragma unroll
        for (int ai = 0; ai < 2; ++ai)
#pragma unroll
            for (int m = 0; m < 4; ++m) { float* rowp = L + (size_t)(row0 + ai * HALF + m * 16) * 64 + col0;
#pragma unroll
                for (int n = 0; n < 2; ++n) *(f32x4*)(rowp + n * 16) = tof(acc[ai][0][m][n]) * rs[ai][m]; }
    }
};
constexpr int YLD = 4096 + 64;
struct EpiGate {
    static constexpr bool PERM = false;
    const bf16_t* Y; int y_row_sub; bf16_t* Mg; const float* srow; const float* scol;
    template <class AT> __device__ __forceinline__ void operator()(const AT (&acc)[2][2][4][2], const Unit& u, int wr, int wc, int fr, int fq) const {
        const int row0 = u.pm * BM + wr * 64 + fr, d0 = u.pn * 64 + wc * 16 + fq * 4;
        f32x4 sc[4];
#pragma unroll
        for (int i = 0; i < 4; ++i) sc[i] = *(const f32x4*)(scol + u.pn * BM + (i >> 1) * HALF + wc * 32 + (i & 1) * 16 + 4 * fq) * (-LOG2E);
        float srv[2][4];
#pragma unroll
        for (int ai = 0; ai < 2; ++ai)
#pragma unroll
            for (int m = 0; m < 4; ++m) srv[ai][m] = srow[row0 + ai * HALF + m * 16];
        u32x2 yv[6][4], yl[2][4], res[6];
#define EG_LOAD(dst, ai, m) do { const bf16_t* yrow = Y + (size_t)(row0 + (ai) * HALF + (m) * 16 - y_row_sub) * YLD + d0; \
            _Pragma("unroll") for (int i = 0; i < 4; ++i) dst[i] = *(const u32x2*)(yrow + 1024 * i); } while (0)
#define EG_WORK(out, src, ai, m) do { const float sr = srv[ai][m]; f32x4 s = (f32x4){0.f, 0.f, 0.f, 0.f}; \
            _Pragma("unroll") for (int i = 0; i < 4; ++i) { const f32x4 g = tof(acc[ai][i >> 1][m][i & 1]) * sc[i] * sr; \
                s[0] += __builtin_amdgcn_rcpf(1.0f + __builtin_amdgcn_exp2f(g[0])) * __uint_as_float(src[i].x << 16); s[1] += __builtin_amdgcn_rcpf(1.0f + __builtin_amdgcn_exp2f(g[1])) * __uint_as_float(src[i].x & 0xffff0000u); \
                s[2] += __builtin_amdgcn_rcpf(1.0f + __builtin_amdgcn_exp2f(g[2])) * __uint_as_float(src[i].y << 16); s[3] += __builtin_amdgcn_rcpf(1.0f + __builtin_amdgcn_exp2f(g[3])) * __uint_as_float(src[i].y & 0xffff0000u); } \
            out.x = cvt_pk_bf16(s[0], s[1]); out.y = cvt_pk_bf16(s[2], s[3]); } while (0)
#define EG_STORE(val, ai, m) *(u32x2*)(Mg + (size_t)(row0 + (ai) * HALF + (m) * 16) * OLD + d0) = val
        EG_LOAD(yv[0], 0, 0); EG_LOAD(yv[1], 0, 1); EG_LOAD(yv[2], 0, 2); EG_LOAD(yv[3], 0, 3); EG_LOAD(yv[4], 1, 0); EG_LOAD(yv[5], 1, 1); __builtin_amdgcn_sched_barrier(0);
        EG_WORK(res[0], yv[0], 0, 0); EG_WORK(res[1], yv[1], 0, 1); __builtin_amdgcn_sched_barrier(0);
        EG_LOAD(yl[0], 1, 2); EG_LOAD(yl[1], 1, 3); __builtin_amdgcn_sched_barrier(0);
        EG_WORK(res[2], yv[2], 0, 2); EG_WORK(res[3], yv[3], 0, 3); EG_WORK(res[4], yv[4], 1, 0); EG_WORK(res[5], yv[5], 1, 1); __builtin_amdgcn_sched_barrier(0);
        { u32x2 w; EG_WORK(w, yl[0], 1, 2); __builtin_amdgcn_sched_barrier(0);
          EG_STORE(res[0], 0, 0); EG_STORE(res[1], 0, 1); EG_STORE(res[2], 0, 2); EG_STORE(res[3], 0, 3); EG_STORE(res[4], 1, 0); EG_STORE(res[5], 1, 1); EG_STORE(w, 1, 2); }
        { u32x2 w; EG_WORK(w, yl[1], 1, 3); EG_STORE(w, 1, 3); }
#undef EG_LOAD
#undef EG_WORK
#undef EG_STORE
    }
};
struct EpiE1 {
    static constexpr bool PERM = true;
    bf16_t* H; const float* srow; const float* scol_all; const int* blk_e;
    template <class AT> __device__ __forceinline__ void operator()(const AT (&acc)[2][2][4][2], const Unit& u, int wr, int wc, int fr, int fq) const {
        const int row0 = u.pm * BM + wr * 64 + fr, col0 = u.pn * 128 + wc * 32 + 8 * fq;
        const float* scol = scol_all + (size_t)__builtin_amdgcn_readfirstlane(blk_e[u.pm]) * 512 + u.pn * BM + wc * 32 + 8 * fq;
        const f32x4 s10 = *(const f32x4*)scol, s11 = *(const f32x4*)(scol + 4), s30 = *(const f32x4*)(scol + HALF), s31 = *(const f32x4*)(scol + HALF + 4);
        float srv[2][4];
#pragma unroll
        for (int ai = 0; ai < 2; ++ai)
#pragma unroll
            for (int m = 0; m < 4; ++m) srv[ai][m] = srow[row0 + ai * HALF + m * 16];
#pragma unroll
        for (int ai = 0; ai < 2; ++ai)
#pragma unroll
            for (int m = 0; m < 4; ++m) { const int r = row0 + ai * HALF + m * 16; const float sr = srv[ai][m]; bf16_t* rowp = H + (size_t)r * EHID + col0;
                const f32x4 a0 = tof(acc[ai][0][m][0]) * s10 * sr, a1 = tof(acc[ai][0][m][1]) * s11 * sr, b0 = tof(acc[ai][1][m][0]) * s30 * sr, b1 = tof(acc[ai][1][m][1]) * s31 * sr;
                f32x4 v0, v1;
#pragma unroll
                for (int j = 0; j < 4; ++j) { v0[j] = a0[j] * sigmoidf_(a0[j]) * b0[j]; v1[j] = a1[j] * sigmoidf_(a1[j]) * b1[j]; }
                u32x4 w; w.x = cvt_pk_bf16(v0[0], v0[1]); w.y = cvt_pk_bf16(v0[2], v0[3]); w.z = cvt_pk_bf16(v1[0], v1[1]); w.w = cvt_pk_bf16(v1[2], v1[3]);
                *(u32x4*)rowp = w; }
    }
};
struct EpiE2 {
    static constexpr bool PERM = true;
    bf16_t* YS; const int* sdst;
    template <class AT> __device__ __forceinline__ void operator()(const AT (&acc)[2][2][4][2], const Unit& u, int wr, int wc, int fr, int fq) const {
        const int row0 = u.pm * BM + wr * 64 + fr, col0 = u.pn * BM + wc * 32 + 8 * fq;
        int dstv[2][4];
#pragma unroll
        for (int ai = 0; ai < 2; ++ai)
#pragma unroll
            for (int m = 0; m < 4; ++m) dstv[ai][m] = sdst[row0 + ai * HALF + m * 16];
#pragma unroll
        for (int ai = 0; ai < 2; ++ai)
#pragma unroll
            for (int m = 0; m < 4; ++m) { const int dst = dstv[ai][m];
                bf16_t* rowp = YS + (size_t)dst * 1024 + col0;
#pragma unroll
                for (int bj = 0; bj < 2; ++bj) { const f32x4 v0 = tof(acc[ai][bj][m][0]), v1 = tof(acc[ai][bj][m][1]);
                    u32x4 w; w.x = cvt_pk_bf16(v0[0], v0[1]); w.y = cvt_pk_bf16(v0[2], v0[3]); w.z = cvt_pk_bf16(v1[0], v1[1]); w.w = cvt_pk_bf16(v1[2], v1[3]);
                    *(u32x4*)(rowp + bj * HALF) = w; }
                asm volatile("" ::: "memory"); }
    }
};

template <class E, class = void> struct IsNarrow { static constexpr bool value = false; };
template <class E> struct IsNarrow<E, decltype((void)E::NARROW)> { static constexpr bool value = E::NARROW; };
template <bool I8> struct AccSel { typedef f32x4 type; };
template <> struct AccSel<true> { typedef i32x4 type; };
__device__ __forceinline__ f32x4 mma16(const bf16x8& a, const bf16x8& b, const f32x4& c) { return __builtin_amdgcn_mfma_f32_16x16x32_bf16(a, b, c, 0, 0, 0); }
__device__ __forceinline__ i32x4 mma16(const bf16x8& a, const bf16x8& b, const i32x4& c) { return __builtin_amdgcn_mfma_i32_16x16x64_i8(__builtin_bit_cast(i32x4, a), __builtin_bit_cast(i32x4, b), c, 0, 0, 0); }
template <int LDAB, int LDBB, int KB, bool I8, bool ALIGN_EPI = false, class Epi, class Sched>
__device__ __forceinline__ void gemm_phase(PG8_LAS unsigned char* lds, const Gemm g, const Sched& S, const Epi& E) {
    int tid = threadIdx.x; asm volatile("" : "+v"(tid));
    const int wid = __builtin_amdgcn_readfirstlane(tid >> 6), lane = tid & 63, wr = wid >> 2, wc = wid & 3, fr = lane & 15, fq = lane >> 4;
    constexpr int nt = KB / (BK * 2);
    unsigned voffA[2], voffB[2]; int Rr[2]; unsigned cby[2];
#pragma unroll
    for (int i = 0; i < 2; ++i) { int R, C; stage_rc(tid * 16 + i * 8192, R, C); const int Rb = Epi::PERM ? ((R & ~31) + perm32(R & 31)) : R;
        voffA[i] = (unsigned)(R * LDAB + C * 2); voffB[i] = (unsigned)(Rb * LDBB + C * 2); Rr[i] = R; cby[i] = (unsigned)(C * 2); }
    unsigned gc[2][2], gn[2][2];
#define PG8_GATH(u_, o_) do { if constexpr (Sched::GATHER) { _Pragma("unroll") for (int h_ = 0; h_ < 2; ++h_) _Pragma("unroll") for (int i_ = 0; i_ < 2; ++i_) { int tk_ = S.rowmap[(u_).pm * BM + HALF * h_ + Rr[i_]] >> 1; tk_ = tk_ < T_ ? tk_ : T_ - 1; \
        o_[h_][i_] = (unsigned)tk_ * (unsigned)LDAB + cby[i_]; } } } while (0)
#define PG8_STAGE_A(bufoff, ptr, kb, h, nx) do { if constexpr (!Sched::GATHER) { PG8_STAGE(bufoff, ptr, voffA); } else { unsigned vo_[2]; vo_[0] = (nx) ? gn[h][0] : gc[h][0]; vo_[1] = (nx) ? gn[h][1] : gc[h][1]; \
        PG8_STAGE(bufoff, (const char*)g.A + (kb), vo_); } } while (0)
    constexpr size_t kstep = (size_t)(BK * 2);
    constexpr size_t hstepA = (size_t)HALF * LDAB, hstepB = (size_t)HALF * LDBB;
    const unsigned ldsw = (unsigned)wid * 1024u;
    const int aoff = lds_byte(wr * 64 + fr, fq * 8), boff = lds_byte(wc * 32 + fr, fq * 8);
#define PG8_SA(b, h) (((b) * 2 + (h)) * HTB)
#define PG8_SB(b, h) ((4 + (b) * 2 + (h)) * HTB)
#define PG8_STAGE(bufoff, gbase, voff) do { _Pragma("unroll") for (int _i = 0; _i < 2; ++_i) \
        __builtin_amdgcn_global_load_lds((const unsigned*)((const char*)(gbase) + (voff)[_i]), (PG8_LAS unsigned*)(lds + (bufoff) + ldsw + _i * 8192), 16, 0, 0); } while (0)
#define PG8_LDA(dst, b, h) do { _Pragma("unroll") for (int m = 0; m < 4; ++m) _Pragma("unroll") for (int k = 0; k < 2; ++k) dst[m][k] = *(const PG8_LAS bf16x8*)(lds + PG8_SA(b, h) + aoff + m * 2048 + k * 1024); } while (0)
#define PG8_LDB(dst, b, h) do { _Pragma("unroll") for (int n = 0; n < 2; ++n) _Pragma("unroll") for (int k = 0; k < 2; ++k) dst[n][k] = *(const PG8_LAS bf16x8*)(lds + PG8_SB(b, h) + boff + n * 2048 + k * 1024); } while (0)
#define PG8_MMA(ai, bj, At, Bt) do { if constexpr (IsNarrow<Epi>::value && (bj) == 1) break; __builtin_amdgcn_s_setprio(1); _Pragma("unroll") for (int m = 0; m < 4; ++m) _Pragma("unroll") for (int n = 0; n < 2; ++n) _Pragma("unroll") for (int k = 0; k < 2; ++k) \
        acc[ai][bj][m][n] = mma16(Bt[n][k], At[m][k], acc[ai][bj][m][n]); __builtin_amdgcn_s_setprio(0); } while (0)
#define PG8_WAIT_V(n) asm volatile("s_waitcnt vmcnt(" #n ")" ::: "memory")
#define PG8_WAIT_L(n) asm volatile("s_waitcnt lgkmcnt(" #n ")" ::: "memory")
#define PG8_BAR __builtin_amdgcn_s_barrier()
#define PG8_SCHED __builtin_amdgcn_sched_barrier(0)
    Unit cur, nxt; int ui = 0;
    if (!S.next(0, cur)) return;
    typedef typename AccSel<I8>::type acc_t;
    acc_t acc[2][2][4][2];
#pragma unroll
    for (int a = 0; a < 2; ++a)
#pragma unroll
        for (int b = 0; b < 2; ++b)
#pragma unroll
            for (int m = 0; m < 4; ++m)
#pragma unroll
                for (int n = 0; n < 2; ++n) acc[a][b][m][n] = (acc_t){0, 0, 0, 0};
    bf16x8 At[4][2], B0[2][2], B1[2][2];
    const char* cA = (const char*)g.A + cur.aoff; const char* cB = (const char*)g.Bt + cur.boff;
    PG8_GATH(cur, gc);
    PG8_STAGE(PG8_SB(0, 0), cB, voffB); PG8_STAGE_A(PG8_SA(0, 0), cA, 0, 0, false); PG8_STAGE(PG8_SB(0, 1), cB + hstepB, voffB); PG8_STAGE_A(PG8_SA(0, 1), cA + hstepA, 0, 1, false);
    if (wr == 1) PG8_BAR;
    PG8_WAIT_V(4); PG8_BAR;
    PG8_STAGE(PG8_SB(1, 0), cB + kstep, voffB); PG8_STAGE_A(PG8_SA(1, 0), cA + kstep, kstep, 0, false); PG8_STAGE(PG8_SB(1, 1), cB + hstepB + kstep, voffB);
    PG8_WAIT_V(6); PG8_BAR;
    for (;;) {
        const bool has_next = S.next(ui + 1, nxt);
        const char* nA = has_next ? (const char*)g.A + nxt.aoff : cA; const char* nB = has_next ? (const char*)g.Bt + nxt.boff : cB;
        if constexpr (Sched::GATHER) { if (has_next) PG8_GATH(nxt, gn); else { gn[0][0] = gc[0][0]; gn[0][1] = gc[0][1]; gn[1][0] = gc[1][0]; gn[1][1] = gc[1][1]; } }
#pragma unroll 1
        for (int t = 0; t < nt; t += 2) {
            const bool last = (t == nt - 2);
            const char* a1 = cA + (size_t)(t + 1) * kstep;
            const char* a2 = last ? nA : cA + (size_t)(t + 2) * kstep; const char* b2 = last ? nB : cB + (size_t)(t + 2) * kstep;
            const char* a3 = a2 + kstep; const char* b3 = b2 + kstep;
            const size_t k2 = last ? 0 : (size_t)(t + 2) * kstep;
            PG8_LDB(B0, 0, 0); PG8_SCHED; PG8_LDA(At, 0, 0); PG8_STAGE_A(PG8_SA(1, 1), a1 + hstepA, (size_t)(t + 1) * kstep, 1, false);
            PG8_WAIT_L(8); PG8_BAR; PG8_WAIT_L(0); PG8_MMA(0, 0, At, B0); PG8_BAR; PG8_SCHED;
            PG8_LDB(B1, 0, 1); PG8_STAGE(PG8_SB(0, 0), b2, voffB);
            PG8_BAR; PG8_WAIT_L(0); PG8_MMA(0, 1, At, B1); PG8_BAR;
            PG8_LDA(At, 0, 1); PG8_STAGE_A(PG8_SA(0, 0), a2, k2, 0, last);
            PG8_BAR; PG8_WAIT_L(0); PG8_MMA(1, 0, At, B0); PG8_BAR; PG8_SCHED;
            PG8_STAGE(PG8_SB(0, 1), b2 + hstepB, voffB);
            PG8_WAIT_V(6); PG8_BAR; PG8_MMA(1, 1, At, B1); PG8_BAR;
            PG8_LDB(B0, 1, 0); PG8_SCHED; PG8_LDA(At, 1, 0); PG8_STAGE_A(PG8_SA(0, 1), a2 + hstepA, k2, 1, last);
            PG8_WAIT_L(8); PG8_BAR; PG8_WAIT_L(0); PG8_MMA(0, 0, At, B0); PG8_BAR; PG8_SCHED;
            PG8_LDB(B1, 1, 1); PG8_STAGE(PG8_SB(1, 0), b3, voffB);
            PG8_BAR; PG8_WAIT_L(0); PG8_MMA(0, 1, At, B1); PG8_BAR;
            PG8_LDA(At, 1, 1); PG8_STAGE_A(PG8_SA(1, 0), a3, k2 + kstep, 0, last);
            PG8_BAR; PG8_WAIT_L(0); PG8_MMA(1, 0, At, B0); PG8_BAR; PG8_SCHED;
            PG8_STAGE(PG8_SB(1, 1), b3 + hstepB, voffB);
            PG8_WAIT_V(6); PG8_BAR; PG8_MMA(1, 1, At, B1); PG8_BAR;
        }
        if constexpr (ALIGN_EPI) { if (wr == 0) PG8_BAR; }
        E(acc, cur, wr, wc, fr, fq);
        if (!has_next) break;
#pragma unroll
        for (int a = 0; a < 2; ++a)
#pragma unroll
            for (int b = 0; b < 2; ++b)
#pragma unroll
                for (int m = 0; m < 4; ++m)
#pragma unroll
                    for (int n = 0; n < 2; ++n) acc[a][b][m][n] = (acc_t){0, 0, 0, 0};
        cur = nxt; cA = nA; cB = nB; ++ui;
        if constexpr (Sched::GATHER) { gc[0][0] = gn[0][0]; gc[0][1] = gn[0][1]; gc[1][0] = gn[1][0]; gc[1][1] = gn[1][1]; }
        if constexpr (ALIGN_EPI) { if (wr == 1) PG8_BAR; }
    }
    PG8_WAIT_V(0);
    if constexpr (!ALIGN_EPI) { if (wr == 0) PG8_BAR; }
    PG8_BAR;
#undef PG8_SA
#undef PG8_GATH
#undef PG8_STAGE_A
#undef PG8_SB
#undef PG8_STAGE
#undef PG8_LDA
#undef PG8_LDB
#undef PG8_MMA
#undef PG8_WAIT_V
#undef PG8_WAIT_L
#undef PG8_BAR
#undef PG8_SCHED
}
}

#define XB_TMO      128
#define XB_XCNT(j)  (256  + 64 * (j))
#define XB_XSUB(j)  (1280 + 64 * (j))
#define XB_XGEN(j)  (2304 + 64 * (j))
#define XB_TOP      3328
#define XB_TOPGEN   3392
#define XCD_BAR_WORDS 3456
#define XB_SPIN_CAP (1u << 21)

__device__ __forceinline__ unsigned xb_ld(unsigned* p)              { return __hip_atomic_load(p, __ATOMIC_RELAXED, __HIP_MEMORY_SCOPE_AGENT); }
__device__ __forceinline__ unsigned xb_add(unsigned* p, unsigned v) { return __hip_atomic_fetch_add(p, v, __ATOMIC_RELAXED, __HIP_MEMORY_SCOPE_AGENT); }
__device__ __forceinline__ unsigned xb_xcc_id() { return (unsigned)__builtin_amdgcn_s_getreg((3 << 11) | 20) & 0xFu; }
#define XB_SPIN(cond, bar) do { unsigned _sp = 0; while (cond) { __builtin_amdgcn_s_sleep(1); \
    if ((++_sp & 255u) == 0u) { if (xb_ld(&(bar)[XB_TMO])) break; if (_sp > XB_SPIN_CAP) { atomicAdd(&(bar)[XB_TMO], 1u); break; } } } } while (0)

struct XcdBarrier {
    unsigned* bar; unsigned x;
    volatile LAS unsigned* st;
};

__device__ __forceinline__ XcdBarrier xcd_barrier_post(unsigned* bar, volatile LAS unsigned* st) {
    XcdBarrier b; b.bar = bar; b.x = xb_xcc_id(); b.st = st;
    if (threadIdx.x == 0) (void)xb_add(&bar[XB_XCNT(b.x)], 1u);
    return b;
}
__device__ __forceinline__ void xcd_barrier_complete(unsigned* bar, unsigned x, unsigned& nloc, unsigned& nx) {
    const unsigned G = gridDim.x * gridDim.y * gridDim.z;
    unsigned sum, cnt, mine, sp = 0u;
    for (;;) {
        sum = 0u; cnt = 0u; mine = 0u;
#pragma unroll
        for (unsigned j = 0; j < 16; ++j) { const unsigned c = xb_ld(&bar[XB_XCNT(j)]); sum += c; cnt += (c > 0u) ? 1u : 0u; mine = (j == x) ? c : mine; }
        if (sum == G) break;
        __builtin_amdgcn_s_sleep(1);
        if ((++sp & 255u) == 0u) { if (xb_ld(&bar[XB_TMO])) break; if (sp > XB_SPIN_CAP) { atomicAdd(&bar[XB_TMO], 1u); break; } }
    }
    nloc = mine > 0u ? mine : 1u; nx = cnt > 0u ? cnt : 1u;
}

__device__ __forceinline__ void xcd_barrier(const XcdBarrier& b) {
    asm volatile("s_waitcnt vmcnt(0)" ::: "memory");
    __syncthreads();
    if (threadIdx.x == 0) {
        unsigned* bar = b.bar;
        __builtin_amdgcn_s_waitcnt(0);
        unsigned nloc = b.st[0], nx = b.st[1];
        if (nloc == 0u) { xcd_barrier_complete(bar, b.x, nloc, nx); b.st[0] = nloc; b.st[1] = nx; }
        const unsigned old = xb_add(&bar[XB_XSUB(b.x)], 1u);
        const unsigned gen = old / nloc;
        if (old + 1u == (gen + 1u) * nloc) {
            __builtin_amdgcn_fence(__ATOMIC_RELEASE, "agent");
            asm volatile("s_waitcnt vmcnt(0)" ::: "memory");
            const unsigned og = xb_add(&bar[XB_TOP], 1u);
            const unsigned tg = og / nx;
            if (og + 1u == (tg + 1u) * nx) xb_add(&bar[XB_TOPGEN], 1u);
            else XB_SPIN(xb_ld(&bar[XB_TOPGEN]) == tg, bar);
            __builtin_amdgcn_fence(__ATOMIC_ACQUIRE, "agent");
            xb_add(&bar[XB_XGEN(b.x)], 1u);
            asm volatile("s_waitcnt vmcnt(0)" ::: "memory");
        } else {
            XB_SPIN(xb_ld(&bar[XB_XGEN(b.x)]) == gen, bar);
            __builtin_amdgcn_fence(__ATOMIC_ACQUIRE, "agent");
            asm volatile("s_waitcnt vmcnt(0)" ::: "memory");
        }
    }
    __syncthreads();
}

constexpr int NWAVES = 8, NTHREADS = 512;
constexpr int RING_BYTES = 131072;
constexpr int LDSCTL_OFF = 163840 - 1024, MISC_OFF = LDSCTL_OFF + 320;
constexpr int LDS_BYTES = 163840;

struct Params { const float* in[19]; float* out; unsigned char* ws; float inv_freq[16]; float ret_lg2[4]; int ph_lo, ph_hi; };
typedef const __attribute__((address_space(4))) Params& KPRef;

__device__ __forceinline__ float wave_sum(float v) {
#pragma unroll
    for (int o = 1; o < 64; o <<= 1) v += __shfl_xor(v, o);
    return v;
}
#define LDS_WAIT() asm volatile("s_waitcnt lgkmcnt(0)" ::: "memory")
#define MFMA16(a, b, c) __builtin_amdgcn_mfma_f32_16x16x32_bf16(a, b, c, 0, 0, 0)
typedef short v4i16_t __attribute__((ext_vector_type(4)));
__device__ __forceinline__ v4i16_t lds_tr16(const bf16_t* p) { return __builtin_amdgcn_ds_read_tr16_b64_v4i16((LAS v4i16_t*)(LAS unsigned char*)(unsigned char*)p); }
__device__ __forceinline__ bf16x8 tr_frag(const bf16_t* tile, int stride, int rowa, int rowb, int col0, int lane) {
    const int i = lane & 15, q = i >> 2, pp = i & 3;
    const v4i16_t lo = lds_tr16(tile + (rowa + q) * stride + col0 + 4 * pp), hi = lds_tr16(tile + (rowb + q) * stride + col0 + 4 * pp);
    return (bf16x8){lo[0], lo[1], lo[2], lo[3], hi[0], hi[1], hi[2], hi[3]};
}
__device__ __forceinline__ bf16x8 pack_p(const f32x4& a, const f32x4& b) {
    u32x4 w; w.x = pg8::cvt_pk_bf16(a[0], a[1]); w.y = pg8::cvt_pk_bf16(a[2], a[3]); w.z = pg8::cvt_pk_bf16(b[0], b[1]); w.w = pg8::cvt_pk_bf16(b[2], b[3]); return __builtin_bit_cast(bf16x8, w); }


template <class LD>
__device__ __forceinline__ void conv_item(LD ld, bf16_t* WT, int K, float* scr, int kb, int nb, int lane) {
    const int k0 = 64 * kb, n0 = 32 * nb;
    float wv[32];
#pragma unroll
    for (int i = 0; i < 32; ++i) wv[i] = ld(k0 + 2 * i + (lane >> 5), n0 + (lane & 31));
#pragma unroll
    for (int i = 0; i < 32; ++i) { const int kk = 2 * i + (lane >> 5); scr[kk * 33 + (lane & 31)] = wv[i]; }
    LDS_WAIT();
    const int c = lane & 7;
#pragma unroll
    for (int j = 0; j < 4; ++j) { const int n = (lane >> 3) + 8 * j; const float* s = scr + (8 * c) * 33 + n;
        u32x4 o; o.x = pk2(s[0 * 33], s[1 * 33]); o.y = pk2(s[2 * 33], s[3 * 33]); o.z = pk2(s[4 * 33], s[5 * 33]); o.w = pk2(s[6 * 33], s[7 * 33]);
        *(u32x4*)(WT + (size_t)(n0 + n) * K + k0 + 8 * c) = o; }
    LDS_WAIT();
}

struct C8Item { const float* base; int stride; int coff; bool valid; signed char* WT; float* scale; float ex; int n0; };
__device__ __forceinline__ void conv8_load(const C8Item& d, float (&wv)[2][32], int wave, int lane) {
    const unsigned lo = (unsigned)((lane >> 5) * d.stride + d.coff);
#pragma unroll
    for (int h = 0; h < 2; ++h)
#pragma unroll
        for (int i = 0; i < 32; ++i) { const float* rp = d.base + (size_t)(128 * wave + 64 * h + 2 * i) * d.stride; wv[h][i] = rp[lo]; }
}
__device__ __forceinline__ void conv8_work(const C8Item& d, float (&wv)[2][32], float* scr, float* red, int wave, int lane) {
    if (!d.valid) {
#pragma unroll
        for (int h = 0; h < 2; ++h)
#pragma unroll
            for (int i = 0; i < 32; ++i) wv[h][i] = 0.f; }
    float am = 0.f;
#pragma unroll
    for (int h = 0; h < 2; ++h)
#pragma unroll
        for (int i = 0; i < 32; ++i) am = fmaxf(am, fabsf(wv[h][i]));
    am = fmaxf(am, __shfl_xor(am, 32));
    if (lane < 32) red[wave * 32 + lane] = am;
    __syncthreads();
    float cm = 0.f;
#pragma unroll
    for (int w = 0; w < 8; ++w) cm = fmaxf(cm, red[w * 32 + (lane & 31)]);
    const float qs = (cm > 0.f) ? 127.0f / cm : 0.f;
    if (wave == 0 && lane < 32) d.scale[d.n0 + lane] = cm * (1.0f / 127.0f) * d.ex;
    const int c = lane & 7;
#pragma unroll
    for (int h = 0; h < 2; ++h) { const int k0 = 128 * wave + 64 * h;
#pragma unroll
        for (int i = 0; i < 32; ++i) { const int kk = 2 * i + (lane >> 5); scr[kk * 33 + (lane & 31)] = rintf(wv[h][i] * qs); }
        LDS_WAIT();
#pragma unroll
        for (int j = 0; j < 4; ++j) { const int n = (lane >> 3) + 8 * j; const float* s = scr + (8 * c) * 33 + n;
            u32x2 o; o.x = ((unsigned)((int)s[0 * 33] & 0xff)) | ((unsigned)((int)s[1 * 33] & 0xff) << 8) | ((unsigned)((int)s[2 * 33] & 0xff) << 16) | ((unsigned)((int)s[3 * 33] & 0xff) << 24);
            o.y = ((unsigned)((int)s[4 * 33] & 0xff)) | ((unsigned)((int)s[5 * 33] & 0xff) << 8) | ((unsigned)((int)s[6 * 33] & 0xff) << 16) | ((unsigned)((int)s[7 * 33] & 0xff) << 24);
            *(u32x2*)(d.WT + (size_t)(d.n0 + n) * 1024 + k0 + 8 * c) = o; }
        LDS_WAIT(); }
    __syncthreads();
}
__device__ __forceinline__ C8Item conv8_desc(KPRef p, int l, unsigned char* wd, int it, int lane) {
    unsigned char* ws = p.ws; const size_t sl = (size_t)l * SW_LSTEP; const float* Win = p.in[2] + (size_t)l * 1024 * IN_W;
    C8Item d;
    if (it < 96) { const int n = 32 * it + (lane & 31); d.valid = n < Z_GATE; d.base = Win; d.stride = IN_W; d.coff = d.valid ? n : 0; d.n0 = 32 * it;
        float s = 1.f; if (n < Z_GK) s = RSQ32; else if (n >= Z_SQ && n < Z_SK) s = C2; else if (n >= Z_MQ && n < Z_MK) s = C2; else if (n >= Z_RK && n < Z_RV) s = RSQ32;
        d.ex = s; d.WT = (signed char*)(wd + WS_WIN); d.scale = (float*)(ws + WS_SWIN + sl);
    } else if (it < 224) { const int nb = it - 96, n = 32 * nb + (lane & 31);
        const int pn = n >> 8, cc = n & 255, bj = (cc >> 7) & 1, wc = (cc >> 5) & 3, nn = (cc >> 4) & 1, fq = (cc >> 2) & 3, j = cc & 3;
        d.valid = true; d.base = Win; d.stride = IN_W; d.coff = Z_GATE + 1024 * (2 * bj + nn) + 64 * pn + 16 * wc + 4 * fq + j; d.n0 = 32 * nb; d.ex = 1.f;
        d.WT = (signed char*)(wd + WS_WG); d.scale = (float*)(ws + WS_SWG + sl);
    } else { const int r = it - 224, e = r >> 4, nb = r & 15;
        const int n0 = 32 * nb, pn = n0 >> 8, c0 = n0 & 255;
        d.valid = true; d.base = ((c0 < 128) ? p.in[15] : p.in[16]) + (size_t)(l * 32 + e) * 1024 * 256 + 128 * pn + (c0 & 127); d.stride = 256; d.coff = lane & 31; d.n0 = n0; d.ex = 1.f;
        d.WT = (signed char*)(wd + WS_E1) + (size_t)e * 512 * 1024; d.scale = (float*)(ws + WS_SWE1 + sl) + e * 512; }
    return d;
}
__device__ __forceinline__ void conv8_phase(KPRef p, int l, unsigned char* wd, unsigned char* lds, int c, int nwg, int wave, int lane, int it_lo, int it_hi) {
    float* scr = (float*)(lds + wave * 16384); float* red = (float*)(lds + RING_BYTES);
    int it = it_lo + c; if (it >= it_hi) return;
    C8Item d0 = conv8_desc(p, l, wd, it, lane); float wa[2][32]; conv8_load(d0, wa, wave, lane);
    for (;;) {
        const int it2 = it + nwg; const bool has = it2 < it_hi;
        const C8Item d1 = conv8_desc(p, l, wd, has ? it2 : it, lane); float wb[2][32];
        if (has) conv8_load(d1, wb, wave, lane);
        conv8_work(d0, wa, scr, red, wave, lane);
        if (!has) break;
#pragma unroll
        for (int h = 0; h < 2; ++h)
#pragma unroll
            for (int i = 0; i < 32; ++i) wa[h][i] = wb[h][i];
        d0 = d1; it = it2;
    }
}

__device__ __forceinline__ void conv_phase(KPRef p, int l, unsigned char* wd, unsigned char* lds, int gw, int NGW, int wave, int lane) {
    float* scr = (float*)(lds + wave * 16384);
    unsigned char* ws = wd;
    {
        for (int it = gw; it < 512; it += NGW) { const int i = it / 128, r = it % 128, kb = r / 32, nb = r % 32;
            const float* W = p.in[8] + (size_t)(l * 4 + i) * 256 * 1024; bf16_t* WT = (bf16_t*)(ws + WS_WB) + (size_t)i * 1024 * 256;
            conv_item([&](int k, int n) -> float { return W[(size_t)k * 1024 + n]; }, WT, 256, scr, kb, nb, lane); }
    }
    {
        const float* W = p.in[9] + (size_t)l * 1024 * 1024; bf16_t* WT = (bf16_t*)(ws + WS_WO);
        for (int it = gw; it < 16 * 32; it += NGW) { const int kb = it / 32, nb = it % 32;
            conv_item([&](int k, int n) -> float { return W[(size_t)k * 1024 + n]; }, WT, 1024, scr, kb, nb, lane); }
    }
    {
        const float* Wg = p.in[11] + (size_t)l * 1024 * 4; const float* We = p.in[13] + (size_t)l * 1024 * 32; const float* g2 = p.in[10] + l * 1024; bf16_t* WT = (bf16_t*)(ws + WS_WR);
        for (int it = gw; it < 16 * 8; it += NGW) { const int kb = it / 8, nb = it % 8;
            conv_item([&](int k, int n) -> float { const float gk = g2[k]; if (n < 4) return gk * Wg[k * 4 + n]; if (n < 36) return gk * We[k * 32 + (n - 4)]; return 0.f; }, WT, 1024, scr, kb, nb, lane); }
    }
    {
        for (int it = gw; it < 32 * 128; it += NGW) { const int e = it / 128, r = it % 128, kb = r / 32, nb = r % 32;
            const float* W = p.in[17] + (size_t)(l * 32 + e) * 256 * 1024; bf16_t* WT = (bf16_t*)(ws + WS_E2) + (size_t)e * 1024 * 256;
            conv_item([&](int k, int n) -> float { return W[(size_t)k * 1024 + n]; }, WT, 256, scr, kb, nb, lane); }
    }
}

__device__ __forceinline__ bf16_t* hbf_ptr(KPRef p) { return (bf16_t*)((unsigned char*)p.out + (size_t)64 * MiB); }
template <bool SRC_F32, bool COMBINE>
__device__ __forceinline__ void norm_load_row(KPRef p, int row, int lane, f32x4 (&v)[4]) {
    if (SRC_F32) { const f32x4* xr = (const f32x4*)(p.in[0] + (size_t)row * 1024) + lane;
#pragma unroll
        for (int j = 0; j < 4; ++j) v[j] = xr[64 * j];
    } else { const u32x2* hr = (const u32x2*)(hbf_ptr(p) + (size_t)row * 1024) + lane;
#pragma unroll
        for (int j = 0; j < 4; ++j) { const u32x2 a = hr[64 * j]; v[j] = (f32x4){__uint_as_float(a.x << 16), __uint_as_float(a.x & 0xffff0000u), __uint_as_float(a.y << 16), __uint_as_float(a.y & 0xffff0000u)}; } }
    if (COMBINE) { const bf16_t* ys = (const bf16_t*)(p.ws + WS_YS); const float* tokw = (const float*)(p.ws + WS_TOKW);
        const float w0 = tokw[2 * row], w1 = tokw[2 * row + 1];
        const u32x2* y0 = (const u32x2*)(ys + (size_t)(2 * row) * 1024) + lane; const u32x2* y1 = (const u32x2*)(ys + (size_t)(2 * row + 1) * 1024) + lane;
        u32x2 ya[4], yb[4];
#pragma unroll
        for (int j = 0; j < 4; ++j) { ya[j] = y0[64 * j]; yb[j] = y1[64 * j]; }
#pragma unroll
        for (int j = 0; j < 4; ++j) { const u32x2 a = ya[j], b = yb[j];
            v[j][0] += w0 * __uint_as_float(a.x << 16) + w1 * __uint_as_float(b.x << 16); v[j][1] += w0 * __uint_as_float(a.x & 0xffff0000u) + w1 * __uint_as_float(b.x & 0xffff0000u);
            v[j][2] += w0 * __uint_as_float(a.y << 16) + w1 * __uint_as_float(b.y << 16); v[j][3] += w0 * __uint_as_float(a.y & 0xffff0000u) + w1 * __uint_as_float(b.y & 0xffff0000u); } }
}
__device__ __forceinline__ float row_rstd(const f32x4 (&v)[4]) {
    float s = 0.f;
#pragma unroll
    for (int j = 0; j < 4; ++j) s += (v[j][0] * v[j][0] + v[j][1] * v[j][1]) + (v[j][2] * v[j][2] + v[j][3] * v[j][3]);
    return rsqrtf(wave_sum(s) * (1.0f / 1024.0f) + NORM_EPS);
}
template <int MODE>
__device__ __forceinline__ void norm_phase(KPRef p, int l, int gw, int NGW, int lane) {
    const float* gain = (MODE == 2 ? p.in[10] + l * 1024 : p.in[1] + l * 1024);
    f32x4 gg[4];
#pragma unroll
    for (int j = 0; j < 4; ++j) gg[j] = ((const f32x4*)gain)[lane + 64 * j];
    constexpr int NR = (MODE == 1) ? 2 : 4;
    for (int row0 = gw * NR; row0 < T_; row0 += NGW * NR) {
        f32x4 v[NR][4];
#pragma unroll
        for (int r = 0; r < NR; ++r) norm_load_row<MODE == 0, MODE == 1>(p, row0 + r, lane, v[r]);
#pragma unroll
        for (int r = 0; r < NR; ++r) {
            if (MODE == 1) { u32x2* hr = (u32x2*)(hbf_ptr(p) + (size_t)(row0 + r) * 1024) + lane;
#pragma unroll
                for (int j = 0; j < 4; ++j) { u32x2 w; w.x = pk2(v[r][j][0], v[r][j][1]); w.y = pk2(v[r][j][2], v[r][j][3]); hr[64 * j] = w; } }
            const float rstd = row_rstd(v[r]);
            f32x4 o[4]; float am = 0.f;
#pragma unroll
            for (int j = 0; j < 4; ++j) { o[j] = v[r][j] * rstd * gg[j]; am = fmaxf(fmaxf(am, fmaxf(fabsf(o[j][0]), fabsf(o[j][1]))), fmaxf(fabsf(o[j][2]), fabsf(o[j][3]))); }
#pragma unroll
            for (int of = 1; of < 64; of <<= 1) am = fmaxf(am, __shfl_xor(am, of));
            const float qs = (am > 0.f) ? 127.0f / am : 0.f;
            unsigned* o4 = (unsigned*)(p.ws + WS_U8 + (size_t)(row0 + r) * 1024) + lane;
#pragma unroll
            for (int j = 0; j < 4; ++j) { const int q0 = (int)rintf(o[j][0] * qs), q1 = (int)rintf(o[j][1] * qs), q2 = (int)rintf(o[j][2] * qs), q3 = (int)rintf(o[j][3] * qs);
                o4[64 * j] = (unsigned)(q0 & 0xff) | ((unsigned)(q1 & 0xff) << 8) | ((unsigned)(q2 & 0xff) << 16) | ((unsigned)(q3 & 0xff) << 24); }
            if (lane == 0) ((float*)(p.ws + WS_SU))[row0 + r] = am * (1.0f / 127.0f);
            if (MODE == 2 && lane == 0) ((float*)(p.ws + WS_RSTD))[row0 + r] = rstd;
        }
    }
}
struct FinalHold { f32x4 v[8][4]; };
__device__ __forceinline__ void final_a(KPRef p, int gw, int NGW, int lane, FinalHold& Hd) {
    f32x4 gg[4];
#pragma unroll
    for (int j = 0; j < 4; ++j) gg[j] = ((const f32x4*)p.in[18])[lane + 64 * j];
    for (int row0 = gw * 4; row0 < T_ / 2; row0 += NGW * 4) {
        f32x4 v[4][4];
#pragma unroll
        for (int r = 0; r < 4; ++r) norm_load_row<false, true>(p, row0 + r, lane, v[r]);
#pragma unroll
        for (int r = 0; r < 4; ++r) { const float rstd = row_rstd(v[r]); f32x4* orow = (f32x4*)(p.out + (size_t)(row0 + r) * 1024) + lane;
#pragma unroll
            for (int j = 0; j < 4; ++j) orow[64 * j] = v[r][j] * rstd * gg[j]; } }
#pragma unroll
    for (int r = 0; r < 8; ++r) norm_load_row<false, true>(p, T_ / 2 + gw * 8 + r, lane, Hd.v[r]);
}
__device__ __forceinline__ void final_b(KPRef p, int gw, int lane, const FinalHold& Hd) {
    f32x4 gg[4];
#pragma unroll
    for (int j = 0; j < 4; ++j) gg[j] = ((const f32x4*)p.in[18])[lane + 64 * j];
#pragma unroll
    for (int r = 0; r < 8; ++r) { const float rstd = row_rstd(Hd.v[r]); f32x4* orow = (f32x4*)(p.out + (size_t)(T_ / 2 + gw * 8 + r) * 1024) + lane;
#pragma unroll
        for (int j = 0; j < 4; ++j) orow[64 * j] = Hd.v[r][j] * rstd * gg[j]; }
}

constexpr int LA_QS = 0, LA_KS = 10240, LA_VS = 20480  , LA_KD = 38912  , LA_PS = 49152  , LA_PW = 58368, LA_PW_WAVE = 4352,
              LA_LA = 93184, LA_AS = 110080, LA_END = 118272;
__device__ __forceinline__ void unpack8f(float (&d)[8], u32x4 kk) {
    d[0] = __uint_as_float(kk.x << 16); d[1] = __uint_as_float(kk.x & 0xffff0000u); d[2] = __uint_as_float(kk.y << 16); d[3] = __uint_as_float(kk.y & 0xffff0000u);
    d[4] = __uint_as_float(kk.z << 16); d[5] = __uint_as_float(kk.z & 0xffff0000u); d[6] = __uint_as_float(kk.w << 16); d[7] = __uint_as_float(kk.w & 0xffff0000u); }
__device__ __forceinline__ u32x4 pack8f(const float (&o)[8]) { u32x4 w; w.x = pk2(o[0], o[1]); w.y = pk2(o[2], o[3]); w.z = pk2(o[4], o[5]); w.w = pk2(o[6], o[7]); return w; }

struct LaRegs { u32x4 a, k[2], q[2], v[2], g[2]; f32x4 pv[2]; };
__device__ __forceinline__ void gla_decay_front(KPRef p, int l, unsigned char* lds, const u32x4& areg, int h, int tid) {
    float* LA = (float*)(lds + LA_LA); float* AS = (float*)(lds + LA_AS);
    const int lane = tid & 63, wave = __builtin_amdgcn_readfirstlane(tid >> 6);
    if (tid < 256) { const int t = tid >> 1, hf = tid & 1; float a[8]; unpack8f(a, areg);
#pragma unroll
        for (int e = 0; e < 8; ++e) AS[t * 16 + 8 * hf + e] = a[e]; }
    const int d = tid & 31; const float* wa2 = p.in[3] + (size_t)l * 16 * 128 + h * 32 + d; float wcol[16];
#pragma unroll
    for (int r = 0; r < 16; ++r) wcol[r] = wa2[r * 128];
    const float bias = p.in[4][l * 128 + h * 32 + d];
    __syncthreads();
#pragma unroll
    for (int i = 0; i < 8; ++i) { const int t = (tid >> 5) + 16 * i; float x = bias;
#pragma unroll
        for (int r = 0; r < 16; ++r) x += AS[t * 16 + r] * wcol[r];
        LA[t * 33 + d] = (fminf(x, 0.f) - __builtin_amdgcn_logf(1.0f + __builtin_amdgcn_exp2f(-fabsf(x) * LOG2E)) * 0.6931471805599453f) * (1.0f / 16.0f); }
    __syncthreads();
#pragma unroll
    for (int s8 = 0; s8 < 8; ++s8) { const int s = wave * 8 + s8, ch = s >> 5, dd = s & 31; float v = LA[(64 * ch + lane) * 33 + dd];
#pragma unroll
        for (int o = 1; o < 64; o <<= 1) { const float t = __shfl_up(v, o); if (lane >= o) v += t; }
        LA[(64 * ch + lane) * 33 + dd] = v; }
    __syncthreads();
}
__device__ __forceinline__ void la_stage_v(unsigned char* lds, const u32x4 (&v)[2], int tid) {
    bf16_t* VS = (bf16_t*)(lds + LA_VS);
#pragma unroll
    for (int i = 0; i < 2; ++i) { const int c = tid + 512 * i, t = c >> 3, oct = c & 7; *(u32x4*)(VS + t * 72 + 8 * oct) = v[i]; }
}
template <bool OUT, bool GLA>
__device__ __forceinline__ void la_load(LaRegs& R, KPRef p, int unit, int tid) {
    const int lane = tid & 63, wave = __builtin_amdgcn_readfirstlane(tid >> 6);
    int b, h, c128; if (GLA) { c128 = unit & 63; h = (unit >> 6) & 3; b = unit >> 8; } else { c128 = unit & 63; const int bh = unit >> 6; h = bh & 3; b = bh >> 2; }
    const size_t t0 = (size_t)b * S_ + (size_t)c128 * 128; const bf16_t* zrow0 = (const bf16_t*)(p.ws + WS_Z) + t0 * ZLD;
    const int kcol = GLA ? Z_GK + h * 32 : Z_RK + h * 32, qcol = GLA ? Z_GQ + h * 32 : Z_RQ + h * 32, vcol = GLA ? Z_GV + h * 64 : Z_RV + h * 64, gcol = GLA ? Z_GR + h * 64 : Z_RG + h * 64;
    if (GLA) { const int t = (tid & 255) >> 1, hf = tid & 1; R.a = *(const u32x4*)(zrow0 + (size_t)t * ZLD + Z_GA + 8 * hf); }
    { const int t = tid >> 2, oct = tid & 3; const bf16_t* kr = zrow0 + (size_t)t * ZLD + kcol; R.k[0] = *(const u32x4*)(kr + 8 * oct); if (!GLA) R.k[1] = *(const u32x4*)(kr + 8 * (oct ^ 2));
      if (OUT) { const bf16_t* qr = zrow0 + (size_t)t * ZLD + qcol; R.q[0] = *(const u32x4*)(qr + 8 * oct); if (!GLA) R.q[1] = *(const u32x4*)(qr + 8 * (oct ^ 2)); } }
#pragma unroll
    for (int i = 0; i < 2; ++i) { const int c = tid + 512 * i, t = c >> 3, oct = c & 7; R.v[i] = *(const u32x4*)(zrow0 + (size_t)t * ZLD + vcol + 8 * oct); }
    if (OUT) {
#pragma unroll
        for (int i = 0; i < 2; ++i) { const int cidx = lane + 64 * i, row = cidx >> 3, oct = cidx & 7; R.g[i] = *(const u32x4*)(zrow0 + (size_t)(16 * wave + row) * ZLD + gcol + 8 * oct); }
        const float* prev = GLA ? (const float*)(p.ws + WS_GKV) + (size_t)((b * 4 + h) * 128 + 2 * c128) * 2048 : (const float*)(p.ws + WS_RKV) + (size_t)unit * 2048;
        const int row = (GLA ? tid : (tid & 255)) >> 3, oct = tid & 7; R.pv[0] = *(const f32x4*)(prev + row * 64 + 8 * oct); R.pv[1] = *(const f32x4*)(prev + row * 64 + 8 * oct + 4); }
}
__device__ __forceinline__ void la_kv_mfma(unsigned char* lds, float* out0, int nch, int clen, int tid) {
    const bf16_t* KD = (const bf16_t*)(lds + LA_KD); const bf16_t* VS = (const bf16_t*)(lds + LA_VS);
    const int lane = tid & 63, wave = __builtin_amdgcn_readfirstlane(tid >> 6), c16 = lane & 15, g = lane >> 4;
    const int ntile = 8 * nch;
    for (int ti = wave; ti < ntile; ti += 8) { const int ch = ti >> 3, dt = (ti >> 2) & 1, et = ti & 3, tok0 = ch * clen;
        f32x4 acc = (f32x4){0.f, 0.f, 0.f, 0.f};
        for (int s = 0; s < clen / 32; ++s) { const int r0 = tok0 + 32 * s + 8 * g;
            acc = MFMA16(tr_frag(KD, 40, r0, r0 + 4, 16 * dt, lane), tr_frag(VS, 72, r0, r0 + 4, 16 * et, lane), acc); }
        float* o = out0 + (size_t)ch * 2048 + (16 * dt + 4 * g) * 64 + 16 * et + c16;
#pragma unroll
        for (int r = 0; r < 4; ++r) o[r * 64] = acc[r]; }
}
__device__ __forceinline__ void gla_kv_unit(KPRef p, int l, unsigned char* lds, int unit, const LaRegs& R, int tid) {
    const int c = unit & 63, h = (unit >> 6) & 3, b = unit >> 8;
    gla_decay_front(p, l, lds, R.a, h, tid);
    const float* LA = (const float*)(lds + LA_LA); bf16_t* KD = (bf16_t*)(lds + LA_KD);
    { const int t = tid >> 2, oct = tid & 3, ch = t >> 6; float k[8]; unpack8f(k, R.k[0]);
#pragma unroll
      for (int e = 0; e < 8; ++e) { const int d = 8 * oct + e; k[e] *= __builtin_amdgcn_exp2f((LA[(64 * ch + 63) * 33 + d] - LA[t * 33 + d]) * LOG2E); }
      *(u32x4*)(KD + t * 40 + 8 * oct) = pack8f(k); }
    la_stage_v(lds, R.v, tid);
    __syncthreads();
    const int cu = ((b * 4 + h) * 128 + 2 * c);
    la_kv_mfma(lds, (float*)(p.ws + WS_GKV) + (size_t)cu * 2048, 2, 64, tid);
    if (tid < 64) { const int ch = tid >> 5, d = tid & 31; ((float*)(p.ws + WS_GDEC))[(size_t)(cu + ch) * 32 + d] = __builtin_amdgcn_exp2f(LA[(64 * ch + 63) * 33 + d] * LOG2E); }
    __syncthreads();
}
__device__ __forceinline__ void la_out_mfma(unsigned char* lds, const u32x4 (&gate)[2], const float* ng, bf16_t* orow0, int ocol, int clen, int tid) {
    const bf16_t* QS = (const bf16_t*)(lds + LA_QS); const bf16_t* KS = (const bf16_t*)(lds + LA_KS); const bf16_t* VS = (const bf16_t*)(lds + LA_VS); const bf16_t* PS = (const bf16_t*)(lds + LA_PS);
    const int lane = tid & 63, wave = __builtin_amdgcn_readfirstlane(tid >> 6), c16 = lane & 15, g = lane >> 4;
    float* PWf = (float*)(lds + LA_PW + wave * LA_PW_WAVE);
    const int ch = (clen == 64) ? (wave >> 2) : 0, kt0 = (clen == 64) ? 4 * ch : 0;
    const bf16x8 qa = *(const bf16x8*)(QS + (16 * wave + c16) * 40 + 8 * g);
    f32x4 O[4];
#pragma unroll
    for (int et = 0; et < 4; ++et) O[et] = MFMA16(qa, tr_frag(PS + ch * 32 * 72, 72, 8 * g, 8 * g + 4, 16 * et, lane), ((f32x4){0.f, 0.f, 0.f, 0.f}));
    for (int s = kt0 >> 1; s <= (wave >> 1); ++s) {
        f32x4 P0, P1;
        { const int kt = 2 * s; P0 = MFMA16(*(const bf16x8*)(KS + (16 * kt + c16) * 40 + 8 * g), qa, ((f32x4){0.f, 0.f, 0.f, 0.f}));
          if (kt == wave) {
#pragma unroll
              for (int r = 0; r < 4; ++r) if (4 * g + r > c16) P0[r] = 0.f; } }
        { const int kt = 2 * s + 1;
          if (kt <= wave) { P1 = MFMA16(*(const bf16x8*)(KS + (16 * kt + c16) * 40 + 8 * g), qa, ((f32x4){0.f, 0.f, 0.f, 0.f}));
            if (kt == wave) {
#pragma unroll
                for (int r = 0; r < 4; ++r) if (4 * g + r > c16) P1[r] = 0.f; } }
          else P1 = (f32x4){0.f, 0.f, 0.f, 0.f}; }
        const bf16x8 pa = pack_p(P0, P1);
#pragma unroll
        for (int et = 0; et < 4; ++et) O[et] = MFMA16(pa, tr_frag(VS, 72, 32 * s + 4 * g, 32 * s + 16 + 4 * g, 16 * et, lane), O[et]); }
    float rs[4];
#pragma unroll
    for (int r = 0; r < 4; ++r) { float ss = O[0][r] * O[0][r] + O[1][r] * O[1][r] + O[2][r] * O[2][r] + O[3][r] * O[3][r];
#pragma unroll
        for (int o = 1; o < 16; o <<= 1) ss += __shfl_xor(ss, o);
        rs[r] = rsqrtf(ss * (1.0f / 64.0f) + NORM_EPS); }
#pragma unroll
    for (int et = 0; et < 4; ++et)
#pragma unroll
        for (int r = 0; r < 4; ++r) PWf[(4 * g + r) * 68 + 16 * et + c16] = O[et][r] * rs[r];
    LDS_WAIT();
#pragma unroll
    for (int i = 0; i < 2; ++i) { const int cidx = lane + 64 * i, row = cidx >> 3, oct = cidx & 7; const int t = 16 * wave + row;
        float gt[8]; unpack8f(gt, gate[i]);
        const f32x4 o0 = *(const f32x4*)(PWf + row * 68 + 8 * oct), o1 = *(const f32x4*)(PWf + row * 68 + 8 * oct + 4), n0 = *(const f32x4*)(ng + 8 * oct), n1 = *(const f32x4*)(ng + 8 * oct + 4);
        float o[8];
#pragma unroll
        for (int e = 0; e < 4; ++e) { o[e] = o0[e] * n0[e] * (gt[e] * sigmoidf_(gt[e])); o[4 + e] = o1[e] * n1[e] * (gt[4 + e] * sigmoidf_(gt[4 + e])); }
        *(u32x4*)(orow0 + (size_t)t * OLD + ocol + 8 * oct) = pack8f(o); }
    LDS_WAIT();
}
__device__ __forceinline__ void gla_out_unit(KPRef p, int l, unsigned char* lds, int unit, const LaRegs& R, int tid) {
    const int c = unit & 63, h = (unit >> 6) & 3, b = unit >> 8;
    const size_t t0 = (size_t)b * S_ + (size_t)c * 128;
    gla_decay_front(p, l, lds, R.a, h, tid);
    const float* LA = (const float*)(lds + LA_LA); bf16_t* QS = (bf16_t*)(lds + LA_QS); bf16_t* KS = (bf16_t*)(lds + LA_KS); bf16_t* PS = (bf16_t*)(lds + LA_PS);
    { const int t = tid >> 2, oct = tid & 3; float k[8], q[8]; unpack8f(k, R.k[0]); unpack8f(q, R.q[0]);
#pragma unroll
      for (int e = 0; e < 8; ++e) { const float bb = LA[t * 33 + 8 * oct + e] * LOG2E; q[e] *= __builtin_amdgcn_exp2f(bb); k[e] *= __builtin_amdgcn_exp2f(-bb); }
      *(u32x4*)(QS + t * 40 + 8 * oct) = pack8f(q); *(u32x4*)(KS + t * 40 + 8 * oct) = pack8f(k); }
    la_stage_v(lds, R.v, tid);
    { const int row = tid >> 3, oct = tid & 7; float o[8] = {R.pv[0][0], R.pv[0][1], R.pv[0][2], R.pv[0][3], R.pv[1][0], R.pv[1][1], R.pv[1][2], R.pv[1][3]}; *(u32x4*)(PS + row * 72 + 8 * oct) = pack8f(o); }
    __syncthreads();
    la_out_mfma(lds, R.g, p.in[5] + l * 64, (bf16_t*)(p.ws + WS_O) + t0 * OLD, 0 + h * 64, 64, tid);
    __syncthreads();
}
__device__ __forceinline__ void rope_cs(float pos, float invf, float& c, float& s) {
    const float ang = pos * invf; const double t = (double)ang * 0.15915494309189535; const float fr = (float)(t - floor(t));
    c = __builtin_amdgcn_cosf(fr); s = __builtin_amdgcn_sinf(fr);
}
__device__ __forceinline__ void ret_cs_table(KPRef p, unsigned char* lds, int pos0, int tid) {
    f32x2* CS = (f32x2*)(lds + LA_LA);
#pragma unroll
    for (int i = 0; i < 4; ++i) { const int idx = tid + 512 * i, t = idx >> 4, f = idx & 15; float c, s; rope_cs((float)(pos0 + t), p.inv_freq[f], c, s); CS[idx] = (f32x2){c, s}; }
}
__device__ __forceinline__ void ret_rot8(const unsigned char* lds, const u32x4& own_q, const u32x4& oth_q, int t, int oct, float (&o)[8]) {
    const f32x2* CS = (const f32x2*)(lds + LA_LA); float own[8], oth[8]; unpack8f(own, own_q); unpack8f(oth, oth_q);
#pragma unroll
    for (int e = 0; e < 8; ++e) { const f32x2 cs = CS[t * 16 + 8 * (oct & 1) + e]; o[e] = (oct < 2) ? (own[e] * cs[0] - oth[e] * cs[1]) : (oth[e] * cs[1] + own[e] * cs[0]); }
}
__device__ __forceinline__ void ret_kv_unit(KPRef p, unsigned char* lds, int unit, const LaRegs& R, int tid) {
    const int n = unit & 63, bh = unit >> 6, h = bh & 3;
    ret_cs_table(p, lds, n * 128, tid);
    la_stage_v(lds, R.v, tid);
    __syncthreads();
    bf16_t* KD = (bf16_t*)(lds + LA_KD); const float lg = p.ret_lg2[h];
    { const int t = tid >> 2, oct = tid & 3; float k[8]; ret_rot8(lds, R.k[0], R.k[1], t, oct, k); const float dk = __builtin_amdgcn_exp2f((float)(127 - t) * lg);
#pragma unroll
      for (int e = 0; e < 8; ++e) k[e] *= dk;
      *(u32x4*)(KD + t * 40 + 8 * oct) = pack8f(k); }
    __syncthreads();
    la_kv_mfma(lds, (float*)(p.ws + WS_RKV) + (size_t)unit * 2048, 1, 128, tid);
    __syncthreads();
}
__device__ __forceinline__ void ret_out_unit(KPRef p, int l, unsigned char* lds, int unit, const LaRegs& R, int tid) {
    const int n = unit & 63, bh = unit >> 6, h = bh & 3, b = bh >> 2;
    const size_t t0 = (size_t)b * S_ + (size_t)n * 128;
    ret_cs_table(p, lds, n * 128, tid);
    la_stage_v(lds, R.v, tid);
    const float lg = p.ret_lg2[h]; bf16_t* PS = (bf16_t*)(lds + LA_PS); const float g1 = __builtin_amdgcn_exp2f(lg);
    if (tid < 256) { const int row = tid >> 3, oct = tid & 7;
      float o[8] = {R.pv[0][0] * g1, R.pv[0][1] * g1, R.pv[0][2] * g1, R.pv[0][3] * g1, R.pv[1][0] * g1, R.pv[1][1] * g1, R.pv[1][2] * g1, R.pv[1][3] * g1}; *(u32x4*)(PS + row * 72 + 8 * oct) = pack8f(o); }
    __syncthreads();
    bf16_t* QS = (bf16_t*)(lds + LA_QS); bf16_t* KS = (bf16_t*)(lds + LA_KS);
    { const int t = tid >> 2, oct = tid & 3; float k[8], q[8]; ret_rot8(lds, R.k[0], R.k[1], t, oct, k); ret_rot8(lds, R.q[0], R.q[1], t, oct, q);
      const float dq = __builtin_amdgcn_exp2f((float)t * lg), dk = __builtin_amdgcn_exp2f(-(float)t * lg);
#pragma unroll
      for (int e = 0; e < 8; ++e) { q[e] *= dq; k[e] *= dk; }
      *(u32x4*)(QS + t * 40 + 8 * oct) = pack8f(q); *(u32x4*)(KS + t * 40 + 8 * oct) = pack8f(k); }
    __syncthreads();
    la_out_mfma(lds, R.g, p.in[7] + l * 64, (bf16_t*)(p.ws + WS_O) + t0 * OLD, 768 + h * 64, 128, tid);
    __syncthreads();
}
template <int KIND>
__device__ __forceinline__ void la_loop(KPRef p, int l, unsigned char* lds, int wg, int tid) {
    constexpr bool OUT = KIND >= 2, GLA = (KIND & 1) == 0; constexpr int NU = 1024, G = 256;
    int u = wg; if (u >= NU) return;
    LaRegs R; la_load<OUT, GLA>(R, p, u, tid);
    for (;;) {
        const int un = u + G; const bool hn = un < NU;
        LaRegs Rn; if (hn) la_load<OUT, GLA>(Rn, p, un, tid);
        if (KIND == 0) gla_kv_unit(p, l, lds, u, R, tid); else if (KIND == 1) ret_kv_unit(p, lds, u, R, tid); else if (KIND == 2) gla_out_unit(p, l, lds, u, R, tid); else ret_out_unit(p, l, lds, u, R, tid);
        if (!hn) break;
        R = Rn; u = un;
    }
}

__device__ __forceinline__ void scan_phase(KPRef p, int wg, int tid) {
    if (wg < 64) {
        const int bh = wg >> 2, elem = (wg & 3) * 512 + tid, d = elem >> 6;
        float* base = (float*)(p.ws + WS_GKV) + (size_t)bh * 128 * 2048 + elem; const float* dec = (const float*)(p.ws + WS_GDEC) + (size_t)bh * 128 * 32 + d;
        float s = 0.f;
#pragma unroll 1
        for (int n0 = 0; n0 < 128; n0 += 32) { float kv[32], dc[32];
#pragma unroll
            for (int j = 0; j < 32; ++j) { kv[j] = base[(size_t)(n0 + j) * 2048]; dc[j] = dec[(n0 + j) * 32]; }
#pragma unroll
            for (int j = 0; j < 32; ++j) { base[(size_t)(n0 + j) * 2048] = s; s = dc[j] * s + kv[j]; } }
    } else if (wg < 128) {
        const int w2 = wg - 64, bh = w2 >> 2, h = bh & 3, elem = (w2 & 3) * 512 + tid;
        float* base = (float*)(p.ws + WS_RKV) + (size_t)bh * 64 * 2048 + elem; const float dc = __builtin_amdgcn_exp2f(128.0f * p.ret_lg2[h]);
        float s = 0.f;
#pragma unroll 1
        for (int n0 = 0; n0 < 64; n0 += 32) { float kv[32];
#pragma unroll
            for (int j = 0; j < 32; ++j) kv[j] = base[(size_t)(n0 + j) * 2048];
#pragma unroll
            for (int j = 0; j < 32; ++j) { base[(size_t)(n0 + j) * 2048] = s; s = dc * s + kv[j]; } }
    }
}

__device__ __forceinline__ void kmean_unit(KPRef p, float* sm, int unit, int tid) {
    const bf16_t* z = (const bf16_t*)(p.ws + WS_Z); const size_t t0 = (size_t)unit * 256;
    const int oct = tid & 31, grp = tid >> 5; float s[8] = {0.f, 0.f, 0.f, 0.f, 0.f, 0.f, 0.f, 0.f};
    u32x4 q[16];
#pragma unroll
    for (int i = 0; i < 16; ++i) q[i] = *(const u32x4*)(z + (t0 + grp * 16 + i) * ZLD + Z_MK + 8 * oct);
#pragma unroll
    for (int i = 0; i < 16; ++i) { float v[8]; unpack8f(v, q[i]);
#pragma unroll
        for (int e = 0; e < 8; ++e) s[e] += v[e]; }
#pragma unroll
    for (int e = 0; e < 8; ++e) sm[grp * 264 + 8 * oct + e] = s[e];
    __syncthreads();
    if (tid < 256) { float a = 0.f;
#pragma unroll
        for (int g2 = 0; g2 < 16; ++g2) a += sm[g2 * 264 + tid];
        ((float*)(p.ws + WS_KMEAN))[(size_t)unit * 256 + tid] = a * (1.0f / 256.0f); }
    __syncthreads();
}

constexpr int AT_BUF = 65536  , AT_PW = 131072, AT_PW_WAVE = 2304, AT_WSF = 149504, LDS_MTAB = 151552;
__device__ __forceinline__ void att_dma(unsigned char* lds, int buf, const bf16_t* kg, const bf16_t* vg, int key_lo_valid, int tid) {
    const int lane = tid & 63, wave = __builtin_amdgcn_readfirstlane(tid >> 6);
#pragma unroll
    for (int i = 0; i < 4; ++i) { const int j = wave * 4 + i, row = 8 * j + (lane >> 3), pos = lane & 7; const int srow = row < key_lo_valid ? key_lo_valid : row;
        const size_t goff = (size_t)srow * ZLD + 8 * (pos ^ (row & 7));
        __builtin_amdgcn_global_load_lds((const unsigned*)(kg + goff), (LAS unsigned*)(LAS unsigned char*)(lds + buf * AT_BUF + j * 1024), 16, 0, 0);
        __builtin_amdgcn_global_load_lds((const unsigned*)(vg + goff), (LAS unsigned*)(LAS unsigned char*)(lds + buf * AT_BUF + 32768 + j * 1024), 16, 0, 0); }
}
struct QPtrs { const bf16_t* p[2]; int tag[2]; };
template <class Fn>
__device__ __forceinline__ QPtrs att_qptrs(const Fn& F, int tid) {
    const int lane = tid & 63, wave = __builtin_amdgcn_readfirstlane(tid >> 6), c16 = lane & 15; QPtrs q;
#pragma unroll
    for (int rt = 0; rt < 2; ++rt) { q.tag[rt] = F.rowtag(32 * wave + 16 * rt + c16); q.p[rt] = F.rowptr(32 * wave + 16 * rt + c16, q.tag[rt]); }
    return q;
}
__device__ __forceinline__ void att_loadq(bf16x8 (&Q)[2][2], const QPtrs& qp, int tid) {
    const int g = (tid & 63) >> 4;
#pragma unroll
    for (int rt = 0; rt < 2; ++rt) { Q[rt][0] = *(const bf16x8*)(qp.p[rt] + 8 * g); Q[rt][1] = *(const bf16x8*)(qp.p[rt] + 32 + 8 * g); }
}
__device__ __forceinline__ bf16x8 tr_frag_sw(const unsigned char* tile, int rowa, int rowb, int col0, int lane) {
    const int i = lane & 15, q = i >> 2, pp = i & 3, ch = (col0 >> 3) + (pp >> 1), sub = (pp & 1) * 8, ra = rowa + q, rb = rowb + q;
    const v4i16_t lo = lds_tr16((const bf16_t*)(tile + ra * 128 + ((ch ^ (ra & 7)) << 4) + sub)), hi = lds_tr16((const bf16_t*)(tile + rb * 128 + ((ch ^ (rb & 7)) << 4) + sub));
    return (bf16x8){lo[0], lo[1], lo[2], lo[3], hi[0], hi[1], hi[2], hi[3]};
}
__device__ __forceinline__ unsigned cvt_pk_c(float lo, float hi) { return pg8::cvt_pk_bf16(lo, hi); }
__device__ __forceinline__ float max3f_(float a, float b2, float c) { return __builtin_fmaxf(__builtin_fmaxf(a, b2), c); }
template <class Fn>
__device__ __forceinline__ void att_compute(unsigned char* lds, int buf, const Fn& F, bf16x8 (&Q)[2][2], const QPtrs& qcur, const QPtrs& qnext, bool has_next, int tid) {
    const int lane = tid & 63, wave = __builtin_amdgcn_readfirstlane(tid >> 6), c16 = lane & 15, g = lane >> 4;
    const unsigned char* KS = lds + buf * AT_BUF; const unsigned char* VS = KS + 32768; bf16_t* PW = (bf16_t*)(lds + AT_PW + wave * AT_PW_WAVE); float* WSF = (float*)(lds + AT_WSF + wave * 256);
#pragma unroll 1
    for (int rt = 0; rt < 2; ++rt) {
        const int rbase = 32 * wave + 16 * rt;
        const typename Fn::Pre pre = F.prefetch(rbase, lane);
        const bf16x8 qa0 = rt ? Q[1][0] : Q[0][0], qa1 = rt ? Q[1][1] : Q[0][1];
        f32x4 S[16]; float m = -1e30f;
#pragma unroll
        for (int ct = 0; ct < 16; ++ct) {
            if (F.live(rbase, ct)) {
                const int R = 16 * ct + c16; const unsigned char* kp = KS + R * 128;
                const bf16x8 k0 = *(const bf16x8*)(kp + ((g ^ (R & 7)) << 4)), k1 = *(const bf16x8*)(kp + (((4 + g) ^ (R & 7)) << 4));
                f32x4 acc = (f32x4){0.f, 0.f, 0.f, 0.f}; acc = MFMA16(k0, qa0, acc); acc = MFMA16(k1, qa1, acc);
                if (Fn::MASKED) { if (F.partial(rbase, ct)) {
#pragma unroll
                    for (int r = 0; r < 4; ++r) { int kk = 16 * ct + 4 * g + r; asm volatile("" : "+v"(kk), "+v"(acc[r]));
                        acc[r] += F.pen(rbase + c16, kk); } } }
                m = max3f_(m, max3f_(acc[0], acc[1], acc[2]), acc[3]); S[ct] = acc;
            } else S[ct] = (f32x4){-1e30f, -1e30f, -1e30f, -1e30f};
        }
        if (rt == 1 && has_next) att_loadq(Q, qnext, tid);
        m = fmaxf(m, __shfl_xor(m, 16)); m = fmaxf(m, __shfl_xor(m, 32));
        u32x2 Pk[16];
#pragma unroll
        for (int ct = 0; ct < 16; ++ct) {
            if (F.live(rbase, ct)) { const float p0 = __builtin_amdgcn_exp2f(S[ct][0] - m), p1 = __builtin_amdgcn_exp2f(S[ct][1] - m), p2 = __builtin_amdgcn_exp2f(S[ct][2] - m), p3 = __builtin_amdgcn_exp2f(S[ct][3] - m);
                Pk[ct].x = cvt_pk_c(p0, p1); Pk[ct].y = cvt_pk_c(p2, p3);
            } else Pk[ct] = (u32x2){0u, 0u};
        }
        f32x4 O[4], OL = (f32x4){0.f, 0.f, 0.f, 0.f};
        const bf16x8 ones = (bf16x8){0x3F80, 0x3F80, 0x3F80, 0x3F80, 0x3F80, 0x3F80, 0x3F80, 0x3F80};
#pragma unroll
        for (int dt = 0; dt < 4; ++dt) O[dt] = (f32x4){0.f, 0.f, 0.f, 0.f};
#pragma unroll
        for (int s8 = 0; s8 < 8; ++s8) if (F.live(rbase, 2 * s8) || F.live(rbase, 2 * s8 + 1)) { const bf16x8 pa = __builtin_bit_cast(bf16x8, ((u32x4){Pk[2 * s8].x, Pk[2 * s8].y, Pk[2 * s8 + 1].x, Pk[2 * s8 + 1].y}));
            OL = MFMA16(pa, ones, OL);
#pragma unroll
            for (int dt = 0; dt < 4; ++dt) O[dt] = MFMA16(pa, tr_frag_sw(VS, 32 * s8 + 4 * g, 32 * s8 + 16 + 4 * g, 16 * dt, lane), O[dt]); }
        float f[4];
        const int mytag = rt ? qcur.tag[1] : qcur.tag[0];
#pragma unroll
        for (int r = 0; r < 4; ++r) { const float mr = __shfl(m, 4 * g + r); const int tg = __shfl(mytag, 4 * g + r); f[r] = F.scale(rbase + 4 * g + r, mr, OL[r], pre, r, WSF + (4 * g + r) * 4, c16 == 0, tg); }
#pragma unroll
        for (int dt = 0; dt < 4; ++dt)
#pragma unroll
            for (int r = 0; r < 4; ++r) PW[(4 * g + r) * 72 + 16 * dt + c16] = (bf16_t)f2bf(O[dt][r] * f[r]);
        LDS_WAIT();
#pragma unroll
        for (int i = 0; i < 2; ++i) { const int ch = lane + 64 * i, row = ch >> 3, oct = ch & 7;
            const u32x4 v = *(const u32x4*)(PW + row * 72 + 8 * oct); F.store(rbase + row, oct, v, pre, i, WSF + row * 4, __shfl(mytag, row)); }
        LDS_WAIT();
    }
}
template <class Fn, class Gen>
__device__ __forceinline__ void attn_loop(unsigned char* lds, const Gen& G, int tid) {
    Fn Fc, Fx; const bf16_t* kg; const bf16_t* vg; int lo;
    bool have = G.get(0, Fc, kg, vg, lo);
    if (!have) return;
    bf16x8 Q[2][2];
    QPtrs qc = att_qptrs(Fc, tid);
    att_dma(lds, 0, kg, vg, lo, tid); att_loadq(Q, qc, tid);
    int buf = 0;
    for (int i = 1; have; ++i) {
        asm volatile("s_waitcnt vmcnt(0)" ::: "memory");
        __syncthreads();
        const bool hn = G.get(i, Fx, kg, vg, lo);
        QPtrs qn = qc;
        if (hn) { att_dma(lds, buf ^ 1, kg, vg, lo, tid); qn = att_qptrs(Fx, tid); }
        att_compute(lds, buf, Fc, Q, qc, qn, hn, tid);
        Fc = Fx; have = hn; buf ^= 1; qc = qn;
    }
    asm volatile("s_waitcnt vmcnt(0)" ::: "memory");
    __syncthreads();
}
struct NoPre {};

struct SwaFn { typedef NoPre Pre; static constexpr bool MASKED = true;
    __device__ __forceinline__ bool live(int rbase, int ct) const { const int i0 = rbase & 127; return 16 * ct + 15 >= i0 + 1 && 16 * ct <= i0 + 143 && (q0 != 0 || ct >= 8); }
    __device__ __forceinline__ bool partial(int rbase, int ct) const { const int t0_ = (rbase & 127) >> 4; return ct == t0_ || ct == t0_ + 8; }     const bf16_t* z; bf16_t* ob; size_t tb; int q0, kvh; float sink2_0, sink2_1;
    __device__ __forceinline__ int rowtag(int) const { return 0; }
    __device__ __forceinline__ const bf16_t* rowptr(int row, int) const { return z + (tb + q0 + (row & 127)) * ZLD + Z_SQ + (kvh * 2 + (row >> 7)) * 64; }
    __device__ __forceinline__ float pen(int row, int kk) const { const int d = (row & 127) + 128 - kk; return __int_as_float(((d | (127 - d) | (q0 - 128 + kk)) >> 31) & (int)0xF149F2CAu); }
    __device__ __forceinline__ NoPre prefetch(int, int) const { return NoPre{}; }
    __device__ __forceinline__ float scale(int row, float m, float l, const NoPre&, int, float*, bool, int) const { const float sk = (row >> 7) ? sink2_1 : sink2_0; const float M = fmaxf(m, sk), w0 = __builtin_amdgcn_exp2f(m - M);
        return w0 / (l * w0 + __builtin_amdgcn_exp2f(sk - M)); }
    __device__ __forceinline__ void store(int row, int oct, u32x4 v, const NoPre&, int, const float*, int) const { *(u32x4*)(ob + (tb + q0 + (row & 127)) * OLD + 256 + (kvh * 2 + (row >> 7)) * 64 + 8 * oct) = v; }
};
struct SwaGen { const bf16_t* z; bf16_t* ob; const float* sinks; int wg, G;
    __device__ __forceinline__ bool get(int i, SwaFn& F, const bf16_t*& kg, const bf16_t*& vg, int& lo) const {
        const int unit = wg + i * G; if (unit >= 512) return false;
        const int qb = unit & 63, kvh = (unit >> 6) & 1, b = unit >> 7; const size_t tb = (size_t)b * S_; const int q0 = qb * 128;
        F = SwaFn{z, ob, tb, q0, kvh, sinks[kvh * 2] * LOG2E, sinks[kvh * 2 + 1] * LOG2E};
        const long kb = (long)tb + q0 - 128;
        kg = z + kb * ZLD + Z_SK + kvh * 64; vg = z + kb * ZLD + Z_SV + kvh * 64; lo = (q0 == 0) ? 128 : 0; return true; }
};

constexpr int ML_PER_BH = 126976;
__device__ __forceinline__ int ml_off(int j) { return 256 * (31 * j - (j * (j - 1)) / 2); }
__device__ __forceinline__ void moba_select(KPRef p, unsigned char* lds, int wg, int tid) {
    const int gid = wg * NTHREADS + tid, t = gid >> 2, h = gid & 3, b = t >> 13, tl = t & 8191, blk = tl >> 8;
    const bf16_t* z = (const bf16_t*)(p.ws + WS_Z);
    f32x4* kml = (f32x4*)lds; const f32x4* kmg = (const f32x4*)((const float*)(p.ws + WS_KMEAN) + (size_t)b * 32 * 256);
    for (int i = tid; i < blk * 64; i += NTHREADS) kml[i] = kmg[i];
    float q[64];
    { const bf16_t* qp = z + (size_t)t * ZLD + Z_MQ + h * 64;
#pragma unroll
      for (int c = 0; c < 8; ++c) { const u32x4 kk = *(const u32x4*)(qp + 8 * c);
        q[8 * c + 0] = __uint_as_float(kk.x << 16); q[8 * c + 1] = __uint_as_float(kk.x & 0xffff0000u); q[8 * c + 2] = __uint_as_float(kk.y << 16); q[8 * c + 3] = __uint_as_float(kk.y & 0xffff0000u);
        q[8 * c + 4] = __uint_as_float(kk.z << 16); q[8 * c + 5] = __uint_as_float(kk.z & 0xffff0000u); q[8 * c + 6] = __uint_as_float(kk.w << 16); q[8 * c + 7] = __uint_as_float(kk.w & 0xffff0000u); } }
    __syncthreads();
    float v0 = -3e38f, v1 = -3e38f, v2 = -3e38f; int i0 = -1, i1 = -1, i2 = -1;
#pragma unroll 1
    for (int nb = 0; nb < blk; ++nb) { const f32x4* kr = kml + nb * 64 + h * 16; float s = 0.f;
#pragma unroll
        for (int c = 0; c < 16; ++c) { const f32x4 kv = kr[c]; s += q[4 * c] * kv[0] + q[4 * c + 1] * kv[1] + q[4 * c + 2] * kv[2] + q[4 * c + 3] * kv[3]; }
        if (s > v0) { v2 = v1; i2 = i1; v1 = v0; i1 = i0; v0 = s; i0 = nb; } else if (s > v1) { v2 = v1; i2 = i1; v1 = s; i1 = nb; } else if (s > v2) { v2 = s; i2 = nb; } }
    int* cnt = (int*)(p.ws + WS_MCNT) + (b * 4 + h) * 32; int* lst = (int*)(p.ws + WS_MLIST) + (size_t)(b * 4 + h) * ML_PER_BH; f32x2* pml = (f32x2*)(p.ws + WS_PARTML) + (size_t)gid * 3;
#pragma unroll
    for (int s3 = 0; s3 < 3; ++s3) { const int sb = (s3 == 0) ? i0 : (s3 == 1 ? i1 : i2);
        if (sb >= 0) { const int pos = atomicAdd(cnt + sb, 1); lst[ml_off(sb) + pos] = tl | (s3 << 13); }
        else { float ng_ = -1e30f, zr_ = 0.f; asm volatile("" : "+v"(ng_), "+v"(zr_)); pml[s3] = (f32x2){ng_, zr_}; } }
    __syncthreads();
}
struct MobaSelFn { typedef NoPre Pre; static constexpr bool MASKED = false;
    __device__ __forceinline__ bool live(int, int) const { return true; }
    __device__ __forceinline__ bool partial(int, int) const { return false; } const bf16_t* z; const int* lst; bf16_t* po; f32x2* pml; size_t tb; int h, n_valid;
    __device__ __forceinline__ int entry(int row) const { return lst[row < n_valid ? row : 0]; }
    __device__ __forceinline__ int rowtag(int row) const { return entry(row); }
    __device__ __forceinline__ const bf16_t* rowptr(int, int e) const { return z + (tb + (e & 8191)) * ZLD + Z_MQ + h * 64; }
    __device__ __forceinline__ float pen(int, int) const { return 0.f; }
    __device__ __forceinline__ NoPre prefetch(int, int) const { return NoPre{}; }
    __device__ __forceinline__ size_t pidx(int e) const { return ((tb + (e & 8191)) * 4 + h) * 3 + (e >> 13); }
    __device__ __forceinline__ float scale(int row, float m, float l, const NoPre&, int, float*, bool writer, int e) const { if (writer && row < n_valid) pml[pidx(e)] = (f32x2){m, l}; return 1.0f / l; }
    __device__ __forceinline__ void store(int row, int oct, u32x4 v, const NoPre&, int, const float*, int e) const { if (row < n_valid) *(u32x4*)(po + pidx(e) * 64 + 8 * oct) = v; }
};
__device__ __forceinline__ void moba_sel_table(KPRef p, unsigned char* lds, int tid) {
    int* tab = (int*)(lds + LDS_MTAB); const int lane = tid & 63, wave = tid >> 6;
    const int cnt = ((const int*)(p.ws + WS_MCNT))[tid]; int v = (cnt + 255) >> 8;
    const int own = v;
#pragma unroll
    for (int o = 1; o < 64; o <<= 1) { const int t = __shfl_up(v, o); if (lane >= o) v += t; }
    if (lane == 63) tab[520 + wave] = v;
    __syncthreads();
    int base = 0;
    for (int w = 0; w < wave; ++w) base += tab[520 + w];
    tab[tid] = base + v - own;
    tab[544 + tid] = cnt;
    if (tid == 511) tab[512] = base + v;
    __syncthreads();
}
struct MobaSelGen { const bf16_t* z; const int* lists; const int* cnts; bf16_t* po; f32x2* pml; const int* tab; int wg, G;
    __device__ __forceinline__ bool get(int i, MobaSelFn& F, const bf16_t*& kg, const bf16_t*& vg, int& lo) const {
        const int u = wg + i * G; if (u >= tab[512]) return false;
        int lo_ = 0, hi_ = 511;
        while (lo_ < hi_) { const int mid = (lo_ + hi_ + 1) >> 1; if (tab[mid] <= u) lo_ = mid; else hi_ = mid - 1; }
        const int k = __builtin_amdgcn_readfirstlane(lo_), c = u - tab[k], bh = k >> 5, j = k & 31, b = bh >> 2, h = bh & 3;
        const int cnt = tab[544 + k]; const int nv = cnt - c * 256; const size_t tb = (size_t)b * S_;
        F = MobaSelFn{z, lists + (size_t)bh * ML_PER_BH + ml_off(j) + c * 256, po, pml, tb, h, nv < 256 ? nv : 256};
        kg = z + (tb + j * 256) * ZLD + Z_MK + h * 64; vg = z + (tb + j * 256) * ZLD + Z_MV + h * 64; lo = 0; return true; }
};
struct MobaOwnFn { typedef NoPre Pre; static constexpr bool MASKED = true;
    __device__ __forceinline__ bool live(int rbase, int ct) const { return 16 * ct <= rbase + 15; }
    __device__ __forceinline__ bool partial(int rbase, int ct) const { return 16 * ct == rbase; }     const bf16_t* z; bf16_t* ob; const bf16_t* po; const f32x2* pml; size_t t0; int h;
    __device__ __forceinline__ int rowtag(int) const { return 0; }
    __device__ __forceinline__ const bf16_t* rowptr(int row, int) const { return z + (t0 + row) * ZLD + Z_MQ + h * 64; }
    __device__ __forceinline__ float pen(int row, int kk) const { return __int_as_float(((row - kk) >> 31) & (int)0xF149F2CAu); }
    __device__ __forceinline__ NoPre prefetch(int, int) const { return NoPre{}; }
    __device__ __forceinline__ float scale(int row, float m, float l, const NoPre&, int, float* wsf, bool writer, int) const {
        const f32x2* ml = pml + ((t0 + row) * 4 + h) * 3; const f32x2 a = ml[0], b = ml[1], c = ml[2];
        const float M = fmaxf(fmaxf(m, a[0]), fmaxf(b[0], c[0]));
        const float w0 = __builtin_amdgcn_exp2f(m - M), wa = a[1] * __builtin_amdgcn_exp2f(a[0] - M), wb = b[1] * __builtin_amdgcn_exp2f(b[0] - M), wc = c[1] * __builtin_amdgcn_exp2f(c[0] - M);
        const float inv = 1.0f / (l * w0 + wa + wb + wc);
        if (writer) { wsf[0] = wa * inv; wsf[1] = wb * inv; wsf[2] = wc * inv; }
        return w0 * inv; }
    __device__ __forceinline__ void store(int row, int oct, u32x4 v, const NoPre&, int, const float* wsf, int) const {
        float o[8]; unpack8f(o, v); const bf16_t* pr = po + (((t0 + row) * 4 + h) * 3) * 64 + 8 * oct;
        u32x4 pc[3];
#pragma unroll
        for (int s = 0; s < 3; ++s) pc[s] = (wsf[s] != 0.f) ? *(const u32x4*)(pr + s * 64) : (u32x4){0u, 0u, 0u, 0u};
#pragma unroll
        for (int s = 0; s < 3; ++s) { const float w = wsf[s]; float q[8]; unpack8f(q, pc[s]);
#pragma unroll
            for (int e = 0; e < 8; ++e) o[e] += w * q[e]; }
        *(u32x4*)(ob + (t0 + row) * OLD + 512 + h * 64 + 8 * oct) = pack8f(o); }
};
struct MobaOwnGen { const bf16_t* z; bf16_t* ob; const bf16_t* po; const f32x2* pml; int wg, G;
    __device__ __forceinline__ bool get(int i, MobaOwnFn& F, const bf16_t*& kg, const bf16_t*& vg, int& lo) const {
        const int unit = wg + i * G; if (unit >= 512) return false;
        const int qb = unit & 31, h = (unit >> 5) & 3, b = unit >> 7; const size_t t0 = (size_t)b * S_ + (size_t)qb * 256;
        F = MobaOwnFn{z, ob, po, pml, t0, h}; kg = z + t0 * ZLD + Z_MK + h * 64; vg = z + t0 * ZLD + Z_MV + h * 64; lo = 0; return true; }
};

__device__ __forceinline__ void route_phase(KPRef p, int l, float* sm, int wg, int tid) {
    int* se = (int*)sm;
    int* toke = (int*)(p.ws + WS_TOKE); float* tokw = (float*)(p.ws + WS_TOKW); int* tokr = (int*)(p.ws + WS_TOKR); int* hist = (int*)(p.ws + WS_HIST); int* sdst = (int*)(p.ws + WS_SDST);
    if (tid < 128) { const int t = wg * 128 + tid; const float* lg = (const float*)(p.ws + WS_LOGIT) + (size_t)t * 64; const float* bg = p.in[12] + l * 4; const float* be = p.in[14] + l * 32;
        float g0 = lg[0] + bg[0], g1 = lg[1] + bg[1], g2 = lg[2] + bg[2], g3 = lg[3] + bg[3];
        int gs = 0; float gm = g0; if (g1 > gm) { gm = g1; gs = 1; } if (g2 > gm) { gm = g2; gs = 2; } if (g3 > gm) { gm = g3; gs = 3; }
        const float gw_ = 1.0f / (expf(g0 - gm) + expf(g1 - gm) + expf(g2 - gm) + expf(g3 - gm));
        float v0 = -3e38f, v1 = -3e38f; int i0 = 0, i1 = 0;
#pragma unroll
        for (int j = 0; j < 8; ++j) { const float s = lg[4 + 8 * gs + j] + be[8 * gs + j]; if (s > v0) { v1 = v0; i1 = i0; v0 = s; i0 = j; } else if (s > v1) { v1 = s; i1 = j; } }
        const float e1 = expf(v1 - v0), w0 = 1.0f / (1.0f + e1), w1 = e1 * w0;
        const int ea = 8 * gs + i0, eb = 8 * gs + i1;
        se[2 * tid] = ea; se[2 * tid + 1] = eb; toke[2 * t] = ea; toke[2 * t + 1] = eb; tokw[2 * t] = w0 * gw_; tokw[2 * t + 1] = w1 * gw_; }
    __syncthreads();
    if (tid < 256) { const int e = se[tid]; int r = 0;
#pragma unroll 4
        for (int a = 0; a < tid; ++a) r += (se[a] == e) ? 1 : 0; tokr[wg * 256 + tid] = r; }
    if (tid >= 256 && tid < 288) { const int e = tid - 256; int c = 0;
#pragma unroll 4
        for (int a = 0; a < 256; ++a) c += (se[a] == e) ? 1 : 0; hist[wg * 32 + e] = c; }
    for (int i = tid; i < NSLOTBLK; i += NTHREADS) sdst[wg * NSLOTBLK + i] = YS_TRASH_ROW;
    __syncthreads();
}
__device__ __forceinline__ void assign_phase(KPRef p, float* sm, int wg, int tid, int wave, int lane) {
    int* cnt = (int*)sm, *bas = cnt + 32, *pend = cnt + 64, *slot_of = cnt + 128;
    const int* hist = (const int*)(p.ws + WS_HIST); const int* toke = (const int*)(p.ws + WS_TOKE); const int* tokr = (const int*)(p.ws + WS_TOKR);
    int* sdst = (int*)(p.ws + WS_SDST); int* blke = (int*)(p.ws + WS_BLKE);
    {
        int* part = cnt + 512;
        const int e = tid & 31, grp = tid >> 5; int c = 0, bb = 0; int v[16];
#pragma unroll
        for (int i = 0; i < 16; ++i) v[i] = hist[(grp * 16 + i) * 32 + e];
#pragma unroll
        for (int i = 0; i < 16; ++i) { c += v[i]; if (grp * 16 + i < wg) bb += v[i]; }
        part[grp * 64 + e] = c; part[grp * 64 + 32 + e] = bb;
        __syncthreads();
        if (tid < 32) { int cs = 0, bs = 0;
#pragma unroll
            for (int g2 = 0; g2 < 16; ++g2) { cs += part[g2 * 64 + tid]; bs += part[g2 * 64 + 32 + tid]; }
            cnt[tid] = cs; bas[tid] = bs; }
    }
    __syncthreads();
    if (tid == 0) { int run = 0; for (int e = 0; e < 32; ++e) { const int pad = ((cnt[e] + 255) >> 8) << 8; bas[e] += run; run += pad; pend[e] = run; } }
    __syncthreads();
    if (wg == 0) { if (tid < NSLOTBLK) { int e = 0; for (int k = 0; k < 32; ++k) e += (pend[k] <= tid * 256) ? 1 : 0; blke[tid] = e > 31 ? 31 : e; } if (tid == 0) blke[511] = pend[31] >> 8; }
    if (tid < 256) { const int a = wg * 256 + tid; const int e = toke[a]; const int slot = bas[e] + tokr[a]; sdst[slot] = a; slot_of[tid] = slot; }
    __syncthreads();
    const float* su = (const float*)(p.ws + WS_SU); float* xss = (float*)(p.ws + WS_XSS);
    if (tid < 256) xss[slot_of[tid]] = su[wg * 128 + (tid >> 1)];
    __syncthreads();
}

#ifndef MK_PER_PHASE
#define MK_PER_PHASE 0
#endif
constexpr int PH_PER_LAYER = 18, N_PHASES = DEPTH_ * PH_PER_LAYER + 1;
constexpr int CW_BAR = 1024;

__global__ void __launch_bounds__(NTHREADS, 2) mega(Params p_unused) {
    extern __shared__ __attribute__((aligned(16))) unsigned char lds[];
    const int tid0 = threadIdx.x;
    constexpr int G = 256, NGW = G * NWAVES;
    const int wg = blockIdx.x;
#define SUB_BEGIN() KPRef p = *KP(); unsigned char* ws = p.ws; (void)ws; int tid = threadIdx.x; asm volatile("" : "+v"(tid))
#define PHASE_BEGIN() KPRef p = *KP(); unsigned char* ws = p.ws; (void)ws; unsigned char* wl = (l == 0) ? p.ws : (unsigned char*)p.out; (void)wl; const size_t sl = (size_t)l * SW_LSTEP; (void)sl; int tid = threadIdx.x; asm volatile("" : "+v"(tid)); const int lane = tid & 63, wave = __builtin_amdgcn_readfirstlane(tid >> 6), gw = wg * NWAVES + wave; (void)lane; (void)gw
    volatile LAS unsigned* MISC = (volatile LAS unsigned*)((LAS unsigned char*)lds + MISC_OFF);
    for (int u = tid0; u < (LDS_BYTES - LDSCTL_OFF) / 4; u += NTHREADS) ((LAS unsigned*)((LAS unsigned char*)lds + LDSCTL_OFF))[u] = 0u;
    __syncthreads();
#define KP() ({ const __attribute__((address_space(4))) Params* _k = (const __attribute__((address_space(4))) Params*)__builtin_amdgcn_kernarg_segment_ptr(); asm volatile("" : "+s"(_k)); _k; })
    unsigned* ctl; { const __attribute__((address_space(4))) Params* k0 = KP(); ctl = (unsigned*)(k0->ws + WS_CTL); }
    XcdBarrier bar = xcd_barrier_post(ctl + CW_BAR, MISC + 8);
    int lo, hi; { const __attribute__((address_space(4))) Params* k0 = KP(); lo = k0->ph_lo; hi = k0->ph_hi; }
    float* sm = (float*)lds;
    PG8_LAS unsigned char* ring = (PG8_LAS unsigned char*)lds;
#ifndef PH_MASK
#define PH_MASK 0x7ffffu
#endif
#define IN(k) ((((PH_MASK) >> ((k) == DEPTH_ * PH_PER_LAYER ? 18 : ((k) % PH_PER_LAYER))) & 1u) && lo <= (k) && (k) < hi)
#define SEAM(k) do { if ((k) + 1 < hi) xcd_barrier(bar); } while (0)
#ifndef REPEAT_MASK
#define REPEAT_MASK 0u
#endif
#ifndef URM
#define URM 0u
#endif
#define UREP(bit) for (int ur_ = 0; ur_ < ((((URM) >> (bit)) & 1u) ? 2 : 1); ++ur_)
#ifndef REPEAT_L0
#define REPEAT_L0 0u
#endif
#define NREP(k) (((((REPEAT_MASK) >> ((k) % PH_PER_LAYER)) & 1u) || ((((REPEAT_L0) >> ((k) % PH_PER_LAYER)) & 1u) && (k) < PH_PER_LAYER)) ? 2 : 1)

    for (int l = 0; l < DEPTH_; ++l) {
        const int P0 = l * PH_PER_LAYER;
        if (IN(P0 + 0)) for (int rep_ = 0; rep_ < NREP(P0 + 0); ++rep_) { PHASE_BEGIN();
            if (l == 0) { UREP(8) { conv8_phase(p, 0, ws, lds, wg, G, wave, lane, 0, 736); conv_phase(p, 0, ws, lds, gw, NGW, wave, lane); } }
            if (l == 0) norm_phase<0>(p, l, gw, NGW, lane); else norm_phase<1>(p, l, gw, NGW, lane);
            SEAM(P0 + 0);
        }
        if (IN(P0 + 2)) for (int rep_ = 0; rep_ < NREP(P0 + 2); ++rep_) { PHASE_BEGIN();
            pg8::Gemm g{(const bf16_t*)(ws + WS_U8), (const bf16_t*)(wl + WS_WIN)};
            pg8::StaticOrder<T_ / 256, ZW / 256, 1024, 1024> S{G, wg, 0};
            pg8::EpiBf16S E{(bf16_t*)(ws + WS_Z), ZLD, (const float*)(ws + WS_SU), (const float*)(ws + WS_SWIN + sl)};
            pg8::gemm_phase<1024, 1024, 1024, true, true>(ring, g, S, E);
            SEAM(P0 + 2);
        }
        if (IN(P0 + 3)) for (int rep_ = 0; rep_ < NREP(P0 + 3); ++rep_) { PHASE_BEGIN();
            if (wg == 0) { int* cnt = (int*)(ws + WS_MCNT); cnt[tid] = 0; }
            UREP(0) { SUB_BEGIN(); la_loop<0>(p, l, lds, wg, tid); }
            UREP(1) { SUB_BEGIN(); la_loop<1>(p, l, lds, wg, tid); }
            UREP(2) { SUB_BEGIN(); for (int u = wg; u < 128; u += G) kmean_unit(p, sm, u, tid); }
            UREP(3) { SUB_BEGIN(); SwaGen SG{(const bf16_t*)(ws + WS_Z), (bf16_t*)(ws + WS_O), p.in[6] + l * 4, wg, G}; attn_loop<SwaFn>(lds, SG, tid); }
            SEAM(P0 + 3);
        }
        if (IN(P0 + 4)) for (int rep_ = 0; rep_ < NREP(P0 + 4); ++rep_) { PHASE_BEGIN(); moba_select(p, lds, wg, tid); { const int s = ((wg & 63) < 32) ? (wg >> 6) * 32 + (wg & 31) : 255; scan_phase(p, s, tid); }   SEAM(P0 + 4); }
        if (IN(P0 + 5)) for (int rep_ = 0; rep_ < NREP(P0 + 5); ++rep_) { PHASE_BEGIN();
            UREP(4) { SUB_BEGIN(); la_loop<2>(p, l, lds, wg, tid); }
            UREP(5) { SUB_BEGIN(); la_loop<3>(p, l, lds, wg, tid); }
            UREP(6) { SUB_BEGIN(); moba_sel_table(p, lds, tid); MobaSelGen MG{(const bf16_t*)(ws + WS_Z), (const int*)(ws + WS_MLIST), (const int*)(ws + WS_MCNT), (bf16_t*)(ws + WS_PARTO), (f32x2*)(ws + WS_PARTML), (const int*)(lds + LDS_MTAB), wg, G}; attn_loop<MobaSelFn>(lds, MG, tid); }
            SEAM(P0 + 5);
        }
        if (IN(P0 + 6)) for (int rep_ = 0; rep_ < NREP(P0 + 6); ++rep_) { PHASE_BEGIN();
            UREP(7) { SUB_BEGIN(); MobaOwnGen OG{(const bf16_t*)(ws + WS_Z), (bf16_t*)(ws + WS_O), (const bf16_t*)(ws + WS_PARTO), (const f32x2*)(ws + WS_PARTML), wg, G}; attn_loop<MobaOwnFn>(lds, OG, tid); }
            SEAM(P0 + 6);
        }
        for (int hf = 0; hf < 2; ++hf) {
            if (IN(P0 + 7 + 2 * hf)) for (int rep_ = 0; rep_ < NREP(P0 + 7 + 2 * hf); ++rep_) { PHASE_BEGIN();
                pg8::Gemm g{(const bf16_t*)(ws + WS_O), (const bf16_t*)(wl + WS_WB)};
                pg8::StaticOrder<T_ / 512, 16, 2 * OLD, 512, 2, 512> S{G, wg, 64 * hf};
                pg8::EpiBf16 E{(bf16_t*)(ws + WS_YH), pg8::YLD, 16384 * hf};
                pg8::gemm_phase<2 * OLD, 512, 512, false, true>(ring, g, S, E);
                SEAM(P0 + 7 + 2 * hf);
            }
            if (IN(P0 + 8 + 2 * hf)) for (int rep_ = 0; rep_ < NREP(P0 + 8 + 2 * hf); ++rep_) { PHASE_BEGIN();
                pg8::Gemm g{(const bf16_t*)(ws + WS_U8), (const bf16_t*)(wl + WS_WG)};
                pg8::StaticOrder<T_ / 512, 16, 1024, 1024> S{G, wg, 64 * hf};
                pg8::EpiGate E{(const bf16_t*)(ws + WS_YH), 16384 * hf, (bf16_t*)(ws + WS_O), (const float*)(ws + WS_SU), (const float*)(ws + WS_SWG + sl)};
                pg8::gemm_phase<1024, 1024, 1024, true, true>(ring, g, S, E);
                SEAM(P0 + 8 + 2 * hf);
            }
        }
        if (IN(P0 + 11)) for (int rep_ = 0; rep_ < NREP(P0 + 11); ++rep_) { PHASE_BEGIN();
            pg8::Gemm g{(const bf16_t*)(ws + WS_O), (const bf16_t*)(wl + WS_WO)};
            pg8::StaticOrder<T_ / 256, 4, 2 * OLD, 2048> S{G, wg, 0};
            if (l == 0) { pg8::EpiRes<true> E{(const void*)p.in[0], hbf_ptr(p)}; pg8::gemm_phase<2 * OLD, 2048, 2048, false, true>(ring, g, S, E); }
            else { pg8::EpiRes<false> E{(const void*)hbf_ptr(p), hbf_ptr(p)}; pg8::gemm_phase<2 * OLD, 2048, 2048, false, true>(ring, g, S, E); }
            SEAM(P0 + 11);
        }
        if (IN(P0 + 12)) for (int rep_ = 0; rep_ < NREP(P0 + 12); ++rep_) { PHASE_BEGIN(); norm_phase<2>(p, l, gw, NGW, lane); SEAM(P0 + 12); }
        if (IN(P0 + 13)) for (int rep_ = 0; rep_ < NREP(P0 + 13); ++rep_) { PHASE_BEGIN();
            pg8::Gemm g{(const bf16_t*)hbf_ptr(p), (const bf16_t*)(wl + WS_WR)};
            pg8::StaticOrder<T_ / 256, 1, 2048, 2048> S{G, wg, 0};
            pg8::EpiRouter E{(float*)(ws + WS_LOGIT), (const float*)(ws + WS_RSTD)};
            pg8::gemm_phase<2048, 2048, 2048, false>(ring, g, S, E);
            if (l == 0 && wg >= 128) { const int gw2 = (wg - 128) * NWAVES + wave; unsigned char* w1 = (unsigned char*)p.out;
                conv_phase(p, 1, w1, lds, gw2, 128 * NWAVES, wave, lane); }
            SEAM(P0 + 13);
        }
        if (IN(P0 + 14)) for (int rep_ = 0; rep_ < NREP(P0 + 14); ++rep_) { PHASE_BEGIN(); route_phase(p, l, sm, wg, tid); SEAM(P0 + 14); }
        if (IN(P0 + 15)) for (int rep_ = 0; rep_ < NREP(P0 + 15); ++rep_) { PHASE_BEGIN(); assign_phase(p, sm, wg, tid, wave, lane); SEAM(P0 + 15); }
        if (IN(P0 + 16)) for (int rep_ = 0; rep_ < NREP(P0 + 16); ++rep_) { PHASE_BEGIN();
            const int* blke = (const int*)(ws + WS_BLKE); const int nb = __builtin_amdgcn_readfirstlane(blke[511]);
            pg8::Gemm g{(const bf16_t*)(ws + WS_U8), (const bf16_t*)(wl + WS_E1)};
            pg8::MoeOrder<2, true> S{blke, nb, G, wg, (size_t)0, (size_t)256 * 1024, (size_t)512 * 1024, (const int*)(ws + WS_SDST)};
            pg8::EpiE1 E{(bf16_t*)(ws + WS_HDN), (const float*)(ws + WS_XSS), (const float*)(ws + WS_SWE1 + sl), blke};
            pg8::gemm_phase<1024, 1024, 1024, true, true>(ring, g, S, E);
            if (l == 0) {
                const int tot = nb * 2, numax = (tot + G - 1) / G; int th = tot - G * (numax - 1); if (th > 192) th = 0;
                if (wg >= th) conv8_phase(p, 1, (unsigned char*)p.out, lds, wg - th, G - th, wave, lane, 0, 736); }
            SEAM(P0 + 16);
        }
        if (IN(P0 + 17)) for (int rep_ = 0; rep_ < NREP(P0 + 17); ++rep_) { PHASE_BEGIN();
            const int* blke = (const int*)(ws + WS_BLKE); const int nb = __builtin_amdgcn_readfirstlane(blke[511]);
            pg8::Gemm g{(const bf16_t*)(ws + WS_HDN), (const bf16_t*)(wl + WS_E2)};
            pg8::MoeOrder<4> S{blke, nb, G, wg, (size_t)256 * 256 * 2, (size_t)256 * 256 * 2, (size_t)1024 * 256 * 2, nullptr};
            pg8::EpiE2 E{(bf16_t*)(ws + WS_YS), (const int*)(ws + WS_SDST)};
            pg8::gemm_phase<512, 512, 512, false, true>(ring, g, S, E);
            SEAM(P0 + 17);
        }
    }
    if (IN(DEPTH_ * PH_PER_LAYER)) { constexpr int l = 0; PHASE_BEGIN(); FinalHold Hd; final_a(p, gw, NGW, lane, Hd); xcd_barrier(bar); final_b(p, gw, lane, Hd); }
#undef IN
#undef SEAM
}

extern "C" void kernel_launch(void* const* d_in, const int* in_sizes, int n_in, void* d_out, int out_size, void* d_ws, size_t ws_size, hipStream_t stream) {
    static int grid = 0;
    if (grid == 0) {
        if (n_in != 19 || out_size != T_ * D_ || ws_size < WS_END) { fprintf(stderr, "kernel_launch: unexpected shapes (n_in %d, out %d, ws %zu); nothing launched\n", n_in, out_size, ws_size); grid = -1; return; }
        int dev = 0, cus = 0;
        if (hipGetDevice(&dev) != hipSuccess || hipDeviceGetAttribute(&cus, hipDeviceAttributeMultiprocessorCount, dev) != hipSuccess) { grid = -1; return; }
        if (hipFuncSetAttribute((const void*)mega, hipFuncAttributeMaxDynamicSharedMemorySize, LDS_BYTES) != hipSuccess) { fprintf(stderr, "kernel_launch: hipFuncSetAttribute failed\n"); grid = -1; return; }
        int per_cu = 0;
        if (hipOccupancyMaxActiveBlocksPerMultiprocessor(&per_cu, (const void*)mega, NTHREADS, LDS_BYTES) != hipSuccess || per_cu < 1) { fprintf(stderr, "kernel_launch: occupancy query reports %d blocks per CU\n", per_cu); }
        (void)hipGetLastError();
        if (cus != 256) { fprintf(stderr, "kernel_launch: built for a 256-CU device (got %d); nothing launched\n", cus); grid = -1; return; }
        grid = cus;
    }
    if (grid <= 0) return;
    Params p{};
    for (int i = 0; i < 19; ++i) p.in[i] = (const float*)d_in[i];
    p.out = (float*)d_out; p.ws = (unsigned char*)d_ws;
    for (int f = 0; f < 16; ++f) p.inv_freq[f] = (float)std::pow(10000.0, -(double)f / 16.0);
    for (int h = 0; h < 4; ++h) p.ret_lg2[h] = (float)std::log2(1.0 - std::exp2(-5.0 - (double)h));
    hipMemsetAsync((unsigned char*)d_ws + WS_CTL, 0, CTL_BYTES, stream);
#if MK_PER_PHASE
    for (int ph = 0; ph < N_PHASES; ++ph) { p.ph_lo = ph; p.ph_hi = ph + 1; hipLaunchKernelGGL(mega, dim3(grid), dim3(NTHREADS), LDS_BYTES, stream, p); }
#else
    p.ph_lo = 0; p.ph_hi = N_PHASES;
    hipLaunchKernelGGL(mega, dim3(grid), dim3(NTHREADS), LDS_BYTES, stream, p);
#endif
}
```

```cpp
#include <hip/hip_runtime.h>
#include <cstdio>
#include <cstdint>
#include <cmath>

#define LAS __attribute__((address_space(3)))
#define GAS __attribute__((address_space(1)))
typedef unsigned short bf16_t;
typedef short bf16x8 __attribute__((ext_vector_type(8)));
typedef float f32x4 __attribute__((ext_vector_type(4)));
typedef float f32x2 __attribute__((ext_vector_type(2)));
typedef unsigned u32x4 __attribute__((ext_vector_type(4)));
typedef unsigned u32x2 __attribute__((ext_vector_type(2)));
typedef int i32x4 __attribute__((ext_vector_type(4)));
__device__ __forceinline__ f32x4 tof(const f32x4& v) { return v; }
__device__ __forceinline__ f32x4 tof(const i32x4& v) { return __builtin_convertvector(v, f32x4); }

constexpr int T_ = 32768, D_ = 1024, S_ = 8192, NBATCH = 4, DEPTH_ = 2;
constexpr int ZW = 3072;
constexpr int OLD = 1024 + 64;
constexpr int ZLD = ZW + 64;
constexpr int Z_GQ = 0, Z_GK = 128, Z_GV = 256, Z_GR = 512, Z_GA = 768, Z_SQ = 784, Z_SK = 1040, Z_SV = 1168, Z_MQ = 1296, Z_MK = 1552, Z_MV = 1808,
              Z_RQ = 2064, Z_RK = 2192, Z_RV = 2320, Z_RG = 2576, Z_GATE = 2832, IN_W = 6928;
constexpr float LOG2E = 1.4426950408889634f;
constexpr float C2 = 0.125f * 1.4426950408889634f;
constexpr float RSQ32 = 0.17677669529663687f;
constexpr float NORM_EPS = 1e-6f;
constexpr int NEXP = 32, EHID = 256, MOE_BLK = 256, NSLOTBLK = 288, NSLOT = NSLOTBLK * MOE_BLK;

constexpr size_t MiB = 1u << 20;
constexpr size_t WS_WIN = 0, WS_WG = 3 * MiB, WS_WB = 7 * MiB, WS_WO = 9 * MiB, WS_WR = 11 * MiB, WS_E1 = 12 * MiB, WS_E2 = 28 * MiB;
constexpr size_t WS_YS = 68 * MiB;
constexpr size_t WS_GKV = 68 * MiB, WS_RKV = 84 * MiB, WS_GDEC = 92 * MiB, WS_KMEAN = 93 * MiB, WS_O = 108 * MiB;
constexpr size_t WS_U8 = 197 * MiB;
constexpr size_t WS_SU = 229 * MiB, WS_RSTD = WS_SU + 128 * 1024  , WS_XSS = WS_SU + 256 * 1024;
constexpr size_t WS_SWIN = 230 * MiB, WS_SWG = WS_SWIN + 16 * 1024, WS_SWE1 = WS_SWG + 16 * 1024;
constexpr size_t WS_Z = 261 * MiB;
constexpr size_t WS_YH = 261 * MiB;
constexpr size_t WS_U2BF = 261 * MiB;
constexpr size_t WS_XS = 325 * MiB, WS_HDN = 397 * MiB;
constexpr size_t WS_LOGIT = 453 * MiB;
constexpr size_t WS_TOKE = 461 * MiB, WS_TOKW = WS_TOKE + 256 * 1024, WS_TOKR = WS_TOKW + 256 * 1024, WS_HIST = WS_TOKR + 256 * 1024,
                 WS_SDST = WS_HIST + 64 * 1024, WS_BLKE = WS_SDST + 512 * 1024;
constexpr size_t WS_MLIST = 94 * MiB, WS_MCNT = 102 * MiB;
constexpr size_t WS_PARTO = 457 * MiB, WS_PARTML = 505 * MiB;
constexpr size_t WS_CTL = 511 * MiB, CTL_BYTES = 256 * 1024;
constexpr size_t WS_SWRAW = WS_CTL + 64 * 1024, SWRAW_LSTEP = 96 * 1024;
constexpr size_t SW_LSTEP = 128 * 1024;
constexpr size_t WS_END = 512 * MiB;
constexpr int YS_TRASH_ROW = 2 * T_;

__device__ __forceinline__ float bf2f(bf16_t v) { return __uint_as_float(((unsigned)v) << 16); }
__device__ __forceinline__ unsigned f2bf(float f) { unsigned u = __float_as_uint(f); return (u + 0x7fffu + ((u >> 16) & 1u)) >> 16; }
__device__ __forceinline__ unsigned pk2(float lo, float hi) { return f2bf(lo) | (f2bf(hi) << 16); }
__device__ __forceinline__ float sigmoidf_(float x) { return __builtin_amdgcn_rcpf(1.0f + __builtin_amdgcn_exp2f(-x * LOG2E)); }

namespace pg8 {
#define PG8_LAS __attribute__((address_space(3)))
constexpr int BM = 256, BK = 64, HALF = 128, HTB = HALF * BK * 2  , STAGE_BYTES = 8 * HTB, NXCD = 8, WGM = 8;

__host__ __device__ __forceinline__ int lds_byte(int r, int c) { const int st = (r >> 4) * 2 + (c >> 5), rr = r & 15, cc = c & 31, ob = rr * 64 + cc * 2; return st * 1024 + (ob ^ (((ob >> 9) & 1) << 5)); }
__host__ __device__ __forceinline__ void stage_rc(int b, int& R, int& C) { const int st = b / 1024, sb = b % 1024, swz = sb ^ (((sb >> 9) & 1) << 5); R = (st >> 1) * 16 + swz / 64; C = (st & 1) * 32 + (swz % 64) / 2; }
__host__ __device__ __forceinline__ int perm32(int rho) { const int n = rho >> 4, i = rho & 15; return 8 * (i >> 2) + 4 * n + (i & 3); }

struct Unit { int pm, pn; size_t aoff, boff; };
struct Gemm { const bf16_t* A; const bf16_t* Bt; };

template <int NM, int NN, int LDAB  , int LDBB, int A_SHIFT = 30, int A_MUL = 0> struct StaticOrder {
    static constexpr bool GATHER = false;
    int G, c, pm_base;
    __device__ bool next(int i, Unit& u) const {
        constexpr int nwg = NM * NN; const int L = i * G + c; if (L >= nwg) return false;
        int wgid = L; { constexpr int q = nwg / NXCD, r = nwg % NXCD; const int xcd = wgid % NXCD, off = wgid / NXCD; wgid = (xcd < r ? xcd * (q + 1) : r * (q + 1) + (xcd - r) * q) + off; }
        static_assert(NM % WGM == 0, "row-tile count must be a multiple of the 8-row group"); constexpr int nig = WGM * NN, gsz = WGM; const int gid = wgid / nig, fm = gid * WGM;
        u.pm = pm_base + fm + ((wgid % nig) % gsz); u.pn = (wgid % nig) / gsz;
        u.aoff = (size_t)u.pm * ((size_t)BM * LDAB) + (size_t)(u.pn >> A_SHIFT) * A_MUL; u.boff = (size_t)u.pn * ((size_t)BM * LDBB); return true;
    }
};
template <int NCOL, bool GATHER_ = false> struct MoeOrder {
    static constexpr bool GATHER = GATHER_;
    const int* blk_e; int nb, G, c; size_t a_tstep, b_tstep, b_estep; const int* rowmap;
    __device__ bool next(int i, Unit& u) const {
        const int L = i * G + c; if (L >= nb * NCOL) return false;
        const int rb = L / NCOL, pn = L % NCOL; const int e = __builtin_amdgcn_readfirstlane(blk_e[rb]);
        u.pm = rb; u.pn = pn; u.aoff = (size_t)rb * a_tstep; u.boff = (size_t)e * b_estep + (size_t)pn * b_tstep; return true;
    }
};

typedef __bf16 bf16x2c_t __attribute__((ext_vector_type(2)));
__device__ __forceinline__ unsigned cvt_pk_bf16(float lo, float hi) { const f32x2 v = {lo, hi}; const bf16x2c_t q = __builtin_convertvector(v, bf16x2c_t); return __builtin_bit_cast(unsigned, q); }

struct EpiBf16 {
    static constexpr bool PERM = true;
    bf16_t* O; int ldc; int row_sub;
    template <class AT> __device__ __forceinline__ void operator()(const AT (&acc)[2][2][4][2], const Unit& u, int wr, int wc, int fr, int fq) const {
        const int row0 = u.pm * BM + wr * 64 + fr - row_sub; const int col0 = u.pn * BM + wc * 32 + 8 * fq;
#pragma unroll
        for (int ai = 0; ai < 2; ++ai)
#pragma unroll
            for (int m = 0; m < 4; ++m) { bf16_t* rowp = O + (size_t)(row0 + ai * HALF + m * 16) * ldc + col0;
#pragma unroll
                for (int bj = 0; bj < 2; ++bj) { const f32x4 v0 = tof(acc[ai][bj][m][0]), v1 = tof(acc[ai][bj][m][1]);
                    u32x4 w; w.x = cvt_pk_bf16(v0[0], v0[1]); w.y = cvt_pk_bf16(v0[2], v0[3]); w.z = cvt_pk_bf16(v1[0], v1[1]); w.w = cvt_pk_bf16(v1[2], v1[3]);
                    *(u32x4*)(rowp + bj * HALF) = w; } }
    }
};
struct EpiBf16S {
    static constexpr bool PERM = true;
    bf16_t* O; int ldc; const float* srow; const float* scol;
    template <class AT> __device__ __forceinline__ void operator()(const AT (&acc)[2][2][4][2], const Unit& u, int wr, int wc, int fr, int fq) const {
        const int row0 = u.pm * BM + wr * 64 + fr; const int col0 = u.pn * BM + wc * 32 + 8 * fq;
        f32x4 sc[2][2];
#pragma unroll
        for (int bj = 0; bj < 2; ++bj)
#pragma unroll
            for (int n = 0; n < 2; ++n) sc[bj][n] = *(const f32x4*)(scol + col0 + bj * HALF + 4 * n);
        float srv[2][4];
#pragma unroll
        for (int ai = 0; ai < 2; ++ai)
#pragma unroll
            for (int m = 0; m < 4; ++m) srv[ai][m] = srow[row0 + ai * HALF + m * 16];
#pragma unroll
        for (int ai = 0; ai < 2; ++ai)
#pragma unroll
            for (int m = 0; m < 4; ++m) { const int r = row0 + ai * HALF + m * 16; const float sr = srv[ai][m]; bf16_t* rowp = O + (size_t)r * ldc + col0;
#pragma unroll
                for (int bj = 0; bj < 2; ++bj) { const f32x4 v0 = tof(acc[ai][bj][m][0]) * sc[bj][0] * sr, v1 = tof(acc[ai][bj][m][1]) * sc[bj][1] * sr;
                    u32x4 w; w.x = cvt_pk_bf16(v0[0], v0[1]); w.y = cvt_pk_bf16(v0[2], v0[3]); w.z = cvt_pk_bf16(v1[0], v1[1]); w.w = cvt_pk_bf16(v1[2], v1[3]);
                    *(u32x4*)(rowp + bj * HALF) = w; } }
    }
};
template <bool BASE_F32> struct EpiRes {
    static constexpr bool PERM = true;
    const void* base; bf16_t* H;
    template <class AT> __device__ __forceinline__ void operator()(const AT (&acc)[2][2][4][2], const Unit& u, int wr, int wc, int fr, int fq) const {
        const int row0 = u.pm * BM + wr * 64 + fr, col0 = u.pn * BM + wc * 32 + 8 * fq;
#pragma unroll
        for (int ai = 0; ai < 2; ++ai) {
            f32x4 b[4][2][2];
#pragma unroll
            for (int m = 0; m < 4; ++m) { const size_t off = (size_t)(row0 + ai * HALF + m * 16) * 1024 + col0;
#pragma unroll
                for (int bj = 0; bj < 2; ++bj) {
                    if (BASE_F32) { b[m][bj][0] = *(const f32x4*)((const float*)base + off + bj * HALF); b[m][bj][1] = *(const f32x4*)((const float*)base + off + bj * HALF + 4); }
                    else { const u32x4 q = *(const u32x4*)((const bf16_t*)base + off + bj * HALF);
                        b[m][bj][0] = (f32x4){__uint_as_float(q.x << 16), __uint_as_float(q.x & 0xffff0000u), __uint_as_float(q.y << 16), __uint_as_float(q.y & 0xffff0000u)};
                        b[m][bj][1] = (f32x4){__uint_as_float(q.z << 16), __uint_as_float(q.z & 0xffff0000u), __uint_as_float(q.w << 16), __uint_as_float(q.w & 0xffff0000u)}; } } }
#pragma unroll
            for (int m = 0; m < 4; ++m) { const size_t off = (size_t)(row0 + ai * HALF + m * 16) * 1024 + col0;
#pragma unroll
                for (int bj = 0; bj < 2; ++bj) { const f32x4 v0 = b[m][bj][0] + tof(acc[ai][bj][m][0]), v1 = b[m][bj][1] + tof(acc[ai][bj][m][1]);
                    u32x4 w; w.x = cvt_pk_bf16(v0[0], v0[1]); w.y = cvt_pk_bf16(v0[2], v0[3]); w.z = cvt_pk_bf16(v1[0], v1[1]); w.w = cvt_pk_bf16(v1[2], v1[3]);
                    *(u32x4*)(H + off + bj * HALF) = w; } }
            asm volatile("" ::: "memory"); }
    }
};
struct EpiRouter {
    static constexpr bool PERM = false; static constexpr bool NARROW = true;
    float* L; const float* rstd;
    template <class AT> __device__ __forceinline__ void operator()(const AT (&acc)[2][2][4][2], const Unit& u, int wr, int wc, int fr, int fq) const {
        if (wc >= 2) return;
        const int row0 = u.pm * BM + wr * 64 + fr, col0 = wc * 32 + 4 * fq;
        float rs[2][4];
#pragma unroll
        for (int ai = 0; ai < 2; ++ai)
#pragma unroll
            for (int m = 0; m < 4; ++m) rs[ai][m] = rstd[row0 + ai * HALF + m * 16];
#pragma unroll
        for (int ai = 0; ai < 2; ++ai)
#pragma unroll
            for (int m = 0; m < 4; ++m) { float* rowp = L + (size_t)(row0 + ai * HALF + m * 16) * 64 + col0;
#pragma unroll
                for (int n = 0; n < 2; ++n) *(f32x4*)(rowp + n * 16) = tof(acc[ai][0][m][n]) * rs[ai][m]; }
    }
};
constexpr int YLD = 4096 + 64;
struct EpiGate {
    static constexpr bool PERM = false;
    const bf16_t* Y; int y_row_sub; bf16_t* Mg; const float* srow; const float* scol;
    __device__ __forceinline__ static u32x2 ld2(const void* p) { u32x2 v; asm volatile("global_load_dwordx2 %0, %1, off" : "=v"(v) : "v"(p) : "memory"); return v; }
    __device__ __forceinline__ static f32x4 ld4(const void* p) { f32x4 v; asm volatile("global_load_dwordx4 %0, %1, off" : "=v"(v) : "v"(p) : "memory"); return v; }
    __device__ __forceinline__ static float ld1(const void* p) { float v; asm volatile("global_load_dword %0, %1, off" : "=v"(v) : "v"(p) : "memory"); return v; }
    __device__ __forceinline__ static void st2(void* p, u32x2 v) { asm volatile("global_store_dwordx2 %0, %1, off" :: "v"(p), "v"(v) : "memory"); }
    template <class AT> __device__ __forceinline__ void operator()(const AT (&acc)[2][2][4][2], const Unit& u, int wr, int wc, int fr, int fq) const {
        const int row0 = u.pm * BM + wr * 64 + fr, d0 = u.pn * 64 + wc * 16 + fq * 4;
        f32x4 sc[4]; float srv[8]; u32x2 yv[6][4];
#pragma unroll
        for (int i = 0; i < 4; ++i) sc[i] = ld4(scol + u.pn * BM + (i >> 1) * HALF + wc * 32 + (i & 1) * 16 + 4 * fq);
#pragma unroll
        for (int r = 0; r < 8; ++r) srv[r] = ld1(srow + row0 + (r >> 2) * HALF + (r & 3) * 16);
#define EG_YROW(r) (Y + (size_t)(row0 + ((r) >> 2) * HALF + ((r) & 3) * 16 - y_row_sub) * YLD + d0)
#define EG_LOAD(dst, r) do { const bf16_t* yrow = EG_YROW(r); _Pragma("unroll") for (int i = 0; i < 4; ++i) dst[i] = ld2(yrow + 1024 * i); } while (0)
#define EG_WAITY(n, y) asm volatile("s_waitcnt vmcnt(" #n ")" : "+v"(y[0]), "+v"(y[1]), "+v"(y[2]), "+v"(y[3]) :: "memory")
#define EG_WORK(src, r) do { const int ai = (r) >> 2, m = (r) & 3; const float sr = srv[r]; f32x4 s = (f32x4){0.f, 0.f, 0.f, 0.f}; \
            _Pragma("unroll") for (int i = 0; i < 4; ++i) { const f32x4 g = tof(acc[ai][i >> 1][m][i & 1]) * sc[i] * sr; \
                s[0] += __builtin_amdgcn_rcpf(1.0f + __builtin_amdgcn_exp2f(g[0])) * __uint_as_float(src[i].x << 16); s[1] += __builtin_amdgcn_rcpf(1.0f + __builtin_amdgcn_exp2f(g[1])) * __uint_as_float(src[i].x & 0xffff0000u); \
                s[2] += __builtin_amdgcn_rcpf(1.0f + __builtin_amdgcn_exp2f(g[2])) * __uint_as_float(src[i].y << 16); s[3] += __builtin_amdgcn_rcpf(1.0f + __builtin_amdgcn_exp2f(g[3])) * __uint_as_float(src[i].y & 0xffff0000u); } \
            u32x2 w; w.x = cvt_pk_bf16(s[0], s[1]); w.y = cvt_pk_bf16(s[2], s[3]); st2(Mg + (size_t)(row0 + ai * HALF + m * 16) * OLD + d0, w); } while (0)
        EG_LOAD(yv[0], 0); EG_LOAD(yv[1], 1); EG_LOAD(yv[2], 2); EG_LOAD(yv[3], 3); EG_LOAD(yv[4], 4); EG_LOAD(yv[5], 5);
        asm volatile("s_waitcnt vmcnt(20)" : "+v"(sc[0]), "+v"(sc[1]), "+v"(sc[2]), "+v"(sc[3]), "+v"(srv[0]), "+v"(srv[1]), "+v"(srv[2]), "+v"(srv[3]), "+v"(srv[4]), "+v"(srv[5]), "+v"(srv[6]), "+v"(srv[7]),
                     "+v"(yv[0][0]), "+v"(yv[0][1]), "+v"(yv[0][2]), "+v"(yv[0][3]) :: "memory");
#pragma unroll
        for (int i = 0; i < 4; ++i) sc[i] *= -LOG2E;
        EG_WORK(yv[0], 0); EG_LOAD(yv[0], 6);
        EG_WAITY(21, yv[1]); EG_WORK(yv[1], 1); EG_LOAD(yv[1], 7);
        EG_WAITY(22, yv[2]); EG_WORK(yv[2], 2);
        EG_WAITY(19, yv[3]); EG_WORK(yv[3], 3);
        EG_WAITY(16, yv[4]); EG_WORK(yv[4], 4);
        EG_WAITY(13, yv[5]); EG_WORK(yv[5], 5);
        EG_WAITY(9, yv[0]); EG_WORK(yv[0], 6);
        EG_WAITY(5, yv[1]); EG_WORK(yv[1], 7);
#undef EG_YROW
#undef EG_LOAD
#undef EG_WAITY
#undef EG_WORK
    }
};
struct EpiE1 {
    static constexpr bool PERM = true;
    bf16_t* H; const float* srow; const float* scol_all; const int* blk_e;
    template <class AT> __device__ __forceinline__ void operator()(const AT (&acc)[2][2][4][2], const Unit& u, int wr, int wc, int fr, int fq) const {
        const int row0 = u.pm * BM + wr * 64 + fr, col0 = u.pn * 128 + wc * 32 + 8 * fq;
        const float* scol = scol_all + (size_t)__builtin_amdgcn_readfirstlane(blk_e[u.pm]) * 512 + u.pn * BM + wc * 32 + 8 * fq;
        const f32x4 s10 = *(const f32x4*)scol, s11 = *(const f32x4*)(scol + 4), s30 = *(const f32x4*)(scol + HALF), s31 = *(const f32x4*)(scol + HALF + 4);
        float srv[2][4];
#pragma unroll
        for (int ai = 0; ai < 2; ++ai)
#pragma unroll
            for (int m = 0; m < 4; ++m) srv[ai][m] = srow[row0 + ai * HALF + m * 16];
#pragma unroll
        for (int ai = 0; ai < 2; ++ai)
#pragma unroll
            for (int m = 0; m < 4; ++m) { const int r = row0 + ai * HALF + m * 16; const float sr = srv[ai][m]; bf16_t* rowp = H + (size_t)r * EHID + col0;
                const f32x4 a0 = tof(acc[ai][0][m][0]) * s10 * sr, a1 = tof(acc[ai][0][m][1]) * s11 * sr, b0 = tof(acc[ai][1][m][0]) * s30 * sr, b1 = tof(acc[ai][1][m][1]) * s31 * sr;
                f32x4 v0, v1;
#pragma unroll
                for (int j = 0; j < 4; ++j) { v0[j] = a0[j] * sigmoidf_(a0[j]) * b0[j]; v1[j] = a1[j] * sigmoidf_(a1[j]) * b1[j]; }
                u32x4 w; w.x = cvt_pk_bf16(v0[0], v0[1]); w.y = cvt_pk_bf16(v0[2], v0[3]); w.z = cvt_pk_bf16(v1[0], v1[1]); w.w = cvt_pk_bf16(v1[2], v1[3]);
                *(u32x4*)rowp = w; }
    }
};
struct EpiE2 {
    static constexpr bool PERM = true;
    bf16_t* YS; const int* sdst;
    template <class AT> __device__ __forceinline__ void operator()(const AT (&acc)[2][2][4][2], const Unit& u, int wr, int wc, int fr, int fq) const {
        const int row0 = u.pm * BM + wr * 64 + fr, col0 = u.pn * BM + wc * 32 + 8 * fq;
        int dstv[2][4];
#pragma unroll
        for (int ai = 0; ai < 2; ++ai)
#pragma unroll
            for (int m = 0; m < 4; ++m) dstv[ai][m] = sdst[row0 + ai * HALF + m * 16];
#pragma unroll
        for (int ai = 0; ai < 2; ++ai)
#pragma unroll
            for (int m = 0; m < 4; ++m) { const int dst = dstv[ai][m];
                bf16_t* rowp = YS + (size_t)dst * 1024 + col0;
#pragma unroll
                for (int bj = 0; bj < 2; ++bj) { const f32x4 v0 = tof(acc[ai][bj][m][0]), v1 = tof(acc[ai][bj][m][1]);
                    u32x4 w; w.x = cvt_pk_bf16(v0[0], v0[1]); w.y = cvt_pk_bf16(v0[2], v0[3]); w.z = cvt_pk_bf16(v1[0], v1[1]); w.w = cvt_pk_bf16(v1[2], v1[3]);
                    *(u32x4*)(rowp + bj * HALF) = w; }
                asm volatile("" ::: "memory"); }
    }
};

template <class E, class = void> struct IsNarrow { static constexpr bool value = false; };
template <class E> struct IsNarrow<E, decltype((void)E::NARROW)> { static constexpr bool value = E::NARROW; };
template <bool I8> struct AccSel { typedef f32x4 type; };
template <> struct AccSel<true> { typedef i32x4 type; };
__device__ __forceinline__ f32x4 mma16(const bf16x8& a, const bf16x8& b, const f32x4& c) { return __builtin_amdgcn_mfma_f32_16x16x32_bf16(a, b, c, 0, 0, 0); }
__device__ __forceinline__ i32x4 mma16(const bf16x8& a, const bf16x8& b, const i32x4& c) { return __builtin_amdgcn_mfma_i32_16x16x64_i8(__builtin_bit_cast(i32x4, a), __builtin_bit_cast(i32x4, b), c, 0, 0, 0); }
template <int LDAB, int LDBB, int KB, bool I8, bool ALIGN_EPI = false, class Epi, class Sched>
__device__ __forceinline__ void gemm_phase(PG8_LAS unsigned char* lds, const Gemm g, const Sched& S, const Epi& E) {
    int tid = threadIdx.x; asm volatile("" : "+v"(tid));
    const int wid = __builtin_amdgcn_readfirstlane(tid >> 6), lane = tid & 63, wr = wid >> 2, wc = wid & 3, fr = lane & 15, fq = lane >> 4;
    constexpr int nt = KB / (BK * 2);
    unsigned voffA[2], voffB[2]; int Rr[2]; unsigned cby[2];
#pragma unroll
    for (int i = 0; i < 2; ++i) { int R, C; stage_rc(tid * 16 + i * 8192, R, C); const int Rb = Epi::PERM ? ((R & ~31) + perm32(R & 31)) : R;
        voffA[i] = (unsigned)(R * LDAB + C * 2); voffB[i] = (unsigned)(Rb * LDBB + C * 2); Rr[i] = R; cby[i] = (unsigned)(C * 2); }
    unsigned gc[2][2], gn[2][2];
#define PG8_GATH(u_, o_) do { if constexpr (Sched::GATHER) { _Pragma("unroll") for (int h_ = 0; h_ < 2; ++h_) _Pragma("unroll") for (int i_ = 0; i_ < 2; ++i_) { int tk_ = S.rowmap[(u_).pm * BM + HALF * h_ + Rr[i_]] >> 1; tk_ = tk_ < T_ ? tk_ : T_ - 1; \
        o_[h_][i_] = (unsigned)tk_ * (unsigned)LDAB + cby[i_]; } } } while (0)
#define PG8_STAGE_A(bufoff, ptr, kb, h, nx) do { if constexpr (!Sched::GATHER) { PG8_STAGE(bufoff, ptr, voffA); } else { unsigned vo_[2]; vo_[0] = (nx) ? gn[h][0] : gc[h][0]; vo_[1] = (nx) ? gn[h][1] : gc[h][1]; \
        PG8_STAGE(bufoff, (const char*)g.A + (kb), vo_); } } while (0)
    constexpr size_t kstep = (size_t)(BK * 2);
    constexpr size_t hstepA = (size_t)HALF * LDAB, hstepB = (size_t)HALF * LDBB;
    const unsigned ldsw = (unsigned)wid * 1024u;
    const int aoff = lds_byte(wr * 64 + fr, fq * 8), boff = lds_byte(wc * 32 + fr, fq * 8);
#define PG8_SA(b, h) (((b) * 2 + (h)) * HTB)
#define PG8_SB(b, h) ((4 + (b) * 2 + (h)) * HTB)
#define PG8_STAGE(bufoff, gbase, voff) do { _Pragma("unroll") for (int _i = 0; _i < 2; ++_i) \
        __builtin_amdgcn_global_load_lds((const unsigned*)((const char*)(gbase) + (voff)[_i]), (PG8_LAS unsigned*)(lds + (bufoff) + ldsw + _i * 8192), 16, 0, 0); } while (0)
#define PG8_LDA(dst, b, h) do { _Pragma("unroll") for (int m = 0; m < 4; ++m) _Pragma("unroll") for (int k = 0; k < 2; ++k) dst[m][k] = *(const PG8_LAS bf16x8*)(lds + PG8_SA(b, h) + aoff + m * 2048 + k * 1024); } while (0)
#define PG8_LDB(dst, b, h) do { _Pragma("unroll") for (int n = 0; n < 2; ++n) _Pragma("unroll") for (int k = 0; k < 2; ++k) dst[n][k] = *(const PG8_LAS bf16x8*)(lds + PG8_SB(b, h) + boff + n * 2048 + k * 1024); } while (0)
#define PG8_MMA(ai, bj, At, Bt) do { if constexpr (IsNarrow<Epi>::value && (bj) == 1) break; __builtin_amdgcn_s_setprio(1); _Pragma("unroll") for (int m = 0; m < 4; ++m) _Pragma("unroll") for (int n = 0; n < 2; ++n) _Pragma("unroll") for (int k = 0; k < 2; ++k) \
        acc[ai][bj][m][n] = mma16(Bt[n][k], At[m][k], acc[ai][bj][m][n]); __builtin_amdgcn_s_setprio(0); } while (0)
#define PG8_WAIT_V(n) asm volatile("s_waitcnt vmcnt(" #n ")" ::: "memory")
#define PG8_WAIT_L(n) asm volatile("s_waitcnt lgkmcnt(" #n ")" ::: "memory")
#define PG8_BAR __builtin_amdgcn_s_barrier()
#define PG8_SCHED __builtin_amdgcn_sched_barrier(0)
    Unit cur, nxt; int ui = 0;
    if (!S.next(0, cur)) return;
    typedef typename AccSel<I8>::type acc_t;
    acc_t acc[2][2][4][2];
#pragma unroll
    for (int a = 0; a < 2; ++a)
#pragma unroll
        for (int b = 0; b < 2; ++b)
#pragma unroll
            for (int m = 0; m < 4; ++m)
#pragma unroll
                for (int n = 0; n < 2; ++n) acc[a][b][m][n] = (acc_t){0, 0, 0, 0};
    bf16x8 At[4][2], B0[2][2], B1[2][2];
    const char* cA = (const char*)g.A + cur.aoff; const char* cB = (const char*)g.Bt + cur.boff;
    PG8_GATH(cur, gc);
    PG8_STAGE(PG8_SB(0, 0), cB, voffB); PG8_STAGE_A(PG8_SA(0, 0), cA, 0, 0, false); PG8_STAGE(PG8_SB(0, 1), cB + hstepB, voffB); PG8_STAGE_A(PG8_SA(0, 1), cA + hstepA, 0, 1, false);
    if (wr == 1) PG8_BAR;
    PG8_WAIT_V(4); PG8_BAR;
    PG8_STAGE(PG8_SB(1, 0), cB + kstep, voffB); PG8_STAGE_A(PG8_SA(1, 0), cA + kstep, kstep, 0, false); PG8_STAGE(PG8_SB(1, 1), cB + hstepB + kstep, voffB);
    PG8_WAIT_V(6); PG8_BAR;
    for (;;) {
        const bool has_next = S.next(ui + 1, nxt);
        const char* nA = has_next ? (const char*)g.A + nxt.aoff : cA; const char* nB = has_next ? (const char*)g.Bt + nxt.boff : cB;
        if constexpr (Sched::GATHER) { if (has_next) PG8_GATH(nxt, gn); else { gn[0][0] = gc[0][0]; gn[0][1] = gc[0][1]; gn[1][0] = gc[1][0]; gn[1][1] = gc[1][1]; } }
#pragma unroll 1
        for (int t = 0; t < nt; t += 2) {
            const bool last = (t == nt - 2);
            const char* a1 = cA + (size_t)(t + 1) * kstep;
            const char* a2 = last ? nA : cA + (size_t)(t + 2) * kstep; const char* b2 = last ? nB : cB + (size_t)(t + 2) * kstep;
            const char* a3 = a2 + kstep; const char* b3 = b2 + kstep;
            const size_t k2 = last ? 0 : (size_t)(t + 2) * kstep;
            PG8_LDB(B0, 0, 0); PG8_SCHED; PG8_LDA(At, 0, 0); PG8_STAGE_A(PG8_SA(1, 1), a1 + hstepA, (size_t)(t + 1) * kstep, 1, false);
            PG8_WAIT_L(8); PG8_BAR; PG8_WAIT_L(0); PG8_MMA(0, 0, At, B0); PG8_BAR; PG8_SCHED;
            PG8_LDB(B1, 0, 1); PG8_STAGE(PG8_SB(0, 0), b2, voffB);
            PG8_BAR; PG8_WAIT_L(0); PG8_MMA(0, 1, At, B1); PG8_BAR;
            PG8_LDA(At, 0, 1); PG8_STAGE_A(PG8_SA(0, 0), a2, k2, 0, last);
            PG8_BAR; PG8_WAIT_L(0); PG8_MMA(1, 0, At, B0); PG8_BAR; PG8_SCHED;
            PG8_STAGE(PG8_SB(0, 1), b2 + hstepB, voffB);
            PG8_WAIT_V(6); PG8_BAR; PG8_MMA(1, 1, At, B1); PG8_BAR;
            PG8_LDB(B0, 1, 0); PG8_SCHED; PG8_LDA(At, 1, 0); PG8_STAGE_A(PG8_SA(0, 1), a2 + hstepA, k2, 1, last);
            PG8_WAIT_L(8); PG8_BAR; PG8_WAIT_L(0); PG8_MMA(0, 0, At, B0); PG8_BAR; PG8_SCHED;
            PG8_LDB(B1, 1, 1); PG8_STAGE(PG8_SB(1, 0), b3, voffB);
            PG8_BAR; PG8_WAIT_L(0); PG8_MMA(0, 1, At, B1); PG8_BAR;
            PG8_LDA(At, 1, 1); PG8_STAGE_A(PG8_SA(1, 0), a3, k2 + kstep, 0, last);
            PG8_BAR; PG8_WAIT_L(0); PG8_MMA(1, 0, At, B0); PG8_BAR; PG8_SCHED;
            PG8_STAGE(PG8_SB(1, 1), b3 + hstepB, voffB);
            PG8_WAIT_V(6); PG8_BAR; PG8_MMA(1, 1, At, B1); PG8_BAR;
        }
        if constexpr (ALIGN_EPI) { if (wr == 0) PG8_BAR; }
        E(acc, cur, wr, wc, fr, fq);
        if (!has_next) break;
#pragma unroll
        for (int a = 0; a < 2; ++a)
#pragma unroll
            for (int b = 0; b < 2; ++b)
#pragma unroll
                for (int m = 0; m < 4; ++m)
#pragma unroll
                    for (int n = 0; n < 2; ++n) acc[a][b][m][n] = (acc_t){0, 0, 0, 0};
        cur = nxt; cA = nA; cB = nB; ++ui;
        if constexpr (Sched::GATHER) { gc[0][0] = gn[0][0]; gc[0][1] = gn[0][1]; gc[1][0] = gn[1][0]; gc[1][1] = gn[1][1]; }
        if constexpr (ALIGN_EPI) { if (wr == 1) PG8_BAR; }
    }
    PG8_WAIT_V(0);
    if constexpr (!ALIGN_EPI) { if (wr == 0) PG8_BAR; }
    PG8_BAR;
#undef PG8_SA
#undef PG8_GATH
#undef PG8_STAGE_A
#undef PG8_SB
#undef PG8_STAGE
#undef PG8_LDA
#undef PG8_LDB
#undef PG8_MMA
#undef PG8_WAIT_V
#undef PG8_WAIT_L
#undef PG8_BAR
#undef PG8_SCHED
}
}

#define XB_TMO      128
#define XB_XCNT(j)  (256  + 64 * (j))
#define XB_XSUB(j)  (1280 + 64 * (j))
#define XB_XGEN(j)  (2304 + 64 * (j))
#define XB_TOP      3328
#define XB_TOPGEN   3392
#define XCD_BAR_WORDS 3456
#define XB_SPIN_CAP (1u << 21)

__device__ __forceinline__ unsigned xb_ld(unsigned* p)              { return __hip_atomic_load(p, __ATOMIC_RELAXED, __HIP_MEMORY_SCOPE_AGENT); }
__device__ __forceinline__ unsigned xb_add(unsigned* p, unsigned v) { return __hip_atomic_fetch_add(p, v, __ATOMIC_RELAXED, __HIP_MEMORY_SCOPE_AGENT); }
__device__ __forceinline__ unsigned xb_xcc_id() { return (unsigned)__builtin_amdgcn_s_getreg((3 << 11) | 20) & 0xFu; }
#define XB_SPIN(cond, bar) do { unsigned _sp = 0; while (cond) { __builtin_amdgcn_s_sleep(1); \
    if ((++_sp & 255u) == 0u) { if (xb_ld(&(bar)[XB_TMO])) break; if (_sp > XB_SPIN_CAP) { atomicAdd(&(bar)[XB_TMO], 1u); break; } } } } while (0)

struct XcdBarrier {
    unsigned* bar; unsigned x;
    volatile LAS unsigned* st;
};

__device__ __forceinline__ XcdBarrier xcd_barrier_post(unsigned* bar, volatile LAS unsigned* st) {
    XcdBarrier b; b.bar = bar; b.x = xb_xcc_id(); b.st = st;
    if (threadIdx.x == 0) (void)xb_add(&bar[XB_XCNT(b.x)], 1u);
    return b;
}
__device__ __forceinline__ void xcd_barrier_complete(unsigned* bar, unsigned x, unsigned& nloc, unsigned& nx) {
    const unsigned G = gridDim.x * gridDim.y * gridDim.z;
    unsigned sum, cnt, mine, sp = 0u;
    for (;;) {
        sum = 0u; cnt = 0u; mine = 0u;
#pragma unroll
        for (unsigned j = 0; j < 16; ++j) { const unsigned c = xb_ld(&bar[XB_XCNT(j)]); sum += c; cnt += (c > 0u) ? 1u : 0u; mine = (j == x) ? c : mine; }
        if (sum == G) break;
        __builtin_amdgcn_s_sleep(1);
        if ((++sp & 255u) == 0u) { if (xb_ld(&bar[XB_TMO])) break; if (sp > XB_SPIN_CAP) { atomicAdd(&bar[XB_TMO], 1u); break; } }
    }
    nloc = mine > 0u ? mine : 1u; nx = cnt > 0u ? cnt : 1u;
}

__device__ __forceinline__ void xcd_barrier(const XcdBarrier& b) {
    asm volatile("s_waitcnt vmcnt(0)" ::: "memory");
    __syncthreads();
    if (threadIdx.x == 0) {
        unsigned* bar = b.bar;
        __builtin_amdgcn_s_waitcnt(0);
        unsigned nloc = b.st[0], nx = b.st[1];
        if (nloc == 0u) { xcd_barrier_complete(bar, b.x, nloc, nx); b.st[0] = nloc; b.st[1] = nx; }
        const unsigned old = xb_add(&bar[XB_XSUB(b.x)], 1u);
        const unsigned gen = old / nloc;
        if (old + 1u == (gen + 1u) * nloc) {
            __builtin_amdgcn_fence(__ATOMIC_RELEASE, "agent");
            asm volatile("s_waitcnt vmcnt(0)" ::: "memory");
            const unsigned og = xb_add(&bar[XB_TOP], 1u);
            const unsigned tg = og / nx;
            if (og + 1u == (tg + 1u) * nx) xb_add(&bar[XB_TOPGEN], 1u);
            else XB_SPIN(xb_ld(&bar[XB_TOPGEN]) == tg, bar);
            __builtin_amdgcn_fence(__ATOMIC_ACQUIRE, "agent");
            xb_add(&bar[XB_XGEN(b.x)], 1u);
            asm volatile("s_waitcnt vmcnt(0)" ::: "memory");
        } else {
            XB_SPIN(xb_ld(&bar[XB_XGEN(b.x)]) == gen, bar);
            __builtin_amdgcn_fence(__ATOMIC_ACQUIRE, "agent");
            asm volatile("s_waitcnt vmcnt(0)" ::: "memory");
        }
    }
    __syncthreads();
}

constexpr int NWAVES = 8, NTHREADS = 512;
constexpr int RING_BYTES = 131072;
constexpr int LDSCTL_OFF = 163840 - 1024, MISC_OFF = LDSCTL_OFF + 320;
constexpr int LDS_BYTES = 163840;

struct Params { const float* in[19]; float* out; unsigned char* ws; float inv_freq[16]; float ret_lg2[4]; int ph_lo, ph_hi; };
typedef const __attribute__((address_space(4))) Params& KPRef;

__device__ __forceinline__ float wave_sum(float v) {
#pragma unroll
    for (int o = 1; o < 64; o <<= 1) v += __shfl_xor(v, o);
    return v;
}
#define LDS_WAIT() asm volatile("s_waitcnt lgkmcnt(0)" ::: "memory")
#define MFMA16(a, b, c) __builtin_amdgcn_mfma_f32_16x16x32_bf16(a, b, c, 0, 0, 0)
typedef short v4i16_t __attribute__((ext_vector_type(4)));
__device__ __forceinline__ v4i16_t lds_tr16(const bf16_t* p) { return __builtin_amdgcn_ds_read_tr16_b64_v4i16((LAS v4i16_t*)(LAS unsigned char*)(unsigned char*)p); }
__device__ __forceinline__ bf16x8 tr_frag(const bf16_t* tile, int stride, int rowa, int rowb, int col0, int lane) {
    const int i = lane & 15, q = i >> 2, pp = i & 3;
    const v4i16_t lo = lds_tr16(tile + (rowa + q) * stride + col0 + 4 * pp), hi = lds_tr16(tile + (rowb + q) * stride + col0 + 4 * pp);
    return (bf16x8){lo[0], lo[1], lo[2], lo[3], hi[0], hi[1], hi[2], hi[3]};
}
__device__ __forceinline__ bf16x8 pack_p(const f32x4& a, const f32x4& b) {
    u32x4 w; w.x = pg8::cvt_pk_bf16(a[0], a[1]); w.y = pg8::cvt_pk_bf16(a[2], a[3]); w.z = pg8::cvt_pk_bf16(b[0], b[1]); w.w = pg8::cvt_pk_bf16(b[2], b[3]); return __builtin_bit_cast(bf16x8, w); }


template <class LD>
__device__ __forceinline__ void conv_item(LD ld, bf16_t* WT, int K, float* scr, int kb, int nb, int lane) {
    const int k0 = 64 * kb, n0 = 32 * nb;
    float wv[32];
#pragma unroll
    for (int i = 0; i < 32; ++i) wv[i] = ld(k0 + 2 * i + (lane >> 5), n0 + (lane & 31));
#pragma unroll
    for (int i = 0; i < 32; ++i) { const int kk = 2 * i + (lane >> 5); scr[kk * 33 + (lane & 31)] = wv[i]; }
    LDS_WAIT();
    const int c = lane & 7;
#pragma unroll
    for (int j = 0; j < 4; ++j) { const int n = (lane >> 3) + 8 * j; const float* s = scr + (8 * c) * 33 + n;
        u32x4 o; o.x = pk2(s[0 * 33], s[1 * 33]); o.y = pk2(s[2 * 33], s[3 * 33]); o.z = pk2(s[4 * 33], s[5 * 33]); o.w = pk2(s[6 * 33], s[7 * 33]);
        *(u32x4*)(WT + (size_t)(n0 + n) * K + k0 + 8 * c) = o; }
    LDS_WAIT();
}

struct C8Item { const float* base; int stride; int coff; bool valid; signed char* WT; float* scale; float ex; int n0; };
__device__ __forceinline__ void conv8_load(const C8Item& d, float (&wv)[2][32], int wave, int lane) {
    const unsigned lo = (unsigned)((lane >> 5) * d.stride + d.coff);
#pragma unroll
    for (int h = 0; h < 2; ++h)
#pragma unroll
        for (int i = 0; i < 32; ++i) { const float* rp = d.base + (size_t)(128 * wave + 64 * h + 2 * i) * d.stride; wv[h][i] = rp[lo]; }
}
__device__ __forceinline__ void conv8_work(const C8Item& d, float (&wv)[2][32], float* scr, float* red, int wave, int lane) {
    if (!d.valid) {
#pragma unroll
        for (int h = 0; h < 2; ++h)
#pragma unroll
            for (int i = 0; i < 32; ++i) wv[h][i] = 0.f; }
    float am = 0.f;
#pragma unroll
    for (int h = 0; h < 2; ++h)
#pragma unroll
        for (int i = 0; i < 32; ++i) am = fmaxf(am, fabsf(wv[h][i]));
    am = fmaxf(am, __shfl_xor(am, 32));
    if (lane < 32) red[wave * 32 + lane] = am;
    __syncthreads();
    float cm = 0.f;
#pragma unroll
    for (int w = 0; w < 8; ++w) cm = fmaxf(cm, red[w * 32 + (lane & 31)]);
    const float qs = (cm > 0.f) ? 127.0f / cm : 0.f;
    if (wave == 0 && lane < 32) d.scale[d.n0 + lane] = cm * (1.0f / 127.0f) * d.ex;
    const int c = lane & 7;
#pragma unroll
    for (int h = 0; h < 2; ++h) { const int k0 = 128 * wave + 64 * h;
#pragma unroll
        for (int i = 0; i < 32; ++i) { const int kk = 2 * i + (lane >> 5); scr[kk * 33 + (lane & 31)] = rintf(wv[h][i] * qs); }
        LDS_WAIT();
#pragma unroll
        for (int j = 0; j < 4; ++j) { const int n = (lane >> 3) + 8 * j; const float* s = scr + (8 * c) * 33 + n;
            u32x2 o; o.x = ((unsigned)((int)s[0 * 33] & 0xff)) | ((unsigned)((int)s[1 * 33] & 0xff) << 8) | ((unsigned)((int)s[2 * 33] & 0xff) << 16) | ((unsigned)((int)s[3 * 33] & 0xff) << 24);
            o.y = ((unsigned)((int)s[4 * 33] & 0xff)) | ((unsigned)((int)s[5 * 33] & 0xff) << 8) | ((unsigned)((int)s[6 * 33] & 0xff) << 16) | ((unsigned)((int)s[7 * 33] & 0xff) << 24);
            *(u32x2*)(d.WT + (size_t)(d.n0 + n) * 1024 + k0 + 8 * c) = o; }
        LDS_WAIT(); }
    __syncthreads();
}
__device__ __forceinline__ C8Item conv8_desc(KPRef p, int l, unsigned char* wd, int it, int lane) {
    unsigned char* ws = p.ws; const size_t sl = (size_t)l * SW_LSTEP; const float* Win = p.in[2] + (size_t)l * 1024 * IN_W;
    C8Item d;
    if (it < 96) { const int n = 32 * it + (lane & 31); d.valid = n < Z_GATE; d.base = Win; d.stride = IN_W; d.coff = d.valid ? n : 0; d.n0 = 32 * it;
        float s = 1.f; if (n < Z_GK) s = RSQ32; else if (n >= Z_SQ && n < Z_SK) s = C2; else if (n >= Z_MQ && n < Z_MK) s = C2; else if (n >= Z_RK && n < Z_RV) s = RSQ32;
        d.ex = s; d.WT = (signed char*)(wd + WS_WIN); d.scale = (float*)(ws + WS_SWIN + sl);
    } else if (it < 224) { const int nb = it - 96, n = 32 * nb + (lane & 31);
        const int pn = n >> 8, cc = n & 255, bj = (cc >> 7) & 1, wc = (cc >> 5) & 3, nn = (cc >> 4) & 1, fq = (cc >> 2) & 3, j = cc & 3;
        d.valid = true; d.base = Win; d.stride = IN_W; d.coff = Z_GATE + 1024 * (2 * bj + nn) + 64 * pn + 16 * wc + 4 * fq + j; d.n0 = 32 * nb; d.ex = 1.f;
        d.WT = (signed char*)(wd + WS_WG); d.scale = (float*)(ws + WS_SWG + sl);
    } else { const int r = it - 224, e = r >> 4, nb = r & 15;
        const int n0 = 32 * nb, pn = n0 >> 8, c0 = n0 & 255;
        d.valid = true; d.base = ((c0 < 128) ? p.in[15] : p.in[16]) + (size_t)(l * 32 + e) * 1024 * 256 + 128 * pn + (c0 & 127); d.stride = 256; d.coff = lane & 31; d.n0 = n0; d.ex = 1.f;
        d.WT = (signed char*)(wd + WS_E1) + (size_t)e * 512 * 1024; d.scale = (float*)(ws + WS_SWE1 + sl) + e * 512; }
    return d;
}
__device__ __forceinline__ void conv8_phase(KPRef p, int l, unsigned char* wd, unsigned char* lds, int c, int nwg, int wave, int lane, int it_lo, int it_hi) {
    float* scr = (float*)(lds + wave * 16384); float* red = (float*)(lds + RING_BYTES);
    int it = it_lo + c; if (it >= it_hi) return;
    C8Item d0 = conv8_desc(p, l, wd, it, lane); float wa[2][32]; conv8_load(d0, wa, wave, lane);
    for (;;) {
        const int it2 = it + nwg; const bool has = it2 < it_hi;
        const C8Item d1 = conv8_desc(p, l, wd, has ? it2 : it, lane); float wb[2][32];
        if (has) conv8_load(d1, wb, wave, lane);
        conv8_work(d0, wa, scr, red, wave, lane);
        if (!has) break;
#pragma unroll
        for (int h = 0; h < 2; ++h)
#pragma unroll
            for (int i = 0; i < 32; ++i) wa[h][i] = wb[h][i];
        d0 = d1; it = it2;
    }
}

__device__ __forceinline__ void conv_phase(KPRef p, int l, unsigned char* wd, unsigned char* lds, int gw, int NGW, int wave, int lane) {
    float* scr = (float*)(lds + wave * 16384);
    unsigned char* ws = wd;
    {
        for (int it = gw; it < 512; it += NGW) { const int i = it / 128, r = it % 128, kb = r / 32, nb = r % 32;
            const float* W = p.in[8] + (size_t)(l * 4 + i) * 256 * 1024; bf16_t* WT = (bf16_t*)(ws + WS_WB) + (size_t)i * 1024 * 256;
            conv_item([&](int k, int n) -> float { return W[(size_t)k * 1024 + n]; }, WT, 256, scr, kb, nb, lane); }
    }
    {
        const float* W = p.in[9] + (size_t)l * 1024 * 1024; bf16_t* WT = (bf16_t*)(ws + WS_WO);
        for (int it = gw; it < 16 * 32; it += NGW) { const int kb = it / 32, nb = it % 32;
            conv_item([&](int k, int n) -> float { return W[(size_t)k * 1024 + n]; }, WT, 1024, scr, kb, nb, lane); }
    }
    {
        const float* Wg = p.in[11] + (size_t)l * 1024 * 4; const float* We = p.in[13] + (size_t)l * 1024 * 32; const float* g2 = p.in[10] + l * 1024; bf16_t* WT = (bf16_t*)(ws + WS_WR);
        for (int it = gw; it < 16 * 8; it += NGW) { const int kb = it / 8, nb = it % 8;
            conv_item([&](int k, int n) -> float { const float gk = g2[k]; if (n < 4) return gk * Wg[k * 4 + n]; if (n < 36) return gk * We[k * 32 + (n - 4)]; return 0.f; }, WT, 1024, scr, kb, nb, lane); }
    }
    {
        for (int it = gw; it < 32 * 128; it += NGW) { const int e = it / 128, r = it % 128, kb = r / 32, nb = r % 32;
            const float* W = p.in[17] + (size_t)(l * 32 + e) * 256 * 1024; bf16_t* WT = (bf16_t*)(ws + WS_E2) + (size_t)e * 1024 * 256;
            conv_item([&](int k, int n) -> float { return W[(size_t)k * 1024 + n]; }, WT, 256, scr, kb, nb, lane); }
    }
}

__device__ __forceinline__ bf16_t* hbf_ptr(KPRef p) { return (bf16_t*)((unsigned char*)p.out + (size_t)64 * MiB); }
template <bool SRC_F32, bool COMBINE>
__device__ __forceinline__ void norm_load_row(KPRef p, int row, int lane, f32x4 (&v)[4]) {
    if (SRC_F32) { const f32x4* xr = (const f32x4*)(p.in[0] + (size_t)row * 1024) + lane;
#pragma unroll
        for (int j = 0; j < 4; ++j) v[j] = xr[64 * j];
    } else { const u32x2* hr = (const u32x2*)(hbf_ptr(p) + (size_t)row * 1024) + lane;
#pragma unroll
        for (int j = 0; j < 4; ++j) { const u32x2 a = hr[64 * j]; v[j] = (f32x4){__uint_as_float(a.x << 16), __uint_as_float(a.x & 0xffff0000u), __uint_as_float(a.y << 16), __uint_as_float(a.y & 0xffff0000u)}; } }
    if (COMBINE) { const bf16_t* ys = (const bf16_t*)(p.ws + WS_YS); const float* tokw = (const float*)(p.ws + WS_TOKW);
        const float w0 = tokw[2 * row], w1 = tokw[2 * row + 1];
        const u32x2* y0 = (const u32x2*)(ys + (size_t)(2 * row) * 1024) + lane; const u32x2* y1 = (const u32x2*)(ys + (size_t)(2 * row + 1) * 1024) + lane;
        u32x2 ya[4], yb[4];
#pragma unroll
        for (int j = 0; j < 4; ++j) { ya[j] = y0[64 * j]; yb[j] = y1[64 * j]; }
#pragma unroll
        for (int j = 0; j < 4; ++j) { const u32x2 a = ya[j], b = yb[j];
            v[j][0] += w0 * __uint_as_float(a.x << 16) + w1 * __uint_as_float(b.x << 16); v[j][1] += w0 * __uint_as_float(a.x & 0xffff0000u) + w1 * __uint_as_float(b.x & 0xffff0000u);
            v[j][2] += w0 * __uint_as_float(a.y << 16) + w1 * __uint_as_float(b.y << 16); v[j][3] += w0 * __uint_as_float(a.y & 0xffff0000u) + w1 * __uint_as_float(b.y & 0xffff0000u); } }
}
__device__ __forceinline__ float row_rstd(const f32x4 (&v)[4]) {
    float s = 0.f;
#pragma unroll
    for (int j = 0; j < 4; ++j) s += (v[j][0] * v[j][0] + v[j][1] * v[j][1]) + (v[j][2] * v[j][2] + v[j][3] * v[j][3]);
    return rsqrtf(wave_sum(s) * (1.0f / 1024.0f) + NORM_EPS);
}
template <int MODE>
__device__ __forceinline__ void norm_phase(KPRef p, int l, int gw, int NGW, int lane) {
    const float* gain = (MODE == 2 ? p.in[10] + l * 1024 : p.in[1] + l * 1024);
    f32x4 gg[4];
#pragma unroll
    for (int j = 0; j < 4; ++j) gg[j] = ((const f32x4*)gain)[lane + 64 * j];
    constexpr int NR = (MODE == 1) ? 2 : 4;
    for (int row0 = gw * NR; row0 < T_; row0 += NGW * NR) {
        f32x4 v[NR][4];
#pragma unroll
        for (int r = 0; r < NR; ++r) norm_load_row<MODE == 0, MODE == 1>(p, row0 + r, lane, v[r]);
#pragma unroll
        for (int r = 0; r < NR; ++r) {
            if (MODE == 1) { u32x2* hr = (u32x2*)(hbf_ptr(p) + (size_t)(row0 + r) * 1024) + lane;
#pragma unroll
                for (int j = 0; j < 4; ++j) { u32x2 w; w.x = pk2(v[r][j][0], v[r][j][1]); w.y = pk2(v[r][j][2], v[r][j][3]); hr[64 * j] = w; } }
            const float rstd = row_rstd(v[r]);
            f32x4 o[4]; float am = 0.f;
#pragma unroll
            for (int j = 0; j < 4; ++j) { o[j] = v[r][j] * rstd * gg[j]; am = fmaxf(fmaxf(am, fmaxf(fabsf(o[j][0]), fabsf(o[j][1]))), fmaxf(fabsf(o[j][2]), fabsf(o[j][3]))); }
#pragma unroll
            for (int of = 1; of < 64; of <<= 1) am = fmaxf(am, __shfl_xor(am, of));
            const float qs = (am > 0.f) ? 127.0f / am : 0.f;
            unsigned* o4 = (unsigned*)(p.ws + WS_U8 + (size_t)(row0 + r) * 1024) + lane;
#pragma unroll
            for (int j = 0; j < 4; ++j) { const int q0 = (int)rintf(o[j][0] * qs), q1 = (int)rintf(o[j][1] * qs), q2 = (int)rintf(o[j][2] * qs), q3 = (int)rintf(o[j][3] * qs);
                o4[64 * j] = (unsigned)(q0 & 0xff) | ((unsigned)(q1 & 0xff) << 8) | ((unsigned)(q2 & 0xff) << 16) | ((unsigned)(q3 & 0xff) << 24); }
            if (lane == 0) ((float*)(p.ws + WS_SU))[row0 + r] = am * (1.0f / 127.0f);
            if (MODE == 2 && lane == 0) ((float*)(p.ws + WS_RSTD))[row0 + r] = rstd;
        }
    }
}
struct FinalHold { f32x4 v[8][4]; };
__device__ __forceinline__ void final_a(KPRef p, int gw, int NGW, int lane, FinalHold& Hd) {
    f32x4 gg[4];
#pragma unroll
    for (int j = 0; j < 4; ++j) gg[j] = ((const f32x4*)p.in[18])[lane + 64 * j];
    for (int row0 = gw * 4; row0 < T_ / 2; row0 += NGW * 4) {
        f32x4 v[4][4];
#pragma unroll
        for (int r = 0; r < 4; ++r) norm_load_row<false, true>(p, row0 + r, lane, v[r]);
#pragma unroll
        for (int r = 0; r < 4; ++r) { const float rstd = row_rstd(v[r]); f32x4* orow = (f32x4*)(p.out + (size_t)(row0 + r) * 1024) + lane;
#pragma unroll
            for (int j = 0; j < 4; ++j) orow[64 * j] = v[r][j] * rstd * gg[j]; } }
#pragma unroll
    for (int r = 0; r < 8; ++r) norm_load_row<false, true>(p, T_ / 2 + gw * 8 + r, lane, Hd.v[r]);
}
__device__ __forceinline__ void final_b(KPRef p, int gw, int lane, const FinalHold& Hd) {
    f32x4 gg[4];
#pragma unroll
    for (int j = 0; j < 4; ++j) gg[j] = ((const f32x4*)p.in[18])[lane + 64 * j];
#pragma unroll
    for (int r = 0; r < 8; ++r) { const float rstd = row_rstd(Hd.v[r]); f32x4* orow = (f32x4*)(p.out + (size_t)(T_ / 2 + gw * 8 + r) * 1024) + lane;
#pragma unroll
        for (int j = 0; j < 4; ++j) orow[64 * j] = Hd.v[r][j] * rstd * gg[j]; }
}

constexpr int LA_QS = 0, LA_KS = 10240, LA_VS = 20480  , LA_KD = 38912  , LA_PS = 49152  , LA_PW = 58368, LA_PW_WAVE = 4352,
              LA_LA = 93184, LA_AS = 110080, LA_END = 118272;
__device__ __forceinline__ void unpack8f(float (&d)[8], u32x4 kk) {
    d[0] = __uint_as_float(kk.x << 16); d[1] = __uint_as_float(kk.x & 0xffff0000u); d[2] = __uint_as_float(kk.y << 16); d[3] = __uint_as_float(kk.y & 0xffff0000u);
    d[4] = __uint_as_float(kk.z << 16); d[5] = __uint_as_float(kk.z & 0xffff0000u); d[6] = __uint_as_float(kk.w << 16); d[7] = __uint_as_float(kk.w & 0xffff0000u); }
__device__ __forceinline__ u32x4 pack8f(const float (&o)[8]) { u32x4 w; w.x = pk2(o[0], o[1]); w.y = pk2(o[2], o[3]); w.z = pk2(o[4], o[5]); w.w = pk2(o[6], o[7]); return w; }

struct LaRegs { u32x4 a, k[2], q[2], v[2], g[2]; f32x4 pv[2]; };
__device__ __forceinline__ void gla_decay_front(KPRef p, int l, unsigned char* lds, const u32x4& areg, int h, int tid) {
    float* LA = (float*)(lds + LA_LA); float* AS = (float*)(lds + LA_AS);
    const int lane = tid & 63, wave = __builtin_amdgcn_readfirstlane(tid >> 6);
    if (tid < 256) { const int t = tid >> 1, hf = tid & 1; float a[8]; unpack8f(a, areg);
#pragma unroll
        for (int e = 0; e < 8; ++e) AS[t * 16 + 8 * hf + e] = a[e]; }
    const int d = tid & 31; const float* wa2 = p.in[3] + (size_t)l * 16 * 128 + h * 32 + d; float wcol[16];
#pragma unroll
    for (int r = 0; r < 16; ++r) wcol[r] = wa2[r * 128];
    const float bias = p.in[4][l * 128 + h * 32 + d];
    __syncthreads();
#pragma unroll
    for (int i = 0; i < 8; ++i) { const int t = (tid >> 5) + 16 * i; float x = bias;
#pragma unroll
        for (int r = 0; r < 16; ++r) x += AS[t * 16 + r] * wcol[r];
        LA[t * 33 + d] = (fminf(x, 0.f) - __builtin_amdgcn_logf(1.0f + __builtin_amdgcn_exp2f(-fabsf(x) * LOG2E)) * 0.6931471805599453f) * (1.0f / 16.0f); }
    __syncthreads();
#pragma unroll
    for (int s8 = 0; s8 < 8; ++s8) { const int s = wave * 8 + s8, ch = s >> 5, dd = s & 31; float v = LA[(64 * ch + lane) * 33 + dd];
#pragma unroll
        for (int o = 1; o < 64; o <<= 1) { const float t = __shfl_up(v, o); if (lane >= o) v += t; }
        LA[(64 * ch + lane) * 33 + dd] = v; }
    __syncthreads();
}
__device__ __forceinline__ void la_stage_v(unsigned char* lds, const u32x4 (&v)[2], int tid) {
    bf16_t* VS = (bf16_t*)(lds + LA_VS);
#pragma unroll
    for (int i = 0; i < 2; ++i) { const int c = tid + 512 * i, t = c >> 3, oct = c & 7; *(u32x4*)(VS + t * 72 + 8 * oct) = v[i]; }
}
template <bool OUT, bool GLA>
__device__ __forceinline__ void la_load(LaRegs& R, KPRef p, int unit, int tid) {
    const int lane = tid & 63, wave = __builtin_amdgcn_readfirstlane(tid >> 6);
    int b, h, c128; if (GLA) { c128 = unit & 63; h = (unit >> 6) & 3; b = unit >> 8; } else { c128 = unit & 63; const int bh = unit >> 6; h = bh & 3; b = bh >> 2; }
    const size_t t0 = (size_t)b * S_ + (size_t)c128 * 128; const bf16_t* zrow0 = (const bf16_t*)(p.ws + WS_Z) + t0 * ZLD;
    const int kcol = GLA ? Z_GK + h * 32 : Z_RK + h * 32, qcol = GLA ? Z_GQ + h * 32 : Z_RQ + h * 32, vcol = GLA ? Z_GV + h * 64 : Z_RV + h * 64, gcol = GLA ? Z_GR + h * 64 : Z_RG + h * 64;
    if (GLA) { const int t = (tid & 255) >> 1, hf = tid & 1; R.a = *(const u32x4*)(zrow0 + (size_t)t * ZLD + Z_GA + 8 * hf); }
    { const int t = tid >> 2, oct = tid & 3; const bf16_t* kr = zrow0 + (size_t)t * ZLD + kcol; R.k[0] = *(const u32x4*)(kr + 8 * oct); if (!GLA) R.k[1] = *(const u32x4*)(kr + 8 * (oct ^ 2));
      if (OUT) { const bf16_t* qr = zrow0 + (size_t)t * ZLD + qcol; R.q[0] = *(const u32x4*)(qr + 8 * oct); if (!GLA) R.q[1] = *(const u32x4*)(qr + 8 * (oct ^ 2)); } }
#pragma unroll
    for (int i = 0; i < 2; ++i) { const int c = tid + 512 * i, t = c >> 3, oct = c & 7; R.v[i] = *(const u32x4*)(zrow0 + (size_t)t * ZLD + vcol + 8 * oct); }
    if (OUT) {
#pragma unroll
        for (int i = 0; i < 2; ++i) { const int cidx = lane + 64 * i, row = cidx >> 3, oct = cidx & 7; R.g[i] = *(const u32x4*)(zrow0 + (size_t)(16 * wave + row) * ZLD + gcol + 8 * oct); }
        const float* prev = GLA ? (const float*)(p.ws + WS_GKV) + (size_t)((b * 4 + h) * 128 + 2 * c128) * 2048 : (const float*)(p.ws + WS_RKV) + (size_t)unit * 2048;
        const int row = (GLA ? tid : (tid & 255)) >> 3, oct = tid & 7; R.pv[0] = *(const f32x4*)(prev + row * 64 + 8 * oct); R.pv[1] = *(const f32x4*)(prev + row * 64 + 8 * oct + 4); }
}
__device__ __forceinline__ void la_kv_mfma(unsigned char* lds, float* out0, int nch, int clen, int tid) {
    const bf16_t* KD = (const bf16_t*)(lds + LA_KD); const bf16_t* VS = (const bf16_t*)(lds + LA_VS);
    const int lane = tid & 63, wave = __builtin_amdgcn_readfirstlane(tid >> 6), c16 = lane & 15, g = lane >> 4;
    const int ntile = 8 * nch;
    for (int ti = wave; ti < ntile; ti += 8) { const int ch = ti >> 3, dt = (ti >> 2) & 1, et = ti & 3, tok0 = ch * clen;
        f32x4 acc = (f32x4){0.f, 0.f, 0.f, 0.f};
        for (int s = 0; s < clen / 32; ++s) { const int r0 = tok0 + 32 * s + 8 * g;
            acc = MFMA16(tr_frag(KD, 40, r0, r0 + 4, 16 * dt, lane), tr_frag(VS, 72, r0, r0 + 4, 16 * et, lane), acc); }
        float* o = out0 + (size_t)ch * 2048 + (16 * dt + 4 * g) * 64 + 16 * et + c16;
#pragma unroll
        for (int r = 0; r < 4; ++r) o[r * 64] = acc[r]; }
}
__device__ __forceinline__ void gla_kv_unit(KPRef p, int l, unsigned char* lds, int unit, const LaRegs& R, int tid) {
    const int c = unit & 63, h = (unit >> 6) & 3, b = unit >> 8;
    gla_decay_front(p, l, lds, R.a, h, tid);
    const float* LA = (const float*)(lds + LA_LA); bf16_t* KD = (bf16_t*)(lds + LA_KD);
    { const int t = tid >> 2, oct = tid & 3, ch = t >> 6; float k[8]; unpack8f(k, R.k[0]);
#pragma unroll
      for (int e = 0; e < 8; ++e) { const int d = 8 * oct + e; k[e] *= __builtin_amdgcn_exp2f((LA[(64 * ch + 63) * 33 + d] - LA[t * 33 + d]) * LOG2E); }
      *(u32x4*)(KD + t * 40 + 8 * oct) = pack8f(k); }
    la_stage_v(lds, R.v, tid);
    __syncthreads();
    const int cu = ((b * 4 + h) * 128 + 2 * c);
    la_kv_mfma(lds, (float*)(p.ws + WS_GKV) + (size_t)cu * 2048, 2, 64, tid);
    if (tid < 64) { const int ch = tid >> 5, d = tid & 31; ((float*)(p.ws + WS_GDEC))[(size_t)(cu + ch) * 32 + d] = __builtin_amdgcn_exp2f(LA[(64 * ch + 63) * 33 + d] * LOG2E); }
    __syncthreads();
}
__device__ __forceinline__ void la_out_mfma(unsigned char* lds, const u32x4 (&gate)[2], const float* ng, bf16_t* orow0, int ocol, int clen, int tid) {
    const bf16_t* QS = (const bf16_t*)(lds + LA_QS); const bf16_t* KS = (const bf16_t*)(lds + LA_KS); const bf16_t* VS = (const bf16_t*)(lds + LA_VS); const bf16_t* PS = (const bf16_t*)(lds + LA_PS);
    const int lane = tid & 63, wave = __builtin_amdgcn_readfirstlane(tid >> 6), c16 = lane & 15, g = lane >> 4;
    float* PWf = (float*)(lds + LA_PW + wave * LA_PW_WAVE);
    const int ch = (clen == 64) ? (wave >> 2) : 0, kt0 = (clen == 64) ? 4 * ch : 0;
    const bf16x8 qa = *(const bf16x8*)(QS + (16 * wave + c16) * 40 + 8 * g);
    f32x4 O[4];
#pragma unroll
    for (int et = 0; et < 4; ++et) O[et] = MFMA16(qa, tr_frag(PS + ch * 32 * 72, 72, 8 * g, 8 * g + 4, 16 * et, lane), ((f32x4){0.f, 0.f, 0.f, 0.f}));
    for (int s = kt0 >> 1; s <= (wave >> 1); ++s) {
        f32x4 P0, P1;
        { const int kt = 2 * s; P0 = MFMA16(*(const bf16x8*)(KS + (16 * kt + c16) * 40 + 8 * g), qa, ((f32x4){0.f, 0.f, 0.f, 0.f}));
          if (kt == wave) {
#pragma unroll
              for (int r = 0; r < 4; ++r) if (4 * g + r > c16) P0[r] = 0.f; } }
        { const int kt = 2 * s + 1;
          if (kt <= wave) { P1 = MFMA16(*(const bf16x8*)(KS + (16 * kt + c16) * 40 + 8 * g), qa, ((f32x4){0.f, 0.f, 0.f, 0.f}));
            if (kt == wave) {
#pragma unroll
                for (int r = 0; r < 4; ++r) if (4 * g + r > c16) P1[r] = 0.f; } }
          else P1 = (f32x4){0.f, 0.f, 0.f, 0.f}; }
        const bf16x8 pa = pack_p(P0, P1);
#pragma unroll
        for (int et = 0; et < 4; ++et) O[et] = MFMA16(pa, tr_frag(VS, 72, 32 * s + 4 * g, 32 * s + 16 + 4 * g, 16 * et, lane), O[et]); }
    float rs[4];
#pragma unroll
    for (int r = 0; r < 4; ++r) { float ss = O[0][r] * O[0][r] + O[1][r] * O[1][r] + O[2][r] * O[2][r] + O[3][r] * O[3][r];
#pragma unroll
        for (int o = 1; o < 16; o <<= 1) ss += __shfl_xor(ss, o);
        rs[r] = rsqrtf(ss * (1.0f / 64.0f) + NORM_EPS); }
#pragma unroll
    for (int et = 0; et < 4; ++et)
#pragma unroll
        for (int r = 0; r < 4; ++r) PWf[(4 * g + r) * 68 + 16 * et + c16] = O[et][r] * rs[r];
    LDS_WAIT();
#pragma unroll
    for (int i = 0; i < 2; ++i) { const int cidx = lane + 64 * i, row = cidx >> 3, oct = cidx & 7; const int t = 16 * wave + row;
        float gt[8]; unpack8f(gt, gate[i]);
        const f32x4 o0 = *(const f32x4*)(PWf + row * 68 + 8 * oct), o1 = *(const f32x4*)(PWf + row * 68 + 8 * oct + 4), n0 = *(const f32x4*)(ng + 8 * oct), n1 = *(const f32x4*)(ng + 8 * oct + 4);
        float o[8];
#pragma unroll
        for (int e = 0; e < 4; ++e) { o[e] = o0[e] * n0[e] * (gt[e] * sigmoidf_(gt[e])); o[4 + e] = o1[e] * n1[e] * (gt[4 + e] * sigmoidf_(gt[4 + e])); }
        *(u32x4*)(orow0 + (size_t)t * OLD + ocol + 8 * oct) = pack8f(o); }
    LDS_WAIT();
}
__device__ __forceinline__ void gla_out_unit(KPRef p, int l, unsigned char* lds, int unit, const LaRegs& R, int tid) {
    const int c = unit & 63, h = (unit >> 6) & 3, b = unit >> 8;
    const size_t t0 = (size_t)b * S_ + (size_t)c * 128;
    gla_decay_front(p, l, lds, R.a, h, tid);
    const float* LA = (const float*)(lds + LA_LA); bf16_t* QS = (bf16_t*)(lds + LA_QS); bf16_t* KS = (bf16_t*)(lds + LA_KS); bf16_t* PS = (bf16_t*)(lds + LA_PS);
    { const int t = tid >> 2, oct = tid & 3; float k[8], q[8]; unpack8f(k, R.k[0]); unpack8f(q, R.q[0]);
#pragma unroll
      for (int e = 0; e < 8; ++e) { const float bb = LA[t * 33 + 8 * oct + e] * LOG2E; q[e] *= __builtin_amdgcn_exp2f(bb); k[e] *= __builtin_amdgcn_exp2f(-bb); }
      *(u32x4*)(QS + t * 40 + 8 * oct) = pack8f(q); *(u32x4*)(KS + t * 40 + 8 * oct) = pack8f(k); }
    la_stage_v(lds, R.v, tid);
    { const int row = tid >> 3, oct = tid & 7; float o[8] = {R.pv[0][0], R.pv[0][1], R.pv[0][2], R.pv[0][3], R.pv[1][0], R.pv[1][1], R.pv[1][2], R.pv[1][3]}; *(u32x4*)(PS + row * 72 + 8 * oct) = pack8f(o); }
    __syncthreads();
    la_out_mfma(lds, R.g, p.in[5] + l * 64, (bf16_t*)(p.ws + WS_O) + t0 * OLD, 0 + h * 64, 64, tid);
    __syncthreads();
}
__device__ __forceinline__ void rope_cs(float pos, float invf, float& c, float& s) {
    const float ang = pos * invf; const double t = (double)ang * 0.15915494309189535; const float fr = (float)(t - floor(t));
    c = __builtin_amdgcn_cosf(fr); s = __builtin_amdgcn_sinf(fr);
}
__device__ __forceinline__ void ret_cs_table(KPRef p, unsigned char* lds, int pos0, int tid) {
    f32x2* CS = (f32x2*)(lds + LA_LA);
#pragma unroll
    for (int i = 0; i < 4; ++i) { const int idx = tid + 512 * i, t = idx >> 4, f = idx & 15; float c, s; rope_cs((float)(pos0 + t), p.inv_freq[f], c, s); CS[idx] = (f32x2){c, s}; }
}
__device__ __forceinline__ void ret_rot8(const unsigned char* lds, const u32x4& own_q, const u32x4& oth_q, int t, int oct, float (&o)[8]) {
    const f32x2* CS = (const f32x2*)(lds + LA_LA); float own[8], oth[8]; unpack8f(own, own_q); unpack8f(oth, oth_q);
#pragma unroll
    for (int e = 0; e < 8; ++e) { const f32x2 cs = CS[t * 16 + 8 * (oct & 1) + e]; o[e] = (oct < 2) ? (own[e] * cs[0] - oth[e] * cs[1]) : (oth[e] * cs[1] + own[e] * cs[0]); }
}
__device__ __forceinline__ void ret_kv_unit(KPRef p, unsigned char* lds, int unit, const LaRegs& R, int tid) {
    const int n = unit & 63, bh = unit >> 6, h = bh & 3;
    ret_cs_table(p, lds, n * 128, tid);
    la_stage_v(lds, R.v, tid);
    __syncthreads();
    bf16_t* KD = (bf16_t*)(lds + LA_KD); const float lg = p.ret_lg2[h];
    { const int t = tid >> 2, oct = tid & 3; float k[8]; ret_rot8(lds, R.k[0], R.k[1], t, oct, k); const float dk = __builtin_amdgcn_exp2f((float)(127 - t) * lg);
#pragma unroll
      for (int e = 0; e < 8; ++e) k[e] *= dk;
      *(u32x4*)(KD + t * 40 + 8 * oct) = pack8f(k); }
    __syncthreads();
    la_kv_mfma(lds, (float*)(p.ws + WS_RKV) + (size_t)unit * 2048, 1, 128, tid);
    __syncthreads();
}
__device__ __forceinline__ void ret_out_unit(KPRef p, int l, unsigned char* lds, int unit, const LaRegs& R, int tid) {
    const int n = unit & 63, bh = unit >> 6, h = bh & 3, b = bh >> 2;
    const size_t t0 = (size_t)b * S_ + (size_t)n * 128;
    ret_cs_table(p, lds, n * 128, tid);
    la_stage_v(lds, R.v, tid);
    const float lg = p.ret_lg2[h]; bf16_t* PS = (bf16_t*)(lds + LA_PS); const float g1 = __builtin_amdgcn_exp2f(lg);
    if (tid < 256) { const int row = tid >> 3, oct = tid & 7;
      float o[8] = {R.pv[0][0] * g1, R.pv[0][1] * g1, R.pv[0][2] * g1, R.pv[0][3] * g1, R.pv[1][0] * g1, R.pv[1][1] * g1, R.pv[1][2] * g1, R.pv[1][3] * g1}; *(u32x4*)(PS + row * 72 + 8 * oct) = pack8f(o); }
    __syncthreads();
    bf16_t* QS = (bf16_t*)(lds + LA_QS); bf16_t* KS = (bf16_t*)(lds + LA_KS);
    { const int t = tid >> 2, oct = tid & 3; float k[8], q[8]; ret_rot8(lds, R.k[0], R.k[1], t, oct, k); ret_rot8(lds, R.q[0], R.q[1], t, oct, q);
      const float dq = __builtin_amdgcn_exp2f((float)t * lg), dk = __builtin_amdgcn_exp2f(-(float)t * lg);
#pragma unroll
      for (int e = 0; e < 8; ++e) { q[e] *= dq; k[e] *= dk; }
      *(u32x4*)(QS + t * 40 + 8 * oct) = pack8f(q); *(u32x4*)(KS + t * 40 + 8 * oct) = pack8f(k); }
    __syncthreads();
    la_out_mfma(lds, R.g, p.in[7] + l * 64, (bf16_t*)(p.ws + WS_O) + t0 * OLD, 768 + h * 64, 128, tid);
    __syncthreads();
}
template <int KIND>
__device__ __forceinline__ void la_loop(KPRef p, int l, unsigned char* lds, int wg, int tid) {
    constexpr bool OUT = KIND >= 2, GLA = (KIND & 1) == 0; constexpr int NU = 1024, G = 256;
    int u = wg; if (u >= NU) return;
    LaRegs R; la_load<OUT, GLA>(R, p, u, tid);
    for (;;) {
        const int un = u + G; const bool hn = un < NU;
        LaRegs Rn; if (hn) la_load<OUT, GLA>(Rn, p, un, tid);
        if (KIND == 0) gla_kv_unit(p, l, lds, u, R, tid); else if (KIND == 1) ret_kv_unit(p, lds, u, R, tid); else if (KIND == 2) gla_out_unit(p, l, lds, u, R, tid); else ret_out_unit(p, l, lds, u, R, tid);
        if (!hn) break;
        R = Rn; u = un;
    }
}

__device__ __forceinline__ void scan_phase(KPRef p, int wg, int tid) {
    if (wg < 64) {
        const int bh = wg >> 2, elem = (wg & 3) * 512 + tid, d = elem >> 6;
        float* base = (float*)(p.ws + WS_GKV) + (size_t)bh * 128 * 2048 + elem; const float* dec = (const float*)(p.ws + WS_GDEC) + (size_t)bh * 128 * 32 + d;
        float s = 0.f;
#pragma unroll 1
        for (int n0 = 0; n0 < 128; n0 += 32) { float kv[32], dc[32];
#pragma unroll
            for (int j = 0; j < 32; ++j) { kv[j] = base[(size_t)(n0 + j) * 2048]; dc[j] = dec[(n0 + j) * 32]; }
#pragma unroll
            for (int j = 0; j < 32; ++j) { base[(size_t)(n0 + j) * 2048] = s; s = dc[j] * s + kv[j]; } }
    } else if (wg < 128) {
        const int w2 = wg - 64, bh = w2 >> 2, h = bh & 3, elem = (w2 & 3) * 512 + tid;
        float* base = (float*)(p.ws + WS_RKV) + (size_t)bh * 64 * 2048 + elem; const float dc = __builtin_amdgcn_exp2f(128.0f * p.ret_lg2[h]);
        float s = 0.f;
#pragma unroll 1
        for (int n0 = 0; n0 < 64; n0 += 32) { float kv[32];
#pragma unroll
            for (int j = 0; j < 32; ++j) kv[j] = base[(size_t)(n0 + j) * 2048];
#pragma unroll
            for (int j = 0; j < 32; ++j) { base[(size_t)(n0 + j) * 2048] = s; s = dc * s + kv[j]; } }
    }
}

__device__ __forceinline__ void kmean_unit(KPRef p, float* sm, int unit, int tid) {
    const bf16_t* z = (const bf16_t*)(p.ws + WS_Z); const size_t t0 = (size_t)unit * 256;
    const int oct = tid & 31, grp = tid >> 5; float s[8] = {0.f, 0.f, 0.f, 0.f, 0.f, 0.f, 0.f, 0.f};
    u32x4 q[16];
#pragma unroll
    for (int i = 0; i < 16; ++i) q[i] = *(const u32x4*)(z + (t0 + grp * 16 + i) * ZLD + Z_MK + 8 * oct);
#pragma unroll
    for (int i = 0; i < 16; ++i) { float v[8]; unpack8f(v, q[i]);
#pragma unroll
        for (int e = 0; e < 8; ++e) s[e] += v[e]; }
#pragma unroll
    for (int e = 0; e < 8; ++e) sm[grp * 264 + 8 * oct + e] = s[e];
    __syncthreads();
    if (tid < 256) { float a = 0.f;
#pragma unroll
        for (int g2 = 0; g2 < 16; ++g2) a += sm[g2 * 264 + tid];
        ((float*)(p.ws + WS_KMEAN))[(size_t)unit * 256 + tid] = a * (1.0f / 256.0f); }
    __syncthreads();
}

constexpr int AT_BUF = 65536  , AT_PW = 131072, AT_PW_WAVE = 2304, AT_WSF = 149504, LDS_MTAB = 151552;
__device__ __forceinline__ void att_dma(unsigned char* lds, int buf, const bf16_t* kg, const bf16_t* vg, int key_lo_valid, int tid) {
    const int lane = tid & 63, wave = __builtin_amdgcn_readfirstlane(tid >> 6);
#pragma unroll
    for (int i = 0; i < 4; ++i) { const int j = wave * 4 + i, row = 8 * j + (lane >> 3), pos = lane & 7; const int srow = row < key_lo_valid ? key_lo_valid : row;
        const size_t goff = (size_t)srow * ZLD + 8 * (pos ^ (row & 7));
        __builtin_amdgcn_global_load_lds((const unsigned*)(kg + goff), (LAS unsigned*)(LAS unsigned char*)(lds + buf * AT_BUF + j * 1024), 16, 0, 0);
        __builtin_amdgcn_global_load_lds((const unsigned*)(vg + goff), (LAS unsigned*)(LAS unsigned char*)(lds + buf * AT_BUF + 32768 + j * 1024), 16, 0, 0); }
}
struct QPtrs { const bf16_t* p[2]; int tag[2]; };
template <class Fn>
__device__ __forceinline__ QPtrs att_qptrs(const Fn& F, int tid) {
    const int lane = tid & 63, wave = __builtin_amdgcn_readfirstlane(tid >> 6), c16 = lane & 15; QPtrs q;
#pragma unroll
    for (int rt = 0; rt < 2; ++rt) { q.tag[rt] = F.rowtag(32 * wave + 16 * rt + c16); q.p[rt] = F.rowptr(32 * wave + 16 * rt + c16, q.tag[rt]); }
    return q;
}
__device__ __forceinline__ void att_loadq(bf16x8 (&Q)[2][2], const QPtrs& qp, int tid) {
    const int g = (tid & 63) >> 4;
#pragma unroll
    for (int rt = 0; rt < 2; ++rt) { Q[rt][0] = *(const bf16x8*)(qp.p[rt] + 8 * g); Q[rt][1] = *(const bf16x8*)(qp.p[rt] + 32 + 8 * g); }
}
__device__ __forceinline__ bf16x8 tr_frag_sw(const unsigned char* tile, int rowa, int rowb, int col0, int lane) {
    const int i = lane & 15, q = i >> 2, pp = i & 3, ch = (col0 >> 3) + (pp >> 1), sub = (pp & 1) * 8, ra = rowa + q, rb = rowb + q;
    const v4i16_t lo = lds_tr16((const bf16_t*)(tile + ra * 128 + ((ch ^ (ra & 7)) << 4) + sub)), hi = lds_tr16((const bf16_t*)(tile + rb * 128 + ((ch ^ (rb & 7)) << 4) + sub));
    return (bf16x8){lo[0], lo[1], lo[2], lo[3], hi[0], hi[1], hi[2], hi[3]};
}
__device__ __forceinline__ unsigned cvt_pk_c(float lo, float hi) { return pg8::cvt_pk_bf16(lo, hi); }
__device__ __forceinline__ float max3f_(float a, float b2, float c) { return __builtin_fmaxf(__builtin_fmaxf(a, b2), c); }
template <class Fn>
__device__ __forceinline__ void att_compute(unsigned char* lds, int buf, const Fn& F, bf16x8 (&Q)[2][2], const QPtrs& qcur, const QPtrs& qnext, bool has_next, int tid) {
    const int lane = tid & 63, wave = __builtin_amdgcn_readfirstlane(tid >> 6), c16 = lane & 15, g = lane >> 4;
    const unsigned char* KS = lds + buf * AT_BUF; const unsigned char* VS = KS + 32768; bf16_t* PW = (bf16_t*)(lds + AT_PW + wave * AT_PW_WAVE); float* WSF = (float*)(lds + AT_WSF + wave * 256);
#pragma unroll 1
    for (int rt = 0; rt < 2; ++rt) {
        const int rbase = 32 * wave + 16 * rt;
        const typename Fn::Pre pre = F.prefetch(rbase, lane);
        const bf16x8 qa0 = rt ? Q[1][0] : Q[0][0], qa1 = rt ? Q[1][1] : Q[0][1];
        f32x4 S[16]; float m = -1e30f;
#pragma unroll
        for (int ct = 0; ct < 16; ++ct) {
            if (F.live(rbase, ct)) {
                const int R = 16 * ct + c16; const unsigned char* kp = KS + R * 128;
                const bf16x8 k0 = *(const bf16x8*)(kp + ((g ^ (R & 7)) << 4)), k1 = *(const bf16x8*)(kp + (((4 + g) ^ (R & 7)) << 4));
                f32x4 acc = (f32x4){0.f, 0.f, 0.f, 0.f}; acc = MFMA16(k0, qa0, acc); acc = MFMA16(k1, qa1, acc);
                if (Fn::MASKED) { if (F.partial(rbase, ct)) {
#pragma unroll
                    for (int r = 0; r < 4; ++r) { int kk = 16 * ct + 4 * g + r; asm volatile("" : "+v"(kk), "+v"(acc[r]));
                        acc[r] += F.pen(rbase + c16, kk); } } }
                m = max3f_(m, max3f_(acc[0], acc[1], acc[2]), acc[3]); S[ct] = acc;
            } else S[ct] = (f32x4){-1e30f, -1e30f, -1e30f, -1e30f};
        }
        if (rt == 1 && has_next) att_loadq(Q, qnext, tid);
        m = fmaxf(m, __shfl_xor(m, 16)); m = fmaxf(m, __shfl_xor(m, 32));
        u32x2 Pk[16];
#pragma unroll
        for (int ct = 0; ct < 16; ++ct) {
            if (F.live(rbase, ct)) { const float p0 = __builtin_amdgcn_exp2f(S[ct][0] - m), p1 = __builtin_amdgcn_exp2f(S[ct][1] - m), p2 = __builtin_amdgcn_exp2f(S[ct][2] - m), p3 = __builtin_amdgcn_exp2f(S[ct][3] - m);
                Pk[ct].x = cvt_pk_c(p0, p1); Pk[ct].y = cvt_pk_c(p2, p3);
            } else Pk[ct] = (u32x2){0u, 0u};
        }
        f32x4 O[4], OL = (f32x4){0.f, 0.f, 0.f, 0.f};
        const bf16x8 ones = (bf16x8){0x3F80, 0x3F80, 0x3F80, 0x3F80, 0x3F80, 0x3F80, 0x3F80, 0x3F80};
#pragma unroll
        for (int dt = 0; dt < 4; ++dt) O[dt] = (f32x4){0.f, 0.f, 0.f, 0.f};
#pragma unroll
        for (int s8 = 0; s8 < 8; ++s8) if (F.live(rbase, 2 * s8) || F.live(rbase, 2 * s8 + 1)) { const bf16x8 pa = __builtin_bit_cast(bf16x8, ((u32x4){Pk[2 * s8].x, Pk[2 * s8].y, Pk[2 * s8 + 1].x, Pk[2 * s8 + 1].y}));
            OL = MFMA16(pa, ones, OL);
#pragma unroll
            for (int dt = 0; dt < 4; ++dt) O[dt] = MFMA16(pa, tr_frag_sw(VS, 32 * s8 + 4 * g, 32 * s8 + 16 + 4 * g, 16 * dt, lane), O[dt]); }
        float f[4];
        const int mytag = rt ? qcur.tag[1] : qcur.tag[0];
#pragma unroll
        for (int r = 0; r < 4; ++r) { const float mr = __shfl(m, 4 * g + r); const int tg = __shfl(mytag, 4 * g + r); f[r] = F.scale(rbase + 4 * g + r, mr, OL[r], pre, r, WSF + (4 * g + r) * 4, c16 == 0, tg); }
#pragma unroll
        for (int dt = 0; dt < 4; ++dt)
#pragma unroll
            for (int r = 0; r < 4; ++r) PW[(4 * g + r) * 72 + 16 * dt + c16] = (bf16_t)f2bf(O[dt][r] * f[r]);
        LDS_WAIT();
#pragma unroll
        for (int i = 0; i < 2; ++i) { const int ch = lane + 64 * i, row = ch >> 3, oct = ch & 7;
            const u32x4 v = *(const u32x4*)(PW + row * 72 + 8 * oct); F.store(rbase + row, oct, v, pre, i, WSF + row * 4, __shfl(mytag, row)); }
        LDS_WAIT();
    }
}
template <class Fn, class Gen>
__device__ __forceinline__ void attn_loop(unsigned char* lds, const Gen& G, int tid) {
    Fn Fc, Fx; const bf16_t* kg; const bf16_t* vg; int lo;
    bool have = G.get(0, Fc, kg, vg, lo);
    if (!have) return;
    bf16x8 Q[2][2];
    QPtrs qc = att_qptrs(Fc, tid);
    att_dma(lds, 0, kg, vg, lo, tid); att_loadq(Q, qc, tid);
    int buf = 0;
    for (int i = 1; have; ++i) {
        asm volatile("s_waitcnt vmcnt(0)" ::: "memory");
        __syncthreads();
        const bool hn = G.get(i, Fx, kg, vg, lo);
        QPtrs qn = qc;
        if (hn) { att_dma(lds, buf ^ 1, kg, vg, lo, tid); qn = att_qptrs(Fx, tid); }
        att_compute(lds, buf, Fc, Q, qc, qn, hn, tid);
        Fc = Fx; have = hn; buf ^= 1; qc = qn;
    }
    asm volatile("s_waitcnt vmcnt(0)" ::: "memory");
    __syncthreads();
}
struct NoPre {};

struct SwaFn { typedef NoPre Pre; static constexpr bool MASKED = true;
    __device__ __forceinline__ bool live(int rbase, int ct) const { const int i0 = rbase & 127; return 16 * ct + 15 >= i0 + 1 && 16 * ct <= i0 + 143 && (q0 != 0 || ct >= 8); }
    __device__ __forceinline__ bool partial(int rbase, int ct) const { const int t0_ = (rbase & 127) >> 4; return ct == t0_ || ct == t0_ + 8; }     const bf16_t* z; bf16_t* ob; size_t tb; int q0, kvh; float sink2_0, sink2_1;
    __device__ __forceinline__ int rowtag(int) const { return 0; }
    __device__ __forceinline__ const bf16_t* rowptr(int row, int) const { return z + (tb + q0 + (row & 127)) * ZLD + Z_SQ + (kvh * 2 + (row >> 7)) * 64; }
    __device__ __forceinline__ float pen(int row, int kk) const { const int d = (row & 127) + 128 - kk; return __int_as_float(((d | (127 - d) | (q0 - 128 + kk)) >> 31) & (int)0xF149F2CAu); }
    __device__ __forceinline__ NoPre prefetch(int, int) const { return NoPre{}; }
    __device__ __forceinline__ float scale(int row, float m, float l, const NoPre&, int, float*, bool, int) const { const float sk = (row >> 7) ? sink2_1 : sink2_0; const float M = fmaxf(m, sk), w0 = __builtin_amdgcn_exp2f(m - M);
        return w0 / (l * w0 + __builtin_amdgcn_exp2f(sk - M)); }
    __device__ __forceinline__ void store(int row, int oct, u32x4 v, const NoPre&, int, const float*, int) const { *(u32x4*)(ob + (tb + q0 + (row & 127)) * OLD + 256 + (kvh * 2 + (row >> 7)) * 64 + 8 * oct) = v; }
};
struct SwaGen { const bf16_t* z; bf16_t* ob; const float* sinks; int wg, G;
    __device__ __forceinline__ bool get(int i, SwaFn& F, const bf16_t*& kg, const bf16_t*& vg, int& lo) const {
        const int unit = wg + i * G; if (unit >= 512) return false;
        const int qb = unit & 63, kvh = (unit >> 6) & 1, b = unit >> 7; const size_t tb = (size_t)b * S_; const int q0 = qb * 128;
        F = SwaFn{z, ob, tb, q0, kvh, sinks[kvh * 2] * LOG2E, sinks[kvh * 2 + 1] * LOG2E};
        const long kb = (long)tb + q0 - 128;
        kg = z + kb * ZLD + Z_SK + kvh * 64; vg = z + kb * ZLD + Z_SV + kvh * 64; lo = (q0 == 0) ? 128 : 0; return true; }
};

constexpr int ML_PER_BH = 126976;
__device__ __forceinline__ int ml_off(int j) { return 256 * (31 * j - (j * (j - 1)) / 2); }
__device__ __forceinline__ void moba_select(KPRef p, unsigned char* lds, int wg, int tid) {
    const int gid = wg * NTHREADS + tid, t = gid >> 2, h = gid & 3, b = t >> 13, tl = t & 8191, blk = tl >> 8;
    const bf16_t* z = (const bf16_t*)(p.ws + WS_Z);
    f32x4* kml = (f32x4*)lds; const f32x4* kmg = (const f32x4*)((const float*)(p.ws + WS_KMEAN) + (size_t)b * 32 * 256);
    for (int i = tid; i < blk * 64; i += NTHREADS) kml[i] = kmg[i];
    float q[64];
    { const bf16_t* qp = z + (size_t)t * ZLD + Z_MQ + h * 64;
#pragma unroll
      for (int c = 0; c < 8; ++c) { const u32x4 kk = *(const u32x4*)(qp + 8 * c);
        q[8 * c + 0] = __uint_as_float(kk.x << 16); q[8 * c + 1] = __uint_as_float(kk.x & 0xffff0000u); q[8 * c + 2] = __uint_as_float(kk.y << 16); q[8 * c + 3] = __uint_as_float(kk.y & 0xffff0000u);
        q[8 * c + 4] = __uint_as_float(kk.z << 16); q[8 * c + 5] = __uint_as_float(kk.z & 0xffff0000u); q[8 * c + 6] = __uint_as_float(kk.w << 16); q[8 * c + 7] = __uint_as_float(kk.w & 0xffff0000u); } }
    __syncthreads();
    float v0 = -3e38f, v1 = -3e38f, v2 = -3e38f; int i0 = -1, i1 = -1, i2 = -1;
#pragma unroll 1
    for (int nb = 0; nb < blk; ++nb) { const f32x4* kr = kml + nb * 64 + h * 16; float s = 0.f;
#pragma unroll
        for (int c = 0; c < 16; ++c) { const f32x4 kv = kr[c]; s += q[4 * c] * kv[0] + q[4 * c + 1] * kv[1] + q[4 * c + 2] * kv[2] + q[4 * c + 3] * kv[3]; }
        if (s > v0) { v2 = v1; i2 = i1; v1 = v0; i1 = i0; v0 = s; i0 = nb; } else if (s > v1) { v2 = v1; i2 = i1; v1 = s; i1 = nb; } else if (s > v2) { v2 = s; i2 = nb; } }
    int* cnt = (int*)(p.ws + WS_MCNT) + (b * 4 + h) * 32; int* lst = (int*)(p.ws + WS_MLIST) + (size_t)(b * 4 + h) * ML_PER_BH; f32x2* pml = (f32x2*)(p.ws + WS_PARTML) + (size_t)gid * 3;
#pragma unroll
    for (int s3 = 0; s3 < 3; ++s3) { const int sb = (s3 == 0) ? i0 : (s3 == 1 ? i1 : i2);
        if (sb >= 0) { const int pos = atomicAdd(cnt + sb, 1); lst[ml_off(sb) + pos] = tl | (s3 << 13); }
        else { float ng_ = -1e30f, zr_ = 0.f; asm volatile("" : "+v"(ng_), "+v"(zr_)); pml[s3] = (f32x2){ng_, zr_}; } }
    __syncthreads();
}
struct MobaSelFn { typedef NoPre Pre; static constexpr bool MASKED = false;
    __device__ __forceinline__ bool live(int, int) const { return true; }
    __device__ __forceinline__ bool partial(int, int) const { return false; } const bf16_t* z; const int* lst; bf16_t* po; f32x2* pml; size_t tb; int h, n_valid;
    __device__ __forceinline__ int entry(int row) const { return lst[row < n_valid ? row : 0]; }
    __device__ __forceinline__ int rowtag(int row) const { return entry(row); }
    __device__ __forceinline__ const bf16_t* rowptr(int, int e) const { return z + (tb + (e & 8191)) * ZLD + Z_MQ + h * 64; }
    __device__ __forceinline__ float pen(int, int) const { return 0.f; }
    __device__ __forceinline__ NoPre prefetch(int, int) const { return NoPre{}; }
    __device__ __forceinline__ size_t pidx(int e) const { return ((tb + (e & 8191)) * 4 + h) * 3 + (e >> 13); }
    __device__ __forceinline__ float scale(int row, float m, float l, const NoPre&, int, float*, bool writer, int e) const { if (writer && row < n_valid) pml[pidx(e)] = (f32x2){m, l}; return 1.0f / l; }
    __device__ __forceinline__ void store(int row, int oct, u32x4 v, const NoPre&, int, const float*, int e) const { if (row < n_valid) *(u32x4*)(po + pidx(e) * 64 + 8 * oct) = v; }
};
__device__ __forceinline__ void moba_sel_table(KPRef p, unsigned char* lds, int tid) {
    int* tab = (int*)(lds + LDS_MTAB); const int lane = tid & 63, wave = tid >> 6;
    const int cnt = ((const int*)(p.ws + WS_MCNT))[tid]; int v = (cnt + 255) >> 8;
    const int own = v;
#pragma unroll
    for (int o = 1; o < 64; o <<= 1) { const int t = __shfl_up(v, o); if (lane >= o) v += t; }
    if (lane == 63) tab[520 + wave] = v;
    __syncthreads();
    int base = 0;
    for (int w = 0; w < wave; ++w) base += tab[520 + w];
    tab[tid] = base + v - own;
    tab[544 + tid] = cnt;
    if (tid == 511) tab[512] = base + v;
    __syncthreads();
}
struct MobaSelGen { const bf16_t* z; const int* lists; const int* cnts; bf16_t* po; f32x2* pml; const int* tab; int wg, G;
    __device__ __forceinline__ bool get(int i, MobaSelFn& F, const bf16_t*& kg, const bf16_t*& vg, int& lo) const {
        const int u = wg + i * G; if (u >= tab[512]) return false;
        int lo_ = 0, hi_ = 511;
        while (lo_ < hi_) { const int mid = (lo_ + hi_ + 1) >> 1; if (tab[mid] <= u) lo_ = mid; else hi_ = mid - 1; }
        const int k = __builtin_amdgcn_readfirstlane(lo_), c = u - tab[k], bh = k >> 5, j = k & 31, b = bh >> 2, h = bh & 3;
        const int cnt = tab[544 + k]; const int nv = cnt - c * 256; const size_t tb = (size_t)b * S_;
        F = MobaSelFn{z, lists + (size_t)bh * ML_PER_BH + ml_off(j) + c * 256, po, pml, tb, h, nv < 256 ? nv : 256};
        kg = z + (tb + j * 256) * ZLD + Z_MK + h * 64; vg = z + (tb + j * 256) * ZLD + Z_MV + h * 64; lo = 0; return true; }
};
struct MobaOwnFn { typedef NoPre Pre; static constexpr bool MASKED = true;
    __device__ __forceinline__ bool live(int rbase, int ct) const { return 16 * ct <= rbase + 15; }
    __device__ __forceinline__ bool partial(int rbase, int ct) const { return 16 * ct == rbase; }     const bf16_t* z; bf16_t* ob; const bf16_t* po; const f32x2* pml; size_t t0; int h;
    __device__ __forceinline__ int rowtag(int) const { return 0; }
    __device__ __forceinline__ const bf16_t* rowptr(int row, int) const { return z + (t0 + row) * ZLD + Z_MQ + h * 64; }
    __device__ __forceinline__ float pen(int row, int kk) const { return __int_as_float(((row - kk) >> 31) & (int)0xF149F2CAu); }
    __device__ __forceinline__ NoPre prefetch(int, int) const { return NoPre{}; }
    __device__ __forceinline__ float scale(int row, float m, float l, const NoPre&, int, float* wsf, bool writer, int) const {
        const f32x2* ml = pml + ((t0 + row) * 4 + h) * 3; const f32x2 a = ml[0], b = ml[1], c = ml[2];
        const float M = fmaxf(fmaxf(m, a[0]), fmaxf(b[0], c[0]));
        const float w0 = __builtin_amdgcn_exp2f(m - M), wa = a[1] * __builtin_amdgcn_exp2f(a[0] - M), wb = b[1] * __builtin_amdgcn_exp2f(b[0] - M), wc = c[1] * __builtin_amdgcn_exp2f(c[0] - M);
        const float inv = 1.0f / (l * w0 + wa + wb + wc);
        if (writer) { wsf[0] = wa * inv; wsf[1] = wb * inv; wsf[2] = wc * inv; }
        return w0 * inv; }
    __device__ __forceinline__ void store(int row, int oct, u32x4 v, const NoPre&, int, const float* wsf, int) const {
        float o[8]; unpack8f(o, v); const bf16_t* pr = po + (((t0 + row) * 4 + h) * 3) * 64 + 8 * oct;
        u32x4 pc[3];
#pragma unroll
        for (int s = 0; s < 3; ++s) pc[s] = (wsf[s] != 0.f) ? *(const u32x4*)(pr + s * 64) : (u32x4){0u, 0u, 0u, 0u};
#pragma unroll
        for (int s = 0; s < 3; ++s) { const float w = wsf[s]; float q[8]; unpack8f(q, pc[s]);
#pragma unroll
            for (int e = 0; e < 8; ++e) o[e] += w * q[e]; }
        *(u32x4*)(ob + (t0 + row) * OLD + 512 + h * 64 + 8 * oct) = pack8f(o); }
};
struct MobaOwnGen { const bf16_t* z; bf16_t* ob; const bf16_t* po; const f32x2* pml; int wg, G;
    __device__ __forceinline__ bool get(int i, MobaOwnFn& F, const bf16_t*& kg, const bf16_t*& vg, int& lo) const {
        const int unit = wg + i * G; if (unit >= 512) return false;
        const int qb = unit & 31, h = (unit >> 5) & 3, b = unit >> 7; const size_t t0 = (size_t)b * S_ + (size_t)qb * 256;
        F = MobaOwnFn{z, ob, po, pml, t0, h}; kg = z + t0 * ZLD + Z_MK + h * 64; vg = z + t0 * ZLD + Z_MV + h * 64; lo = 0; return true; }
};

__device__ __forceinline__ void route_phase(KPRef p, int l, float* sm, int wg, int tid) {
    int* se = (int*)sm;
    int* toke = (int*)(p.ws + WS_TOKE); float* tokw = (float*)(p.ws + WS_TOKW); int* tokr = (int*)(p.ws + WS_TOKR); int* hist = (int*)(p.ws + WS_HIST); int* sdst = (int*)(p.ws + WS_SDST);
    if (tid < 128) { const int t = wg * 128 + tid; const float* lg = (const float*)(p.ws + WS_LOGIT) + (size_t)t * 64; const float* bg = p.in[12] + l * 4; const float* be = p.in[14] + l * 32;
        float g0 = lg[0] + bg[0], g1 = lg[1] + bg[1], g2 = lg[2] + bg[2], g3 = lg[3] + bg[3];
        int gs = 0; float gm = g0; if (g1 > gm) { gm = g1; gs = 1; } if (g2 > gm) { gm = g2; gs = 2; } if (g3 > gm) { gm = g3; gs = 3; }
        const float gw_ = 1.0f / (expf(g0 - gm) + expf(g1 - gm) + expf(g2 - gm) + expf(g3 - gm));
        float v0 = -3e38f, v1 = -3e38f; int i0 = 0, i1 = 0;
#pragma unroll
        for (int j = 0; j < 8; ++j) { const float s = lg[4 + 8 * gs + j] + be[8 * gs + j]; if (s > v0) { v1 = v0; i1 = i0; v0 = s; i0 = j; } else if (s > v1) { v1 = s; i1 = j; } }
        const float e1 = expf(v1 - v0), w0 = 1.0f / (1.0f + e1), w1 = e1 * w0;
        const int ea = 8 * gs + i0, eb = 8 * gs + i1;
        se[2 * tid] = ea; se[2 * tid + 1] = eb; toke[2 * t] = ea; toke[2 * t + 1] = eb; tokw[2 * t] = w0 * gw_; tokw[2 * t + 1] = w1 * gw_; }
    __syncthreads();
    if (tid < 256) { const int e = se[tid]; int r = 0;
#pragma unroll 4
        for (int a = 0; a < tid; ++a) r += (se[a] == e) ? 1 : 0; tokr[wg * 256 + tid] = r; }
    if (tid >= 256 && tid < 288) { const int e = tid - 256; int c = 0;
#pragma unroll 4
        for (int a = 0; a < 256; ++a) c += (se[a] == e) ? 1 : 0; hist[wg * 32 + e] = c; }
    for (int i = tid; i < NSLOTBLK; i += NTHREADS) sdst[wg * NSLOTBLK + i] = YS_TRASH_ROW;
    __syncthreads();
}
__device__ __forceinline__ void assign_phase(KPRef p, float* sm, int wg, int tid, int wave, int lane) {
    int* cnt = (int*)sm, *bas = cnt + 32, *pend = cnt + 64, *slot_of = cnt + 128;
    const int* hist = (const int*)(p.ws + WS_HIST); const int* toke = (const int*)(p.ws + WS_TOKE); const int* tokr = (const int*)(p.ws + WS_TOKR);
    int* sdst = (int*)(p.ws + WS_SDST); int* blke = (int*)(p.ws + WS_BLKE);
    {
        int* part = cnt + 512;
        const int e = tid & 31, grp = tid >> 5; int c = 0, bb = 0; int v[16];
#pragma unroll
        for (int i = 0; i < 16; ++i) v[i] = hist[(grp * 16 + i) * 32 + e];
#pragma unroll
        for (int i = 0; i < 16; ++i) { c += v[i]; if (grp * 16 + i < wg) bb += v[i]; }
        part[grp * 64 + e] = c; part[grp * 64 + 32 + e] = bb;
        __syncthreads();
        if (tid < 32) { int cs = 0, bs = 0;
#pragma unroll
            for (int g2 = 0; g2 < 16; ++g2) { cs += part[g2 * 64 + tid]; bs += part[g2 * 64 + 32 + tid]; }
            cnt[tid] = cs; bas[tid] = bs; }
    }
    __syncthreads();
    if (tid == 0) { int run = 0; for (int e = 0; e < 32; ++e) { const int pad = ((cnt[e] + 255) >> 8) << 8; bas[e] += run; run += pad; pend[e] = run; } }
    __syncthreads();
    if (wg == 0) { if (tid < NSLOTBLK) { int e = 0; for (int k = 0; k < 32; ++k) e += (pend[k] <= tid * 256) ? 1 : 0; blke[tid] = e > 31 ? 31 : e; } if (tid == 0) blke[511] = pend[31] >> 8; }
    if (tid < 256) { const int a = wg * 256 + tid; const int e = toke[a]; const int slot = bas[e] + tokr[a]; sdst[slot] = a; slot_of[tid] = slot; }
    __syncthreads();
    const float* su = (const float*)(p.ws + WS_SU); float* xss = (float*)(p.ws + WS_XSS);
    if (tid < 256) xss[slot_of[tid]] = su[wg * 128 + (tid >> 1)];
    __syncthreads();
}

#ifndef MK_PER_PHASE
#define MK_PER_PHASE 0
#endif
constexpr int PH_PER_LAYER = 18, N_PHASES = DEPTH_ * PH_PER_LAYER + 1;
constexpr int CW_BAR = 1024;

__global__ void __launch_bounds__(NTHREADS, 2) mega(Params p_unused) {
    extern __shared__ __attribute__((aligned(16))) unsigned char lds[];
    const int tid0 = threadIdx.x;
    constexpr int G = 256, NGW = G * NWAVES;
    const int wg = blockIdx.x;
#define SUB_BEGIN() KPRef p = *KP(); unsigned char* ws = p.ws; (void)ws; int tid = threadIdx.x; asm volatile("" : "+v"(tid))
#define PHASE_BEGIN() KPRef p = *KP(); unsigned char* ws = p.ws; (void)ws; unsigned char* wl = (l == 0) ? p.ws : (unsigned char*)p.out; (void)wl; const size_t sl = (size_t)l * SW_LSTEP; (void)sl; int tid = threadIdx.x; asm volatile("" : "+v"(tid)); const int lane = tid & 63, wave = __builtin_amdgcn_readfirstlane(tid >> 6), gw = wg * NWAVES + wave; (void)lane; (void)gw
    volatile LAS unsigned* MISC = (volatile LAS unsigned*)((LAS unsigned char*)lds + MISC_OFF);
    for (int u = tid0; u < (LDS_BYTES - LDSCTL_OFF) / 4; u += NTHREADS) ((LAS unsigned*)((LAS unsigned char*)lds + LDSCTL_OFF))[u] = 0u;
    __syncthreads();
#define KP() ({ const __attribute__((address_space(4))) Params* _k = (const __attribute__((address_space(4))) Params*)__builtin_amdgcn_kernarg_segment_ptr(); asm volatile("" : "+s"(_k)); _k; })
    unsigned* ctl; { const __attribute__((address_space(4))) Params* k0 = KP(); ctl = (unsigned*)(k0->ws + WS_CTL); }
    XcdBarrier bar = xcd_barrier_post(ctl + CW_BAR, MISC + 8);
    int lo, hi; { const __attribute__((address_space(4))) Params* k0 = KP(); lo = k0->ph_lo; hi = k0->ph_hi; }
    float* sm = (float*)lds;
    PG8_LAS unsigned char* ring = (PG8_LAS unsigned char*)lds;
#ifndef PH_MASK
#define PH_MASK 0x7ffffu
#endif
#define IN(k) ((((PH_MASK) >> ((k) == DEPTH_ * PH_PER_LAYER ? 18 : ((k) % PH_PER_LAYER))) & 1u) && lo <= (k) && (k) < hi)
#define SEAM(k) do { if ((k) + 1 < hi) xcd_barrier(bar); } while (0)
#ifndef REPEAT_MASK
#define REPEAT_MASK 0u
#endif
#ifndef URM
#define URM 0u
#endif
#define UREP(bit) for (int ur_ = 0; ur_ < ((((URM) >> (bit)) & 1u) ? 2 : 1); ++ur_)
#ifndef REPEAT_L0
#define REPEAT_L0 0u
#endif
#define NREP(k) (((((REPEAT_MASK) >> ((k) % PH_PER_LAYER)) & 1u) || ((((REPEAT_L0) >> ((k) % PH_PER_LAYER)) & 1u) && (k) < PH_PER_LAYER)) ? 2 : 1)

    for (int l = 0; l < DEPTH_; ++l) {
        const int P0 = l * PH_PER_LAYER;
        if (IN(P0 + 0)) for (int rep_ = 0; rep_ < NREP(P0 + 0); ++rep_) { PHASE_BEGIN();
            if (l == 0) { UREP(8) { conv8_phase(p, 0, ws, lds, wg, G, wave, lane, 0, 736); conv_phase(p, 0, ws, lds, gw, NGW, wave, lane); } }
            if (l == 0) norm_phase<0>(p, l, gw, NGW, lane); else norm_phase<1>(p, l, gw, NGW, lane);
            SEAM(P0 + 0);
        }
        if (IN(P0 + 2)) for (int rep_ = 0; rep_ < NREP(P0 + 2); ++rep_) { PHASE_BEGIN();
            pg8::Gemm g{(const bf16_t*)(ws + WS_U8), (const bf16_t*)(wl + WS_WIN)};
            pg8::StaticOrder<T_ / 256, ZW / 256, 1024, 1024> S{G, wg, 0};
            pg8::EpiBf16S E{(bf16_t*)(ws + WS_Z), ZLD, (const float*)(ws + WS_SU), (const float*)(ws + WS_SWIN + sl)};
            pg8::gemm_phase<1024, 1024, 1024, true, true>(ring, g, S, E);
            SEAM(P0 + 2);
        }
        if (IN(P0 + 3)) for (int rep_ = 0; rep_ < NREP(P0 + 3); ++rep_) { PHASE_BEGIN();
            if (wg == 0) { int* cnt = (int*)(ws + WS_MCNT); cnt[tid] = 0; }
            UREP(0) { SUB_BEGIN(); la_loop<0>(p, l, lds, wg, tid); }
            UREP(1) { SUB_BEGIN(); la_loop<1>(p, l, lds, wg, tid); }
            UREP(2) { SUB_BEGIN(); for (int u = wg; u < 128; u += G) kmean_unit(p, sm, u, tid); }
            UREP(3) { SUB_BEGIN(); SwaGen SG{(const bf16_t*)(ws + WS_Z), (bf16_t*)(ws + WS_O), p.in[6] + l * 4, wg, G}; attn_loop<SwaFn>(lds, SG, tid); }
            SEAM(P0 + 3);
        }
        if (IN(P0 + 4)) for (int rep_ = 0; rep_ < NREP(P0 + 4); ++rep_) { PHASE_BEGIN(); moba_select(p, lds, wg, tid); { const int s = ((wg & 63) < 32) ? (wg >> 6) * 32 + (wg & 31) : 255; scan_phase(p, s, tid); }   SEAM(P0 + 4); }
        if (IN(P0 + 5)) for (int rep_ = 0; rep_ < NREP(P0 + 5); ++rep_) { PHASE_BEGIN();
            UREP(4) { SUB_BEGIN(); la_loop<2>(p, l, lds, wg, tid); }
            UREP(5) { SUB_BEGIN(); la_loop<3>(p, l, lds, wg, tid); }
            UREP(6) { SUB_BEGIN(); moba_sel_table(p, lds, tid); MobaSelGen MG{(const bf16_t*)(ws + WS_Z), (const int*)(ws + WS_MLIST), (const int*)(ws + WS_MCNT), (bf16_t*)(ws + WS_PARTO), (f32x2*)(ws + WS_PARTML), (const int*)(lds + LDS_MTAB), wg, G}; attn_loop<MobaSelFn>(lds, MG, tid); }
            SEAM(P0 + 5);
        }
        if (IN(P0 + 6)) for (int rep_ = 0; rep_ < NREP(P0 + 6); ++rep_) { PHASE_BEGIN();
            UREP(7) { SUB_BEGIN(); MobaOwnGen OG{(const bf16_t*)(ws + WS_Z), (bf16_t*)(ws + WS_O), (const bf16_t*)(ws + WS_PARTO), (const f32x2*)(ws + WS_PARTML), wg, G}; attn_loop<MobaOwnFn>(lds, OG, tid); }
            SEAM(P0 + 6);
        }
        for (int hf = 0; hf < 2; ++hf) {
            if (IN(P0 + 7 + 2 * hf)) for (int rep_ = 0; rep_ < NREP(P0 + 7 + 2 * hf); ++rep_) { PHASE_BEGIN();
                pg8::Gemm g{(const bf16_t*)(ws + WS_O), (const bf16_t*)(wl + WS_WB)};
                pg8::StaticOrder<T_ / 512, 16, 2 * OLD, 512, 2, 512> S{G, wg, 64 * hf};
                pg8::EpiBf16 E{(bf16_t*)(ws + WS_YH), pg8::YLD, 16384 * hf};
                pg8::gemm_phase<2 * OLD, 512, 512, false, true>(ring, g, S, E);
                SEAM(P0 + 7 + 2 * hf);
            }
            if (IN(P0 + 8 + 2 * hf)) for (int rep_ = 0; rep_ < NREP(P0 + 8 + 2 * hf); ++rep_) { PHASE_BEGIN();
                pg8::Gemm g{(const bf16_t*)(ws + WS_U8), (const bf16_t*)(wl + WS_WG)};
                pg8::StaticOrder<T_ / 512, 16, 1024, 1024> S{G, wg, 64 * hf};
                pg8::EpiGate E{(const bf16_t*)(ws + WS_YH), 16384 * hf, (bf16_t*)(ws + WS_O), (const float*)(ws + WS_SU), (const float*)(ws + WS_SWG + sl)};
                pg8::gemm_phase<1024, 1024, 1024, true, true>(ring, g, S, E);
                SEAM(P0 + 8 + 2 * hf);
            }
        }
        if (IN(P0 + 11)) for (int rep_ = 0; rep_ < NREP(P0 + 11); ++rep_) { PHASE_BEGIN();
            pg8::Gemm g{(const bf16_t*)(ws + WS_O), (const bf16_t*)(wl + WS_WO)};
            pg8::StaticOrder<T_ / 256, 4, 2 * OLD, 2048> S{G, wg, 0};
            if (l == 0) { pg8::EpiRes<true> E{(const void*)p.in[0], hbf_ptr(p)}; pg8::gemm_phase<2 * OLD, 2048, 2048, false, true>(ring, g, S, E); }
            else { pg8::EpiRes<false> E{(const void*)hbf_ptr(p), hbf_ptr(p)}; pg8::gemm_phase<2 * OLD, 2048, 2048, false, true>(ring, g, S, E); }
            SEAM(P0 + 11);
        }
        if (IN(P0 + 12)) for (int rep_ = 0; rep_ < NREP(P0 + 12); ++rep_) { PHASE_BEGIN(); norm_phase<2>(p, l, gw, NGW, lane); SEAM(P0 + 12); }
        if (IN(P0 + 13)) for (int rep_ = 0; rep_ < NREP(P0 + 13); ++rep_) { PHASE_BEGIN();
            pg8::Gemm g{(const bf16_t*)hbf_ptr(p), (const bf16_t*)(wl + WS_WR)};
            pg8::StaticOrder<T_ / 256, 1, 2048, 2048> S{G, wg, 0};
            pg8::EpiRouter E{(float*)(ws + WS_LOGIT), (const float*)(ws + WS_RSTD)};
            pg8::gemm_phase<2048, 2048, 2048, false>(ring, g, S, E);
            if (l == 0 && wg >= 128) { const int gw2 = (wg - 128) * NWAVES + wave; unsigned char* w1 = (unsigned char*)p.out;
                conv_phase(p, 1, w1, lds, gw2, 128 * NWAVES, wave, lane); }
            SEAM(P0 + 13);
        }
        if (IN(P0 + 14)) for (int rep_ = 0; rep_ < NREP(P0 + 14); ++rep_) { PHASE_BEGIN(); route_phase(p, l, sm, wg, tid); SEAM(P0 + 14); }
        if (IN(P0 + 15)) for (int rep_ = 0; rep_ < NREP(P0 + 15); ++rep_) { PHASE_BEGIN(); assign_phase(p, sm, wg, tid, wave, lane); SEAM(P0 + 15); }
        if (IN(P0 + 16)) for (int rep_ = 0; rep_ < NREP(P0 + 16); ++rep_) { PHASE_BEGIN();
            const int* blke = (const int*)(ws + WS_BLKE); const int nb = __builtin_amdgcn_readfirstlane(blke[511]);
            pg8::Gemm g{(const bf16_t*)(ws + WS_U8), (const bf16_t*)(wl + WS_E1)};
            pg8::MoeOrder<2, true> S{blke, nb, G, wg, (size_t)0, (size_t)256 * 1024, (size_t)512 * 1024, (const int*)(ws + WS_SDST)};
            pg8::EpiE1 E{(bf16_t*)(ws + WS_HDN), (const float*)(ws + WS_XSS), (const float*)(ws + WS_SWE1 + sl), blke};
            pg8::gemm_phase<1024, 1024, 1024, true, true>(ring, g, S, E);
            if (l == 0) {
                const int tot = nb * 2, numax = (tot + G - 1) / G; int th = tot - G * (numax - 1); if (th > 192) th = 0;
                if (wg >= th) conv8_phase(p, 1, (unsigned char*)p.out, lds, wg - th, G - th, wave, lane, 0, 736); }
            SEAM(P0 + 16);
        }
        if (IN(P0 + 17)) for (int rep_ = 0; rep_ < NREP(P0 + 17); ++rep_) { PHASE_BEGIN();
            const int* blke = (const int*)(ws + WS_BLKE); const int nb = __builtin_amdgcn_readfirstlane(blke[511]);
            pg8::Gemm g{(const bf16_t*)(ws + WS_HDN), (const bf16_t*)(wl + WS_E2)};
            pg8::MoeOrder<4> S{blke, nb, G, wg, (size_t)256 * 256 * 2, (size_t)256 * 256 * 2, (size_t)1024 * 256 * 2, nullptr};
            pg8::EpiE2 E{(bf16_t*)(ws + WS_YS), (const int*)(ws + WS_SDST)};
            pg8::gemm_phase<512, 512, 512, false, true>(ring, g, S, E);
            SEAM(P0 + 17);
        }
    }
    if (IN(DEPTH_ * PH_PER_LAYER)) { constexpr int l = 0; PHASE_BEGIN(); FinalHold Hd; final_a(p, gw, NGW, lane, Hd); xcd_barrier(bar); final_b(p, gw, lane, Hd); }
#undef IN
#undef SEAM
}

extern "C" void kernel_launch(void* const* d_in, const int* in_sizes, int n_in, void* d_out, int out_size, void* d_ws, size_t ws_size, hipStream_t stream) {
    static int grid = 0;
    if (grid == 0) {
        if (n_in != 19 || out_size != T_ * D_ || ws_size < WS_END) { fprintf(stderr, "kernel_launch: unexpected shapes (n_in %d, out %d, ws %zu); nothing launched\n", n_in, out_size, ws_size); grid = -1; return; }
        int dev = 0, cus = 0;
        if (hipGetDevice(&dev) != hipSuccess || hipDeviceGetAttribute(&cus, hipDeviceAttributeMultiprocessorCount, dev) != hipSuccess) { grid = -1; return; }
        if (hipFuncSetAttribute((const void*)mega, hipFuncAttributeMaxDynamicSharedMemorySize, LDS_BYTES) != hipSuccess) { fprintf(stderr, "kernel_launch: hipFuncSetAttribute failed\n"); grid = -1; return; }
        int per_cu = 0;
        if (hipOccupancyMaxActiveBlocksPerMultiprocessor(&per_cu, (const void*)mega, NTHREADS, LDS_BYTES) != hipSuccess || per_cu < 1) { fprintf(stderr, "kernel_launch: occupancy query reports %d blocks per CU\n", per_cu); }
        (void)hipGetLastError();
        if (cus != 256) { fprintf(stderr, "kernel_launch: built for a 256-CU device (got %d); nothing launched\n", cus); grid = -1; return; }
        grid = cus;
    }
    if (grid <= 0) return;
    Params p{};
    for (int i = 0; i < 19; ++i) p.in[i] = (const float*)d_in[i];
    p.out = (float*)d_out; p.ws = (unsigned char*)d_ws;
    for (int f = 0; f < 16; ++f) p.inv_freq[f] = (float)std::pow(10000.0, -(double)f / 16.0);
    for (int h = 0; h < 4; ++h) p.ret_lg2[h] = (float)std::log2(1.0 - std::exp2(-5.0 - (double)h));
    hipMemsetAsync((unsigned char*)d_ws + WS_CTL, 0, CTL_BYTES, stream);
#if MK_PER_PHASE
    for (int ph = 0; ph < N_PHASES; ++ph) { p.ph_lo = ph; p.ph_hi = ph + 1; hipLaunchKernelGGL(mega, dim3(grid), dim3(NTHREADS), LDS_BYTES, stream, p); }
#else
    p.ph_lo = 0; p.ph_hi = N_PHASES;
    hipLaunchKernelGGL(mega, dim3(grid), dim3(NTHREADS), LDS_BYTES, stream, p);
#endif
}
```

```cpp
#include <hip/hip_runtime.h>
#include <cstdio>
#include <cstdint>
#include <cmath>

#define LAS __attribute__((address_space(3)))
#define GAS __attribute__((address_space(1)))
typedef unsigned short bf16_t;
typedef short bf16x8 __attribute__((ext_vector_type(8)));
typedef float f32x4 __attribute__((ext_vector_type(4)));
typedef float f32x2 __attribute__((ext_vector_type(2)));
typedef unsigned u32x4 __attribute__((ext_vector_type(4)));
typedef unsigned u32x2 __attribute__((ext_vector_type(2)));
typedef int i32x4 __attribute__((ext_vector_type(4)));
__device__ __forceinline__ f32x4 tof(const f32x4& v) { return v; }
__device__ __forceinline__ f32x4 tof(const i32x4& v) { return __builtin_convertvector(v, f32x4); }

constexpr int T_ = 32768, D_ = 1024, S_ = 8192, NBATCH = 4, DEPTH_ = 2;
constexpr int ZW = 3072;
constexpr int OLD = 1024 + 64;
constexpr int ZLD = ZW + 64;
constexpr int Z_GQ = 0, Z_GK = 128, Z_GV = 256, Z_GR = 512, Z_GA = 768, Z_SQ = 784, Z_SK = 1040, Z_SV = 1168, Z_MQ = 1296, Z_MK = 1552, Z_MV = 1808,
              Z_RQ = 2064, Z_RK = 2192, Z_RV = 2320, Z_RG = 2576, Z_GATE = 2832, IN_W = 6928;
constexpr float LOG2E = 1.4426950408889634f;
constexpr float C2 = 0.125f * 1.4426950408889634f;
constexpr float RSQ32 = 0.17677669529663687f;
constexpr float NORM_EPS = 1e-6f;
constexpr int NEXP = 32, EHID = 256, MOE_BLK = 256, NSLOTBLK = 288, NSLOT = NSLOTBLK * MOE_BLK;

constexpr size_t MiB = 1u << 20;
constexpr size_t WS_WIN = 0, WS_WG = 3 * MiB, WS_WB = 7 * MiB, WS_WO = 9 * MiB, WS_WR = 11 * MiB, WS_E1 = 12 * MiB, WS_E2 = 28 * MiB;
constexpr size_t WS_YS = 68 * MiB;
constexpr size_t WS_GKV = 68 * MiB, WS_RKV = 84 * MiB, WS_GDEC = 92 * MiB, WS_KMEAN = 93 * MiB, WS_O = 108 * MiB;
constexpr size_t WS_U8 = 197 * MiB;
constexpr size_t WS_SU = 229 * MiB, WS_RSTD = WS_SU + 128 * 1024  , WS_XSS = WS_SU + 256 * 1024;
constexpr size_t WS_SWIN = 230 * MiB, WS_SWG = WS_SWIN + 16 * 1024, WS_SWE1 = WS_SWG + 16 * 1024;
constexpr size_t WS_Z = 261 * MiB;
constexpr size_t WS_YH = 261 * MiB;
constexpr size_t WS_U2BF = 261 * MiB;
constexpr size_t WS_XS = 325 * MiB, WS_HDN = 397 * MiB;
constexpr size_t WS_LOGIT = 453 * MiB;
constexpr size_t WS_TOKE = 461 * MiB, WS_TOKW = WS_TOKE + 256 * 1024, WS_TOKR = WS_TOKW + 256 * 1024, WS_HIST = WS_TOKR + 256 * 1024,
                 WS_SDST = WS_HIST + 64 * 1024, WS_BLKE = WS_SDST + 512 * 1024;
constexpr size_t WS_MLIST = 94 * MiB, WS_MCNT = 102 * MiB;
constexpr size_t WS_PARTO = 457 * MiB, WS_PARTML = 505 * MiB;
constexpr size_t WS_CTL = 511 * MiB, CTL_BYTES = 256 * 1024;
constexpr size_t WS_RBCNT = WS_CTL + 128 * 1024;
constexpr size_t WS_SWRAW = WS_CTL + 64 * 1024, SWRAW_LSTEP = 96 * 1024;
constexpr size_t SW_LSTEP = 128 * 1024;
constexpr size_t WS_END = 512 * MiB;
constexpr int YS_TRASH_ROW = 2 * T_;

__device__ __forceinline__ float bf2f(bf16_t v) { return __uint_as_float(((unsigned)v) << 16); }
__device__ __forceinline__ unsigned f2bf(float f) { unsigned u = __float_as_uint(f); return (u + 0x7fffu + ((u >> 16) & 1u)) >> 16; }
__device__ __forceinline__ unsigned pk2(float lo, float hi) { return f2bf(lo) | (f2bf(hi) << 16); }
__device__ __forceinline__ float sigmoidf_(float x) { return __builtin_amdgcn_rcpf(1.0f + __builtin_amdgcn_exp2f(-x * LOG2E)); }

namespace pg8 {
#define PG8_LAS __attribute__((address_space(3)))
constexpr int BM = 256, BK = 64, HALF = 128, HTB = HALF * BK * 2  , STAGE_BYTES = 8 * HTB, NXCD = 8, WGM = 8;

__host__ __device__ __forceinline__ int lds_byte(int r, int c) { const int st = (r >> 4) * 2 + (c >> 5), rr = r & 15, cc = c & 31, ob = rr * 64 + cc * 2; return st * 1024 + (ob ^ (((ob >> 9) & 1) << 5)); }
__host__ __device__ __forceinline__ void stage_rc(int b, int& R, int& C) { const int st = b / 1024, sb = b % 1024, swz = sb ^ (((sb >> 9) & 1) << 5); R = (st >> 1) * 16 + swz / 64; C = (st & 1) * 32 + (swz % 64) / 2; }
__host__ __device__ __forceinline__ int perm32(int rho) { const int n = rho >> 4, i = rho & 15; return 8 * (i >> 2) + 4 * n + (i & 3); }

struct Unit { int pm, pn; size_t aoff, boff; };
struct Gemm { const bf16_t* A; const bf16_t* Bt; };

template <int NM, int NN, int LDAB  , int LDBB, int A_SHIFT = 30, int A_MUL = 0> struct StaticOrder {
    static constexpr bool GATHER = false;
    int G, c, pm_base;
    __device__ bool next(int i, Unit& u) const {
        constexpr int nwg = NM * NN; const int L = i * G + c; if (L >= nwg) return false;
        int wgid = L; { constexpr int q = nwg / NXCD, r = nwg % NXCD; const int xcd = wgid % NXCD, off = wgid / NXCD; wgid = (xcd < r ? xcd * (q + 1) : r * (q + 1) + (xcd - r) * q) + off; }
        static_assert(NM % WGM == 0, "row-tile count must be a multiple of the 8-row group"); constexpr int nig = WGM * NN, gsz = WGM; const int gid = wgid / nig, fm = gid * WGM;
        u.pm = pm_base + fm + ((wgid % nig) % gsz); u.pn = (wgid % nig) / gsz;
        u.aoff = (size_t)u.pm * ((size_t)BM * LDAB) + (size_t)(u.pn >> A_SHIFT) * A_MUL; u.boff = (size_t)u.pn * ((size_t)BM * LDBB); return true;
    }
};
template <int NCOL, bool GATHER_ = false, int HOOK_ = 0> struct MoeOrder {
    static constexpr bool GATHER = GATHER_; static constexpr int HOOK = HOOK_;
    const int* blk_e; int nb, G, c; size_t a_tstep, b_tstep, b_estep; const int* rowmap; unsigned* cnt; unsigned need;
    __device__ bool next(int i, Unit& u) const {
        const int n = nb * NCOL; int L = i * G + c; if (L >= n) return false;
        { const int q = n >> 3, r = n & 7, xcd = L & 7, off = L >> 3; L = (xcd < r ? xcd * (q + 1) : r * (q + 1) + (xcd - r) * q) + off; }
        const int rb = L / NCOL, pn = L % NCOL; const int e = __builtin_amdgcn_readfirstlane(blk_e[rb]);
        u.pm = rb; u.pn = pn; u.aoff = (size_t)rb * a_tstep; u.boff = (size_t)e * b_estep + (size_t)pn * b_tstep; return true;
    }
    __device__ __forceinline__ void done(const Unit& u) const {
        asm volatile("s_waitcnt vmcnt(0)" ::: "memory");
        if ((threadIdx.x & 63) == 0) (void)__hip_atomic_fetch_add(cnt + u.pm, 1u, __ATOMIC_RELAXED, __HIP_MEMORY_SCOPE_AGENT);
    }
    __device__ __forceinline__ void a_ready(const Unit& u) const {
        if (threadIdx.x < 64) { unsigned sp = 0;
            while ((unsigned)__builtin_amdgcn_readfirstlane(__hip_atomic_load(cnt + u.pm, __ATOMIC_RELAXED, __HIP_MEMORY_SCOPE_AGENT)) < need) { __builtin_amdgcn_s_sleep(2); if (++sp > (1u << 20)) break; }
            __builtin_amdgcn_fence(__ATOMIC_ACQUIRE, "agent");
            asm volatile("s_waitcnt vmcnt(0)" ::: "memory"); }
        asm volatile("" ::: "memory"); __builtin_amdgcn_s_barrier(); asm volatile("" ::: "memory");
    }
};
template <class S, class = void> struct SchedHook { static constexpr int value = 0; };
template <class S> struct SchedHook<S, decltype((void)S::HOOK)> { static constexpr int value = S::HOOK; };

typedef __bf16 bf16x2c_t __attribute__((ext_vector_type(2)));
__device__ __forceinline__ unsigned cvt_pk_bf16(float lo, float hi) { const f32x2 v = {lo, hi}; const bf16x2c_t q = __builtin_convertvector(v, bf16x2c_t); return __builtin_bit_cast(unsigned, q); }

struct EpiBf16 {
    static constexpr bool PERM = true;
    bf16_t* O; int ldc; int row_sub;
    template <class AT> __device__ __forceinline__ void operator()(const AT (&acc)[2][2][4][2], const Unit& u, int wr, int wc, int fr, int fq) const {
        const int row0 = u.pm * BM + wr * 64 + fr - row_sub; const int col0 = u.pn * BM + wc * 32 + 8 * fq;
#pragma unroll
        for (int ai = 0; ai < 2; ++ai)
#pragma unroll
            for (int m = 0; m < 4; ++m) { bf16_t* rowp = O + (size_t)(row0 + ai * HALF + m * 16) * ldc + col0;
#pragma unroll
                for (int bj = 0; bj < 2; ++bj) { const f32x4 v0 = tof(acc[ai][bj][m][0]), v1 = tof(acc[ai][bj][m][1]);
                    u32x4 w; w.x = cvt_pk_bf16(v0[0], v0[1]); w.y = cvt_pk_bf16(v0[2], v0[3]); w.z = cvt_pk_bf16(v1[0], v1[1]); w.w = cvt_pk_bf16(v1[2], v1[3]);
                    *(u32x4*)(rowp + bj * HALF) = w; } }
    }
};
struct EpiBf16S {
    static constexpr bool PERM = true;
    bf16_t* O; int ldc; const float* srow; const float* scol; int ncols;
    template <class AT> __device__ __forceinline__ void operator()(const AT (&acc)[2][2][4][2], const Unit& u, int wr, int wc, int fr, int fq) const {
        const int row0 = u.pm * BM + wr * 64 + fr; const int col0 = u.pn * BM + wc * 32 + 8 * fq;
        f32x4 sc[2][2];
#pragma unroll
        for (int bj = 0; bj < 2; ++bj)
#pragma unroll
            for (int n = 0; n < 2; ++n) sc[bj][n] = *(const f32x4*)(scol + col0 + bj * HALF + 4 * n);
        float srv[2][4];
#pragma unroll
        for (int ai = 0; ai < 2; ++ai)
#pragma unroll
            for (int m = 0; m < 4; ++m) srv[ai][m] = srow[row0 + ai * HALF + m * 16];
#pragma unroll
        for (int ai = 0; ai < 2; ++ai)
#pragma unroll
            for (int m = 0; m < 4; ++m) { const int r = row0 + ai * HALF + m * 16; const float sr = srv[ai][m]; bf16_t* rowp = O + (size_t)r * ldc + col0;
#pragma unroll
                for (int bj = 0; bj < 2; ++bj) { const f32x4 v0 = tof(acc[ai][bj][m][0]) * sc[bj][0] * sr, v1 = tof(acc[ai][bj][m][1]) * sc[bj][1] * sr;
                    u32x4 w; w.x = cvt_pk_bf16(v0[0], v0[1]); w.y = cvt_pk_bf16(v0[2], v0[3]); w.z = cvt_pk_bf16(v1[0], v1[1]); w.w = cvt_pk_bf16(v1[2], v1[3]);
                    if (col0 + bj * HALF < ncols) *(u32x4*)(rowp + bj * HALF) = w; } }
    }
};
template <bool BASE_F32> struct EpiRes {
    static constexpr bool PERM = true;
    const void* base; bf16_t* H;
    template <class AT> __device__ __forceinline__ void operator()(const AT (&acc)[2][2][4][2], const Unit& u, int wr, int wc, int fr, int fq) const {
        const int row0 = u.pm * BM + wr * 64 + fr, col0 = u.pn * BM + wc * 32 + 8 * fq;
#pragma unroll
        for (int ai = 0; ai < 2; ++ai) {
            f32x4 b[4][2][2];
#pragma unroll
            for (int m = 0; m < 4; ++m) { const size_t off = (size_t)(row0 + ai * HALF + m * 16) * 1024 + col0;
#pragma unroll
                for (int bj = 0; bj < 2; ++bj) {
                    if (BASE_F32) { b[m][bj][0] = *(const f32x4*)((const float*)base + off + bj * HALF); b[m][bj][1] = *(const f32x4*)((const float*)base + off + bj * HALF + 4); }
                    else { const u32x4 q = *(const u32x4*)((const bf16_t*)base + off + bj * HALF);
                        b[m][bj][0] = (f32x4){__uint_as_float(q.x << 16), __uint_as_float(q.x & 0xffff0000u), __uint_as_float(q.y << 16), __uint_as_float(q.y & 0xffff0000u)};
                        b[m][bj][1] = (f32x4){__uint_as_float(q.z << 16), __uint_as_float(q.z & 0xffff0000u), __uint_as_float(q.w << 16), __uint_as_float(q.w & 0xffff0000u)}; } } }
#pragma unroll
            for (int m = 0; m < 4; ++m) { const size_t off = (size_t)(row0 + ai * HALF + m * 16) * 1024 + col0;
#pragma unroll
                for (int bj = 0; bj < 2; ++bj) { const f32x4 v0 = b[m][bj][0] + tof(acc[ai][bj][m][0]), v1 = b[m][bj][1] + tof(acc[ai][bj][m][1]);
                    u32x4 w; w.x = cvt_pk_bf16(v0[0], v0[1]); w.y = cvt_pk_bf16(v0[2], v0[3]); w.z = cvt_pk_bf16(v1[0], v1[1]); w.w = cvt_pk_bf16(v1[2], v1[3]);
                    *(u32x4*)(H + off + bj * HALF) = w; } }
            asm volatile("" ::: "memory"); }
    }
};
struct EpiRouter {
    static constexpr bool PERM = false; static constexpr bool NARROW = true;
    float* L;
    template <class AT> __device__ __forceinline__ void operator()(const AT (&acc)[2][2][4][2], const Unit& u, int wr, int wc, int fr, int fq) const {
        if (wc >= 2) return;
        const int row0 = u.pm * BM + wr * 64 + fr, col0 = wc * 32 + 4 * fq;
#pragma unroll
        for (int ai = 0; ai < 2; ++ai)
#pragma unroll
            for (int m = 0; m < 4; ++m) { float* rowp = L + (size_t)(row0 + ai * HALF + m * 16) * 64 + col0;
#pragma unroll
                for (int n = 0; n < 2; ++n) *(f32x4*)(rowp + n * 16) = tof(acc[ai][0][m][n]); }
    }
};
constexpr int YLD = 4096 + 64;
struct EpiGate {
    static constexpr bool PERM = false;
    const bf16_t* Y; int y_row_sub; bf16_t* Mg; const float* srow; const float* scol;
    __device__ __forceinline__ static u32x2 ld2(const void* p) { u32x2 v; asm volatile("global_load_dwordx2 %0, %1, off" : "=v"(v) : "v"(p) : "memory"); return v; }
    __device__ __forceinline__ static f32x4 ld4(const void* p) { f32x4 v; asm volatile("global_load_dwordx4 %0, %1, off" : "=v"(v) : "v"(p) : "memory"); return v; }
    __device__ __forceinline__ static float ld1(const void* p) { float v; asm volatile("global_load_dword %0, %1, off" : "=v"(v) : "v"(p) : "memory"); return v; }
    __device__ __forceinline__ static void st2(void* p, u32x2 v) { asm volatile("global_store_dwordx2 %0, %1, off" :: "v"(p), "v"(v) : "memory"); }
    template <class AT> __device__ __forceinline__ void operator()(const AT (&acc)[2][2][4][2], const Unit& u, int wr, int wc, int fr, int fq) const {
        const int row0 = u.pm * BM + wr * 64 + fr, d0 = u.pn * 64 + wc * 16 + fq * 4;
        f32x4 sc[4]; float srv[8]; u32x2 yv[6][4];
#pragma unroll
        for (int i = 0; i < 4; ++i) sc[i] = ld4(scol + u.pn * BM + (i >> 1) * HALF + wc * 32 + (i & 1) * 16 + 4 * fq);
#pragma unroll
        for (int r = 0; r < 8; ++r) srv[r] = ld1(srow + row0 + (r >> 2) * HALF + (r & 3) * 16);
#define EG_YROW(r) (Y + (size_t)(row0 + ((r) >> 2) * HALF + ((r) & 3) * 16 - y_row_sub) * YLD + d0)
#define EG_LOAD(dst, r) do { const bf16_t* yrow = EG_YROW(r); _Pragma("unroll") for (int i = 0; i < 4; ++i) dst[i] = ld2(yrow + 1024 * i); } while (0)
#define EG_WAITY(n, y) asm volatile("s_waitcnt vmcnt(" #n ")" : "+v"(y[0]), "+v"(y[1]), "+v"(y[2]), "+v"(y[3]) :: "memory")
#define EG_WORK(src, r) do { const int ai = (r) >> 2, m = (r) & 3; const float sr = srv[r]; f32x4 s = (f32x4){0.f, 0.f, 0.f, 0.f}; \
            _Pragma("unroll") for (int i = 0; i < 4; ++i) { const f32x4 g = tof(acc[ai][i >> 1][m][i & 1]) * sc[i] * sr; \
                s[0] += __builtin_amdgcn_rcpf(1.0f + __builtin_amdgcn_exp2f(g[0])) * __uint_as_float(src[i].x << 16); s[1] += __builtin_amdgcn_rcpf(1.0f + __builtin_amdgcn_exp2f(g[1])) * __uint_as_float(src[i].x & 0xffff0000u); \
                s[2] += __builtin_amdgcn_rcpf(1.0f + __builtin_amdgcn_exp2f(g[2])) * __uint_as_float(src[i].y << 16); s[3] += __builtin_amdgcn_rcpf(1.0f + __builtin_amdgcn_exp2f(g[3])) * __uint_as_float(src[i].y & 0xffff0000u); } \
            u32x2 w; w.x = cvt_pk_bf16(s[0], s[1]); w.y = cvt_pk_bf16(s[2], s[3]); st2(Mg + (size_t)(row0 + ai * HALF + m * 16) * OLD + d0, w); } while (0)
        EG_LOAD(yv[0], 0); EG_LOAD(yv[1], 1); EG_LOAD(yv[2], 2); EG_LOAD(yv[3], 3); EG_LOAD(yv[4], 4); EG_LOAD(yv[5], 5);
        asm volatile("s_waitcnt vmcnt(20)" : "+v"(sc[0]), "+v"(sc[1]), "+v"(sc[2]), "+v"(sc[3]), "+v"(srv[0]), "+v"(srv[1]), "+v"(srv[2]), "+v"(srv[3]), "+v"(srv[4]), "+v"(srv[5]), "+v"(srv[6]), "+v"(srv[7]),
                     "+v"(yv[0][0]), "+v"(yv[0][1]), "+v"(yv[0][2]), "+v"(yv[0][3]) :: "memory");
#pragma unroll
        for (int i = 0; i < 4; ++i) sc[i] *= -LOG2E;
        EG_WORK(yv[0], 0); EG_LOAD(yv[0], 6);
        EG_WAITY(21, yv[1]); EG_WORK(yv[1], 1); EG_LOAD(yv[1], 7);
        EG_WAITY(22, yv[2]); EG_WORK(yv[2], 2);
        EG_WAITY(19, yv[3]); EG_WORK(yv[3], 3);
        EG_WAITY(16, yv[4]); EG_WORK(yv[4], 4);
        EG_WAITY(13, yv[5]); EG_WORK(yv[5], 5);
        EG_WAITY(9, yv[0]); EG_WORK(yv[0], 6);
        EG_WAITY(5, yv[1]); EG_WORK(yv[1], 7);
#undef EG_YROW
#undef EG_LOAD
#undef EG_WAITY
#undef EG_WORK
    }
};
template <bool WT> struct EpiE1T {
    static constexpr bool PERM = true;
    bf16_t* H; const float* srow; const float* scol_all; const int* blk_e;
    template <class AT> __device__ __forceinline__ void operator()(const AT (&acc)[2][2][4][2], const Unit& u, int wr, int wc, int fr, int fq) const {
        const int row0 = u.pm * BM + wr * 64 + fr, col0 = u.pn * 128 + wc * 32 + 8 * fq;
        const float* scol = scol_all + (size_t)(u.boff >> 19) * 512 + u.pn * BM + wc * 32 + 8 * fq;
        const f32x4 s10 = *(const f32x4*)scol, s11 = *(const f32x4*)(scol + 4), s30 = *(const f32x4*)(scol + HALF), s31 = *(const f32x4*)(scol + HALF + 4);
        float srv[2][4];
#pragma unroll
        for (int ai = 0; ai < 2; ++ai)
#pragma unroll
            for (int m = 0; m < 4; ++m) srv[ai][m] = srow[row0 + ai * HALF + m * 16];
#pragma unroll
        for (int ai = 0; ai < 2; ++ai)
#pragma unroll
            for (int m = 0; m < 4; ++m) { const int r = row0 + ai * HALF + m * 16; const float sr = srv[ai][m]; bf16_t* rowp = H + (size_t)r * EHID + col0;
                const f32x4 a0 = tof(acc[ai][0][m][0]) * s10 * sr, a1 = tof(acc[ai][0][m][1]) * s11 * sr, b0 = tof(acc[ai][1][m][0]) * s30 * sr, b1 = tof(acc[ai][1][m][1]) * s31 * sr;
                f32x4 v0, v1;
#pragma unroll
                for (int j = 0; j < 4; ++j) { v0[j] = a0[j] * sigmoidf_(a0[j]) * b0[j]; v1[j] = a1[j] * sigmoidf_(a1[j]) * b1[j]; }
                u32x4 w; w.x = cvt_pk_bf16(v0[0], v0[1]); w.y = cvt_pk_bf16(v0[2], v0[3]); w.z = cvt_pk_bf16(v1[0], v1[1]); w.w = cvt_pk_bf16(v1[2], v1[3]);
                if constexpr (WT) asm volatile("global_store_dwordx4 %0, %1, off sc1\n\ts_nop 1" :: "v"(rowp), "v"(w) : "memory"); else *(u32x4*)rowp = w; }
    }
};
typedef EpiE1T<false> EpiE1;
struct EpiE2 {
    static constexpr bool PERM = true;
    bf16_t* YS; const int* sdst;
    template <class AT> __device__ __forceinline__ void operator()(const AT (&acc)[2][2][4][2], const Unit& u, int wr, int wc, int fr, int fq) const {
        const int row0 = u.pm * BM + wr * 64 + fr, col0 = u.pn * BM + wc * 32 + 8 * fq;
        int dstv[2][4];
#pragma unroll
        for (int ai = 0; ai < 2; ++ai)
#pragma unroll
            for (int m = 0; m < 4; ++m) dstv[ai][m] = sdst[row0 + ai * HALF + m * 16];
#pragma unroll
        for (int ai = 0; ai < 2; ++ai)
#pragma unroll
            for (int m = 0; m < 4; ++m) { const int dst = dstv[ai][m];
                bf16_t* rowp = YS + (size_t)dst * 1024 + col0;
#pragma unroll
                for (int bj = 0; bj < 2; ++bj) { const f32x4 v0 = tof(acc[ai][bj][m][0]), v1 = tof(acc[ai][bj][m][1]);
                    u32x4 w; w.x = cvt_pk_bf16(v0[0], v0[1]); w.y = cvt_pk_bf16(v0[2], v0[3]); w.z = cvt_pk_bf16(v1[0], v1[1]); w.w = cvt_pk_bf16(v1[2], v1[3]);
                    *(u32x4*)(rowp + bj * HALF) = w; }
                asm volatile("" ::: "memory"); }
    }
};

template <class E, class = void> struct IsNarrow { static constexpr bool value = false; };
template <class E> struct IsNarrow<E, decltype((void)E::NARROW)> { static constexpr bool value = E::NARROW; };
template <bool I8> struct AccSel { typedef f32x4 type; };
template <> struct AccSel<true> { typedef i32x4 type; };
__device__ __forceinline__ f32x4 mma16(const bf16x8& a, const bf16x8& b, const f32x4& c) { return __builtin_amdgcn_mfma_f32_16x16x32_bf16(a, b, c, 0, 0, 0); }
__device__ __forceinline__ i32x4 mma16(const bf16x8& a, const bf16x8& b, const i32x4& c) { return __builtin_amdgcn_mfma_i32_16x16x64_i8(__builtin_bit_cast(i32x4, a), __builtin_bit_cast(i32x4, b), c, 0, 0, 0); }
template <int LDAB, int LDBB, int KB, bool I8, bool ALIGN_EPI = false, class Epi, class Sched>
__device__ __forceinline__ void gemm_phase(PG8_LAS unsigned char* lds, const Gemm g, const Sched& S, const Epi& E) {
    int tid = threadIdx.x; asm volatile("" : "+v"(tid));
    const int wid = __builtin_amdgcn_readfirstlane(tid >> 6), lane = tid & 63, wr = wid >> 2, wc = wid & 3, fr = lane & 15, fq = lane >> 4;
    constexpr int nt = KB / (BK * 2);
    unsigned voffA[2], voffB[2]; int Rr[2]; unsigned cby[2];
#pragma unroll
    for (int i = 0; i < 2; ++i) { int R, C; stage_rc(tid * 16 + i * 8192, R, C); const int Rb = Epi::PERM ? ((R & ~31) + perm32(R & 31)) : R;
        voffA[i] = (unsigned)(R * LDAB + C * 2); voffB[i] = (unsigned)(Rb * LDBB + C * 2); Rr[i] = R; cby[i] = (unsigned)(C * 2); }
    unsigned gc[2][2], gn[2][2];
#define PG8_GATH(u_, o_) do { if constexpr (Sched::GATHER) { _Pragma("unroll") for (int h_ = 0; h_ < 2; ++h_) _Pragma("unroll") for (int i_ = 0; i_ < 2; ++i_) { int tk_ = S.rowmap[(u_).pm * BM + HALF * h_ + Rr[i_]] >> 1; tk_ = tk_ < T_ ? tk_ : T_ - 1; \
        o_[h_][i_] = (unsigned)tk_ * (unsigned)LDAB + cby[i_]; } } } while (0)
#define PG8_STAGE_A(bufoff, ptr, kb, h, nx) do { if constexpr (!Sched::GATHER) { PG8_STAGE(bufoff, ptr, voffA); } else { unsigned vo_[2]; vo_[0] = (nx) ? gn[h][0] : gc[h][0]; vo_[1] = (nx) ? gn[h][1] : gc[h][1]; \
        PG8_STAGE(bufoff, (const char*)g.A + (kb), vo_); } } while (0)
    constexpr size_t kstep = (size_t)(BK * 2);
    constexpr size_t hstepA = (size_t)HALF * LDAB, hstepB = (size_t)HALF * LDBB;
    const unsigned ldsw = (unsigned)wid * 1024u;
    const int aoff = lds_byte(wr * 64 + fr, fq * 8), boff = lds_byte(wc * 32 + fr, fq * 8);
#define PG8_SA(b, h) (((b) * 2 + (h)) * HTB)
#define PG8_SB(b, h) ((4 + (b) * 2 + (h)) * HTB)
#define PG8_STAGE(bufoff, gbase, voff) do { _Pragma("unroll") for (int _i = 0; _i < 2; ++_i) \
        __builtin_amdgcn_global_load_lds((const unsigned*)((const char*)(gbase) + (voff)[_i]), (PG8_LAS unsigned*)(lds + (bufoff) + ldsw + _i * 8192), 16, 0, 0); } while (0)
#define PG8_LDA(dst, b, h) do { _Pragma("unroll") for (int m = 0; m < 4; ++m) _Pragma("unroll") for (int k = 0; k < 2; ++k) dst[m][k] = *(const PG8_LAS bf16x8*)(lds + PG8_SA(b, h) + aoff + m * 2048 + k * 1024); } while (0)
#define PG8_LDB(dst, b, h) do { _Pragma("unroll") for (int n = 0; n < 2; ++n) _Pragma("unroll") for (int k = 0; k < 2; ++k) dst[n][k] = *(const PG8_LAS bf16x8*)(lds + PG8_SB(b, h) + boff + n * 2048 + k * 1024); } while (0)
#define PG8_MMA(ai, bj, At, Bt) do { if constexpr (IsNarrow<Epi>::value && (bj) == 1) break; __builtin_amdgcn_s_setprio(1); _Pragma("unroll") for (int m = 0; m < 4; ++m) _Pragma("unroll") for (int n = 0; n < 2; ++n) _Pragma("unroll") for (int k = 0; k < 2; ++k) \
        acc[ai][bj][m][n] = mma16(Bt[n][k], At[m][k], acc[ai][bj][m][n]); __builtin_amdgcn_s_setprio(0); } while (0)
#define PG8_WAIT_V(n) asm volatile("s_waitcnt vmcnt(" #n ")" ::: "memory")
#define PG8_WAIT_L(n) asm volatile("s_waitcnt lgkmcnt(" #n ")" ::: "memory")
#define PG8_BAR __builtin_amdgcn_s_barrier()
#define PG8_SCHED __builtin_amdgcn_sched_barrier(0)
    Unit cur, nxt; int ui = 0;
    if (!S.next(0, cur)) return;
    if constexpr (SchedHook<Sched>::value == 2) S.a_ready(cur);
    typedef typename AccSel<I8>::type acc_t;
    acc_t acc[2][2][4][2];
#pragma unroll
    for (int a = 0; a < 2; ++a)
#pragma unroll
        for (int b = 0; b < 2; ++b)
#pragma unroll
            for (int m = 0; m < 4; ++m)
#pragma unroll
                for (int n = 0; n < 2; ++n) acc[a][b][m][n] = (acc_t){0, 0, 0, 0};
    bf16x8 At[4][2], B0[2][2], B1[2][2];
    const char* cA = (const char*)g.A + cur.aoff; const char* cB = (const char*)g.Bt + cur.boff;
    PG8_GATH(cur, gc);
    PG8_STAGE(PG8_SB(0, 0), cB, voffB); PG8_STAGE_A(PG8_SA(0, 0), cA, 0, 0, false); PG8_STAGE(PG8_SB(0, 1), cB + hstepB, voffB); PG8_STAGE_A(PG8_SA(0, 1), cA + hstepA, 0, 1, false);
    if (wr == 1) PG8_BAR;
    PG8_WAIT_V(4); PG8_BAR;
    PG8_STAGE(PG8_SB(1, 0), cB + kstep, voffB); PG8_STAGE_A(PG8_SA(1, 0), cA + kstep, kstep, 0, false); PG8_STAGE(PG8_SB(1, 1), cB + hstepB + kstep, voffB);
    PG8_WAIT_V(6); PG8_BAR;
    for (;;) {
        const bool has_next = S.next(ui + 1, nxt);
        const char* nA = has_next ? (const char*)g.A + nxt.aoff : cA; const char* nB = has_next ? (const char*)g.Bt + nxt.boff : cB;
        if constexpr (Sched::GATHER) { if (has_next) PG8_GATH(nxt, gn); else { gn[0][0] = gc[0][0]; gn[0][1] = gc[0][1]; gn[1][0] = gc[1][0]; gn[1][1] = gc[1][1]; } }
#pragma unroll 1
        for (int t = 0; t < nt; t += 2) {
            const bool last = (t == nt - 2);
            if constexpr (SchedHook<Sched>::value == 2) { if (last && has_next) S.a_ready(nxt); }
            const char* a1 = cA + (size_t)(t + 1) * kstep;
            const char* a2 = last ? nA : cA + (size_t)(t + 2) * kstep; const char* b2 = last ? nB : cB + (size_t)(t + 2) * kstep;
            const char* a3 = a2 + kstep; const char* b3 = b2 + kstep;
            const size_t k2 = last ? 0 : (size_t)(t + 2) * kstep;
            PG8_LDB(B0, 0, 0); PG8_SCHED; PG8_LDA(At, 0, 0); PG8_STAGE_A(PG8_SA(1, 1), a1 + hstepA, (size_t)(t + 1) * kstep, 1, false);
            PG8_WAIT_L(8); PG8_BAR; PG8_WAIT_L(0); PG8_MMA(0, 0, At, B0); PG8_BAR; PG8_SCHED;
            PG8_LDB(B1, 0, 1); PG8_STAGE(PG8_SB(0, 0), b2, voffB);
            PG8_BAR; PG8_WAIT_L(0); PG8_MMA(0, 1, At, B1); PG8_BAR;
            PG8_LDA(At, 0, 1); PG8_STAGE_A(PG8_SA(0, 0), a2, k2, 0, last);
            PG8_BAR; PG8_WAIT_L(0); PG8_MMA(1, 0, At, B0); PG8_BAR; PG8_SCHED;
            PG8_STAGE(PG8_SB(0, 1), b2 + hstepB, voffB);
            PG8_WAIT_V(6); PG8_BAR; PG8_MMA(1, 1, At, B1); PG8_BAR;
            PG8_LDB(B0, 1, 0); PG8_SCHED; PG8_LDA(At, 1, 0); PG8_STAGE_A(PG8_SA(0, 1), a2 + hstepA, k2, 1, last);
            PG8_WAIT_L(8); PG8_BAR; PG8_WAIT_L(0); PG8_MMA(0, 0, At, B0); PG8_BAR; PG8_SCHED;
            PG8_LDB(B1, 1, 1); PG8_STAGE(PG8_SB(1, 0), b3, voffB);
            PG8_BAR; PG8_WAIT_L(0); PG8_MMA(0, 1, At, B1); PG8_BAR;
            PG8_LDA(At, 1, 1); PG8_STAGE_A(PG8_SA(1, 0), a3, k2 + kstep, 0, last);
            PG8_BAR; PG8_WAIT_L(0); PG8_MMA(1, 0, At, B0); PG8_BAR; PG8_SCHED;
            PG8_STAGE(PG8_SB(1, 1), b3 + hstepB, voffB);
            PG8_WAIT_V(6); PG8_BAR; PG8_MMA(1, 1, At, B1); PG8_BAR;
        }
        if constexpr (ALIGN_EPI) { if (wr == 0) PG8_BAR; }
        E(acc, cur, wr, wc, fr, fq);
        if constexpr (SchedHook<Sched>::value == 1) S.done(cur);
        if (!has_next) break;
#pragma unroll
        for (int a = 0; a < 2; ++a)
#pragma unroll
            for (int b = 0; b < 2; ++b)
#pragma unroll
                for (int m = 0; m < 4; ++m)
#pragma unroll
                    for (int n = 0; n < 2; ++n) acc[a][b][m][n] = (acc_t){0, 0, 0, 0};
        cur = nxt; cA = nA; cB = nB; ++ui;
        if constexpr (Sched::GATHER) { gc[0][0] = gn[0][0]; gc[0][1] = gn[0][1]; gc[1][0] = gn[1][0]; gc[1][1] = gn[1][1]; }
        if constexpr (ALIGN_EPI) { if (wr == 1) PG8_BAR; }
    }
    PG8_WAIT_V(0);
    if constexpr (!ALIGN_EPI) { if (wr == 0) PG8_BAR; }
    PG8_BAR;
#undef PG8_SA
#undef PG8_GATH
#undef PG8_STAGE_A
#undef PG8_SB
#undef PG8_STAGE
#undef PG8_LDA
#undef PG8_LDB
#undef PG8_MMA
#undef PG8_WAIT_V
#undef PG8_WAIT_L
#undef PG8_BAR
#undef PG8_SCHED
}
}

#define XB_TMO      128
#define XB_XCNT(j)  (256  + 64 * (j))
#define XB_XSUB(j)  (1280 + 64 * (j))
#define XB_XGEN(j)  (2304 + 64 * (j))
#define XB_TOP      3328
#define XB_TOPGEN   3392
#define XCD_BAR_WORDS 3456
#define XB_SPIN_CAP (1u << 21)

__device__ __forceinline__ unsigned xb_ld(unsigned* p)              { return __hip_atomic_load(p, __ATOMIC_RELAXED, __HIP_MEMORY_SCOPE_AGENT); }
__device__ __forceinline__ unsigned xb_add(unsigned* p, unsigned v) { return __hip_atomic_fetch_add(p, v, __ATOMIC_RELAXED, __HIP_MEMORY_SCOPE_AGENT); }
__device__ __forceinline__ unsigned xb_xcc_id() { return (unsigned)__builtin_amdgcn_s_getreg((3 << 11) | 20) & 0xFu; }
#define XB_SPIN(cond, bar) do { unsigned _sp = 0; while (cond) { __builtin_amdgcn_s_sleep(1); \
    if ((++_sp & 255u) == 0u) { if (xb_ld(&(bar)[XB_TMO])) break; if (_sp > XB_SPIN_CAP) { atomicAdd(&(bar)[XB_TMO], 1u); break; } } } } while (0)

struct XcdBarrier {
    unsigned* bar; unsigned x;
    volatile LAS unsigned* st;
};

__device__ __forceinline__ XcdBarrier xcd_barrier_post(unsigned* bar, volatile LAS unsigned* st) {
    XcdBarrier b; b.bar = bar; b.x = xb_xcc_id(); b.st = st;
    if (threadIdx.x == 0) (void)xb_add(&bar[XB_XCNT(b.x)], 1u);
    return b;
}
__device__ __forceinline__ void xcd_barrier_complete(unsigned* bar, unsigned x, unsigned& nloc, unsigned& nx) {
    const unsigned G = gridDim.x * gridDim.y * gridDim.z;
    unsigned sum, cnt, mine, sp = 0u;
    for (;;) {
        sum = 0u; cnt = 0u; mine = 0u;
#pragma unroll
        for (unsigned j = 0; j < 16; ++j) { const unsigned c = xb_ld(&bar[XB_XCNT(j)]); sum += c; cnt += (c > 0u) ? 1u : 0u; mine = (j == x) ? c : mine; }
        if (sum == G) break;
        __builtin_amdgcn_s_sleep(1);
        if ((++sp & 255u) == 0u) { if (xb_ld(&bar[XB_TMO])) break; if (sp > XB_SPIN_CAP) { atomicAdd(&bar[XB_TMO], 1u); break; } }
    }
    nloc = mine > 0u ? mine : 1u; nx = cnt > 0u ? cnt : 1u;
}

__device__ __forceinline__ void xcd_barrier(const XcdBarrier& b) {
    asm volatile("s_waitcnt vmcnt(0)" ::: "memory");
    __syncthreads();
    if (threadIdx.x == 0) {
        unsigned* bar = b.bar;
        __builtin_amdgcn_s_waitcnt(0);
        unsigned nloc = b.st[0], nx = b.st[1];
        if (nloc == 0u) { xcd_barrier_complete(bar, b.x, nloc, nx); b.st[0] = nloc; b.st[1] = nx; }
        const unsigned old = xb_add(&bar[XB_XSUB(b.x)], 1u);
        const unsigned gen = old / nloc;
        if (old + 1u == (gen + 1u) * nloc) {
            __builtin_amdgcn_fence(__ATOMIC_RELEASE, "agent");
            asm volatile("s_waitcnt vmcnt(0)" ::: "memory");
            const unsigned og = xb_add(&bar[XB_TOP], 1u);
            const unsigned tg = og / nx;
            if (og + 1u == (tg + 1u) * nx) xb_add(&bar[XB_TOPGEN], 1u);
            else XB_SPIN(xb_ld(&bar[XB_TOPGEN]) == tg, bar);
            __builtin_amdgcn_fence(__ATOMIC_ACQUIRE, "agent");
            xb_add(&bar[XB_XGEN(b.x)], 1u);
            asm volatile("s_waitcnt vmcnt(0)" ::: "memory");
        } else {
            XB_SPIN(xb_ld(&bar[XB_XGEN(b.x)]) == gen, bar);
            __builtin_amdgcn_fence(__ATOMIC_ACQUIRE, "agent");
            asm volatile("s_waitcnt vmcnt(0)" ::: "memory");
        }
    }
    __syncthreads();
}

constexpr int NWAVES = 8, NTHREADS = 512;
constexpr int RING_BYTES = 131072;
constexpr int LDSCTL_OFF = 163840 - 1024, MISC_OFF = LDSCTL_OFF + 320;
constexpr int LDS_BYTES = 163840;

struct Params { const float* in[19]; float* out; unsigned char* ws; float inv_freq[16]; float ret_lg2[4]; int ph_lo, ph_hi; };
typedef const __attribute__((address_space(4))) Params& KPRef;

__device__ __forceinline__ float wave_sum(float v) {
#pragma unroll
    for (int o = 1; o < 64; o <<= 1) v += __shfl_xor(v, o);
    return v;
}
#define LDS_WAIT() asm volatile("s_waitcnt lgkmcnt(0)" ::: "memory")
#define MFMA16(a, b, c) __builtin_amdgcn_mfma_f32_16x16x32_bf16(a, b, c, 0, 0, 0)
typedef short v4i16_t __attribute__((ext_vector_type(4)));
__device__ __forceinline__ v4i16_t lds_tr16(const bf16_t* p) { return __builtin_amdgcn_ds_read_tr16_b64_v4i16((LAS v4i16_t*)(LAS unsigned char*)(unsigned char*)p); }
__device__ __forceinline__ bf16x8 tr_frag(const bf16_t* tile, int stride, int rowa, int rowb, int col0, int lane) {
    const int i = lane & 15, q = i >> 2, pp = i & 3;
    const v4i16_t lo = lds_tr16(tile + (rowa + q) * stride + col0 + 4 * pp), hi = lds_tr16(tile + (rowb + q) * stride + col0 + 4 * pp);
    return (bf16x8){lo[0], lo[1], lo[2], lo[3], hi[0], hi[1], hi[2], hi[3]};
}
__device__ __forceinline__ bf16x8 pack_p(const f32x4& a, const f32x4& b) {
    u32x4 w; w.x = pg8::cvt_pk_bf16(a[0], a[1]); w.y = pg8::cvt_pk_bf16(a[2], a[3]); w.z = pg8::cvt_pk_bf16(b[0], b[1]); w.w = pg8::cvt_pk_bf16(b[2], b[3]); return __builtin_bit_cast(bf16x8, w); }


template <class LD>
__device__ __forceinline__ void conv_item(LD ld, bf16_t* WT, int K, float* scr, int kb, int nb, int lane) {
    const int k0 = 64 * kb, n0 = 32 * nb;
    float wv[32];
#pragma unroll
    for (int i = 0; i < 32; ++i) wv[i] = ld(k0 + 2 * i + (lane >> 5), n0 + (lane & 31));
#pragma unroll
    for (int i = 0; i < 32; ++i) { const int kk = 2 * i + (lane >> 5); scr[kk * 33 + (lane & 31)] = wv[i]; }
    LDS_WAIT();
    const int c = lane & 7;
#pragma unroll
    for (int j = 0; j < 4; ++j) { const int n = (lane >> 3) + 8 * j; const float* s = scr + (8 * c) * 33 + n;
        u32x4 o; o.x = pk2(s[0 * 33], s[1 * 33]); o.y = pk2(s[2 * 33], s[3 * 33]); o.z = pk2(s[4 * 33], s[5 * 33]); o.w = pk2(s[6 * 33], s[7 * 33]);
        *(u32x4*)(WT + (size_t)(n0 + n) * K + k0 + 8 * c) = o; }
    LDS_WAIT();
}

struct C8Item { const float* base; int stride; int coff; bool valid; signed char* WT; float* scale; float ex; int n0; };
__device__ __forceinline__ void conv8_load(const C8Item& d, f32x4 (&wv)[2][8], int wave, int lane) {
    const unsigned lo = (unsigned)((lane >> 3) * d.stride + d.coff);
#pragma unroll
    for (int h = 0; h < 2; ++h)
#pragma unroll
        for (int j = 0; j < 8; ++j) { const float* rp = d.base + (size_t)(128 * wave + 64 * h + 8 * j) * d.stride; wv[h][j] = __builtin_nontemporal_load((const f32x4*)(rp + lo)); }
}
__device__ __forceinline__ void conv8_work(const C8Item& d, f32x4 (&wv)[2][8], float* scr, float* red, int wave, int lane) {
    if (!d.valid) {
#pragma unroll
        for (int h = 0; h < 2; ++h)
#pragma unroll
            for (int j = 0; j < 8; ++j) wv[h][j] = (f32x4){0.f, 0.f, 0.f, 0.f}; }
    f32x4 am = (f32x4){0.f, 0.f, 0.f, 0.f};
#pragma unroll
    for (int h = 0; h < 2; ++h)
#pragma unroll
        for (int j = 0; j < 8; ++j)
#pragma unroll
            for (int t = 0; t < 4; ++t) am[t] = fmaxf(am[t], fabsf(wv[h][j][t]));
#pragma unroll
    for (int of = 8; of < 64; of <<= 1)
#pragma unroll
        for (int t = 0; t < 4; ++t) am[t] = fmaxf(am[t], __shfl_xor(am[t], of));
    const int c4 = lane & 7;
    if (lane < 8) *(f32x4*)(red + wave * 32 + 4 * lane) = am;
    __syncthreads();
    float cm = 0.f; f32x4 cq = (f32x4){0.f, 0.f, 0.f, 0.f};
#pragma unroll
    for (int w = 0; w < 8; ++w) { cm = fmaxf(cm, red[w * 32 + (lane & 31)]); const f32x4 r4 = *(const f32x4*)(red + w * 32 + 4 * c4);
#pragma unroll
        for (int t = 0; t < 4; ++t) cq[t] = fmaxf(cq[t], r4[t]); }
    f32x4 qs;
#pragma unroll
    for (int t = 0; t < 4; ++t) qs[t] = (cq[t] > 0.f) ? 127.0f / cq[t] : 0.f;
    if (wave == 0 && lane < 32) d.scale[d.n0 + lane] = cm * (1.0f / 127.0f) * d.ex;
    const int c = lane & 7;
#pragma unroll
    for (int h = 0; h < 2; ++h) { const int k0 = 128 * wave + 64 * h;
#pragma unroll
        for (int j = 0; j < 8; ++j) { const int kk = 8 * j + (lane >> 3);
#pragma unroll
            for (int t = 0; t < 4; ++t) scr[kk * 33 + 4 * c4 + t] = rintf(wv[h][j][t] * qs[t]); }
        LDS_WAIT();
#pragma unroll
        for (int j = 0; j < 4; ++j) { const int n = (lane >> 3) + 8 * j; const float* s = scr + (8 * c) * 33 + n;
            u32x2 o; o.x = ((unsigned)((int)s[0 * 33] & 0xff)) | ((unsigned)((int)s[1 * 33] & 0xff) << 8) | ((unsigned)((int)s[2 * 33] & 0xff) << 16) | ((unsigned)((int)s[3 * 33] & 0xff) << 24);
            o.y = ((unsigned)((int)s[4 * 33] & 0xff)) | ((unsigned)((int)s[5 * 33] & 0xff) << 8) | ((unsigned)((int)s[6 * 33] & 0xff) << 16) | ((unsigned)((int)s[7 * 33] & 0xff) << 24);
            *(u32x2*)(d.WT + (size_t)(d.n0 + n) * 1024 + k0 + 8 * c) = o; }
        LDS_WAIT(); }
    __syncthreads();
}
__device__ __forceinline__ C8Item conv8_desc(KPRef p, int l, unsigned char* wd, int it, int lane) {
    unsigned char* ws = p.ws; const size_t sl = (size_t)l * SW_LSTEP; const float* Win = p.in[2] + (size_t)l * 1024 * IN_W;
    C8Item d;
    if (it < 96) { const int n = 32 * it + (lane & 31), n4 = 32 * it + 4 * (lane & 7); d.valid = n4 < Z_GATE; d.base = Win; d.stride = IN_W; d.coff = d.valid ? n4 : 0; d.n0 = 32 * it;
        float s = 1.f; if (n < Z_GK) s = RSQ32; else if (n >= Z_SQ && n < Z_SK) s = C2; else if (n >= Z_MQ && n < Z_MK) s = C2; else if (n >= Z_RK && n < Z_RV) s = RSQ32;
        d.ex = s; d.WT = (signed char*)(wd + WS_WIN); d.scale = (float*)(ws + WS_SWIN + sl);
    } else if (it < 224) { const int nb = it - 96, n = 32 * nb + 4 * (lane & 7);
        const int pn = n >> 8, cc = n & 255, bj = (cc >> 7) & 1, wc = (cc >> 5) & 3, nn = (cc >> 4) & 1, fq = (cc >> 2) & 3, j = cc & 3;
        d.valid = true; d.base = Win; d.stride = IN_W; d.coff = Z_GATE + 1024 * (2 * bj + nn) + 64 * pn + 16 * wc + 4 * fq + j; d.n0 = 32 * nb; d.ex = 1.f;
        d.WT = (signed char*)(wd + WS_WG); d.scale = (float*)(ws + WS_SWG + sl);
    } else { const int r = it - 224, e = r >> 4, nb = r & 15;
        const int n0 = 32 * nb, pn = n0 >> 8, c0 = n0 & 255;
        d.valid = true; d.base = ((c0 < 128) ? p.in[15] : p.in[16]) + (size_t)(l * 32 + e) * 1024 * 256 + 128 * pn + (c0 & 127); d.stride = 256; d.coff = 4 * (lane & 7); d.n0 = n0; d.ex = 1.f;
        d.WT = (signed char*)(wd + WS_E1) + (size_t)e * 512 * 1024; d.scale = (float*)(ws + WS_SWE1 + sl) + e * 512; }
    return d;
}
__device__ __forceinline__ void conv8_phase(KPRef p, int l, unsigned char* wd, unsigned char* lds, int c, int nwg, int wave, int lane, int it_lo, int it_hi) {
    float* scr = (float*)(lds + wave * 16384); float* red = (float*)(lds + RING_BYTES);
    int it = it_lo + c; if (it >= it_hi) return;
    C8Item d0 = conv8_desc(p, l, wd, it, lane); f32x4 wa[2][8]; conv8_load(d0, wa, wave, lane);
    for (;;) {
        const int it2 = it + nwg; const bool has = it2 < it_hi;
        C8Item d1 = conv8_desc(p, l, wd, has ? it2 : it, lane); f32x4 wb[2][8];
        if (!has) { d1.stride = 0; d1.coff = 0; }
        conv8_load(d1, wb, wave, lane);
        conv8_work(d0, wa, scr, red, wave, lane);
        if (!has) break;
#pragma unroll
        for (int h = 0; h < 2; ++h)
#pragma unroll
            for (int j = 0; j < 8; ++j) wa[h][j] = wb[h][j];
        d0 = d1; it = it2;
    }
}

__device__ __forceinline__ void conv_phase(KPRef p, int l, unsigned char* wd, unsigned char* lds, int gw, int NGW, int wave, int lane) {
    float* scr = (float*)(lds + wave * 16384);
    unsigned char* ws = wd;
    {
        for (int it = gw; it < 512; it += NGW) { const int i = it / 128, r = it % 128, kb = r / 32, nb = r % 32;
            const float* W = p.in[8] + (size_t)(l * 4 + i) * 256 * 1024; bf16_t* WT = (bf16_t*)(ws + WS_WB) + (size_t)i * 1024 * 256;
            conv_item([&](int k, int n) -> float { return __builtin_nontemporal_load(W + (size_t)k * 1024 + n); }, WT, 256, scr, kb, nb, lane); }
    }
    {
        const float* W = p.in[9] + (size_t)l * 1024 * 1024; bf16_t* WT = (bf16_t*)(ws + WS_WO);
        for (int it = gw; it < 16 * 32; it += NGW) { const int kb = it / 32, nb = it % 32;
            conv_item([&](int k, int n) -> float { return __builtin_nontemporal_load(W + (size_t)k * 1024 + n); }, WT, 1024, scr, kb, nb, lane); }
    }
    {
        const float* Wg = p.in[11] + (size_t)l * 1024 * 4; const float* We = p.in[13] + (size_t)l * 1024 * 32; const float* g2 = p.in[10] + l * 1024; bf16_t* WT = (bf16_t*)(ws + WS_WR);
        for (int it = gw; it < 16 * 8; it += NGW) { const int kb = it / 8, nb = it % 8;
            conv_item([&](int k, int n) -> float { const float gk = g2[k]; if (n < 4) return gk * Wg[k * 4 + n]; if (n < 36) return gk * We[k * 32 + (n - 4)]; return 0.f; }, WT, 1024, scr, kb, nb, lane); }
    }
    {
        for (int it = gw; it < 32 * 128; it += NGW) { const int e = it / 128, r = it % 128, kb = r / 32, nb = r % 32;
            const float* W = p.in[17] + (size_t)(l * 32 + e) * 256 * 1024; bf16_t* WT = (bf16_t*)(ws + WS_E2) + (size_t)e * 1024 * 256;
            conv_item([&](int k, int n) -> float { return __builtin_nontemporal_load(W + (size_t)k * 1024 + n); }, WT, 256, scr, kb, nb, lane); }
    }
}

__device__ __forceinline__ bf16_t* hbf_ptr(KPRef p, int l) { return l == 0 ? (bf16_t*)((unsigned char*)p.out + (size_t)64 * MiB) : (bf16_t*)p.ws; }
template <bool SRC_F32, bool COMBINE>
__device__ __forceinline__ void norm_load_row(KPRef p, const bf16_t* hsrc, int row, int lane, f32x4 (&v)[4]) {
    if (SRC_F32) { const f32x4* xr = (const f32x4*)(p.in[0] + (size_t)row * 1024) + lane;
#pragma unroll
        for (int j = 0; j < 4; ++j) v[j] = __builtin_nontemporal_load(xr + 64 * j);
    } else { const u32x2* hr = (const u32x2*)(hsrc + (size_t)row * 1024) + lane;
#pragma unroll
        for (int j = 0; j < 4; ++j) { const u32x2 a = hr[64 * j]; v[j] = (f32x4){__uint_as_float(a.x << 16), __uint_as_float(a.x & 0xffff0000u), __uint_as_float(a.y << 16), __uint_as_float(a.y & 0xffff0000u)}; } }
    if (COMBINE) { const bf16_t* ys = (const bf16_t*)(p.ws + WS_YS); const float* tokw = (const float*)(p.ws + WS_TOKW);
        const float w0 = tokw[2 * row], w1 = tokw[2 * row + 1];
        const u32x2* y0 = (const u32x2*)(ys + (size_t)(2 * row) * 1024) + lane; const u32x2* y1 = (const u32x2*)(ys + (size_t)(2 * row + 1) * 1024) + lane;
        u32x2 ya[4], yb[4];
#pragma unroll
        for (int j = 0; j < 4; ++j) { ya[j] = y0[64 * j]; yb[j] = y1[64 * j]; }
#pragma unroll
        for (int j = 0; j < 4; ++j) { const u32x2 a = ya[j], b = yb[j];
            v[j][0] += w0 * __uint_as_float(a.x << 16) + w1 * __uint_as_float(b.x << 16); v[j][1] += w0 * __uint_as_float(a.x & 0xffff0000u) + w1 * __uint_as_float(b.x & 0xffff0000u);
            v[j][2] += w0 * __uint_as_float(a.y << 16) + w1 * __uint_as_float(b.y << 16); v[j][3] += w0 * __uint_as_float(a.y & 0xffff0000u) + w1 * __uint_as_float(b.y & 0xffff0000u); } }
}
__device__ __forceinline__ float row_rstd(const f32x4 (&v)[4]) {
    float s = 0.f;
#pragma unroll
    for (int j = 0; j < 4; ++j) s += (v[j][0] * v[j][0] + v[j][1] * v[j][1]) + (v[j][2] * v[j][2] + v[j][3] * v[j][3]);
    return rsqrtf(wave_sum(s) * (1.0f / 1024.0f) + NORM_EPS);
}
template <int MODE>
__device__ __forceinline__ void norm_phase(KPRef p, int l, int rg0, int rg_end, int rg_step, int lane) {
    const float* gain = (MODE == 2 ? p.in[10] + l * 1024 : p.in[1] + l * 1024);
    f32x4 gg[4];
#pragma unroll
    for (int j = 0; j < 4; ++j) gg[j] = ((const f32x4*)gain)[lane + 64 * j];
    constexpr int NR = (MODE == 1) ? 2 : 4;
    for (int rg = rg0; rg < rg_end; rg += rg_step) { const int row0 = rg * NR;
        f32x4 v[NR][4];
#pragma unroll
        for (int r = 0; r < NR; ++r) norm_load_row<MODE == 0, MODE == 1>(p, hbf_ptr(p, MODE == 1 ? l - 1 : l), row0 + r, lane, v[r]);
#pragma unroll
        for (int r = 0; r < NR; ++r) {
            if (MODE == 1) { u32x2* hr = (u32x2*)(hbf_ptr(p, l) + (size_t)(row0 + r) * 1024) + lane;
#pragma unroll
                for (int j = 0; j < 4; ++j) { u32x2 w; w.x = pk2(v[r][j][0], v[r][j][1]); w.y = pk2(v[r][j][2], v[r][j][3]); hr[64 * j] = w; } }
            const float rstd = row_rstd(v[r]);
            f32x4 o[4]; float am = 0.f;
#pragma unroll
            for (int j = 0; j < 4; ++j) { o[j] = v[r][j] * rstd * gg[j]; am = fmaxf(fmaxf(am, fmaxf(fabsf(o[j][0]), fabsf(o[j][1]))), fmaxf(fabsf(o[j][2]), fabsf(o[j][3]))); }
#pragma unroll
            for (int of = 1; of < 64; of <<= 1) am = fmaxf(am, __shfl_xor(am, of));
            const float qs = (am > 0.f) ? 127.0f / am : 0.f;
            unsigned* o4 = (unsigned*)(p.ws + WS_U8 + (size_t)(row0 + r) * 1024) + lane;
#pragma unroll
            for (int j = 0; j < 4; ++j) { const int q0 = (int)rintf(o[j][0] * qs), q1 = (int)rintf(o[j][1] * qs), q2 = (int)rintf(o[j][2] * qs), q3 = (int)rintf(o[j][3] * qs);
                o4[64 * j] = (unsigned)(q0 & 0xff) | ((unsigned)(q1 & 0xff) << 8) | ((unsigned)(q2 & 0xff) << 16) | ((unsigned)(q3 & 0xff) << 24); }
            if (lane == 0) ((float*)(p.ws + WS_SU))[row0 + r] = am * (1.0f / 127.0f);
            if (MODE == 2 && lane == 0) ((float*)(p.ws + WS_RSTD))[row0 + r] = rstd;
        }
    }
}
__device__ __forceinline__ void final_phase(KPRef p, int gw, int NGW, int lane) {
    f32x4 gg[4];
#pragma unroll
    for (int j = 0; j < 4; ++j) gg[j] = ((const f32x4*)p.in[18])[lane + 64 * j];
    const bf16_t* hsrc = hbf_ptr(p, DEPTH_ - 1);
    for (int row0 = gw * 4; row0 < T_; row0 += NGW * 4) {
        f32x4 v[4][4];
#pragma unroll
        for (int r = 0; r < 4; ++r) norm_load_row<false, true>(p, hsrc, row0 + r, lane, v[r]);
#pragma unroll
        for (int r = 0; r < 4; ++r) { const float rstd = row_rstd(v[r]); f32x4* orow = (f32x4*)(p.out + (size_t)(row0 + r) * 1024) + lane;
#pragma unroll
            for (int j = 0; j < 4; ++j) orow[64 * j] = v[r][j] * rstd * gg[j]; } }
}

constexpr int LA_QS = 0, LA_KS = 10240, LA_VS = 20480  , LA_KD = 38912  , LA_PS = 49152  , LA_PW = 58368, LA_PW_WAVE = 4352,
              LA_LA = 93184, LA_AS = 110080, LA_END = 118272;
__device__ __forceinline__ void unpack8f(float (&d)[8], u32x4 kk) {
    d[0] = __uint_as_float(kk.x << 16); d[1] = __uint_as_float(kk.x & 0xffff0000u); d[2] = __uint_as_float(kk.y << 16); d[3] = __uint_as_float(kk.y & 0xffff0000u);
    d[4] = __uint_as_float(kk.z << 16); d[5] = __uint_as_float(kk.z & 0xffff0000u); d[6] = __uint_as_float(kk.w << 16); d[7] = __uint_as_float(kk.w & 0xffff0000u); }
__device__ __forceinline__ u32x4 pack8f(const float (&o)[8]) { u32x4 w; w.x = pk2(o[0], o[1]); w.y = pk2(o[2], o[3]); w.z = pk2(o[4], o[5]); w.w = pk2(o[6], o[7]); return w; }

struct LaRegs { u32x4 a, k[2], q[2], v[2], g[2]; f32x4 pv[2]; };
struct LaConst { float wcol[16]; float bias; f32x4 n0, n1; };
template <int KIND>
__device__ __forceinline__ LaConst la_const(KPRef p, int l, int unit0, int tid) {
    LaConst C; const int h = (unit0 >> 6) & 3, d = tid & 31;
    if (KIND == 0 || KIND == 2) { const float* wa2 = p.in[3] + (size_t)l * 16 * 128 + h * 32 + d;
#pragma unroll
        for (int r = 0; r < 16; ++r) C.wcol[r] = wa2[r * 128];
        C.bias = p.in[4][l * 128 + h * 32 + d]; }
    if (KIND >= 2) { const float* ng = (KIND == 2 ? p.in[5] : p.in[7]) + l * 64; const int oct = tid & 7; C.n0 = *(const f32x4*)(ng + 8 * oct); C.n1 = *(const f32x4*)(ng + 8 * oct + 4); }
    return C;
}
__device__ __forceinline__ void gla_decay_front(unsigned char* lds, const u32x4& areg, const LaConst& C, int tid) {
    float* LA = (float*)(lds + LA_LA); float* AS = (float*)(lds + LA_AS);
    const int lane = tid & 63, wave = __builtin_amdgcn_readfirstlane(tid >> 6);
    if (tid < 256) { const int t = tid >> 1, hf = tid & 1; float a[8]; unpack8f(a, areg);
#pragma unroll
        for (int e = 0; e < 8; ++e) AS[t * 16 + 8 * hf + e] = a[e]; }
    const int d = tid & 31; const float bias = C.bias;
    __syncthreads();
#pragma unroll
    for (int i = 0; i < 8; ++i) { const int t = (tid >> 5) + 16 * i; float x = bias;
#pragma unroll
        for (int r = 0; r < 16; ++r) x += AS[t * 16 + r] * C.wcol[r];
        LA[t * 33 + d] = (fminf(x, 0.f) - __builtin_amdgcn_logf(1.0f + __builtin_amdgcn_exp2f(-fabsf(x) * LOG2E)) * 0.6931471805599453f) * (1.0f / 16.0f); }
    __syncthreads();
#pragma unroll
    for (int s8 = 0; s8 < 8; ++s8) { const int s = wave * 8 + s8, ch = s >> 5, dd = s & 31; float v = LA[(64 * ch + lane) * 33 + dd];
#pragma unroll
        for (int o = 1; o < 64; o <<= 1) { const float t = __shfl_up(v, o); if (lane >= o) v += t; }
        LA[(64 * ch + lane) * 33 + dd] = v; }
    __syncthreads();
}
__device__ __forceinline__ void la_stage_v(unsigned char* lds, const u32x4 (&v)[2], int tid) {
    bf16_t* VS = (bf16_t*)(lds + LA_VS);
#pragma unroll
    for (int i = 0; i < 2; ++i) { const int c = tid + 512 * i, t = c >> 3, oct = c & 7; *(u32x4*)(VS + t * 72 + 8 * oct) = v[i]; }
}
template <bool OUT, bool GLA>
__device__ __forceinline__ void la_load(LaRegs& R, KPRef p, int unit, int tid) {
    const int lane = tid & 63, wave = __builtin_amdgcn_readfirstlane(tid >> 6);
    int b, h, c128; if (GLA) { c128 = unit & 63; h = (unit >> 6) & 3; b = unit >> 8; } else { c128 = unit & 63; const int bh = unit >> 6; h = bh & 3; b = bh >> 2; }
    const size_t t0 = (size_t)b * S_ + (size_t)c128 * 128; const bf16_t* zrow0 = (const bf16_t*)(p.ws + WS_Z) + t0 * ZLD;
    const int kcol = GLA ? Z_GK + h * 32 : Z_RK + h * 32, qcol = GLA ? Z_GQ + h * 32 : Z_RQ + h * 32, vcol = GLA ? Z_GV + h * 64 : Z_RV + h * 64, gcol = GLA ? Z_GR + h * 64 : Z_RG + h * 64;
    if (GLA) { const int t = (tid & 255) >> 1, hf = tid & 1; R.a = *(const u32x4*)(zrow0 + (size_t)t * ZLD + Z_GA + 8 * hf); }
    { const int t = tid >> 2, oct = tid & 3; const bf16_t* kr = zrow0 + (size_t)t * ZLD + kcol; R.k[0] = *(const u32x4*)(kr + 8 * oct); if (!GLA) R.k[1] = *(const u32x4*)(kr + 8 * (oct ^ 2));
      if (OUT) { const bf16_t* qr = zrow0 + (size_t)t * ZLD + qcol; R.q[0] = *(const u32x4*)(qr + 8 * oct); if (!GLA) R.q[1] = *(const u32x4*)(qr + 8 * (oct ^ 2)); } }
#pragma unroll
    for (int i = 0; i < 2; ++i) { const int c = tid + 512 * i, t = c >> 3, oct = c & 7; R.v[i] = *(const u32x4*)(zrow0 + (size_t)t * ZLD + vcol + 8 * oct); }
    if (OUT) {
#pragma unroll
        for (int i = 0; i < 2; ++i) { const int cidx = lane + 64 * i, row = cidx >> 3, oct = cidx & 7; R.g[i] = *(const u32x4*)(zrow0 + (size_t)(16 * wave + row) * ZLD + gcol + 8 * oct); }
        const float* prev = GLA ? (const float*)(p.ws + WS_GKV) + (size_t)((b * 4 + h) * 128 + 2 * c128) * 2048 : (const float*)(p.ws + WS_RKV) + (size_t)unit * 2048;
        const int row = (GLA ? tid : (tid & 255)) >> 3, oct = tid & 7; R.pv[0] = *(const f32x4*)(prev + row * 64 + 8 * oct); R.pv[1] = *(const f32x4*)(prev + row * 64 + 8 * oct + 4); }
}
__device__ __forceinline__ void la_kv_mfma(unsigned char* lds, float* out0, int nch, int clen, int tid) {
    const bf16_t* KD = (const bf16_t*)(lds + LA_KD); const bf16_t* VS = (const bf16_t*)(lds + LA_VS);
    const int lane = tid & 63, wave = __builtin_amdgcn_readfirstlane(tid >> 6), c16 = lane & 15, g = lane >> 4;
    const int ntile = 8 * nch;
    for (int ti = wave; ti < ntile; ti += 8) { const int ch = ti >> 3, dt = (ti >> 2) & 1, et = ti & 3, tok0 = ch * clen;
        f32x4 acc = (f32x4){0.f, 0.f, 0.f, 0.f};
        for (int s = 0; s < clen / 32; ++s) { const int r0 = tok0 + 32 * s + 8 * g;
            acc = MFMA16(tr_frag(KD, 40, r0, r0 + 4, 16 * dt, lane), tr_frag(VS, 72, r0, r0 + 4, 16 * et, lane), acc); }
        float* o = out0 + (size_t)ch * 2048 + (16 * dt + 4 * g) * 64 + 16 * et + c16;
#pragma unroll
        for (int r = 0; r < 4; ++r) o[r * 64] = acc[r]; }
}
__device__ __forceinline__ void gla_kv_unit(KPRef p, int l, unsigned char* lds, int unit, const LaRegs& R, const LaConst& C, int tid) {
    const int c = unit & 63, h = (unit >> 6) & 3, b = unit >> 8;
    gla_decay_front(lds, R.a, C, tid);
    const float* LA = (const float*)(lds + LA_LA); bf16_t* KD = (bf16_t*)(lds + LA_KD);
    { const int t = tid >> 2, oct = tid & 3, ch = t >> 6; float k[8]; unpack8f(k, R.k[0]);
#pragma unroll
      for (int e = 0; e < 8; ++e) { const int d = 8 * oct + e; k[e] *= __builtin_amdgcn_exp2f((LA[(64 * ch + 63) * 33 + d] - LA[t * 33 + d]) * LOG2E); }
      *(u32x4*)(KD + t * 40 + 8 * oct) = pack8f(k); }
    la_stage_v(lds, R.v, tid);
    __syncthreads();
    const int cu = ((b * 4 + h) * 128 + 2 * c);
    la_kv_mfma(lds, (float*)(p.ws + WS_GKV) + (size_t)cu * 2048, 2, 64, tid);
    if (tid < 64) { const int ch = tid >> 5, d = tid & 31; ((float*)(p.ws + WS_GDEC))[(size_t)(cu + ch) * 32 + d] = __builtin_amdgcn_exp2f(LA[(64 * ch + 63) * 33 + d] * LOG2E); }
    __syncthreads();
}
__device__ __forceinline__ void la_out_mfma(unsigned char* lds, const u32x4 (&gate)[2], const LaConst& C, bf16_t* orow0, int ocol, int clen, int tid) {
    const bf16_t* QS = (const bf16_t*)(lds + LA_QS); const bf16_t* KS = (const bf16_t*)(lds + LA_KS); const bf16_t* VS = (const bf16_t*)(lds + LA_VS); const bf16_t* PS = (const bf16_t*)(lds + LA_PS);
    const int lane = tid & 63, wave = __builtin_amdgcn_readfirstlane(tid >> 6), c16 = lane & 15, g = lane >> 4;
    float* PWf = (float*)(lds + LA_PW + wave * LA_PW_WAVE);
    const int ch = (clen == 64) ? (wave >> 2) : 0, kt0 = (clen == 64) ? 4 * ch : 0;
    const bf16x8 qa = *(const bf16x8*)(QS + (16 * wave + c16) * 40 + 8 * g);
    f32x4 O[4];
#pragma unroll
    for (int et = 0; et < 4; ++et) O[et] = MFMA16(qa, tr_frag(PS + ch * 32 * 72, 72, 8 * g, 8 * g + 4, 16 * et, lane), ((f32x4){0.f, 0.f, 0.f, 0.f}));
    for (int s = kt0 >> 1; s <= (wave >> 1); ++s) {
        f32x4 P0, P1;
        { const int kt = 2 * s; P0 = MFMA16(*(const bf16x8*)(KS + (16 * kt + c16) * 40 + 8 * g), qa, ((f32x4){0.f, 0.f, 0.f, 0.f}));
          if (kt == wave) {
#pragma unroll
              for (int r = 0; r < 4; ++r) if (4 * g + r > c16) P0[r] = 0.f; } }
        { const int kt = 2 * s + 1;
          if (kt <= wave) { P1 = MFMA16(*(const bf16x8*)(KS + (16 * kt + c16) * 40 + 8 * g), qa, ((f32x4){0.f, 0.f, 0.f, 0.f}));
            if (kt == wave) {
#pragma unroll
                for (int r = 0; r < 4; ++r) if (4 * g + r > c16) P1[r] = 0.f; } }
          else P1 = (f32x4){0.f, 0.f, 0.f, 0.f}; }
        const bf16x8 pa = pack_p(P0, P1);
#pragma unroll
        for (int et = 0; et < 4; ++et) O[et] = MFMA16(pa, tr_frag(VS, 72, 32 * s + 4 * g, 32 * s + 16 + 4 * g, 16 * et, lane), O[et]); }
    float rs[4];
#pragma unroll
    for (int r = 0; r < 4; ++r) { float ss = O[0][r] * O[0][r] + O[1][r] * O[1][r] + O[2][r] * O[2][r] + O[3][r] * O[3][r];
#pragma unroll
        for (int o = 1; o < 16; o <<= 1) ss += __shfl_xor(ss, o);
        rs[r] = rsqrtf(ss * (1.0f / 64.0f) + NORM_EPS); }
#pragma unroll
    for (int et = 0; et < 4; ++et)
#pragma unroll
        for (int r = 0; r < 4; ++r) PWf[(4 * g + r) * 68 + 16 * et + c16] = O[et][r] * rs[r];
    LDS_WAIT();
#pragma unroll
    for (int i = 0; i < 2; ++i) { const int cidx = lane + 64 * i, row = cidx >> 3, oct = cidx & 7; const int t = 16 * wave + row;
        float gt[8]; unpack8f(gt, gate[i]);
        const f32x4 o0 = *(const f32x4*)(PWf + row * 68 + 8 * oct), o1 = *(const f32x4*)(PWf + row * 68 + 8 * oct + 4), n0 = C.n0, n1 = C.n1;
        float o[8];
#pragma unroll
        for (int e = 0; e < 4; ++e) { o[e] = o0[e] * n0[e] * (gt[e] * sigmoidf_(gt[e])); o[4 + e] = o1[e] * n1[e] * (gt[4 + e] * sigmoidf_(gt[4 + e])); }
        *(u32x4*)(orow0 + (size_t)t * OLD + ocol + 8 * oct) = pack8f(o); }
    LDS_WAIT();
}
__device__ __forceinline__ void gla_out_unit(KPRef p, int l, unsigned char* lds, int unit, const LaRegs& R, const LaConst& C, int tid) {
    const int c = unit & 63, h = (unit >> 6) & 3, b = unit >> 8;
    const size_t t0 = (size_t)b * S_ + (size_t)c * 128;
    gla_decay_front(lds, R.a, C, tid);
    const float* LA = (const float*)(lds + LA_LA); bf16_t* QS = (bf16_t*)(lds + LA_QS); bf16_t* KS = (bf16_t*)(lds + LA_KS); bf16_t* PS = (bf16_t*)(lds + LA_PS);
    { const int t = tid >> 2, oct = tid & 3; float k[8], q[8]; unpack8f(k, R.k[0]); unpack8f(q, R.q[0]);
#pragma unroll
      for (int e = 0; e < 8; ++e) { const float bb = LA[t * 33 + 8 * oct + e] * LOG2E; q[e] *= __builtin_amdgcn_exp2f(bb); k[e] *= __builtin_amdgcn_exp2f(-bb); }
      *(u32x4*)(QS + t * 40 + 8 * oct) = pack8f(q); *(u32x4*)(KS + t * 40 + 8 * oct) = pack8f(k); }
    la_stage_v(lds, R.v, tid);
    { const int row = tid >> 3, oct = tid & 7; float o[8] = {R.pv[0][0], R.pv[0][1], R.pv[0][2], R.pv[0][3], R.pv[1][0], R.pv[1][1], R.pv[1][2], R.pv[1][3]}; *(u32x4*)(PS + row * 72 + 8 * oct) = pack8f(o); }
    __syncthreads();
    la_out_mfma(lds, R.g, C, (bf16_t*)(p.ws + WS_O) + t0 * OLD, 0 + h * 64, 64, tid);
    __syncthreads();
}
__device__ __forceinline__ void rope_cs(float pos, float invf, float& c, float& s) {
    const float ang = pos * invf; const double t = (double)ang * 0.15915494309189535; const float fr = (float)(t - floor(t));
    c = __builtin_amdgcn_cosf(fr); s = __builtin_amdgcn_sinf(fr);
}
__device__ __forceinline__ void ret_cs_table(KPRef p, unsigned char* lds, int pos0, int tid) {
    f32x2* CS = (f32x2*)(lds + LA_LA);
#pragma unroll
    for (int i = 0; i < 4; ++i) { const int idx = tid + 512 * i, t = idx >> 4, f = idx & 15; float c, s; rope_cs((float)(pos0 + t), p.inv_freq[f], c, s); CS[idx] = (f32x2){c, s}; }
}
__device__ __forceinline__ void ret_rot8(const unsigned char* lds, const u32x4& own_q, const u32x4& oth_q, int t, int oct, float (&o)[8]) {
    const f32x2* CS = (const f32x2*)(lds + LA_LA); float own[8], oth[8]; unpack8f(own, own_q); unpack8f(oth, oth_q);
#pragma unroll
    for (int e = 0; e < 8; ++e) { const f32x2 cs = CS[t * 16 + 8 * (oct & 1) + e]; o[e] = (oct < 2) ? (own[e] * cs[0] - oth[e] * cs[1]) : (oth[e] * cs[1] + own[e] * cs[0]); }
}
__device__ __forceinline__ void ret_kv_unit(KPRef p, unsigned char* lds, int unit, const LaRegs& R, int tid) {
    const int n = unit & 63, bh = unit >> 6, h = bh & 3;
    ret_cs_table(p, lds, n * 128, tid);
    la_stage_v(lds, R.v, tid);
    __syncthreads();
    bf16_t* KD = (bf16_t*)(lds + LA_KD); const float lg = p.ret_lg2[h];
    { const int t = tid >> 2, oct = tid & 3; float k[8]; ret_rot8(lds, R.k[0], R.k[1], t, oct, k); const float dk = __builtin_amdgcn_exp2f((float)(127 - t) * lg);
#pragma unroll
      for (int e = 0; e < 8; ++e) k[e] *= dk;
      *(u32x4*)(KD + t * 40 + 8 * oct) = pack8f(k); }
    __syncthreads();
    la_kv_mfma(lds, (float*)(p.ws + WS_RKV) + (size_t)unit * 2048, 1, 128, tid);
    __syncthreads();
}
__device__ __forceinline__ void ret_out_unit(KPRef p, int l, unsigned char* lds, int unit, const LaRegs& R, const LaConst& C, int tid) {
    const int n = unit & 63, bh = unit >> 6, h = bh & 3, b = bh >> 2;
    const size_t t0 = (size_t)b * S_ + (size_t)n * 128;
    ret_cs_table(p, lds, n * 128, tid);
    la_stage_v(lds, R.v, tid);
    const float lg = p.ret_lg2[h]; bf16_t* PS = (bf16_t*)(lds + LA_PS); const float g1 = __builtin_amdgcn_exp2f(lg);
    if (tid < 256) { const int row = tid >> 3, oct = tid & 7;
      float o[8] = {R.pv[0][0] * g1, R.pv[0][1] * g1, R.pv[0][2] * g1, R.pv[0][3] * g1, R.pv[1][0] * g1, R.pv[1][1] * g1, R.pv[1][2] * g1, R.pv[1][3] * g1}; *(u32x4*)(PS + row * 72 + 8 * oct) = pack8f(o); }
    __syncthreads();
    bf16_t* QS = (bf16_t*)(lds + LA_QS); bf16_t* KS = (bf16_t*)(lds + LA_KS);
    { const int t = tid >> 2, oct = tid & 3; float k[8], q[8]; ret_rot8(lds, R.k[0], R.k[1], t, oct, k); ret_rot8(lds, R.q[0], R.q[1], t, oct, q);
      const float dq = __builtin_amdgcn_exp2f((float)t * lg), dk = __builtin_amdgcn_exp2f(-(float)t * lg);
#pragma unroll
      for (int e = 0; e < 8; ++e) { q[e] *= dq; k[e] *= dk; }
      *(u32x4*)(QS + t * 40 + 8 * oct) = pack8f(q); *(u32x4*)(KS + t * 40 + 8 * oct) = pack8f(k); }
    __syncthreads();
    la_out_mfma(lds, R.g, C, (bf16_t*)(p.ws + WS_O) + t0 * OLD, 768 + h * 64, 128, tid);
    __syncthreads();
}
template <int KIND>
__device__ __forceinline__ void la_loop(KPRef p, int l, unsigned char* lds, int wg, int tid) {
    constexpr bool OUT = KIND >= 2, GLA = (KIND & 1) == 0; constexpr int NU = 1024, G = 256;
    int u = wg; if (u >= NU) return;
    const LaConst C = la_const<KIND>(p, l, u, tid);
    LaRegs R; la_load<OUT, GLA>(R, p, u, tid);
    for (;;) {
        const int un = u + G; const bool hn = un < NU;
        LaRegs Rn; if (hn) la_load<OUT, GLA>(Rn, p, un, tid);
        if (KIND == 0) gla_kv_unit(p, l, lds, u, R, C, tid); else if (KIND == 1) ret_kv_unit(p, lds, u, R, tid); else if (KIND == 2) gla_out_unit(p, l, lds, u, R, C, tid); else ret_out_unit(p, l, lds, u, R, C, tid);
        if (!hn) break;
        R = Rn; u = un;
    }
}

__device__ __forceinline__ void scan_phase(KPRef p, int wg, int tid) {
    if (wg < 64) {
        const int bh = wg >> 2, elem = (wg & 3) * 512 + tid, d = elem >> 6;
        float* base = (float*)(p.ws + WS_GKV) + (size_t)bh * 128 * 2048 + elem; const float* dec = (const float*)(p.ws + WS_GDEC) + (size_t)bh * 128 * 32 + d;
        float s = 0.f;
#pragma unroll 1
        for (int n0 = 0; n0 < 128; n0 += 32) { float kv[32], dc[32];
#pragma unroll
            for (int j = 0; j < 32; ++j) { kv[j] = base[(size_t)(n0 + j) * 2048]; dc[j] = dec[(n0 + j) * 32]; }
#pragma unroll
            for (int j = 0; j < 32; ++j) { base[(size_t)(n0 + j) * 2048] = s; s = dc[j] * s + kv[j]; } }
    } else if (wg < 128) {
        const int w2 = wg - 64, bh = w2 >> 2, h = bh & 3, elem = (w2 & 3) * 512 + tid;
        float* base = (float*)(p.ws + WS_RKV) + (size_t)bh * 64 * 2048 + elem; const float dc = __builtin_amdgcn_exp2f(128.0f * p.ret_lg2[h]);
        float s = 0.f;
#pragma unroll 1
        for (int n0 = 0; n0 < 64; n0 += 32) { float kv[32];
#pragma unroll
            for (int j = 0; j < 32; ++j) kv[j] = base[(size_t)(n0 + j) * 2048];
#pragma unroll
            for (int j = 0; j < 32; ++j) { base[(size_t)(n0 + j) * 2048] = s; s = dc * s + kv[j]; } }
    }
}

__device__ __forceinline__ void kmean_unit(KPRef p, float* sm, int unit, int tid) {
    const bf16_t* z = (const bf16_t*)(p.ws + WS_Z); const size_t t0 = (size_t)unit * 256;
    const int oct = tid & 31, grp = tid >> 5; float s[8] = {0.f, 0.f, 0.f, 0.f, 0.f, 0.f, 0.f, 0.f};
    u32x4 q[16];
#pragma unroll
    for (int i = 0; i < 16; ++i) q[i] = *(const u32x4*)(z + (t0 + grp * 16 + i) * ZLD + Z_MK + 8 * oct);
#pragma unroll
    for (int i = 0; i < 16; ++i) { float v[8]; unpack8f(v, q[i]);
#pragma unroll
        for (int e = 0; e < 8; ++e) s[e] += v[e]; }
#pragma unroll
    for (int e = 0; e < 8; ++e) sm[grp * 264 + 8 * oct + e] = s[e];
    __syncthreads();
    if (tid < 256) { float a = 0.f;
#pragma unroll
        for (int g2 = 0; g2 < 16; ++g2) a += sm[g2 * 264 + tid];
        ((float*)(p.ws + WS_KMEAN))[(size_t)unit * 256 + tid] = a * (1.0f / 256.0f); }
    __syncthreads();
}

constexpr int AT_BUF = 65536  , AT_PW = 131072, AT_PW_WAVE = 2304, AT_WSF = 149504, LDS_MTAB = 151552;
__device__ __forceinline__ void att_dma(unsigned char* lds, int buf, const bf16_t* kg, const bf16_t* vg, int key_lo_valid, int tid) {
    const int lane = tid & 63, wave = __builtin_amdgcn_readfirstlane(tid >> 6);
#pragma unroll
    for (int i = 0; i < 4; ++i) { const int j = wave * 4 + i, row = 8 * j + (lane >> 3), pos = lane & 7; const int srow = row < key_lo_valid ? key_lo_valid : row;
        const size_t goff = (size_t)srow * ZLD + 8 * (pos ^ (row & 7));
        __builtin_amdgcn_global_load_lds((const unsigned*)(kg + goff), (LAS unsigned*)(LAS unsigned char*)(lds + buf * AT_BUF + j * 1024), 16, 0, 0);
        __builtin_amdgcn_global_load_lds((const unsigned*)(vg + goff), (LAS unsigned*)(LAS unsigned char*)(lds + buf * AT_BUF + 32768 + j * 1024), 16, 0, 0); }
}
struct QPtrs { int tag[2]; };
template <class Fn>
__device__ __forceinline__ QPtrs att_qptrs(const Fn& F, int tid) {
    const int lane = tid & 63, wave = __builtin_amdgcn_readfirstlane(tid >> 6), c16 = lane & 15; QPtrs q;
#pragma unroll
    for (int rt = 0; rt < 2; ++rt) { const int row = (rt ? 240 - 16 * wave : 16 * wave) + c16; q.tag[rt] = F.rowtag(row); }
    return q;
}
template <class Fn>
__device__ __forceinline__ void att_loadq(bf16x8 (&Q)[2][2], const Fn& F, const QPtrs& qp, int tid) {
    const int lane = tid & 63, wave = __builtin_amdgcn_readfirstlane(tid >> 6), c16 = lane & 15, g = lane >> 4;
#pragma unroll
    for (int rt = 0; rt < 2; ++rt) { const bf16_t* rp = F.rowptr((rt ? 240 - 16 * wave : 16 * wave) + c16, qp.tag[rt]); Q[rt][0] = *(const bf16x8*)(rp + 8 * g); Q[rt][1] = *(const bf16x8*)(rp + 32 + 8 * g); }
}
__device__ __forceinline__ bf16x8 tr_frag_sw(const unsigned char* tile, int rowa, int rowb, int col0, int lane) {
    const int i = lane & 15, q = i >> 2, pp = i & 3, ch = (col0 >> 3) + (pp >> 1), sub = (pp & 1) * 8, ra = rowa + q, rb = rowb + q;
    const v4i16_t lo = lds_tr16((const bf16_t*)(tile + ra * 128 + ((ch ^ (ra & 7)) << 4) + sub)), hi = lds_tr16((const bf16_t*)(tile + rb * 128 + ((ch ^ (rb & 7)) << 4) + sub));
    return (bf16x8){lo[0], lo[1], lo[2], lo[3], hi[0], hi[1], hi[2], hi[3]};
}
__device__ __forceinline__ unsigned cvt_pk_c(float lo, float hi) { return pg8::cvt_pk_bf16(lo, hi); }
__device__ __forceinline__ float max3f_(float a, float b2, float c) { return __builtin_fmaxf(__builtin_fmaxf(a, b2), c); }
template <class Fn>
__device__ __forceinline__ void att_compute(unsigned char* lds, int buf, const Fn& F, const Fn& Fnext, bf16x8 (&Q)[2][2], const QPtrs& qcur, const QPtrs& qnext, bool has_next, const bf16_t* kgn, const bf16_t* vgn, int lon, int tid) {
    const int lane = tid & 63, wave = __builtin_amdgcn_readfirstlane(tid >> 6), c16 = lane & 15, g = lane >> 4;
    const unsigned char* KS = lds + buf * AT_BUF; const unsigned char* VS = KS + 32768; bf16_t* PW = (bf16_t*)(lds + AT_PW + wave * AT_PW_WAVE); float* WSF = (float*)(lds + AT_WSF + wave * 256);
#pragma unroll 1
    for (int rt = 0; rt < 2; ++rt) {
        const int rbase = rt ? 240 - 16 * wave : 16 * wave;
        if (F.skip(rbase)) { if (rt == 1 && has_next) { att_loadq(Q, Fnext, qnext, tid); if (!Fn::DMA_EARLY) att_dma(lds, buf ^ 1, kgn, vgn, lon, tid); } continue; }
        const bf16x8 qa0 = rt ? Q[1][0] : Q[0][0], qa1 = rt ? Q[1][1] : Q[0][1];
        f32x4 S[16]; float m = -1e30f;
#pragma unroll
        for (int ct = 0; ct < 16; ++ct) {
            if (F.live(rbase, ct)) {
                const int R = 16 * ct + c16; const unsigned char* kp = KS + R * 128;
                const bf16x8 k0 = *(const bf16x8*)(kp + ((g ^ (R & 7)) << 4)), k1 = *(const bf16x8*)(kp + (((4 + g) ^ (R & 7)) << 4));
                f32x4 acc = (f32x4){0.f, 0.f, 0.f, 0.f}; acc = MFMA16(k0, qa0, acc); acc = MFMA16(k1, qa1, acc);
                if (Fn::MASKED) { if (F.partial(rbase, ct)) {
#pragma unroll
                    for (int r = 0; r < 4; ++r) { int kk = 16 * ct + 4 * g + r; asm volatile("" : "+v"(kk), "+v"(acc[r]));
                        acc[r] += F.pen(rbase + c16, kk); } } }
                m = max3f_(m, max3f_(acc[0], acc[1], acc[2]), acc[3]); S[ct] = acc;
            } else S[ct] = (f32x4){-1e30f, -1e30f, -1e30f, -1e30f};
        }
        if (rt == 1 && has_next) { att_loadq(Q, Fnext, qnext, tid); if (!Fn::DMA_EARLY) att_dma(lds, buf ^ 1, kgn, vgn, lon, tid); }
        m = fmaxf(m, __shfl_xor(m, 16)); m = fmaxf(m, __shfl_xor(m, 32));
        u32x2 Pk[16];
#pragma unroll
        for (int ct = 0; ct < 16; ++ct) {
            if (F.live(rbase, ct)) { const float p0 = __builtin_amdgcn_exp2f(S[ct][0] - m), p1 = __builtin_amdgcn_exp2f(S[ct][1] - m), p2 = __builtin_amdgcn_exp2f(S[ct][2] - m), p3 = __builtin_amdgcn_exp2f(S[ct][3] - m);
                Pk[ct].x = cvt_pk_c(p0, p1); Pk[ct].y = cvt_pk_c(p2, p3);
            } else Pk[ct] = (u32x2){0u, 0u};
        }
        const typename Fn::Pre pre = F.prefetch(rbase, lane);
        f32x4 O[4], OL = (f32x4){0.f, 0.f, 0.f, 0.f};
        const bf16x8 ones = (bf16x8){0x3F80, 0x3F80, 0x3F80, 0x3F80, 0x3F80, 0x3F80, 0x3F80, 0x3F80};
#pragma unroll
        for (int dt = 0; dt < 4; ++dt) O[dt] = (f32x4){0.f, 0.f, 0.f, 0.f};
#pragma unroll
        for (int s8 = 0; s8 < 8; ++s8) if (F.live(rbase, 2 * s8) || F.live(rbase, 2 * s8 + 1)) { const bf16x8 pa = __builtin_bit_cast(bf16x8, ((u32x4){Pk[2 * s8].x, Pk[2 * s8].y, Pk[2 * s8 + 1].x, Pk[2 * s8 + 1].y}));
            OL = MFMA16(pa, ones, OL);
#pragma unroll
            for (int dt = 0; dt < 4; ++dt) O[dt] = MFMA16(pa, tr_frag_sw(VS, 32 * s8 + 4 * g, 32 * s8 + 16 + 4 * g, 16 * dt, lane), O[dt]); }
        float f[4];
        const int mytag = rt ? qcur.tag[1] : qcur.tag[0];
#pragma unroll
        for (int r = 0; r < 4; ++r) { const float mr = __shfl(m, 4 * g + r); const int tg = __shfl(mytag, 4 * g + r); f[r] = F.scale(rbase + 4 * g + r, mr, OL[r], pre, r, WSF + (4 * g + r) * 4, c16 == 0, tg); }
        if (Fn::DMA_EARLY && rt == 0 && has_next) att_dma(lds, buf ^ 1, kgn, vgn, lon, tid);
#pragma unroll
        for (int dt = 0; dt < 4; ++dt)
#pragma unroll
            for (int r = 0; r < 4; ++r) PW[(4 * g + r) * 72 + 16 * dt + c16] = (bf16_t)f2bf(O[dt][r] * f[r]);
        LDS_WAIT();
        { const int rowa = lane >> 3, rowb = rowa + 8, oct = lane & 7;
          const u32x4 va = *(const u32x4*)(PW + rowa * 72 + 8 * oct), vb = *(const u32x4*)(PW + rowb * 72 + 8 * oct);
          F.store2(rbase + rowa, rbase + rowb, oct, va, vb, pre, WSF + rowa * 4, WSF + rowb * 4, __shfl(mytag, rowa), __shfl(mytag, rowb)); }
        LDS_WAIT();
    }
}
template <class Fn, class Gen>
__device__ __forceinline__ void attn_loop(unsigned char* lds, const Gen& G, int tid) {
    Fn Fc, Fx; const bf16_t* kg; const bf16_t* vg; int lo;
    bool have = G.get(0, Fc, kg, vg, lo);
    if (!have) return;
    bf16x8 Q[2][2];
    QPtrs qc = att_qptrs(Fc, tid);
    att_dma(lds, 0, kg, vg, lo, tid); att_loadq(Q, Fc, qc, tid);
    int buf = 0;
    for (int i = 1; have; ++i) {
        asm volatile("s_waitcnt vmcnt(0)" ::: "memory");
        __syncthreads();
        const bool hn = G.get(i, Fx, kg, vg, lo);
        QPtrs qn = qc;
        if (hn) qn = att_qptrs(Fx, tid);
        att_compute(lds, buf, Fc, Fx, Q, qc, qn, hn, kg, vg, lo, tid);
        Fc = Fx; have = hn; buf ^= 1; qc = qn;
    }
    asm volatile("s_waitcnt vmcnt(0)" ::: "memory");
    __syncthreads();
}
struct NoPre {};

struct SwaFn { typedef NoPre Pre; static constexpr bool MASKED = true; static constexpr bool DMA_EARLY = false;
    __device__ __forceinline__ bool skip(int) const { return false; }
    __device__ __forceinline__ void store2(int ra, int rb, int oct, u32x4 va, u32x4 vb, const NoPre& P, const float* wa, const float* wb, int ta, int tb_) const { store(ra, oct, va, P, 0, wa, ta); store(rb, oct, vb, P, 1, wb, tb_); }
    __device__ __forceinline__ bool live(int rbase, int ct) const { const int i0 = rbase & 127; return 16 * ct + 15 >= i0 + 1 && 16 * ct <= i0 + 143 && (q0 != 0 || ct >= 8); }
    __device__ __forceinline__ bool partial(int rbase, int ct) const { const int t0_ = (rbase & 127) >> 4; return ct == t0_ || ct == t0_ + 8; }     const bf16_t* z; bf16_t* ob; size_t tb; int q0, kvh; float sink2_0, sink2_1;
    __device__ __forceinline__ int rowtag(int) const { return 0; }
    __device__ __forceinline__ const bf16_t* rowptr(int row, int) const { return z + (tb + q0 + (row & 127)) * ZLD + Z_SQ + (kvh * 2 + (row >> 7)) * 64; }
    __device__ __forceinline__ float pen(int row, int kk) const { const int d = (row & 127) + 128 - kk; return __int_as_float(((d | (127 - d) | (q0 - 128 + kk)) >> 31) & (int)0xF149F2CAu); }
    __device__ __forceinline__ NoPre prefetch(int, int) const { return NoPre{}; }
    __device__ __forceinline__ float scale(int row, float m, float l, const NoPre&, int, float*, bool, int) const { const float sk = (row >> 7) ? sink2_1 : sink2_0; const float M = fmaxf(m, sk), w0 = __builtin_amdgcn_exp2f(m - M);
        return w0 / (l * w0 + __builtin_amdgcn_exp2f(sk - M)); }
    __device__ __forceinline__ void store(int row, int oct, u32x4 v, const NoPre&, int, const float*, int) const { *(u32x4*)(ob + (tb + q0 + (row & 127)) * OLD + 256 + (kvh * 2 + (row >> 7)) * 64 + 8 * oct) = v; }
};
struct SwaGen { const bf16_t* z; bf16_t* ob; const float* sinks; int wg, G;
    __device__ __forceinline__ bool get(int i, SwaFn& F, const bf16_t*& kg, const bf16_t*& vg, int& lo) const {
        const int unit = wg + i * G; if (unit >= 512) return false;
        const int qb = unit & 63, kvh = (unit >> 6) & 1, b = unit >> 7; const size_t tb = (size_t)b * S_; const int q0 = qb * 128;
        F = SwaFn{z, ob, tb, q0, kvh, sinks[kvh * 2] * LOG2E, sinks[kvh * 2 + 1] * LOG2E};
        const long kb = (long)tb + q0 - 128;
        kg = z + kb * ZLD + Z_SK + kvh * 64; vg = z + kb * ZLD + Z_SV + kvh * 64; lo = (q0 == 0) ? 128 : 0; return true; }
};

constexpr int ML_PER_BH = 126976;
__device__ __forceinline__ int ml_off(int j) { return 256 * (31 * j - (j * (j - 1)) / 2); }
__device__ __forceinline__ void moba_select(KPRef p, unsigned char* lds, int wg, int tid) {
    const int gid = wg * NTHREADS + tid, t = gid >> 2, h = gid & 3, b = t >> 13, tl = t & 8191, blk = tl >> 8;
    const bf16_t* z = (const bf16_t*)(p.ws + WS_Z);
    f32x4* kml = (f32x4*)lds; const f32x4* kmg = (const f32x4*)((const float*)(p.ws + WS_KMEAN) + (size_t)b * 32 * 256);
    for (int i = tid; i < blk * 64; i += NTHREADS) kml[i] = kmg[i];
    float q[64];
    { const bf16_t* qp = z + (size_t)t * ZLD + Z_MQ + h * 64;
#pragma unroll
      for (int c = 0; c < 8; ++c) { const u32x4 kk = *(const u32x4*)(qp + 8 * c);
        q[8 * c + 0] = __uint_as_float(kk.x << 16); q[8 * c + 1] = __uint_as_float(kk.x & 0xffff0000u); q[8 * c + 2] = __uint_as_float(kk.y << 16); q[8 * c + 3] = __uint_as_float(kk.y & 0xffff0000u);
        q[8 * c + 4] = __uint_as_float(kk.z << 16); q[8 * c + 5] = __uint_as_float(kk.z & 0xffff0000u); q[8 * c + 6] = __uint_as_float(kk.w << 16); q[8 * c + 7] = __uint_as_float(kk.w & 0xffff0000u); } }
    __syncthreads();
    float v0 = -3e38f, v1 = -3e38f, v2 = -3e38f; int i0 = -1, i1 = -1, i2 = -1;
#pragma unroll 1
    for (int nb = 0; nb < blk; ++nb) { const f32x4* kr = kml + nb * 64 + h * 16; float s = 0.f;
#pragma unroll
        for (int c = 0; c < 16; ++c) { const f32x4 kv = kr[c]; s += q[4 * c] * kv[0] + q[4 * c + 1] * kv[1] + q[4 * c + 2] * kv[2] + q[4 * c + 3] * kv[3]; }
        if (s > v0) { v2 = v1; i2 = i1; v1 = v0; i1 = i0; v0 = s; i0 = nb; } else if (s > v1) { v2 = v1; i2 = i1; v1 = s; i1 = nb; } else if (s > v2) { v2 = s; i2 = nb; } }
    int* cnt = (int*)(p.ws + WS_MCNT) + (b * 4 + h) * 32; int* lst = (int*)(p.ws + WS_MLIST) + (size_t)(b * 4 + h) * ML_PER_BH; f32x2* pml = (f32x2*)(p.ws + WS_PARTML) + (size_t)gid * 3;
#pragma unroll
    for (int s3 = 0; s3 < 3; ++s3) { const int sb = (s3 == 0) ? i0 : (s3 == 1 ? i1 : i2);
        if (sb >= 0) { const int pos = atomicAdd(cnt + sb, 1); lst[ml_off(sb) + pos] = tl | (s3 << 13); }
        else { float ng_ = -1e30f, zr_ = 0.f; asm volatile("" : "+v"(ng_), "+v"(zr_)); pml[s3] = (f32x2){ng_, zr_}; } }
    __syncthreads();
}
struct MobaSelFn { typedef NoPre Pre; static constexpr bool MASKED = false; static constexpr bool DMA_EARLY = false;
    __device__ __forceinline__ bool skip(int rbase) const { return rbase >= n_valid; }
    __device__ __forceinline__ void store2(int ra, int rb, int oct, u32x4 va, u32x4 vb, const NoPre& P, const float* wa, const float* wb, int ta, int tb_) const { store(ra, oct, va, P, 0, wa, ta); store(rb, oct, vb, P, 1, wb, tb_); }
    __device__ __forceinline__ bool live(int, int) const { return true; }
    __device__ __forceinline__ bool partial(int, int) const { return false; } const bf16_t* z; const int* lst; bf16_t* po; f32x2* pml; size_t tb; int h, n_valid;
    __device__ __forceinline__ int entry(int row) const { return lst[row < n_valid ? row : 0]; }
    __device__ __forceinline__ int rowtag(int row) const { return entry(row); }
    __device__ __forceinline__ const bf16_t* rowptr(int, int e) const { return z + (tb + (e & 8191)) * ZLD + Z_MQ + h * 64; }
    __device__ __forceinline__ float pen(int, int) const { return 0.f; }
    __device__ __forceinline__ NoPre prefetch(int, int) const { return NoPre{}; }
    __device__ __forceinline__ size_t pidx(int e) const { return ((tb + (e & 8191)) * 4 + h) * 3 + (e >> 13); }
    __device__ __forceinline__ float scale(int row, float m, float l, const NoPre&, int, float*, bool writer, int e) const { if (writer && row < n_valid) pml[pidx(e)] = (f32x2){m, l}; return 1.0f / l; }
    __device__ __forceinline__ void store(int row, int oct, u32x4 v, const NoPre&, int, const float*, int e) const { if (row < n_valid) *(u32x4*)(po + pidx(e) * 64 + 8 * oct) = v; }
};
__device__ __forceinline__ void moba_sel_table(KPRef p, unsigned char* lds, int tid) {
    int* tab = (int*)(lds + LDS_MTAB); const int lane = tid & 63, wave = tid >> 6;
    const int cnt = ((const int*)(p.ws + WS_MCNT))[tid]; int v = (cnt + 255) >> 8;
    const int own = v;
#pragma unroll
    for (int o = 1; o < 64; o <<= 1) { const int t = __shfl_up(v, o); if (lane >= o) v += t; }
    if (lane == 63) tab[520 + wave] = v;
    __syncthreads();
    int base = 0;
    for (int w = 0; w < wave; ++w) base += tab[520 + w];
    tab[tid] = base + v - own;
    tab[544 + tid] = cnt;
    if (tid == 511) tab[512] = base + v;
    __syncthreads();
}
struct MobaSelGen { const bf16_t* z; const int* lists; const int* cnts; bf16_t* po; f32x2* pml; const int* tab; int wg, G;
    __device__ __forceinline__ bool get(int i, MobaSelFn& F, const bf16_t*& kg, const bf16_t*& vg, int& lo) const {
        const int u = wg + i * G; if (u >= tab[512]) return false;
        int lo_ = 0, hi_ = 511;
        while (lo_ < hi_) { const int mid = (lo_ + hi_ + 1) >> 1; if (tab[mid] <= u) lo_ = mid; else hi_ = mid - 1; }
        const int k = __builtin_amdgcn_readfirstlane(lo_), c = u - tab[k], bh = k >> 5, j = k & 31, b = bh >> 2, h = bh & 3;
        const int cnt = tab[544 + k]; const int nv = cnt - c * 256; const size_t tb = (size_t)b * S_;
        F = MobaSelFn{z, lists + (size_t)bh * ML_PER_BH + ml_off(j) + c * 256, po, pml, tb, h, nv < 256 ? nv : 256};
        kg = z + (tb + j * 256) * ZLD + Z_MK + h * 64; vg = z + (tb + j * 256) * ZLD + Z_MV + h * 64; lo = 0; return true; }
};
struct OwnPre { f32x2 ml[4][3]; };
struct MobaOwnFn { typedef OwnPre Pre; static constexpr bool MASKED = true; static constexpr bool DMA_EARLY = true;
    __device__ __forceinline__ bool skip(int) const { return false; }
    __device__ __forceinline__ bool live(int rbase, int ct) const { return 16 * ct <= rbase + 15; }
    __device__ __forceinline__ bool partial(int rbase, int ct) const { return 16 * ct == rbase; }     const bf16_t* z; bf16_t* ob; const bf16_t* po; const f32x2* pml; size_t t0; int h;
    __device__ __forceinline__ int rowtag(int) const { return 0; }
    __device__ __forceinline__ const bf16_t* rowptr(int row, int) const { return z + (t0 + row) * ZLD + Z_MQ + h * 64; }
    __device__ __forceinline__ float pen(int row, int kk) const { return __int_as_float(((row - kk) >> 31) & (int)0xF149F2CAu); }
    __device__ __forceinline__ OwnPre prefetch(int rbase, int lane) const { OwnPre P; const int g = lane >> 4;
#pragma unroll
        for (int r = 0; r < 4; ++r) { const f32x2* ml = pml + ((t0 + rbase + 4 * g + r) * 4 + h) * 3;
#pragma unroll
            for (int s = 0; s < 3; ++s) P.ml[r][s] = ml[s]; }
        return P; }
    __device__ __forceinline__ float scale(int row, float m, float l, const OwnPre& P, int r, float* wsf, bool writer, int) const {
        const f32x2 a = P.ml[r][0], b = P.ml[r][1], c = P.ml[r][2];
        const float M = fmaxf(fmaxf(m, a[0]), fmaxf(b[0], c[0]));
        const float w0 = __builtin_amdgcn_exp2f(m - M), wa = a[1] * __builtin_amdgcn_exp2f(a[0] - M), wb = b[1] * __builtin_amdgcn_exp2f(b[0] - M), wc = c[1] * __builtin_amdgcn_exp2f(c[0] - M);
        const float inv = 1.0f / (l * w0 + wa + wb + wc);
        if (writer) { wsf[0] = wa * inv; wsf[1] = wb * inv; wsf[2] = wc * inv; }
        return w0 * inv; }
    __device__ __forceinline__ void store2(int ra, int rb, int oct, u32x4 va, u32x4 vb, const OwnPre&, const float* wfa, const float* wfb, int, int) const {
        const bf16_t* pa = po + (((t0 + ra) * 4 + h) * 3) * 64 + 8 * oct; const bf16_t* pb = po + (((t0 + rb) * 4 + h) * 3) * 64 + 8 * oct;
        u32x4 pca[3], pcb[3];
#pragma unroll
        for (int s = 0; s < 3; ++s) { pca[s] = (wfa[s] != 0.f) ? *(const u32x4*)(pa + s * 64) : (u32x4){0u, 0u, 0u, 0u}; pcb[s] = (wfb[s] != 0.f) ? *(const u32x4*)(pb + s * 64) : (u32x4){0u, 0u, 0u, 0u}; }
        float oa[8], ob8[8]; unpack8f(oa, va); unpack8f(ob8, vb);
#pragma unroll
        for (int s = 0; s < 3; ++s) { const float wa_ = wfa[s], wb_ = wfb[s]; float qa[8], qb[8]; unpack8f(qa, pca[s]); unpack8f(qb, pcb[s]);
#pragma unroll
            for (int e = 0; e < 8; ++e) { oa[e] += wa_ * qa[e]; ob8[e] += wb_ * qb[e]; } }
        *(u32x4*)(ob + (t0 + ra) * OLD + 512 + h * 64 + 8 * oct) = pack8f(oa);
        *(u32x4*)(ob + (t0 + rb) * OLD + 512 + h * 64 + 8 * oct) = pack8f(ob8); }
};
struct MobaOwnGen { const bf16_t* z; bf16_t* ob; const bf16_t* po; const f32x2* pml; int wg, G;
    __device__ __forceinline__ bool get(int i, MobaOwnFn& F, const bf16_t*& kg, const bf16_t*& vg, int& lo) const {
        const int unit = wg + i * G; if (unit >= 512) return false;
        const int qb = unit & 31, h = (unit >> 5) & 3, b = unit >> 7; const size_t t0 = (size_t)b * S_ + (size_t)qb * 256;
        F = MobaOwnFn{z, ob, po, pml, t0, h}; kg = z + t0 * ZLD + Z_MK + h * 64; vg = z + t0 * ZLD + Z_MV + h * 64; lo = 0; return true; }
};

__device__ __forceinline__ void route_phase(KPRef p, int l, float* sm, int wg, int tid) {
    int* se = (int*)sm;
    int* toke = (int*)(p.ws + WS_TOKE); float* tokw = (float*)(p.ws + WS_TOKW); int* tokr = (int*)(p.ws + WS_TOKR); int* hist = (int*)(p.ws + WS_HIST); int* sdst = (int*)(p.ws + WS_SDST);
    if (tid < 128) { const int t = wg * 128 + tid; const float* lg = (const float*)(p.ws + WS_LOGIT) + (size_t)t * 64; const float* bg = p.in[12] + l * 4; const float* be = p.in[14] + l * 32;
        const float rs = ((const float*)(p.ws + WS_RSTD))[t];
        float g0 = lg[0] * rs + bg[0], g1 = lg[1] * rs + bg[1], g2 = lg[2] * rs + bg[2], g3 = lg[3] * rs + bg[3];
        int gs = 0; float gm = g0; if (g1 > gm) { gm = g1; gs = 1; } if (g2 > gm) { gm = g2; gs = 2; } if (g3 > gm) { gm = g3; gs = 3; }
        const float gw_ = 1.0f / (expf(g0 - gm) + expf(g1 - gm) + expf(g2 - gm) + expf(g3 - gm));
        float v0 = -3e38f, v1 = -3e38f; int i0 = 0, i1 = 0;
#pragma unroll
        for (int j = 0; j < 8; ++j) { const float s = lg[4 + 8 * gs + j] * rs + be[8 * gs + j]; if (s > v0) { v1 = v0; i1 = i0; v0 = s; i0 = j; } else if (s > v1) { v1 = s; i1 = j; } }
        const float e1 = expf(v1 - v0), w0 = 1.0f / (1.0f + e1), w1 = e1 * w0;
        const int ea = 8 * gs + i0, eb = 8 * gs + i1;
        se[2 * tid] = ea; se[2 * tid + 1] = eb; toke[2 * t] = ea; toke[2 * t + 1] = eb; tokw[2 * t] = w0 * gw_; tokw[2 * t + 1] = w1 * gw_; }
    __syncthreads();
    if (tid < 256) { const int e = se[tid]; int r = 0;
#pragma unroll 4
        for (int a = 0; a < tid; ++a) r += (se[a] == e) ? 1 : 0; tokr[wg * 256 + tid] = r; }
    if (tid >= 256 && tid < 288) { const int e = tid - 256; int c = 0;
#pragma unroll 4
        for (int a = 0; a < 256; ++a) c += (se[a] == e) ? 1 : 0; hist[wg * 32 + e] = c; }
    for (int i = tid; i < NSLOTBLK; i += NTHREADS) sdst[wg * NSLOTBLK + i] = YS_TRASH_ROW;
    __syncthreads();
}
__device__ __forceinline__ void assign_phase(KPRef p, float* sm, int wg, int tid, int wave, int lane) {
    int* cnt = (int*)sm, *bas = cnt + 32, *pend = cnt + 64, *slot_of = cnt + 128;
    const int* hist = (const int*)(p.ws + WS_HIST); const int* toke = (const int*)(p.ws + WS_TOKE); const int* tokr = (const int*)(p.ws + WS_TOKR);
    int* sdst = (int*)(p.ws + WS_SDST); int* blke = (int*)(p.ws + WS_BLKE);
    {
        int* part = cnt + 512;
        const int e = tid & 31, grp = tid >> 5; int c = 0, bb = 0; int v[16];
#pragma unroll
        for (int i = 0; i < 16; ++i) v[i] = hist[(grp * 16 + i) * 32 + e];
#pragma unroll
        for (int i = 0; i < 16; ++i) { c += v[i]; if (grp * 16 + i < wg) bb += v[i]; }
        part[grp * 64 + e] = c; part[grp * 64 + 32 + e] = bb;
        __syncthreads();
        if (tid < 32) { int cs = 0, bs = 0;
#pragma unroll
            for (int g2 = 0; g2 < 16; ++g2) { cs += part[g2 * 64 + tid]; bs += part[g2 * 64 + 32 + tid]; }
            cnt[tid] = cs; bas[tid] = bs; }
    }
    __syncthreads();
    if (tid == 0) { int run = 0; for (int e = 0; e < 32; ++e) { const int pad = ((cnt[e] + 255) >> 8) << 8; bas[e] += run; run += pad; pend[e] = run; } }
    __syncthreads();
    if (wg == 0) { if (tid < NSLOTBLK) { int e = 0; for (int k = 0; k < 32; ++k) e += (pend[k] <= tid * 256) ? 1 : 0; blke[tid] = e > 31 ? 31 : e; } if (tid == 0) blke[511] = pend[31] >> 8; }
    if (tid < 256) { const int a = wg * 256 + tid; const int e = toke[a]; const int slot = bas[e] + tokr[a]; sdst[slot] = a; slot_of[tid] = slot; }
    __syncthreads();
    const float* su = (const float*)(p.ws + WS_SU); float* xss = (float*)(p.ws + WS_XSS);
    if (tid < 256) xss[slot_of[tid]] = su[wg * 128 + (tid >> 1)];
    __syncthreads();
}

#ifndef MK_PER_PHASE
#define MK_PER_PHASE 0
#endif
constexpr int PH_PER_LAYER = 18, N_PHASES = DEPTH_ * PH_PER_LAYER + 1;
constexpr int CW_BAR = 1024;

__global__ void __launch_bounds__(NTHREADS, 2) mega(Params p_unused) {
    extern __shared__ __attribute__((aligned(16))) unsigned char lds[];
    const int tid0 = threadIdx.x;
    constexpr int G = 256, NGW = G * NWAVES;
    const int wg = blockIdx.x;
#define SUB_BEGIN() KPRef p = *KP(); unsigned char* ws = p.ws; (void)ws; int tid = threadIdx.x; asm volatile("" : "+v"(tid))
#define PHASE_BEGIN() KPRef p = *KP(); unsigned char* ws = p.ws; (void)ws; unsigned char* wl = (l == 0) ? p.ws : (unsigned char*)p.out; (void)wl; const size_t sl = (size_t)l * SW_LSTEP; (void)sl; int tid = threadIdx.x; asm volatile("" : "+v"(tid)); const int lane = tid & 63, wave = __builtin_amdgcn_readfirstlane(tid >> 6), gw = wg * NWAVES + wave; (void)lane; (void)gw
    volatile LAS unsigned* MISC = (volatile LAS unsigned*)((LAS unsigned char*)lds + MISC_OFF);
    for (int u = tid0; u < (LDS_BYTES - LDSCTL_OFF) / 4; u += NTHREADS) ((LAS unsigned*)((LAS unsigned char*)lds + LDSCTL_OFF))[u] = 0u;
    __syncthreads();
#define KP() ({ const __attribute__((address_space(4))) Params* _k = (const __attribute__((address_space(4))) Params*)__builtin_amdgcn_kernarg_segment_ptr(); asm volatile("" : "+s"(_k)); _k; })
    unsigned* ctl; { const __attribute__((address_space(4))) Params* k0 = KP(); ctl = (unsigned*)(k0->ws + WS_CTL); }
    XcdBarrier bar = xcd_barrier_post(ctl + CW_BAR, MISC + 8);
    int lo, hi; { const __attribute__((address_space(4))) Params* k0 = KP(); lo = k0->ph_lo; hi = k0->ph_hi; }
    float* sm = (float*)lds;
    PG8_LAS unsigned char* ring = (PG8_LAS unsigned char*)lds;
#ifndef PH_MASK
#define PH_MASK 0x7ffffu
#endif
#define IN(k) ((((PH_MASK) >> ((k) == DEPTH_ * PH_PER_LAYER ? 18 : ((k) % PH_PER_LAYER))) & 1u) && lo <= (k) && (k) < hi)
#define SEAM(k) do { if ((k) + 1 < hi) xcd_barrier(bar); } while (0)
#ifndef REPEAT_MASK
#define REPEAT_MASK 0u
#endif
#ifndef URM
#define URM 0u
#endif
#define UREP(bit) for (int ur_ = 0; ur_ < ((((URM) >> (bit)) & 1u) ? 2 : 1); ++ur_)
#ifndef REPEAT_L0
#define REPEAT_L0 0u
#endif
#define NREP(k) (((((REPEAT_MASK) >> ((k) % PH_PER_LAYER)) & 1u) || ((((REPEAT_L0) >> ((k) % PH_PER_LAYER)) & 1u) && (k) < PH_PER_LAYER)) ? 2 : 1)

    for (int l = 0; l < DEPTH_; ++l) {
        const int P0 = l * PH_PER_LAYER;
        if (IN(P0 + 0)) for (int rep_ = 0; rep_ < NREP(P0 + 0); ++rep_) { PHASE_BEGIN();
            if (l == 0) { UREP(8) { conv8_phase(p, 0, ws, lds, wg, G, wave, lane, 0, 736); conv_phase(p, 0, ws, lds, gw, NGW, wave, lane); } }
            if (l == 0) norm_phase<0>(p, l, gw, T_ / 4, NGW, lane); else norm_phase<1>(p, l, gw, T_ / 2, NGW, lane);
            SEAM(P0 + 0);
        }
        if (IN(P0 + 2)) for (int rep_ = 0; rep_ < NREP(P0 + 2); ++rep_) { PHASE_BEGIN();
            pg8::Gemm g{(const bf16_t*)(ws + WS_U8), (const bf16_t*)(wl + WS_WIN)};
            pg8::StaticOrder<T_ / 256, ZW / 256, 1024, 1024> S{G, wg, 0};
            pg8::EpiBf16S E{(bf16_t*)(ws + WS_Z), ZLD, (const float*)(ws + WS_SU), (const float*)(ws + WS_SWIN + sl), Z_GATE};
            pg8::gemm_phase<1024, 1024, 1024, true, true>(ring, g, S, E);
            SEAM(P0 + 2);
        }
        if (IN(P0 + 3)) for (int rep_ = 0; rep_ < NREP(P0 + 3); ++rep_) { PHASE_BEGIN();
            if (wg == 0) { int* cnt = (int*)(ws + WS_MCNT); cnt[tid] = 0; }
            UREP(0) { SUB_BEGIN(); la_loop<0>(p, l, lds, wg, tid); }
            UREP(1) { SUB_BEGIN(); la_loop<1>(p, l, lds, wg, tid); }
            UREP(2) { SUB_BEGIN(); for (int u = wg; u < 128; u += G) kmean_unit(p, sm, u, tid); }
            UREP(3) { SUB_BEGIN(); SwaGen SG{(const bf16_t*)(ws + WS_Z), (bf16_t*)(ws + WS_O), p.in[6] + l * 4, wg, G}; attn_loop<SwaFn>(lds, SG, tid); }
            SEAM(P0 + 3);
        }
        if (IN(P0 + 4)) for (int rep_ = 0; rep_ < NREP(P0 + 4); ++rep_) { PHASE_BEGIN(); moba_select(p, lds, wg, tid); { const int s = ((wg & 63) < 32) ? (wg >> 6) * 32 + (wg & 31) : 255; scan_phase(p, s, tid); }   SEAM(P0 + 4); }
        if (IN(P0 + 5)) for (int rep_ = 0; rep_ < NREP(P0 + 5); ++rep_) { PHASE_BEGIN();
            UREP(4) { SUB_BEGIN(); la_loop<2>(p, l, lds, wg, tid); }
            UREP(5) { SUB_BEGIN(); la_loop<3>(p, l, lds, wg, tid); }
            UREP(6) { SUB_BEGIN(); moba_sel_table(p, lds, tid); MobaSelGen MG{(const bf16_t*)(ws + WS_Z), (const int*)(ws + WS_MLIST), (const int*)(ws + WS_MCNT), (bf16_t*)(ws + WS_PARTO), (f32x2*)(ws + WS_PARTML), (const int*)(lds + LDS_MTAB), wg, G}; attn_loop<MobaSelFn>(lds, MG, tid); }
            SEAM(P0 + 5);
        }
        if (IN(P0 + 6)) for (int rep_ = 0; rep_ < NREP(P0 + 6); ++rep_) { PHASE_BEGIN();
            UREP(7) { SUB_BEGIN(); MobaOwnGen OG{(const bf16_t*)(ws + WS_Z), (bf16_t*)(ws + WS_O), (const bf16_t*)(ws + WS_PARTO), (const f32x2*)(ws + WS_PARTML), wg, G}; attn_loop<MobaOwnFn>(lds, OG, tid); }
            SEAM(P0 + 6);
        }
        for (int hf = 0; hf < 2; ++hf) {
            if (IN(P0 + 7 + 2 * hf)) for (int rep_ = 0; rep_ < NREP(P0 + 7 + 2 * hf); ++rep_) { PHASE_BEGIN();
                pg8::Gemm g{(const bf16_t*)(ws + WS_O), (const bf16_t*)(wl + WS_WB)};
                pg8::StaticOrder<T_ / 512, 16, 2 * OLD, 512, 2, 512> S{G, wg, 64 * hf};
                pg8::EpiBf16 E{(bf16_t*)(ws + WS_YH), pg8::YLD, 16384 * hf};
                pg8::gemm_phase<2 * OLD, 512, 512, false, true>(ring, g, S, E);
                SEAM(P0 + 7 + 2 * hf);
            }
            if (IN(P0 + 8 + 2 * hf)) for (int rep_ = 0; rep_ < NREP(P0 + 8 + 2 * hf); ++rep_) { PHASE_BEGIN();
                pg8::Gemm g{(const bf16_t*)(ws + WS_U8), (const bf16_t*)(wl + WS_WG)};
                pg8::StaticOrder<T_ / 512, 16, 1024, 1024> S{G, wg, 64 * hf};
                pg8::EpiGate E{(const bf16_t*)(ws + WS_YH), 16384 * hf, (bf16_t*)(ws + WS_O), (const float*)(ws + WS_SU), (const float*)(ws + WS_SWG + sl)};
                pg8::gemm_phase<1024, 1024, 1024, true, true>(ring, g, S, E);
                SEAM(P0 + 8 + 2 * hf);
            }
        }
        if (IN(P0 + 11)) for (int rep_ = 0; rep_ < NREP(P0 + 11); ++rep_) { PHASE_BEGIN();
            pg8::Gemm g{(const bf16_t*)(ws + WS_O), (const bf16_t*)(wl + WS_WO)};
            pg8::StaticOrder<T_ / 256, 4, 2 * OLD, 2048> S{G, wg, 0};
            if (l == 0) { pg8::EpiRes<true> E{(const void*)p.in[0], hbf_ptr(p, 0)}; pg8::gemm_phase<2 * OLD, 2048, 2048, false, true>(ring, g, S, E); }
            else { pg8::EpiRes<false> E{(const void*)hbf_ptr(p, 1), hbf_ptr(p, 1)}; pg8::gemm_phase<2 * OLD, 2048, 2048, false, true>(ring, g, S, E); }
            SEAM(P0 + 11);
        }
        if (IN(P0 + 12)) for (int rep_ = 0; rep_ < NREP(P0 + 12); ++rep_) { PHASE_BEGIN();
            pg8::Gemm g{(const bf16_t*)hbf_ptr(p, l), (const bf16_t*)(wl + WS_WR)};
            pg8::StaticOrder<T_ / 256, 1, 2048, 2048> S{G, wg, 0};
            pg8::EpiRouter E{(float*)(ws + WS_LOGIT)};
            pg8::gemm_phase<2048, 2048, 2048, false>(ring, g, S, E);
            if (wg < 128) norm_phase<2>(p, l, gw, 2048, 1024, lane);
            else norm_phase<2>(p, l, 2048 + (wg - 128) * NWAVES + wave, T_ / 4, 1024, lane);
            SEAM(P0 + 12);
        }
        if (IN(P0 + 14)) for (int rep_ = 0; rep_ < NREP(P0 + 14); ++rep_) { PHASE_BEGIN(); route_phase(p, l, sm, wg, tid); SEAM(P0 + 14); }
        if (IN(P0 + 15)) for (int rep_ = 0; rep_ < NREP(P0 + 15); ++rep_) { PHASE_BEGIN(); assign_phase(p, sm, wg, tid, wave, lane); SEAM(P0 + 15); }
        if (IN(P0 + 16)) for (int rep_ = 0; rep_ < NREP(P0 + 16); ++rep_) { PHASE_BEGIN();
            const int* blke = (const int*)(ws + WS_BLKE); const int nb = __builtin_amdgcn_readfirstlane(blke[511]);
            pg8::Gemm g{(const bf16_t*)(ws + WS_U8), (const bf16_t*)(wl + WS_E1)};
            if (l == 0) {
                pg8::MoeOrder<2, true> S{blke, nb, G, wg, (size_t)0, (size_t)256 * 1024, (size_t)512 * 1024, (const int*)(ws + WS_SDST), nullptr, 0u};
                pg8::EpiE1 E{(bf16_t*)(ws + WS_HDN), (const float*)(ws + WS_XSS), (const float*)(ws + WS_SWE1 + sl), blke};
                pg8::gemm_phase<1024, 1024, 1024, true, true>(ring, g, S, E);
                {
                    const int tot = nb * 2, numax = (tot + G - 1) / G; int th = tot - G * (numax - 1); if (th > 192) th = 0;
                    if (wg >= th) conv8_phase(p, 1, (unsigned char*)p.out, lds, wg - th, G - th, wave, lane, 0, 736); }
                SEAM(P0 + 16);
            } else {
                pg8::MoeOrder<2, true, 1> S{blke, nb, G, wg, (size_t)0, (size_t)256 * 1024, (size_t)512 * 1024, (const int*)(ws + WS_SDST), (unsigned*)(ws + WS_RBCNT), 0u};
                pg8::EpiE1T<true> E{(bf16_t*)(ws + WS_HDN), (const float*)(ws + WS_XSS), (const float*)(ws + WS_SWE1 + sl), blke};
                pg8::gemm_phase<1024, 1024, 1024, true, true>(ring, g, S, E);
            }
        }
        if (IN(P0 + 17)) for (int rep_ = 0; rep_ < NREP(P0 + 17); ++rep_) { PHASE_BEGIN();
            const int* blke = (const int*)(ws + WS_BLKE); const int nb = __builtin_amdgcn_readfirstlane(blke[511]);
            pg8::Gemm g{(const bf16_t*)(ws + WS_HDN), (const bf16_t*)(wl + WS_E2)};
            pg8::EpiE2 E{(bf16_t*)(ws + WS_YS), (const int*)(ws + WS_SDST)};
            if (l == 0) {
                pg8::MoeOrder<4> S{blke, nb, G, wg, (size_t)256 * 256 * 2, (size_t)256 * 256 * 2, (size_t)1024 * 256 * 2, nullptr, nullptr, 0u};
                pg8::gemm_phase<512, 512, 512, false, true>(ring, g, S, E);
                {
                    const int tot = nb * 4, numax = (tot + G - 1) / G; int th = tot - G * (numax - 1); if (th > 192) th = 0;
                    if (wg >= th) conv_phase(p, 1, (unsigned char*)p.out, lds, (wg - th) * NWAVES + wave, (G - th) * NWAVES, wave, lane); }
            } else {
                const int off8 = (((nb * 2) & (G - 1)) + 7) & ~7;
                pg8::MoeOrder<4, false, 2> S{blke, nb, G, (wg - off8) & (G - 1), (size_t)256 * 256 * 2, (size_t)256 * 256 * 2, (size_t)1024 * 256 * 2, nullptr, (unsigned*)(ws + WS_RBCNT), 16u};
                pg8::gemm_phase<512, 512, 512, false, true>(ring, g, S, E);
            }
            SEAM(P0 + 17);
        }
    }
    if (IN(DEPTH_ * PH_PER_LAYER)) { constexpr int l = 0; PHASE_BEGIN(); final_phase(p, gw, NGW, lane); }
#undef IN
#undef SEAM
}

extern "C" void kernel_launch(void* const* d_in, const int* in_sizes, int n_in, void* d_out, int out_size, void* d_ws, size_t ws_size, hipStream_t stream) {
    static int grid = 0;
    if (grid == 0) {
        if (n_in != 19 || out_size != T_ * D_ || ws_size < WS_END) { fprintf(stderr, "kernel_launch: unexpected shapes (n_in %d, out %d, ws %zu); nothing launched\n", n_in, out_size, ws_size); grid = -1; return; }
        int dev = 0, cus = 0;
        if (hipGetDevice(&dev) != hipSuccess || hipDeviceGetAttribute(&cus, hipDeviceAttributeMultiprocessorCount, dev) != hipSuccess) { grid = -1; return; }
        if (hipFuncSetAttribute((const void*)mega, hipFuncAttributeMaxDynamicSharedMemorySize, LDS_BYTES) != hipSuccess) { fprintf(stderr, "kernel_launch: hipFuncSetAttribute failed\n"); grid = -1; return; }
        int per_cu = 0;
        if (hipOccupancyMaxActiveBlocksPerMultiprocessor(&per_cu, (const void*)mega, NTHREADS, LDS_BYTES) != hipSuccess || per_cu < 1) { fprintf(stderr, "kernel_launch: occupancy query reports %d blocks per CU\n", per_cu); }
        (void)hipGetLastError();
        if (cus != 256) { fprintf(stderr, "kernel_launch: built for a 256-CU device (got %d); nothing launched\n", cus); grid = -1; return; }
        grid = cus;
    }
    if (grid <= 0) return;
    Params p{};
    for (int i = 0; i < 19; ++i) p.in[i] = (const float*)d_in[i];
    p.out = (float*)d_out; p.ws = (unsigned char*)d_ws;
    for (int f = 0; f < 16; ++f) p.inv_freq[f] = (float)std::pow(10000.0, -(double)f / 16.0);
    for (int h = 0; h < 4; ++h) p.ret_lg2[h] = (float)std::log2(1.0 - std::exp2(-5.0 - (double)h));
    hipMemsetAsync((unsigned char*)d_ws + WS_CTL, 0, CTL_BYTES, stream);
#if MK_PER_PHASE
    for (int ph = 0; ph < N_PHASES; ++ph) { p.ph_lo = ph; p.ph_hi = ph + 1; hipLaunchKernelGGL(mega, dim3(grid), dim3(NTHREADS), LDS_BYTES, stream, p); }
#else
    p.ph_lo = 0; p.ph_hi = N_PHASES;
    hipLaunchKernelGGL(mega, dim3(grid), dim3(NTHREADS), LDS_BYTES, stream, p);
#endif
}
```
